# Optimizing an MI355X kernel written in HIP

```python
import jax
import jax.numpy as jnp
from jax import lax
import numpy as np

D_MODEL = 1024
BATCH = 32
SEQ = 2048
DEPTH = 1
DEC_BATCH = 32
DEC_SEQ = 64
PAST_LEN = 2048

CHUNK = 64
RET_HEADS = 4
RET_DK = 128
RET_DV = 128
RET_WIDTH = RET_HEADS * RET_DV
ATT_HEADS = 8
ATT_KV_HEADS = 2
ATT_HD = 64
ATT_REP = ATT_HEADS // ATT_KV_HEADS
ATT_WIDTH = ATT_HEADS * ATT_HD
WINDOW = 128
BAND_CHUNKS = WINDOW // CHUNK
MIX_WIDTH = RET_WIDTH + ATT_WIDTH
D_FF = 2816
CONV_W = 3
EPS = 1e-6
IN_SIZES = (RET_HEADS * RET_DK, RET_HEADS * RET_DK, RET_WIDTH, RET_WIDTH,
            ATT_WIDTH, ATT_KV_HEADS * ATT_HD, ATT_KV_HEADS * ATT_HD)
IN_WIDTH = sum(IN_SIZES)

kernel_name = 'hymba_retention_swa_convffn_stream_step'


def rmsnorm(x, g):
    xf = x.astype(jnp.float32)
    y = xf * lax.rsqrt(jnp.mean(xf * xf, axis=-1, keepdims=True) + EPS)
    return (y * g.astype(jnp.float32)).astype(x.dtype)


def modulate(h, shift, scale):
    return h * (1 + scale[:, None, :]) + shift[:, None, :]


def split_in(proj):
    idx = np.cumsum(IN_SIZES)[:-1].tolist()
    return jnp.split(proj, idx, axis=-1)


def ret_log_gamma():
    return jnp.log1p(-jnp.exp2(-5.0 - jnp.arange(RET_HEADS, dtype=jnp.float32)))


def retention_block(q, k, v, state):
    L = q.shape[1]
    lg = ret_log_gamma()
    i = jnp.arange(L, dtype=jnp.float32)
    diff = i[:, None] - i[None, :]
    decay = jnp.where(diff >= 0, jnp.exp(lg[:, None, None] * jnp.maximum(diff, 0.0)), 0.0)
    scores = jnp.einsum('blhd,bmhd->bhlm', q, k) * decay[None]
    intra = jnp.einsum('bhlm,bmhe->blhe', scores, v)
    q_decay = jnp.exp(lg[None, :] * (i[:, None] + 1.0))
    cross = jnp.einsum('blhd,bhde->blhe', q, state) * q_decay[None, :, :, None]
    k_decay = jnp.exp(lg[None, :] * (L - 1.0 - i[:, None]))
    new_state = (state * jnp.exp(lg * L)[None, :, None, None]
                 + jnp.einsum('blhd,blhe->bhde', k * k_decay[None, :, :, None], v))
    return intra + cross, new_state


def retention_qkv(rq, rk, rv):
    B, L = rq.shape[:2]
    q = rq.reshape(B, L, RET_HEADS, RET_DK).astype(jnp.float32)
    k = rk.reshape(B, L, RET_HEADS, RET_DK).astype(jnp.float32) * (RET_DK ** -0.5)
    v = rv.reshape(B, L, RET_HEADS, RET_DV).astype(jnp.float32)
    return q, k, v


def retention_out(o, rg):
    B, L = o.shape[:2]
    o = o * lax.rsqrt(jnp.mean(o * o, axis=-1, keepdims=True) + EPS)
    return (jax.nn.silu(rg.astype(jnp.float32)) * o.reshape(B, L, RET_WIDTH)).astype(rg.dtype)


def retention_prompt(rq, rk, rv, rg):
    B, S = rq.shape[:2]
    nc = S // CHUNK
    q, k, v = retention_qkv(rq, rk, rv)

    def to_chunks(t):
        return t.reshape(B, nc, CHUNK, *t.shape[2:]).swapaxes(0, 1)

    def step(state, blk):
        out, state = retention_block(blk[0], blk[1], blk[2], state)
        return state, out

    state0 = jnp.zeros((B, RET_HEADS, RET_DK, RET_DV), jnp.float32)
    state, outs = lax.scan(step, state0, (to_chunks(q), to_chunks(k), to_chunks(v)))
    o = outs.swapaxes(0, 1).reshape(B, S, RET_HEADS, RET_DV)
    return retention_out(o, rg), state


def retention_sample(rq, rk, rv, rg, state):
    q, k, v = retention_qkv(rq, rk, rv)
    o, new_state = retention_block(q, k, v, state.astype(jnp.float32))
    return retention_out(o, rg), new_state


def alibi_slopes():
    h = jnp.arange(1, ATT_HEADS + 1, dtype=jnp.float32)
    return jnp.exp2(-8.0 * h / ATT_HEADS)


def band_attention(q, k, v, sinks, q_pos, k_pos, k_valid):
    s = jnp.einsum('bnqgrd,bnkgd->bngrqk', q, k).astype(jnp.float32) * (ATT_HD ** -0.5)
    dist = jnp.abs(q_pos[:, :, None] - k_pos[:, None, :]).astype(jnp.float32)
    slopes = alibi_slopes().reshape(ATT_KV_HEADS, ATT_REP)
    s = s - slopes[None, None, :, :, None, None] * dist[None, :, None, None, :, :]
    s = jnp.where(k_valid[None, :, None, None, None, :], s, -jnp.inf)
    sink = sinks.astype(jnp.float32).reshape(ATT_KV_HEADS, ATT_REP)[None, None, :, :, None, None]
    m = jnp.maximum(jnp.max(s, axis=-1, keepdims=True), sink)
    p = jnp.exp(s - m)
    p = p / (jnp.sum(p, axis=-1, keepdims=True) + jnp.exp(sink - m))
    return jnp.einsum('bngrqk,bnkgd->bnqgrd', p.astype(v.dtype), v)


def band_view(t, nc):
    B = t.shape[0]
    tp = jnp.pad(t, ((0, 0), (BAND_CHUNKS * CHUNK, 0), (0, 0), (0, 0)))
    tc = tp.reshape(B, nc + BAND_CHUNKS, CHUNK, ATT_KV_HEADS, ATT_HD)
    return jnp.concatenate([tc[:, j:j + nc] for j in range(BAND_CHUNKS + 1)], axis=2)


def attention_prompt(aq, ak, av, sinks):
    B, S = aq.shape[:2]
    nc = S // CHUNK
    q = aq.reshape(B, nc, CHUNK, ATT_KV_HEADS, ATT_REP, ATT_HD)
    k = ak.reshape(B, S, ATT_KV_HEADS, ATT_HD)
    v = av.reshape(B, S, ATT_KV_HEADS, ATT_HD)
    q_pos = jnp.arange(S).reshape(nc, CHUNK)
    k_pos = ((jnp.arange(nc)[:, None] - BAND_CHUNKS) * CHUNK
             + jnp.arange((BAND_CHUNKS + 1) * CHUNK)[None, :])
    o = band_attention(q, band_view(k, nc), band_view(v, nc), sinks, q_pos, k_pos, k_pos >= 0)
    w = min(WINDOW, S)
    return o.reshape(B, S, ATT_WIDTH), k[:, S - w:], v[:, S - w:]


def attention_sample(aq, ak, av, sinks, cache_k, cache_v):
    B, L = aq.shape[:2]
    wc = cache_k.shape[1]
    q = aq.reshape(B, 1, L, ATT_KV_HEADS, ATT_REP, ATT_HD)
    k = ak.reshape(B, L, ATT_KV_HEADS, ATT_HD)
    v = av.reshape(B, L, ATT_KV_HEADS, ATT_HD)
    kk = jnp.concatenate([cache_k.astype(k.dtype), k], axis=1)[:, None]
    vv = jnp.concatenate([cache_v.astype(v.dtype), v], axis=1)[:, None]
    q_pos = (PAST_LEN + jnp.arange(L))[None, :]
    k_pos = (PAST_LEN - wc + jnp.arange(wc + L))[None, :]
    o = band_attention(q, kk, vv, sinks, q_pos, k_pos, k_pos >= 0)
    return o.reshape(B, L, ATT_WIDTH), k, v


def conv_ffn(h, w_up, conv_w, conv_b, w_down, conv_state):
    L = h.shape[1]
    a, b = jnp.split(h @ w_up, 2, axis=-1)
    ext = jnp.concatenate([conv_state.astype(a.dtype), a], axis=1)
    conv = conv_b[None, None, :] + sum(ext[:, j:j + L] * conv_w[j] for j in range(CONV_W))
    y = (jax.nn.silu(conv) * b) @ w_down
    return y, ext[:, L:]


def trunk_layer(x, c, ln1, ln2, w_ada, b_ada, w_in, w_out, sinks, w_up, conv_w, conv_b, w_down,
                cache_k=None, cache_v=None, ret_state=None, conv_state=None):
    is_prompt = cache_k is None
    B = x.shape[0]
    mod = jax.nn.silu(c) @ w_ada + b_ada
    sh1, sc1, g1, sh2, sc2, g2 = jnp.split(mod, 6, axis=-1)
    h = modulate(rmsnorm(x, ln1), sh1, sc1)
    rq, rk, rv, rg, aq, ak, av = split_in(h @ w_in)
    if is_prompt:
        ret_o, ret_new = retention_prompt(rq, rk, rv, rg)
        att_o, k_rows, v_rows = attention_prompt(aq, ak, av, sinks)
        conv_state = jnp.zeros((B, CONV_W - 1, D_FF), x.dtype)
    else:
        ret_o, ret_new = retention_sample(rq, rk, rv, rg, ret_state)
        att_o, k_rows, v_rows = attention_sample(aq, ak, av, sinks, cache_k, cache_v)
    mix = jnp.concatenate([ret_o, att_o], axis=-1) @ w_out
    x = x + g1[:, None, :] * mix
    h2 = modulate(rmsnorm(x, ln2), sh2, sc2)
    ffn, conv_new = conv_ffn(h2, w_up, conv_w, conv_b, w_down, conv_state)
    x = x + g2[:, None, :] * ffn
    return x, ret_new.astype(x.dtype), k_rows, v_rows, conv_new


def setup_inputs(seed: int = 0) -> dict:
    key = jax.random.key(seed)
    ks = jax.random.split(key, 24)
    f32 = jnp.float32

    def nrm(k, shape, s):
        return jax.random.normal(k, shape, f32) * s

    wc = min(WINDOW, PAST_LEN)
    return {
        'x_prompt': nrm(ks[0], (BATCH, SEQ, D_MODEL), 1.0),
        'x_sample': nrm(ks[1], (DEC_BATCH, DEC_SEQ, D_MODEL), 1.0),
        'cache_k': nrm(ks[2], (DEPTH, DEC_BATCH, wc, ATT_KV_HEADS, ATT_HD), 1.0),
        'cache_v': nrm(ks[3], (DEPTH, DEC_BATCH, wc, ATT_KV_HEADS, ATT_HD), 1.0),
        'state_ret': nrm(ks[4], (DEPTH, DEC_BATCH, RET_HEADS, RET_DK, RET_DV), 0.5),
        'state_conv': nrm(ks[5], (DEPTH, DEC_BATCH, CONV_W - 1, D_FF), 1.0),
        'c_prompt': nrm(ks[6], (BATCH, D_MODEL), 1.0),
        'c_sample': nrm(ks[7], (DEC_BATCH, D_MODEL), 1.0),
        'norm1_g': 1.0 + nrm(ks[8], (DEPTH, D_MODEL), 0.05),
        'norm2_g': 1.0 + nrm(ks[9], (DEPTH, D_MODEL), 0.05),
        'w_ada': nrm(ks[10], (DEPTH, D_MODEL, 6 * D_MODEL), 0.5 * D_MODEL ** -0.5),
        'b_ada': nrm(ks[11], (DEPTH, 6 * D_MODEL), 0.01),
        'w_in': nrm(ks[12], (DEPTH, D_MODEL, IN_WIDTH), D_MODEL ** -0.5),
        'w_out': nrm(ks[13], (DEPTH, MIX_WIDTH, D_MODEL), MIX_WIDTH ** -0.5),
        'attn_sinks': nrm(ks[14], (DEPTH, ATT_HEADS), 0.5),
        'w_up': nrm(ks[15], (DEPTH, D_MODEL, 2 * D_FF), D_MODEL ** -0.5),
        'conv_w': nrm(ks[16], (DEPTH, CONV_W, D_FF), CONV_W ** -0.5),
        'conv_b': nrm(ks[17], (DEPTH, D_FF), 0.01),
        'w_down': nrm(ks[18], (DEPTH, D_FF, D_MODEL), D_FF ** -0.5),
        'normf_g': 1.0 + nrm(ks[19], (D_MODEL,), 0.05),
        'w_ada_f': nrm(ks[20], (D_MODEL, 2 * D_MODEL), 0.5 * D_MODEL ** -0.5),
        'b_ada_f': nrm(ks[21], (2 * D_MODEL,), 0.01),
    }


def reference(x_prompt, x_sample, cache_k, cache_v, state_ret, state_conv, c_prompt, c_sample,
              norm1_g, norm2_g, w_ada, b_ada, w_in, w_out, attn_sinks, w_up, conv_w, conv_b,
              w_down, normf_g, w_ada_f, b_ada_f):
    yp, ys = x_prompt, x_sample
    p_ret, p_k, p_v, p_conv = [], [], [], []
    s_ret, s_k, s_v, s_conv = [], [], [], []
    for l in range(DEPTH):
        yp, r, kr, vr, cv = trunk_layer(yp, c_prompt, norm1_g[l], norm2_g[l], w_ada[l], b_ada[l],
                                        w_in[l], w_out[l], attn_sinks[l], w_up[l], conv_w[l],
                                        conv_b[l], w_down[l])
        p_ret.append(r); p_k.append(kr); p_v.append(vr); p_conv.append(cv)
        ys, r, kr, vr, cv = trunk_layer(ys, c_sample, norm1_g[l], norm2_g[l], w_ada[l], b_ada[l],
                                        w_in[l], w_out[l], attn_sinks[l], w_up[l], conv_w[l],
                                        conv_b[l], w_down[l], cache_k=cache_k[l], cache_v=cache_v[l],
                                        ret_state=state_ret[l], conv_state=state_conv[l])
        s_ret.append(r); s_k.append(kr); s_v.append(vr); s_conv.append(cv)
    shp, scp = jnp.split(jax.nn.silu(c_prompt) @ w_ada_f + b_ada_f, 2, axis=-1)
    shs, scs = jnp.split(jax.nn.silu(c_sample) @ w_ada_f + b_ada_f, 2, axis=-1)
    y_prompt = modulate(rmsnorm(yp, normf_g), shp, scp)
    y_sample = modulate(rmsnorm(ys, normf_g), shs, scs)
    p_state_ret = jnp.stack(p_ret)
    p_k_rows = jnp.stack(p_k)
    p_v_rows = jnp.stack(p_v)
    p_state_conv = jnp.stack(p_conv)
    s_state_ret = jnp.stack(s_ret)
    s_k_rows = jnp.stack(s_k)
    s_v_rows = jnp.stack(s_v)
    s_state_conv = jnp.stack(s_conv)
    return (y_prompt, y_sample, p_state_ret, p_k_rows, p_v_rows, p_state_conv,
            s_state_ret, s_k_rows, s_v_rows, s_state_conv)
```

```cpp
#include <hip/hip_runtime.h>
#include <hip/hip_cooperative_groups.h>
#include <cstdio>
#include <cstdint>
namespace cg = cooperative_groups;
namespace pg8 {
#define PG8_LAS __attribute__((address_space(3)))
typedef unsigned short bf16_t;
typedef short bf16x8 __attribute__((ext_vector_type(8)));
typedef float f32x4 __attribute__((ext_vector_type(4)));
typedef unsigned u32x4 __attribute__((ext_vector_type(4)));
constexpr int BM = 256, BK = 64, HALF = 128, HTB = HALF * BK * 2  , STAGE_BYTES = 8 * HTB, NXCD = 8, WGM = 8;

__host__ __device__ __forceinline__ int lds_byte(int r, int c) { const int st = (r >> 4) * 2 + (c >> 5), rr = r & 15, cc = c & 31, ob = rr * 64 + cc * 2; return st * 1024 + (ob ^ (((ob >> 9) & 1) << 5)); }
__host__ __device__ __forceinline__ void stage_rc(int b, int& R, int& C) { const int st = b / 1024, sb = b % 1024, swz = sb ^ (((sb >> 9) & 1) << 5); R = (st >> 1) * 16 + swz / 64; C = (st & 1) * 32 + (swz % 64) / 2; }
__host__ __device__ __forceinline__ int perm32(int rho) { const int n = rho >> 4, i = rho & 15; return 8 * (i >> 2) + 4 * n + (i & 3); }

struct Unit { int pm, pn, seq; };
struct Gemm { const bf16_t* A; const bf16_t* Bt; int M, N, K; };

struct StaticOrder {
    int nM, nN, nwg, G, c;
    __host__ __device__ __forceinline__ void init(int M, int N, int G_, int c_) { nM = M / BM; nN = N / BM; nwg = nM * nN; G = G_; c = c_; }
    __host__ __device__ __forceinline__ bool next(int i, Unit& u) const {
        const long L = (long)i * G + c; if (L >= nwg) return false; u.seq = i;
        int wgid = (int)L; { const int q = nwg / NXCD, r = nwg % NXCD, xcd = wgid % NXCD, off = wgid / NXCD; wgid = (xcd < r ? xcd * (q + 1) : r * (q + 1) + (xcd - r) * q) + off; }
        const int nig = WGM * nN, gid = wgid / nig, fm = gid * WGM, gsz = (nM - fm) < WGM ? (nM - fm) : WGM;
        u.pm = fm + ((wgid % nig) % gsz); u.pn = (wgid % nig) / gsz; return true;
    }
    __device__ __forceinline__ void a_ready(const Unit&) const {}
    __device__ __forceinline__ void done(const Unit&) const {}
};

__device__ __forceinline__ unsigned cvt_pk_bf16(float lo, float hi) { unsigned r; asm volatile("v_cvt_pk_bf16_f32 %0, %1, %2" : "=v"(r) : "v"(lo), "v"(hi)); return r; }

template <class Epi, class Sched, bool ALIGN_EPI = false, bool SP2 = false>
__device__ __forceinline__ void gemm_phase(PG8_LAS unsigned char* lds, const Gemm g, const Sched& S, const Epi& E) {
    int tid_ = threadIdx.x; asm volatile("" : "+v"(tid_));
    const int tid = tid_, wid = __builtin_amdgcn_readfirstlane(tid >> 6), lane = tid & 63, wr = wid >> 2, wc = wid & 3, fr = lane & 15, fq = lane >> 4;
    const int K = g.K, nt = K / BK;
    unsigned voffA[2], voffB[2];
#pragma unroll
    for (int i = 0; i < 2; ++i) { int R, C; stage_rc(tid * 16 + i * 8192, R, C); const int Rb = Epi::PERM ? ((R & ~31) + perm32(R & 31)) : R;
        voffA[i] = (unsigned)(R * K + C) * 2u; voffB[i] = (unsigned)(Rb * K + C) * 2u; }
    const size_t kstep = (size_t)(BK * 2);
    const size_t hstep = (size_t)HALF * K * 2;
    const size_t tstep = 2 * hstep;
    const unsigned ldsw = (unsigned)wid * 1024u;
    const int aoff = lds_byte(wr * 64 + fr, fq * 8), boff = lds_byte(wc * 32 + fr, fq * 8);
#define PG8_SA(b, h) (((b) * 2 + (h)) * HTB)
#define PG8_SB(b, h) ((4 + (b) * 2 + (h)) * HTB)
#define PG8_STAGE(bufoff, gbase, voff) do { _Pragma("unroll") for (int _i = 0; _i < 2; ++_i) \
        __builtin_amdgcn_global_load_lds((const unsigned*)((const char*)(gbase) + (voff)[_i]), (PG8_LAS unsigned*)(lds + (bufoff) + ldsw + _i * 8192), 16, 0, 0); } while (0)
#define PG8_LDA(dst, b, h) do { _Pragma("unroll") for (int m = 0; m < 4; ++m) _Pragma("unroll") for (int k = 0; k < 2; ++k) dst[m][k] = *(const PG8_LAS bf16x8*)(lds + PG8_SA(b, h) + aoff + m * 2048 + k * 1024); } while (0)
#define PG8_LDB(dst, b, h) do { _Pragma("unroll") for (int n = 0; n < 2; ++n) _Pragma("unroll") for (int k = 0; k < 2; ++k) dst[n][k] = *(const PG8_LAS bf16x8*)(lds + PG8_SB(b, h) + boff + n * 2048 + k * 1024); } while (0)
#define PG8_MMA(ai, bj, At, Bt) do { __builtin_amdgcn_s_setprio(1); _Pragma("unroll") for (int m = 0; m < 4; ++m) _Pragma("unroll") for (int n = 0; n < 2; ++n) _Pragma("unroll") for (int k = 0; k < 2; ++k) \
        acc[ai][bj][m][n] = __builtin_amdgcn_mfma_f32_16x16x32_bf16(Bt[n][k], At[m][k], acc[ai][bj][m][n], 0, 0, 0); __builtin_amdgcn_s_setprio(0); } while (0)
#define PG8_WAIT_V(n) asm volatile("s_waitcnt vmcnt(" #n ")" ::: "memory")
#define PG8_WAIT_L(n) asm volatile("s_waitcnt lgkmcnt(" #n ")" ::: "memory")
#define PG8_BAR __builtin_amdgcn_s_barrier()
#define PG8_SCHED __builtin_amdgcn_sched_barrier(0)
    Unit cur, nxt; int ui = 0;
    if (!S.next(0, cur)) return;
    f32x4 acc[2][2][4][2];
#pragma unroll
    for (int a = 0; a < 2; ++a)
#pragma unroll
        for (int b = 0; b < 2; ++b)
#pragma unroll
            for (int m = 0; m < 4; ++m)
#pragma unroll
                for (int n = 0; n < 2; ++n) acc[a][b][m][n] = (f32x4){0.f, 0.f, 0.f, 0.f};
    bf16x8 At[4][2], B0[2][2], B1[2][2];
    const char* cA = (const char*)g.A + (size_t)cur.pm * tstep; const char* cB = (const char*)g.Bt + (size_t)cur.pn * tstep;
    S.a_ready(cur);
    if constexpr (SP2) {
        PG8_STAGE(PG8_SB(0, 0), cB, voffB); PG8_STAGE(PG8_SB(0, 1), cB + hstep, voffB); PG8_STAGE(PG8_SA(0, 0), cA, voffA); PG8_STAGE(PG8_SA(0, 1), cA + hstep, voffA);
        if (wr == 1) PG8_BAR;
        PG8_WAIT_V(2); PG8_BAR;
        PG8_STAGE(PG8_SB(1, 0), cB + kstep, voffB); PG8_STAGE(PG8_SA(1, 0), cA + kstep, voffA); PG8_STAGE(PG8_SB(1, 1), cB + hstep + kstep, voffB);
        PG8_WAIT_V(6); PG8_BAR;
    } else {
        PG8_STAGE(PG8_SB(0, 0), cB, voffB); PG8_STAGE(PG8_SA(0, 0), cA, voffA); PG8_STAGE(PG8_SB(0, 1), cB + hstep, voffB); PG8_STAGE(PG8_SA(0, 1), cA + hstep, voffA);
        if (wr == 1) PG8_BAR;
        PG8_WAIT_V(4); PG8_BAR;
        PG8_STAGE(PG8_SB(1, 0), cB + kstep, voffB); PG8_STAGE(PG8_SA(1, 0), cA + kstep, voffA); PG8_STAGE(PG8_SB(1, 1), cB + hstep + kstep, voffB);
        PG8_WAIT_V(6); PG8_BAR;
    }
    for (;;) {
        const bool has_next = S.next(ui + 1, nxt);
        const char* nA = has_next ? (const char*)g.A + (size_t)nxt.pm * tstep : cA; const char* nB = has_next ? (const char*)g.Bt + (size_t)nxt.pn * tstep : cB;
        for (int t = 0; t < nt; t += 2) {
            const bool last = (t == nt - 2);
            const char* a1 = cA + (size_t)(t + 1) * kstep;
            const char* a2 = last ? nA : cA + (size_t)(t + 2) * kstep; const char* b2 = last ? nB : cB + (size_t)(t + 2) * kstep;
            const char* a3 = a2 + kstep; const char* b3 = b2 + kstep;
            if (last && has_next) S.a_ready(nxt);
            if constexpr (SP2) {
            PG8_LDB(B0, 0, 0); PG8_LDB(B1, 0, 1); PG8_SCHED; PG8_LDA(At, 0, 0); PG8_STAGE(PG8_SA(1, 1), a1 + hstep, voffA);
            PG8_WAIT_V(8); PG8_WAIT_L(0); PG8_BAR; PG8_MMA(0, 0, At, B0); PG8_MMA(0, 1, At, B1); PG8_BAR; PG8_SCHED;
            PG8_LDA(At, 0, 1); PG8_STAGE(PG8_SB(0, 0), b2, voffB); PG8_STAGE(PG8_SB(0, 1), b2 + hstep, voffB); PG8_STAGE(PG8_SA(0, 0), a2, voffA);
            PG8_WAIT_V(8); PG8_WAIT_L(0); PG8_BAR; PG8_MMA(1, 0, At, B0); PG8_MMA(1, 1, At, B1); PG8_BAR; PG8_SCHED;
            PG8_LDB(B0, 1, 0); PG8_LDB(B1, 1, 1); PG8_SCHED; PG8_LDA(At, 1, 0); PG8_STAGE(PG8_SA(0, 1), a2 + hstep, voffA);
            PG8_WAIT_V(8); PG8_WAIT_L(0); PG8_BAR; PG8_MMA(0, 0, At, B0); PG8_MMA(0, 1, At, B1); PG8_BAR; PG8_SCHED;
            PG8_LDA(At, 1, 1); PG8_STAGE(PG8_SB(1, 0), b3, voffB); PG8_STAGE(PG8_SB(1, 1), b3 + hstep, voffB); PG8_STAGE(PG8_SA(1, 0), a3, voffA);
            PG8_WAIT_V(8); PG8_WAIT_L(0); PG8_BAR; PG8_MMA(1, 0, At, B0); PG8_MMA(1, 1, At, B1); PG8_BAR; PG8_SCHED;
            } else {
            PG8_LDB(B0, 0, 0); PG8_SCHED; PG8_LDA(At, 0, 0); PG8_STAGE(PG8_SA(1, 1), a1 + hstep, voffA);
            PG8_WAIT_L(8); PG8_BAR; PG8_WAIT_L(0); PG8_MMA(0, 0, At, B0); PG8_BAR; PG8_SCHED;
            PG8_LDB(B1, 0, 1); PG8_STAGE(PG8_SB(0, 0), b2, voffB);
            PG8_BAR; PG8_WAIT_L(0); PG8_MMA(0, 1, At, B1); PG8_BAR;
            PG8_LDA(At, 0, 1); PG8_STAGE(PG8_SA(0, 0), a2, voffA);
            PG8_BAR; PG8_WAIT_L(0); PG8_MMA(1, 0, At, B0); PG8_BAR; PG8_SCHED;
            PG8_STAGE(PG8_SB(0, 1), b2 + hstep, voffB);
            PG8_WAIT_V(6); PG8_BAR; PG8_MMA(1, 1, At, B1); PG8_BAR;
            PG8_LDB(B0, 1, 0); PG8_SCHED; PG8_LDA(At, 1, 0); PG8_STAGE(PG8_SA(0, 1), a2 + hstep, voffA);
            PG8_WAIT_L(8); PG8_BAR; PG8_WAIT_L(0); PG8_MMA(0, 0, At, B0); PG8_BAR; PG8_SCHED;
            PG8_LDB(B1, 1, 1); PG8_STAGE(PG8_SB(1, 0), b3, voffB);
            PG8_BAR; PG8_WAIT_L(0); PG8_MMA(0, 1, At, B1); PG8_BAR;
            PG8_LDA(At, 1, 1); PG8_STAGE(PG8_SA(1, 0), a3, voffA);
            PG8_BAR; PG8_WAIT_L(0); PG8_MMA(1, 0, At, B0); PG8_BAR; PG8_SCHED;
            PG8_STAGE(PG8_SB(1, 1), b3 + hstep, voffB);
            PG8_WAIT_V(6); PG8_BAR; PG8_MMA(1, 1, At, B1); PG8_BAR;
            }
        }
        if constexpr (ALIGN_EPI) { if (wr == 0) PG8_BAR; }
        if constexpr (!Epi::AFTER_DRAIN) { E(acc, cur, wr, wc, fr, fq); S.done(cur); }
        if (!has_next) break;
#pragma unroll
        for (int a = 0; a < 2; ++a)
#pragma unroll
            for (int b = 0; b < 2; ++b)
#pragma unroll
                for (int m = 0; m < 4; ++m)
#pragma unroll
                    for (int n = 0; n < 2; ++n) acc[a][b][m][n] = (f32x4){0.f, 0.f, 0.f, 0.f};
        cur = nxt; cA = nA; cB = nB; ++ui;
        if constexpr (ALIGN_EPI) { if (wr == 1) PG8_BAR; }
    }
    PG8_WAIT_V(0);
    if constexpr (!ALIGN_EPI) { if (wr == 0) PG8_BAR; }
    PG8_BAR;
    if constexpr (Epi::AFTER_DRAIN) { E.fused(acc, cur, wr, wc, fr, fq, lds, wid, lane); S.done(cur); }
#undef PG8_SA
#undef PG8_SB
#undef PG8_STAGE
#undef PG8_LDA
#undef PG8_LDB
#undef PG8_MMA
#undef PG8_WAIT_V
#undef PG8_WAIT_L
#undef PG8_BAR
#undef PG8_SCHED
}
}
constexpr int DM = 1024, SEQ = 2048, NB = 32, DECL = 64, DFF = 2816, INW = 2816;
constexpr int MP = NB * SEQ, MS = NB * DECL, MT = MP + MS;
constexpr int NGRP = MT / 64;
constexpr int NTM = MT / 256;
constexpr float EPS = 1e-6f;
constexpr size_t OFF_Y = 0;
constexpr size_t OFF_PRET = (size_t)MT * DM;
constexpr size_t OFF_PK = OFF_PRET + (size_t)NB * 4 * 128 * 128;
constexpr size_t OFF_PV = OFF_PK + (size_t)NB * 128 * 128;
constexpr size_t OFF_PCONV = OFF_PV + (size_t)NB * 128 * 128;
constexpr size_t OFF_SRET = OFF_PCONV + (size_t)NB * 2 * DFF;
constexpr size_t OFF_SK = OFF_SRET + (size_t)NB * 4 * 128 * 128;
constexpr size_t OFF_SV = OFF_SK + (size_t)NB * 64 * 128;
constexpr size_t OFF_SCONV = OFF_SV + (size_t)NB * 64 * 128;
constexpr size_t OUT_TOTAL = OFF_SCONV + (size_t)NB * 2 * DFF;
constexpr size_t MiB = 1u << 20;
constexpr size_t WS_WIN = 0;
constexpr size_t WS_WUP = WS_WIN + (size_t)INW * DM * 2;
constexpr size_t WS_WOUT = WS_WUP + (size_t)2 * DFF * DM * 2;
constexpr size_t WS_WDN = WS_WOUT + (size_t)DM * DM * 2;
constexpr size_t WS_MODP = 24 * MiB;
constexpr size_t WS_MOD = 32 * MiB;
constexpr size_t WS_SHW = 34 * MiB;
constexpr size_t WS_SS1 = 36 * MiB;
constexpr size_t WS_SS2 = 41 * MiB;
constexpr size_t WS_R0 = 48 * MiB;
constexpr size_t WS_R1 = WS_R0 + 133 * MiB;
constexpr size_t WS_R2 = WS_R1 + 363 * MiB;
constexpr size_t WS_END = WS_R2 + 363 * MiB;
static_assert(WS_WDN + (size_t)DM * DFF * 2 <= WS_MODP, "ws map");
static_assert((size_t)(MT + 256) * DM * 2 <= 133 * MiB && (size_t)MT * DFF * 2 <= 363 * MiB, "ws map");
constexpr size_t HT_STRIDE = (size_t)NGRP * 2 * DFF;
static_assert(3 * HT_STRIDE * 4 <= 133 * MiB, "ws map");

constexpr int LDS_BYTES = 155648;

#define LAS __attribute__((address_space(3)))
typedef unsigned short bf16;
typedef float f32x4 __attribute__((ext_vector_type(4)));
typedef float f32x2 __attribute__((ext_vector_type(2)));
typedef short bf16x8 __attribute__((ext_vector_type(8)));
typedef unsigned u32x4 __attribute__((ext_vector_type(4)));
typedef unsigned u32x2 __attribute__((ext_vector_type(2)));
typedef __bf16 bf16x2_t __attribute__((ext_vector_type(2)));
#define LDS_WAIT() asm volatile("s_waitcnt lgkmcnt(0)" ::: "memory")

__device__ __forceinline__ unsigned pk2(float lo, float hi) { f32x2 v = {lo, hi}; bf16x2_t b = __builtin_convertvector(v, bf16x2_t); return __builtin_bit_cast(unsigned, b); }
__device__ __forceinline__ float bflo(unsigned w) { return __uint_as_float(w << 16); }
__device__ __forceinline__ float bfhi(unsigned w) { return __uint_as_float(w & 0xffff0000u); }
__device__ __forceinline__ float wave_sum(float v) {
#pragma unroll
    for (int o = 1; o < 64; o <<= 1) v += __shfl_xor(v, o);
    return v;
}
__device__ __forceinline__ float silu_f(float x) { return x * __builtin_amdgcn_rcpf(1.0f + __builtin_amdgcn_exp2f(-1.4426950408889634f * x)); }
__device__ __forceinline__ int grp_bs(int g) { return g < 1024 ? (g >> 5) : 32 + (g - 1024); }

struct Params {
    const float *x_p, *x_s, *cache_k, *cache_v, *state_ret, *state_conv, *c_p, *c_s, *ln1, *ln2, *w_ada, *b_ada, *w_in, *w_out, *sinks, *w_up, *conv_w, *conv_b, *w_down, *normf, *w_ada_f, *b_ada_f;
    float* out; unsigned char* ws;
};

__device__ __forceinline__ void transpose_item(const float* W, int K, int N, bf16* WT, int dst_row0, int k0, int n0, LAS float* scr, int lane) {
#pragma unroll 8
    for (int i = 0; i < 32; ++i) { const int kk = 2 * i + (lane >> 5); scr[kk * 33 + (lane & 31)] = W[(size_t)(k0 + kk) * N + n0 + (lane & 31)]; }
    LDS_WAIT(); asm volatile("" ::: "memory");
    const int c = lane & 7;
#pragma unroll
    for (int j = 0; j < 4; ++j) { const int n = (lane >> 3) + 8 * j; const LAS float* s = scr + (8 * c) * 33 + n;
        u32x4 o; o.x = pk2(s[0 * 33], s[1 * 33]); o.y = pk2(s[2 * 33], s[3 * 33]); o.z = pk2(s[4 * 33], s[5 * 33]); o.w = pk2(s[6 * 33], s[7 * 33]);
        *(u32x4*)(WT + (size_t)(dst_row0 + n) * K + k0 + 8 * c) = o; }
    LDS_WAIT(); asm volatile("" ::: "memory");
}
__device__ __forceinline__ void mod_item(const Params& P, int it, LAS float* scr, int lane) {
    const int ct = it >> 2, ks = it & 3, c0 = ct * 64;
    const float* W; const float* bias; int ldw;
    if (c0 < 6144) { W = P.w_ada + c0; bias = P.b_ada + c0; ldw = 6144; } else { W = P.w_ada_f + (c0 - 6144); bias = P.b_ada_f + (c0 - 6144); ldw = 2048; }
    float acc[64];
#pragma unroll
    for (int r = 0; r < 64; ++r) acc[r] = 0.f;
    const float* crow = (lane < 32 ? P.c_p + (size_t)lane * DM : P.c_s + (size_t)(lane - 32) * DM) + ks * 256;
    for (int kc = 0; kc < 8; ++kc) {
#pragma unroll
        for (int q = 0; q < 8; ++q) { f32x4 v = *(const f32x4*)(crow + kc * 32 + 4 * q);
            v.x = silu_f(v.x); v.y = silu_f(v.y); v.z = silu_f(v.z); v.w = silu_f(v.w);
            *(LAS f32x4*)(scr + lane * 36 + 4 * q) = v; }
        LDS_WAIT(); asm volatile("" ::: "memory");
        const float* wk = W + (size_t)(ks * 256 + kc * 32) * ldw + lane;
        for (int k4 = 0; k4 < 8; ++k4) {
            const float w0 = wk[(size_t)(4 * k4 + 0) * ldw], w1 = wk[(size_t)(4 * k4 + 1) * ldw], w2 = wk[(size_t)(4 * k4 + 2) * ldw], w3 = wk[(size_t)(4 * k4 + 3) * ldw];
#pragma unroll
            for (int r = 0; r < 64; ++r) { const f32x4 s = *(const LAS f32x4*)(scr + r * 36 + 4 * k4); acc[r] += (s.x * w0 + s.y * w1) + (s.z * w2 + s.w * w3); }
        }
        LDS_WAIT(); asm volatile("" ::: "memory");
    }
    float* dst = (float*)(P.ws + WS_MODP) + (size_t)ks * 64 * 8192 + c0 + lane;
    const float bv = (ks == 0) ? bias[lane] : 0.f;
#pragma unroll
    for (int r = 0; r < 64; ++r) dst[(size_t)r * 8192] = acc[r] + bv;
}
__device__ __forceinline__ void phase0(const Params& P, LAS unsigned char* lds, int wave, int lane) {
    LAS float* scr = (LAS float*)(lds + wave * 16384);
    const int gw = blockIdx.x * 8 + wave, NGW = gridDim.x * 8;
    constexpr int I_MOD = 512, I_IN = 16 * 88, I_UP = 16 * 176, I_OUT = 16 * 32, I_DN = 44 * 32;
    constexpr int NIT = I_MOD + I_IN + I_UP + I_OUT + I_DN;
    for (int it = gw; it < NIT; it += NGW) {
        int r = it;
        if (r < I_MOD) { mod_item(P, r, scr, lane); continue; } r -= I_MOD;
        if (r < I_IN) { const int kb = r / 88, nb = r % 88; transpose_item(P.w_in, DM, INW, (bf16*)(P.ws + WS_WIN), nb * 32, kb * 64, nb * 32, scr, lane); continue; } r -= I_IN;
        if (r < I_UP) { const int kb = r / 176, nb = r % 176, n0 = nb * 32, isb = n0 >= DFF, j0 = n0 - isb * DFF;
            transpose_item(P.w_up, DM, 2 * DFF, (bf16*)(P.ws + WS_WUP), 256 * (j0 >> 7) + 128 * isb + (j0 & 127), kb * 64, n0, scr, lane); continue; } r -= I_UP;
        if (r < I_OUT) { const int kb = r / 32, nb = r % 32; transpose_item(P.w_out, DM, DM, (bf16*)(P.ws + WS_WOUT), nb * 32, kb * 64, nb * 32, scr, lane); continue; } r -= I_OUT;
        { const int kb = r / 32, nb = r % 32; transpose_item(P.w_down, DFF, DM, (bf16*)(P.ws + WS_WDN), nb * 32, kb * 64, nb * 32, scr, lane); }
    }
}

__device__ __forceinline__ void phase1(const Params& P, LAS unsigned char* lds, int tid, int wave, int lane) {
    const float* modp = (const float*)(P.ws + WS_MODP);
    float* mod = (float*)(P.ws + WS_MOD);
    bf16* H1 = (bf16*)(P.ws + WS_R0);
    for (int idx = blockIdx.x * 512 + tid; idx < 64 * 8192; idx += gridDim.x * 512) {
        const float s = (modp[idx] + modp[idx + 524288]) + (modp[idx + 2 * 524288] + modp[idx + 3 * 524288]);
        mod[idx] = s;
        const int col = idx & 8191, bs = idx >> 13;
        if (col >= 3072 && col < 4096) H1[(size_t)(MT + bs) * DM + (col - 3072)] = (bf16)(pk2(s, 0.f) & 0xffffu);
    }
    LAS float* lv = (LAS float*)lds;
    for (int g = blockIdx.x; g < NGRP; g += gridDim.x) {
        const int bs = grp_bs(g);
        __syncthreads();
        for (int i = tid; i < 2048; i += 512) { const int which = i >> 10, col = i & 1023; const size_t o = (size_t)bs * 8192 + which * 1024 + col;
            float s = (modp[o] + modp[o + 524288]) + (modp[o + 2 * 524288] + modp[o + 3 * 524288]);
            if (which) s = P.ln1[col] * (1.f + s);
            lv[i] = s; }
        __syncthreads();
#pragma unroll 2
        for (int i = 0; i < 8; ++i) {
            const int row = g * 64 + wave * 8 + i;
            const float* xr = (row < MP ? P.x_p + (size_t)row * DM : P.x_s + (size_t)(row - MP) * DM) + 4 * lane;
            f32x4 v[4]; float ss = 0.f;
#pragma unroll
            for (int j = 0; j < 4; ++j) { v[j] = *(const f32x4*)(xr + 256 * j); ss += (v[j].x * v[j].x + v[j].y * v[j].y) + (v[j].z * v[j].z + v[j].w * v[j].w); }
            const float rstd = rsqrtf(wave_sum(ss) * (1.f / DM) + EPS);
            bf16* hr = H1 + (size_t)row * DM + 4 * lane;
#pragma unroll
            for (int j = 0; j < 4; ++j) { const f32x4 sh = *(const LAS f32x4*)(lv + 256 * j + 4 * lane), gs = *(const LAS f32x4*)(lv + 1024 + 256 * j + 4 * lane);
                const f32x4 h = v[j] * rstd * gs + sh; u32x2 w; w.x = pk2(h.x, h.y); w.y = pk2(h.z, h.w); *(u32x2*)(hr + 256 * j) = w; }
        }
    }
}

struct OrderX {
    pg8::StaticOrder S; int nX, xpm, xpn0;
    __device__ __forceinline__ bool next(int i, pg8::Unit& u) const {
        const long L = (long)i * S.G + S.c;
        int pm = 0, pn = 0; bool ok = false;
        if (L < S.nwg) { pg8::Unit t; t.pm = 0; t.pn = 0; t.seq = 0; (void)S.next(i, t); pm = t.pm; pn = t.pn; ok = true; }
        else if (L < S.nwg + nX) { pm = xpm; pn = xpn0 + (int)(L - S.nwg); ok = true; }
        u.pm = pm; u.pn = pn; u.seq = i;
        return ok;
    }
    __device__ __forceinline__ void a_ready(const pg8::Unit&) const {}
    __device__ __forceinline__ void done(const pg8::Unit&) const {}
};
typedef const f32x4 (&AccRef)[2][2][4][2];
struct Epi1 {
    static constexpr bool PERM = true, AFTER_DRAIN = false;
    bf16* proj; float* shw; float* out;
    __device__ __forceinline__ void operator()(AccRef acc, const pg8::Unit& u, int wr, int wc, int fr, int fq) const {
        if (u.pm == NTM) {
            if (wr == 0) {
#pragma unroll
                for (int m = 0; m < 4; ++m) { float* d = shw + (size_t)(16 * m + fr) * (2 * DFF) + 256 * (u.pn - 11) + 32 * wc + 8 * fq;
#pragma unroll
                    for (int bj = 0; bj < 2; ++bj)
#pragma unroll
                        for (int n = 0; n < 2; ++n) *(f32x4*)(d + 128 * bj + 4 * n) = acc[0][bj][m][n]; }
            }
            return;
        }
        const unsigned row0 = u.pm * 256 + wr * 64 + fr, col0 = u.pn * 256 + wc * 32 + 8 * fq;
#pragma unroll
        for (int ai = 0; ai < 2; ++ai)
#pragma unroll
            for (int m = 0; m < 4; ++m) { const unsigned o = (row0 + 128 * ai + 16 * m) * (unsigned)INW + col0;
#pragma unroll
                for (int bj = 0; bj < 2; ++bj) { const f32x4 v0 = acc[ai][bj][m][0], v1 = acc[ai][bj][m][1];
                    u32x4 w; w.x = pk2(v0[0], v0[1]); w.y = pk2(v0[2], v0[3]); w.z = pk2(v1[0], v1[1]); w.w = pk2(v1[2], v1[3]);
                    *(u32x4*)(proj + (o + 128 * bj)) = w; }
                asm volatile("" ::: "memory"); }
        if (u.pn == 10) {
            const unsigned c = 32 * wc + 8 * fq;
#pragma unroll
            for (int ai = 0; ai < 2; ++ai)
#pragma unroll
                for (int m = 0; m < 4; ++m) { const unsigned row = row0 + 128 * ai + 16 * m; unsigned ok, ov;
                    if (row < (unsigned)MP) { const unsigned t = row & 2047; if (t < SEQ - 128) continue; const unsigned o = ((row >> 11) * 128 + (t - (SEQ - 128))) * 128 + c; ok = (unsigned)OFF_PK + o; ov = (unsigned)OFF_PV + o; }
                    else { const unsigned o = (row - MP) * 128 + c; ok = (unsigned)OFF_SK + o; ov = (unsigned)OFF_SV + o; }
                    *(f32x4*)(out + ok) = acc[ai][0][m][0]; *(f32x4*)(out + ok + 4) = acc[ai][0][m][1];
                    *(f32x4*)(out + ov) = acc[ai][1][m][0]; *(f32x4*)(out + ov + 4) = acc[ai][1][m][1];
                    asm volatile("" ::: "memory"); }
        }
    }
};
struct Epi2 {
    static constexpr bool PERM = true, AFTER_DRAIN = false;
    const float *xp, *xs, *mod, *ln2; float* x1; bf16* a2; float* ss;
    __device__ __forceinline__ void operator()(AccRef acc, const pg8::Unit& u, int wr, int wc, int fr, int fq) const {
        const int col0 = u.pn * 256 + wc * 32 + 8 * fq;
#pragma unroll
        for (int ai = 0; ai < 2; ++ai) {
            const int bs = grp_bs(4 * u.pm + 2 * ai + wr);
            const float* mb = mod + (size_t)bs * 8192;
            f32x4 g1v[2][2], gsv[2][2];
#pragma unroll
            for (int bj = 0; bj < 2; ++bj)
#pragma unroll
                for (int n = 0; n < 2; ++n) { const int c = col0 + 128 * bj + 4 * n; g1v[bj][n] = *(const f32x4*)(mb + 2048 + c);
                    gsv[bj][n] = *(const f32x4*)(ln2 + c) * (*(const f32x4*)(mb + 4096 + c) + 1.0f); }
#pragma unroll
            for (int m = 0; m < 4; ++m) {
                const int row = u.pm * 256 + 128 * ai + 64 * wr + 16 * m + fr;
                const float* xr = row < MP ? xp + (size_t)row * DM : xs + (size_t)(row - MP) * DM;
                float s = 0.f;
#pragma unroll
                for (int bj = 0; bj < 2; ++bj) { f32x4 a[2];
#pragma unroll
                    for (int n = 0; n < 2; ++n) { const int c = col0 + 128 * bj + 4 * n; const f32x4 xv = *(const f32x4*)(xr + c); const f32x4 v = xv + g1v[bj][n] * acc[ai][bj][m][n];
                        *(f32x4*)(x1 + (size_t)row * DM + c) = v; s += (v.x * v.x + v.y * v.y) + (v.z * v.z + v.w * v.w); a[n] = v * gsv[bj][n]; }
                    u32x4 w; w.x = pk2(a[0].x, a[0].y); w.y = pk2(a[0].z, a[0].w); w.z = pk2(a[1].x, a[1].y); w.w = pk2(a[1].z, a[1].w);
                    *(u32x4*)(a2 + (size_t)row * DM + col0 + 128 * bj) = w; }
                s += __shfl_xor(s, 16); s += __shfl_xor(s, 32);
                if (fq == 0) ss[(size_t)row * 16 + 4 * u.pn + wc] = s;
            }
        }
    }
};
struct Epi3 {
    static constexpr bool PERM = true, AFTER_DRAIN = false;
    const LAS float* rtab; const float* shw; bf16 *ua, *ub; float* out;
    __device__ __forceinline__ void operator()(AccRef acc, const pg8::Unit& u, int wr, int wc, int fr, int fq) const {
        const unsigned j0 = u.pn * 128 + wc * 32 + 8 * fq, pc0 = u.pn * 256 + wc * 32 + 8 * fq;
#pragma unroll
        for (int ai = 0; ai < 2; ++ai) {
            const unsigned grp = 4 * u.pm + 2 * ai + wr, bs = grp_bs((int)grp);
            const unsigned so = bs * (2 * DFF) + pc0;
            const f32x4 sa0 = *(const f32x4*)(shw + so), sa1 = *(const f32x4*)(shw + so + 4), sb0 = *(const f32x4*)(shw + so + 128), sb1 = *(const f32x4*)(shw + so + 132);
#pragma unroll
            for (int m = 0; m < 4; ++m) {
                const float rstd = rtab[u.seq * 256 + 128 * ai + 64 * wr + 16 * m + fr];
                const unsigned row = grp * 64 + 16 * m + fr;
                const f32x4 a0 = acc[ai][0][m][0] * rstd + sa0, a1 = acc[ai][0][m][1] * rstd + sa1, b0 = acc[ai][1][m][0] * rstd + sb0, b1 = acc[ai][1][m][1] * rstd + sb1;
                u32x4 w; w.x = pk2(a0[0], a0[1]); w.y = pk2(a0[2], a0[3]); w.z = pk2(a1[0], a1[1]); w.w = pk2(a1[2], a1[3]);
                *(u32x4*)(ua + (row * (unsigned)DFF + j0)) = w;
                w.x = pk2(b0[0], b0[1]); w.y = pk2(b0[2], b0[3]); w.z = pk2(b1[0], b1[1]); w.w = pk2(b1[2], b1[3]);
                *(u32x4*)(ub + (row * (unsigned)DFF + j0)) = w;
                if (m == 3 && fr >= 14) {
                    if (grp >= 1024) { float* d = out + OFF_SCONV + ((size_t)(grp - 1024) * 2 + (fr - 14)) * DFF + j0; *(f32x4*)d = a0; *(f32x4*)(d + 4) = a1; }
                    else if ((grp & 31) == 31) { float* d = out + OFF_PCONV + ((size_t)(grp >> 5) * 2 + (fr - 14)) * DFF + j0; *(f32x4*)d = a0; *(f32x4*)(d + 4) = a1; }
                }
            }
        }
    }
};
struct Epi4 {
    static constexpr bool PERM = true, AFTER_DRAIN = false;
    const float* mod; float* x1; float* ss;
    __device__ __forceinline__ void operator()(AccRef acc, const pg8::Unit& u, int wr, int wc, int fr, int fq) const {
        const int col0 = u.pn * 256 + wc * 32 + 8 * fq;
#pragma unroll
        for (int ai = 0; ai < 2; ++ai) {
            const int bs = grp_bs(4 * u.pm + 2 * ai + wr);
            const float* mb = mod + (size_t)bs * 8192 + 5120;
            f32x4 g2v[2][2];
#pragma unroll
            for (int bj = 0; bj < 2; ++bj)
#pragma unroll
                for (int n = 0; n < 2; ++n) g2v[bj][n] = *(const f32x4*)(mb + col0 + 128 * bj + 4 * n);
#pragma unroll
            for (int m = 0; m < 4; ++m) {
                const int row = u.pm * 256 + 128 * ai + 64 * wr + 16 * m + fr;
                float* xr = x1 + (size_t)row * DM;
                float s = 0.f;
#pragma unroll
                for (int bj = 0; bj < 2; ++bj)
#pragma unroll
                    for (int n = 0; n < 2; ++n) { const int c = col0 + 128 * bj + 4 * n; const f32x4 v = *(const f32x4*)(xr + c) + g2v[bj][n] * acc[ai][bj][m][n];
                        *(f32x4*)(xr + c) = v; s += (v.x * v.x + v.y * v.y) + (v.z * v.z + v.w * v.w); }
                s += __shfl_xor(s, 16); s += __shfl_xor(s, 32);
                if (fq == 0) ss[(size_t)row * 16 + 4 * u.pn + wc] = s;
            }
        }
    }
};
#define MFMA16(a, b, c) __builtin_amdgcn_mfma_f32_16x16x32_bf16((a), (b), (c), 0, 0, 0)
constexpr int RQ = 0, RK = 17408, RKT = 34816, RVT = 53248, RP = 71680, RST = 80896, RO = 115712;
__device__ __forceinline__ void ret_item(const Params& P, LAS unsigned char* lds, int tid, int wave, int lane, int h, int row0, int nchunks, const float* st_in, bool has_in, float* st_out) {
    const bf16* proj = (const bf16*)(P.ws + WS_R1);
    bf16* mix = (bf16*)(P.ws + WS_R2);
    const int fr = lane & 15, fq = lane >> 4;
    const float lg2 = log2f(1.0f - exp2f(-5.0f - (float)h));
    const float kscale = 0.08838834764831845f;
    LAS bf16* Qs = (LAS bf16*)(lds + RQ); LAS bf16* Ks = (LAS bf16*)(lds + RK); LAS bf16* KT = (LAS bf16*)(lds + RKT); LAS bf16* VT = (LAS bf16*)(lds + RVT);
    LAS bf16* Ps = (LAS bf16*)(lds + RP); LAS bf16* ST = (LAS bf16*)(lds + RST); LAS float* Os = (LAS float*)(lds + RO);
    f32x4 st[8];
#pragma unroll
    for (int et = 0; et < 8; ++et) {
        f32x4 v;
#pragma unroll
        for (int r = 0; r < 4; ++r) v[r] = st_in[(size_t)(16 * wave + 4 * fq + r) * 128 + 16 * et + fr];
        asm volatile("" : "+v"(v));
#pragma unroll
        for (int r = 0; r < 4; ++r) v[r] = has_in ? v[r] : 0.f;
        st[et] = v;
    }
    __syncthreads();
#pragma unroll
    for (int et = 0; et < 8; ++et) { u32x2 w; w.x = pk2(st[et][0], st[et][1]); w.y = pk2(st[et][2], st[et][3]); *(LAS u32x2*)(ST + (16 * et + fr) * 136 + 16 * wave + 4 * fq) = w; }
    const size_t goff = (size_t)lane * INW + h * 128 + wave * 16;
    u32x4 pq[2], pk[2], pv[2];
    { const bf16* g = proj + (size_t)row0 * INW + goff;
      pq[0] = *(const u32x4*)(g); pq[1] = *(const u32x4*)(g + 8); pk[0] = *(const u32x4*)(g + 512); pk[1] = *(const u32x4*)(g + 520); pv[0] = *(const u32x4*)(g + 1024); pv[1] = *(const u32x4*)(g + 1032); }
    const float kf = kscale * exp2f(lg2 * (float)(63 - lane));
    const float g64 = exp2f(lg2 * 64.0f);
    for (int c = 0; c < nchunks; ++c) {
        const int rowc = row0 + 64 * c;
        *(LAS u32x4*)(Qs + lane * 136 + wave * 16) = pq[0]; *(LAS u32x4*)(Qs + lane * 136 + wave * 16 + 8) = pq[1];
        *(LAS u32x4*)(Ks + lane * 136 + wave * 16) = pk[0]; *(LAS u32x4*)(Ks + lane * 136 + wave * 16 + 8) = pk[1];
#pragma unroll
        for (int i = 0; i < 2; ++i)
#pragma unroll
            for (int j = 0; j < 4; ++j) { const unsigned wk = pk[i][j], wv = pv[i][j]; const int d = wave * 16 + i * 8 + j * 2;
                const unsigned kk = pk2(bflo(wk) * kf, bfhi(wk) * kf);
                KT[(d) * 72 + lane] = (bf16)(kk & 0xffffu); KT[(d + 1) * 72 + lane] = (bf16)(kk >> 16);
                VT[(d) * 72 + lane] = (bf16)(wv & 0xffffu); VT[(d + 1) * 72 + lane] = (bf16)(wv >> 16); }
        if (c + 1 < nchunks) { const bf16* g = proj + (size_t)(rowc + 64) * INW + goff;
            pq[0] = *(const u32x4*)(g); pq[1] = *(const u32x4*)(g + 8); pk[0] = *(const u32x4*)(g + 512); pk[1] = *(const u32x4*)(g + 520); pv[0] = *(const u32x4*)(g + 1024); pv[1] = *(const u32x4*)(g + 1032); }
        __syncthreads();
        { const int mi = wave >> 1;
#pragma unroll
          for (int jj = 0; jj < 2; ++jj) { const int lj = 2 * (wave & 1) + jj; f32x4 s = (f32x4){0.f, 0.f, 0.f, 0.f};
#pragma unroll
            for (int ks = 0; ks < 4; ++ks) { const bf16x8 a = *(const LAS bf16x8*)(Ks + (16 * mi + fr) * 136 + 32 * ks + 8 * fq), b = *(const LAS bf16x8*)(Qs + (16 * lj + fr) * 136 + 32 * ks + 8 * fq); s = MFMA16(a, b, s); __builtin_amdgcn_sched_barrier(0); }
            const int l = 16 * lj + fr; float pvv[4];
#pragma unroll
            for (int r = 0; r < 4; ++r) { const int m = 16 * mi + 4 * fq + r; const int dlt = l - m; pvv[r] = dlt >= 0 ? s[r] * kscale * exp2f(lg2 * (float)dlt) : 0.f; }
            u32x2 w; w.x = pk2(pvv[0], pvv[1]); w.y = pk2(pvv[2], pvv[3]); *(LAS u32x2*)(Ps + l * 72 + 16 * mi + 4 * fq) = w; } }
#pragma unroll
        for (int et = 0; et < 8; ++et) st[et] = st[et] * g64;
#pragma unroll
        for (int ks = 0; ks < 2; ++ks) { const bf16x8 a = *(const LAS bf16x8*)(KT + (16 * wave + fr) * 72 + 32 * ks + 8 * fq);
#pragma unroll
            for (int et = 0; et < 8; ++et) { const bf16x8 b = *(const LAS bf16x8*)(VT + (16 * et + fr) * 72 + 32 * ks + 8 * fq); st[et] = MFMA16(a, b, st[et]); if (et & 1) __builtin_amdgcn_sched_barrier(0); } }
        __syncthreads();
        { f32x4 oi[4], oc[4];
#pragma unroll
          for (int lt = 0; lt < 4; ++lt) { oi[lt] = (f32x4){0.f, 0.f, 0.f, 0.f}; oc[lt] = (f32x4){0.f, 0.f, 0.f, 0.f}; }
#pragma unroll
          for (int ks = 0; ks < 2; ++ks) { const bf16x8 b = *(const LAS bf16x8*)(VT + (16 * wave + fr) * 72 + 32 * ks + 8 * fq);
#pragma unroll
            for (int lt = 0; lt < 4; ++lt) { const bf16x8 a = *(const LAS bf16x8*)(Ps + (16 * lt + fr) * 72 + 32 * ks + 8 * fq); oi[lt] = MFMA16(a, b, oi[lt]); } __builtin_amdgcn_sched_barrier(0); }
#pragma unroll
          for (int ks = 0; ks < 4; ++ks) { const bf16x8 b = *(const LAS bf16x8*)(ST + (16 * wave + fr) * 136 + 32 * ks + 8 * fq);
#pragma unroll
            for (int lt = 0; lt < 4; ++lt) { const bf16x8 a = *(const LAS bf16x8*)(Qs + (16 * lt + fr) * 136 + 32 * ks + 8 * fq); oc[lt] = MFMA16(a, b, oc[lt]); } __builtin_amdgcn_sched_barrier(0); }
#pragma unroll
          for (int lt = 0; lt < 4; ++lt)
#pragma unroll
            for (int r = 0; r < 4; ++r) { const int l = 16 * lt + 4 * fq + r; Os[l * 132 + 16 * wave + fr] = oi[lt][r] + exp2f(lg2 * (float)(l + 1)) * oc[lt][r]; } }
        __syncthreads();
#pragma unroll
        for (int et = 0; et < 8; ++et) { u32x2 w; w.x = pk2(st[et][0], st[et][1]); w.y = pk2(st[et][2], st[et][3]); *(LAS u32x2*)(ST + (16 * et + fr) * 136 + 16 * wave + 4 * fq) = w; }
        { unsigned gv[8];
#pragma unroll
          for (int i = 0; i < 8; ++i) gv[i] = *(const unsigned*)(proj + (size_t)(rowc + 8 * wave + i) * INW + 1536 + h * 128 + 2 * lane);
#pragma unroll
          for (int i = 0; i < 8; ++i) { const int l = 8 * wave + i; const f32x2 o = *(const LAS f32x2*)(Os + l * 132 + 2 * lane);
            const float ssq = wave_sum(o.x * o.x + o.y * o.y); const float rstd = rsqrtf(ssq * (1.f / 128.f) + EPS);
            const float g0 = bflo(gv[i]), g1 = bfhi(gv[i]);
            *(unsigned*)(mix + (size_t)(rowc + l) * DM + h * 128 + 2 * lane) = pk2(silu_f(g0) * o.x * rstd, silu_f(g1) * o.y * rstd); } }
    }
#pragma unroll
    for (int et = 0; et < 8; ++et)
#pragma unroll
        for (int r = 0; r < 4; ++r) st_out[(size_t)(16 * wave + 4 * fq + r) * 128 + 16 * et + fr] = st[et][r];
}
constexpr int AK = 0, AVT = 27648;
__device__ __forceinline__ void att_item(const Params& P, LAS unsigned char* lds, int tid, int wave, int lane, bool sample, int b, int n, int g) {
    const bf16* proj = (const bf16*)(P.ws + WS_R1);
    bf16* mix = (bf16*)(P.ws + WS_R2);
    const int fr = lane & 15, fq = lane >> 4;
    LAS bf16* Kl = (LAS bf16*)(lds + AK); LAS bf16* VTl = (LAS bf16*)(lds + AVT);
    const int qrow0 = sample ? MP + 64 * b : b * SEQ + 64 * n;
    const int jmin = sample ? 0 : (n >= 2 ? 0 : 64 * (2 - n));
    __syncthreads();
#pragma unroll
    for (int i = 0; i < 3; ++i) { const int p = tid + 512 * i, j = p >> 3, c8 = p & 7; u32x4 w = (u32x4){0u, 0u, 0u, 0u};
        if (j >= jmin) {
            if (sample && j < 128) { const float* s = P.cache_k + ((size_t)(b * 128 + j) * 2 + g) * 64 + 8 * c8; const f32x4 a = *(const f32x4*)s, bb = *(const f32x4*)(s + 4);
                w.x = pk2(a.x, a.y); w.y = pk2(a.z, a.w); w.z = pk2(bb.x, bb.y); w.w = pk2(bb.z, bb.w); }
            else { const int row = sample ? MP + 64 * b + (j - 128) : b * SEQ + 64 * (n - 2) + j; w = *(const u32x4*)(proj + (size_t)row * INW + 2560 + g * 64 + 8 * c8); } }
        *(LAS u32x4*)(Kl + j * 72 + 8 * c8) = w; }
#pragma unroll
    for (int i = 0; i < 3; ++i) { const int j = 64 * i + lane; u32x4 w = (u32x4){0u, 0u, 0u, 0u};
        if (j >= jmin) {
            if (sample && j < 128) { const float* s = P.cache_v + ((size_t)(b * 128 + j) * 2 + g) * 64 + 8 * wave; const f32x4 a = *(const f32x4*)s, bb = *(const f32x4*)(s + 4);
                w.x = pk2(a.x, a.y); w.y = pk2(a.z, a.w); w.z = pk2(bb.x, bb.y); w.w = pk2(bb.z, bb.w); }
            else { const int row = sample ? MP + 64 * b + (j - 128) : b * SEQ + 64 * (n - 2) + j; w = *(const u32x4*)(proj + (size_t)row * INW + 2688 + g * 64 + 8 * wave); } }
#pragma unroll
        for (int e = 0; e < 4; ++e) { VTl[(8 * wave + 2 * e) * 200 + j] = (bf16)(w[e] & 0xffffu); VTl[(8 * wave + 2 * e + 1) * 200 + j] = (bf16)(w[e] >> 16); } }
    const int r = wave >> 1, qh = wave & 1, head = 4 * g + r;
    const float slope = exp2f(-(float)(head + 1));
    const float sink = P.sinks[head];
    const float L2E = 1.4426950408889634f;
    __syncthreads();
#pragma unroll 1
    for (int qt = 0; qt < 2; ++qt) {
        asm volatile("" ::: "memory");
        const int qi = 32 * qh + 16 * qt + fr;
        bf16x8 qf[2];
#pragma unroll
        for (int ks = 0; ks < 2; ++ks) qf[ks] = *(const bf16x8*)(proj + (size_t)(qrow0 + qi) * INW + 2048 + head * 64 + 32 * ks + 8 * fq);
        f32x4 s[12];
#pragma unroll
        for (int kt = 0; kt < 12; ++kt) { s[kt] = (f32x4){0.f, 0.f, 0.f, 0.f};
#pragma unroll
            for (int ks = 0; ks < 2; ++ks) { const bf16x8 a = *(const LAS bf16x8*)(Kl + (16 * kt + fr) * 72 + 32 * ks + 8 * fq); s[kt] = MFMA16(a, qf[ks], s[kt]); } }
        float mx = sink;
#pragma unroll
        for (int kt = 0; kt < 12; ++kt)
#pragma unroll
            for (int rr = 0; rr < 4; ++rr) { const int j = 16 * kt + 4 * fq + rr; const int dist = 128 + qi - j;
                float v = s[kt][rr] * 0.125f - slope * fabsf((float)dist);
                v = j >= jmin ? v : -INFINITY; s[kt][rr] = v; mx = fmaxf(mx, v); }
        mx = fmaxf(mx, __shfl_xor(mx, 16)); mx = fmaxf(mx, __shfl_xor(mx, 32));
        float ls = 0.f;
#pragma unroll
        for (int kt = 0; kt < 12; ++kt)
#pragma unroll
            for (int rr = 0; rr < 4; ++rr) { const float p = exp2f((s[kt][rr] - mx) * L2E); s[kt][rr] = p; ls += p; }
        ls += __shfl_xor(ls, 16); ls += __shfl_xor(ls, 32);
        const float inv = 1.0f / (ls + exp2f((sink - mx) * L2E));
        f32x4 o[4];
#pragma unroll
        for (int dt = 0; dt < 4; ++dt) o[dt] = (f32x4){0.f, 0.f, 0.f, 0.f};
#pragma unroll
        for (int kk = 0; kk < 6; ++kk) {
            u32x4 w; w.x = pk2(s[2 * kk][0], s[2 * kk][1]); w.y = pk2(s[2 * kk][2], s[2 * kk][3]); w.z = pk2(s[2 * kk + 1][0], s[2 * kk + 1][1]); w.w = pk2(s[2 * kk + 1][2], s[2 * kk + 1][3]);
            const bf16x8 pb = __builtin_bit_cast(bf16x8, w);
#pragma unroll
            for (int dt = 0; dt < 4; ++dt) { const LAS bf16* vp = VTl + (16 * dt + fr) * 200 + 32 * kk + 4 * fq;
                const u32x2 lo = *(const LAS u32x2*)vp, hi = *(const LAS u32x2*)(vp + 16);
                const u32x4 aw = (u32x4){lo.x, lo.y, hi.x, hi.y}; const bf16x8 a = __builtin_bit_cast(bf16x8, aw);
                o[dt] = MFMA16(a, pb, o[dt]); }
        }
        bf16* mp = mix + (size_t)(qrow0 + qi) * DM + 512 + head * 64 + 4 * fq;
#pragma unroll
        for (int dt = 0; dt < 4; ++dt) { const f32x4 v = o[dt] * inv; u32x2 w; w.x = pk2(v[0], v[1]); w.y = pk2(v[2], v[3]); *(u32x2*)(mp + 16 * dt) = w; }
    }
}
__device__ __forceinline__ void phase3(const Params& P, LAS unsigned char* lds, int tid, int wave, int lane) {
    const int G = gridDim.x, NR = G / 2, blk = blockIdx.x;
    if (blk < NR) {
#ifndef NO_RET
        for (int it = blk; it < 256; it += NR) {
            const bool sample = it >= 128; const int bh = it & 127, b = bh >> 2, h = bh & 3;
            ret_item(P, lds, tid, wave, lane, h, sample ? MP + 64 * b : b * SEQ, sample ? 1 : 32, P.state_ret + (size_t)bh * 16384, sample, P.out + (sample ? OFF_SRET : OFF_PRET) + (size_t)bh * 16384);
        }
#endif
    } else {
#ifndef NO_ATT
        for (int it = blk - NR; it < 2112; it += G - NR) {
            const bool sample = it >= 2048;
            att_item(P, lds, tid, wave, lane, sample, sample ? (it - 2048) >> 1 : it >> 6, sample ? 2 : (it >> 1) & 31, it & 1);
        }
#endif
    }
}

__device__ __forceinline__ void unpack8(const u32x4 w, float (&f)[8]) { f[0] = bflo(w.x); f[1] = bfhi(w.x); f[2] = bflo(w.y); f[3] = bfhi(w.y); f[4] = bflo(w.z); f[5] = bfhi(w.z); f[6] = bflo(w.w); f[7] = bfhi(w.w); }
__device__ __forceinline__ void phase6(const Params& P, int tid) {
    const bf16* ua = (const bf16*)(P.ws + WS_R1); bf16* ub = (bf16*)(P.ws + WS_R2);
    constexpr int CH = DFF / 8;
    const int total = MT * CH;
    for (int idx = blockIdx.x * 512 + tid; idx < total; idx += gridDim.x * 512) {
        const int row = idx / CH, j = (idx - row * CH) * 8;
        const bool smp = row >= MP; const int t = smp ? ((row - MP) & 63) : (row & 2047);
        float a[8], p1[8], p2[8], bb[8];
        unpack8(*(const u32x4*)(ua + (size_t)row * DFF + j), a);
        unpack8(*(const u32x4*)(ub + (size_t)row * DFF + j), bb);
        if (t >= 1) unpack8(*(const u32x4*)(ua + (size_t)(row - 1) * DFF + j), p1);
        else if (smp) { const float* s = P.state_conv + ((size_t)((row - MP) >> 6) * 2 + 1) * DFF + j; const f32x4 x = *(const f32x4*)s, y = *(const f32x4*)(s + 4); p1[0] = x.x; p1[1] = x.y; p1[2] = x.z; p1[3] = x.w; p1[4] = y.x; p1[5] = y.y; p1[6] = y.z; p1[7] = y.w; }
        else {
#pragma unroll
            for (int e = 0; e < 8; ++e) p1[e] = 0.f; }
        if (t >= 2) unpack8(*(const u32x4*)(ua + (size_t)(row - 2) * DFF + j), p2);
        else if (smp) { const float* s = P.state_conv + ((size_t)((row - MP) >> 6) * 2 + t) * DFF + j; const f32x4 x = *(const f32x4*)s, y = *(const f32x4*)(s + 4); p2[0] = x.x; p2[1] = x.y; p2[2] = x.z; p2[3] = x.w; p2[4] = y.x; p2[5] = y.y; p2[6] = y.z; p2[7] = y.w; }
        else {
#pragma unroll
            for (int e = 0; e < 8; ++e) p2[e] = 0.f; }
        float r[8];
#pragma unroll
        for (int h = 0; h < 2; ++h) { const f32x4 w0 = *(const f32x4*)(P.conv_w + j + 4 * h), w1 = *(const f32x4*)(P.conv_w + DFF + j + 4 * h), w2 = *(const f32x4*)(P.conv_w + 2 * DFF + j + 4 * h), cb = *(const f32x4*)(P.conv_b + j + 4 * h);
#pragma unroll
            for (int e = 0; e < 4; ++e) { const float cv = cb[e] + w0[e] * p2[4 * h + e] + w1[e] * p1[4 * h + e] + w2[e] * a[4 * h + e]; r[4 * h + e] = silu_f(cv) * bb[4 * h + e]; } }
        u32x4 w; w.x = pk2(r[0], r[1]); w.y = pk2(r[2], r[3]); w.z = pk2(r[4], r[5]); w.w = pk2(r[6], r[7]);
        *(u32x4*)(ub + (size_t)row * DFF + j) = w;
    }
}
__device__ __forceinline__ void phase8(const Params& P, int wave, int lane) {
    const float* mod = (const float*)(P.ws + WS_MOD); const float* ss = (const float*)(P.ws + WS_SS2);
    const int gw = blockIdx.x * 8 + wave, NGW = gridDim.x * 8;
    for (int row = gw; row < MT; row += NGW) {
        const int bs = row < MP ? (row >> 11) : 32 + ((row - MP) >> 6);
        float* yr = P.out + (size_t)row * DM + 4 * lane;
        const float* mb = mod + (size_t)bs * 8192 + 6144 + 4 * lane;
        float q = lane < 16 ? ss[(size_t)row * 16 + lane] : 0.f;
        q = wave_sum(q);
        const float rstd = rsqrtf(q * (1.f / DM) + EPS);
#pragma unroll
        for (int j = 0; j < 4; ++j) { const f32x4 v = *(const f32x4*)(yr + 256 * j), sh = *(const f32x4*)(mb + 256 * j), sc = *(const f32x4*)(mb + 1024 + 256 * j), gn = *(const f32x4*)(P.normf + 4 * lane + 256 * j);
            *(f32x4*)(yr + 256 * j) = v * rstd * gn * (sc + 1.0f) + sh; }
    }
}

#ifndef N_LAUNCH
#define N_LAUNCH 1
#endif
#define LAUNDER_TID() int tid = threadIdx.x; asm volatile("" : "+v"(tid)); const int lane = tid & 63, wave = __builtin_amdgcn_readfirstlane(tid >> 6); (void)lane; (void)wave
template <int PHM>
__global__ void __launch_bounds__(512) fwd_mega(Params P) {
    extern __shared__ __attribute__((aligned(16))) unsigned char lds_raw[];
    LAS unsigned char* lds = (LAS unsigned char*)lds_raw;
    const int G = gridDim.x;
    unsigned char* ws = P.ws;
#define GSYNC(a, b) do { if ((PHM & (a)) && (PHM & (b))) cg::this_grid().sync(); } while (0)
    if constexpr ((PHM & 1) != 0) { LAUNDER_TID(); phase0(P, lds, wave, lane); }
    GSYNC(1, 2);
    if constexpr ((PHM & 2) != 0) { LAUNDER_TID(); phase1(P, lds, tid, wave, lane); }
    GSYNC(2, 4);
    if constexpr ((PHM & 4) != 0) {
      pg8::Gemm g{(const bf16*)(ws + WS_R0), (const bf16*)(ws + WS_WIN), MT, INW, DM};
      OrderX S; S.S.init(MT, INW, G, (int)blockIdx.x); S.nX = 22; S.xpm = NTM; S.xpn0 = 11;
      Epi1 E{(bf16*)(ws + WS_R1), (float*)(ws + WS_SHW), P.out};
      pg8::gemm_phase<Epi1, OrderX, true, true>(lds, g, S, E); }
    GSYNC(4, 8);
    if constexpr ((PHM & 8) != 0) { LAUNDER_TID(); phase3(P, lds, tid, wave, lane); }
    GSYNC(8, 16);
    if constexpr ((PHM & 16) != 0) {
      pg8::Gemm g{(const bf16*)(ws + WS_R2), (const bf16*)(ws + WS_WOUT), MT, DM, DM};
      pg8::StaticOrder S; S.init(MT, DM, G, (int)blockIdx.x);
      Epi2 E{P.x_p, P.x_s, (const float*)(ws + WS_MOD), P.ln2, P.out, (bf16*)(ws + WS_R0), (float*)(ws + WS_SS1)};
      pg8::gemm_phase<Epi2, pg8::StaticOrder, true, true>(lds, g, S, E); }
    GSYNC(16, 32);
    if constexpr ((PHM & 32) != 0) {
      LAUNDER_TID();
      pg8::Gemm g{(const bf16*)(ws + WS_R0), (const bf16*)(ws + WS_WUP), MT, 2 * DFF, DM};
      pg8::StaticOrder S; S.init(MT, 2 * DFF, G, (int)blockIdx.x);
      LAS float* rtab = (LAS float*)(lds + 131072);
      { pg8::Unit u; const float* ss = (const float*)(ws + WS_SS1);
        for (int i = 0; S.next(i, u) && i < 24; ++i) if (tid < 256) { const f32x4* sp = (const f32x4*)(ss + (size_t)(u.pm * 256 + tid) * 16);
            const f32x4 q0 = sp[0], q1 = sp[1], q2 = sp[2], q3 = sp[3];
            const float tot = ((q0.x + q0.y) + (q0.z + q0.w)) + ((q1.x + q1.y) + (q1.z + q1.w)) + ((q2.x + q2.y) + (q2.z + q2.w)) + ((q3.x + q3.y) + (q3.z + q3.w));
            rtab[i * 256 + tid] = rsqrtf(tot * (1.f / DM) + EPS); }
        __syncthreads(); }
      Epi3 E{rtab, (const float*)(ws + WS_SHW), (bf16*)(ws + WS_R1), (bf16*)(ws + WS_R2), P.out};
      pg8::gemm_phase<Epi3, pg8::StaticOrder, true, true>(lds, g, S, E); }
    GSYNC(32, 64);
    if constexpr ((PHM & 64) != 0) { LAUNDER_TID(); phase6(P, tid); }
    GSYNC(64, 128);
    if constexpr ((PHM & 128) != 0) {
      pg8::Gemm g{(const bf16*)(ws + WS_R2), (const bf16*)(ws + WS_WDN), MT, DM, DFF};
      pg8::StaticOrder S; S.init(MT, DM, G, (int)blockIdx.x);
      Epi4 E{(const float*)(ws + WS_MOD), P.out, (float*)(ws + WS_SS2)};
      pg8::gemm_phase<Epi4, pg8::StaticOrder, true, true>(lds, g, S, E); }
    GSYNC(128, 256);
    if constexpr ((PHM & 256) != 0) { LAUNDER_TID(); phase8(P, wave, lane); }
}

template <int PHM> static bool launch_one(const Params& p, int grid, bool coop, hipStream_t stream) {
    static bool attr_done = false;
    if (!attr_done) { if (hipFuncSetAttribute((const void*)fwd_mega<PHM>, hipFuncAttributeMaxDynamicSharedMemorySize, LDS_BYTES) != hipSuccess) { fprintf(stderr, "kernel_launch: hipFuncSetAttribute failed\n"); return false; } attr_done = true; }
    hipError_t e;
    if (coop) { Params pc = p; void* args[] = {&pc}; e = hipLaunchCooperativeKernel((const void*)fwd_mega<PHM>, dim3(grid), dim3(512), args, LDS_BYTES, stream); }
    else { hipLaunchKernelGGL(fwd_mega<PHM>, dim3(grid), dim3(512), LDS_BYTES, stream, p); e = hipPeekAtLastError(); }
    if (e != hipSuccess) { fprintf(stderr, "launch (mask %d) failed: %s (grid %d)\n", PHM, hipGetErrorString(e), grid); return false; }
    return true;
}
extern "C" void kernel_launch(void* const* d_in, const int* in_sizes, int n_in, void* d_out, int out_size, void* d_ws, size_t ws_size, hipStream_t stream) {
    static int grid = 0;
    if (grid == 0) {
        if (n_in != 22 || (size_t)out_size != OUT_TOTAL || ws_size < WS_END) { fprintf(stderr, "kernel_launch: unexpected sizes n_in %d out %d ws %zu\n", n_in, out_size, ws_size); grid = -1; return; }
        int dev = 0, cus = 0;
        (void)hipGetDevice(&dev);
        (void)hipDeviceGetAttribute(&cus, hipDeviceAttributeMultiprocessorCount, dev);
        grid = cus;
        if (grid > 256) grid = 256;
        if (grid < 2) grid = -1;
    }
    if (grid < 0) return;
    Params p{};
    const float** pp = (const float**)&p;
    for (int i = 0; i < 22; ++i) pp[i] = (const float*)d_in[i];
    p.out = (float*)d_out; p.ws = (unsigned char*)d_ws;
#if N_LAUNCH == 1
    launch_one<511>(p, grid, true, stream);
#else
    launch_one<1>(p, grid, false, stream) && launch_one<2>(p, grid, false, stream) && launch_one<4>(p, grid, false, stream) && launch_one<8>(p, grid, false, stream) &&
    launch_one<16>(p, grid, false, stream) && launch_one<32>(p, grid, false, stream) && launch_one<64>(p, grid, false, stream) && launch_one<128>(p, grid, false, stream) && launch_one<256>(p, grid, false, stream);
#endif
}
```

```cpp
#include <hip/hip_runtime.h>
#include <hip/hip_cooperative_groups.h>
#include <cstdio>
#include <cstdint>
namespace cg = cooperative_groups;
namespace pg8 {
#define PG8_LAS __attribute__((address_space(3)))
typedef unsigned short bf16_t;
typedef short bf16x8 __attribute__((ext_vector_type(8)));
typedef float f32x4 __attribute__((ext_vector_type(4)));
typedef unsigned u32x4 __attribute__((ext_vector_type(4)));
constexpr int BM = 256, BK = 64, HALF = 128, HTB = HALF * BK * 2  , STAGE_BYTES = 8 * HTB, NXCD = 8, WGM = 8;

__host__ __device__ __forceinline__ int lds_byte(int r, int c) { const int st = (r >> 4) * 2 + (c >> 5), rr = r & 15, cc = c & 31, ob = rr * 64 + cc * 2; return st * 1024 + (ob ^ (((ob >> 9) & 1) << 5)); }
__host__ __device__ __forceinline__ void stage_rc(int b, int& R, int& C) { const int st = b / 1024, sb = b % 1024, swz = sb ^ (((sb >> 9) & 1) << 5); R = (st >> 1) * 16 + swz / 64; C = (st & 1) * 32 + (swz % 64) / 2; }
__host__ __device__ __forceinline__ int perm32(int rho) { const int n = rho >> 4, i = rho & 15; return 8 * (i >> 2) + 4 * n + (i & 3); }

struct Unit { int pm, pn, seq; };
struct Gemm { const bf16_t* A; const bf16_t* Bt; int M, N, K; };

struct StaticOrder {
    int nM, nN, nwg, G, c;
    __host__ __device__ __forceinline__ void init(int M, int N, int G_, int c_) { nM = M / BM; nN = N / BM; nwg = nM * nN; G = G_; c = c_; }
    __host__ __device__ __forceinline__ bool next(int i, Unit& u) const {
        const long L = (long)i * G + c; if (L >= nwg) return false; u.seq = i;
        int wgid = (int)L; { const int q = nwg / NXCD, r = nwg % NXCD, xcd = wgid % NXCD, off = wgid / NXCD; wgid = (xcd < r ? xcd * (q + 1) : r * (q + 1) + (xcd - r) * q) + off; }
        const int nig = WGM * nN, gid = wgid / nig, fm = gid * WGM, gsz = (nM - fm) < WGM ? (nM - fm) : WGM;
        u.pm = fm + ((wgid % nig) % gsz); u.pn = (wgid % nig) / gsz; return true;
    }
    __device__ __forceinline__ void a_ready(const Unit&) const {}
    __device__ __forceinline__ void done(const Unit&) const {}
};

__device__ __forceinline__ unsigned cvt_pk_bf16(float lo, float hi) { unsigned r; asm volatile("v_cvt_pk_bf16_f32 %0, %1, %2" : "=v"(r) : "v"(lo), "v"(hi)); return r; }

template <class Epi, class Sched, bool ALIGN_EPI = false, bool SP2 = false>
__device__ __forceinline__ void gemm_phase(PG8_LAS unsigned char* lds, const Gemm g, const Sched& S, const Epi& E) {
    int tid_ = threadIdx.x; asm volatile("" : "+v"(tid_));
    const int tid = tid_, wid = __builtin_amdgcn_readfirstlane(tid >> 6), lane = tid & 63, wr = wid >> 2, wc = wid & 3, fr = lane & 15, fq = lane >> 4;
    const int K = g.K, nt = K / BK;
    unsigned voffA[2], voffB[2];
#pragma unroll
    for (int i = 0; i < 2; ++i) { int R, C; stage_rc(tid * 16 + i * 8192, R, C); const int Rb = Epi::PERM ? ((R & ~31) + perm32(R & 31)) : R;
        voffA[i] = (unsigned)(R * K + C) * 2u; voffB[i] = (unsigned)(Rb * K + C) * 2u; }
    const size_t kstep = (size_t)(BK * 2);
    const size_t hstep = (size_t)HALF * K * 2;
    const size_t tstep = 2 * hstep;
    const unsigned ldsw = (unsigned)wid * 1024u;
    const int aoff = lds_byte(wr * 64 + fr, fq * 8), boff = lds_byte(wc * 32 + fr, fq * 8);
#define PG8_SA(b, h) (((b) * 2 + (h)) * HTB)
#define PG8_SB(b, h) ((4 + (b) * 2 + (h)) * HTB)
#define PG8_STAGE(bufoff, gbase, voff) do { _Pragma("unroll") for (int _i = 0; _i < 2; ++_i) \
        __builtin_amdgcn_global_load_lds((const unsigned*)((const char*)(gbase) + (voff)[_i]), (PG8_LAS unsigned*)(lds + (bufoff) + ldsw + _i * 8192), 16, 0, 0); } while (0)
#define PG8_LDA(dst, b, h) do { _Pragma("unroll") for (int m = 0; m < 4; ++m) _Pragma("unroll") for (int k = 0; k < 2; ++k) dst[m][k] = *(const PG8_LAS bf16x8*)(lds + PG8_SA(b, h) + aoff + m * 2048 + k * 1024); } while (0)
#define PG8_LDB(dst, b, h) do { _Pragma("unroll") for (int n = 0; n < 2; ++n) _Pragma("unroll") for (int k = 0; k < 2; ++k) dst[n][k] = *(const PG8_LAS bf16x8*)(lds + PG8_SB(b, h) + boff + n * 2048 + k * 1024); } while (0)
#define PG8_MMA(ai, bj, At, Bt) do { __builtin_amdgcn_s_setprio(1); _Pragma("unroll") for (int m = 0; m < 4; ++m) _Pragma("unroll") for (int n = 0; n < 2; ++n) _Pragma("unroll") for (int k = 0; k < 2; ++k) \
        acc[ai][bj][m][n] = __builtin_amdgcn_mfma_f32_16x16x32_bf16(Bt[n][k], At[m][k], acc[ai][bj][m][n], 0, 0, 0); __builtin_amdgcn_s_setprio(0); } while (0)
#define PG8_WAIT_V(n) asm volatile("s_waitcnt vmcnt(" #n ")" ::: "memory")
#define PG8_WAIT_L(n) asm volatile("s_waitcnt lgkmcnt(" #n ")" ::: "memory")
#define PG8_BAR __builtin_amdgcn_s_barrier()
#define PG8_SCHED __builtin_amdgcn_sched_barrier(0)
    Unit cur, nxt; int ui = 0;
    if (!S.next(0, cur)) return;
    f32x4 acc[2][2][4][2];
#pragma unroll
    for (int a = 0; a < 2; ++a)
#pragma unroll
        for (int b = 0; b < 2; ++b)
#pragma unroll
            for (int m = 0; m < 4; ++m)
#pragma unroll
                for (int n = 0; n < 2; ++n) acc[a][b][m][n] = (f32x4){0.f, 0.f, 0.f, 0.f};
    bf16x8 At[4][2], B0[2][2], B1[2][2];
    const char* cA = (const char*)g.A + (size_t)cur.pm * tstep; const char* cB = (const char*)g.Bt + (size_t)cur.pn * tstep;
    S.a_ready(cur);
    if constexpr (SP2) {
        PG8_STAGE(PG8_SB(0, 0), cB, voffB); PG8_STAGE(PG8_SB(0, 1), cB + hstep, voffB); PG8_STAGE(PG8_SA(0, 0), cA, voffA); PG8_STAGE(PG8_SA(0, 1), cA + hstep, voffA);
        if (wr == 1) PG8_BAR;
        PG8_WAIT_V(2); PG8_BAR;
        PG8_STAGE(PG8_SB(1, 0), cB + kstep, voffB); PG8_STAGE(PG8_SA(1, 0), cA + kstep, voffA); PG8_STAGE(PG8_SB(1, 1), cB + hstep + kstep, voffB);
        PG8_WAIT_V(6); PG8_BAR;
    } else {
        PG8_STAGE(PG8_SB(0, 0), cB, voffB); PG8_STAGE(PG8_SA(0, 0), cA, voffA); PG8_STAGE(PG8_SB(0, 1), cB + hstep, voffB); PG8_STAGE(PG8_SA(0, 1), cA + hstep, voffA);
        if (wr == 1) PG8_BAR;
        PG8_WAIT_V(4); PG8_BAR;
        PG8_STAGE(PG8_SB(1, 0), cB + kstep, voffB); PG8_STAGE(PG8_SA(1, 0), cA + kstep, voffA); PG8_STAGE(PG8_SB(1, 1), cB + hstep + kstep, voffB);
        PG8_WAIT_V(6); PG8_BAR;
    }
    for (;;) {
        const bool has_next = S.next(ui + 1, nxt);
        const char* nA = has_next ? (const char*)g.A + (size_t)nxt.pm * tstep : cA; const char* nB = has_next ? (const char*)g.Bt + (size_t)nxt.pn * tstep : cB;
        for (int t = 0; t < nt; t += 2) {
            const bool last = (t == nt - 2);
            const char* a1 = cA + (size_t)(t + 1) * kstep;
            const char* a2 = last ? nA : cA + (size_t)(t + 2) * kstep; const char* b2 = last ? nB : cB + (size_t)(t + 2) * kstep;
            const char* a3 = a2 + kstep; const char* b3 = b2 + kstep;
            if (last && has_next) S.a_ready(nxt);
            if constexpr (SP2) {
            PG8_LDB(B0, 0, 0); PG8_LDB(B1, 0, 1); PG8_SCHED; PG8_LDA(At, 0, 0); PG8_STAGE(PG8_SA(1, 1), a1 + hstep, voffA);
            PG8_WAIT_V(8); PG8_WAIT_L(0); PG8_BAR; PG8_MMA(0, 0, At, B0); PG8_MMA(0, 1, At, B1); PG8_BAR; PG8_SCHED;
            PG8_LDA(At, 0, 1); PG8_STAGE(PG8_SB(0, 0), b2, voffB); PG8_STAGE(PG8_SB(0, 1), b2 + hstep, voffB); PG8_STAGE(PG8_SA(0, 0), a2, voffA);
            PG8_WAIT_V(8); PG8_WAIT_L(0); PG8_BAR; PG8_MMA(1, 0, At, B0); PG8_MMA(1, 1, At, B1); PG8_BAR; PG8_SCHED;
            PG8_LDB(B0, 1, 0); PG8_LDB(B1, 1, 1); PG8_SCHED; PG8_LDA(At, 1, 0); PG8_STAGE(PG8_SA(0, 1), a2 + hstep, voffA);
            PG8_WAIT_V(8); PG8_WAIT_L(0); PG8_BAR; PG8_MMA(0, 0, At, B0); PG8_MMA(0, 1, At, B1); PG8_BAR; PG8_SCHED;
            PG8_LDA(At, 1, 1); PG8_STAGE(PG8_SB(1, 0), b3, voffB); PG8_STAGE(PG8_SB(1, 1), b3 + hstep, voffB); PG8_STAGE(PG8_SA(1, 0), a3, voffA);
            PG8_WAIT_V(8); PG8_WAIT_L(0); PG8_BAR; PG8_MMA(1, 0, At, B0); PG8_MMA(1, 1, At, B1); PG8_BAR; PG8_SCHED;
            } else {
            PG8_LDB(B0, 0, 0); PG8_SCHED; PG8_LDA(At, 0, 0); PG8_STAGE(PG8_SA(1, 1), a1 + hstep, voffA);
            PG8_WAIT_L(8); PG8_BAR; PG8_WAIT_L(0); PG8_MMA(0, 0, At, B0); PG8_BAR; PG8_SCHED;
            PG8_LDB(B1, 0, 1); PG8_STAGE(PG8_SB(0, 0), b2, voffB);
            PG8_BAR; PG8_WAIT_L(0); PG8_MMA(0, 1, At, B1); PG8_BAR;
            PG8_LDA(At, 0, 1); PG8_STAGE(PG8_SA(0, 0), a2, voffA);
            PG8_BAR; PG8_WAIT_L(0); PG8_MMA(1, 0, At, B0); PG8_BAR; PG8_SCHED;
            PG8_STAGE(PG8_SB(0, 1), b2 + hstep, voffB);
            PG8_WAIT_V(6); PG8_BAR; PG8_MMA(1, 1, At, B1); PG8_BAR;
            PG8_LDB(B0, 1, 0); PG8_SCHED; PG8_LDA(At, 1, 0); PG8_STAGE(PG8_SA(0, 1), a2 + hstep, voffA);
            PG8_WAIT_L(8); PG8_BAR; PG8_WAIT_L(0); PG8_MMA(0, 0, At, B0); PG8_BAR; PG8_SCHED;
            PG8_LDB(B1, 1, 1); PG8_STAGE(PG8_SB(1, 0), b3, voffB);
            PG8_BAR; PG8_WAIT_L(0); PG8_MMA(0, 1, At, B1); PG8_BAR;
            PG8_LDA(At, 1, 1); PG8_STAGE(PG8_SA(1, 0), a3, voffA);
            PG8_BAR; PG8_WAIT_L(0); PG8_MMA(1, 0, At, B0); PG8_BAR; PG8_SCHED;
            PG8_STAGE(PG8_SB(1, 1), b3 + hstep, voffB);
            PG8_WAIT_V(6); PG8_BAR; PG8_MMA(1, 1, At, B1); PG8_BAR;
            }
        }
        if constexpr (ALIGN_EPI) { if (wr == 0) PG8_BAR; }
        if constexpr (!Epi::AFTER_DRAIN) { E(acc, cur, wr, wc, fr, fq); S.done(cur); }
        if (!has_next) break;
#pragma unroll
        for (int a = 0; a < 2; ++a)
#pragma unroll
            for (int b = 0; b < 2; ++b)
#pragma unroll
                for (int m = 0; m < 4; ++m)
#pragma unroll
                    for (int n = 0; n < 2; ++n) acc[a][b][m][n] = (f32x4){0.f, 0.f, 0.f, 0.f};
        cur = nxt; cA = nA; cB = nB; ++ui;
        if constexpr (ALIGN_EPI) { if (wr == 1) PG8_BAR; }
    }
    PG8_WAIT_V(0);
    if constexpr (!ALIGN_EPI) { if (wr == 0) PG8_BAR; }
    PG8_BAR;
    if constexpr (Epi::AFTER_DRAIN) { E.fused(acc, cur, wr, wc, fr, fq, lds, wid, lane); S.done(cur); }
#undef PG8_SA
#undef PG8_SB
#undef PG8_STAGE
#undef PG8_LDA
#undef PG8_LDB
#undef PG8_MMA
#undef PG8_WAIT_V
#undef PG8_WAIT_L
#undef PG8_BAR
#undef PG8_SCHED
}
}
constexpr int DM = 1024, SEQ = 2048, NB = 32, DECL = 64, DFF = 2816, INW = 2816;
constexpr int MP = NB * SEQ, MS = NB * DECL, MT = MP + MS;
constexpr int NGRP = MT / 64;
constexpr int NTM = MT / 256;
constexpr float EPS = 1e-6f;
constexpr size_t OFF_Y = 0;
constexpr size_t OFF_PRET = (size_t)MT * DM;
constexpr size_t OFF_PK = OFF_PRET + (size_t)NB * 4 * 128 * 128;
constexpr size_t OFF_PV = OFF_PK + (size_t)NB * 128 * 128;
constexpr size_t OFF_PCONV = OFF_PV + (size_t)NB * 128 * 128;
constexpr size_t OFF_SRET = OFF_PCONV + (size_t)NB * 2 * DFF;
constexpr size_t OFF_SK = OFF_SRET + (size_t)NB * 4 * 128 * 128;
constexpr size_t OFF_SV = OFF_SK + (size_t)NB * 64 * 128;
constexpr size_t OFF_SCONV = OFF_SV + (size_t)NB * 64 * 128;
constexpr size_t OUT_TOTAL = OFF_SCONV + (size_t)NB * 2 * DFF;
constexpr size_t MiB = 1u << 20;
constexpr size_t WS_WIN = 0;
constexpr size_t WS_WUP = WS_WIN + (size_t)INW * DM * 2;
constexpr size_t WS_WOUT = WS_WUP + (size_t)2 * DFF * DM * 2;
constexpr size_t WS_WDN = WS_WOUT + (size_t)DM * DM * 2;
constexpr size_t WS_MODP = 24 * MiB;
constexpr size_t WS_MOD = 32 * MiB;
constexpr size_t WS_SHW = 34 * MiB;
constexpr size_t WS_SS1 = 36 * MiB;
constexpr size_t WS_SS2 = 41 * MiB;
constexpr size_t WS_R0 = 48 * MiB;
constexpr size_t WS_R1 = WS_R0 + 133 * MiB;
constexpr size_t WS_R2 = WS_R1 + 363 * MiB;
constexpr size_t WS_END = WS_R2 + 363 * MiB;
static_assert(WS_WDN + (size_t)DM * DFF * 2 <= WS_MODP, "ws map");
static_assert((size_t)(MT + 256) * DM * 2 <= 133 * MiB && (size_t)MT * DFF * 2 <= 363 * MiB, "ws map");
constexpr size_t HT_STRIDE = (size_t)NGRP * 2 * DFF;
static_assert(3 * HT_STRIDE * 4 <= 133 * MiB, "ws map");

constexpr size_t WS_BAR = 46 * MiB;
constexpr int LDS_MISC = 155648;
constexpr int LDS_BYTES = 155648 + 64;

#define LAS __attribute__((address_space(3)))
typedef unsigned short bf16;
typedef float f32x4 __attribute__((ext_vector_type(4)));
typedef float f32x2 __attribute__((ext_vector_type(2)));
typedef short bf16x8 __attribute__((ext_vector_type(8)));
typedef unsigned u32x4 __attribute__((ext_vector_type(4)));
typedef unsigned u32x2 __attribute__((ext_vector_type(2)));
typedef __bf16 bf16x2_t __attribute__((ext_vector_type(2)));
#define LDS_WAIT() asm volatile("s_waitcnt lgkmcnt(0)" ::: "memory")

__device__ __forceinline__ unsigned pk2(float lo, float hi) { f32x2 v = {lo, hi}; bf16x2_t b = __builtin_convertvector(v, bf16x2_t); return __builtin_bit_cast(unsigned, b); }
__device__ __forceinline__ float bflo(unsigned w) { return __uint_as_float(w << 16); }
__device__ __forceinline__ float bfhi(unsigned w) { return __uint_as_float(w & 0xffff0000u); }
__device__ __forceinline__ float wave_sum(float v) {
#pragma unroll
    for (int o = 1; o < 64; o <<= 1) v += __shfl_xor(v, o);
    return v;
}
__device__ __forceinline__ float silu_f(float x) { return x * __builtin_amdgcn_rcpf(1.0f + __builtin_amdgcn_exp2f(-1.4426950408889634f * x)); }
__device__ __forceinline__ int grp_bs(int g) { return g < 1024 ? (g >> 5) : 32 + (g - 1024); }

struct Params {
    const float *x_p, *x_s, *cache_k, *cache_v, *state_ret, *state_conv, *c_p, *c_s, *ln1, *ln2, *w_ada, *b_ada, *w_in, *w_out, *sinks, *w_up, *conv_w, *conv_b, *w_down, *normf, *w_ada_f, *b_ada_f;
    float* out; unsigned char* ws;
};

__device__ __forceinline__ void transpose_item(const float* W, int K, int N, bf16* WT, int dst_row0, int k0, int n0, LAS float* scr, int lane) {
#pragma unroll 8
    for (int i = 0; i < 32; ++i) { const int kk = 2 * i + (lane >> 5); scr[kk * 33 + (lane & 31)] = W[(size_t)(k0 + kk) * N + n0 + (lane & 31)]; }
    LDS_WAIT(); asm volatile("" ::: "memory");
    const int c = lane & 7;
#pragma unroll
    for (int j = 0; j < 4; ++j) { const int n = (lane >> 3) + 8 * j; const LAS float* s = scr + (8 * c) * 33 + n;
        u32x4 o; o.x = pk2(s[0 * 33], s[1 * 33]); o.y = pk2(s[2 * 33], s[3 * 33]); o.z = pk2(s[4 * 33], s[5 * 33]); o.w = pk2(s[6 * 33], s[7 * 33]);
        *(u32x4*)(WT + (size_t)(dst_row0 + n) * K + k0 + 8 * c) = o; }
    LDS_WAIT(); asm volatile("" ::: "memory");
}
__device__ __forceinline__ void mod_item(const Params& P, int it, LAS float* scr, int lane) {
    const int ct = it >> 2, ks = it & 3, c0 = ct * 64;
    const float* W; const float* bias; int ldw;
    if (c0 < 6144) { W = P.w_ada + c0; bias = P.b_ada + c0; ldw = 6144; } else { W = P.w_ada_f + (c0 - 6144); bias = P.b_ada_f + (c0 - 6144); ldw = 2048; }
    float acc[64];
#pragma unroll
    for (int r = 0; r < 64; ++r) acc[r] = 0.f;
    const float* crow = (lane < 32 ? P.c_p + (size_t)lane * DM : P.c_s + (size_t)(lane - 32) * DM) + ks * 256;
    for (int kc = 0; kc < 8; ++kc) {
#pragma unroll
        for (int q = 0; q < 8; ++q) { f32x4 v = *(const f32x4*)(crow + kc * 32 + 4 * q);
            v.x = silu_f(v.x); v.y = silu_f(v.y); v.z = silu_f(v.z); v.w = silu_f(v.w);
            *(LAS f32x4*)(scr + lane * 36 + 4 * q) = v; }
        LDS_WAIT(); asm volatile("" ::: "memory");
        const float* wk = W + (size_t)(ks * 256 + kc * 32) * ldw + lane;
        for (int k4 = 0; k4 < 8; ++k4) {
            const float w0 = wk[(size_t)(4 * k4 + 0) * ldw], w1 = wk[(size_t)(4 * k4 + 1) * ldw], w2 = wk[(size_t)(4 * k4 + 2) * ldw], w3 = wk[(size_t)(4 * k4 + 3) * ldw];
#pragma unroll
            for (int r = 0; r < 64; ++r) { const f32x4 s = *(const LAS f32x4*)(scr + r * 36 + 4 * k4); acc[r] += (s.x * w0 + s.y * w1) + (s.z * w2 + s.w * w3); }
        }
        LDS_WAIT(); asm volatile("" ::: "memory");
    }
    float* dst = (float*)(P.ws + WS_MODP) + (size_t)ks * 64 * 8192 + c0 + lane;
    const float bv = (ks == 0) ? bias[lane] : 0.f;
#pragma unroll
    for (int r = 0; r < 64; ++r) dst[(size_t)r * 8192] = acc[r] + bv;
}
__device__ __forceinline__ void phase0(const Params& P, LAS unsigned char* lds, int wave, int lane) {
    LAS float* scr = (LAS float*)(lds + wave * 16384);
    const int gw = blockIdx.x * 8 + wave, NGW = gridDim.x * 8;
    constexpr int I_MOD = 512, I_IN = 16 * 88, I_UP = 16 * 176, I_OUT = 16 * 32, I_DN = 44 * 32;
    constexpr int NIT = I_MOD + I_IN + I_UP + I_OUT + I_DN;
    for (int it = gw; it < NIT; it += NGW) {
        int r = it;
        if (r < I_MOD) { mod_item(P, r, scr, lane); continue; } r -= I_MOD;
        if (r < I_IN) { const int kb = r / 88, nb = r % 88; transpose_item(P.w_in, DM, INW, (bf16*)(P.ws + WS_WIN), nb * 32, kb * 64, nb * 32, scr, lane); continue; } r -= I_IN;
        if (r < I_UP) { const int kb = r / 176, nb = r % 176, n0 = nb * 32, isb = n0 >= DFF, j0 = n0 - isb * DFF;
            transpose_item(P.w_up, DM, 2 * DFF, (bf16*)(P.ws + WS_WUP), 256 * (j0 >> 7) + 128 * isb + (j0 & 127), kb * 64, n0, scr, lane); continue; } r -= I_UP;
        if (r < I_OUT) { const int kb = r / 32, nb = r % 32; transpose_item(P.w_out, DM, DM, (bf16*)(P.ws + WS_WOUT), nb * 32, kb * 64, nb * 32, scr, lane); continue; } r -= I_OUT;
        { const int kb = r / 32, nb = r % 32; transpose_item(P.w_down, DFF, DM, (bf16*)(P.ws + WS_WDN), nb * 32, kb * 64, nb * 32, scr, lane); }
    }
}

__device__ __forceinline__ void phase1(const Params& P, LAS unsigned char* lds, int tid, int wave, int lane) {
    const float* modp = (const float*)(P.ws + WS_MODP);
    float* mod = (float*)(P.ws + WS_MOD);
    bf16* H1 = (bf16*)(P.ws + WS_R0);
    for (int idx = blockIdx.x * 512 + tid; idx < 64 * 8192; idx += gridDim.x * 512) {
        const float s = (modp[idx] + modp[idx + 524288]) + (modp[idx + 2 * 524288] + modp[idx + 3 * 524288]);
        mod[idx] = s;
        const int col = idx & 8191, bs = idx >> 13;
        if (col >= 3072 && col < 4096) H1[(size_t)(MT + bs) * DM + (col - 3072)] = (bf16)(pk2(s, 0.f) & 0xffffu);
    }
    LAS float* lv = (LAS float*)lds;
    for (int g = blockIdx.x; g < NGRP; g += gridDim.x) {
        const int bs = grp_bs(g);
        __syncthreads();
        for (int i = tid; i < 2048; i += 512) { const int which = i >> 10, col = i & 1023; const size_t o = (size_t)bs * 8192 + which * 1024 + col;
            float s = (modp[o] + modp[o + 524288]) + (modp[o + 2 * 524288] + modp[o + 3 * 524288]);
            if (which) s = P.ln1[col] * (1.f + s);
            lv[i] = s; }
        __syncthreads();
#pragma unroll 2
        for (int i = 0; i < 8; ++i) {
            const int row = g * 64 + wave * 8 + i;
            const float* xr = (row < MP ? P.x_p + (size_t)row * DM : P.x_s + (size_t)(row - MP) * DM) + 4 * lane;
            f32x4 v[4]; float ss = 0.f;
#pragma unroll
            for (int j = 0; j < 4; ++j) { v[j] = *(const f32x4*)(xr + 256 * j); ss += (v[j].x * v[j].x + v[j].y * v[j].y) + (v[j].z * v[j].z + v[j].w * v[j].w); }
            const float rstd = rsqrtf(wave_sum(ss) * (1.f / DM) + EPS);
            bf16* hr = H1 + (size_t)row * DM + 4 * lane;
#pragma unroll
            for (int j = 0; j < 4; ++j) { const f32x4 sh = *(const LAS f32x4*)(lv + 256 * j + 4 * lane), gs = *(const LAS f32x4*)(lv + 1024 + 256 * j + 4 * lane);
                const f32x4 h = v[j] * rstd * gs + sh; u32x2 w; w.x = pk2(h.x, h.y); w.y = pk2(h.z, h.w); *(u32x2*)(hr + 256 * j) = w; }
        }
    }
}

struct OrderX {
    pg8::StaticOrder S; int nX, xpm, xpn0;
    __device__ __forceinline__ bool next(int i, pg8::Unit& u) const {
        const long L = (long)i * S.G + S.c;
        int pm = 0, pn = 0; bool ok = false;
        if (L < S.nwg) { pg8::Unit t; t.pm = 0; t.pn = 0; t.seq = 0; (void)S.next(i, t); pm = t.pm; pn = t.pn; ok = true; }
        else if (L < S.nwg + nX) { pm = xpm; pn = xpn0 + (int)(L - S.nwg); ok = true; }
        u.pm = pm; u.pn = pn; u.seq = i;
        return ok;
    }
    __device__ __forceinline__ void a_ready(const pg8::Unit&) const {}
    __device__ __forceinline__ void done(const pg8::Unit&) const {}
};
typedef const f32x4 (&AccRef)[2][2][4][2];
struct Epi1 {
    static constexpr bool PERM = true, AFTER_DRAIN = false;
    bf16* proj; float* shw; float* out;
    __device__ __forceinline__ void operator()(AccRef acc, const pg8::Unit& u, int wr, int wc, int fr, int fq) const {
        if (u.pm == NTM) {
            if (wr == 0) {
#pragma unroll
                for (int m = 0; m < 4; ++m) { float* d = shw + (size_t)(16 * m + fr) * (2 * DFF) + 256 * (u.pn - 11) + 32 * wc + 8 * fq;
#pragma unroll
                    for (int bj = 0; bj < 2; ++bj)
#pragma unroll
                        for (int n = 0; n < 2; ++n) *(f32x4*)(d + 128 * bj + 4 * n) = acc[0][bj][m][n]; }
            }
            return;
        }
        const unsigned row0 = u.pm * 256 + wr * 64 + fr, col0 = u.pn * 256 + wc * 32 + 8 * fq;
#pragma unroll
        for (int ai = 0; ai < 2; ++ai)
#pragma unroll
            for (int m = 0; m < 4; ++m) { const unsigned o = (row0 + 128 * ai + 16 * m) * (unsigned)INW + col0;
#pragma unroll
                for (int bj = 0; bj < 2; ++bj) { const f32x4 v0 = acc[ai][bj][m][0], v1 = acc[ai][bj][m][1];
                    u32x4 w; w.x = pk2(v0[0], v0[1]); w.y = pk2(v0[2], v0[3]); w.z = pk2(v1[0], v1[1]); w.w = pk2(v1[2], v1[3]);
                    *(u32x4*)(proj + (o + 128 * bj)) = w; }
                asm volatile("" ::: "memory"); }
        if (u.pn == 10) {
            const unsigned c = 32 * wc + 8 * fq;
#pragma unroll
            for (int ai = 0; ai < 2; ++ai)
#pragma unroll
                for (int m = 0; m < 4; ++m) { const unsigned row = row0 + 128 * ai + 16 * m; unsigned ok, ov;
                    if (row < (unsigned)MP) { const unsigned t = row & 2047; if (t < SEQ - 128) continue; const unsigned o = ((row >> 11) * 128 + (t - (SEQ - 128))) * 128 + c; ok = (unsigned)OFF_PK + o; ov = (unsigned)OFF_PV + o; }
                    else { const unsigned o = (row - MP) * 128 + c; ok = (unsigned)OFF_SK + o; ov = (unsigned)OFF_SV + o; }
                    *(f32x4*)(out + ok) = acc[ai][0][m][0]; *(f32x4*)(out + ok + 4) = acc[ai][0][m][1];
                    *(f32x4*)(out + ov) = acc[ai][1][m][0]; *(f32x4*)(out + ov + 4) = acc[ai][1][m][1];
                    asm volatile("" ::: "memory"); }
        }
    }
};
struct Epi2 {
    static constexpr bool PERM = true, AFTER_DRAIN = false;
    const float *xp, *xs, *mod, *ln2; float* x1; bf16* a2; float* ss;
    __device__ __forceinline__ void operator()(AccRef acc, const pg8::Unit& u, int wr, int wc, int fr, int fq) const {
        const int col0 = u.pn * 256 + wc * 32 + 8 * fq;
#pragma unroll
        for (int ai = 0; ai < 2; ++ai) {
            const int bs = grp_bs(4 * u.pm + 2 * ai + wr);
            const float* mb = mod + (size_t)bs * 8192;
            f32x4 g1v[2][2], gsv[2][2];
#pragma unroll
            for (int bj = 0; bj < 2; ++bj)
#pragma unroll
                for (int n = 0; n < 2; ++n) { const int c = col0 + 128 * bj + 4 * n; g1v[bj][n] = *(const f32x4*)(mb + 2048 + c);
                    gsv[bj][n] = *(const f32x4*)(ln2 + c) * (*(const f32x4*)(mb + 4096 + c) + 1.0f); }
#pragma unroll
            for (int m = 0; m < 4; ++m) {
                const int row = u.pm * 256 + 128 * ai + 64 * wr + 16 * m + fr;
                const float* xr = row < MP ? xp + (size_t)row * DM : xs + (size_t)(row - MP) * DM;
                float s = 0.f;
#pragma unroll
                for (int bj = 0; bj < 2; ++bj) { f32x4 a[2];
#pragma unroll
                    for (int n = 0; n < 2; ++n) { const int c = col0 + 128 * bj + 4 * n; const f32x4 xv = *(const f32x4*)(xr + c); const f32x4 v = xv + g1v[bj][n] * acc[ai][bj][m][n];
                        *(f32x4*)(x1 + (size_t)row * DM + c) = v; s += (v.x * v.x + v.y * v.y) + (v.z * v.z + v.w * v.w); a[n] = v * gsv[bj][n]; }
                    u32x4 w; w.x = pk2(a[0].x, a[0].y); w.y = pk2(a[0].z, a[0].w); w.z = pk2(a[1].x, a[1].y); w.w = pk2(a[1].z, a[1].w);
                    *(u32x4*)(a2 + (size_t)row * DM + col0 + 128 * bj) = w; }
                s += __shfl_xor(s, 16); s += __shfl_xor(s, 32);
                if (fq == 0) ss[(size_t)row * 16 + 4 * u.pn + wc] = s;
            }
        }
    }
};
struct Epi3 {
    static constexpr bool PERM = true, AFTER_DRAIN = false;
    const LAS float* rtab; const float* shw; bf16 *ua, *ub; float* out;
    __device__ __forceinline__ void operator()(AccRef acc, const pg8::Unit& u, int wr, int wc, int fr, int fq) const {
        const unsigned j0 = u.pn * 128 + wc * 32 + 8 * fq, pc0 = u.pn * 256 + wc * 32 + 8 * fq;
#pragma unroll
        for (int ai = 0; ai < 2; ++ai) {
            const unsigned grp = 4 * u.pm + 2 * ai + wr, bs = grp_bs((int)grp);
            const unsigned so = bs * (2 * DFF) + pc0;
            const f32x4 sa0 = *(const f32x4*)(shw + so), sa1 = *(const f32x4*)(shw + so + 4), sb0 = *(const f32x4*)(shw + so + 128), sb1 = *(const f32x4*)(shw + so + 132);
#pragma unroll
            for (int m = 0; m < 4; ++m) {
                const float rstd = rtab[u.seq * 256 + 128 * ai + 64 * wr + 16 * m + fr];
                const unsigned row = grp * 64 + 16 * m + fr;
                const f32x4 a0 = acc[ai][0][m][0] * rstd + sa0, a1 = acc[ai][0][m][1] * rstd + sa1, b0 = acc[ai][1][m][0] * rstd + sb0, b1 = acc[ai][1][m][1] * rstd + sb1;
                u32x4 w; w.x = pk2(a0[0], a0[1]); w.y = pk2(a0[2], a0[3]); w.z = pk2(a1[0], a1[1]); w.w = pk2(a1[2], a1[3]);
                *(u32x4*)(ua + (row * (unsigned)DFF + j0)) = w;
                w.x = pk2(b0[0], b0[1]); w.y = pk2(b0[2], b0[3]); w.z = pk2(b1[0], b1[1]); w.w = pk2(b1[2], b1[3]);
                *(u32x4*)(ub + (row * (unsigned)DFF + j0)) = w;
                if (m == 3 && fr >= 14) {
                    if (grp >= 1024) { float* d = out + OFF_SCONV + ((size_t)(grp - 1024) * 2 + (fr - 14)) * DFF + j0; *(f32x4*)d = a0; *(f32x4*)(d + 4) = a1; }
                    else if ((grp & 31) == 31) { float* d = out + OFF_PCONV + ((size_t)(grp >> 5) * 2 + (fr - 14)) * DFF + j0; *(f32x4*)d = a0; *(f32x4*)(d + 4) = a1; }
                }
            }
        }
    }
};
struct Epi4 {
    static constexpr bool PERM = true, AFTER_DRAIN = false;
    const float* mod; float* x1; float* ss;
    __device__ __forceinline__ void operator()(AccRef acc, const pg8::Unit& u, int wr, int wc, int fr, int fq) const {
        const int col0 = u.pn * 256 + wc * 32 + 8 * fq;
#pragma unroll
        for (int ai = 0; ai < 2; ++ai) {
            const int bs = grp_bs(4 * u.pm + 2 * ai + wr);
            const float* mb = mod + (size_t)bs * 8192 + 5120;
            f32x4 g2v[2][2];
#pragma unroll
            for (int bj = 0; bj < 2; ++bj)
#pragma unroll
                for (int n = 0; n < 2; ++n) g2v[bj][n] = *(const f32x4*)(mb + col0 + 128 * bj + 4 * n);
#pragma unroll
            for (int m = 0; m < 4; ++m) {
                const int row = u.pm * 256 + 128 * ai + 64 * wr + 16 * m + fr;
                float* xr = x1 + (size_t)row * DM;
                float s = 0.f;
#pragma unroll
                for (int bj = 0; bj < 2; ++bj)
#pragma unroll
                    for (int n = 0; n < 2; ++n) { const int c = col0 + 128 * bj + 4 * n; const f32x4 v = *(const f32x4*)(xr + c) + g2v[bj][n] * acc[ai][bj][m][n];
                        *(f32x4*)(xr + c) = v; s += (v.x * v.x + v.y * v.y) + (v.z * v.z + v.w * v.w); }
                s += __shfl_xor(s, 16); s += __shfl_xor(s, 32);
                if (fq == 0) ss[(size_t)row * 16 + 4 * u.pn + wc] = s;
            }
        }
    }
};
#define GAS __attribute__((address_space(1)))
#define RLX_AGENT __ATOMIC_RELAXED, __HIP_MEMORY_SCOPE_AGENT
#define XB_TMO      128
#define XB_XCNT(j)  (256  + 64 * (j))
#define XB_XSUB(j)  (1280 + 64 * (j))
#define XB_XGEN(j)  (2304 + 64 * (j))
#define XB_TOP      3328
#define XB_TOPGEN   3392
#define XCD_BAR_WORDS 3456
#define XB_SPIN_CAP (1u << 18)

__device__ __forceinline__ unsigned xb_ld(unsigned* p)              { return __hip_atomic_load(p, __ATOMIC_RELAXED, __HIP_MEMORY_SCOPE_AGENT); }
__device__ __forceinline__ unsigned xb_add(unsigned* p, unsigned v) { return __hip_atomic_fetch_add(p, v, __ATOMIC_RELAXED, __HIP_MEMORY_SCOPE_AGENT); }
__device__ __forceinline__ unsigned xb_xcc_id() { return (unsigned)__builtin_amdgcn_s_getreg((3 << 11) | 20) & 0xFu; }
#define XB_SPIN(cond, bar) do { unsigned _sp = 0; while (cond) { __builtin_amdgcn_s_sleep(1); \
    if ((++_sp & 255u) == 0u) { if (xb_ld(&(bar)[XB_TMO])) break; if (_sp > XB_SPIN_CAP) { atomicAdd(&(bar)[XB_TMO], 1u); break; } } } } while (0)

struct XcdBarrier {
    unsigned* bar; unsigned x;
    volatile LAS unsigned* st;
};

__device__ __forceinline__ XcdBarrier xcd_barrier_post(unsigned* bar, volatile LAS unsigned* st) {
    XcdBarrier b; b.bar = bar; b.x = xb_xcc_id(); b.st = st;
    if (threadIdx.x == 0) (void)xb_add(&bar[XB_XCNT(b.x)], 1u);
    return b;
}
__device__ __forceinline__ void xcd_barrier_complete(unsigned* bar, unsigned x, unsigned& nloc, unsigned& nx) {
    const unsigned G = gridDim.x * gridDim.y * gridDim.z;
    unsigned sum, cnt, mine, sp = 0u;
    for (;;) {
        sum = 0u; cnt = 0u; mine = 0u;
#pragma unroll
        for (unsigned j = 0; j < 16; ++j) { const unsigned c = xb_ld(&bar[XB_XCNT(j)]); sum += c; cnt += (c > 0u) ? 1u : 0u; mine = (j == x) ? c : mine; }
        if (sum == G) break;
        __builtin_amdgcn_s_sleep(1);
        if ((++sp & 255u) == 0u) { if (xb_ld(&bar[XB_TMO])) break; if (sp > XB_SPIN_CAP) { atomicAdd(&bar[XB_TMO], 1u); break; } }
    }
    nloc = mine > 0u ? mine : 1u; nx = cnt > 0u ? cnt : 1u;
}

__device__ __forceinline__ void xcd_barrier(const XcdBarrier& b) {
    asm volatile("s_waitcnt vmcnt(0)" ::: "memory");
    __syncthreads();
    if (threadIdx.x == 0) {
        unsigned* bar = b.bar;
        __builtin_amdgcn_s_waitcnt(0);
        unsigned nloc = b.st[0], nx = b.st[1];
        if (nloc == 0u) { xcd_barrier_complete(bar, b.x, nloc, nx); b.st[0] = nloc; b.st[1] = nx; }
        const unsigned old = xb_add(&bar[XB_XSUB(b.x)], 1u);
        const unsigned gen = old / nloc;
        if (old + 1u == (gen + 1u) * nloc) {
            __builtin_amdgcn_fence(__ATOMIC_RELEASE, "agent");
            asm volatile("s_waitcnt vmcnt(0)" ::: "memory");
            const unsigned og = xb_add(&bar[XB_TOP], 1u);
            const unsigned tg = og / nx;
            if (og + 1u == (tg + 1u) * nx) xb_add(&bar[XB_TOPGEN], 1u);
            else XB_SPIN(xb_ld(&bar[XB_TOPGEN]) == tg, bar);
            __builtin_amdgcn_fence(__ATOMIC_ACQUIRE, "agent");
            xb_add(&bar[XB_XGEN(b.x)], 1u);
            asm volatile("s_waitcnt vmcnt(0)" ::: "memory");
        } else {
            XB_SPIN(xb_ld(&bar[XB_XGEN(b.x)]) == gen, bar);
            __builtin_amdgcn_fence(__ATOMIC_ACQUIRE, "agent");
            asm volatile("s_waitcnt vmcnt(0)" ::: "memory");
        }
    }
    __syncthreads();
}
#define MFMA16(a, b, c) __builtin_amdgcn_mfma_f32_16x16x32_bf16((a), (b), (c), 0, 0, 0)
constexpr int RQ = 0, RK = 17408, RKT = 34816, RVT = 53248, RP = 71680, RST = 80896, RO = 115712;
__device__ __forceinline__ void ret_item(const Params& P, LAS unsigned char* lds, int tid, int wave, int lane, int h, int row0, int nchunks, const float* st_in, bool has_in, float* st_out) {
    const bf16* proj = (const bf16*)(P.ws + WS_R1);
    bf16* mix = (bf16*)(P.ws + WS_R2);
    const int fr = lane & 15, fq = lane >> 4;
    const float lg2 = log2f(1.0f - exp2f(-5.0f - (float)h));
    const float kscale = 0.08838834764831845f;
    LAS bf16* Qs = (LAS bf16*)(lds + RQ); LAS bf16* Ks = (LAS bf16*)(lds + RK); LAS bf16* KT = (LAS bf16*)(lds + RKT); LAS bf16* VT = (LAS bf16*)(lds + RVT);
    LAS bf16* Ps = (LAS bf16*)(lds + RP); LAS bf16* ST = (LAS bf16*)(lds + RST); LAS float* Os = (LAS float*)(lds + RO);
    f32x4 st[8];
#pragma unroll
    for (int et = 0; et < 8; ++et) {
        f32x4 v;
#pragma unroll
        for (int r = 0; r < 4; ++r) v[r] = st_in[(size_t)(16 * wave + 4 * fq + r) * 128 + 16 * et + fr];
        asm volatile("" : "+v"(v));
#pragma unroll
        for (int r = 0; r < 4; ++r) v[r] = has_in ? v[r] : 0.f;
        st[et] = v;
    }
    __syncthreads();
#pragma unroll
    for (int et = 0; et < 8; ++et) { u32x2 w; w.x = pk2(st[et][0], st[et][1]); w.y = pk2(st[et][2], st[et][3]); *(LAS u32x2*)(ST + (16 * et + fr) * 136 + 16 * wave + 4 * fq) = w; }
    const size_t goff = (size_t)lane * INW + h * 128 + wave * 16;
    u32x4 pq[2], pk[2], pv[2];
    { const bf16* g = proj + (size_t)row0 * INW + goff;
      pq[0] = *(const u32x4*)(g); pq[1] = *(const u32x4*)(g + 8); pk[0] = *(const u32x4*)(g + 512); pk[1] = *(const u32x4*)(g + 520); pv[0] = *(const u32x4*)(g + 1024); pv[1] = *(const u32x4*)(g + 1032); }
    const float kf = kscale * exp2f(lg2 * (float)(63 - lane));
    const float g64 = exp2f(lg2 * 64.0f);
    for (int c = 0; c < nchunks; ++c) {
        const int rowc = row0 + 64 * c;
        *(LAS u32x4*)(Qs + lane * 136 + wave * 16) = pq[0]; *(LAS u32x4*)(Qs + lane * 136 + wave * 16 + 8) = pq[1];
        *(LAS u32x4*)(Ks + lane * 136 + wave * 16) = pk[0]; *(LAS u32x4*)(Ks + lane * 136 + wave * 16 + 8) = pk[1];
#pragma unroll
        for (int i = 0; i < 2; ++i)
#pragma unroll
            for (int j = 0; j < 4; ++j) { const unsigned wk = pk[i][j], wv = pv[i][j]; const int d = wave * 16 + i * 8 + j * 2;
                const unsigned kk = pk2(bflo(wk) * kf, bfhi(wk) * kf);
                KT[(d) * 72 + lane] = (bf16)(kk & 0xffffu); KT[(d + 1) * 72 + lane] = (bf16)(kk >> 16);
                VT[(d) * 72 + lane] = (bf16)(wv & 0xffffu); VT[(d + 1) * 72 + lane] = (bf16)(wv >> 16); }
        if (c + 1 < nchunks) { const bf16* g = proj + (size_t)(rowc + 64) * INW + goff;
            pq[0] = *(const u32x4*)(g); pq[1] = *(const u32x4*)(g + 8); pk[0] = *(const u32x4*)(g + 512); pk[1] = *(const u32x4*)(g + 520); pv[0] = *(const u32x4*)(g + 1024); pv[1] = *(const u32x4*)(g + 1032); }
        __syncthreads();
        { const int mi = wave >> 1;
#pragma unroll
          for (int jj = 0; jj < 2; ++jj) { const int lj = 2 * (wave & 1) + jj; f32x4 s = (f32x4){0.f, 0.f, 0.f, 0.f};
#pragma unroll
            for (int ks = 0; ks < 4; ++ks) { const bf16x8 a = *(const LAS bf16x8*)(Ks + (16 * mi + fr) * 136 + 32 * ks + 8 * fq), b = *(const LAS bf16x8*)(Qs + (16 * lj + fr) * 136 + 32 * ks + 8 * fq); s = MFMA16(a, b, s); __builtin_amdgcn_sched_barrier(0); }
            const int l = 16 * lj + fr; float pvv[4];
#pragma unroll
            for (int r = 0; r < 4; ++r) { const int m = 16 * mi + 4 * fq + r; const int dlt = l - m; pvv[r] = dlt >= 0 ? s[r] * kscale * exp2f(lg2 * (float)dlt) : 0.f; }
            u32x2 w; w.x = pk2(pvv[0], pvv[1]); w.y = pk2(pvv[2], pvv[3]); *(LAS u32x2*)(Ps + l * 72 + 16 * mi + 4 * fq) = w; } }
#pragma unroll
        for (int et = 0; et < 8; ++et) st[et] = st[et] * g64;
#pragma unroll
        for (int ks = 0; ks < 2; ++ks) { const bf16x8 a = *(const LAS bf16x8*)(KT + (16 * wave + fr) * 72 + 32 * ks + 8 * fq);
#pragma unroll
            for (int et = 0; et < 8; ++et) { const bf16x8 b = *(const LAS bf16x8*)(VT + (16 * et + fr) * 72 + 32 * ks + 8 * fq); st[et] = MFMA16(a, b, st[et]); if (et & 1) __builtin_amdgcn_sched_barrier(0); } }
        __syncthreads();
        { f32x4 oi[4], oc[4];
#pragma unroll
          for (int lt = 0; lt < 4; ++lt) { oi[lt] = (f32x4){0.f, 0.f, 0.f, 0.f}; oc[lt] = (f32x4){0.f, 0.f, 0.f, 0.f}; }
#pragma unroll
          for (int ks = 0; ks < 2; ++ks) { const bf16x8 b = *(const LAS bf16x8*)(VT + (16 * wave + fr) * 72 + 32 * ks + 8 * fq);
#pragma unroll
            for (int lt = 0; lt < 4; ++lt) { const bf16x8 a = *(const LAS bf16x8*)(Ps + (16 * lt + fr) * 72 + 32 * ks + 8 * fq); oi[lt] = MFMA16(a, b, oi[lt]); } __builtin_amdgcn_sched_barrier(0); }
#pragma unroll
          for (int ks = 0; ks < 4; ++ks) { const bf16x8 b = *(const LAS bf16x8*)(ST + (16 * wave + fr) * 136 + 32 * ks + 8 * fq);
#pragma unroll
            for (int lt = 0; lt < 4; ++lt) { const bf16x8 a = *(const LAS bf16x8*)(Qs + (16 * lt + fr) * 136 + 32 * ks + 8 * fq); oc[lt] = MFMA16(a, b, oc[lt]); } __builtin_amdgcn_sched_barrier(0); }
#pragma unroll
          for (int lt = 0; lt < 4; ++lt)
#pragma unroll
            for (int r = 0; r < 4; ++r) { const int l = 16 * lt + 4 * fq + r; Os[l * 132 + 16 * wave + fr] = oi[lt][r] + exp2f(lg2 * (float)(l + 1)) * oc[lt][r]; } }
        __syncthreads();
#pragma unroll
        for (int et = 0; et < 8; ++et) { u32x2 w; w.x = pk2(st[et][0], st[et][1]); w.y = pk2(st[et][2], st[et][3]); *(LAS u32x2*)(ST + (16 * et + fr) * 136 + 16 * wave + 4 * fq) = w; }
        { unsigned gv[8];
#pragma unroll
          for (int i = 0; i < 8; ++i) gv[i] = *(const unsigned*)(proj + (size_t)(rowc + 8 * wave + i) * INW + 1536 + h * 128 + 2 * lane);
#pragma unroll
          for (int i = 0; i < 8; ++i) { const int l = 8 * wave + i; const f32x2 o = *(const LAS f32x2*)(Os + l * 132 + 2 * lane);
            const float ssq = wave_sum(o.x * o.x + o.y * o.y); const float rstd = rsqrtf(ssq * (1.f / 128.f) + EPS);
            const float g0 = bflo(gv[i]), g1 = bfhi(gv[i]);
            *(unsigned*)(mix + (size_t)(rowc + l) * DM + h * 128 + 2 * lane) = pk2(silu_f(g0) * o.x * rstd, silu_f(g1) * o.y * rstd); } }
    }
#pragma unroll
    for (int et = 0; et < 8; ++et)
#pragma unroll
        for (int r = 0; r < 4; ++r) st_out[(size_t)(16 * wave + 4 * fq + r) * 128 + 16 * et + fr] = st[et][r];
}
constexpr int AK = 0, AVT = 27648;
__device__ __forceinline__ void att_item(const Params& P, LAS unsigned char* lds, int tid, int wave, int lane, bool sample, int b, int n, int g) {
    const bf16* proj = (const bf16*)(P.ws + WS_R1);
    bf16* mix = (bf16*)(P.ws + WS_R2);
    const int fr = lane & 15, fq = lane >> 4;
    LAS bf16* Kl = (LAS bf16*)(lds + AK); LAS bf16* VTl = (LAS bf16*)(lds + AVT);
    const int qrow0 = sample ? MP + 64 * b : b * SEQ + 64 * n;
    const int jmin = sample ? 0 : (n >= 2 ? 0 : 64 * (2 - n));
    __syncthreads();
#pragma unroll
    for (int i = 0; i < 3; ++i) { const int p = tid + 512 * i, j = p >> 3, c8 = p & 7; u32x4 w = (u32x4){0u, 0u, 0u, 0u};
        if (j >= jmin) {
            if (sample && j < 128) { const float* s = P.cache_k + ((size_t)(b * 128 + j) * 2 + g) * 64 + 8 * c8; const f32x4 a = *(const f32x4*)s, bb = *(const f32x4*)(s + 4);
                w.x = pk2(a.x, a.y); w.y = pk2(a.z, a.w); w.z = pk2(bb.x, bb.y); w.w = pk2(bb.z, bb.w); }
            else { const int row = sample ? MP + 64 * b + (j - 128) : b * SEQ + 64 * (n - 2) + j; w = *(const u32x4*)(proj + (size_t)row * INW + 2560 + g * 64 + 8 * c8); } }
        *(LAS u32x4*)(Kl + j * 72 + 8 * c8) = w; }
#pragma unroll
    for (int i = 0; i < 3; ++i) { const int j = 64 * i + lane; u32x4 w = (u32x4){0u, 0u, 0u, 0u};
        if (j >= jmin) {
            if (sample && j < 128) { const float* s = P.cache_v + ((size_t)(b * 128 + j) * 2 + g) * 64 + 8 * wave; const f32x4 a = *(const f32x4*)s, bb = *(const f32x4*)(s + 4);
                w.x = pk2(a.x, a.y); w.y = pk2(a.z, a.w); w.z = pk2(bb.x, bb.y); w.w = pk2(bb.z, bb.w); }
            else { const int row = sample ? MP + 64 * b + (j - 128) : b * SEQ + 64 * (n - 2) + j; w = *(const u32x4*)(proj + (size_t)row * INW + 2688 + g * 64 + 8 * wave); } }
#pragma unroll
        for (int e = 0; e < 4; ++e) { VTl[(8 * wave + 2 * e) * 200 + j] = (bf16)(w[e] & 0xffffu); VTl[(8 * wave + 2 * e + 1) * 200 + j] = (bf16)(w[e] >> 16); } }
    const int r = wave >> 1, qh = wave & 1, head = 4 * g + r;
    const float slope = exp2f(-(float)(head + 1));
    const float sink = P.sinks[head];
    const float L2E = 1.4426950408889634f;
    __syncthreads();
#pragma unroll 1
    for (int qt = 0; qt < 2; ++qt) {
        asm volatile("" ::: "memory");
        const int qi = 32 * qh + 16 * qt + fr;
        bf16x8 qf[2];
#pragma unroll
        for (int ks = 0; ks < 2; ++ks) qf[ks] = *(const bf16x8*)(proj + (size_t)(qrow0 + qi) * INW + 2048 + head * 64 + 32 * ks + 8 * fq);
        f32x4 s[12];
#pragma unroll
        for (int kt = 0; kt < 12; ++kt) { s[kt] = (f32x4){0.f, 0.f, 0.f, 0.f};
#pragma unroll
            for (int ks = 0; ks < 2; ++ks) { const bf16x8 a = *(const LAS bf16x8*)(Kl + (16 * kt + fr) * 72 + 32 * ks + 8 * fq); s[kt] = MFMA16(a, qf[ks], s[kt]); } }
        float mx = sink;
#pragma unroll
        for (int kt = 0; kt < 12; ++kt)
#pragma unroll
            for (int rr = 0; rr < 4; ++rr) { const int j = 16 * kt + 4 * fq + rr; const int dist = 128 + qi - j;
                float v = s[kt][rr] * 0.125f - slope * fabsf((float)dist);
                v = j >= jmin ? v : -INFINITY; s[kt][rr] = v; mx = fmaxf(mx, v); }
        mx = fmaxf(mx, __shfl_xor(mx, 16)); mx = fmaxf(mx, __shfl_xor(mx, 32));
        float ls = 0.f;
#pragma unroll
        for (int kt = 0; kt < 12; ++kt)
#pragma unroll
            for (int rr = 0; rr < 4; ++rr) { const float p = exp2f((s[kt][rr] - mx) * L2E); s[kt][rr] = p; ls += p; }
        ls += __shfl_xor(ls, 16); ls += __shfl_xor(ls, 32);
        const float inv = 1.0f / (ls + exp2f((sink - mx) * L2E));
        f32x4 o[4];
#pragma unroll
        for (int dt = 0; dt < 4; ++dt) o[dt] = (f32x4){0.f, 0.f, 0.f, 0.f};
#pragma unroll
        for (int kk = 0; kk < 6; ++kk) {
            u32x4 w; w.x = pk2(s[2 * kk][0], s[2 * kk][1]); w.y = pk2(s[2 * kk][2], s[2 * kk][3]); w.z = pk2(s[2 * kk + 1][0], s[2 * kk + 1][1]); w.w = pk2(s[2 * kk + 1][2], s[2 * kk + 1][3]);
            const bf16x8 pb = __builtin_bit_cast(bf16x8, w);
#pragma unroll
            for (int dt = 0; dt < 4; ++dt) { const LAS bf16* vp = VTl + (16 * dt + fr) * 200 + 32 * kk + 4 * fq;
                const u32x2 lo = *(const LAS u32x2*)vp, hi = *(const LAS u32x2*)(vp + 16);
                const u32x4 aw = (u32x4){lo.x, lo.y, hi.x, hi.y}; const bf16x8 a = __builtin_bit_cast(bf16x8, aw);
                o[dt] = MFMA16(a, pb, o[dt]); }
        }
        bf16* mp = mix + (size_t)(qrow0 + qi) * DM + 512 + head * 64 + 4 * fq;
#pragma unroll
        for (int dt = 0; dt < 4; ++dt) { const f32x4 v = o[dt] * inv; u32x2 w; w.x = pk2(v[0], v[1]); w.y = pk2(v[2], v[3]); *(u32x2*)(mp + 16 * dt) = w; }
    }
}
__device__ __forceinline__ void phase3(const Params& P, LAS unsigned char* lds, int tid, int wave, int lane) {
    const int G = gridDim.x, NR = G / 2, blk = blockIdx.x;
    if (blk < NR) {
#ifndef NO_RET
#ifdef PROBE_RETX2
        for (int rep = 0; rep < 2; ++rep)
#endif
        for (int it = blk; it < 256; it += NR) {
            const bool sample = it >= 128; const int bh = it & 127, b = bh >> 2, h = bh & 3;
            ret_item(P, lds, tid, wave, lane, h, sample ? MP + 64 * b : b * SEQ, sample ? 1 : 32, P.state_ret + (size_t)bh * 16384, sample, P.out + (sample ? OFF_SRET : OFF_PRET) + (size_t)bh * 16384);
        }
#endif
    } else {
#ifndef NO_ATT
        for (int it = blk - NR; it < 2112; it += G - NR) {
            const bool sample = it >= 2048;
            att_item(P, lds, tid, wave, lane, sample, sample ? (it - 2048) >> 1 : it >> 6, sample ? 2 : (it >> 1) & 31, it & 1);
        }
#endif
    }
}

__device__ __forceinline__ void unpack8(const u32x4 w, float (&f)[8]) { f[0] = bflo(w.x); f[1] = bfhi(w.x); f[2] = bflo(w.y); f[3] = bfhi(w.y); f[4] = bflo(w.z); f[5] = bfhi(w.z); f[6] = bflo(w.w); f[7] = bfhi(w.w); }
__device__ __forceinline__ void phase6(const Params& P, int tid) {
    const bf16* ua = (const bf16*)(P.ws + WS_R1); bf16* ub = (bf16*)(P.ws + WS_R2);
    constexpr int CH = DFF / 8;
    const int total = MT * CH;
    for (int idx = blockIdx.x * 512 + tid; idx < total; idx += gridDim.x * 512) {
        const int row = idx / CH, j = (idx - row * CH) * 8;
        const bool smp = row >= MP; const int t = smp ? ((row - MP) & 63) : (row & 2047);
        float a[8], p1[8], p2[8], bb[8];
        unpack8(*(const u32x4*)(ua + (size_t)row * DFF + j), a);
        unpack8(*(const u32x4*)(ub + (size_t)row * DFF + j), bb);
        if (t >= 1) unpack8(*(const u32x4*)(ua + (size_t)(row - 1) * DFF + j), p1);
        else if (smp) { const float* s = P.state_conv + ((size_t)((row - MP) >> 6) * 2 + 1) * DFF + j; const f32x4 x = *(const f32x4*)s, y = *(const f32x4*)(s + 4); p1[0] = x.x; p1[1] = x.y; p1[2] = x.z; p1[3] = x.w; p1[4] = y.x; p1[5] = y.y; p1[6] = y.z; p1[7] = y.w; }
        else {
#pragma unroll
            for (int e = 0; e < 8; ++e) p1[e] = 0.f; }
        if (t >= 2) unpack8(*(const u32x4*)(ua + (size_t)(row - 2) * DFF + j), p2);
        else if (smp) { const float* s = P.state_conv + ((size_t)((row - MP) >> 6) * 2 + t) * DFF + j; const f32x4 x = *(const f32x4*)s, y = *(const f32x4*)(s + 4); p2[0] = x.x; p2[1] = x.y; p2[2] = x.z; p2[3] = x.w; p2[4] = y.x; p2[5] = y.y; p2[6] = y.z; p2[7] = y.w; }
        else {
#pragma unroll
            for (int e = 0; e < 8; ++e) p2[e] = 0.f; }
        float r[8];
#pragma unroll
        for (int h = 0; h < 2; ++h) { const f32x4 w0 = *(const f32x4*)(P.conv_w + j + 4 * h), w1 = *(const f32x4*)(P.conv_w + DFF + j + 4 * h), w2 = *(const f32x4*)(P.conv_w + 2 * DFF + j + 4 * h), cb = *(const f32x4*)(P.conv_b + j + 4 * h);
#pragma unroll
            for (int e = 0; e < 4; ++e) { const float cv = cb[e] + w0[e] * p2[4 * h + e] + w1[e] * p1[4 * h + e] + w2[e] * a[4 * h + e]; r[4 * h + e] = silu_f(cv) * bb[4 * h + e]; } }
        u32x4 w; w.x = pk2(r[0], r[1]); w.y = pk2(r[2], r[3]); w.z = pk2(r[4], r[5]); w.w = pk2(r[6], r[7]);
        *(u32x4*)(ub + (size_t)row * DFF + j) = w;
    }
}
__device__ __forceinline__ void phase8(const Params& P, int wave, int lane) {
    const float* mod = (const float*)(P.ws + WS_MOD); const float* ss = (const float*)(P.ws + WS_SS2);
    const int gw = blockIdx.x * 8 + wave, NGW = gridDim.x * 8;
    for (int row = gw; row < MT; row += NGW) {
        const int bs = row < MP ? (row >> 11) : 32 + ((row - MP) >> 6);
        float* yr = P.out + (size_t)row * DM + 4 * lane;
        const float* mb = mod + (size_t)bs * 8192 + 6144 + 4 * lane;
        float q = lane < 16 ? ss[(size_t)row * 16 + lane] : 0.f;
        q = wave_sum(q);
        const float rstd = rsqrtf(q * (1.f / DM) + EPS);
#pragma unroll
        for (int j = 0; j < 4; ++j) { const f32x4 v = *(const f32x4*)(yr + 256 * j), sh = *(const f32x4*)(mb + 256 * j), sc = *(const f32x4*)(mb + 1024 + 256 * j), gn = *(const f32x4*)(P.normf + 4 * lane + 256 * j);
            *(f32x4*)(yr + 256 * j) = v * rstd * gn * (sc + 1.0f) + sh; }
    }
}

#ifndef N_LAUNCH
#define N_LAUNCH 1
#endif
#define LAUNDER_TID() int tid = threadIdx.x; asm volatile("" : "+v"(tid)); const int lane = tid & 63, wave = __builtin_amdgcn_readfirstlane(tid >> 6); (void)lane; (void)wave
template <int PHM>
__global__ void __launch_bounds__(512) fwd_mega(Params P) {
    extern __shared__ __attribute__((aligned(16))) unsigned char lds_raw[];
    LAS unsigned char* lds = (LAS unsigned char*)lds_raw;
    const int G = gridDim.x;
    unsigned char* ws = P.ws;
    volatile LAS unsigned* misc = (volatile LAS unsigned*)(lds + LDS_MISC);
    if (threadIdx.x < 2) misc[threadIdx.x] = 0u;
    __syncthreads();
    XcdBarrier bar; bar.bar = (unsigned*)(ws + WS_BAR); bar.x = 0; bar.st = misc;
#define GSYNC(a, b) do { if ((PHM & (a)) && (PHM & (b))) xcd_barrier(bar); } while (0)
    if constexpr ((PHM & 1) != 0) { LAUNDER_TID(); phase0(P, lds, wave, lane);
      if (blockIdx.x == 0) for (int i = tid; i < XCD_BAR_WORDS; i += 512) ((unsigned*)(ws + WS_BAR))[i] = 0u; }
    if constexpr ((PHM & 1) != 0 && (PHM & 2) != 0) {
      cg::this_grid().sync();
      bar = xcd_barrier_post((unsigned*)(ws + WS_BAR), misc); }
    if constexpr ((PHM & 2) != 0) { LAUNDER_TID(); phase1(P, lds, tid, wave, lane); }
    GSYNC(2, 4);
    if constexpr ((PHM & 4) != 0) {
      pg8::Gemm g{(const bf16*)(ws + WS_R0), (const bf16*)(ws + WS_WIN), MT, INW, DM};
      OrderX S; S.S.init(MT, INW, G, (int)blockIdx.x); S.nX = 22; S.xpm = NTM; S.xpn0 = 11;
      Epi1 E{(bf16*)(ws + WS_R1), (float*)(ws + WS_SHW), P.out};
      pg8::gemm_phase<Epi1, OrderX, true, true>(lds, g, S, E); }
    GSYNC(4, 8);
    if constexpr ((PHM & 8) != 0) { LAUNDER_TID(); phase3(P, lds, tid, wave, lane);
#ifdef PROBE_P3X2
      cg::this_grid().sync(); phase3(P, lds, tid, wave, lane);
#endif
    }
    GSYNC(8, 16);
    if constexpr ((PHM & 16) != 0) {
      pg8::Gemm g{(const bf16*)(ws + WS_R2), (const bf16*)(ws + WS_WOUT), MT, DM, DM};
      pg8::StaticOrder S; S.init(MT, DM, G, (int)blockIdx.x);
      Epi2 E{P.x_p, P.x_s, (const float*)(ws + WS_MOD), P.ln2, P.out, (bf16*)(ws + WS_R0), (float*)(ws + WS_SS1)};
      pg8::gemm_phase<Epi2, pg8::StaticOrder, true, true>(lds, g, S, E); }
    GSYNC(16, 32);
    if constexpr ((PHM & 32) != 0) {
      LAUNDER_TID();
      pg8::Gemm g{(const bf16*)(ws + WS_R0), (const bf16*)(ws + WS_WUP), MT, 2 * DFF, DM};
      pg8::StaticOrder S; S.init(MT, 2 * DFF, G, (int)blockIdx.x);
      LAS float* rtab = (LAS float*)(lds + 131072);
      { pg8::Unit u; const float* ss = (const float*)(ws + WS_SS1);
        for (int i = 0; S.next(i, u) && i < 24; ++i) if (tid < 256) { const f32x4* sp = (const f32x4*)(ss + (size_t)(u.pm * 256 + tid) * 16);
            const f32x4 q0 = sp[0], q1 = sp[1], q2 = sp[2], q3 = sp[3];
            const float tot = ((q0.x + q0.y) + (q0.z + q0.w)) + ((q1.x + q1.y) + (q1.z + q1.w)) + ((q2.x + q2.y) + (q2.z + q2.w)) + ((q3.x + q3.y) + (q3.z + q3.w));
            rtab[i * 256 + tid] = rsqrtf(tot * (1.f / DM) + EPS); }
        __syncthreads(); }
      Epi3 E{rtab, (const float*)(ws + WS_SHW), (bf16*)(ws + WS_R1), (bf16*)(ws + WS_R2), P.out};
      pg8::gemm_phase<Epi3, pg8::StaticOrder, true, true>(lds, g, S, E);
#ifdef PROBE_P5X2
      cg::this_grid().sync(); pg8::gemm_phase<Epi3, pg8::StaticOrder, true, true>(lds, g, S, E);
#endif
    }
    GSYNC(32, 64);
    if constexpr ((PHM & 64) != 0) { LAUNDER_TID(); phase6(P, tid); }
    GSYNC(64, 128);
    if constexpr ((PHM & 128) != 0) {
      pg8::Gemm g{(const bf16*)(ws + WS_R2), (const bf16*)(ws + WS_WDN), MT, DM, DFF};
      pg8::StaticOrder S; S.init(MT, DM, G, (int)blockIdx.x);
      Epi4 E{(const float*)(ws + WS_MOD), P.out, (float*)(ws + WS_SS2)};
      pg8::gemm_phase<Epi4, pg8::StaticOrder, true, true>(lds, g, S, E); }
    GSYNC(128, 256);
    if constexpr ((PHM & 256) != 0) { LAUNDER_TID(); phase8(P, wave, lane); }
}

template <int PHM> static bool launch_one(const Params& p, int grid, bool coop, hipStream_t stream) {
    static bool attr_done = false;
    if (!attr_done) { if (hipFuncSetAttribute((const void*)fwd_mega<PHM>, hipFuncAttributeMaxDynamicSharedMemorySize, LDS_BYTES) != hipSuccess) { fprintf(stderr, "kernel_launch: hipFuncSetAttribute failed\n"); return false; } attr_done = true; }
    hipError_t e;
    if (coop) { Params pc = p; void* args[] = {&pc}; e = hipLaunchCooperativeKernel((const void*)fwd_mega<PHM>, dim3(grid), dim3(512), args, LDS_BYTES, stream); }
    else { hipLaunchKernelGGL(fwd_mega<PHM>, dim3(grid), dim3(512), LDS_BYTES, stream, p); e = hipPeekAtLastError(); }
    if (e != hipSuccess) { fprintf(stderr, "launch (mask %d) failed: %s (grid %d)\n", PHM, hipGetErrorString(e), grid); return false; }
    return true;
}
extern "C" void kernel_launch(void* const* d_in, const int* in_sizes, int n_in, void* d_out, int out_size, void* d_ws, size_t ws_size, hipStream_t stream) {
    static int grid = 0;
    if (grid == 0) {
        if (n_in != 22 || (size_t)out_size != OUT_TOTAL || ws_size < WS_END) { fprintf(stderr, "kernel_launch: unexpected sizes n_in %d out %d ws %zu\n", n_in, out_size, ws_size); grid = -1; return; }
        int dev = 0, cus = 0;
        (void)hipGetDevice(&dev);
        (void)hipDeviceGetAttribute(&cus, hipDeviceAttributeMultiprocessorCount, dev);
        grid = cus;
        if (grid > 256) grid = 256;
        if (grid < 2) grid = -1;
    }
    if (grid < 0) return;
    Params p{};
    const float** pp = (const float**)&p;
    for (int i = 0; i < 22; ++i) pp[i] = (const float*)d_in[i];
    p.out = (float*)d_out; p.ws = (unsigned char*)d_ws;
#if N_LAUNCH == 1
    launch_one<511>(p, grid, true, stream);
#else
    launch_one<1>(p, grid, false, stream) && launch_one<2>(p, grid, false, stream) && launch_one<4>(p, grid, false, stream) && launch_one<8>(p, grid, false, stream) &&
    launch_one<16>(p, grid, false, stream) && launch_one<32>(p, grid, false, stream) && launch_one<64>(p, grid, false, stream) && launch_one<128>(p, grid, false, stream) && launch_one<256>(p, grid, false, stream);
#endif
}
```

```cpp
#define CONV_FUSED 1
#include <hip/hip_runtime.h>
#include <hip/hip_cooperative_groups.h>
#include <cstdio>
#include <cstdint>
namespace cg = cooperative_groups;
namespace pg8 {
#define PG8_LAS __attribute__((address_space(3)))
typedef unsigned short bf16_t;
typedef short bf16x8 __attribute__((ext_vector_type(8)));
typedef float f32x4 __attribute__((ext_vector_type(4)));
typedef unsigned u32x4 __attribute__((ext_vector_type(4)));
constexpr int BM = 256, BK = 64, HALF = 128, HTB = HALF * BK * 2  , STAGE_BYTES = 8 * HTB, NXCD = 8, WGM = 8;

__host__ __device__ __forceinline__ int lds_byte(int r, int c) { const int st = (r >> 4) * 2 + (c >> 5), rr = r & 15, cc = c & 31, ob = rr * 64 + cc * 2; return st * 1024 + (ob ^ (((ob >> 9) & 1) << 5)); }
__host__ __device__ __forceinline__ void stage_rc(int b, int& R, int& C) { const int st = b / 1024, sb = b % 1024, swz = sb ^ (((sb >> 9) & 1) << 5); R = (st >> 1) * 16 + swz / 64; C = (st & 1) * 32 + (swz % 64) / 2; }
__host__ __device__ __forceinline__ int perm32(int rho) { const int n = rho >> 4, i = rho & 15; return 8 * (i >> 2) + 4 * n + (i & 3); }

struct Unit { int pm, pn, seq; };
struct Gemm { const bf16_t* A; const bf16_t* Bt; int M, N, K; };

struct StaticOrder {
    int nM, nN, nwg, G, c;
    __host__ __device__ __forceinline__ void init(int M, int N, int G_, int c_) { nM = M / BM; nN = N / BM; nwg = nM * nN; G = G_; c = c_; }
    __host__ __device__ __forceinline__ bool next(int i, Unit& u) const {
        const long L = (long)i * G + c; if (L >= nwg) return false; u.seq = i;
        int wgid = (int)L; { const int q = nwg / NXCD, r = nwg % NXCD, xcd = wgid % NXCD, off = wgid / NXCD; wgid = (xcd < r ? xcd * (q + 1) : r * (q + 1) + (xcd - r) * q) + off; }
        const int nig = WGM * nN, gid = wgid / nig, fm = gid * WGM, gsz = (nM - fm) < WGM ? (nM - fm) : WGM;
        u.pm = fm + ((wgid % nig) % gsz); u.pn = (wgid % nig) / gsz; return true;
    }
    __device__ __forceinline__ void a_ready(const Unit&) const {}
    __device__ __forceinline__ void done(const Unit&) const {}
};

__device__ __forceinline__ unsigned cvt_pk_bf16(float lo, float hi) { unsigned r; asm volatile("v_cvt_pk_bf16_f32 %0, %1, %2" : "=v"(r) : "v"(lo), "v"(hi)); return r; }

template <class Epi, class Sched, bool ALIGN_EPI = false, bool SP2 = false>
__device__ __forceinline__ void gemm_phase(PG8_LAS unsigned char* lds, const Gemm g, const Sched& S, const Epi& E) {
    int tid_ = threadIdx.x; asm volatile("" : "+v"(tid_));
    const int tid = tid_, wid = __builtin_amdgcn_readfirstlane(tid >> 6), lane = tid & 63, wr = wid >> 2, wc = wid & 3, fr = lane & 15, fq = lane >> 4;
    const int K = g.K, nt = K / BK;
    unsigned voffA[2], voffB[2];
#pragma unroll
    for (int i = 0; i < 2; ++i) { int R, C; stage_rc(tid * 16 + i * 8192, R, C); const int Rb = Epi::PERM ? ((R & ~31) + perm32(R & 31)) : R;
        voffA[i] = (unsigned)(R * K + C) * 2u; voffB[i] = (unsigned)(Rb * K + C) * 2u; }
    const size_t kstep = (size_t)(BK * 2);
    const size_t hstep = (size_t)HALF * K * 2;
    const size_t tstep = 2 * hstep;
    const unsigned ldsw = (unsigned)wid * 1024u;
    const int aoff = lds_byte(wr * 64 + fr, fq * 8), boff = lds_byte(wc * 32 + fr, fq * 8);
#define PG8_SA(b, h) (((b) * 2 + (h)) * HTB)
#define PG8_SB(b, h) ((4 + (b) * 2 + (h)) * HTB)
#define PG8_STAGE(bufoff, gbase, voff) do { _Pragma("unroll") for (int _i = 0; _i < 2; ++_i) \
        __builtin_amdgcn_global_load_lds((const unsigned*)((const char*)(gbase) + (voff)[_i]), (PG8_LAS unsigned*)(lds + (bufoff) + ldsw + _i * 8192), 16, 0, 0); } while (0)
#define PG8_LDA(dst, b, h) do { _Pragma("unroll") for (int m = 0; m < 4; ++m) _Pragma("unroll") for (int k = 0; k < 2; ++k) dst[m][k] = *(const PG8_LAS bf16x8*)(lds + PG8_SA(b, h) + aoff + m * 2048 + k * 1024); } while (0)
#define PG8_LDB(dst, b, h) do { _Pragma("unroll") for (int n = 0; n < 2; ++n) _Pragma("unroll") for (int k = 0; k < 2; ++k) dst[n][k] = *(const PG8_LAS bf16x8*)(lds + PG8_SB(b, h) + boff + n * 2048 + k * 1024); } while (0)
#define PG8_MMA(ai, bj, At, Bt) do { __builtin_amdgcn_s_setprio(1); _Pragma("unroll") for (int m = 0; m < 4; ++m) _Pragma("unroll") for (int n = 0; n < 2; ++n) _Pragma("unroll") for (int k = 0; k < 2; ++k) \
        acc[ai][bj][m][n] = __builtin_amdgcn_mfma_f32_16x16x32_bf16(Bt[n][k], At[m][k], acc[ai][bj][m][n], 0, 0, 0); __builtin_amdgcn_s_setprio(0); } while (0)
#define PG8_WAIT_V(n) asm volatile("s_waitcnt vmcnt(" #n ")" ::: "memory")
#define PG8_WAIT_L(n) asm volatile("s_waitcnt lgkmcnt(" #n ")" ::: "memory")
#define PG8_BAR __builtin_amdgcn_s_barrier()
#define PG8_SCHED __builtin_amdgcn_sched_barrier(0)
    Unit cur, nxt; int ui = 0;
    if (!S.next(0, cur)) return;
    f32x4 acc[2][2][4][2];
#pragma unroll
    for (int a = 0; a < 2; ++a)
#pragma unroll
        for (int b = 0; b < 2; ++b)
#pragma unroll
            for (int m = 0; m < 4; ++m)
#pragma unroll
                for (int n = 0; n < 2; ++n) acc[a][b][m][n] = (f32x4){0.f, 0.f, 0.f, 0.f};
    bf16x8 At[4][2], B0[2][2], B1[2][2];
    const char* cA = (const char*)g.A + (size_t)cur.pm * tstep; const char* cB = (const char*)g.Bt + (size_t)cur.pn * tstep;
    S.a_ready(cur);
    if constexpr (SP2) {
        PG8_STAGE(PG8_SB(0, 0), cB, voffB); PG8_STAGE(PG8_SB(0, 1), cB + hstep, voffB); PG8_STAGE(PG8_SA(0, 0), cA, voffA); PG8_STAGE(PG8_SA(0, 1), cA + hstep, voffA);
        if (wr == 1) PG8_BAR;
        PG8_WAIT_V(2); PG8_BAR;
        PG8_STAGE(PG8_SB(1, 0), cB + kstep, voffB); PG8_STAGE(PG8_SA(1, 0), cA + kstep, voffA); PG8_STAGE(PG8_SB(1, 1), cB + hstep + kstep, voffB);
        PG8_WAIT_V(6); PG8_BAR;
    } else {
        PG8_STAGE(PG8_SB(0, 0), cB, voffB); PG8_STAGE(PG8_SA(0, 0), cA, voffA); PG8_STAGE(PG8_SB(0, 1), cB + hstep, voffB); PG8_STAGE(PG8_SA(0, 1), cA + hstep, voffA);
        if (wr == 1) PG8_BAR;
        PG8_WAIT_V(4); PG8_BAR;
        PG8_STAGE(PG8_SB(1, 0), cB + kstep, voffB); PG8_STAGE(PG8_SA(1, 0), cA + kstep, voffA); PG8_STAGE(PG8_SB(1, 1), cB + hstep + kstep, voffB);
        PG8_WAIT_V(6); PG8_BAR;
    }
    for (;;) {
        const bool has_next = S.next(ui + 1, nxt);
        const char* nA = has_next ? (const char*)g.A + (size_t)nxt.pm * tstep : cA; const char* nB = has_next ? (const char*)g.Bt + (size_t)nxt.pn * tstep : cB;
        for (int t = 0; t < nt; t += 2) {
            const bool last = (t == nt - 2);
            const char* a1 = cA + (size_t)(t + 1) * kstep;
            const char* a2 = last ? nA : cA + (size_t)(t + 2) * kstep; const char* b2 = last ? nB : cB + (size_t)(t + 2) * kstep;
            const char* a3 = a2 + kstep; const char* b3 = b2 + kstep;
            if (last && has_next) S.a_ready(nxt);
            if constexpr (SP2) {
            PG8_LDB(B0, 0, 0); PG8_LDB(B1, 0, 1); PG8_SCHED; PG8_LDA(At, 0, 0); PG8_STAGE(PG8_SA(1, 1), a1 + hstep, voffA);
            PG8_WAIT_V(8); PG8_WAIT_L(0); PG8_BAR; PG8_MMA(0, 0, At, B0); PG8_MMA(0, 1, At, B1); PG8_BAR; PG8_SCHED;
            PG8_LDA(At, 0, 1); PG8_STAGE(PG8_SB(0, 0), b2, voffB); PG8_STAGE(PG8_SB(0, 1), b2 + hstep, voffB); PG8_STAGE(PG8_SA(0, 0), a2, voffA);
            PG8_WAIT_V(8); PG8_WAIT_L(0); PG8_BAR; PG8_MMA(1, 0, At, B0); PG8_MMA(1, 1, At, B1); PG8_BAR; PG8_SCHED;
            PG8_LDB(B0, 1, 0); PG8_LDB(B1, 1, 1); PG8_SCHED; PG8_LDA(At, 1, 0); PG8_STAGE(PG8_SA(0, 1), a2 + hstep, voffA);
            PG8_WAIT_V(8); PG8_WAIT_L(0); PG8_BAR; PG8_MMA(0, 0, At, B0); PG8_MMA(0, 1, At, B1); PG8_BAR; PG8_SCHED;
            PG8_LDA(At, 1, 1); PG8_STAGE(PG8_SB(1, 0), b3, voffB); PG8_STAGE(PG8_SB(1, 1), b3 + hstep, voffB); PG8_STAGE(PG8_SA(1, 0), a3, voffA);
            PG8_WAIT_V(8); PG8_WAIT_L(0); PG8_BAR; PG8_MMA(1, 0, At, B0); PG8_MMA(1, 1, At, B1); PG8_BAR; PG8_SCHED;
            } else {
            PG8_LDB(B0, 0, 0); PG8_SCHED; PG8_LDA(At, 0, 0); PG8_STAGE(PG8_SA(1, 1), a1 + hstep, voffA);
            PG8_WAIT_L(8); PG8_BAR; PG8_WAIT_L(0); PG8_MMA(0, 0, At, B0); PG8_BAR; PG8_SCHED;
            PG8_LDB(B1, 0, 1); PG8_STAGE(PG8_SB(0, 0), b2, voffB);
            PG8_BAR; PG8_WAIT_L(0); PG8_MMA(0, 1, At, B1); PG8_BAR;
            PG8_LDA(At, 0, 1); PG8_STAGE(PG8_SA(0, 0), a2, voffA);
            PG8_BAR; PG8_WAIT_L(0); PG8_MMA(1, 0, At, B0); PG8_BAR; PG8_SCHED;
            PG8_STAGE(PG8_SB(0, 1), b2 + hstep, voffB);
            PG8_WAIT_V(6); PG8_BAR; PG8_MMA(1, 1, At, B1); PG8_BAR;
            PG8_LDB(B0, 1, 0); PG8_SCHED; PG8_LDA(At, 1, 0); PG8_STAGE(PG8_SA(0, 1), a2 + hstep, voffA);
            PG8_WAIT_L(8); PG8_BAR; PG8_WAIT_L(0); PG8_MMA(0, 0, At, B0); PG8_BAR; PG8_SCHED;
            PG8_LDB(B1, 1, 1); PG8_STAGE(PG8_SB(1, 0), b3, voffB);
            PG8_BAR; PG8_WAIT_L(0); PG8_MMA(0, 1, At, B1); PG8_BAR;
            PG8_LDA(At, 1, 1); PG8_STAGE(PG8_SA(1, 0), a3, voffA);
            PG8_BAR; PG8_WAIT_L(0); PG8_MMA(1, 0, At, B0); PG8_BAR; PG8_SCHED;
            PG8_STAGE(PG8_SB(1, 1), b3 + hstep, voffB);
            PG8_WAIT_V(6); PG8_BAR; PG8_MMA(1, 1, At, B1); PG8_BAR;
            }
        }
        if constexpr (ALIGN_EPI) { if (wr == 0) PG8_BAR; }
        if constexpr (!Epi::AFTER_DRAIN) { E(acc, cur, wr, wc, fr, fq); S.done(cur); }
        if (!has_next) break;
#pragma unroll
        for (int a = 0; a < 2; ++a)
#pragma unroll
            for (int b = 0; b < 2; ++b)
#pragma unroll
                for (int m = 0; m < 4; ++m)
#pragma unroll
                    for (int n = 0; n < 2; ++n) acc[a][b][m][n] = (f32x4){0.f, 0.f, 0.f, 0.f};
        cur = nxt; cA = nA; cB = nB; ++ui;
        if constexpr (ALIGN_EPI) { if (wr == 1) PG8_BAR; }
    }
    PG8_WAIT_V(0);
    if constexpr (!ALIGN_EPI) { if (wr == 0) PG8_BAR; }
    PG8_BAR;
    if constexpr (Epi::AFTER_DRAIN) { E.fused(acc, cur, wr, wc, fr, fq, lds, wid, lane); S.done(cur); }
#undef PG8_SA
#undef PG8_SB
#undef PG8_STAGE
#undef PG8_LDA
#undef PG8_LDB
#undef PG8_MMA
#undef PG8_WAIT_V
#undef PG8_WAIT_L
#undef PG8_BAR
#undef PG8_SCHED
}
}
constexpr int DM = 1024, SEQ = 2048, NB = 32, DECL = 64, DFF = 2816, INW = 2816;
constexpr int MP = NB * SEQ, MS = NB * DECL, MT = MP + MS;
constexpr int NGRP = MT / 64;
constexpr int NTM = MT / 256;
constexpr float EPS = 1e-6f;
constexpr size_t OFF_Y = 0;
constexpr size_t OFF_PRET = (size_t)MT * DM;
constexpr size_t OFF_PK = OFF_PRET + (size_t)NB * 4 * 128 * 128;
constexpr size_t OFF_PV = OFF_PK + (size_t)NB * 128 * 128;
constexpr size_t OFF_PCONV = OFF_PV + (size_t)NB * 128 * 128;
constexpr size_t OFF_SRET = OFF_PCONV + (size_t)NB * 2 * DFF;
constexpr size_t OFF_SK = OFF_SRET + (size_t)NB * 4 * 128 * 128;
constexpr size_t OFF_SV = OFF_SK + (size_t)NB * 64 * 128;
constexpr size_t OFF_SCONV = OFF_SV + (size_t)NB * 64 * 128;
constexpr size_t OUT_TOTAL = OFF_SCONV + (size_t)NB * 2 * DFF;
constexpr size_t MiB = 1u << 20;
constexpr size_t WS_WIN = 0;
constexpr size_t WS_WUP = WS_WIN + (size_t)INW * DM * 2;
constexpr size_t WS_WOUT = WS_WUP + (size_t)2 * DFF * DM * 2;
constexpr size_t WS_WDN = WS_WOUT + (size_t)DM * DM * 2;
constexpr size_t WS_MODP = 24 * MiB;
constexpr size_t WS_MOD = 32 * MiB;
constexpr size_t WS_SHW = 34 * MiB;
constexpr size_t WS_SS1 = 36 * MiB;
constexpr size_t WS_SS2 = 41 * MiB;
constexpr size_t WS_R0 = 48 * MiB;
constexpr size_t WS_R1 = WS_R0 + 133 * MiB;
constexpr size_t WS_R2 = WS_R1 + 363 * MiB;
constexpr size_t WS_END = WS_R2 + 363 * MiB;
static_assert(WS_WDN + (size_t)DM * DFF * 2 <= WS_MODP, "ws map");
static_assert((size_t)(MT + 256) * DM * 2 <= 133 * MiB && (size_t)MT * DFF * 2 <= 363 * MiB, "ws map");
constexpr size_t HT_STRIDE = (size_t)NGRP * 2 * DFF;
static_assert(3 * HT_STRIDE * 4 <= 133 * MiB, "ws map");

constexpr size_t WS_BAR = 46 * MiB;
constexpr int LDS_MISC = 155648;
constexpr int LDS_BYTES = 155648 + 64;

#define LAS __attribute__((address_space(3)))
typedef unsigned short bf16;
typedef float f32x4 __attribute__((ext_vector_type(4)));
typedef float f32x2 __attribute__((ext_vector_type(2)));
typedef short bf16x8 __attribute__((ext_vector_type(8)));
typedef unsigned u32x4 __attribute__((ext_vector_type(4)));
typedef unsigned u32x2 __attribute__((ext_vector_type(2)));
typedef __bf16 bf16x2_t __attribute__((ext_vector_type(2)));
#define LDS_WAIT() asm volatile("s_waitcnt lgkmcnt(0)" ::: "memory")

__device__ __forceinline__ unsigned pk2(float lo, float hi) { f32x2 v = {lo, hi}; bf16x2_t b = __builtin_convertvector(v, bf16x2_t); return __builtin_bit_cast(unsigned, b); }
__device__ __forceinline__ float bflo(unsigned w) { return __uint_as_float(w << 16); }
__device__ __forceinline__ float bfhi(unsigned w) { return __uint_as_float(w & 0xffff0000u); }
__device__ __forceinline__ float wave_sum(float v) {
#pragma unroll
    for (int o = 1; o < 64; o <<= 1) v += __shfl_xor(v, o);
    return v;
}
__device__ __forceinline__ float silu_f(float x) { return x * __builtin_amdgcn_rcpf(1.0f + __builtin_amdgcn_exp2f(-1.4426950408889634f * x)); }
__device__ __forceinline__ int grp_bs(int g) { return g < 1024 ? (g >> 5) : 32 + (g - 1024); }

struct Params {
    const float *x_p, *x_s, *cache_k, *cache_v, *state_ret, *state_conv, *c_p, *c_s, *ln1, *ln2, *w_ada, *b_ada, *w_in, *w_out, *sinks, *w_up, *conv_w, *conv_b, *w_down, *normf, *w_ada_f, *b_ada_f;
    float* out; unsigned char* ws;
};

__device__ __forceinline__ void transpose_item(const float* W, int K, int N, bf16* WT, int dst_row0, int k0, int n0, LAS float* scr, int lane) {
#pragma unroll 8
    for (int i = 0; i < 32; ++i) { const int kk = 2 * i + (lane >> 5); scr[kk * 33 + (lane & 31)] = W[(size_t)(k0 + kk) * N + n0 + (lane & 31)]; }
    LDS_WAIT(); asm volatile("" ::: "memory");
    const int c = lane & 7;
#pragma unroll
    for (int j = 0; j < 4; ++j) { const int n = (lane >> 3) + 8 * j; const LAS float* s = scr + (8 * c) * 33 + n;
        u32x4 o; o.x = pk2(s[0 * 33], s[1 * 33]); o.y = pk2(s[2 * 33], s[3 * 33]); o.z = pk2(s[4 * 33], s[5 * 33]); o.w = pk2(s[6 * 33], s[7 * 33]);
        *(u32x4*)(WT + (size_t)(dst_row0 + n) * K + k0 + 8 * c) = o; }
    LDS_WAIT(); asm volatile("" ::: "memory");
}
__device__ __forceinline__ void mod_item(const Params& P, int it, LAS float* scr, int lane) {
    const int ct = it >> 2, ks = it & 3, c0 = ct * 64;
    const float* W; const float* bias; int ldw;
    if (c0 < 6144) { W = P.w_ada + c0; bias = P.b_ada + c0; ldw = 6144; } else { W = P.w_ada_f + (c0 - 6144); bias = P.b_ada_f + (c0 - 6144); ldw = 2048; }
    float acc[64];
#pragma unroll
    for (int r = 0; r < 64; ++r) acc[r] = 0.f;
    const float* crow = (lane < 32 ? P.c_p + (size_t)lane * DM : P.c_s + (size_t)(lane - 32) * DM) + ks * 256;
    for (int kc = 0; kc < 8; ++kc) {
#pragma unroll
        for (int q = 0; q < 8; ++q) { f32x4 v = *(const f32x4*)(crow + kc * 32 + 4 * q);
            v.x = silu_f(v.x); v.y = silu_f(v.y); v.z = silu_f(v.z); v.w = silu_f(v.w);
            *(LAS f32x4*)(scr + lane * 36 + 4 * q) = v; }
        LDS_WAIT(); asm volatile("" ::: "memory");
        const float* wk = W + (size_t)(ks * 256 + kc * 32) * ldw + lane;
        for (int k4 = 0; k4 < 8; ++k4) {
            const float w0 = wk[(size_t)(4 * k4 + 0) * ldw], w1 = wk[(size_t)(4 * k4 + 1) * ldw], w2 = wk[(size_t)(4 * k4 + 2) * ldw], w3 = wk[(size_t)(4 * k4 + 3) * ldw];
#pragma unroll
            for (int r = 0; r < 64; ++r) { const f32x4 s = *(const LAS f32x4*)(scr + r * 36 + 4 * k4); acc[r] += (s.x * w0 + s.y * w1) + (s.z * w2 + s.w * w3); }
        }
        LDS_WAIT(); asm volatile("" ::: "memory");
    }
    float* dst = (float*)(P.ws + WS_MODP) + (size_t)ks * 64 * 8192 + c0 + lane;
    const float bv = (ks == 0) ? bias[lane] : 0.f;
#pragma unroll
    for (int r = 0; r < 64; ++r) dst[(size_t)r * 8192] = acc[r] + bv;
}
__device__ __forceinline__ void phase0(const Params& P, LAS unsigned char* lds, int wave, int lane) {
    LAS float* scr = (LAS float*)(lds + wave * 16384);
    const int gw = blockIdx.x * 8 + wave, NGW = gridDim.x * 8;
    constexpr int I_MOD = 512, I_IN = 16 * 88, I_UP = 16 * 176, I_OUT = 16 * 32, I_DN = 44 * 32;
    constexpr int NIT = I_MOD + I_IN + I_UP + I_OUT + I_DN;
    for (int it = gw; it < NIT; it += NGW) {
        int r = it;
        if (r < I_MOD) { mod_item(P, r, scr, lane); continue; } r -= I_MOD;
        if (r < I_IN) { const int kb = r / 88, nb = r % 88; transpose_item(P.w_in, DM, INW, (bf16*)(P.ws + WS_WIN), nb * 32, kb * 64, nb * 32, scr, lane); continue; } r -= I_IN;
        if (r < I_UP) { const int kb = r / 176, nb = r % 176, n0 = nb * 32, isb = n0 >= DFF, j0 = n0 - isb * DFF;
            transpose_item(P.w_up, DM, 2 * DFF, (bf16*)(P.ws + WS_WUP), 256 * (j0 >> 7) + 128 * isb + (j0 & 127), kb * 64, n0, scr, lane); continue; } r -= I_UP;
        if (r < I_OUT) { const int kb = r / 32, nb = r % 32; transpose_item(P.w_out, DM, DM, (bf16*)(P.ws + WS_WOUT), nb * 32, kb * 64, nb * 32, scr, lane); continue; } r -= I_OUT;
        { const int kb = r / 32, nb = r % 32; transpose_item(P.w_down, DFF, DM, (bf16*)(P.ws + WS_WDN), nb * 32, kb * 64, nb * 32, scr, lane); }
    }
}

__device__ __forceinline__ void phase1(const Params& P, LAS unsigned char* lds, int tid, int wave, int lane) {
    const float* modp = (const float*)(P.ws + WS_MODP);
    float* mod = (float*)(P.ws + WS_MOD);
    bf16* H1 = (bf16*)(P.ws + WS_R0);
    for (int idx = blockIdx.x * 512 + tid; idx < 64 * 8192; idx += gridDim.x * 512) {
        const float s = (modp[idx] + modp[idx + 524288]) + (modp[idx + 2 * 524288] + modp[idx + 3 * 524288]);
        mod[idx] = s;
        const int col = idx & 8191, bs = idx >> 13;
        if (col >= 3072 && col < 4096) H1[(size_t)(MT + bs) * DM + (col - 3072)] = (bf16)(pk2(s, 0.f) & 0xffffu);
    }
    LAS float* lv = (LAS float*)lds;
    for (int g = blockIdx.x; g < NGRP; g += gridDim.x) {
        const int bs = grp_bs(g);
        __syncthreads();
        for (int i = tid; i < 2048; i += 512) { const int which = i >> 10, col = i & 1023; const size_t o = (size_t)bs * 8192 + which * 1024 + col;
            float s = (modp[o] + modp[o + 524288]) + (modp[o + 2 * 524288] + modp[o + 3 * 524288]);
            if (which) s = P.ln1[col] * (1.f + s);
            lv[i] = s; }
        __syncthreads();
#pragma unroll 2
        for (int i = 0; i < 8; ++i) {
            const int row = g * 64 + wave * 8 + i;
            const float* xr = (row < MP ? P.x_p + (size_t)row * DM : P.x_s + (size_t)(row - MP) * DM) + 4 * lane;
            f32x4 v[4]; float ss = 0.f;
#pragma unroll
            for (int j = 0; j < 4; ++j) { v[j] = *(const f32x4*)(xr + 256 * j); ss += (v[j].x * v[j].x + v[j].y * v[j].y) + (v[j].z * v[j].z + v[j].w * v[j].w); }
            const float rstd = rsqrtf(wave_sum(ss) * (1.f / DM) + EPS);
            bf16* hr = H1 + (size_t)row * DM + 4 * lane;
#pragma unroll
            for (int j = 0; j < 4; ++j) { const f32x4 sh = *(const LAS f32x4*)(lv + 256 * j + 4 * lane), gs = *(const LAS f32x4*)(lv + 1024 + 256 * j + 4 * lane);
                const f32x4 h = v[j] * rstd * gs + sh; u32x2 w; w.x = pk2(h.x, h.y); w.y = pk2(h.z, h.w); *(u32x2*)(hr + 256 * j) = w; }
        }
    }
}

struct OrderX {
    pg8::StaticOrder S; int nX, xpm, xpn0;
    __device__ __forceinline__ bool next(int i, pg8::Unit& u) const {
        const long L = (long)i * S.G + S.c;
        int pm = 0, pn = 0; bool ok = false;
        if (L < S.nwg) { pg8::Unit t; t.pm = 0; t.pn = 0; t.seq = 0; (void)S.next(i, t); pm = t.pm; pn = t.pn; ok = true; }
        else if (L < S.nwg + nX) { pm = xpm; pn = xpn0 + (int)(L - S.nwg); ok = true; }
        u.pm = pm; u.pn = pn; u.seq = i;
        return ok;
    }
    __device__ __forceinline__ void a_ready(const pg8::Unit&) const {}
    __device__ __forceinline__ void done(const pg8::Unit&) const {}
};
typedef const f32x4 (&AccRef)[2][2][4][2];
struct Epi1 {
    static constexpr bool PERM = true, AFTER_DRAIN = false;
    bf16* proj; float* shw; float* out;
    __device__ __forceinline__ void operator()(AccRef acc, const pg8::Unit& u, int wr, int wc, int fr, int fq) const {
        if (u.pm == NTM) {
            if (wr == 0) {
#pragma unroll
                for (int m = 0; m < 4; ++m) { float* d = shw + (size_t)(16 * m + fr) * (2 * DFF) + 256 * (u.pn - 11) + 32 * wc + 8 * fq;
#pragma unroll
                    for (int bj = 0; bj < 2; ++bj)
#pragma unroll
                        for (int n = 0; n < 2; ++n) *(f32x4*)(d + 128 * bj + 4 * n) = acc[0][bj][m][n]; }
            }
            return;
        }
        const unsigned row0 = u.pm * 256 + wr * 64 + fr, col0 = u.pn * 256 + wc * 32 + 8 * fq;
#pragma unroll
        for (int ai = 0; ai < 2; ++ai)
#pragma unroll
            for (int m = 0; m < 4; ++m) { const unsigned o = (row0 + 128 * ai + 16 * m) * (unsigned)INW + col0;
#pragma unroll
                for (int bj = 0; bj < 2; ++bj) { const f32x4 v0 = acc[ai][bj][m][0], v1 = acc[ai][bj][m][1];
                    u32x4 w; w.x = pk2(v0[0], v0[1]); w.y = pk2(v0[2], v0[3]); w.z = pk2(v1[0], v1[1]); w.w = pk2(v1[2], v1[3]);
                    *(u32x4*)(proj + (o + 128 * bj)) = w; }
                asm volatile("" ::: "memory"); }
        if (u.pn == 10) {
            const unsigned c = 32 * wc + 8 * fq;
#pragma unroll
            for (int ai = 0; ai < 2; ++ai)
#pragma unroll
                for (int m = 0; m < 4; ++m) { const unsigned row = row0 + 128 * ai + 16 * m; unsigned ok, ov;
                    if (row < (unsigned)MP) { const unsigned t = row & 2047; if (t < SEQ - 128) continue; const unsigned o = ((row >> 11) * 128 + (t - (SEQ - 128))) * 128 + c; ok = (unsigned)OFF_PK + o; ov = (unsigned)OFF_PV + o; }
                    else { const unsigned o = (row - MP) * 128 + c; ok = (unsigned)OFF_SK + o; ov = (unsigned)OFF_SV + o; }
                    *(f32x4*)(out + ok) = acc[ai][0][m][0]; *(f32x4*)(out + ok + 4) = acc[ai][0][m][1];
                    *(f32x4*)(out + ov) = acc[ai][1][m][0]; *(f32x4*)(out + ov + 4) = acc[ai][1][m][1];
                    asm volatile("" ::: "memory"); }
        }
    }
};
struct Epi2 {
    static constexpr bool PERM = true, AFTER_DRAIN = false;
    const float *xp, *xs, *mod, *ln2; float* x1; bf16* a2; float* ss;
    __device__ __forceinline__ void operator()(AccRef acc, const pg8::Unit& u, int wr, int wc, int fr, int fq) const {
        const int col0 = u.pn * 256 + wc * 32 + 8 * fq;
#pragma unroll
        for (int ai = 0; ai < 2; ++ai) {
            const int bs = grp_bs(4 * u.pm + 2 * ai + wr);
            const float* mb = mod + (size_t)bs * 8192;
            f32x4 g1v[2][2], gsv[2][2];
#pragma unroll
            for (int bj = 0; bj < 2; ++bj)
#pragma unroll
                for (int n = 0; n < 2; ++n) { const int c = col0 + 128 * bj + 4 * n; g1v[bj][n] = *(const f32x4*)(mb + 2048 + c);
                    gsv[bj][n] = *(const f32x4*)(ln2 + c) * (*(const f32x4*)(mb + 4096 + c) + 1.0f); }
#pragma unroll
            for (int m = 0; m < 4; ++m) {
                const int row = u.pm * 256 + 128 * ai + 64 * wr + 16 * m + fr;
                const float* xr = row < MP ? xp + (size_t)row * DM : xs + (size_t)(row - MP) * DM;
                float s = 0.f;
#pragma unroll
                for (int bj = 0; bj < 2; ++bj) { f32x4 a[2];
#pragma unroll
                    for (int n = 0; n < 2; ++n) { const int c = col0 + 128 * bj + 4 * n; const f32x4 xv = *(const f32x4*)(xr + c); const f32x4 v = xv + g1v[bj][n] * acc[ai][bj][m][n];
                        *(f32x4*)(x1 + (size_t)row * DM + c) = v; s += (v.x * v.x + v.y * v.y) + (v.z * v.z + v.w * v.w); a[n] = v * gsv[bj][n]; }
                    u32x4 w; w.x = pk2(a[0].x, a[0].y); w.y = pk2(a[0].z, a[0].w); w.z = pk2(a[1].x, a[1].y); w.w = pk2(a[1].z, a[1].w);
                    *(u32x4*)(a2 + (size_t)row * DM + col0 + 128 * bj) = w; }
                s += __shfl_xor(s, 16); s += __shfl_xor(s, 32);
                if (fq == 0) ss[(size_t)row * 16 + 4 * u.pn + wc] = s;
            }
        }
    }
};
struct Epi3 {
    static constexpr bool PERM = true, AFTER_DRAIN = false;
    const LAS float* rtab; const float* shw; bf16 *ua, *ub; float* out;
    __device__ __forceinline__ void operator()(AccRef acc, const pg8::Unit& u, int wr, int wc, int fr, int fq) const {
        const unsigned j0 = u.pn * 128 + wc * 32 + 8 * fq, pc0 = u.pn * 256 + wc * 32 + 8 * fq;
#pragma unroll
        for (int ai = 0; ai < 2; ++ai) {
            const unsigned grp = 4 * u.pm + 2 * ai + wr, bs = grp_bs((int)grp);
            const unsigned so = bs * (2 * DFF) + pc0;
            const f32x4 sa0 = *(const f32x4*)(shw + so), sa1 = *(const f32x4*)(shw + so + 4), sb0 = *(const f32x4*)(shw + so + 128), sb1 = *(const f32x4*)(shw + so + 132);
#pragma unroll
            for (int m = 0; m < 4; ++m) {
                const float rstd = rtab[u.seq * 256 + 128 * ai + 64 * wr + 16 * m + fr];
                const unsigned row = grp * 64 + 16 * m + fr;
                const f32x4 a0 = acc[ai][0][m][0] * rstd + sa0, a1 = acc[ai][0][m][1] * rstd + sa1, b0 = acc[ai][1][m][0] * rstd + sb0, b1 = acc[ai][1][m][1] * rstd + sb1;
                u32x4 w; w.x = pk2(a0[0], a0[1]); w.y = pk2(a0[2], a0[3]); w.z = pk2(a1[0], a1[1]); w.w = pk2(a1[2], a1[3]);
                *(u32x4*)(ua + (row * (unsigned)DFF + j0)) = w;
                w.x = pk2(b0[0], b0[1]); w.y = pk2(b0[2], b0[3]); w.z = pk2(b1[0], b1[1]); w.w = pk2(b1[2], b1[3]);
                *(u32x4*)(ub + (row * (unsigned)DFF + j0)) = w;
                if (m == 3 && fr >= 14) {
                    if (grp >= 1024) { float* d = out + OFF_SCONV + ((size_t)(grp - 1024) * 2 + (fr - 14)) * DFF + j0; *(f32x4*)d = a0; *(f32x4*)(d + 4) = a1; }
                    else if ((grp & 31) == 31) { float* d = out + OFF_PCONV + ((size_t)(grp >> 5) * 2 + (fr - 14)) * DFF + j0; *(f32x4*)d = a0; *(f32x4*)(d + 4) = a1; }
                }
            }
        }
    }
};
#ifdef CONV_FUSED
struct Epi3C {
    static constexpr bool PERM = true, AFTER_DRAIN = false;
    const LAS float* rtab; const float *shw, *cw, *cb; bf16* act; float *headA, *headB, *tailA;
    __device__ __forceinline__ void operator()(AccRef acc, const pg8::Unit& u, int wr, int wc, int fr, int fq) const {
        const unsigned j0 = u.pn * 128 + wc * 32 + 8 * fq, pc0 = u.pn * 256 + wc * 32 + 8 * fq;
        f32x4 w0[2], w1[2], w2[2], cbv[2];
#pragma unroll
        for (int n = 0; n < 2; ++n) { w0[n] = *(const f32x4*)(cw + j0 + 4 * n); w1[n] = *(const f32x4*)(cw + DFF + j0 + 4 * n); w2[n] = *(const f32x4*)(cw + 2 * DFF + j0 + 4 * n); cbv[n] = *(const f32x4*)(cb + j0 + 4 * n); }
#pragma unroll
        for (int ai = 0; ai < 2; ++ai) {
            asm volatile("" ::: "memory");
            const unsigned grp = 4 * u.pm + 2 * ai + wr, bs = grp_bs((int)grp);
            const unsigned so = bs * (2 * DFF) + pc0, ho = (grp * 2 + (fr & 1)) * DFF + j0;
            u32x2 ap[4][2], bp[4][2];
            {
                f32x4 sa[2], sb[2];
#pragma unroll
                for (int n = 0; n < 2; ++n) { sa[n] = *(const f32x4*)(shw + so + 4 * n); sb[n] = *(const f32x4*)(shw + so + 128 + 4 * n); }
#pragma unroll
                for (int m = 0; m < 4; ++m) {
                    const float rs = rtab[u.seq * 256 + 128 * ai + 64 * wr + 16 * m + fr];
#pragma unroll
                    for (int n = 0; n < 2; ++n) {
                        const f32x4 av = acc[ai][0][m][n] * rs + sa[n], bv = acc[ai][1][m][n] * rs + sb[n];
                        if (m == 0) { if (fr < 2) { *(f32x4*)(headA + ho + 4 * n) = av; *(f32x4*)(headB + ho + 4 * n) = bv; } }
                        if (m == 3) { if (fr >= 14) *(f32x4*)(tailA + ho + 4 * n) = av; }
                        ap[m][n].x = pk2(av.x, av.y); ap[m][n].y = pk2(av.z, av.w); bp[m][n].x = pk2(bv.x, bv.y); bp[m][n].y = pk2(bv.z, bv.w);
                    }
                }
            }
            asm volatile("" ::: "memory");
#pragma unroll
            for (int n = 0; n < 2; ++n)
#pragma unroll
                for (int h = 0; h < 2; ++h) {
                    unsigned q1 = 0u, q2 = 0u;
#pragma unroll
                    for (int m = 0; m < 4; ++m) {
                        const unsigned a = ap[m][n][h];
                        const unsigned s1 = (unsigned)__builtin_amdgcn_update_dpp((int)a, (int)a, 0x121, 0xf, 0xf, false);
                        const unsigned s2 = (unsigned)__builtin_amdgcn_update_dpp((int)a, (int)a, 0x122, 0xf, 0xf, false);
                        const unsigned pr1 = fr >= 1 ? s1 : q1, pr2 = fr >= 2 ? s2 : q2;
                        q1 = s1; q2 = s2;
                        const float c0 = cbv[n][2 * h] + w0[n][2 * h] * bflo(pr2) + w1[n][2 * h] * bflo(pr1) + w2[n][2 * h] * bflo(a);
                        const float c1 = cbv[n][2 * h + 1] + w0[n][2 * h + 1] * bfhi(pr2) + w1[n][2 * h + 1] * bfhi(pr1) + w2[n][2 * h + 1] * bfhi(a);
                        const unsigned bw = bp[m][n][h];
                        bp[m][n][h] = pk2(silu_f(c0) * bflo(bw), silu_f(c1) * bfhi(bw));
                    }
                    __builtin_amdgcn_sched_barrier(0);
                }
            asm volatile("" ::: "memory");
#pragma unroll
            for (int m = 0; m < 4; ++m) {
                if (m == 0 && fr < 2) continue;
                const unsigned row = grp * 64 + 16 * m + fr;
                const u32x4 w = (u32x4){bp[m][0].x, bp[m][0].y, bp[m][1].x, bp[m][1].y};
                *(u32x4*)(act + (row * (unsigned)DFF + j0)) = w;
            }
        }
    }
};
#endif
struct Epi4 {
    static constexpr bool PERM = true, AFTER_DRAIN = false;
    const float* mod; float* x1; float* ss;
    __device__ __forceinline__ void operator()(AccRef acc, const pg8::Unit& u, int wr, int wc, int fr, int fq) const {
        const int col0 = u.pn * 256 + wc * 32 + 8 * fq;
#pragma unroll
        for (int ai = 0; ai < 2; ++ai) {
            const int bs = grp_bs(4 * u.pm + 2 * ai + wr);
            const float* mb = mod + (size_t)bs * 8192 + 5120;
            f32x4 g2v[2][2];
#pragma unroll
            for (int bj = 0; bj < 2; ++bj)
#pragma unroll
                for (int n = 0; n < 2; ++n) g2v[bj][n] = *(const f32x4*)(mb + col0 + 128 * bj + 4 * n);
#pragma unroll
            for (int m = 0; m < 4; ++m) {
                const int row = u.pm * 256 + 128 * ai + 64 * wr + 16 * m + fr;
                float* xr = x1 + (size_t)row * DM;
                float s = 0.f;
#pragma unroll
                for (int bj = 0; bj < 2; ++bj)
#pragma unroll
                    for (int n = 0; n < 2; ++n) { const int c = col0 + 128 * bj + 4 * n; const f32x4 v = *(const f32x4*)(xr + c) + g2v[bj][n] * acc[ai][bj][m][n];
                        *(f32x4*)(xr + c) = v; s += (v.x * v.x + v.y * v.y) + (v.z * v.z + v.w * v.w); }
                s += __shfl_xor(s, 16); s += __shfl_xor(s, 32);
                if (fq == 0) ss[(size_t)row * 16 + 4 * u.pn + wc] = s;
            }
        }
    }
};
#define GAS __attribute__((address_space(1)))
#define RLX_AGENT __ATOMIC_RELAXED, __HIP_MEMORY_SCOPE_AGENT
#define XB_TMO      128
#define XB_XCNT(j)  (256  + 64 * (j))
#define XB_XSUB(j)  (1280 + 64 * (j))
#define XB_XGEN(j)  (2304 + 64 * (j))
#define XB_TOP      3328
#define XB_TOPGEN   3392
#define XCD_BAR_WORDS 3456
#define XB_SPIN_CAP (1u << 18)

__device__ __forceinline__ unsigned xb_ld(unsigned* p)              { return __hip_atomic_load(p, __ATOMIC_RELAXED, __HIP_MEMORY_SCOPE_AGENT); }
__device__ __forceinline__ unsigned xb_add(unsigned* p, unsigned v) { return __hip_atomic_fetch_add(p, v, __ATOMIC_RELAXED, __HIP_MEMORY_SCOPE_AGENT); }
__device__ __forceinline__ unsigned xb_xcc_id() { return (unsigned)__builtin_amdgcn_s_getreg((3 << 11) | 20) & 0xFu; }
#define XB_SPIN(cond, bar) do { unsigned _sp = 0; while (cond) { __builtin_amdgcn_s_sleep(1); \
    if ((++_sp & 255u) == 0u) { if (xb_ld(&(bar)[XB_TMO])) break; if (_sp > XB_SPIN_CAP) { atomicAdd(&(bar)[XB_TMO], 1u); break; } } } } while (0)

struct XcdBarrier {
    unsigned* bar; unsigned x;
    volatile LAS unsigned* st;
};

__device__ __forceinline__ XcdBarrier xcd_barrier_post(unsigned* bar, volatile LAS unsigned* st) {
    XcdBarrier b; b.bar = bar; b.x = xb_xcc_id(); b.st = st;
    if (threadIdx.x == 0) (void)xb_add(&bar[XB_XCNT(b.x)], 1u);
    return b;
}
__device__ __forceinline__ void xcd_barrier_complete(unsigned* bar, unsigned x, unsigned& nloc, unsigned& nx) {
    const unsigned G = gridDim.x * gridDim.y * gridDim.z;
    unsigned sum, cnt, mine, sp = 0u;
    for (;;) {
        sum = 0u; cnt = 0u; mine = 0u;
#pragma unroll
        for (unsigned j = 0; j < 16; ++j) { const unsigned c = xb_ld(&bar[XB_XCNT(j)]); sum += c; cnt += (c > 0u) ? 1u : 0u; mine = (j == x) ? c : mine; }
        if (sum == G) break;
        __builtin_amdgcn_s_sleep(1);
        if ((++sp & 255u) == 0u) { if (xb_ld(&bar[XB_TMO])) break; if (sp > XB_SPIN_CAP) { atomicAdd(&bar[XB_TMO], 1u); break; } }
    }
    nloc = mine > 0u ? mine : 1u; nx = cnt > 0u ? cnt : 1u;
}

__device__ __forceinline__ void xcd_barrier(const XcdBarrier& b) {
    asm volatile("s_waitcnt vmcnt(0)" ::: "memory");
    __syncthreads();
    if (threadIdx.x == 0) {
        unsigned* bar = b.bar;
        __builtin_amdgcn_s_waitcnt(0);
        unsigned nloc = b.st[0], nx = b.st[1];
        if (nloc == 0u) { xcd_barrier_complete(bar, b.x, nloc, nx); b.st[0] = nloc; b.st[1] = nx; }
        const unsigned old = xb_add(&bar[XB_XSUB(b.x)], 1u);
        const unsigned gen = old / nloc;
        if (old + 1u == (gen + 1u) * nloc) {
            __builtin_amdgcn_fence(__ATOMIC_RELEASE, "agent");
            asm volatile("s_waitcnt vmcnt(0)" ::: "memory");
            const unsigned og = xb_add(&bar[XB_TOP], 1u);
            const unsigned tg = og / nx;
            if (og + 1u == (tg + 1u) * nx) xb_add(&bar[XB_TOPGEN], 1u);
            else XB_SPIN(xb_ld(&bar[XB_TOPGEN]) == tg, bar);
            __builtin_amdgcn_fence(__ATOMIC_ACQUIRE, "agent");
            xb_add(&bar[XB_XGEN(b.x)], 1u);
            asm volatile("s_waitcnt vmcnt(0)" ::: "memory");
        } else {
            XB_SPIN(xb_ld(&bar[XB_XGEN(b.x)]) == gen, bar);
            __builtin_amdgcn_fence(__ATOMIC_ACQUIRE, "agent");
            asm volatile("s_waitcnt vmcnt(0)" ::: "memory");
        }
    }
    __syncthreads();
}
#define MFMA16(a, b, c) __builtin_amdgcn_mfma_f32_16x16x32_bf16((a), (b), (c), 0, 0, 0)
constexpr int RQ = 0, RK = 17408, RKT = 34816, RVT = 53248, RP = 71680, RST = 80896, RO = 115712;
__device__ __forceinline__ void ret_item(const Params& P, LAS unsigned char* lds, int tid, int wave, int lane, int h, int row0, int nchunks, const float* st_in, bool has_in, float* st_out) {
    const bf16* proj = (const bf16*)(P.ws + WS_R1);
    bf16* mix = (bf16*)(P.ws + WS_R2);
    const int fr = lane & 15, fq = lane >> 4;
    const float lg2 = log2f(1.0f - exp2f(-5.0f - (float)h));
    const float kscale = 0.08838834764831845f;
    LAS bf16* Qs = (LAS bf16*)(lds + RQ); LAS bf16* Ks = (LAS bf16*)(lds + RK); LAS bf16* KT = (LAS bf16*)(lds + RKT); LAS bf16* VT = (LAS bf16*)(lds + RVT);
    LAS bf16* Ps = (LAS bf16*)(lds + RP); LAS bf16* ST = (LAS bf16*)(lds + RST); LAS float* Os = (LAS float*)(lds + RO);
    f32x4 st[8];
#pragma unroll
    for (int et = 0; et < 8; ++et) {
        f32x4 v;
#pragma unroll
        for (int r = 0; r < 4; ++r) v[r] = st_in[(size_t)(16 * wave + 4 * fq + r) * 128 + 16 * et + fr];
        asm volatile("" : "+v"(v));
#pragma unroll
        for (int r = 0; r < 4; ++r) v[r] = has_in ? v[r] : 0.f;
        st[et] = v;
    }
    __syncthreads();
#pragma unroll
    for (int et = 0; et < 8; ++et) { u32x2 w; w.x = pk2(st[et][0], st[et][1]); w.y = pk2(st[et][2], st[et][3]); *(LAS u32x2*)(ST + (16 * et + fr) * 136 + 16 * wave + 4 * fq) = w; }
    const size_t goff = (size_t)lane * INW + h * 128 + wave * 16;
    u32x4 pq[2], pk[2], pv[2];
    { const bf16* g = proj + (size_t)row0 * INW + goff;
      pq[0] = *(const u32x4*)(g); pq[1] = *(const u32x4*)(g + 8); pk[0] = *(const u32x4*)(g + 512); pk[1] = *(const u32x4*)(g + 520); pv[0] = *(const u32x4*)(g + 1024); pv[1] = *(const u32x4*)(g + 1032); }
    const float kf = kscale * exp2f(lg2 * (float)(63 - lane));
    const float g64 = exp2f(lg2 * 64.0f);
    for (int c = 0; c < nchunks; ++c) {
        const int rowc = row0 + 64 * c;
        *(LAS u32x4*)(Qs + lane * 136 + wave * 16) = pq[0]; *(LAS u32x4*)(Qs + lane * 136 + wave * 16 + 8) = pq[1];
        *(LAS u32x4*)(Ks + lane * 136 + wave * 16) = pk[0]; *(LAS u32x4*)(Ks + lane * 136 + wave * 16 + 8) = pk[1];
#pragma unroll
        for (int i = 0; i < 2; ++i)
#pragma unroll
            for (int j = 0; j < 4; ++j) { const unsigned wk = pk[i][j], wv = pv[i][j]; const int d = wave * 16 + i * 8 + j * 2;
                const unsigned kk = pk2(bflo(wk) * kf, bfhi(wk) * kf);
                KT[(d) * 72 + lane] = (bf16)(kk & 0xffffu); KT[(d + 1) * 72 + lane] = (bf16)(kk >> 16);
                VT[(d) * 72 + lane] = (bf16)(wv & 0xffffu); VT[(d + 1) * 72 + lane] = (bf16)(wv >> 16); }
        if (c + 1 < nchunks) { const bf16* g = proj + (size_t)(rowc + 64) * INW + goff;
            pq[0] = *(const u32x4*)(g); pq[1] = *(const u32x4*)(g + 8); pk[0] = *(const u32x4*)(g + 512); pk[1] = *(const u32x4*)(g + 520); pv[0] = *(const u32x4*)(g + 1024); pv[1] = *(const u32x4*)(g + 1032); }
        __syncthreads();
        { const int mi = wave >> 1;
#pragma unroll
          for (int jj = 0; jj < 2; ++jj) { const int lj = 2 * (wave & 1) + jj; f32x4 s = (f32x4){0.f, 0.f, 0.f, 0.f};
#pragma unroll
            for (int ks = 0; ks < 4; ++ks) { const bf16x8 a = *(const LAS bf16x8*)(Ks + (16 * mi + fr) * 136 + 32 * ks + 8 * fq), b = *(const LAS bf16x8*)(Qs + (16 * lj + fr) * 136 + 32 * ks + 8 * fq); s = MFMA16(a, b, s); __builtin_amdgcn_sched_barrier(0); }
            const int l = 16 * lj + fr; float pvv[4];
#pragma unroll
            for (int r = 0; r < 4; ++r) { const int m = 16 * mi + 4 * fq + r; const int dlt = l - m; pvv[r] = dlt >= 0 ? s[r] * kscale * exp2f(lg2 * (float)dlt) : 0.f; }
            u32x2 w; w.x = pk2(pvv[0], pvv[1]); w.y = pk2(pvv[2], pvv[3]); *(LAS u32x2*)(Ps + l * 72 + 16 * mi + 4 * fq) = w; } }
#pragma unroll
        for (int et = 0; et < 8; ++et) st[et] = st[et] * g64;
#pragma unroll
        for (int ks = 0; ks < 2; ++ks) { const bf16x8 a = *(const LAS bf16x8*)(KT + (16 * wave + fr) * 72 + 32 * ks + 8 * fq);
#pragma unroll
            for (int et = 0; et < 8; ++et) { const bf16x8 b = *(const LAS bf16x8*)(VT + (16 * et + fr) * 72 + 32 * ks + 8 * fq); st[et] = MFMA16(a, b, st[et]); if (et & 1) __builtin_amdgcn_sched_barrier(0); } }
        __syncthreads();
        { f32x4 oi[4], oc[4];
#pragma unroll
          for (int lt = 0; lt < 4; ++lt) { oi[lt] = (f32x4){0.f, 0.f, 0.f, 0.f}; oc[lt] = (f32x4){0.f, 0.f, 0.f, 0.f}; }
#pragma unroll
          for (int ks = 0; ks < 2; ++ks) { const bf16x8 b = *(const LAS bf16x8*)(VT + (16 * wave + fr) * 72 + 32 * ks + 8 * fq);
#pragma unroll
            for (int lt = 0; lt < 4; ++lt) { const bf16x8 a = *(const LAS bf16x8*)(Ps + (16 * lt + fr) * 72 + 32 * ks + 8 * fq); oi[lt] = MFMA16(a, b, oi[lt]); } __builtin_amdgcn_sched_barrier(0); }
#pragma unroll
          for (int ks = 0; ks < 4; ++ks) { const bf16x8 b = *(const LAS bf16x8*)(ST + (16 * wave + fr) * 136 + 32 * ks + 8 * fq);
#pragma unroll
            for (int lt = 0; lt < 4; ++lt) { const bf16x8 a = *(const LAS bf16x8*)(Qs + (16 * lt + fr) * 136 + 32 * ks + 8 * fq); oc[lt] = MFMA16(a, b, oc[lt]); } __builtin_amdgcn_sched_barrier(0); }
#pragma unroll
          for (int lt = 0; lt < 4; ++lt)
#pragma unroll
            for (int r = 0; r < 4; ++r) { const int l = 16 * lt + 4 * fq + r; Os[l * 132 + 16 * wave + fr] = oi[lt][r] + exp2f(lg2 * (float)(l + 1)) * oc[lt][r]; } }
        __syncthreads();
#pragma unroll
        for (int et = 0; et < 8; ++et) { u32x2 w; w.x = pk2(st[et][0], st[et][1]); w.y = pk2(st[et][2], st[et][3]); *(LAS u32x2*)(ST + (16 * et + fr) * 136 + 16 * wave + 4 * fq) = w; }
        { unsigned gv[8];
#pragma unroll
          for (int i = 0; i < 8; ++i) gv[i] = *(const unsigned*)(proj + (size_t)(rowc + 8 * wave + i) * INW + 1536 + h * 128 + 2 * lane);
#pragma unroll
          for (int i = 0; i < 8; ++i) { const int l = 8 * wave + i; const f32x2 o = *(const LAS f32x2*)(Os + l * 132 + 2 * lane);
            const float ssq = wave_sum(o.x * o.x + o.y * o.y); const float rstd = rsqrtf(ssq * (1.f / 128.f) + EPS);
            const float g0 = bflo(gv[i]), g1 = bfhi(gv[i]);
            *(unsigned*)(mix + (size_t)(rowc + l) * DM + h * 128 + 2 * lane) = pk2(silu_f(g0) * o.x * rstd, silu_f(g1) * o.y * rstd); } }
    }
#pragma unroll
    for (int et = 0; et < 8; ++et)
#pragma unroll
        for (int r = 0; r < 4; ++r) st_out[(size_t)(16 * wave + 4 * fq + r) * 128 + 16 * et + fr] = st[et][r];
}
constexpr int AK = 0, AVT = 27648;
__device__ __forceinline__ void att_item(const Params& P, LAS unsigned char* lds, int tid, int wave, int lane, bool sample, int b, int n, int g) {
    const bf16* proj = (const bf16*)(P.ws + WS_R1);
    bf16* mix = (bf16*)(P.ws + WS_R2);
    const int fr = lane & 15, fq = lane >> 4;
    LAS bf16* Kl = (LAS bf16*)(lds + AK); LAS bf16* VTl = (LAS bf16*)(lds + AVT);
    const int qrow0 = sample ? MP + 64 * b : b * SEQ + 64 * n;
    const int jmin = sample ? 0 : (n >= 2 ? 0 : 64 * (2 - n));
    __syncthreads();
#pragma unroll
    for (int i = 0; i < 3; ++i) { const int p = tid + 512 * i, j = p >> 3, c8 = p & 7; u32x4 w = (u32x4){0u, 0u, 0u, 0u};
        if (j >= jmin) {
            if (sample && j < 128) { const float* s = P.cache_k + ((size_t)(b * 128 + j) * 2 + g) * 64 + 8 * c8; const f32x4 a = *(const f32x4*)s, bb = *(const f32x4*)(s + 4);
                w.x = pk2(a.x, a.y); w.y = pk2(a.z, a.w); w.z = pk2(bb.x, bb.y); w.w = pk2(bb.z, bb.w); }
            else { const int row = sample ? MP + 64 * b + (j - 128) : b * SEQ + 64 * (n - 2) + j; w = *(const u32x4*)(proj + (size_t)row * INW + 2560 + g * 64 + 8 * c8); } }
        *(LAS u32x4*)(Kl + j * 72 + 8 * c8) = w; }
#pragma unroll
    for (int i = 0; i < 3; ++i) { const int j = 64 * i + lane; u32x4 w = (u32x4){0u, 0u, 0u, 0u};
        if (j >= jmin) {
            if (sample && j < 128) { const float* s = P.cache_v + ((size_t)(b * 128 + j) * 2 + g) * 64 + 8 * wave; const f32x4 a = *(const f32x4*)s, bb = *(const f32x4*)(s + 4);
                w.x = pk2(a.x, a.y); w.y = pk2(a.z, a.w); w.z = pk2(bb.x, bb.y); w.w = pk2(bb.z, bb.w); }
            else { const int row = sample ? MP + 64 * b + (j - 128) : b * SEQ + 64 * (n - 2) + j; w = *(const u32x4*)(proj + (size_t)row * INW + 2688 + g * 64 + 8 * wave); } }
#pragma unroll
        for (int e = 0; e < 4; ++e) { VTl[(8 * wave + 2 * e) * 200 + j] = (bf16)(w[e] & 0xffffu); VTl[(8 * wave + 2 * e + 1) * 200 + j] = (bf16)(w[e] >> 16); } }
    const int r = wave >> 1, qh = wave & 1, head = 4 * g + r;
    const float slope = exp2f(-(float)(head + 1));
    const float sink = P.sinks[head];
    const float L2E = 1.4426950408889634f;
    __syncthreads();
#pragma unroll 1
    for (int qt = 0; qt < 2; ++qt) {
        asm volatile("" ::: "memory");
        const int qi = 32 * qh + 16 * qt + fr;
        bf16x8 qf[2];
#pragma unroll
        for (int ks = 0; ks < 2; ++ks) qf[ks] = *(const bf16x8*)(proj + (size_t)(qrow0 + qi) * INW + 2048 + head * 64 + 32 * ks + 8 * fq);
        f32x4 s[12];
#pragma unroll
        for (int kt = 0; kt < 12; ++kt) { s[kt] = (f32x4){0.f, 0.f, 0.f, 0.f};
#pragma unroll
            for (int ks = 0; ks < 2; ++ks) { const bf16x8 a = *(const LAS bf16x8*)(Kl + (16 * kt + fr) * 72 + 32 * ks + 8 * fq); s[kt] = MFMA16(a, qf[ks], s[kt]); } }
        float mx = sink;
#pragma unroll
        for (int kt = 0; kt < 12; ++kt)
#pragma unroll
            for (int rr = 0; rr < 4; ++rr) { const int j = 16 * kt + 4 * fq + rr; const int dist = 128 + qi - j;
                float v = s[kt][rr] * 0.125f - slope * fabsf((float)dist);
                v = j >= jmin ? v : -INFINITY; s[kt][rr] = v; mx = fmaxf(mx, v); }
        mx = fmaxf(mx, __shfl_xor(mx, 16)); mx = fmaxf(mx, __shfl_xor(mx, 32));
        float ls = 0.f;
#pragma unroll
        for (int kt = 0; kt < 12; ++kt)
#pragma unroll
            for (int rr = 0; rr < 4; ++rr) { const float p = exp2f((s[kt][rr] - mx) * L2E); s[kt][rr] = p; ls += p; }
        ls += __shfl_xor(ls, 16); ls += __shfl_xor(ls, 32);
        const float inv = 1.0f / (ls + exp2f((sink - mx) * L2E));
        f32x4 o[4];
#pragma unroll
        for (int dt = 0; dt < 4; ++dt) o[dt] = (f32x4){0.f, 0.f, 0.f, 0.f};
#pragma unroll
        for (int kk = 0; kk < 6; ++kk) {
            u32x4 w; w.x = pk2(s[2 * kk][0], s[2 * kk][1]); w.y = pk2(s[2 * kk][2], s[2 * kk][3]); w.z = pk2(s[2 * kk + 1][0], s[2 * kk + 1][1]); w.w = pk2(s[2 * kk + 1][2], s[2 * kk + 1][3]);
            const bf16x8 pb = __builtin_bit_cast(bf16x8, w);
#pragma unroll
            for (int dt = 0; dt < 4; ++dt) { const LAS bf16* vp = VTl + (16 * dt + fr) * 200 + 32 * kk + 4 * fq;
                const u32x2 lo = *(const LAS u32x2*)vp, hi = *(const LAS u32x2*)(vp + 16);
                const u32x4 aw = (u32x4){lo.x, lo.y, hi.x, hi.y}; const bf16x8 a = __builtin_bit_cast(bf16x8, aw);
                o[dt] = MFMA16(a, pb, o[dt]); }
        }
        bf16* mp = mix + (size_t)(qrow0 + qi) * DM + 512 + head * 64 + 4 * fq;
#pragma unroll
        for (int dt = 0; dt < 4; ++dt) { const f32x4 v = o[dt] * inv; u32x2 w; w.x = pk2(v[0], v[1]); w.y = pk2(v[2], v[3]); *(u32x2*)(mp + 16 * dt) = w; }
    }
}
__device__ __forceinline__ void phase3(const Params& P, LAS unsigned char* lds, int tid, int wave, int lane) {
    const int G = gridDim.x, NR = G / 2, blk = blockIdx.x;
    if (blk < NR) {
#ifndef NO_RET
#ifdef PROBE_RETX2
        for (int rep = 0; rep < 2; ++rep)
#endif
        for (int it = blk; it < 256; it += NR) {
            const bool sample = it >= 128; const int bh = it & 127, b = bh >> 2, h = bh & 3;
            ret_item(P, lds, tid, wave, lane, h, sample ? MP + 64 * b : b * SEQ, sample ? 1 : 32, P.state_ret + (size_t)bh * 16384, sample, P.out + (sample ? OFF_SRET : OFF_PRET) + (size_t)bh * 16384);
        }
#endif
    } else {
#ifndef NO_ATT
        for (int it = blk - NR; it < 2112; it += G - NR) {
            const bool sample = it >= 2048;
            att_item(P, lds, tid, wave, lane, sample, sample ? (it - 2048) >> 1 : it >> 6, sample ? 2 : (it >> 1) & 31, it & 1);
        }
#endif
    }
}

__device__ __forceinline__ void unpack8(const u32x4 w, float (&f)[8]) { f[0] = bflo(w.x); f[1] = bfhi(w.x); f[2] = bflo(w.y); f[3] = bfhi(w.y); f[4] = bflo(w.z); f[5] = bfhi(w.z); f[6] = bflo(w.w); f[7] = bfhi(w.w); }
__device__ __forceinline__ void phase6(const Params& P, int tid) {
    const bf16* ua = (const bf16*)(P.ws + WS_R1); bf16* ub = (bf16*)(P.ws + WS_R2);
    constexpr int CH = DFF / 8;
    const int total = MT * CH;
    for (int idx = blockIdx.x * 512 + tid; idx < total; idx += gridDim.x * 512) {
        const int row = idx / CH, j = (idx - row * CH) * 8;
        const bool smp = row >= MP; const int t = smp ? ((row - MP) & 63) : (row & 2047);
        float a[8], p1[8], p2[8], bb[8];
        unpack8(*(const u32x4*)(ua + (size_t)row * DFF + j), a);
        unpack8(*(const u32x4*)(ub + (size_t)row * DFF + j), bb);
        if (t >= 1) unpack8(*(const u32x4*)(ua + (size_t)(row - 1) * DFF + j), p1);
        else if (smp) { const float* s = P.state_conv + ((size_t)((row - MP) >> 6) * 2 + 1) * DFF + j; const f32x4 x = *(const f32x4*)s, y = *(const f32x4*)(s + 4); p1[0] = x.x; p1[1] = x.y; p1[2] = x.z; p1[3] = x.w; p1[4] = y.x; p1[5] = y.y; p1[6] = y.z; p1[7] = y.w; }
        else {
#pragma unroll
            for (int e = 0; e < 8; ++e) p1[e] = 0.f; }
        if (t >= 2) unpack8(*(const u32x4*)(ua + (size_t)(row - 2) * DFF + j), p2);
        else if (smp) { const float* s = P.state_conv + ((size_t)((row - MP) >> 6) * 2 + t) * DFF + j; const f32x4 x = *(const f32x4*)s, y = *(const f32x4*)(s + 4); p2[0] = x.x; p2[1] = x.y; p2[2] = x.z; p2[3] = x.w; p2[4] = y.x; p2[5] = y.y; p2[6] = y.z; p2[7] = y.w; }
        else {
#pragma unroll
            for (int e = 0; e < 8; ++e) p2[e] = 0.f; }
        float r[8];
#pragma unroll
        for (int h = 0; h < 2; ++h) { const f32x4 w0 = *(const f32x4*)(P.conv_w + j + 4 * h), w1 = *(const f32x4*)(P.conv_w + DFF + j + 4 * h), w2 = *(const f32x4*)(P.conv_w + 2 * DFF + j + 4 * h), cb = *(const f32x4*)(P.conv_b + j + 4 * h);
#pragma unroll
            for (int e = 0; e < 4; ++e) { const float cv = cb[e] + w0[e] * p2[4 * h + e] + w1[e] * p1[4 * h + e] + w2[e] * a[4 * h + e]; r[4 * h + e] = silu_f(cv) * bb[4 * h + e]; } }
        u32x4 w; w.x = pk2(r[0], r[1]); w.y = pk2(r[2], r[3]); w.z = pk2(r[4], r[5]); w.w = pk2(r[6], r[7]);
        *(u32x4*)(ub + (size_t)row * DFF + j) = w;
    }
}
#ifdef CONV_FUSED
__device__ __forceinline__ void phase6c(const Params& P, int tid) {
    const float* headA = (const float*)(P.ws + WS_R1); const float* headB = headA + HT_STRIDE; const float* tailA = headA + 2 * HT_STRIDE;
    bf16* act = (bf16*)(P.ws + WS_R2);
    const int total = NGRP * DFF;
    for (int idx = blockIdx.x * 512 + tid; idx < total; idx += gridDim.x * 512) {
        const int g = idx / DFF, j = idx - g * DFF;
        float p0, p1;
        if (g < 1024) { if ((g & 31) == 0) { p0 = 0.f; p1 = 0.f; } else { p0 = tailA[((size_t)(g - 1) * 2) * DFF + j]; p1 = tailA[((size_t)(g - 1) * 2 + 1) * DFF + j]; } }
        else { p0 = P.state_conv[((size_t)(g - 1024) * 2) * DFF + j]; p1 = P.state_conv[((size_t)(g - 1024) * 2 + 1) * DFF + j]; }
        const float a0 = headA[((size_t)g * 2) * DFF + j], a1 = headA[((size_t)g * 2 + 1) * DFF + j];
        const float b0 = headB[((size_t)g * 2) * DFF + j], b1 = headB[((size_t)g * 2 + 1) * DFF + j];
        const float w0 = P.conv_w[j], w1 = P.conv_w[DFF + j], w2 = P.conv_w[2 * DFF + j], cb = P.conv_b[j];
        const float c0 = cb + w0 * p0 + w1 * p1 + w2 * a0, c1 = cb + w0 * p1 + w1 * a0 + w2 * a1;
        act[(size_t)(64 * g) * DFF + j] = (bf16)(pk2(silu_f(c0) * b0, 0.f) & 0xffffu);
        act[(size_t)(64 * g + 1) * DFF + j] = (bf16)(pk2(silu_f(c1) * b1, 0.f) & 0xffffu);
        const float t0 = tailA[((size_t)g * 2) * DFF + j], t1 = tailA[((size_t)g * 2 + 1) * DFF + j];
        if (g < 1024) { if ((g & 31) == 31) { P.out[OFF_PCONV + ((size_t)(g >> 5) * 2) * DFF + j] = t0; P.out[OFF_PCONV + ((size_t)(g >> 5) * 2 + 1) * DFF + j] = t1; } }
        else { P.out[OFF_SCONV + ((size_t)(g - 1024) * 2) * DFF + j] = t0; P.out[OFF_SCONV + ((size_t)(g - 1024) * 2 + 1) * DFF + j] = t1; }
    }
}
#endif
__device__ __forceinline__ void phase8(const Params& P, int wave, int lane) {
    const float* mod = (const float*)(P.ws + WS_MOD); const float* ss = (const float*)(P.ws + WS_SS2);
    const int gw = blockIdx.x * 8 + wave, NGW = gridDim.x * 8;
    for (int row = gw; row < MT; row += NGW) {
        const int bs = row < MP ? (row >> 11) : 32 + ((row - MP) >> 6);
        float* yr = P.out + (size_t)row * DM + 4 * lane;
        const float* mb = mod + (size_t)bs * 8192 + 6144 + 4 * lane;
        float q = lane < 16 ? ss[(size_t)row * 16 + lane] : 0.f;
        q = wave_sum(q);
        const float rstd = rsqrtf(q * (1.f / DM) + EPS);
#pragma unroll
        for (int j = 0; j < 4; ++j) { const f32x4 v = *(const f32x4*)(yr + 256 * j), sh = *(const f32x4*)(mb + 256 * j), sc = *(const f32x4*)(mb + 1024 + 256 * j), gn = *(const f32x4*)(P.normf + 4 * lane + 256 * j);
            *(f32x4*)(yr + 256 * j) = v * rstd * gn * (sc + 1.0f) + sh; }
    }
}

#ifndef N_LAUNCH
#define N_LAUNCH 1
#endif
#define LAUNDER_TID() int tid = threadIdx.x; asm volatile("" : "+v"(tid)); const int lane = tid & 63, wave = __builtin_amdgcn_readfirstlane(tid >> 6); (void)lane; (void)wave
template <int PHM>
__global__ void __launch_bounds__(512) fwd_mega(Params P) {
    extern __shared__ __attribute__((aligned(16))) unsigned char lds_raw[];
    LAS unsigned char* lds = (LAS unsigned char*)lds_raw;
    const int G = gridDim.x;
    unsigned char* ws = P.ws;
    volatile LAS unsigned* misc = (volatile LAS unsigned*)(lds + LDS_MISC);
    if (threadIdx.x < 2) misc[threadIdx.x] = 0u;
    __syncthreads();
    XcdBarrier bar; bar.bar = (unsigned*)(ws + WS_BAR); bar.x = 0; bar.st = misc;
#define GSYNC(a, b) do { if ((PHM & (a)) && (PHM & (b))) xcd_barrier(bar); } while (0)
    if constexpr ((PHM & 1) != 0) { LAUNDER_TID(); phase0(P, lds, wave, lane);
      if (blockIdx.x == 0) for (int i = tid; i < XCD_BAR_WORDS; i += 512) ((unsigned*)(ws + WS_BAR))[i] = 0u; }
    if constexpr ((PHM & 1) != 0 && (PHM & 2) != 0) {
      cg::this_grid().sync();
      bar = xcd_barrier_post((unsigned*)(ws + WS_BAR), misc); }
    if constexpr ((PHM & 2) != 0) { LAUNDER_TID(); phase1(P, lds, tid, wave, lane); }
    GSYNC(2, 4);
    if constexpr ((PHM & 4) != 0) {
      pg8::Gemm g{(const bf16*)(ws + WS_R0), (const bf16*)(ws + WS_WIN), MT, INW, DM};
      OrderX S; S.S.init(MT, INW, G, (int)blockIdx.x); S.nX = 22; S.xpm = NTM; S.xpn0 = 11;
      Epi1 E{(bf16*)(ws + WS_R1), (float*)(ws + WS_SHW), P.out};
      pg8::gemm_phase<Epi1, OrderX, true, true>(lds, g, S, E); }
    GSYNC(4, 8);
    if constexpr ((PHM & 8) != 0) { LAUNDER_TID(); phase3(P, lds, tid, wave, lane);
#ifdef PROBE_P3X2
      cg::this_grid().sync(); phase3(P, lds, tid, wave, lane);
#endif
    }
    GSYNC(8, 16);
    if constexpr ((PHM & 16) != 0) {
      pg8::Gemm g{(const bf16*)(ws + WS_R2), (const bf16*)(ws + WS_WOUT), MT, DM, DM};
      pg8::StaticOrder S; S.init(MT, DM, G, (int)blockIdx.x);
      Epi2 E{P.x_p, P.x_s, (const float*)(ws + WS_MOD), P.ln2, P.out, (bf16*)(ws + WS_R0), (float*)(ws + WS_SS1)};
      pg8::gemm_phase<Epi2, pg8::StaticOrder, true, true>(lds, g, S, E); }
    GSYNC(16, 32);
    if constexpr ((PHM & 32) != 0) {
      LAUNDER_TID();
      pg8::Gemm g{(const bf16*)(ws + WS_R0), (const bf16*)(ws + WS_WUP), MT, 2 * DFF, DM};
      pg8::StaticOrder S; S.init(MT, 2 * DFF, G, (int)blockIdx.x);
      LAS float* rtab = (LAS float*)(lds + 131072);
      { pg8::Unit u; const float* ss = (const float*)(ws + WS_SS1);
        for (int i = 0; S.next(i, u) && i < 24; ++i) if (tid < 256) { const f32x4* sp = (const f32x4*)(ss + (size_t)(u.pm * 256 + tid) * 16);
            const f32x4 q0 = sp[0], q1 = sp[1], q2 = sp[2], q3 = sp[3];
            const float tot = ((q0.x + q0.y) + (q0.z + q0.w)) + ((q1.x + q1.y) + (q1.z + q1.w)) + ((q2.x + q2.y) + (q2.z + q2.w)) + ((q3.x + q3.y) + (q3.z + q3.w));
            rtab[i * 256 + tid] = rsqrtf(tot * (1.f / DM) + EPS); }
        __syncthreads(); }
#ifdef CONV_FUSED
      float* hA = (float*)(ws + WS_R1);
      Epi3C E{rtab, (const float*)(ws + WS_SHW), P.conv_w, P.conv_b, (bf16*)(ws + WS_R2), hA, hA + HT_STRIDE, hA + 2 * HT_STRIDE};
      pg8::gemm_phase<Epi3C, pg8::StaticOrder, true, true>(lds, g, S, E);
#else
      Epi3 E{rtab, (const float*)(ws + WS_SHW), (bf16*)(ws + WS_R1), (bf16*)(ws + WS_R2), P.out};
      pg8::gemm_phase<Epi3, pg8::StaticOrder, true, true>(lds, g, S, E);
#endif
#ifdef PROBE_P5X2
      cg::this_grid().sync(); pg8::gemm_phase<Epi3, pg8::StaticOrder, true, true>(lds, g, S, E);
#endif
    }
    GSYNC(32, 64);
#ifdef CONV_FUSED
    if constexpr ((PHM & 64) != 0) { LAUNDER_TID(); phase6c(P, tid); }
#else
    if constexpr ((PHM & 64) != 0) { LAUNDER_TID(); phase6(P, tid); }
#endif
    GSYNC(64, 128);
    if constexpr ((PHM & 128) != 0) {
      pg8::Gemm g{(const bf16*)(ws + WS_R2), (const bf16*)(ws + WS_WDN), MT, DM, DFF};
      pg8::StaticOrder S; S.init(MT, DM, G, (int)blockIdx.x);
      Epi4 E{(const float*)(ws + WS_MOD), P.out, (float*)(ws + WS_SS2)};
      pg8::gemm_phase<Epi4, pg8::StaticOrder, true, true>(lds, g, S, E); }
    GSYNC(128, 256);
    if constexpr ((PHM & 256) != 0) { LAUNDER_TID(); phase8(P, wave, lane); }
}

template <int PHM> static bool launch_one(const Params& p, int grid, bool coop, hipStream_t stream) {
    static bool attr_done = false;
    if (!attr_done) { if (hipFuncSetAttribute((const void*)fwd_mega<PHM>, hipFuncAttributeMaxDynamicSharedMemorySize, LDS_BYTES) != hipSuccess) { fprintf(stderr, "kernel_launch: hipFuncSetAttribute failed\n"); return false; } attr_done = true; }
    hipError_t e;
    if (coop) { Params pc = p; void* args[] = {&pc}; e = hipLaunchCooperativeKernel((const void*)fwd_mega<PHM>, dim3(grid), dim3(512), args, LDS_BYTES, stream); }
    else { hipLaunchKernelGGL(fwd_mega<PHM>, dim3(grid), dim3(512), LDS_BYTES, stream, p); e = hipPeekAtLastError(); }
    if (e != hipSuccess) { fprintf(stderr, "launch (mask %d) failed: %s (grid %d)\n", PHM, hipGetErrorString(e), grid); return false; }
    return true;
}
extern "C" void kernel_launch(void* const* d_in, const int* in_sizes, int n_in, void* d_out, int out_size, void* d_ws, size_t ws_size, hipStream_t stream) {
    static int grid = 0;
    if (grid == 0) {
        if (n_in != 22 || (size_t)out_size != OUT_TOTAL || ws_size < WS_END) { fprintf(stderr, "kernel_launch: unexpected sizes n_in %d out %d ws %zu\n", n_in, out_size, ws_size); grid = -1; return; }
        int dev = 0, cus = 0;
        (void)hipGetDevice(&dev);
        (void)hipDeviceGetAttribute(&cus, hipDeviceAttributeMultiprocessorCount, dev);
        grid = cus;
        if (grid > 256) grid = 256;
        if (grid < 2) grid = -1;
    }
    if (grid < 0) return;
    Params p{};
    const float** pp = (const float**)&p;
    for (int i = 0; i < 22; ++i) pp[i] = (const float*)d_in[i];
    p.out = (float*)d_out; p.ws = (unsigned char*)d_ws;
#if N_LAUNCH == 1
    launch_one<511>(p, grid, true, stream);
#else
    launch_one<1>(p, grid, false, stream) && launch_one<2>(p, grid, false, stream) && launch_one<4>(p, grid, false, stream) && launch_one<8>(p, grid, false, stream) &&
    launch_one<16>(p, grid, false, stream) && launch_one<32>(p, grid, false, stream) && launch_one<64>(p, grid, false, stream) && launch_one<128>(p, grid, false, stream) && launch_one<256>(p, grid, false, stream);
#endif
}
```

```cpp
#define CONV_FUSED 1
#include <hip/hip_runtime.h>
#include <hip/hip_cooperative_groups.h>
#include <cstdio>
#include <cstdint>
namespace cg = cooperative_groups;
namespace pg8 {
#define PG8_LAS __attribute__((address_space(3)))
typedef unsigned short bf16_t;
typedef short bf16x8 __attribute__((ext_vector_type(8)));
typedef float f32x4 __attribute__((ext_vector_type(4)));
typedef unsigned u32x4 __attribute__((ext_vector_type(4)));
constexpr int BM = 256, BK = 64, HALF = 128, HTB = HALF * BK * 2  , STAGE_BYTES = 8 * HTB, NXCD = 8, WGM = 8;

__host__ __device__ __forceinline__ int lds_byte(int r, int c) { const int st = (r >> 4) * 2 + (c >> 5), rr = r & 15, cc = c & 31, ob = rr * 64 + cc * 2; return st * 1024 + (ob ^ (((ob >> 9) & 1) << 5)); }
__host__ __device__ __forceinline__ void stage_rc(int b, int& R, int& C) { const int st = b / 1024, sb = b % 1024, swz = sb ^ (((sb >> 9) & 1) << 5); R = (st >> 1) * 16 + swz / 64; C = (st & 1) * 32 + (swz % 64) / 2; }
__host__ __device__ __forceinline__ int perm32(int rho) { const int n = rho >> 4, i = rho & 15; return 8 * (i >> 2) + 4 * n + (i & 3); }

struct Unit { int pm, pn, seq; };
struct Gemm { const bf16_t* A; const bf16_t* Bt; int M, N, K; };

struct StaticOrder {
    int nM, nN, nwg, G, c;
    __host__ __device__ __forceinline__ void init(int M, int N, int G_, int c_) { nM = M / BM; nN = N / BM; nwg = nM * nN; G = G_; c = c_; }
    __host__ __device__ __forceinline__ bool next(int i, Unit& u) const {
        const long L = (long)i * G + c; if (L >= nwg) return false; u.seq = i; map(L, u); return true; }
    __host__ __device__ __forceinline__ void map(long L, Unit& u) const {
        int wgid = (int)L; { const int q = nwg / NXCD, r = nwg % NXCD, xcd = wgid % NXCD, off = wgid / NXCD; wgid = (xcd < r ? xcd * (q + 1) : r * (q + 1) + (xcd - r) * q) + off; }
        const int nig = WGM * nN, gid = wgid / nig, fm = gid * WGM, gsz = (nM - fm) < WGM ? (nM - fm) : WGM;
        u.pm = fm + ((wgid % nig) % gsz); u.pn = (wgid % nig) / gsz;
    }
    __device__ __forceinline__ void a_ready(const Unit&) const {}
    __device__ __forceinline__ void done(const Unit&) const {}
};

__device__ __forceinline__ unsigned cvt_pk_bf16(float lo, float hi) { unsigned r; asm volatile("v_cvt_pk_bf16_f32 %0, %1, %2" : "=v"(r) : "v"(lo), "v"(hi)); return r; }

template <class Epi, class Sched, bool ALIGN_EPI = false, bool SP2 = false>
__device__ __forceinline__ void gemm_phase(PG8_LAS unsigned char* lds, const Gemm g, const Sched& S, const Epi& E) {
    int tid_ = threadIdx.x; asm volatile("" : "+v"(tid_));
    const int tid = tid_, wid = __builtin_amdgcn_readfirstlane(tid >> 6), lane = tid & 63, wr = wid >> 2, wc = wid & 3, fr = lane & 15, fq = lane >> 4;
    const int K = g.K, nt = K / BK;
    unsigned voffA[2], voffB[2];
#pragma unroll
    for (int i = 0; i < 2; ++i) { int R, C; stage_rc(tid * 16 + i * 8192, R, C); const int Rb = Epi::PERM ? ((R & ~31) + perm32(R & 31)) : R;
        voffA[i] = (unsigned)(R * K + C) * 2u; voffB[i] = (unsigned)(Rb * K + C) * 2u; }
    const size_t kstep = (size_t)(BK * 2);
    const size_t hstep = (size_t)HALF * K * 2;
    const size_t tstep = 2 * hstep;
    const unsigned ldsw = (unsigned)wid * 1024u;
    const int aoff = lds_byte(wr * 64 + fr, fq * 8), boff = lds_byte(wc * 32 + fr, fq * 8);
#define PG8_SA(b, h) (((b) * 2 + (h)) * HTB)
#define PG8_SB(b, h) ((4 + (b) * 2 + (h)) * HTB)
#define PG8_STAGE(bufoff, gbase, voff) do { _Pragma("unroll") for (int _i = 0; _i < 2; ++_i) \
        __builtin_amdgcn_global_load_lds((const unsigned*)((const char*)(gbase) + (voff)[_i]), (PG8_LAS unsigned*)(lds + (bufoff) + ldsw + _i * 8192), 16, 0, 0); } while (0)
#define PG8_LDA(dst, b, h) do { _Pragma("unroll") for (int m = 0; m < 4; ++m) _Pragma("unroll") for (int k = 0; k < 2; ++k) dst[m][k] = *(const PG8_LAS bf16x8*)(lds + PG8_SA(b, h) + aoff + m * 2048 + k * 1024); } while (0)
#define PG8_LDB(dst, b, h) do { _Pragma("unroll") for (int n = 0; n < 2; ++n) _Pragma("unroll") for (int k = 0; k < 2; ++k) dst[n][k] = *(const PG8_LAS bf16x8*)(lds + PG8_SB(b, h) + boff + n * 2048 + k * 1024); } while (0)
#define PG8_MMA(ai, bj, At, Bt) do { __builtin_amdgcn_s_setprio(1); _Pragma("unroll") for (int m = 0; m < 4; ++m) _Pragma("unroll") for (int n = 0; n < 2; ++n) _Pragma("unroll") for (int k = 0; k < 2; ++k) \
        acc[ai][bj][m][n] = __builtin_amdgcn_mfma_f32_16x16x32_bf16(Bt[n][k], At[m][k], acc[ai][bj][m][n], 0, 0, 0); __builtin_amdgcn_s_setprio(0); } while (0)
#define PG8_WAIT_V(n) asm volatile("s_waitcnt vmcnt(" #n ")" ::: "memory")
#define PG8_WAIT_L(n) asm volatile("s_waitcnt lgkmcnt(" #n ")" ::: "memory")
#define PG8_BAR __builtin_amdgcn_s_barrier()
#define PG8_SCHED __builtin_amdgcn_sched_barrier(0)
    Unit cur, nxt; int ui = 0;
    if (!S.next(0, cur)) return;
    f32x4 acc[2][2][4][2];
#pragma unroll
    for (int a = 0; a < 2; ++a)
#pragma unroll
        for (int b = 0; b < 2; ++b)
#pragma unroll
            for (int m = 0; m < 4; ++m)
#pragma unroll
                for (int n = 0; n < 2; ++n) acc[a][b][m][n] = (f32x4){0.f, 0.f, 0.f, 0.f};
    bf16x8 At[4][2], B0[2][2], B1[2][2];
    const char* cA = (const char*)g.A + (size_t)cur.pm * tstep; const char* cB = (const char*)g.Bt + (size_t)cur.pn * tstep;
    S.a_ready(cur);
    if constexpr (SP2) {
        PG8_STAGE(PG8_SB(0, 0), cB, voffB); PG8_STAGE(PG8_SB(0, 1), cB + hstep, voffB); PG8_STAGE(PG8_SA(0, 0), cA, voffA); PG8_STAGE(PG8_SA(0, 1), cA + hstep, voffA);
        if (wr == 1) PG8_BAR;
        PG8_WAIT_V(2); PG8_BAR;
        PG8_STAGE(PG8_SB(1, 0), cB + kstep, voffB); PG8_STAGE(PG8_SA(1, 0), cA + kstep, voffA); PG8_STAGE(PG8_SB(1, 1), cB + hstep + kstep, voffB);
        PG8_WAIT_V(6); PG8_BAR;
    } else {
        PG8_STAGE(PG8_SB(0, 0), cB, voffB); PG8_STAGE(PG8_SA(0, 0), cA, voffA); PG8_STAGE(PG8_SB(0, 1), cB + hstep, voffB); PG8_STAGE(PG8_SA(0, 1), cA + hstep, voffA);
        if (wr == 1) PG8_BAR;
        PG8_WAIT_V(4); PG8_BAR;
        PG8_STAGE(PG8_SB(1, 0), cB + kstep, voffB); PG8_STAGE(PG8_SA(1, 0), cA + kstep, voffA); PG8_STAGE(PG8_SB(1, 1), cB + hstep + kstep, voffB);
        PG8_WAIT_V(6); PG8_BAR;
    }
    for (;;) {
        const bool has_next = S.next(ui + 1, nxt);
        const char* nA = has_next ? (const char*)g.A + (size_t)nxt.pm * tstep : cA; const char* nB = has_next ? (const char*)g.Bt + (size_t)nxt.pn * tstep : cB;
        for (int t = 0; t < nt; t += 2) {
            const bool last = (t == nt - 2);
            const char* a1 = cA + (size_t)(t + 1) * kstep;
            const char* a2 = last ? nA : cA + (size_t)(t + 2) * kstep; const char* b2 = last ? nB : cB + (size_t)(t + 2) * kstep;
            const char* a3 = a2 + kstep; const char* b3 = b2 + kstep;
            if (last && has_next) S.a_ready(nxt);
            if constexpr (SP2) {
            PG8_LDB(B0, 0, 0); PG8_LDB(B1, 0, 1); PG8_SCHED; PG8_LDA(At, 0, 0); PG8_STAGE(PG8_SA(1, 1), a1 + hstep, voffA);
            PG8_WAIT_V(8); PG8_WAIT_L(0); PG8_BAR; PG8_MMA(0, 0, At, B0); PG8_MMA(0, 1, At, B1); PG8_BAR; PG8_SCHED;
            PG8_LDA(At, 0, 1); PG8_STAGE(PG8_SB(0, 0), b2, voffB); PG8_STAGE(PG8_SB(0, 1), b2 + hstep, voffB); PG8_STAGE(PG8_SA(0, 0), a2, voffA);
            PG8_WAIT_V(8); PG8_WAIT_L(0); PG8_BAR; PG8_MMA(1, 0, At, B0); PG8_MMA(1, 1, At, B1); PG8_BAR; PG8_SCHED;
            PG8_LDB(B0, 1, 0); PG8_LDB(B1, 1, 1); PG8_SCHED; PG8_LDA(At, 1, 0); PG8_STAGE(PG8_SA(0, 1), a2 + hstep, voffA);
            PG8_WAIT_V(8); PG8_WAIT_L(0); PG8_BAR; PG8_MMA(0, 0, At, B0); PG8_MMA(0, 1, At, B1); PG8_BAR; PG8_SCHED;
            PG8_LDA(At, 1, 1); PG8_STAGE(PG8_SB(1, 0), b3, voffB); PG8_STAGE(PG8_SB(1, 1), b3 + hstep, voffB); PG8_STAGE(PG8_SA(1, 0), a3, voffA);
            PG8_WAIT_V(8); PG8_WAIT_L(0); PG8_BAR; PG8_MMA(1, 0, At, B0); PG8_MMA(1, 1, At, B1); PG8_BAR; PG8_SCHED;
            } else {
            PG8_LDB(B0, 0, 0); PG8_SCHED; PG8_LDA(At, 0, 0); PG8_STAGE(PG8_SA(1, 1), a1 + hstep, voffA);
            PG8_WAIT_L(8); PG8_BAR; PG8_WAIT_L(0); PG8_MMA(0, 0, At, B0); PG8_BAR; PG8_SCHED;
            PG8_LDB(B1, 0, 1); PG8_STAGE(PG8_SB(0, 0), b2, voffB);
            PG8_BAR; PG8_WAIT_L(0); PG8_MMA(0, 1, At, B1); PG8_BAR;
            PG8_LDA(At, 0, 1); PG8_STAGE(PG8_SA(0, 0), a2, voffA);
            PG8_BAR; PG8_WAIT_L(0); PG8_MMA(1, 0, At, B0); PG8_BAR; PG8_SCHED;
            PG8_STAGE(PG8_SB(0, 1), b2 + hstep, voffB);
            PG8_WAIT_V(6); PG8_BAR; PG8_MMA(1, 1, At, B1); PG8_BAR;
            PG8_LDB(B0, 1, 0); PG8_SCHED; PG8_LDA(At, 1, 0); PG8_STAGE(PG8_SA(0, 1), a2 + hstep, voffA);
            PG8_WAIT_L(8); PG8_BAR; PG8_WAIT_L(0); PG8_MMA(0, 0, At, B0); PG8_BAR; PG8_SCHED;
            PG8_LDB(B1, 1, 1); PG8_STAGE(PG8_SB(1, 0), b3, voffB);
            PG8_BAR; PG8_WAIT_L(0); PG8_MMA(0, 1, At, B1); PG8_BAR;
            PG8_LDA(At, 1, 1); PG8_STAGE(PG8_SA(1, 0), a3, voffA);
            PG8_BAR; PG8_WAIT_L(0); PG8_MMA(1, 0, At, B0); PG8_BAR; PG8_SCHED;
            PG8_STAGE(PG8_SB(1, 1), b3 + hstep, voffB);
            PG8_WAIT_V(6); PG8_BAR; PG8_MMA(1, 1, At, B1); PG8_BAR;
            }
        }
        if constexpr (ALIGN_EPI) { if (wr == 0) PG8_BAR; }
        if constexpr (!Epi::AFTER_DRAIN) { E(acc, cur, wr, wc, fr, fq); S.done(cur); }
        if (!has_next) break;
#pragma unroll
        for (int a = 0; a < 2; ++a)
#pragma unroll
            for (int b = 0; b < 2; ++b)
#pragma unroll
                for (int m = 0; m < 4; ++m)
#pragma unroll
                    for (int n = 0; n < 2; ++n) acc[a][b][m][n] = (f32x4){0.f, 0.f, 0.f, 0.f};
        cur = nxt; cA = nA; cB = nB; ++ui;
        if constexpr (ALIGN_EPI) { if (wr == 1) PG8_BAR; }
    }
    PG8_WAIT_V(0);
    if constexpr (!ALIGN_EPI) { if (wr == 0) PG8_BAR; }
    PG8_BAR;
    if constexpr (Epi::AFTER_DRAIN) { E.fused(acc, cur, wr, wc, fr, fq, lds, wid, lane); S.done(cur); }
#undef PG8_SA
#undef PG8_SB
#undef PG8_STAGE
#undef PG8_LDA
#undef PG8_LDB
#undef PG8_MMA
#undef PG8_WAIT_V
#undef PG8_WAIT_L
#undef PG8_BAR
#undef PG8_SCHED
}
}
constexpr int DM = 1024, SEQ = 2048, NB = 32, DECL = 64, DFF = 2816, INW = 2816;
constexpr int MP = NB * SEQ, MS = NB * DECL, MT = MP + MS;
constexpr int NGRP = MT / 64;
constexpr int NTM = MT / 256;
constexpr float EPS = 1e-6f;
constexpr size_t OFF_Y = 0;
constexpr size_t OFF_PRET = (size_t)MT * DM;
constexpr size_t OFF_PK = OFF_PRET + (size_t)NB * 4 * 128 * 128;
constexpr size_t OFF_PV = OFF_PK + (size_t)NB * 128 * 128;
constexpr size_t OFF_PCONV = OFF_PV + (size_t)NB * 128 * 128;
constexpr size_t OFF_SRET = OFF_PCONV + (size_t)NB * 2 * DFF;
constexpr size_t OFF_SK = OFF_SRET + (size_t)NB * 4 * 128 * 128;
constexpr size_t OFF_SV = OFF_SK + (size_t)NB * 64 * 128;
constexpr size_t OFF_SCONV = OFF_SV + (size_t)NB * 64 * 128;
constexpr size_t OUT_TOTAL = OFF_SCONV + (size_t)NB * 2 * DFF;
constexpr size_t MiB = 1u << 20;
constexpr size_t WS_WIN = 0;
constexpr size_t WS_WUP = WS_WIN + (size_t)INW * DM * 2;
constexpr size_t WS_WOUT = WS_WUP + (size_t)2 * DFF * DM * 2;
constexpr size_t WS_WDN = WS_WOUT + (size_t)DM * DM * 2;
constexpr size_t WS_MODP = 24 * MiB;
constexpr size_t WS_MOD = 32 * MiB;
constexpr size_t WS_SHW = 34 * MiB;
constexpr size_t WS_SS1 = 36 * MiB;
constexpr size_t WS_SS2 = 41 * MiB;
constexpr size_t WS_R0 = 48 * MiB;
constexpr size_t WS_R1 = WS_R0 + 133 * MiB;
constexpr size_t WS_R2 = WS_R1 + 363 * MiB;
constexpr size_t HT_STRIDE = (size_t)NGRP * 2 * DFF;
constexpr size_t WS_END = WS_R2 + 363 * MiB;
constexpr size_t WS_X1B = WS_R1 + 128 * MiB;
static_assert(3 * HT_STRIDE * 4 <= 128 * MiB && WS_X1B + (size_t)MT * DM * 2 <= WS_R2, "ws map");
static_assert(WS_WDN + (size_t)DM * DFF * 2 <= WS_MODP, "ws map");
static_assert((size_t)(MT + 256) * DM * 2 <= 133 * MiB && (size_t)MT * DFF * 2 <= 363 * MiB, "ws map");

constexpr size_t WS_BAR = 46 * MiB;
constexpr size_t WS_TICKET = 46 * MiB + 32768;
constexpr size_t WS_CNT7 = 46 * MiB + 65536;
constexpr int LDS_MISC = 155648;
constexpr int LDS_BYTES = 155648 + 64;

#define LAS __attribute__((address_space(3)))
typedef unsigned short bf16;
typedef float f32x4 __attribute__((ext_vector_type(4)));
typedef float f32x2 __attribute__((ext_vector_type(2)));
typedef short bf16x8 __attribute__((ext_vector_type(8)));
typedef unsigned u32x4 __attribute__((ext_vector_type(4)));
typedef unsigned u32x2 __attribute__((ext_vector_type(2)));
typedef __bf16 bf16x2_t __attribute__((ext_vector_type(2)));
#define LDS_WAIT() asm volatile("s_waitcnt lgkmcnt(0)" ::: "memory")

__device__ __forceinline__ unsigned pk2(float lo, float hi) { f32x2 v = {lo, hi}; bf16x2_t b = __builtin_convertvector(v, bf16x2_t); return __builtin_bit_cast(unsigned, b); }
__device__ __forceinline__ float bflo(unsigned w) { return __uint_as_float(w << 16); }
__device__ __forceinline__ float bfhi(unsigned w) { return __uint_as_float(w & 0xffff0000u); }
__device__ __forceinline__ float wave_sum(float v) {
#pragma unroll
    for (int o = 1; o < 64; o <<= 1) v += __shfl_xor(v, o);
    return v;
}
__device__ __forceinline__ float silu_f(float x) { return x * __builtin_amdgcn_rcpf(1.0f + __builtin_amdgcn_exp2f(-1.4426950408889634f * x)); }
__device__ __forceinline__ void unpack8(const u32x4 w, float (&f)[8]) { f[0] = bflo(w.x); f[1] = bfhi(w.x); f[2] = bflo(w.y); f[3] = bfhi(w.y); f[4] = bflo(w.z); f[5] = bfhi(w.z); f[6] = bflo(w.w); f[7] = bfhi(w.w); }
__device__ __forceinline__ int grp_bs(int g) { return g < 1024 ? (g >> 5) : 32 + (g - 1024); }

struct Params {
    const float *x_p, *x_s, *cache_k, *cache_v, *state_ret, *state_conv, *c_p, *c_s, *ln1, *ln2, *w_ada, *b_ada, *w_in, *w_out, *sinks, *w_up, *conv_w, *conv_b, *w_down, *normf, *w_ada_f, *b_ada_f;
    float* out; unsigned char* ws;
};

__device__ __forceinline__ void transpose_item(const float* W, int K, int N, bf16* WT, int dst_row0, int k0, int n0, LAS float* scr, int lane) {
#pragma unroll 8
    for (int i = 0; i < 32; ++i) { const int kk = 2 * i + (lane >> 5); scr[kk * 33 + (lane & 31)] = W[(size_t)(k0 + kk) * N + n0 + (lane & 31)]; }
    LDS_WAIT(); asm volatile("" ::: "memory");
    const int c = lane & 7;
#pragma unroll
    for (int j = 0; j < 4; ++j) { const int n = (lane >> 3) + 8 * j; const LAS float* s = scr + (8 * c) * 33 + n;
        u32x4 o; o.x = pk2(s[0 * 33], s[1 * 33]); o.y = pk2(s[2 * 33], s[3 * 33]); o.z = pk2(s[4 * 33], s[5 * 33]); o.w = pk2(s[6 * 33], s[7 * 33]);
        *(u32x4*)(WT + (size_t)(dst_row0 + n) * K + k0 + 8 * c) = o; }
    LDS_WAIT(); asm volatile("" ::: "memory");
}
__device__ __forceinline__ void mod_item(const Params& P, int it, LAS float* scr, int lane) {
    const int ct = it >> 2, ks = it & 3, c0 = ct * 64;
    const float* W; const float* bias; int ldw;
    if (c0 < 6144) { W = P.w_ada + c0; bias = P.b_ada + c0; ldw = 6144; } else { W = P.w_ada_f + (c0 - 6144); bias = P.b_ada_f + (c0 - 6144); ldw = 2048; }
    float acc[64];
#pragma unroll
    for (int r = 0; r < 64; ++r) acc[r] = 0.f;
    const float* crow = (lane < 32 ? P.c_p + (size_t)lane * DM : P.c_s + (size_t)(lane - 32) * DM) + ks * 256;
    for (int kc = 0; kc < 8; ++kc) {
#pragma unroll
        for (int q = 0; q < 8; ++q) { f32x4 v = *(const f32x4*)(crow + kc * 32 + 4 * q);
            v.x = silu_f(v.x); v.y = silu_f(v.y); v.z = silu_f(v.z); v.w = silu_f(v.w);
            *(LAS f32x4*)(scr + lane * 36 + 4 * q) = v; }
        LDS_WAIT(); asm volatile("" ::: "memory");
        const float* wk = W + (size_t)(ks * 256 + kc * 32) * ldw + lane;
        for (int k4 = 0; k4 < 8; ++k4) {
            const float w0 = wk[(size_t)(4 * k4 + 0) * ldw], w1 = wk[(size_t)(4 * k4 + 1) * ldw], w2 = wk[(size_t)(4 * k4 + 2) * ldw], w3 = wk[(size_t)(4 * k4 + 3) * ldw];
#pragma unroll
            for (int r = 0; r < 64; ++r) { const f32x4 s = *(const LAS f32x4*)(scr + r * 36 + 4 * k4); acc[r] += (s.x * w0 + s.y * w1) + (s.z * w2 + s.w * w3); }
        }
        LDS_WAIT(); asm volatile("" ::: "memory");
    }
    float* dst = (float*)(P.ws + WS_MODP) + (size_t)ks * 64 * 8192 + c0 + lane;
    const float bv = (ks == 0) ? bias[lane] : 0.f;
#pragma unroll
    for (int r = 0; r < 64; ++r) dst[(size_t)r * 8192] = acc[r] + bv;
}
__device__ __forceinline__ void phase0(const Params& P, LAS unsigned char* lds, int wave, int lane) {
    LAS float* scr = (LAS float*)(lds + wave * 16384);
    const int gw = blockIdx.x * 8 + wave, NGW = gridDim.x * 8;
    constexpr int I_MOD = 512, I_IN = 16 * 88, I_UP = 16 * 176, I_OUT = 16 * 32, I_DN = 44 * 32;
    constexpr int NIT = I_MOD + I_IN + I_UP + I_OUT + I_DN;
    for (int it = gw; it < NIT; it += NGW) {
        int r = it;
        if (r < I_MOD) { mod_item(P, r, scr, lane); continue; } r -= I_MOD;
        if (r < I_IN) { const int kb = r / 88, nb = r % 88; transpose_item(P.w_in, DM, INW, (bf16*)(P.ws + WS_WIN), nb * 32, kb * 64, nb * 32, scr, lane); continue; } r -= I_IN;
        if (r < I_UP) { const int kb = r / 176, nb = r % 176, n0 = nb * 32, isb = n0 >= DFF, j0 = n0 - isb * DFF;
            transpose_item(P.w_up, DM, 2 * DFF, (bf16*)(P.ws + WS_WUP), 256 * (j0 >> 7) + 128 * isb + (j0 & 127), kb * 64, n0, scr, lane); continue; } r -= I_UP;
        if (r < I_OUT) { const int kb = r / 32, nb = r % 32; transpose_item(P.w_out, DM, DM, (bf16*)(P.ws + WS_WOUT), nb * 32, kb * 64, nb * 32, scr, lane); continue; } r -= I_OUT;
        { const int kb = r / 32, nb = r % 32; transpose_item(P.w_down, DFF, DM, (bf16*)(P.ws + WS_WDN), nb * 32, kb * 64, nb * 32, scr, lane); }
    }
}

__device__ __forceinline__ void phase1(const Params& P, LAS unsigned char* lds, int tid, int wave, int lane) {
    const float* modp = (const float*)(P.ws + WS_MODP);
    float* mod = (float*)(P.ws + WS_MOD);
    bf16* H1 = (bf16*)(P.ws + WS_R0);
    for (int idx = blockIdx.x * 512 + tid; idx < 64 * 8192; idx += gridDim.x * 512) {
        const float s = (modp[idx] + modp[idx + 524288]) + (modp[idx + 2 * 524288] + modp[idx + 3 * 524288]);
        mod[idx] = s;
        const int col = idx & 8191, bs = idx >> 13;
        if (col >= 3072 && col < 4096) H1[(size_t)(MT + bs) * DM + (col - 3072)] = (bf16)(pk2(s, 0.f) & 0xffffu);
    }
    LAS float* lv = (LAS float*)lds;
    for (int g = blockIdx.x; g < NGRP; g += gridDim.x) {
        const int bs = grp_bs(g);
        __syncthreads();
        for (int i = tid; i < 2048; i += 512) { const int which = i >> 10, col = i & 1023; const size_t o = (size_t)bs * 8192 + which * 1024 + col;
            float s = (modp[o] + modp[o + 524288]) + (modp[o + 2 * 524288] + modp[o + 3 * 524288]);
            if (which) s = P.ln1[col] * (1.f + s);
            lv[i] = s; }
        __syncthreads();
#pragma unroll 2
        for (int i = 0; i < 8; ++i) {
            const int row = g * 64 + wave * 8 + i;
            const float* xr = (row < MP ? P.x_p + (size_t)row * DM : P.x_s + (size_t)(row - MP) * DM) + 4 * lane;
            f32x4 v[4]; float ss = 0.f;
#pragma unroll
            for (int j = 0; j < 4; ++j) { v[j] = *(const f32x4*)(xr + 256 * j); ss += (v[j].x * v[j].x + v[j].y * v[j].y) + (v[j].z * v[j].z + v[j].w * v[j].w); }
            const float rstd = rsqrtf(wave_sum(ss) * (1.f / DM) + EPS);
            bf16* hr = H1 + (size_t)row * DM + 4 * lane;
#pragma unroll
            for (int j = 0; j < 4; ++j) { const f32x4 sh = *(const LAS f32x4*)(lv + 256 * j + 4 * lane), gs = *(const LAS f32x4*)(lv + 1024 + 256 * j + 4 * lane);
                const f32x4 h = v[j] * rstd * gs + sh; u32x2 w; w.x = pk2(h.x, h.y); w.y = pk2(h.z, h.w); *(u32x2*)(hr + 256 * j) = w; }
        }
    }
}

struct OrderX {
    pg8::StaticOrder S; int nX, xpm, xpn0;
    __device__ __forceinline__ bool next(int i, pg8::Unit& u) const {
        const long L = (long)i * S.G + S.c;
        int pm = 0, pn = 0; bool ok = false;
        if (L < S.nwg) { pg8::Unit t; t.pm = 0; t.pn = 0; t.seq = 0; (void)S.next(i, t); pm = t.pm; pn = t.pn; ok = true; }
        else if (L < S.nwg + nX) { pm = xpm; pn = xpn0 + (int)(L - S.nwg); ok = true; }
        u.pm = pm; u.pn = pn; u.seq = i;
        return ok;
    }
    __device__ __forceinline__ void a_ready(const pg8::Unit&) const {}
    __device__ __forceinline__ void done(const pg8::Unit&) const {}
};
struct OrderPub : pg8::StaticOrder {
    unsigned* cnt;
    __device__ __forceinline__ void done(const pg8::Unit& u) const {
        asm volatile("s_waitcnt vmcnt(0)" ::: "memory");
        if ((threadIdx.x & 63) == 0) __hip_atomic_fetch_add(cnt + 64 * u.pm, 1u, __ATOMIC_RELAXED, __HIP_MEMORY_SCOPE_AGENT);
    }
};
typedef const f32x4 (&AccRef)[2][2][4][2];
struct Epi1 {
    static constexpr bool PERM = true, AFTER_DRAIN = false;
    bf16* proj; float* shw; float* out;
    __device__ __forceinline__ void operator()(AccRef acc, const pg8::Unit& u, int wr, int wc, int fr, int fq) const {
        if (u.pm == NTM) {
            if (wr == 0) {
#pragma unroll
                for (int m = 0; m < 4; ++m) { float* d = shw + (size_t)(16 * m + fr) * (2 * DFF) + 256 * (u.pn - 11) + 32 * wc + 8 * fq;
#pragma unroll
                    for (int bj = 0; bj < 2; ++bj)
#pragma unroll
                        for (int n = 0; n < 2; ++n) *(f32x4*)(d + 128 * bj + 4 * n) = acc[0][bj][m][n]; }
            }
            return;
        }
        const unsigned row0 = u.pm * 256 + wr * 64 + fr, col0 = u.pn * 256 + wc * 32 + 8 * fq;
#pragma unroll
        for (int ai = 0; ai < 2; ++ai)
#pragma unroll
            for (int m = 0; m < 4; ++m) { const unsigned o = (row0 + 128 * ai + 16 * m) * (unsigned)INW + col0;
#pragma unroll
                for (int bj = 0; bj < 2; ++bj) { const f32x4 v0 = acc[ai][bj][m][0], v1 = acc[ai][bj][m][1];
                    u32x4 w; w.x = pk2(v0[0], v0[1]); w.y = pk2(v0[2], v0[3]); w.z = pk2(v1[0], v1[1]); w.w = pk2(v1[2], v1[3]);
                    *(u32x4*)(proj + (o + 128 * bj)) = w; }
                asm volatile("" ::: "memory"); }
        if (u.pn == 10) {
            const unsigned c = 32 * wc + 8 * fq;
#pragma unroll
            for (int ai = 0; ai < 2; ++ai)
#pragma unroll
                for (int m = 0; m < 4; ++m) { const unsigned row = row0 + 128 * ai + 16 * m; unsigned ok, ov;
                    if (row < (unsigned)MP) { const unsigned t = row & 2047; if (t < SEQ - 128) continue; const unsigned o = ((row >> 11) * 128 + (t - (SEQ - 128))) * 128 + c; ok = (unsigned)OFF_PK + o; ov = (unsigned)OFF_PV + o; }
                    else { const unsigned o = (row - MP) * 128 + c; ok = (unsigned)OFF_SK + o; ov = (unsigned)OFF_SV + o; }
                    *(f32x4*)(out + ok) = acc[ai][0][m][0]; *(f32x4*)(out + ok + 4) = acc[ai][0][m][1];
                    *(f32x4*)(out + ov) = acc[ai][1][m][0]; *(f32x4*)(out + ov + 4) = acc[ai][1][m][1];
                    asm volatile("" ::: "memory"); }
        }
    }
};
struct Epi2 {
    static constexpr bool PERM = true, AFTER_DRAIN = false;
    const float *xp, *xs, *mod, *ln2; bf16* x1; bf16* a2; float* ss;
    __device__ __forceinline__ void operator()(AccRef acc, const pg8::Unit& u, int wr, int wc, int fr, int fq) const {
        const int col0 = u.pn * 256 + wc * 32 + 8 * fq;
#pragma unroll
        for (int ai = 0; ai < 2; ++ai) {
            const int bs = grp_bs(4 * u.pm + 2 * ai + wr);
            const float* mb = mod + (size_t)bs * 8192;
            f32x4 g1v[2][2], gsv[2][2];
#pragma unroll
            for (int bj = 0; bj < 2; ++bj)
#pragma unroll
                for (int n = 0; n < 2; ++n) { const int c = col0 + 128 * bj + 4 * n; g1v[bj][n] = *(const f32x4*)(mb + 2048 + c);
                    gsv[bj][n] = *(const f32x4*)(ln2 + c) * (*(const f32x4*)(mb + 4096 + c) + 1.0f); }
#pragma unroll
            for (int m = 0; m < 4; ++m) {
                const int row = u.pm * 256 + 128 * ai + 64 * wr + 16 * m + fr;
                const float* xr = row < MP ? xp + (size_t)row * DM : xs + (size_t)(row - MP) * DM;
                float s = 0.f;
#pragma unroll
                for (int bj = 0; bj < 2; ++bj) { f32x4 a[2]; f32x4 xb[2];
#pragma unroll
                    for (int n = 0; n < 2; ++n) { const int c = col0 + 128 * bj + 4 * n; const f32x4 xv = *(const f32x4*)(xr + c); const f32x4 v = xv + g1v[bj][n] * acc[ai][bj][m][n];
                        xb[n] = v; s += (v.x * v.x + v.y * v.y) + (v.z * v.z + v.w * v.w); a[n] = v * gsv[bj][n]; }
                    u32x4 w; w.x = pk2(a[0].x, a[0].y); w.y = pk2(a[0].z, a[0].w); w.z = pk2(a[1].x, a[1].y); w.w = pk2(a[1].z, a[1].w);
                    *(u32x4*)(a2 + (size_t)row * DM + col0 + 128 * bj) = w;
                    w.x = pk2(xb[0].x, xb[0].y); w.y = pk2(xb[0].z, xb[0].w); w.z = pk2(xb[1].x, xb[1].y); w.w = pk2(xb[1].z, xb[1].w);
                    *(u32x4*)(x1 + (size_t)row * DM + col0 + 128 * bj) = w; }
                s += __shfl_xor(s, 16); s += __shfl_xor(s, 32);
                if (fq == 0) ss[(size_t)row * 16 + 4 * u.pn + wc] = s;
            }
        }
    }
};
struct Epi3 {
    static constexpr bool PERM = true, AFTER_DRAIN = false;
    const LAS float* rtab; const float* shw; bf16 *ua, *ub; float* out;
    __device__ __forceinline__ void operator()(AccRef acc, const pg8::Unit& u, int wr, int wc, int fr, int fq) const {
        const unsigned j0 = u.pn * 128 + wc * 32 + 8 * fq, pc0 = u.pn * 256 + wc * 32 + 8 * fq;
#pragma unroll
        for (int ai = 0; ai < 2; ++ai) {
            const unsigned grp = 4 * u.pm + 2 * ai + wr, bs = grp_bs((int)grp);
            const unsigned so = bs * (2 * DFF) + pc0;
            const f32x4 sa0 = *(const f32x4*)(shw + so), sa1 = *(const f32x4*)(shw + so + 4), sb0 = *(const f32x4*)(shw + so + 128), sb1 = *(const f32x4*)(shw + so + 132);
#pragma unroll
            for (int m = 0; m < 4; ++m) {
                const float rstd = rtab[u.seq * 256 + 128 * ai + 64 * wr + 16 * m + fr];
                const unsigned row = grp * 64 + 16 * m + fr;
                const f32x4 a0 = acc[ai][0][m][0] * rstd + sa0, a1 = acc[ai][0][m][1] * rstd + sa1, b0 = acc[ai][1][m][0] * rstd + sb0, b1 = acc[ai][1][m][1] * rstd + sb1;
                u32x4 w; w.x = pk2(a0[0], a0[1]); w.y = pk2(a0[2], a0[3]); w.z = pk2(a1[0], a1[1]); w.w = pk2(a1[2], a1[3]);
                *(u32x4*)(ua + (row * (unsigned)DFF + j0)) = w;
                w.x = pk2(b0[0], b0[1]); w.y = pk2(b0[2], b0[3]); w.z = pk2(b1[0], b1[1]); w.w = pk2(b1[2], b1[3]);
                *(u32x4*)(ub + (row * (unsigned)DFF + j0)) = w;
                if (m == 3 && fr >= 14) {
                    if (grp >= 1024) { float* d = out + OFF_SCONV + ((size_t)(grp - 1024) * 2 + (fr - 14)) * DFF + j0; *(f32x4*)d = a0; *(f32x4*)(d + 4) = a1; }
                    else if ((grp & 31) == 31) { float* d = out + OFF_PCONV + ((size_t)(grp >> 5) * 2 + (fr - 14)) * DFF + j0; *(f32x4*)d = a0; *(f32x4*)(d + 4) = a1; }
                }
            }
        }
    }
};
#ifdef CONV_FUSED
struct Epi3C {
    static constexpr bool PERM = true, AFTER_DRAIN = false;
    const LAS float* rtab; const float *shw, *cw, *cb; bf16* act; float *headA, *headB, *tailA;
    __device__ __forceinline__ void operator()(AccRef acc, const pg8::Unit& u, int wr, int wc, int fr, int fq) const {
        const unsigned j0 = u.pn * 128 + wc * 32 + 8 * fq, pc0 = u.pn * 256 + wc * 32 + 8 * fq;
        f32x4 w0[2], w1[2], w2[2], cbv[2];
#pragma unroll
        for (int n = 0; n < 2; ++n) { w0[n] = *(const f32x4*)(cw + j0 + 4 * n); w1[n] = *(const f32x4*)(cw + DFF + j0 + 4 * n); w2[n] = *(const f32x4*)(cw + 2 * DFF + j0 + 4 * n); cbv[n] = *(const f32x4*)(cb + j0 + 4 * n); }
#pragma unroll
        for (int ai = 0; ai < 2; ++ai) {
            asm volatile("" ::: "memory");
            const unsigned grp = 4 * u.pm + 2 * ai + wr, bs = grp_bs((int)grp);
            const unsigned so = bs * (2 * DFF) + pc0, ho = (grp * 2 + (fr & 1)) * DFF + j0;
            u32x2 ap[4][2], bp[4][2];
            {
                f32x4 sa[2], sb[2];
#pragma unroll
                for (int n = 0; n < 2; ++n) { sa[n] = *(const f32x4*)(shw + so + 4 * n); sb[n] = *(const f32x4*)(shw + so + 128 + 4 * n); }
#pragma unroll
                for (int m = 0; m < 4; ++m) {
                    const float rs = rtab[u.seq * 256 + 128 * ai + 64 * wr + 16 * m + fr];
#pragma unroll
                    for (int n = 0; n < 2; ++n) {
                        const f32x4 av = acc[ai][0][m][n] * rs + sa[n], bv = acc[ai][1][m][n] * rs + sb[n];
                        if (m == 0) { if (fr < 2) { *(f32x4*)(headA + ho + 4 * n) = av; *(f32x4*)(headB + ho + 4 * n) = bv; } }
                        if (m == 3) { if (fr >= 14) *(f32x4*)(tailA + ho + 4 * n) = av; }
                        ap[m][n].x = pk2(av.x, av.y); ap[m][n].y = pk2(av.z, av.w); bp[m][n].x = pk2(bv.x, bv.y); bp[m][n].y = pk2(bv.z, bv.w);
                    }
                }
            }
            asm volatile("" ::: "memory");
#pragma unroll
            for (int n = 0; n < 2; ++n)
#pragma unroll
                for (int h = 0; h < 2; ++h) {
                    unsigned q1 = 0u, q2 = 0u;
#pragma unroll
                    for (int m = 0; m < 4; ++m) {
                        const unsigned a = ap[m][n][h];
                        const unsigned s1 = (unsigned)__builtin_amdgcn_update_dpp((int)a, (int)a, 0x121, 0xf, 0xf, false);
                        const unsigned s2 = (unsigned)__builtin_amdgcn_update_dpp((int)a, (int)a, 0x122, 0xf, 0xf, false);
                        const unsigned pr1 = fr >= 1 ? s1 : q1, pr2 = fr >= 2 ? s2 : q2;
                        q1 = s1; q2 = s2;
                        const float c0 = cbv[n][2 * h] + w0[n][2 * h] * bflo(pr2) + w1[n][2 * h] * bflo(pr1) + w2[n][2 * h] * bflo(a);
                        const float c1 = cbv[n][2 * h + 1] + w0[n][2 * h + 1] * bfhi(pr2) + w1[n][2 * h + 1] * bfhi(pr1) + w2[n][2 * h + 1] * bfhi(a);
                        const unsigned bw = bp[m][n][h];
                        bp[m][n][h] = pk2(silu_f(c0) * bflo(bw), silu_f(c1) * bfhi(bw));
                    }
                    __builtin_amdgcn_sched_barrier(0);
                }
            asm volatile("" ::: "memory");
#pragma unroll
            for (int m = 0; m < 4; ++m) {
                if (m == 0 && fr < 2) continue;
                const unsigned row = grp * 64 + 16 * m + fr;
                const u32x4 w = (u32x4){bp[m][0].x, bp[m][0].y, bp[m][1].x, bp[m][1].y};
                *(u32x4*)(act + (row * (unsigned)DFF + j0)) = w;
            }
        }
    }
};
#endif
struct Epi4 {
    static constexpr bool PERM = true, AFTER_DRAIN = false;
    const float* mod; const bf16* x1; bf16* x2;
    __device__ __forceinline__ void operator()(AccRef acc, const pg8::Unit& u, int wr, int wc, int fr, int fq) const {
        const int col0 = u.pn * 256 + wc * 32 + 8 * fq;
#pragma unroll
        for (int ai = 0; ai < 2; ++ai) {
            const int bs = grp_bs(4 * u.pm + 2 * ai + wr);
            const float* mb = mod + (size_t)bs * 8192 + 5120;
            f32x4 g2v[2][2];
#pragma unroll
            for (int bj = 0; bj < 2; ++bj)
#pragma unroll
                for (int n = 0; n < 2; ++n) g2v[bj][n] = *(const f32x4*)(mb + col0 + 128 * bj + 4 * n);
#pragma unroll
            for (int m = 0; m < 4; ++m) {
                const unsigned ro = (unsigned)(u.pm * 256 + 128 * ai + 64 * wr + 16 * m + fr) * DM + col0;
#pragma unroll
                for (int bj = 0; bj < 2; ++bj) { const u32x4 xw = *(const u32x4*)(x1 + ro + 128 * bj);
                    const f32x4 v0 = (f32x4){bflo(xw.x), bfhi(xw.x), bflo(xw.y), bfhi(xw.y)} + g2v[bj][0] * acc[ai][bj][m][0];
                    const f32x4 v1 = (f32x4){bflo(xw.z), bfhi(xw.z), bflo(xw.w), bfhi(xw.w)} + g2v[bj][1] * acc[ai][bj][m][1];
                    u32x4 w; w.x = pk2(v0.x, v0.y); w.y = pk2(v0.z, v0.w); w.z = pk2(v1.x, v1.y); w.w = pk2(v1.z, v1.w);
                    *(u32x4*)(x2 + ro + 128 * bj) = w; }
            }
        }
    }
};
#define GAS __attribute__((address_space(1)))
#define RLX_AGENT __ATOMIC_RELAXED, __HIP_MEMORY_SCOPE_AGENT
#define XB_TMO      128
#define XB_XCNT(j)  (256  + 64 * (j))
#define XB_XSUB(j)  (1280 + 64 * (j))
#define XB_XGEN(j)  (2304 + 64 * (j))
#define XB_TOP      3328
#define XB_TOPGEN   3392
#define XCD_BAR_WORDS 3456
#define XB_SPIN_CAP (1u << 18)

__device__ __forceinline__ unsigned xb_ld(unsigned* p)              { return __hip_atomic_load(p, __ATOMIC_RELAXED, __HIP_MEMORY_SCOPE_AGENT); }
__device__ __forceinline__ unsigned xb_add(unsigned* p, unsigned v) { return __hip_atomic_fetch_add(p, v, __ATOMIC_RELAXED, __HIP_MEMORY_SCOPE_AGENT); }
__device__ __forceinline__ unsigned xb_xcc_id() { return (unsigned)__builtin_amdgcn_s_getreg((3 << 11) | 20) & 0xFu; }
#define XB_SPIN(cond, bar) do { unsigned _sp = 0; while (cond) { __builtin_amdgcn_s_sleep(1); \
    if ((++_sp & 255u) == 0u) { if (xb_ld(&(bar)[XB_TMO])) break; if (_sp > XB_SPIN_CAP) { atomicAdd(&(bar)[XB_TMO], 1u); break; } } } } while (0)

struct XcdBarrier {
    unsigned* bar; unsigned x;
    volatile LAS unsigned* st;
};

__device__ __forceinline__ XcdBarrier xcd_barrier_post(unsigned* bar, volatile LAS unsigned* st) {
    XcdBarrier b; b.bar = bar; b.x = xb_xcc_id(); b.st = st;
    if (threadIdx.x == 0) (void)xb_add(&bar[XB_XCNT(b.x)], 1u);
    return b;
}
__device__ __forceinline__ void xcd_barrier_complete(unsigned* bar, unsigned x, unsigned& nloc, unsigned& nx) {
    const unsigned G = gridDim.x * gridDim.y * gridDim.z;
    unsigned sum, cnt, mine, sp = 0u;
    for (;;) {
        sum = 0u; cnt = 0u; mine = 0u;
#pragma unroll
        for (unsigned j = 0; j < 16; ++j) { const unsigned c = xb_ld(&bar[XB_XCNT(j)]); sum += c; cnt += (c > 0u) ? 1u : 0u; mine = (j == x) ? c : mine; }
        if (sum == G) break;
        __builtin_amdgcn_s_sleep(1);
        if ((++sp & 255u) == 0u) { if (xb_ld(&bar[XB_TMO])) break; if (sp > XB_SPIN_CAP) { atomicAdd(&bar[XB_TMO], 1u); break; } }
    }
    nloc = mine > 0u ? mine : 1u; nx = cnt > 0u ? cnt : 1u;
}

__device__ __forceinline__ void xcd_barrier(const XcdBarrier& b) {
    asm volatile("s_waitcnt vmcnt(0)" ::: "memory");
    __syncthreads();
    if (threadIdx.x == 0) {
        unsigned* bar = b.bar;
        __builtin_amdgcn_s_waitcnt(0);
        unsigned nloc = b.st[0], nx = b.st[1];
        if (nloc == 0u) { xcd_barrier_complete(bar, b.x, nloc, nx); b.st[0] = nloc; b.st[1] = nx; }
        const unsigned old = xb_add(&bar[XB_XSUB(b.x)], 1u);
        const unsigned gen = old / nloc;
        if (old + 1u == (gen + 1u) * nloc) {
            __builtin_amdgcn_fence(__ATOMIC_RELEASE, "agent");
            asm volatile("s_waitcnt vmcnt(0)" ::: "memory");
            const unsigned og = xb_add(&bar[XB_TOP], 1u);
            const unsigned tg = og / nx;
            if (og + 1u == (tg + 1u) * nx) xb_add(&bar[XB_TOPGEN], 1u);
            else XB_SPIN(xb_ld(&bar[XB_TOPGEN]) == tg, bar);
            __builtin_amdgcn_fence(__ATOMIC_ACQUIRE, "agent");
            xb_add(&bar[XB_XGEN(b.x)], 1u);
            asm volatile("s_waitcnt vmcnt(0)" ::: "memory");
        } else {
            XB_SPIN(xb_ld(&bar[XB_XGEN(b.x)]) == gen, bar);
            __builtin_amdgcn_fence(__ATOMIC_ACQUIRE, "agent");
            asm volatile("s_waitcnt vmcnt(0)" ::: "memory");
        }
    }
    __syncthreads();
}
#define MFMA16(a, b, c) __builtin_amdgcn_mfma_f32_16x16x32_bf16((a), (b), (c), 0, 0, 0)
constexpr int RQ = 0, RK = 17408, RKT = 34816, RVT = 53248, RP = 71680, RST = 80896, RO = 115712;
__device__ __forceinline__ void ret_item(const Params& P, LAS unsigned char* lds, int tid, int wave, int lane, int h, int row0, int nchunks, const float* st_in, bool has_in, float* st_out) {
    const bf16* proj = (const bf16*)(P.ws + WS_R1);
    bf16* mix = (bf16*)(P.ws + WS_R2);
    const int fr = lane & 15, fq = lane >> 4;
    const float lg2 = log2f(1.0f - exp2f(-5.0f - (float)h));
    const float kscale = 0.08838834764831845f;
    LAS bf16* Qs = (LAS bf16*)(lds + RQ); LAS bf16* Ks = (LAS bf16*)(lds + RK); LAS bf16* KT = (LAS bf16*)(lds + RKT); LAS bf16* VT = (LAS bf16*)(lds + RVT);
    LAS bf16* Ps = (LAS bf16*)(lds + RP); LAS bf16* ST = (LAS bf16*)(lds + RST); LAS float* Os = (LAS float*)(lds + RO);
    f32x4 st[8];
#pragma unroll
    for (int et = 0; et < 8; ++et) {
        f32x4 v;
#pragma unroll
        for (int r = 0; r < 4; ++r) v[r] = st_in[(size_t)(16 * wave + 4 * fq + r) * 128 + 16 * et + fr];
        asm volatile("" : "+v"(v));
#pragma unroll
        for (int r = 0; r < 4; ++r) v[r] = has_in ? v[r] : 0.f;
        st[et] = v;
    }
    __syncthreads();
#pragma unroll
    for (int et = 0; et < 8; ++et) { u32x2 w; w.x = pk2(st[et][0], st[et][1]); w.y = pk2(st[et][2], st[et][3]); *(LAS u32x2*)(ST + (16 * et + fr) * 136 + 16 * wave + 4 * fq) = w; }
    const size_t goff = (size_t)lane * INW + h * 128 + wave * 16;
    u32x4 pq[2], pk[2], pv[2];
    { const bf16* g = proj + (size_t)row0 * INW + goff;
      pq[0] = *(const u32x4*)(g); pq[1] = *(const u32x4*)(g + 8); pk[0] = *(const u32x4*)(g + 512); pk[1] = *(const u32x4*)(g + 520); pv[0] = *(const u32x4*)(g + 1024); pv[1] = *(const u32x4*)(g + 1032); }
    const float kf = kscale * exp2f(lg2 * (float)(63 - lane));
    const float g64 = exp2f(lg2 * 64.0f);
    for (int c = 0; c < nchunks; ++c) {
        const int rowc = row0 + 64 * c;
        *(LAS u32x4*)(Qs + lane * 136 + wave * 16) = pq[0]; *(LAS u32x4*)(Qs + lane * 136 + wave * 16 + 8) = pq[1];
        *(LAS u32x4*)(Ks + lane * 136 + wave * 16) = pk[0]; *(LAS u32x4*)(Ks + lane * 136 + wave * 16 + 8) = pk[1];
#pragma unroll
        for (int i = 0; i < 2; ++i)
#pragma unroll
            for (int j = 0; j < 4; ++j) { const unsigned wk = pk[i][j], wv = pv[i][j]; const int d = wave * 16 + i * 8 + j * 2;
                const unsigned kk = pk2(bflo(wk) * kf, bfhi(wk) * kf);
                KT[(d) * 72 + lane] = (bf16)(kk & 0xffffu); KT[(d + 1) * 72 + lane] = (bf16)(kk >> 16);
                VT[(d) * 72 + lane] = (bf16)(wv & 0xffffu); VT[(d + 1) * 72 + lane] = (bf16)(wv >> 16); }
        if (c + 1 < nchunks) { const bf16* g = proj + (size_t)(rowc + 64) * INW + goff;
            pq[0] = *(const u32x4*)(g); pq[1] = *(const u32x4*)(g + 8); pk[0] = *(const u32x4*)(g + 512); pk[1] = *(const u32x4*)(g + 520); pv[0] = *(const u32x4*)(g + 1024); pv[1] = *(const u32x4*)(g + 1032); }
        __syncthreads();
        { const int mi = wave >> 1;
#pragma unroll
          for (int jj = 0; jj < 2; ++jj) { const int lj = 2 * (wave & 1) + jj; f32x4 s = (f32x4){0.f, 0.f, 0.f, 0.f};
#pragma unroll
            for (int ks = 0; ks < 4; ++ks) { const bf16x8 a = *(const LAS bf16x8*)(Ks + (16 * mi + fr) * 136 + 32 * ks + 8 * fq), b = *(const LAS bf16x8*)(Qs + (16 * lj + fr) * 136 + 32 * ks + 8 * fq); s = MFMA16(a, b, s); __builtin_amdgcn_sched_barrier(0); }
            const int l = 16 * lj + fr; float pvv[4];
#pragma unroll
            for (int r = 0; r < 4; ++r) { const int m = 16 * mi + 4 * fq + r; const int dlt = l - m; pvv[r] = dlt >= 0 ? s[r] * kscale * exp2f(lg2 * (float)dlt) : 0.f; }
            u32x2 w; w.x = pk2(pvv[0], pvv[1]); w.y = pk2(pvv[2], pvv[3]); *(LAS u32x2*)(Ps + l * 72 + 16 * mi + 4 * fq) = w; } }
#pragma unroll
        for (int et = 0; et < 8; ++et) st[et] = st[et] * g64;
#pragma unroll
        for (int ks = 0; ks < 2; ++ks) { const bf16x8 a = *(const LAS bf16x8*)(KT + (16 * wave + fr) * 72 + 32 * ks + 8 * fq);
#pragma unroll
            for (int et = 0; et < 8; ++et) { const bf16x8 b = *(const LAS bf16x8*)(VT + (16 * et + fr) * 72 + 32 * ks + 8 * fq); st[et] = MFMA16(a, b, st[et]); if (et & 1) __builtin_amdgcn_sched_barrier(0); } }
        __syncthreads();
        { f32x4 oi[4], oc[4];
#pragma unroll
          for (int lt = 0; lt < 4; ++lt) { oi[lt] = (f32x4){0.f, 0.f, 0.f, 0.f}; oc[lt] = (f32x4){0.f, 0.f, 0.f, 0.f}; }
#pragma unroll
          for (int ks = 0; ks < 2; ++ks) { const bf16x8 b = *(const LAS bf16x8*)(VT + (16 * wave + fr) * 72 + 32 * ks + 8 * fq);
#pragma unroll
            for (int lt = 0; lt < 4; ++lt) { const bf16x8 a = *(const LAS bf16x8*)(Ps + (16 * lt + fr) * 72 + 32 * ks + 8 * fq); oi[lt] = MFMA16(a, b, oi[lt]); } __builtin_amdgcn_sched_barrier(0); }
#pragma unroll
          for (int ks = 0; ks < 4; ++ks) { const bf16x8 b = *(const LAS bf16x8*)(ST + (16 * wave + fr) * 136 + 32 * ks + 8 * fq);
#pragma unroll
            for (int lt = 0; lt < 4; ++lt) { const bf16x8 a = *(const LAS bf16x8*)(Qs + (16 * lt + fr) * 136 + 32 * ks + 8 * fq); oc[lt] = MFMA16(a, b, oc[lt]); } __builtin_amdgcn_sched_barrier(0); }
#pragma unroll
          for (int lt = 0; lt < 4; ++lt)
#pragma unroll
            for (int r = 0; r < 4; ++r) { const int l = 16 * lt + 4 * fq + r; Os[l * 132 + 16 * wave + fr] = oi[lt][r] + exp2f(lg2 * (float)(l + 1)) * oc[lt][r]; } }
        __syncthreads();
#pragma unroll
        for (int et = 0; et < 8; ++et) { u32x2 w; w.x = pk2(st[et][0], st[et][1]); w.y = pk2(st[et][2], st[et][3]); *(LAS u32x2*)(ST + (16 * et + fr) * 136 + 16 * wave + 4 * fq) = w; }
        { unsigned gv[8];
#pragma unroll
          for (int i = 0; i < 8; ++i) gv[i] = *(const unsigned*)(proj + (size_t)(rowc + 8 * wave + i) * INW + 1536 + h * 128 + 2 * lane);
#pragma unroll
          for (int i = 0; i < 8; ++i) { const int l = 8 * wave + i; const f32x2 o = *(const LAS f32x2*)(Os + l * 132 + 2 * lane);
            const float ssq = wave_sum(o.x * o.x + o.y * o.y); const float rstd = rsqrtf(ssq * (1.f / 128.f) + EPS);
            const float g0 = bflo(gv[i]), g1 = bfhi(gv[i]);
            *(unsigned*)(mix + (size_t)(rowc + l) * DM + h * 128 + 2 * lane) = pk2(silu_f(g0) * o.x * rstd, silu_f(g1) * o.y * rstd); } }
    }
#pragma unroll
    for (int et = 0; et < 8; ++et)
#pragma unroll
        for (int r = 0; r < 4; ++r) st_out[(size_t)(16 * wave + 4 * fq + r) * 128 + 16 * et + fr] = st[et][r];
}
constexpr int AK = 0, AVT = 27648;
__device__ __forceinline__ void att_item(const Params& P, LAS unsigned char* lds, int tid, int wave, int lane, bool sample, int b, int n, int g) {
    const bf16* proj = (const bf16*)(P.ws + WS_R1);
    bf16* mix = (bf16*)(P.ws + WS_R2);
    const int fr = lane & 15, fq = lane >> 4;
    LAS bf16* Kl = (LAS bf16*)(lds + AK); LAS bf16* VTl = (LAS bf16*)(lds + AVT);
    const int qrow0 = sample ? MP + 64 * b : b * SEQ + 64 * n;
    const int jmin = sample ? 0 : (n >= 2 ? 0 : 64 * (2 - n));
    __syncthreads();
#pragma unroll
    for (int i = 0; i < 3; ++i) { const int p = tid + 512 * i, j = p >> 3, c8 = p & 7; u32x4 w = (u32x4){0u, 0u, 0u, 0u};
        if (j >= jmin) {
            if (sample && j < 128) { const float* s = P.cache_k + ((size_t)(b * 128 + j) * 2 + g) * 64 + 8 * c8; const f32x4 a = *(const f32x4*)s, bb = *(const f32x4*)(s + 4);
                w.x = pk2(a.x, a.y); w.y = pk2(a.z, a.w); w.z = pk2(bb.x, bb.y); w.w = pk2(bb.z, bb.w); }
            else { const int row = sample ? MP + 64 * b + (j - 128) : b * SEQ + 64 * (n - 2) + j; w = *(const u32x4*)(proj + (size_t)row * INW + 2560 + g * 64 + 8 * c8); } }
        *(LAS u32x4*)(Kl + j * 72 + 8 * c8) = w; }
#pragma unroll
    for (int i = 0; i < 3; ++i) { const int j = 64 * i + lane; u32x4 w = (u32x4){0u, 0u, 0u, 0u};
        if (j >= jmin) {
            if (sample && j < 128) { const float* s = P.cache_v + ((size_t)(b * 128 + j) * 2 + g) * 64 + 8 * wave; const f32x4 a = *(const f32x4*)s, bb = *(const f32x4*)(s + 4);
                w.x = pk2(a.x, a.y); w.y = pk2(a.z, a.w); w.z = pk2(bb.x, bb.y); w.w = pk2(bb.z, bb.w); }
            else { const int row = sample ? MP + 64 * b + (j - 128) : b * SEQ + 64 * (n - 2) + j; w = *(const u32x4*)(proj + (size_t)row * INW + 2688 + g * 64 + 8 * wave); } }
#pragma unroll
        for (int e = 0; e < 4; ++e) { VTl[(8 * wave + 2 * e) * 200 + j] = (bf16)(w[e] & 0xffffu); VTl[(8 * wave + 2 * e + 1) * 200 + j] = (bf16)(w[e] >> 16); } }
    const int r = wave >> 1, qh = wave & 1, head = 4 * g + r;
    const float slope = exp2f(-(float)(head + 1));
    const float sink = P.sinks[head];
    const float L2E = 1.4426950408889634f;
    __syncthreads();
#pragma unroll 1
    for (int qt = 0; qt < 2; ++qt) {
        asm volatile("" ::: "memory");
        const int qi = 32 * qh + 16 * qt + fr;
        bf16x8 qf[2];
#pragma unroll
        for (int ks = 0; ks < 2; ++ks) qf[ks] = *(const bf16x8*)(proj + (size_t)(qrow0 + qi) * INW + 2048 + head * 64 + 32 * ks + 8 * fq);
        f32x4 s[12];
#pragma unroll
        for (int kt = 0; kt < 12; ++kt) { s[kt] = (f32x4){0.f, 0.f, 0.f, 0.f};
#pragma unroll
            for (int ks = 0; ks < 2; ++ks) { const bf16x8 a = *(const LAS bf16x8*)(Kl + (16 * kt + fr) * 72 + 32 * ks + 8 * fq); s[kt] = MFMA16(a, qf[ks], s[kt]); } }
        float mx = sink;
#pragma unroll
        for (int kt = 0; kt < 12; ++kt)
#pragma unroll
            for (int rr = 0; rr < 4; ++rr) { const int j = 16 * kt + 4 * fq + rr; const int dist = 128 + qi - j;
                float v = s[kt][rr] * 0.125f - slope * fabsf((float)dist);
                v = j >= jmin ? v : -INFINITY; s[kt][rr] = v; mx = fmaxf(mx, v); }
        mx = fmaxf(mx, __shfl_xor(mx, 16)); mx = fmaxf(mx, __shfl_xor(mx, 32));
        float ls = 0.f;
#pragma unroll
        for (int kt = 0; kt < 12; ++kt)
#pragma unroll
            for (int rr = 0; rr < 4; ++rr) { const float p = exp2f((s[kt][rr] - mx) * L2E); s[kt][rr] = p; ls += p; }
        ls += __shfl_xor(ls, 16); ls += __shfl_xor(ls, 32);
        const float inv = 1.0f / (ls + exp2f((sink - mx) * L2E));
        f32x4 o[4];
#pragma unroll
        for (int dt = 0; dt < 4; ++dt) o[dt] = (f32x4){0.f, 0.f, 0.f, 0.f};
#pragma unroll
        for (int kk = 0; kk < 6; ++kk) {
            u32x4 w; w.x = pk2(s[2 * kk][0], s[2 * kk][1]); w.y = pk2(s[2 * kk][2], s[2 * kk][3]); w.z = pk2(s[2 * kk + 1][0], s[2 * kk + 1][1]); w.w = pk2(s[2 * kk + 1][2], s[2 * kk + 1][3]);
            const bf16x8 pb = __builtin_bit_cast(bf16x8, w);
#pragma unroll
            for (int dt = 0; dt < 4; ++dt) { const LAS bf16* vp = VTl + (16 * dt + fr) * 200 + 32 * kk + 4 * fq;
                const u32x2 lo = *(const LAS u32x2*)vp, hi = *(const LAS u32x2*)(vp + 16);
                const u32x4 aw = (u32x4){lo.x, lo.y, hi.x, hi.y}; const bf16x8 a = __builtin_bit_cast(bf16x8, aw);
                o[dt] = MFMA16(a, pb, o[dt]); }
        }
        bf16* mp = mix + (size_t)(qrow0 + qi) * DM + 512 + head * 64 + 4 * fq;
#pragma unroll
        for (int dt = 0; dt < 4; ++dt) { const f32x4 v = o[dt] * inv; u32x2 w; w.x = pk2(v[0], v[1]); w.y = pk2(v[2], v[3]); *(u32x2*)(mp + 16 * dt) = w; }
    }
}
__device__ __forceinline__ void phase3(const Params& P, LAS unsigned char* lds, int tid, int wave, int lane) {
    const int G = gridDim.x, NR = G / 2, blk = blockIdx.x;
    if (blk < NR) {
#ifndef NO_RET
#ifdef PROBE_RETX2
        for (int rep = 0; rep < 2; ++rep)
#endif
        for (int it = blk; it < 256; it += NR) {
            const bool sample = it >= 128; const int bh = it & 127, b = bh >> 2, h = bh & 3;
            ret_item(P, lds, tid, wave, lane, h, sample ? MP + 64 * b : b * SEQ, sample ? 1 : 32, P.state_ret + (size_t)bh * 16384, sample, P.out + (sample ? OFF_SRET : OFF_PRET) + (size_t)bh * 16384);
        }
#endif
    } else {
#ifndef NO_ATT
#ifdef PROBE_ATTX2
        for (int rep = 0; rep < 2; ++rep)
#endif
        for (int it = blk - NR; it < 2112; it += G - NR) {
            const bool sample = it >= 2048;
            att_item(P, lds, tid, wave, lane, sample, sample ? (it - 2048) >> 1 : it >> 6, sample ? 2 : (it >> 1) & 31, it & 1);
        }
#endif
    }
}

__device__ __forceinline__ void phase6(const Params& P, int tid) {
    const bf16* ua = (const bf16*)(P.ws + WS_R1); bf16* ub = (bf16*)(P.ws + WS_R2);
    constexpr int CH = DFF / 8;
    const int total = MT * CH;
    for (int idx = blockIdx.x * 512 + tid; idx < total; idx += gridDim.x * 512) {
        const int row = idx / CH, j = (idx - row * CH) * 8;
        const bool smp = row >= MP; const int t = smp ? ((row - MP) & 63) : (row & 2047);
        float a[8], p1[8], p2[8], bb[8];
        unpack8(*(const u32x4*)(ua + (size_t)row * DFF + j), a);
        unpack8(*(const u32x4*)(ub + (size_t)row * DFF + j), bb);
        if (t >= 1) unpack8(*(const u32x4*)(ua + (size_t)(row - 1) * DFF + j), p1);
        else if (smp) { const float* s = P.state_conv + ((size_t)((row - MP) >> 6) * 2 + 1) * DFF + j; const f32x4 x = *(const f32x4*)s, y = *(const f32x4*)(s + 4); p1[0] = x.x; p1[1] = x.y; p1[2] = x.z; p1[3] = x.w; p1[4] = y.x; p1[5] = y.y; p1[6] = y.z; p1[7] = y.w; }
        else {
#pragma unroll
            for (int e = 0; e < 8; ++e) p1[e] = 0.f; }
        if (t >= 2) unpack8(*(const u32x4*)(ua + (size_t)(row - 2) * DFF + j), p2);
        else if (smp) { const float* s = P.state_conv + ((size_t)((row - MP) >> 6) * 2 + t) * DFF + j; const f32x4 x = *(const f32x4*)s, y = *(const f32x4*)(s + 4); p2[0] = x.x; p2[1] = x.y; p2[2] = x.z; p2[3] = x.w; p2[4] = y.x; p2[5] = y.y; p2[6] = y.z; p2[7] = y.w; }
        else {
#pragma unroll
            for (int e = 0; e < 8; ++e) p2[e] = 0.f; }
        float r[8];
#pragma unroll
        for (int h = 0; h < 2; ++h) { const f32x4 w0 = *(const f32x4*)(P.conv_w + j + 4 * h), w1 = *(const f32x4*)(P.conv_w + DFF + j + 4 * h), w2 = *(const f32x4*)(P.conv_w + 2 * DFF + j + 4 * h), cb = *(const f32x4*)(P.conv_b + j + 4 * h);
#pragma unroll
            for (int e = 0; e < 4; ++e) { const float cv = cb[e] + w0[e] * p2[4 * h + e] + w1[e] * p1[4 * h + e] + w2[e] * a[4 * h + e]; r[4 * h + e] = silu_f(cv) * bb[4 * h + e]; } }
        u32x4 w; w.x = pk2(r[0], r[1]); w.y = pk2(r[2], r[3]); w.z = pk2(r[4], r[5]); w.w = pk2(r[6], r[7]);
        *(u32x4*)(ub + (size_t)row * DFF + j) = w;
    }
}
#ifdef CONV_FUSED
__device__ __forceinline__ void phase6c(const Params& P, int tid) {
    const float* headA = (const float*)(P.ws + WS_R1); const float* headB = headA + HT_STRIDE; const float* tailA = headA + 2 * HT_STRIDE;
    bf16* act = (bf16*)(P.ws + WS_R2);
    const int total = NGRP * DFF;
    for (int idx = blockIdx.x * 512 + tid; idx < total; idx += gridDim.x * 512) {
        const int g = idx / DFF, j = idx - g * DFF;
        float p0, p1;
        if (g < 1024) { if ((g & 31) == 0) { p0 = 0.f; p1 = 0.f; } else { p0 = tailA[((size_t)(g - 1) * 2) * DFF + j]; p1 = tailA[((size_t)(g - 1) * 2 + 1) * DFF + j]; } }
        else { p0 = P.state_conv[((size_t)(g - 1024) * 2) * DFF + j]; p1 = P.state_conv[((size_t)(g - 1024) * 2 + 1) * DFF + j]; }
        const float a0 = headA[((size_t)g * 2) * DFF + j], a1 = headA[((size_t)g * 2 + 1) * DFF + j];
        const float b0 = headB[((size_t)g * 2) * DFF + j], b1 = headB[((size_t)g * 2 + 1) * DFF + j];
        const float w0 = P.conv_w[j], w1 = P.conv_w[DFF + j], w2 = P.conv_w[2 * DFF + j], cb = P.conv_b[j];
        const float c0 = cb + w0 * p0 + w1 * p1 + w2 * a0, c1 = cb + w0 * p1 + w1 * a0 + w2 * a1;
        act[(size_t)(64 * g) * DFF + j] = (bf16)(pk2(silu_f(c0) * b0, 0.f) & 0xffffu);
        act[(size_t)(64 * g + 1) * DFF + j] = (bf16)(pk2(silu_f(c1) * b1, 0.f) & 0xffffu);
        const float t0 = tailA[((size_t)g * 2) * DFF + j], t1 = tailA[((size_t)g * 2 + 1) * DFF + j];
        if (g < 1024) { if ((g & 31) == 31) { P.out[OFF_PCONV + ((size_t)(g >> 5) * 2) * DFF + j] = t0; P.out[OFF_PCONV + ((size_t)(g >> 5) * 2 + 1) * DFF + j] = t1; } }
        else { P.out[OFF_SCONV + ((size_t)(g - 1024) * 2) * DFF + j] = t0; P.out[OFF_SCONV + ((size_t)(g - 1024) * 2 + 1) * DFF + j] = t1; }
    }
}
#endif
__device__ __forceinline__ void phase8(const Params& P, int wave, int lane) {
    const float* mod = (const float*)(P.ws + WS_MOD); const bf16* x2 = (const bf16*)(P.ws + WS_R0);
    const int gw = blockIdx.x * 8 + wave, NGW = gridDim.x * 8;
#pragma unroll 2
    for (int row = gw; row < MT; row += NGW) {
        const int bs = row < MP ? (row >> 11) : 32 + ((row - MP) >> 6);
        float* yr = P.out + (size_t)row * DM + 8 * lane;
        const float* mb = mod + (size_t)bs * 8192 + 6144 + 8 * lane;
        const bf16* xr = x2 + (size_t)row * DM + 8 * lane;
        float v[2][8]; float ss = 0.f;
#pragma unroll
        for (int j = 0; j < 2; ++j) { unpack8(*(const u32x4*)(xr + 512 * j), v[j]);
#pragma unroll
            for (int e = 0; e < 8; ++e) ss += v[j][e] * v[j][e]; }
        const float rstd = rsqrtf(wave_sum(ss) * (1.f / DM) + EPS);
#pragma unroll
        for (int j = 0; j < 2; ++j)
#pragma unroll
            for (int h = 0; h < 2; ++h) { const int o = 512 * j + 4 * h; const f32x4 sh = *(const f32x4*)(mb + o), sc = *(const f32x4*)(mb + 1024 + o), gn = *(const f32x4*)(P.normf + 8 * lane + o);
                const f32x4 x = (f32x4){v[j][4 * h], v[j][4 * h + 1], v[j][4 * h + 2], v[j][4 * h + 3]};
                *(f32x4*)(yr + o) = x * rstd * gn * (sc + 1.0f) + sh; }
    }
}
__device__ __forceinline__ void phase8q(const Params& P, LAS unsigned char* lds, int tid, int wave, int lane) {
    const float* mod = (const float*)(P.ws + WS_MOD);
    unsigned* cnt = (unsigned*)(P.ws + WS_CNT7); unsigned* ticket = (unsigned*)(P.ws + WS_TICKET);
    LAS int* ord = (LAS int*)(lds + 131072);
    LAS int* flag = ord + 272;
    pg8::StaticOrder S; S.init(MT, DM, (int)gridDim.x, 0);
    for (int i = tid; i < NTM; i += 512) flag[i] = 0;
    __syncthreads();
    { const int full = (S.nwg / S.G) * S.G; for (int L = full + tid; L < S.nwg; L += 512) { pg8::Unit u; S.map(L, u); flag[u.pm] = 1; } }
    __syncthreads();
    if (tid == 0) { int k = 0; for (int i = 0; i < NTM; ++i) if (!flag[i]) ord[k++] = i; for (int i = 0; i < NTM; ++i) if (flag[i]) ord[k++] = i; }
    __syncthreads();
    for (;;) {
        if (tid == 0) flag[268] = (int)__hip_atomic_fetch_add(ticket, 1u, __ATOMIC_RELAXED, __HIP_MEMORY_SCOPE_AGENT);
        __syncthreads();
        const int tk = flag[268];
        if (tk >= NTM * 4) break;
        const int pm = ord[tk >> 2], rb = tk & 3;
        if (wave == 0) {
            unsigned spins = 0;
            while ((unsigned)__builtin_amdgcn_readfirstlane(__hip_atomic_load(cnt + 64 * pm, __ATOMIC_RELAXED, __HIP_MEMORY_SCOPE_AGENT)) < 32u) { __builtin_amdgcn_s_sleep(4); if (++spins > (1u << 22)) break; }
            __builtin_amdgcn_fence(__ATOMIC_ACQUIRE, "agent");
            asm volatile("s_waitcnt vmcnt(0)" ::: "memory");
        }
        __syncthreads();
#pragma unroll 2
        for (int i = 0; i < 8; ++i) {
            const int row = pm * 256 + rb * 64 + wave * 8 + i;
            const int bs = row < MP ? (row >> 11) : 32 + ((row - MP) >> 6);
            float* yr = P.out + (size_t)row * DM + 4 * lane;
            const float* mb = mod + (size_t)bs * 8192 + 6144 + 4 * lane;
            f32x4 v[4]; float ss = 0.f;
#pragma unroll
            for (int j = 0; j < 4; ++j) { v[j] = *(const f32x4*)(yr + 256 * j); ss += (v[j].x * v[j].x + v[j].y * v[j].y) + (v[j].z * v[j].z + v[j].w * v[j].w); }
            const float rstd = rsqrtf(wave_sum(ss) * (1.f / DM) + EPS);
#pragma unroll
            for (int j = 0; j < 4; ++j) { const f32x4 sh = *(const f32x4*)(mb + 256 * j), sc = *(const f32x4*)(mb + 1024 + 256 * j), gn = *(const f32x4*)(P.normf + 4 * lane + 256 * j);
                *(f32x4*)(yr + 256 * j) = v[j] * rstd * gn * (sc + 1.0f) + sh; }
        }
    }
}

#ifndef N_LAUNCH
#define N_LAUNCH 1
#endif
#define LAUNDER_TID() int tid = threadIdx.x; asm volatile("" : "+v"(tid)); const int lane = tid & 63, wave = __builtin_amdgcn_readfirstlane(tid >> 6); (void)lane; (void)wave
template <int PHM>
__global__ void __launch_bounds__(512) fwd_mega(Params P) {
    extern __shared__ __attribute__((aligned(16))) unsigned char lds_raw[];
    LAS unsigned char* lds = (LAS unsigned char*)lds_raw;
    const int G = gridDim.x;
    unsigned char* ws = P.ws;
    volatile LAS unsigned* misc = (volatile LAS unsigned*)(lds + LDS_MISC);
    if (threadIdx.x < 2) misc[threadIdx.x] = 0u;
    __syncthreads();
    XcdBarrier bar; bar.bar = (unsigned*)(ws + WS_BAR); bar.x = 0; bar.st = misc;
#define GSYNC(a, b) do { if ((PHM & (a)) && (PHM & (b))) xcd_barrier(bar); } while (0)
    if constexpr ((PHM & 1) != 0) { LAUNDER_TID(); phase0(P, lds, wave, lane);
      if (blockIdx.x == 0) for (int i = tid; i < XCD_BAR_WORDS; i += 512) ((unsigned*)(ws + WS_BAR))[i] = 0u;
      if (blockIdx.x == 1) { for (int i = tid; i < NTM * 64; i += 512) ((unsigned*)(ws + WS_CNT7))[i] = 0u; if (tid < 64) ((unsigned*)(ws + WS_TICKET))[tid] = 0u; } }
    if constexpr ((PHM & 1) != 0 && (PHM & 2) != 0) {
      cg::this_grid().sync();
      bar = xcd_barrier_post((unsigned*)(ws + WS_BAR), misc); }
    if constexpr ((PHM & 2) != 0) { LAUNDER_TID(); phase1(P, lds, tid, wave, lane); }
    GSYNC(2, 4);
    if constexpr ((PHM & 4) != 0) {
      pg8::Gemm g{(const bf16*)(ws + WS_R0), (const bf16*)(ws + WS_WIN), MT, INW, DM};
      OrderX S; S.S.init(MT, INW, G, (int)blockIdx.x); S.nX = 22; S.xpm = NTM; S.xpn0 = 11;
      Epi1 E{(bf16*)(ws + WS_R1), (float*)(ws + WS_SHW), P.out};
      pg8::gemm_phase<Epi1, OrderX, true, true>(lds, g, S, E); }
    GSYNC(4, 8);
    if constexpr ((PHM & 8) != 0) { LAUNDER_TID(); phase3(P, lds, tid, wave, lane);
#ifdef PROBE_P3X2
      cg::this_grid().sync(); phase3(P, lds, tid, wave, lane);
#endif
    }
    GSYNC(8, 16);
    if constexpr ((PHM & 16) != 0) {
      pg8::Gemm g{(const bf16*)(ws + WS_R2), (const bf16*)(ws + WS_WOUT), MT, DM, DM};
      pg8::StaticOrder S; S.init(MT, DM, G, (int)blockIdx.x);
      Epi2 E{P.x_p, P.x_s, (const float*)(ws + WS_MOD), P.ln2, (bf16*)(ws + WS_X1B), (bf16*)(ws + WS_R0), (float*)(ws + WS_SS1)};
      pg8::gemm_phase<Epi2, pg8::StaticOrder, true, true>(lds, g, S, E); }
    GSYNC(16, 32);
    if constexpr ((PHM & 32) != 0) {
      LAUNDER_TID();
      pg8::Gemm g{(const bf16*)(ws + WS_R0), (const bf16*)(ws + WS_WUP), MT, 2 * DFF, DM};
      pg8::StaticOrder S; S.init(MT, 2 * DFF, G, (int)blockIdx.x);
      LAS float* rtab = (LAS float*)(lds + 131072);
      { pg8::Unit u; const float* ss = (const float*)(ws + WS_SS1);
        for (int i = 0; S.next(i, u) && i < 24; ++i) if (tid < 256) { const f32x4* sp = (const f32x4*)(ss + (size_t)(u.pm * 256 + tid) * 16);
            const f32x4 q0 = sp[0], q1 = sp[1], q2 = sp[2], q3 = sp[3];
            const float tot = ((q0.x + q0.y) + (q0.z + q0.w)) + ((q1.x + q1.y) + (q1.z + q1.w)) + ((q2.x + q2.y) + (q2.z + q2.w)) + ((q3.x + q3.y) + (q3.z + q3.w));
            rtab[i * 256 + tid] = rsqrtf(tot * (1.f / DM) + EPS); }
        __syncthreads(); }
#ifdef CONV_FUSED
      float* hA = (float*)(ws + WS_R1);
      Epi3C E{rtab, (const float*)(ws + WS_SHW), P.conv_w, P.conv_b, (bf16*)(ws + WS_R2), hA, hA + HT_STRIDE, hA + 2 * HT_STRIDE};
      pg8::gemm_phase<Epi3C, pg8::StaticOrder, true, true>(lds, g, S, E);
#else
      Epi3 E{rtab, (const float*)(ws + WS_SHW), (bf16*)(ws + WS_R1), (bf16*)(ws + WS_R2), P.out};
      pg8::gemm_phase<Epi3, pg8::StaticOrder, true, true>(lds, g, S, E);
#endif
#ifdef PROBE_P5X2
      cg::this_grid().sync(); pg8::gemm_phase<Epi3, pg8::StaticOrder, true, true>(lds, g, S, E);
#endif
    }
    GSYNC(32, 64);
#ifdef CONV_FUSED
    if constexpr ((PHM & 64) != 0) { LAUNDER_TID(); phase6c(P, tid); }
#else
    if constexpr ((PHM & 64) != 0) { LAUNDER_TID(); phase6(P, tid); }
#endif
    GSYNC(64, 128);
    if constexpr ((PHM & 128) != 0) {
      pg8::Gemm g{(const bf16*)(ws + WS_R2), (const bf16*)(ws + WS_WDN), MT, DM, DFF};
#ifdef P8_QUEUE
      OrderPub S; S.init(MT, DM, G, (int)blockIdx.x); S.cnt = (unsigned*)(ws + WS_CNT7);
      Epi4 E{(const float*)(ws + WS_MOD), (const bf16*)(ws + WS_X1B), (bf16*)(ws + WS_R0)};
      pg8::gemm_phase<Epi4, OrderPub, true, true>(lds, g, S, E); }
    if constexpr ((PHM & 256) != 0) { LAUNDER_TID(); phase8q(P, lds, tid, wave, lane); }
#else
      pg8::StaticOrder S; S.init(MT, DM, G, (int)blockIdx.x);
      Epi4 E{(const float*)(ws + WS_MOD), (const bf16*)(ws + WS_X1B), (bf16*)(ws + WS_R0)};
      pg8::gemm_phase<Epi4, pg8::StaticOrder, true, true>(lds, g, S, E); }
    GSYNC(128, 256);
    if constexpr ((PHM & 256) != 0) { LAUNDER_TID(); phase8(P, wave, lane); }
#endif
}

template <int PHM> static bool launch_one(const Params& p, int grid, bool coop, hipStream_t stream) {
    static bool attr_done = false;
    if (!attr_done) { if (hipFuncSetAttribute((const void*)fwd_mega<PHM>, hipFuncAttributeMaxDynamicSharedMemorySize, LDS_BYTES) != hipSuccess) { fprintf(stderr, "kernel_launch: hipFuncSetAttribute failed\n"); return false; } attr_done = true; }
    hipError_t e;
    if (coop) { Params pc = p; void* args[] = {&pc}; e = hipLaunchCooperativeKernel((const void*)fwd_mega<PHM>, dim3(grid), dim3(512), args, LDS_BYTES, stream); }
    else { hipLaunchKernelGGL(fwd_mega<PHM>, dim3(grid), dim3(512), LDS_BYTES, stream, p); e = hipPeekAtLastError(); }
    if (e != hipSuccess) { fprintf(stderr, "launch (mask %d) failed: %s (grid %d)\n", PHM, hipGetErrorString(e), grid); return false; }
    return true;
}
extern "C" void kernel_launch(void* const* d_in, const int* in_sizes, int n_in, void* d_out, int out_size, void* d_ws, size_t ws_size, hipStream_t stream) {
    static int grid = 0;
    if (grid == 0) {
        if (n_in != 22 || (size_t)out_size != OUT_TOTAL || ws_size < WS_END) { fprintf(stderr, "kernel_launch: unexpected sizes n_in %d out %d ws %zu\n", n_in, out_size, ws_size); grid = -1; return; }
        int dev = 0, cus = 0;
        (void)hipGetDevice(&dev);
        (void)hipDeviceGetAttribute(&cus, hipDeviceAttributeMultiprocessorCount, dev);
        grid = cus;
        if (grid > 256) grid = 256;
        if (grid < 2) grid = -1;
    }
    if (grid < 0) return;
    Params p{};
    const float** pp = (const float**)&p;
    for (int i = 0; i < 22; ++i) pp[i] = (const float*)d_in[i];
    p.out = (float*)d_out; p.ws = (unsigned char*)d_ws;
#if N_LAUNCH == 1
    launch_one<511>(p, grid, true, stream);
#else
    launch_one<1>(p, grid, false, stream) && launch_one<2>(p, grid, false, stream) && launch_one<4>(p, grid, false, stream) && launch_one<8>(p, grid, false, stream) &&
    launch_one<16>(p, grid, false, stream) && launch_one<32>(p, grid, false, stream) && launch_one<64>(p, grid, false, stream) && launch_one<128>(p, grid, false, stream) && launch_one<256>(p, grid, false, stream);
#endif
}
```

```cpp
#define CONV_FUSED 1
#include <hip/hip_runtime.h>
#include <hip/hip_cooperative_groups.h>
#include <cstdio>
#include <cstdint>
namespace cg = cooperative_groups;
namespace pg8 {
#define PG8_LAS __attribute__((address_space(3)))
typedef unsigned short bf16_t;
typedef short bf16x8 __attribute__((ext_vector_type(8)));
typedef float f32x4 __attribute__((ext_vector_type(4)));
typedef unsigned u32x4 __attribute__((ext_vector_type(4)));
constexpr int BM = 256, BK = 64, HALF = 128, HTB = HALF * BK * 2  , STAGE_BYTES = 8 * HTB, NXCD = 8, WGM = 8;

__host__ __device__ __forceinline__ int lds_byte(int r, int c) { const int st = (r >> 4) * 2 + (c >> 5), rr = r & 15, cc = c & 31, ob = rr * 64 + cc * 2; return st * 1024 + (ob ^ (((ob >> 9) & 1) << 5)); }
__host__ __device__ __forceinline__ void stage_rc(int b, int& R, int& C) { const int st = b / 1024, sb = b % 1024, swz = sb ^ (((sb >> 9) & 1) << 5); R = (st >> 1) * 16 + swz / 64; C = (st & 1) * 32 + (swz % 64) / 2; }
__host__ __device__ __forceinline__ int perm32(int rho) { const int n = rho >> 4, i = rho & 15; return 8 * (i >> 2) + 4 * n + (i & 3); }

struct Unit { int pm, pn, seq; };
struct Gemm { const bf16_t* A; const bf16_t* Bt; int M, N, K; };

struct StaticOrder {
    int nM, nN, nwg, G, c;
    __host__ __device__ __forceinline__ void init(int M, int N, int G_, int c_) { nM = M / BM; nN = N / BM; nwg = nM * nN; G = G_; c = c_; }
    __host__ __device__ __forceinline__ bool next(int i, Unit& u) const {
        const long L = (long)i * G + c; if (L >= nwg) return false; u.seq = i; map(L, u); return true; }
    __host__ __device__ __forceinline__ void map(long L, Unit& u) const {
        int wgid = (int)L; { const int q = nwg / NXCD, r = nwg % NXCD, xcd = wgid % NXCD, off = wgid / NXCD; wgid = (xcd < r ? xcd * (q + 1) : r * (q + 1) + (xcd - r) * q) + off; }
        const int nig = WGM * nN, gid = wgid / nig, fm = gid * WGM, gsz = (nM - fm) < WGM ? (nM - fm) : WGM;
        u.pm = fm + ((wgid % nig) % gsz); u.pn = (wgid % nig) / gsz;
    }
    __device__ __forceinline__ void a_ready(const Unit&) const {}
    __device__ __forceinline__ void done(const Unit&) const {}
};

__device__ __forceinline__ unsigned cvt_pk_bf16(float lo, float hi) { unsigned r; asm volatile("v_cvt_pk_bf16_f32 %0, %1, %2" : "=v"(r) : "v"(lo), "v"(hi)); return r; }

template <class Epi, class Sched, bool ALIGN_EPI = false, bool SP2 = false>
__device__ __forceinline__ void gemm_phase(PG8_LAS unsigned char* lds, const Gemm g, const Sched& S, const Epi& E) {
    int tid_ = threadIdx.x; asm volatile("" : "+v"(tid_));
    const int tid = tid_, wid = __builtin_amdgcn_readfirstlane(tid >> 6), lane = tid & 63, wr = wid >> 2, wc = wid & 3, fr = lane & 15, fq = lane >> 4;
    const int K = g.K, nt = K / BK;
    unsigned voffA[2], voffB[2];
#pragma unroll
    for (int i = 0; i < 2; ++i) { int R, C; stage_rc(tid * 16 + i * 8192, R, C); const int Rb = Epi::PERM ? ((R & ~31) + perm32(R & 31)) : R;
        voffA[i] = (unsigned)(R * K + C) * 2u; voffB[i] = (unsigned)(Rb * K + C) * 2u; }
    const size_t kstep = (size_t)(BK * 2);
    const size_t hstep = (size_t)HALF * K * 2;
    const size_t tstep = 2 * hstep;
    const unsigned ldsw = (unsigned)wid * 1024u;
    const int aoff = lds_byte(wr * 64 + fr, fq * 8), boff = lds_byte(wc * 32 + fr, fq * 8);
#define PG8_SA(b, h) (((b) * 2 + (h)) * HTB)
#define PG8_SB(b, h) ((4 + (b) * 2 + (h)) * HTB)
#define PG8_STAGE(bufoff, gbase, voff) do { _Pragma("unroll") for (int _i = 0; _i < 2; ++_i) \
        __builtin_amdgcn_global_load_lds((const unsigned*)((const char*)(gbase) + (voff)[_i]), (PG8_LAS unsigned*)(lds + (bufoff) + ldsw + _i * 8192), 16, 0, 0); } while (0)
#define PG8_LDA(dst, b, h) do { _Pragma("unroll") for (int m = 0; m < 4; ++m) _Pragma("unroll") for (int k = 0; k < 2; ++k) dst[m][k] = *(const PG8_LAS bf16x8*)(lds + PG8_SA(b, h) + aoff + m * 2048 + k * 1024); } while (0)
#define PG8_LDB(dst, b, h) do { _Pragma("unroll") for (int n = 0; n < 2; ++n) _Pragma("unroll") for (int k = 0; k < 2; ++k) dst[n][k] = *(const PG8_LAS bf16x8*)(lds + PG8_SB(b, h) + boff + n * 2048 + k * 1024); } while (0)
#define PG8_MMA(ai, bj, At, Bt) do { __builtin_amdgcn_s_setprio(1); _Pragma("unroll") for (int m = 0; m < 4; ++m) _Pragma("unroll") for (int n = 0; n < 2; ++n) _Pragma("unroll") for (int k = 0; k < 2; ++k) \
        acc[ai][bj][m][n] = __builtin_amdgcn_mfma_f32_16x16x32_bf16(Bt[n][k], At[m][k], acc[ai][bj][m][n], 0, 0, 0); __builtin_amdgcn_s_setprio(0); } while (0)
#define PG8_WAIT_V(n) asm volatile("s_waitcnt vmcnt(" #n ")" ::: "memory")
#define PG8_WAIT_L(n) asm volatile("s_waitcnt lgkmcnt(" #n ")" ::: "memory")
#define PG8_BAR __builtin_amdgcn_s_barrier()
#define PG8_SCHED __builtin_amdgcn_sched_barrier(0)
    Unit cur, nxt; int ui = 0;
    if (!S.next(0, cur)) return;
    f32x4 acc[2][2][4][2];
#pragma unroll
    for (int a = 0; a < 2; ++a)
#pragma unroll
        for (int b = 0; b < 2; ++b)
#pragma unroll
            for (int m = 0; m < 4; ++m)
#pragma unroll
                for (int n = 0; n < 2; ++n) acc[a][b][m][n] = (f32x4){0.f, 0.f, 0.f, 0.f};
    bf16x8 At[4][2], B0[2][2], B1[2][2];
    const char* cA = (const char*)g.A + (size_t)cur.pm * tstep; const char* cB = (const char*)g.Bt + (size_t)cur.pn * tstep;
    S.a_ready(cur);
    if constexpr (SP2) {
        PG8_STAGE(PG8_SB(0, 0), cB, voffB); PG8_STAGE(PG8_SB(0, 1), cB + hstep, voffB); PG8_STAGE(PG8_SA(0, 0), cA, voffA); PG8_STAGE(PG8_SA(0, 1), cA + hstep, voffA);
        if (wr == 1) PG8_BAR;
        PG8_WAIT_V(2); PG8_BAR;
        PG8_STAGE(PG8_SB(1, 0), cB + kstep, voffB); PG8_STAGE(PG8_SA(1, 0), cA + kstep, voffA); PG8_STAGE(PG8_SB(1, 1), cB + hstep + kstep, voffB);
        PG8_WAIT_V(6); PG8_BAR;
    } else {
        PG8_STAGE(PG8_SB(0, 0), cB, voffB); PG8_STAGE(PG8_SA(0, 0), cA, voffA); PG8_STAGE(PG8_SB(0, 1), cB + hstep, voffB); PG8_STAGE(PG8_SA(0, 1), cA + hstep, voffA);
        if (wr == 1) PG8_BAR;
        PG8_WAIT_V(4); PG8_BAR;
        PG8_STAGE(PG8_SB(1, 0), cB + kstep, voffB); PG8_STAGE(PG8_SA(1, 0), cA + kstep, voffA); PG8_STAGE(PG8_SB(1, 1), cB + hstep + kstep, voffB);
        PG8_WAIT_V(6); PG8_BAR;
    }
    for (;;) {
        const bool has_next = S.next(ui + 1, nxt);
        const char* nA = has_next ? (const char*)g.A + (size_t)nxt.pm * tstep : cA; const char* nB = has_next ? (const char*)g.Bt + (size_t)nxt.pn * tstep : cB;
        for (int t = 0; t < nt; t += 2) {
            const bool last = (t == nt - 2);
            const char* a1 = cA + (size_t)(t + 1) * kstep;
            const char* a2 = last ? nA : cA + (size_t)(t + 2) * kstep; const char* b2 = last ? nB : cB + (size_t)(t + 2) * kstep;
            const char* a3 = a2 + kstep; const char* b3 = b2 + kstep;
            if (last && has_next) S.a_ready(nxt);
            if constexpr (SP2) {
            PG8_LDB(B0, 0, 0); PG8_LDB(B1, 0, 1); PG8_SCHED; PG8_LDA(At, 0, 0); PG8_STAGE(PG8_SA(1, 1), a1 + hstep, voffA);
            PG8_WAIT_V(8); PG8_WAIT_L(0); PG8_BAR; PG8_MMA(0, 0, At, B0); PG8_MMA(0, 1, At, B1); PG8_BAR; PG8_SCHED;
            PG8_LDA(At, 0, 1); PG8_STAGE(PG8_SB(0, 0), b2, voffB); PG8_STAGE(PG8_SB(0, 1), b2 + hstep, voffB); PG8_STAGE(PG8_SA(0, 0), a2, voffA);
            PG8_WAIT_V(8); PG8_WAIT_L(0); PG8_BAR; PG8_MMA(1, 0, At, B0); PG8_MMA(1, 1, At, B1); PG8_BAR; PG8_SCHED;
            PG8_LDB(B0, 1, 0); PG8_LDB(B1, 1, 1); PG8_SCHED; PG8_LDA(At, 1, 0); PG8_STAGE(PG8_SA(0, 1), a2 + hstep, voffA);
            PG8_WAIT_V(8); PG8_WAIT_L(0); PG8_BAR; PG8_MMA(0, 0, At, B0); PG8_MMA(0, 1, At, B1); PG8_BAR; PG8_SCHED;
            PG8_LDA(At, 1, 1); PG8_STAGE(PG8_SB(1, 0), b3, voffB); PG8_STAGE(PG8_SB(1, 1), b3 + hstep, voffB); PG8_STAGE(PG8_SA(1, 0), a3, voffA);
            PG8_WAIT_V(8); PG8_WAIT_L(0); PG8_BAR; PG8_MMA(1, 0, At, B0); PG8_MMA(1, 1, At, B1); PG8_BAR; PG8_SCHED;
            } else {
            PG8_LDB(B0, 0, 0); PG8_SCHED; PG8_LDA(At, 0, 0); PG8_STAGE(PG8_SA(1, 1), a1 + hstep, voffA);
            PG8_WAIT_L(8); PG8_BAR; PG8_WAIT_L(0); PG8_MMA(0, 0, At, B0); PG8_BAR; PG8_SCHED;
            PG8_LDB(B1, 0, 1); PG8_STAGE(PG8_SB(0, 0), b2, voffB);
            PG8_BAR; PG8_WAIT_L(0); PG8_MMA(0, 1, At, B1); PG8_BAR;
            PG8_LDA(At, 0, 1); PG8_STAGE(PG8_SA(0, 0), a2, voffA);
            PG8_BAR; PG8_WAIT_L(0); PG8_MMA(1, 0, At, B0); PG8_BAR; PG8_SCHED;
            PG8_STAGE(PG8_SB(0, 1), b2 + hstep, voffB);
            PG8_WAIT_V(6); PG8_BAR; PG8_MMA(1, 1, At, B1); PG8_BAR;
            PG8_LDB(B0, 1, 0); PG8_SCHED; PG8_LDA(At, 1, 0); PG8_STAGE(PG8_SA(0, 1), a2 + hstep, voffA);
            PG8_WAIT_L(8); PG8_BAR; PG8_WAIT_L(0); PG8_MMA(0, 0, At, B0); PG8_BAR; PG8_SCHED;
            PG8_LDB(B1, 1, 1); PG8_STAGE(PG8_SB(1, 0), b3, voffB);
            PG8_BAR; PG8_WAIT_L(0); PG8_MMA(0, 1, At, B1); PG8_BAR;
            PG8_LDA(At, 1, 1); PG8_STAGE(PG8_SA(1, 0), a3, voffA);
            PG8_BAR; PG8_WAIT_L(0); PG8_MMA(1, 0, At, B0); PG8_BAR; PG8_SCHED;
            PG8_STAGE(PG8_SB(1, 1), b3 + hstep, voffB);
            PG8_WAIT_V(6); PG8_BAR; PG8_MMA(1, 1, At, B1); PG8_BAR;
            }
        }
        if constexpr (ALIGN_EPI) { if (wr == 0) PG8_BAR; }
        if constexpr (!Epi::AFTER_DRAIN) { E(acc, cur, wr, wc, fr, fq); S.done(cur); }
        if (!has_next) break;
#pragma unroll
        for (int a = 0; a < 2; ++a)
#pragma unroll
            for (int b = 0; b < 2; ++b)
#pragma unroll
                for (int m = 0; m < 4; ++m)
#pragma unroll
                    for (int n = 0; n < 2; ++n) acc[a][b][m][n] = (f32x4){0.f, 0.f, 0.f, 0.f};
        cur = nxt; cA = nA; cB = nB; ++ui;
        if constexpr (ALIGN_EPI) { if (wr == 1) PG8_BAR; }
    }
    PG8_WAIT_V(0);
    if constexpr (!ALIGN_EPI) { if (wr == 0) PG8_BAR; }
    PG8_BAR;
    if constexpr (Epi::AFTER_DRAIN) { E.fused(acc, cur, wr, wc, fr, fq, lds, wid, lane); S.done(cur); }
#undef PG8_SA
#undef PG8_SB
#undef PG8_STAGE
#undef PG8_LDA
#undef PG8_LDB
#undef PG8_MMA
#undef PG8_WAIT_V
#undef PG8_WAIT_L
#undef PG8_BAR
#undef PG8_SCHED
}
}
constexpr int DM = 1024, SEQ = 2048, NB = 32, DECL = 64, DFF = 2816, INW = 2816;
constexpr int MP = NB * SEQ, MS = NB * DECL, MT = MP + MS;
constexpr int NGRP = MT / 64;
constexpr int NTM = MT / 256;
constexpr float EPS = 1e-6f;
constexpr size_t OFF_Y = 0;
constexpr size_t OFF_PRET = (size_t)MT * DM;
constexpr size_t OFF_PK = OFF_PRET + (size_t)NB * 4 * 128 * 128;
constexpr size_t OFF_PV = OFF_PK + (size_t)NB * 128 * 128;
constexpr size_t OFF_PCONV = OFF_PV + (size_t)NB * 128 * 128;
constexpr size_t OFF_SRET = OFF_PCONV + (size_t)NB * 2 * DFF;
constexpr size_t OFF_SK = OFF_SRET + (size_t)NB * 4 * 128 * 128;
constexpr size_t OFF_SV = OFF_SK + (size_t)NB * 64 * 128;
constexpr size_t OFF_SCONV = OFF_SV + (size_t)NB * 64 * 128;
constexpr size_t OUT_TOTAL = OFF_SCONV + (size_t)NB * 2 * DFF;
constexpr size_t MiB = 1u << 20;
constexpr size_t WS_WIN = 0;
constexpr size_t WS_WUP = WS_WIN + (size_t)INW * DM * 2;
constexpr size_t WS_WOUT = WS_WUP + (size_t)2 * DFF * DM * 2;
constexpr size_t WS_WDN = WS_WOUT + (size_t)DM * DM * 2;
constexpr size_t WS_MODP = 24 * MiB;
constexpr size_t WS_MOD = 32 * MiB;
constexpr size_t WS_SHW = 34 * MiB;
constexpr size_t WS_SS1 = 36 * MiB;
constexpr size_t WS_SS2 = 41 * MiB;
constexpr size_t WS_R0 = 48 * MiB;
constexpr size_t WS_R1 = WS_R0 + 133 * MiB;
constexpr size_t WS_R2 = WS_R1 + 363 * MiB;
constexpr size_t HT_STRIDE = (size_t)NGRP * 2 * DFF;
constexpr size_t WS_END = WS_R2 + 363 * MiB;
constexpr size_t WS_X1B = WS_R1 + 128 * MiB;
static_assert(3 * HT_STRIDE * 4 <= 128 * MiB && WS_X1B + (size_t)MT * DM * 2 <= WS_R2, "ws map");
static_assert(WS_WDN + (size_t)DM * DFF * 2 <= WS_MODP, "ws map");
static_assert((size_t)(MT + 256) * DM * 2 <= 133 * MiB && (size_t)MT * DFF * 2 <= 363 * MiB, "ws map");

constexpr size_t WS_BAR = 46 * MiB;
constexpr size_t WS_TICKET = 46 * MiB + 32768;
constexpr size_t WS_CNT7 = 46 * MiB + 65536;
constexpr int LDS_MISC = 155648;
constexpr int LDS_BYTES = 155648 + 64;

#define LAS __attribute__((address_space(3)))
typedef unsigned short bf16;
typedef float f32x4 __attribute__((ext_vector_type(4)));
typedef float f32x2 __attribute__((ext_vector_type(2)));
typedef short bf16x8 __attribute__((ext_vector_type(8)));
typedef unsigned u32x4 __attribute__((ext_vector_type(4)));
typedef unsigned u32x2 __attribute__((ext_vector_type(2)));
typedef __bf16 bf16x2_t __attribute__((ext_vector_type(2)));
#define LDS_WAIT() asm volatile("s_waitcnt lgkmcnt(0)" ::: "memory")

__device__ __forceinline__ unsigned pk2(float lo, float hi) { f32x2 v = {lo, hi}; bf16x2_t b = __builtin_convertvector(v, bf16x2_t); return __builtin_bit_cast(unsigned, b); }
__device__ __forceinline__ float bflo(unsigned w) { return __uint_as_float(w << 16); }
__device__ __forceinline__ float bfhi(unsigned w) { return __uint_as_float(w & 0xffff0000u); }
__device__ __forceinline__ float wave_sum(float v) {
#pragma unroll
    for (int o = 1; o < 64; o <<= 1) v += __shfl_xor(v, o);
    return v;
}
__device__ __forceinline__ float wave_sum_dpp(float v) {
    v += __int_as_float(__builtin_amdgcn_update_dpp(__float_as_int(v), __float_as_int(v), 0x128, 0xf, 0xf, false));
    v += __int_as_float(__builtin_amdgcn_update_dpp(__float_as_int(v), __float_as_int(v), 0x124, 0xf, 0xf, false));
    v += __int_as_float(__builtin_amdgcn_update_dpp(__float_as_int(v), __float_as_int(v), 0x122, 0xf, 0xf, false));
    v += __int_as_float(__builtin_amdgcn_update_dpp(__float_as_int(v), __float_as_int(v), 0x121, 0xf, 0xf, false));
    const int i = __float_as_int(v);
    return (__int_as_float(__builtin_amdgcn_readlane(i, 0)) + __int_as_float(__builtin_amdgcn_readlane(i, 16))) + (__int_as_float(__builtin_amdgcn_readlane(i, 32)) + __int_as_float(__builtin_amdgcn_readlane(i, 48)));
}
__device__ __forceinline__ float silu_f(float x) { return x * __builtin_amdgcn_rcpf(1.0f + __builtin_amdgcn_exp2f(-1.4426950408889634f * x)); }
__device__ __forceinline__ void unpack8(const u32x4 w, float (&f)[8]) { f[0] = bflo(w.x); f[1] = bfhi(w.x); f[2] = bflo(w.y); f[3] = bfhi(w.y); f[4] = bflo(w.z); f[5] = bfhi(w.z); f[6] = bflo(w.w); f[7] = bfhi(w.w); }
__device__ __forceinline__ int grp_bs(int g) { return g < 1024 ? (g >> 5) : 32 + (g - 1024); }

struct Params {
    const float *x_p, *x_s, *cache_k, *cache_v, *state_ret, *state_conv, *c_p, *c_s, *ln1, *ln2, *w_ada, *b_ada, *w_in, *w_out, *sinks, *w_up, *conv_w, *conv_b, *w_down, *normf, *w_ada_f, *b_ada_f;
    float* out; unsigned char* ws;
};

__device__ __forceinline__ void transpose_item(const float* W, int K, int N, bf16* WT, int dst_row0, int k0, int n0, LAS float* scr, int lane) {
#pragma unroll 8
    for (int i = 0; i < 32; ++i) { const int kk = 2 * i + (lane >> 5); scr[kk * 33 + (lane & 31)] = W[(size_t)(k0 + kk) * N + n0 + (lane & 31)]; }
    LDS_WAIT(); asm volatile("" ::: "memory");
    const int c = lane & 7;
#pragma unroll
    for (int j = 0; j < 4; ++j) { const int n = (lane >> 3) + 8 * j; const LAS float* s = scr + (8 * c) * 33 + n;
        u32x4 o; o.x = pk2(s[0 * 33], s[1 * 33]); o.y = pk2(s[2 * 33], s[3 * 33]); o.z = pk2(s[4 * 33], s[5 * 33]); o.w = pk2(s[6 * 33], s[7 * 33]);
        *(u32x4*)(WT + (size_t)(dst_row0 + n) * K + k0 + 8 * c) = o; }
    LDS_WAIT(); asm volatile("" ::: "memory");
}
__device__ __forceinline__ void mod_item(const Params& P, int it, LAS float* scr, int lane) {
    const int ct = it >> 2, ks = it & 3, c0 = ct * 64;
    const float* W; const float* bias; int ldw;
    if (c0 < 6144) { W = P.w_ada + c0; bias = P.b_ada + c0; ldw = 6144; } else { W = P.w_ada_f + (c0 - 6144); bias = P.b_ada_f + (c0 - 6144); ldw = 2048; }
    float acc[64];
#pragma unroll
    for (int r = 0; r < 64; ++r) acc[r] = 0.f;
    const float* crow = (lane < 32 ? P.c_p + (size_t)lane * DM : P.c_s + (size_t)(lane - 32) * DM) + ks * 256;
    for (int kc = 0; kc < 8; ++kc) {
#pragma unroll
        for (int q = 0; q < 8; ++q) { f32x4 v = *(const f32x4*)(crow + kc * 32 + 4 * q);
            v.x = silu_f(v.x); v.y = silu_f(v.y); v.z = silu_f(v.z); v.w = silu_f(v.w);
            *(LAS f32x4*)(scr + lane * 36 + 4 * q) = v; }
        LDS_WAIT(); asm volatile("" ::: "memory");
        const float* wk = W + (size_t)(ks * 256 + kc * 32) * ldw + lane;
        for (int k4 = 0; k4 < 8; ++k4) {
            const float w0 = wk[(size_t)(4 * k4 + 0) * ldw], w1 = wk[(size_t)(4 * k4 + 1) * ldw], w2 = wk[(size_t)(4 * k4 + 2) * ldw], w3 = wk[(size_t)(4 * k4 + 3) * ldw];
#pragma unroll
            for (int r = 0; r < 64; ++r) { const f32x4 s = *(const LAS f32x4*)(scr + r * 36 + 4 * k4); acc[r] += (s.x * w0 + s.y * w1) + (s.z * w2 + s.w * w3); }
        }
        LDS_WAIT(); asm volatile("" ::: "memory");
    }
    float* dst = (float*)(P.ws + WS_MODP) + (size_t)ks * 64 * 8192 + c0 + lane;
    const float bv = (ks == 0) ? bias[lane] : 0.f;
#pragma unroll
    for (int r = 0; r < 64; ++r) dst[(size_t)r * 8192] = acc[r] + bv;
}
__device__ __forceinline__ void phase0(const Params& P, LAS unsigned char* lds, int wave, int lane) {
    LAS float* scr = (LAS float*)(lds + wave * 16384);
    const int gw = blockIdx.x * 8 + wave, NGW = gridDim.x * 8;
    constexpr int I_MOD = 512, I_IN = 16 * 88, I_UP = 16 * 176, I_OUT = 16 * 32, I_DN = 44 * 32;
    constexpr int NIT = I_MOD + I_IN + I_UP + I_OUT + I_DN;
    for (int it = gw; it < NIT; it += NGW) {
        int r = it;
        if (r < I_MOD) { mod_item(P, r, scr, lane); continue; } r -= I_MOD;
        if (r < I_IN) { const int kb = r / 88, nb = r % 88; transpose_item(P.w_in, DM, INW, (bf16*)(P.ws + WS_WIN), nb * 32, kb * 64, nb * 32, scr, lane); continue; } r -= I_IN;
        if (r < I_UP) { const int kb = r / 176, nb = r % 176, n0 = nb * 32, isb = n0 >= DFF, j0 = n0 - isb * DFF;
            transpose_item(P.w_up, DM, 2 * DFF, (bf16*)(P.ws + WS_WUP), 256 * (j0 >> 7) + 128 * isb + (j0 & 127), kb * 64, n0, scr, lane); continue; } r -= I_UP;
        if (r < I_OUT) { const int kb = r / 32, nb = r % 32; transpose_item(P.w_out, DM, DM, (bf16*)(P.ws + WS_WOUT), nb * 32, kb * 64, nb * 32, scr, lane); continue; } r -= I_OUT;
        { const int kb = r / 32, nb = r % 32; transpose_item(P.w_down, DFF, DM, (bf16*)(P.ws + WS_WDN), nb * 32, kb * 64, nb * 32, scr, lane); }
    }
}

__device__ __forceinline__ void phase1(const Params& P, LAS unsigned char* lds, int tid, int wave, int lane) {
    const float* modp = (const float*)(P.ws + WS_MODP);
    float* mod = (float*)(P.ws + WS_MOD);
    bf16* H1 = (bf16*)(P.ws + WS_R0);
    for (int idx = blockIdx.x * 512 + tid; idx < 64 * 8192; idx += gridDim.x * 512) {
        const float s = (modp[idx] + modp[idx + 524288]) + (modp[idx + 2 * 524288] + modp[idx + 3 * 524288]);
        mod[idx] = s;
        const int col = idx & 8191, bs = idx >> 13;
        if (col >= 3072 && col < 4096) H1[(size_t)(MT + bs) * DM + (col - 3072)] = (bf16)(pk2(s, 0.f) & 0xffffu);
    }
    LAS float* lv = (LAS float*)lds;
    for (int g = blockIdx.x; g < NGRP; g += gridDim.x) {
        const int bs = grp_bs(g);
        __syncthreads();
        for (int i = tid; i < 2048; i += 512) { const int which = i >> 10, col = i & 1023; const size_t o = (size_t)bs * 8192 + which * 1024 + col;
            float s = (modp[o] + modp[o + 524288]) + (modp[o + 2 * 524288] + modp[o + 3 * 524288]);
            if (which) s = P.ln1[col] * (1.f + s);
            lv[i] = s; }
        __syncthreads();
#pragma unroll 2
        for (int i = 0; i < 8; ++i) {
            const int row = g * 64 + wave * 8 + i;
            const float* xr = (row < MP ? P.x_p + (size_t)row * DM : P.x_s + (size_t)(row - MP) * DM) + 4 * lane;
            f32x4 v[4]; float ss = 0.f;
#pragma unroll
            for (int j = 0; j < 4; ++j) { v[j] = *(const f32x4*)(xr + 256 * j); ss += (v[j].x * v[j].x + v[j].y * v[j].y) + (v[j].z * v[j].z + v[j].w * v[j].w); }
            const float rstd = rsqrtf(wave_sum(ss) * (1.f / DM) + EPS);
            bf16* hr = H1 + (size_t)row * DM + 4 * lane;
#pragma unroll
            for (int j = 0; j < 4; ++j) { const f32x4 sh = *(const LAS f32x4*)(lv + 256 * j + 4 * lane), gs = *(const LAS f32x4*)(lv + 1024 + 256 * j + 4 * lane);
                const f32x4 h = v[j] * rstd * gs + sh; u32x2 w; w.x = pk2(h.x, h.y); w.y = pk2(h.z, h.w); *(u32x2*)(hr + 256 * j) = w; }
        }
    }
}

struct OrderX {
    pg8::StaticOrder S; int nX, xpm, xpn0;
    __device__ __forceinline__ bool next(int i, pg8::Unit& u) const {
        const long L = (long)i * S.G + S.c;
        int pm = 0, pn = 0; bool ok = false;
        if (L < S.nwg) { pg8::Unit t; t.pm = 0; t.pn = 0; t.seq = 0; (void)S.next(i, t); pm = t.pm; pn = t.pn; ok = true; }
        else if (L < S.nwg + nX) { pm = xpm; pn = xpn0 + (int)(L - S.nwg); ok = true; }
        u.pm = pm; u.pn = pn; u.seq = i;
        return ok;
    }
    __device__ __forceinline__ void a_ready(const pg8::Unit&) const {}
    __device__ __forceinline__ void done(const pg8::Unit&) const {}
};
struct OrderPub : pg8::StaticOrder {
    unsigned* cnt;
    __device__ __forceinline__ void done(const pg8::Unit& u) const {
        asm volatile("s_waitcnt vmcnt(0)" ::: "memory");
        if ((threadIdx.x & 63) == 0) __hip_atomic_fetch_add(cnt + 64 * u.pm, 1u, __ATOMIC_RELAXED, __HIP_MEMORY_SCOPE_AGENT);
    }
};
typedef const f32x4 (&AccRef)[2][2][4][2];
struct Epi1 {
    static constexpr bool PERM = true, AFTER_DRAIN = false;
    bf16* proj; float* shw; float* out;
    __device__ __forceinline__ void operator()(AccRef acc, const pg8::Unit& u, int wr, int wc, int fr, int fq) const {
        if (u.pm == NTM) {
            if (wr == 0) {
#pragma unroll
                for (int m = 0; m < 4; ++m) { float* d = shw + (size_t)(16 * m + fr) * (2 * DFF) + 256 * (u.pn - 11) + 32 * wc + 8 * fq;
#pragma unroll
                    for (int bj = 0; bj < 2; ++bj)
#pragma unroll
                        for (int n = 0; n < 2; ++n) *(f32x4*)(d + 128 * bj + 4 * n) = acc[0][bj][m][n]; }
            }
            return;
        }
        const unsigned row0 = u.pm * 256 + wr * 64 + fr, col0 = u.pn * 256 + wc * 32 + 8 * fq;
#pragma unroll
        for (int ai = 0; ai < 2; ++ai)
#pragma unroll
            for (int m = 0; m < 4; ++m) { const unsigned o = (row0 + 128 * ai + 16 * m) * (unsigned)INW + col0;
#pragma unroll
                for (int bj = 0; bj < 2; ++bj) { const f32x4 v0 = acc[ai][bj][m][0], v1 = acc[ai][bj][m][1];
                    u32x4 w; w.x = pk2(v0[0], v0[1]); w.y = pk2(v0[2], v0[3]); w.z = pk2(v1[0], v1[1]); w.w = pk2(v1[2], v1[3]);
                    *(u32x4*)(proj + (o + 128 * bj)) = w; }
                asm volatile("" ::: "memory"); }
        if (u.pn == 10) {
            const unsigned c = 32 * wc + 8 * fq;
#pragma unroll
            for (int ai = 0; ai < 2; ++ai)
#pragma unroll
                for (int m = 0; m < 4; ++m) { const unsigned row = row0 + 128 * ai + 16 * m; unsigned ok, ov;
                    if (row < (unsigned)MP) { const unsigned t = row & 2047; if (t < SEQ - 128) continue; const unsigned o = ((row >> 11) * 128 + (t - (SEQ - 128))) * 128 + c; ok = (unsigned)OFF_PK + o; ov = (unsigned)OFF_PV + o; }
                    else { const unsigned o = (row - MP) * 128 + c; ok = (unsigned)OFF_SK + o; ov = (unsigned)OFF_SV + o; }
                    *(f32x4*)(out + ok) = acc[ai][0][m][0]; *(f32x4*)(out + ok + 4) = acc[ai][0][m][1];
                    *(f32x4*)(out + ov) = acc[ai][1][m][0]; *(f32x4*)(out + ov + 4) = acc[ai][1][m][1];
                    asm volatile("" ::: "memory"); }
        }
    }
};
struct Epi2 {
    static constexpr bool PERM = true, AFTER_DRAIN = false;
    const float *xp, *xs, *mod, *ln2; bf16* x1; bf16* a2; float* ss;
    __device__ __forceinline__ void operator()(AccRef acc, const pg8::Unit& u, int wr, int wc, int fr, int fq) const {
        const int col0 = u.pn * 256 + wc * 32 + 8 * fq;
#pragma unroll
        for (int ai = 0; ai < 2; ++ai) {
            const int bs = grp_bs(4 * u.pm + 2 * ai + wr);
            const float* mb = mod + (size_t)bs * 8192;
            f32x4 g1v[2][2], gsv[2][2];
#pragma unroll
            for (int bj = 0; bj < 2; ++bj)
#pragma unroll
                for (int n = 0; n < 2; ++n) { const int c = col0 + 128 * bj + 4 * n; g1v[bj][n] = *(const f32x4*)(mb + 2048 + c);
                    gsv[bj][n] = *(const f32x4*)(ln2 + c) * (*(const f32x4*)(mb + 4096 + c) + 1.0f); }
#pragma unroll
            for (int m = 0; m < 4; ++m) {
                const int row = u.pm * 256 + 128 * ai + 64 * wr + 16 * m + fr;
                const float* xr = row < MP ? xp + (size_t)row * DM : xs + (size_t)(row - MP) * DM;
                float s = 0.f;
#pragma unroll
                for (int bj = 0; bj < 2; ++bj) { f32x4 a[2]; f32x4 xb[2];
#pragma unroll
                    for (int n = 0; n < 2; ++n) { const int c = col0 + 128 * bj + 4 * n; const f32x4 xv = *(const f32x4*)(xr + c); const f32x4 v = xv + g1v[bj][n] * acc[ai][bj][m][n];
                        xb[n] = v; s += (v.x * v.x + v.y * v.y) + (v.z * v.z + v.w * v.w); a[n] = v * gsv[bj][n]; }
                    u32x4 w; w.x = pk2(a[0].x, a[0].y); w.y = pk2(a[0].z, a[0].w); w.z = pk2(a[1].x, a[1].y); w.w = pk2(a[1].z, a[1].w);
                    *(u32x4*)(a2 + (size_t)row * DM + col0 + 128 * bj) = w;
                    w.x = pk2(xb[0].x, xb[0].y); w.y = pk2(xb[0].z, xb[0].w); w.z = pk2(xb[1].x, xb[1].y); w.w = pk2(xb[1].z, xb[1].w);
                    *(u32x4*)(x1 + (size_t)row * DM + col0 + 128 * bj) = w; }
                s += __shfl_xor(s, 16); s += __shfl_xor(s, 32);
                if (fq == 0) ss[(size_t)row * 16 + 4 * u.pn + wc] = s;
            }
        }
    }
};
struct Epi3 {
    static constexpr bool PERM = true, AFTER_DRAIN = false;
    const LAS float* rtab; const float* shw; bf16 *ua, *ub; float* out;
    __device__ __forceinline__ void operator()(AccRef acc, const pg8::Unit& u, int wr, int wc, int fr, int fq) const {
        const unsigned j0 = u.pn * 128 + wc * 32 + 8 * fq, pc0 = u.pn * 256 + wc * 32 + 8 * fq;
#pragma unroll
        for (int ai = 0; ai < 2; ++ai) {
            const unsigned grp = 4 * u.pm + 2 * ai + wr, bs = grp_bs((int)grp);
            const unsigned so = bs * (2 * DFF) + pc0;
            const f32x4 sa0 = *(const f32x4*)(shw + so), sa1 = *(const f32x4*)(shw + so + 4), sb0 = *(const f32x4*)(shw + so + 128), sb1 = *(const f32x4*)(shw + so + 132);
#pragma unroll
            for (int m = 0; m < 4; ++m) {
                const float rstd = rtab[u.seq * 256 + 128 * ai + 64 * wr + 16 * m + fr];
                const unsigned row = grp * 64 + 16 * m + fr;
                const f32x4 a0 = acc[ai][0][m][0] * rstd + sa0, a1 = acc[ai][0][m][1] * rstd + sa1, b0 = acc[ai][1][m][0] * rstd + sb0, b1 = acc[ai][1][m][1] * rstd + sb1;
                u32x4 w; w.x = pk2(a0[0], a0[1]); w.y = pk2(a0[2], a0[3]); w.z = pk2(a1[0], a1[1]); w.w = pk2(a1[2], a1[3]);
                *(u32x4*)(ua + (row * (unsigned)DFF + j0)) = w;
                w.x = pk2(b0[0], b0[1]); w.y = pk2(b0[2], b0[3]); w.z = pk2(b1[0], b1[1]); w.w = pk2(b1[2], b1[3]);
                *(u32x4*)(ub + (row * (unsigned)DFF + j0)) = w;
                if (m == 3 && fr >= 14) {
                    if (grp >= 1024) { float* d = out + OFF_SCONV + ((size_t)(grp - 1024) * 2 + (fr - 14)) * DFF + j0; *(f32x4*)d = a0; *(f32x4*)(d + 4) = a1; }
                    else if ((grp & 31) == 31) { float* d = out + OFF_PCONV + ((size_t)(grp >> 5) * 2 + (fr - 14)) * DFF + j0; *(f32x4*)d = a0; *(f32x4*)(d + 4) = a1; }
                }
            }
        }
    }
};
#ifdef CONV_FUSED
struct Epi3C {
    static constexpr bool PERM = true, AFTER_DRAIN = false;
    const LAS float* rtab; const float *shw, *cw, *cb; bf16* act; float *headA, *headB, *tailA;
    __device__ __forceinline__ void operator()(AccRef acc, const pg8::Unit& u, int wr, int wc, int fr, int fq) const {
        const unsigned j0 = u.pn * 128 + wc * 32 + 8 * fq, pc0 = u.pn * 256 + wc * 32 + 8 * fq;
        f32x4 w0[2], w1[2], w2[2], cbv[2];
#pragma unroll
        for (int n = 0; n < 2; ++n) { w0[n] = *(const f32x4*)(cw + j0 + 4 * n); w1[n] = *(const f32x4*)(cw + DFF + j0 + 4 * n); w2[n] = *(const f32x4*)(cw + 2 * DFF + j0 + 4 * n); cbv[n] = *(const f32x4*)(cb + j0 + 4 * n); }
#pragma unroll
        for (int ai = 0; ai < 2; ++ai) {
            asm volatile("" ::: "memory");
            const unsigned grp = 4 * u.pm + 2 * ai + wr, bs = grp_bs((int)grp);
            const unsigned so = bs * (2 * DFF) + pc0, ho = (grp * 2 + (fr & 1)) * DFF + j0;
            u32x2 ap[4][2], bp[4][2];
            {
                f32x4 sa[2], sb[2];
#pragma unroll
                for (int n = 0; n < 2; ++n) { sa[n] = *(const f32x4*)(shw + so + 4 * n); sb[n] = *(const f32x4*)(shw + so + 128 + 4 * n); }
#pragma unroll
                for (int m = 0; m < 4; ++m) {
                    const float rs = rtab[u.seq * 256 + 128 * ai + 64 * wr + 16 * m + fr];
#pragma unroll
                    for (int n = 0; n < 2; ++n) {
                        const f32x4 av = acc[ai][0][m][n] * rs + sa[n], bv = acc[ai][1][m][n] * rs + sb[n];
                        if (m == 0) { if (fr < 2) { *(f32x4*)(headA + ho + 4 * n) = av; *(f32x4*)(headB + ho + 4 * n) = bv; } }
                        if (m == 3) { if (fr >= 14) *(f32x4*)(tailA + ho + 4 * n) = av; }
                        ap[m][n].x = pk2(av.x, av.y); ap[m][n].y = pk2(av.z, av.w); bp[m][n].x = pk2(bv.x, bv.y); bp[m][n].y = pk2(bv.z, bv.w);
                    }
                }
            }
            asm volatile("" ::: "memory");
#pragma unroll
            for (int n = 0; n < 2; ++n)
#pragma unroll
                for (int h = 0; h < 2; ++h) {
                    unsigned q1 = 0u, q2 = 0u;
#pragma unroll
                    for (int m = 0; m < 4; ++m) {
                        const unsigned a = ap[m][n][h];
                        const unsigned s1 = (unsigned)__builtin_amdgcn_update_dpp((int)a, (int)a, 0x121, 0xf, 0xf, false);
                        const unsigned s2 = (unsigned)__builtin_amdgcn_update_dpp((int)a, (int)a, 0x122, 0xf, 0xf, false);
                        const unsigned pr1 = fr >= 1 ? s1 : q1, pr2 = fr >= 2 ? s2 : q2;
                        q1 = s1; q2 = s2;
                        const float c0 = cbv[n][2 * h] + w0[n][2 * h] * bflo(pr2) + w1[n][2 * h] * bflo(pr1) + w2[n][2 * h] * bflo(a);
                        const float c1 = cbv[n][2 * h + 1] + w0[n][2 * h + 1] * bfhi(pr2) + w1[n][2 * h + 1] * bfhi(pr1) + w2[n][2 * h + 1] * bfhi(a);
                        const unsigned bw = bp[m][n][h];
                        bp[m][n][h] = pk2(silu_f(c0) * bflo(bw), silu_f(c1) * bfhi(bw));
                    }
                    __builtin_amdgcn_sched_barrier(0);
                }
            asm volatile("" ::: "memory");
#pragma unroll
            for (int m = 0; m < 4; ++m) {
                if (m == 0 && fr < 2) continue;
                const unsigned row = grp * 64 + 16 * m + fr;
                const u32x4 w = (u32x4){bp[m][0].x, bp[m][0].y, bp[m][1].x, bp[m][1].y};
                *(u32x4*)(act + (row * (unsigned)DFF + j0)) = w;
            }
        }
    }
};
#endif
struct Epi4 {
    static constexpr bool PERM = true, AFTER_DRAIN = false;
    const float* mod; const bf16* x1; bf16* x2;
    __device__ __forceinline__ void operator()(AccRef acc, const pg8::Unit& u, int wr, int wc, int fr, int fq) const {
        const int col0 = u.pn * 256 + wc * 32 + 8 * fq;
#pragma unroll
        for (int ai = 0; ai < 2; ++ai) {
            const int bs = grp_bs(4 * u.pm + 2 * ai + wr);
            const float* mb = mod + (size_t)bs * 8192 + 5120;
            f32x4 g2v[2][2];
#pragma unroll
            for (int bj = 0; bj < 2; ++bj)
#pragma unroll
                for (int n = 0; n < 2; ++n) g2v[bj][n] = *(const f32x4*)(mb + col0 + 128 * bj + 4 * n);
#pragma unroll
            for (int m = 0; m < 4; ++m) {
                const unsigned ro = (unsigned)(u.pm * 256 + 128 * ai + 64 * wr + 16 * m + fr) * DM + col0;
#pragma unroll
                for (int bj = 0; bj < 2; ++bj) { const u32x4 xw = *(const u32x4*)(x1 + ro + 128 * bj);
                    const f32x4 v0 = (f32x4){bflo(xw.x), bfhi(xw.x), bflo(xw.y), bfhi(xw.y)} + g2v[bj][0] * acc[ai][bj][m][0];
                    const f32x4 v1 = (f32x4){bflo(xw.z), bfhi(xw.z), bflo(xw.w), bfhi(xw.w)} + g2v[bj][1] * acc[ai][bj][m][1];
                    u32x4 w; w.x = pk2(v0.x, v0.y); w.y = pk2(v0.z, v0.w); w.z = pk2(v1.x, v1.y); w.w = pk2(v1.z, v1.w);
                    *(u32x4*)(x2 + ro + 128 * bj) = w; }
            }
        }
    }
};
#define GAS __attribute__((address_space(1)))
#define RLX_AGENT __ATOMIC_RELAXED, __HIP_MEMORY_SCOPE_AGENT
#define XB_TMO      128
#define XB_XCNT(j)  (256  + 64 * (j))
#define XB_XSUB(j)  (1280 + 64 * (j))
#define XB_XGEN(j)  (2304 + 64 * (j))
#define XB_TOP      3328
#define XB_TOPGEN   3392
#define XCD_BAR_WORDS 3456
#define XB_SPIN_CAP (1u << 18)

__device__ __forceinline__ unsigned xb_ld(unsigned* p)              { return __hip_atomic_load(p, __ATOMIC_RELAXED, __HIP_MEMORY_SCOPE_AGENT); }
__device__ __forceinline__ unsigned xb_add(unsigned* p, unsigned v) { return __hip_atomic_fetch_add(p, v, __ATOMIC_RELAXED, __HIP_MEMORY_SCOPE_AGENT); }
__device__ __forceinline__ unsigned xb_xcc_id() { return (unsigned)__builtin_amdgcn_s_getreg((3 << 11) | 20) & 0xFu; }
#define XB_SPIN(cond, bar) do { unsigned _sp = 0; while (cond) { __builtin_amdgcn_s_sleep(1); \
    if ((++_sp & 255u) == 0u) { if (xb_ld(&(bar)[XB_TMO])) break; if (_sp > XB_SPIN_CAP) { atomicAdd(&(bar)[XB_TMO], 1u); break; } } } } while (0)

struct XcdBarrier {
    unsigned* bar; unsigned x;
    volatile LAS unsigned* st;
};

__device__ __forceinline__ XcdBarrier xcd_barrier_post(unsigned* bar, volatile LAS unsigned* st) {
    XcdBarrier b; b.bar = bar; b.x = xb_xcc_id(); b.st = st;
    if (threadIdx.x == 0) (void)xb_add(&bar[XB_XCNT(b.x)], 1u);
    return b;
}
__device__ __forceinline__ void xcd_barrier_complete(unsigned* bar, unsigned x, unsigned& nloc, unsigned& nx) {
    const unsigned G = gridDim.x * gridDim.y * gridDim.z;
    unsigned sum, cnt, mine, sp = 0u;
    for (;;) {
        sum = 0u; cnt = 0u; mine = 0u;
#pragma unroll
        for (unsigned j = 0; j < 16; ++j) { const unsigned c = xb_ld(&bar[XB_XCNT(j)]); sum += c; cnt += (c > 0u) ? 1u : 0u; mine = (j == x) ? c : mine; }
        if (sum == G) break;
        __builtin_amdgcn_s_sleep(1);
        if ((++sp & 255u) == 0u) { if (xb_ld(&bar[XB_TMO])) break; if (sp > XB_SPIN_CAP) { atomicAdd(&bar[XB_TMO], 1u); break; } }
    }
    nloc = mine > 0u ? mine : 1u; nx = cnt > 0u ? cnt : 1u;
}

__device__ __forceinline__ void xcd_barrier(const XcdBarrier& b) {
    asm volatile("s_waitcnt vmcnt(0)" ::: "memory");
    __syncthreads();
    if (threadIdx.x == 0) {
        unsigned* bar = b.bar;
        __builtin_amdgcn_s_waitcnt(0);
        unsigned nloc = b.st[0], nx = b.st[1];
        if (nloc == 0u) { xcd_barrier_complete(bar, b.x, nloc, nx); b.st[0] = nloc; b.st[1] = nx; }
        const unsigned old = xb_add(&bar[XB_XSUB(b.x)], 1u);
        const unsigned gen = old / nloc;
        if (old + 1u == (gen + 1u) * nloc) {
            __builtin_amdgcn_fence(__ATOMIC_RELEASE, "agent");
            asm volatile("s_waitcnt vmcnt(0)" ::: "memory");
            const unsigned og = xb_add(&bar[XB_TOP], 1u);
            const unsigned tg = og / nx;
            if (og + 1u == (tg + 1u) * nx) xb_add(&bar[XB_TOPGEN], 1u);
            else XB_SPIN(xb_ld(&bar[XB_TOPGEN]) == tg, bar);
            __builtin_amdgcn_fence(__ATOMIC_ACQUIRE, "agent");
            xb_add(&bar[XB_XGEN(b.x)], 1u);
            asm volatile("s_waitcnt vmcnt(0)" ::: "memory");
        } else {
            XB_SPIN(xb_ld(&bar[XB_XGEN(b.x)]) == gen, bar);
            __builtin_amdgcn_fence(__ATOMIC_ACQUIRE, "agent");
            asm volatile("s_waitcnt vmcnt(0)" ::: "memory");
        }
    }
    __syncthreads();
}
#define MFMA16(a, b, c) __builtin_amdgcn_mfma_f32_16x16x32_bf16((a), (b), (c), 0, 0, 0)
constexpr int RQ = 0, RK = 17408, RKT = 34816, RVT = 53248, RP = 71680, RST = 80896, RO = 115712;
__device__ __forceinline__ void ret_item(const Params& P, LAS unsigned char* lds, int tid, int wave, int lane, int h, int row0, int nchunks, const float* st_in, bool has_in, float* st_out) {
    const bf16* proj = (const bf16*)(P.ws + WS_R1);
    bf16* mix = (bf16*)(P.ws + WS_R2);
    const int fr = lane & 15, fq = lane >> 4;
    const float lg2 = log2f(1.0f - exp2f(-5.0f - (float)h));
    const float kscale = 0.08838834764831845f;
    LAS bf16* Qs = (LAS bf16*)(lds + RQ); LAS bf16* Ks = (LAS bf16*)(lds + RK); LAS bf16* KT = (LAS bf16*)(lds + RKT); LAS bf16* VT = (LAS bf16*)(lds + RVT);
    LAS bf16* Ps = (LAS bf16*)(lds + RP); LAS bf16* ST = (LAS bf16*)(lds + RST); LAS float* Os = (LAS float*)(lds + RO);
    f32x4 st[8];
#pragma unroll
    for (int et = 0; et < 8; ++et) {
        f32x4 v;
#pragma unroll
        for (int r = 0; r < 4; ++r) v[r] = st_in[(size_t)(16 * wave + 4 * fq + r) * 128 + 16 * et + fr];
        asm volatile("" : "+v"(v));
#pragma unroll
        for (int r = 0; r < 4; ++r) v[r] = has_in ? v[r] : 0.f;
        st[et] = v;
    }
    __syncthreads();
#pragma unroll
    for (int et = 0; et < 8; ++et) { u32x2 w; w.x = pk2(st[et][0], st[et][1]); w.y = pk2(st[et][2], st[et][3]); *(LAS u32x2*)(ST + (16 * et + fr) * 136 + 16 * wave + 4 * fq) = w; }
    const size_t goff = (size_t)lane * INW + h * 128 + wave * 16;
    u32x4 pq[2], pk[2], pv[2];
    { const bf16* g = proj + (size_t)row0 * INW + goff;
      pq[0] = *(const u32x4*)(g); pq[1] = *(const u32x4*)(g + 8); pk[0] = *(const u32x4*)(g + 512); pk[1] = *(const u32x4*)(g + 520); pv[0] = *(const u32x4*)(g + 1024); pv[1] = *(const u32x4*)(g + 1032); }
    const float kf = kscale * exp2f(lg2 * (float)(63 - lane));
    const float g64 = exp2f(lg2 * 64.0f);
    for (int c = 0; c < nchunks; ++c) {
        const int rowc = row0 + 64 * c;
        *(LAS u32x4*)(Qs + lane * 136 + wave * 16) = pq[0]; *(LAS u32x4*)(Qs + lane * 136 + wave * 16 + 8) = pq[1];
        *(LAS u32x4*)(Ks + lane * 136 + wave * 16) = pk[0]; *(LAS u32x4*)(Ks + lane * 136 + wave * 16 + 8) = pk[1];
#pragma unroll
        for (int i = 0; i < 2; ++i)
#pragma unroll
            for (int j = 0; j < 4; ++j) { const unsigned wk = pk[i][j], wv = pv[i][j]; const int d = wave * 16 + i * 8 + j * 2;
                const unsigned kk = pk2(bflo(wk) * kf, bfhi(wk) * kf);
                KT[(d) * 72 + lane] = (bf16)(kk & 0xffffu); KT[(d + 1) * 72 + lane] = (bf16)(kk >> 16);
                VT[(d) * 72 + lane] = (bf16)(wv & 0xffffu); VT[(d + 1) * 72 + lane] = (bf16)(wv >> 16); }
        if (c + 1 < nchunks) { const bf16* g = proj + (size_t)(rowc + 64) * INW + goff;
            pq[0] = *(const u32x4*)(g); pq[1] = *(const u32x4*)(g + 8); pk[0] = *(const u32x4*)(g + 512); pk[1] = *(const u32x4*)(g + 520); pv[0] = *(const u32x4*)(g + 1024); pv[1] = *(const u32x4*)(g + 1032); }
        __syncthreads();
        { const int mi = wave >> 1;
#pragma unroll
          for (int jj = 0; jj < 2; ++jj) { const int lj = 2 * (wave & 1) + jj; f32x4 s = (f32x4){0.f, 0.f, 0.f, 0.f};
#pragma unroll
            for (int ks = 0; ks < 4; ++ks) { const bf16x8 a = *(const LAS bf16x8*)(Ks + (16 * mi + fr) * 136 + 32 * ks + 8 * fq), b = *(const LAS bf16x8*)(Qs + (16 * lj + fr) * 136 + 32 * ks + 8 * fq); s = MFMA16(a, b, s); }
            const int l = 16 * lj + fr; float pvv[4];
#pragma unroll
            for (int r = 0; r < 4; ++r) { const int m = 16 * mi + 4 * fq + r; const int dlt = l - m; pvv[r] = dlt >= 0 ? s[r] * kscale * exp2f(lg2 * (float)dlt) : 0.f; }
            u32x2 w; w.x = pk2(pvv[0], pvv[1]); w.y = pk2(pvv[2], pvv[3]); *(LAS u32x2*)(Ps + l * 72 + 16 * mi + 4 * fq) = w; } }
#pragma unroll
        for (int et = 0; et < 8; ++et) st[et] = st[et] * g64;
#pragma unroll
        for (int ks = 0; ks < 2; ++ks) { const bf16x8 a = *(const LAS bf16x8*)(KT + (16 * wave + fr) * 72 + 32 * ks + 8 * fq);
#pragma unroll
            for (int et = 0; et < 8; ++et) { const bf16x8 b = *(const LAS bf16x8*)(VT + (16 * et + fr) * 72 + 32 * ks + 8 * fq); st[et] = MFMA16(a, b, st[et]); } }
        __syncthreads();
        { f32x4 oi[4], oc[4];
#pragma unroll
          for (int lt = 0; lt < 4; ++lt) { oi[lt] = (f32x4){0.f, 0.f, 0.f, 0.f}; oc[lt] = (f32x4){0.f, 0.f, 0.f, 0.f}; }
#pragma unroll
          for (int ks = 0; ks < 2; ++ks) { const bf16x8 b = *(const LAS bf16x8*)(VT + (16 * wave + fr) * 72 + 32 * ks + 8 * fq);
#pragma unroll
            for (int lt = 0; lt < 4; ++lt) { const bf16x8 a = *(const LAS bf16x8*)(Ps + (16 * lt + fr) * 72 + 32 * ks + 8 * fq); oi[lt] = MFMA16(a, b, oi[lt]); } }
#pragma unroll
          for (int ks = 0; ks < 4; ++ks) { const bf16x8 b = *(const LAS bf16x8*)(ST + (16 * wave + fr) * 136 + 32 * ks + 8 * fq);
#pragma unroll
            for (int lt = 0; lt < 4; ++lt) { const bf16x8 a = *(const LAS bf16x8*)(Qs + (16 * lt + fr) * 136 + 32 * ks + 8 * fq); oc[lt] = MFMA16(a, b, oc[lt]); } }
#pragma unroll
          for (int lt = 0; lt < 4; ++lt)
#pragma unroll
            for (int r = 0; r < 4; ++r) { const int l = 16 * lt + 4 * fq + r; Os[l * 132 + 16 * wave + fr] = oi[lt][r] + exp2f(lg2 * (float)(l + 1)) * oc[lt][r]; } }
        __syncthreads();
#pragma unroll
        for (int et = 0; et < 8; ++et) { u32x2 w; w.x = pk2(st[et][0], st[et][1]); w.y = pk2(st[et][2], st[et][3]); *(LAS u32x2*)(ST + (16 * et + fr) * 136 + 16 * wave + 4 * fq) = w; }
        { unsigned gv[8];
#pragma unroll
          for (int i = 0; i < 8; ++i) gv[i] = *(const unsigned*)(proj + (size_t)(rowc + 8 * wave + i) * INW + 1536 + h * 128 + 2 * lane);
#pragma unroll
          for (int i = 0; i < 8; ++i) { const int l = 8 * wave + i; const f32x2 o = *(const LAS f32x2*)(Os + l * 132 + 2 * lane);
            const float ssq = wave_sum_dpp(o.x * o.x + o.y * o.y); const float rstd = rsqrtf(ssq * (1.f / 128.f) + EPS);
            const float g0 = bflo(gv[i]), g1 = bfhi(gv[i]);
            *(unsigned*)(mix + (size_t)(rowc + l) * DM + h * 128 + 2 * lane) = pk2(silu_f(g0) * o.x * rstd, silu_f(g1) * o.y * rstd); } }
    }
#pragma unroll
    for (int et = 0; et < 8; ++et)
#pragma unroll
        for (int r = 0; r < 4; ++r) st_out[(size_t)(16 * wave + 4 * fq + r) * 128 + 16 * et + fr] = st[et][r];
}
constexpr int AK = 0, AVT = 27648;
__device__ __forceinline__ void att_item(const Params& P, LAS unsigned char* lds, int tid, int wave, int lane, bool sample, int b, int n, int g) {
    const bf16* proj = (const bf16*)(P.ws + WS_R1);
    bf16* mix = (bf16*)(P.ws + WS_R2);
    const int fr = lane & 15, fq = lane >> 4;
    LAS bf16* Kl = (LAS bf16*)(lds + AK); LAS bf16* VTl = (LAS bf16*)(lds + AVT);
    const int qrow0 = sample ? MP + 64 * b : b * SEQ + 64 * n;
    const int jmin = sample ? 0 : (n >= 2 ? 0 : 64 * (2 - n));
    __syncthreads();
#pragma unroll
    for (int i = 0; i < 3; ++i) { const int p = tid + 512 * i, j = p >> 3, c8 = p & 7; u32x4 w = (u32x4){0u, 0u, 0u, 0u};
        if (j >= jmin) {
            if (sample && j < 128) { const float* s = P.cache_k + ((size_t)(b * 128 + j) * 2 + g) * 64 + 8 * c8; const f32x4 a = *(const f32x4*)s, bb = *(const f32x4*)(s + 4);
                w.x = pk2(a.x, a.y); w.y = pk2(a.z, a.w); w.z = pk2(bb.x, bb.y); w.w = pk2(bb.z, bb.w); }
            else { const int row = sample ? MP + 64 * b + (j - 128) : b * SEQ + 64 * (n - 2) + j; w = *(const u32x4*)(proj + (size_t)row * INW + 2560 + g * 64 + 8 * c8); } }
        *(LAS u32x4*)(Kl + j * 72 + 8 * c8) = w; }
#pragma unroll
    for (int i = 0; i < 3; ++i) { const int j = 64 * i + lane; u32x4 w = (u32x4){0u, 0u, 0u, 0u};
        if (j >= jmin) {
            if (sample && j < 128) { const float* s = P.cache_v + ((size_t)(b * 128 + j) * 2 + g) * 64 + 8 * wave; const f32x4 a = *(const f32x4*)s, bb = *(const f32x4*)(s + 4);
                w.x = pk2(a.x, a.y); w.y = pk2(a.z, a.w); w.z = pk2(bb.x, bb.y); w.w = pk2(bb.z, bb.w); }
            else { const int row = sample ? MP + 64 * b + (j - 128) : b * SEQ + 64 * (n - 2) + j; w = *(const u32x4*)(proj + (size_t)row * INW + 2688 + g * 64 + 8 * wave); } }
#pragma unroll
        for (int e = 0; e < 4; ++e) { VTl[(8 * wave + 2 * e) * 200 + j] = (bf16)(w[e] & 0xffffu); VTl[(8 * wave + 2 * e + 1) * 200 + j] = (bf16)(w[e] >> 16); } }
    const int r = wave >> 1, qh = wave & 1, head = 4 * g + r;
    const float slope = exp2f(-(float)(head + 1));
    const float sink = P.sinks[head];
    const float L2E = 1.4426950408889634f;
    __syncthreads();
#pragma unroll 1
    for (int qt = 0; qt < 2; ++qt) {
        asm volatile("" ::: "memory");
        const int qi = 32 * qh + 16 * qt + fr;
        bf16x8 qf[2];
#pragma unroll
        for (int ks = 0; ks < 2; ++ks) qf[ks] = *(const bf16x8*)(proj + (size_t)(qrow0 + qi) * INW + 2048 + head * 64 + 32 * ks + 8 * fq);
        f32x4 s[12];
#pragma unroll
        for (int kt = 0; kt < 12; ++kt) { s[kt] = (f32x4){0.f, 0.f, 0.f, 0.f};
#pragma unroll
            for (int ks = 0; ks < 2; ++ks) { const bf16x8 a = *(const LAS bf16x8*)(Kl + (16 * kt + fr) * 72 + 32 * ks + 8 * fq); s[kt] = MFMA16(a, qf[ks], s[kt]); } }
        float mx = sink;
#pragma unroll
        for (int kt = 0; kt < 12; ++kt)
#pragma unroll
            for (int rr = 0; rr < 4; ++rr) { const int j = 16 * kt + 4 * fq + rr; const int dist = 128 + qi - j;
                float v = s[kt][rr] * 0.125f - slope * fabsf((float)dist);
                v = j >= jmin ? v : -INFINITY; s[kt][rr] = v; mx = fmaxf(mx, v); }
        mx = fmaxf(mx, __shfl_xor(mx, 16)); mx = fmaxf(mx, __shfl_xor(mx, 32));
        float ls = 0.f;
#pragma unroll
        for (int kt = 0; kt < 12; ++kt)
#pragma unroll
            for (int rr = 0; rr < 4; ++rr) { const float p = exp2f((s[kt][rr] - mx) * L2E); s[kt][rr] = p; ls += p; }
        ls += __shfl_xor(ls, 16); ls += __shfl_xor(ls, 32);
        const float inv = 1.0f / (ls + exp2f((sink - mx) * L2E));
        f32x4 o[4];
#pragma unroll
        for (int dt = 0; dt < 4; ++dt) o[dt] = (f32x4){0.f, 0.f, 0.f, 0.f};
#pragma unroll
        for (int kk = 0; kk < 6; ++kk) {
            u32x4 w; w.x = pk2(s[2 * kk][0], s[2 * kk][1]); w.y = pk2(s[2 * kk][2], s[2 * kk][3]); w.z = pk2(s[2 * kk + 1][0], s[2 * kk + 1][1]); w.w = pk2(s[2 * kk + 1][2], s[2 * kk + 1][3]);
            const bf16x8 pb = __builtin_bit_cast(bf16x8, w);
#pragma unroll
            for (int dt = 0; dt < 4; ++dt) { const LAS bf16* vp = VTl + (16 * dt + fr) * 200 + 32 * kk + 4 * fq;
                const u32x2 lo = *(const LAS u32x2*)vp, hi = *(const LAS u32x2*)(vp + 16);
                const u32x4 aw = (u32x4){lo.x, lo.y, hi.x, hi.y}; const bf16x8 a = __builtin_bit_cast(bf16x8, aw);
                o[dt] = MFMA16(a, pb, o[dt]); }
        }
        bf16* mp = mix + (size_t)(qrow0 + qi) * DM + 512 + head * 64 + 4 * fq;
#pragma unroll
        for (int dt = 0; dt < 4; ++dt) { const f32x4 v = o[dt] * inv; u32x2 w; w.x = pk2(v[0], v[1]); w.y = pk2(v[2], v[3]); *(u32x2*)(mp + 16 * dt) = w; }
    }
}
__device__ __forceinline__ void phase3(const Params& P, LAS unsigned char* lds, int tid, int wave, int lane) {
    const int G = gridDim.x, NR = G / 2, blk = blockIdx.x;
    if (blk < NR) {
#ifndef NO_RET
#ifdef PROBE_RETX2
        for (int rep = 0; rep < 2; ++rep)
#endif
        for (int it = blk; it < 256; it += NR) {
            const bool sample = it >= 128; const int bh = it & 127, b = bh >> 2, h = bh & 3;
            ret_item(P, lds, tid, wave, lane, h, sample ? MP + 64 * b : b * SEQ, sample ? 1 : 32, P.state_ret + (size_t)bh * 16384, sample, P.out + (sample ? OFF_SRET : OFF_PRET) + (size_t)bh * 16384);
        }
#endif
    } else {
#ifndef NO_ATT
#ifdef PROBE_ATTX2
        for (int rep = 0; rep < 2; ++rep)
#endif
        for (int it = blk - NR; it < 2112; it += G - NR) {
            const bool sample = it >= 2048;
            att_item(P, lds, tid, wave, lane, sample, sample ? (it - 2048) >> 1 : it >> 6, sample ? 2 : (it >> 1) & 31, it & 1);
        }
#endif
    }
}

__device__ __forceinline__ void phase6(const Params& P, int tid) {
    const bf16* ua = (const bf16*)(P.ws + WS_R1); bf16* ub = (bf16*)(P.ws + WS_R2);
    constexpr int CH = DFF / 8;
    const int total = MT * CH;
    for (int idx = blockIdx.x * 512 + tid; idx < total; idx += gridDim.x * 512) {
        const int row = idx / CH, j = (idx - row * CH) * 8;
        const bool smp = row >= MP; const int t = smp ? ((row - MP) & 63) : (row & 2047);
        float a[8], p1[8], p2[8], bb[8];
        unpack8(*(const u32x4*)(ua + (size_t)row * DFF + j), a);
        unpack8(*(const u32x4*)(ub + (size_t)row * DFF + j), bb);
        if (t >= 1) unpack8(*(const u32x4*)(ua + (size_t)(row - 1) * DFF + j), p1);
        else if (smp) { const float* s = P.state_conv + ((size_t)((row - MP) >> 6) * 2 + 1) * DFF + j; const f32x4 x = *(const f32x4*)s, y = *(const f32x4*)(s + 4); p1[0] = x.x; p1[1] = x.y; p1[2] = x.z; p1[3] = x.w; p1[4] = y.x; p1[5] = y.y; p1[6] = y.z; p1[7] = y.w; }
        else {
#pragma unroll
            for (int e = 0; e < 8; ++e) p1[e] = 0.f; }
        if (t >= 2) unpack8(*(const u32x4*)(ua + (size_t)(row - 2) * DFF + j), p2);
        else if (smp) { const float* s = P.state_conv + ((size_t)((row - MP) >> 6) * 2 + t) * DFF + j; const f32x4 x = *(const f32x4*)s, y = *(const f32x4*)(s + 4); p2[0] = x.x; p2[1] = x.y; p2[2] = x.z; p2[3] = x.w; p2[4] = y.x; p2[5] = y.y; p2[6] = y.z; p2[7] = y.w; }
        else {
#pragma unroll
            for (int e = 0; e < 8; ++e) p2[e] = 0.f; }
        float r[8];
#pragma unroll
        for (int h = 0; h < 2; ++h) { const f32x4 w0 = *(const f32x4*)(P.conv_w + j + 4 * h), w1 = *(const f32x4*)(P.conv_w + DFF + j + 4 * h), w2 = *(const f32x4*)(P.conv_w + 2 * DFF + j + 4 * h), cb = *(const f32x4*)(P.conv_b + j + 4 * h);
#pragma unroll
            for (int e = 0; e < 4; ++e) { const float cv = cb[e] + w0[e] * p2[4 * h + e] + w1[e] * p1[4 * h + e] + w2[e] * a[4 * h + e]; r[4 * h + e] = silu_f(cv) * bb[4 * h + e]; } }
        u32x4 w; w.x = pk2(r[0], r[1]); w.y = pk2(r[2], r[3]); w.z = pk2(r[4], r[5]); w.w = pk2(r[6], r[7]);
        *(u32x4*)(ub + (size_t)row * DFF + j) = w;
    }
}
#ifdef CONV_FUSED
__device__ __forceinline__ void phase6c(const Params& P, int tid) {
    const float* headA = (const float*)(P.ws + WS_R1); const float* headB = headA + HT_STRIDE; const float* tailA = headA + 2 * HT_STRIDE;
    bf16* act = (bf16*)(P.ws + WS_R2);
    const int total = NGRP * DFF;
    for (int idx = blockIdx.x * 512 + tid; idx < total; idx += gridDim.x * 512) {
        const int g = idx / DFF, j = idx - g * DFF;
        float p0, p1;
        if (g < 1024) { if ((g & 31) == 0) { p0 = 0.f; p1 = 0.f; } else { p0 = tailA[((size_t)(g - 1) * 2) * DFF + j]; p1 = tailA[((size_t)(g - 1) * 2 + 1) * DFF + j]; } }
        else { p0 = P.state_conv[((size_t)(g - 1024) * 2) * DFF + j]; p1 = P.state_conv[((size_t)(g - 1024) * 2 + 1) * DFF + j]; }
        const float a0 = headA[((size_t)g * 2) * DFF + j], a1 = headA[((size_t)g * 2 + 1) * DFF + j];
        const float b0 = headB[((size_t)g * 2) * DFF + j], b1 = headB[((size_t)g * 2 + 1) * DFF + j];
        const float w0 = P.conv_w[j], w1 = P.conv_w[DFF + j], w2 = P.conv_w[2 * DFF + j], cb = P.conv_b[j];
        const float c0 = cb + w0 * p0 + w1 * p1 + w2 * a0, c1 = cb + w0 * p1 + w1 * a0 + w2 * a1;
        act[(size_t)(64 * g) * DFF + j] = (bf16)(pk2(silu_f(c0) * b0, 0.f) & 0xffffu);
        act[(size_t)(64 * g + 1) * DFF + j] = (bf16)(pk2(silu_f(c1) * b1, 0.f) & 0xffffu);
        const float t0 = tailA[((size_t)g * 2) * DFF + j], t1 = tailA[((size_t)g * 2 + 1) * DFF + j];
        if (g < 1024) { if ((g & 31) == 31) { P.out[OFF_PCONV + ((size_t)(g >> 5) * 2) * DFF + j] = t0; P.out[OFF_PCONV + ((size_t)(g >> 5) * 2 + 1) * DFF + j] = t1; } }
        else { P.out[OFF_SCONV + ((size_t)(g - 1024) * 2) * DFF + j] = t0; P.out[OFF_SCONV + ((size_t)(g - 1024) * 2 + 1) * DFF + j] = t1; }
    }
}
#endif
__device__ __forceinline__ void phase8(const Params& P, int wave, int lane) {
    const float* mod = (const float*)(P.ws + WS_MOD); const bf16* x2 = (const bf16*)(P.ws + WS_R0);
    const int gw = blockIdx.x * 8 + wave, NGW = gridDim.x * 8;
#pragma unroll 2
    for (int row = gw; row < MT; row += NGW) {
        const int bs = row < MP ? (row >> 11) : 32 + ((row - MP) >> 6);
        float* yr = P.out + (size_t)row * DM + 8 * lane;
        const float* mb = mod + (size_t)bs * 8192 + 6144 + 8 * lane;
        const bf16* xr = x2 + (size_t)row * DM + 8 * lane;
        float v[2][8]; float ss = 0.f;
#pragma unroll
        for (int j = 0; j < 2; ++j) { unpack8(*(const u32x4*)(xr + 512 * j), v[j]);
#pragma unroll
            for (int e = 0; e < 8; ++e) ss += v[j][e] * v[j][e]; }
        const float rstd = rsqrtf(wave_sum(ss) * (1.f / DM) + EPS);
#pragma unroll
        for (int j = 0; j < 2; ++j)
#pragma unroll
            for (int h = 0; h < 2; ++h) { const int o = 512 * j + 4 * h; const f32x4 sh = *(const f32x4*)(mb + o), sc = *(const f32x4*)(mb + 1024 + o), gn = *(const f32x4*)(P.normf + 8 * lane + o);
                const f32x4 x = (f32x4){v[j][4 * h], v[j][4 * h + 1], v[j][4 * h + 2], v[j][4 * h + 3]};
                *(f32x4*)(yr + o) = x * rstd * gn * (sc + 1.0f) + sh; }
    }
}
__device__ __forceinline__ void phase8q(const Params& P, LAS unsigned char* lds, int tid, int wave, int lane) {
    const float* mod = (const float*)(P.ws + WS_MOD);
    unsigned* cnt = (unsigned*)(P.ws + WS_CNT7); unsigned* ticket = (unsigned*)(P.ws + WS_TICKET);
    LAS int* ord = (LAS int*)(lds + 131072);
    LAS int* flag = ord + 272;
    pg8::StaticOrder S; S.init(MT, DM, (int)gridDim.x, 0);
    for (int i = tid; i < NTM; i += 512) flag[i] = 0;
    __syncthreads();
    { const int full = (S.nwg / S.G) * S.G; for (int L = full + tid; L < S.nwg; L += 512) { pg8::Unit u; S.map(L, u); flag[u.pm] = 1; } }
    __syncthreads();
    if (tid == 0) { int k = 0; for (int i = 0; i < NTM; ++i) if (!flag[i]) ord[k++] = i; for (int i = 0; i < NTM; ++i) if (flag[i]) ord[k++] = i; }
    __syncthreads();
    for (;;) {
        if (tid == 0) flag[268] = (int)__hip_atomic_fetch_add(ticket, 1u, __ATOMIC_RELAXED, __HIP_MEMORY_SCOPE_AGENT);
        __syncthreads();
        const int tk = flag[268];
        if (tk >= NTM * 4) break;
        const int pm = ord[tk >> 2], rb = tk & 3;
        if (wave == 0) {
            unsigned spins = 0;
            while ((unsigned)__builtin_amdgcn_readfirstlane(__hip_atomic_load(cnt + 64 * pm, __ATOMIC_RELAXED, __HIP_MEMORY_SCOPE_AGENT)) < 32u) { __builtin_amdgcn_s_sleep(4); if (++spins > (1u << 22)) break; }
            __builtin_amdgcn_fence(__ATOMIC_ACQUIRE, "agent");
            asm volatile("s_waitcnt vmcnt(0)" ::: "memory");
        }
        __syncthreads();
#pragma unroll 2
        for (int i = 0; i < 8; ++i) {
            const int row = pm * 256 + rb * 64 + wave * 8 + i;
            const int bs = row < MP ? (row >> 11) : 32 + ((row - MP) >> 6);
            float* yr = P.out + (size_t)row * DM + 4 * lane;
            const float* mb = mod + (size_t)bs * 8192 + 6144 + 4 * lane;
            f32x4 v[4]; float ss = 0.f;
#pragma unroll
            for (int j = 0; j < 4; ++j) { v[j] = *(const f32x4*)(yr + 256 * j); ss += (v[j].x * v[j].x + v[j].y * v[j].y) + (v[j].z * v[j].z + v[j].w * v[j].w); }
            const float rstd = rsqrtf(wave_sum(ss) * (1.f / DM) + EPS);
#pragma unroll
            for (int j = 0; j < 4; ++j) { const f32x4 sh = *(const f32x4*)(mb + 256 * j), sc = *(const f32x4*)(mb + 1024 + 256 * j), gn = *(const f32x4*)(P.normf + 4 * lane + 256 * j);
                *(f32x4*)(yr + 256 * j) = v[j] * rstd * gn * (sc + 1.0f) + sh; }
        }
    }
}

#ifndef N_LAUNCH
#define N_LAUNCH 1
#endif
#define LAUNDER_TID() int tid = threadIdx.x; asm volatile("" : "+v"(tid)); const int lane = tid & 63, wave = __builtin_amdgcn_readfirstlane(tid >> 6); (void)lane; (void)wave
template <int PHM>
__global__ void __launch_bounds__(512) fwd_mega(Params P) {
    extern __shared__ __attribute__((aligned(16))) unsigned char lds_raw[];
    LAS unsigned char* lds = (LAS unsigned char*)lds_raw;
    const int G = gridDim.x;
    unsigned char* ws = P.ws;
    volatile LAS unsigned* misc = (volatile LAS unsigned*)(lds + LDS_MISC);
    if (threadIdx.x < 2) misc[threadIdx.x] = 0u;
    __syncthreads();
    XcdBarrier bar; bar.bar = (unsigned*)(ws + WS_BAR); bar.x = 0; bar.st = misc;
#define GSYNC(a, b) do { if ((PHM & (a)) && (PHM & (b))) xcd_barrier(bar); } while (0)
    if constexpr ((PHM & 1) != 0) { LAUNDER_TID(); phase0(P, lds, wave, lane);
      if (blockIdx.x == 0) for (int i = tid; i < XCD_BAR_WORDS; i += 512) ((unsigned*)(ws + WS_BAR))[i] = 0u;
      if (blockIdx.x == 1) { for (int i = tid; i < NTM * 64; i += 512) ((unsigned*)(ws + WS_CNT7))[i] = 0u; if (tid < 64) ((unsigned*)(ws + WS_TICKET))[tid] = 0u; } }
    if constexpr ((PHM & 1) != 0 && (PHM & 2) != 0) {
      cg::this_grid().sync();
      bar = xcd_barrier_post((unsigned*)(ws + WS_BAR), misc); }
    if constexpr ((PHM & 2) != 0) { LAUNDER_TID(); phase1(P, lds, tid, wave, lane); }
    GSYNC(2, 4);
    if constexpr ((PHM & 4) != 0) {
      pg8::Gemm g{(const bf16*)(ws + WS_R0), (const bf16*)(ws + WS_WIN), MT, INW, DM};
      OrderX S; S.S.init(MT, INW, G, (int)blockIdx.x); S.nX = 22; S.xpm = NTM; S.xpn0 = 11;
      Epi1 E{(bf16*)(ws + WS_R1), (float*)(ws + WS_SHW), P.out};
      pg8::gemm_phase<Epi1, OrderX, true, true>(lds, g, S, E); }
    GSYNC(4, 8);
    if constexpr ((PHM & 8) != 0) { LAUNDER_TID(); phase3(P, lds, tid, wave, lane);
#ifdef PROBE_P3X2
      cg::this_grid().sync(); phase3(P, lds, tid, wave, lane);
#endif
    }
    GSYNC(8, 16);
    if constexpr ((PHM & 16) != 0) {
      pg8::Gemm g{(const bf16*)(ws + WS_R2), (const bf16*)(ws + WS_WOUT), MT, DM, DM};
      pg8::StaticOrder S; S.init(MT, DM, G, (int)blockIdx.x);
      Epi2 E{P.x_p, P.x_s, (const float*)(ws + WS_MOD), P.ln2, (bf16*)(ws + WS_X1B), (bf16*)(ws + WS_R0), (float*)(ws + WS_SS1)};
      pg8::gemm_phase<Epi2, pg8::StaticOrder, true, true>(lds, g, S, E); }
    GSYNC(16, 32);
    if constexpr ((PHM & 32) != 0) {
      LAUNDER_TID();
      pg8::Gemm g{(const bf16*)(ws + WS_R0), (const bf16*)(ws + WS_WUP), MT, 2 * DFF, DM};
      pg8::StaticOrder S; S.init(MT, 2 * DFF, G, (int)blockIdx.x);
      LAS float* rtab = (LAS float*)(lds + 131072);
      { pg8::Unit u; const float* ss = (const float*)(ws + WS_SS1);
        for (int i = 0; S.next(i, u) && i < 24; ++i) if (tid < 256) { const f32x4* sp = (const f32x4*)(ss + (size_t)(u.pm * 256 + tid) * 16);
            const f32x4 q0 = sp[0], q1 = sp[1], q2 = sp[2], q3 = sp[3];
            const float tot = ((q0.x + q0.y) + (q0.z + q0.w)) + ((q1.x + q1.y) + (q1.z + q1.w)) + ((q2.x + q2.y) + (q2.z + q2.w)) + ((q3.x + q3.y) + (q3.z + q3.w));
            rtab[i * 256 + tid] = rsqrtf(tot * (1.f / DM) + EPS); }
        __syncthreads(); }
#ifdef CONV_FUSED
      float* hA = (float*)(ws + WS_R1);
      Epi3C E{rtab, (const float*)(ws + WS_SHW), P.conv_w, P.conv_b, (bf16*)(ws + WS_R2), hA, hA + HT_STRIDE, hA + 2 * HT_STRIDE};
      pg8::gemm_phase<Epi3C, pg8::StaticOrder, true, true>(lds, g, S, E);
#else
      Epi3 E{rtab, (const float*)(ws + WS_SHW), (bf16*)(ws + WS_R1), (bf16*)(ws + WS_R2), P.out};
      pg8::gemm_phase<Epi3, pg8::StaticOrder, true, true>(lds, g, S, E);
#endif
#ifdef PROBE_P5X2
      cg::this_grid().sync(); pg8::gemm_phase<Epi3, pg8::StaticOrder, true, true>(lds, g, S, E);
#endif
    }
    GSYNC(32, 64);
#ifdef CONV_FUSED
    if constexpr ((PHM & 64) != 0) { LAUNDER_TID(); phase6c(P, tid); }
#else
    if constexpr ((PHM & 64) != 0) { LAUNDER_TID(); phase6(P, tid); }
#endif
    GSYNC(64, 128);
    if constexpr ((PHM & 128) != 0) {
      pg8::Gemm g{(const bf16*)(ws + WS_R2), (const bf16*)(ws + WS_WDN), MT, DM, DFF};
#ifdef P8_QUEUE
      OrderPub S; S.init(MT, DM, G, (int)blockIdx.x); S.cnt = (unsigned*)(ws + WS_CNT7);
      Epi4 E{(const float*)(ws + WS_MOD), (const bf16*)(ws + WS_X1B), (bf16*)(ws + WS_R0)};
      pg8::gemm_phase<Epi4, OrderPub, true, true>(lds, g, S, E); }
    if constexpr ((PHM & 256) != 0) { LAUNDER_TID(); phase8q(P, lds, tid, wave, lane); }
#else
      pg8::StaticOrder S; S.init(MT, DM, G, (int)blockIdx.x);
      Epi4 E{(const float*)(ws + WS_MOD), (const bf16*)(ws + WS_X1B), (bf16*)(ws + WS_R0)};
      pg8::gemm_phase<Epi4, pg8::StaticOrder, true, true>(lds, g, S, E); }
    GSYNC(128, 256);
    if constexpr ((PHM & 256) != 0) { LAUNDER_TID(); phase8(P, wave, lane); }
#endif
}

template <int PHM> static bool launch_one(const Params& p, int grid, bool coop, hipStream_t stream) {
    static bool attr_done = false;
    if (!attr_done) { if (hipFuncSetAttribute((const void*)fwd_mega<PHM>, hipFuncAttributeMaxDynamicSharedMemorySize, LDS_BYTES) != hipSuccess) { fprintf(stderr, "kernel_launch: hipFuncSetAttribute failed\n"); return false; } attr_done = true; }
    hipError_t e;
    if (coop) { Params pc = p; void* args[] = {&pc}; e = hipLaunchCooperativeKernel((const void*)fwd_mega<PHM>, dim3(grid), dim3(512), args, LDS_BYTES, stream); }
    else { hipLaunchKernelGGL(fwd_mega<PHM>, dim3(grid), dim3(512), LDS_BYTES, stream, p); e = hipPeekAtLastError(); }
    if (e != hipSuccess) { fprintf(stderr, "launch (mask %d) failed: %s (grid %d)\n", PHM, hipGetErrorString(e), grid); return false; }
    return true;
}
extern "C" void kernel_launch(void* const* d_in, const int* in_sizes, int n_in, void* d_out, int out_size, void* d_ws, size_t ws_size, hipStream_t stream) {
    static int grid = 0;
    if (grid == 0) {
        if (n_in != 22 || (size_t)out_size != OUT_TOTAL || ws_size < WS_END) { fprintf(stderr, "kernel_launch: unexpected sizes n_in %d out %d ws %zu\n", n_in, out_size, ws_size); grid = -1; return; }
        int dev = 0, cus = 0;
        (void)hipGetDevice(&dev);
        (void)hipDeviceGetAttribute(&cus, hipDeviceAttributeMultiprocessorCount, dev);
        grid = cus;
        if (grid > 256) grid = 256;
        if (grid < 2) grid = -1;
    }
    if (grid < 0) return;
    Params p{};
    const float** pp = (const float**)&p;
    for (int i = 0; i < 22; ++i) pp[i] = (const float*)d_in[i];
    p.out = (float*)d_out; p.ws = (unsigned char*)d_ws;
#if N_LAUNCH == 1
    launch_one<511>(p, grid, true, stream);
#else
    launch_one<1>(p, grid, false, stream) && launch_one<2>(p, grid, false, stream) && launch_one<4>(p, grid, false, stream) && launch_one<8>(p, grid, false, stream) &&
    launch_one<16>(p, grid, false, stream) && launch_one<32>(p, grid, false, stream) && launch_one<64>(p, grid, false, stream) && launch_one<128>(p, grid, false, stream) && launch_one<256>(p, grid, false, stream);
#endif
}
```

```cpp
#define CONV_FUSED 1
#include <hip/hip_runtime.h>
#include <hip/hip_cooperative_groups.h>
#include <cstdio>
#include <cstdint>
namespace cg = cooperative_groups;
namespace pg8 {
#define PG8_LAS __attribute__((address_space(3)))
typedef unsigned short bf16_t;
typedef short bf16x8 __attribute__((ext_vector_type(8)));
typedef float f32x4 __attribute__((ext_vector_type(4)));
typedef unsigned u32x4 __attribute__((ext_vector_type(4)));
constexpr int BM = 256, BK = 64, HALF = 128, HTB = HALF * BK * 2  , STAGE_BYTES = 8 * HTB, NXCD = 8, WGM = 8;

__host__ __device__ __forceinline__ int lds_byte(int r, int c) { const int st = (r >> 4) * 2 + (c >> 5), rr = r & 15, cc = c & 31, ob = rr * 64 + cc * 2; return st * 1024 + (ob ^ (((ob >> 9) & 1) << 5)); }
__host__ __device__ __forceinline__ void stage_rc(int b, int& R, int& C) { const int st = b / 1024, sb = b % 1024, swz = sb ^ (((sb >> 9) & 1) << 5); R = (st >> 1) * 16 + swz / 64; C = (st & 1) * 32 + (swz % 64) / 2; }
__host__ __device__ __forceinline__ int perm32(int rho) { const int n = rho >> 4, i = rho & 15; return 8 * (i >> 2) + 4 * n + (i & 3); }

struct Unit { int pm, pn, seq; };
struct Gemm { const bf16_t* A; const bf16_t* Bt; int M, N, K; };

struct StaticOrder {
    int nM, nN, nwg, G, c;
    __host__ __device__ __forceinline__ void init(int M, int N, int G_, int c_) { nM = M / BM; nN = N / BM; nwg = nM * nN; G = G_; c = c_; }
    __host__ __device__ __forceinline__ bool next(int i, Unit& u) const {
        const long L = (long)i * G + c; if (L >= nwg) return false; u.seq = i; map(L, u); return true; }
    __host__ __device__ __forceinline__ void map(long L, Unit& u) const {
        int wgid = (int)L; { const int q = nwg / NXCD, r = nwg % NXCD, xcd = wgid % NXCD, off = wgid / NXCD; wgid = (xcd < r ? xcd * (q + 1) : r * (q + 1) + (xcd - r) * q) + off; }
        const int nig = WGM * nN, gid = wgid / nig, fm = gid * WGM, gsz = (nM - fm) < WGM ? (nM - fm) : WGM;
        u.pm = fm + ((wgid % nig) % gsz); u.pn = (wgid % nig) / gsz;
    }
    __device__ __forceinline__ void a_ready(const Unit&) const {}
    __device__ __forceinline__ void done(const Unit&) const {}
};

__device__ __forceinline__ unsigned cvt_pk_bf16(float lo, float hi) { unsigned r; asm volatile("v_cvt_pk_bf16_f32 %0, %1, %2" : "=v"(r) : "v"(lo), "v"(hi)); return r; }

template <class Epi, class Sched, bool ALIGN_EPI = false, bool SP2 = false>
__device__ __forceinline__ void gemm_phase(PG8_LAS unsigned char* lds, const Gemm g, const Sched& S, const Epi& E) {
    int tid_ = threadIdx.x; asm volatile("" : "+v"(tid_));
    const int tid = tid_, wid = __builtin_amdgcn_readfirstlane(tid >> 6), lane = tid & 63, wr = wid >> 2, wc = wid & 3, fr = lane & 15, fq = lane >> 4;
    const int K = g.K, nt = K / BK;
    unsigned voffA[2], voffB[2];
#pragma unroll
    for (int i = 0; i < 2; ++i) { int R, C; stage_rc(tid * 16 + i * 8192, R, C); const int Rb = Epi::PERM ? ((R & ~31) + perm32(R & 31)) : R;
        voffA[i] = (unsigned)(R * K + C) * 2u; voffB[i] = (unsigned)(Rb * K + C) * 2u; }
    const size_t kstep = (size_t)(BK * 2);
    const size_t hstep = (size_t)HALF * K * 2;
    const size_t tstep = 2 * hstep;
    const unsigned ldsw = (unsigned)wid * 1024u;
    const int aoff = lds_byte(wr * 64 + fr, fq * 8), boff = lds_byte(wc * 32 + fr, fq * 8);
#define PG8_SA(b, h) (((b) * 2 + (h)) * HTB)
#define PG8_SB(b, h) ((4 + (b) * 2 + (h)) * HTB)
#define PG8_STAGE(bufoff, gbase, voff) do { _Pragma("unroll") for (int _i = 0; _i < 2; ++_i) \
        __builtin_amdgcn_global_load_lds((const unsigned*)((const char*)(gbase) + (voff)[_i]), (PG8_LAS unsigned*)(lds + (bufoff) + ldsw + _i * 8192), 16, 0, 0); } while (0)
#define PG8_LDA(dst, b, h) do { _Pragma("unroll") for (int m = 0; m < 4; ++m) _Pragma("unroll") for (int k = 0; k < 2; ++k) dst[m][k] = *(const PG8_LAS bf16x8*)(lds + PG8_SA(b, h) + aoff + m * 2048 + k * 1024); } while (0)
#define PG8_LDB(dst, b, h) do { _Pragma("unroll") for (int n = 0; n < 2; ++n) _Pragma("unroll") for (int k = 0; k < 2; ++k) dst[n][k] = *(const PG8_LAS bf16x8*)(lds + PG8_SB(b, h) + boff + n * 2048 + k * 1024); } while (0)
#define PG8_MMA(ai, bj, At, Bt) do { __builtin_amdgcn_s_setprio(1); _Pragma("unroll") for (int m = 0; m < 4; ++m) _Pragma("unroll") for (int n = 0; n < 2; ++n) _Pragma("unroll") for (int k = 0; k < 2; ++k) \
        acc[ai][bj][m][n] = __builtin_amdgcn_mfma_f32_16x16x32_bf16(Bt[n][k], At[m][k], acc[ai][bj][m][n], 0, 0, 0); __builtin_amdgcn_s_setprio(0); } while (0)
#define PG8_WAIT_V(n) asm volatile("s_waitcnt vmcnt(" #n ")" ::: "memory")
#define PG8_WAIT_L(n) asm volatile("s_waitcnt lgkmcnt(" #n ")" ::: "memory")
#define PG8_BAR __builtin_amdgcn_s_barrier()
#define PG8_SCHED __builtin_amdgcn_sched_barrier(0)
    Unit cur, nxt; int ui = 0;
    if (!S.next(0, cur)) return;
    f32x4 acc[2][2][4][2];
#pragma unroll
    for (int a = 0; a < 2; ++a)
#pragma unroll
        for (int b = 0; b < 2; ++b)
#pragma unroll
            for (int m = 0; m < 4; ++m)
#pragma unroll
                for (int n = 0; n < 2; ++n) acc[a][b][m][n] = (f32x4){0.f, 0.f, 0.f, 0.f};
    bf16x8 At[4][2], B0[2][2], B1[2][2];
    const char* cA = (const char*)g.A + (size_t)cur.pm * tstep; const char* cB = (const char*)g.Bt + (size_t)cur.pn * tstep;
    S.a_ready(cur);
    if constexpr (SP2) {
        PG8_STAGE(PG8_SB(0, 0), cB, voffB); PG8_STAGE(PG8_SB(0, 1), cB + hstep, voffB); PG8_STAGE(PG8_SA(0, 0), cA, voffA); PG8_STAGE(PG8_SA(0, 1), cA + hstep, voffA);
        if (wr == 1) PG8_BAR;
        PG8_WAIT_V(2); PG8_BAR;
        PG8_STAGE(PG8_SB(1, 0), cB + kstep, voffB); PG8_STAGE(PG8_SA(1, 0), cA + kstep, voffA); PG8_STAGE(PG8_SB(1, 1), cB + hstep + kstep, voffB);
        PG8_WAIT_V(6); PG8_BAR;
    } else {
        PG8_STAGE(PG8_SB(0, 0), cB, voffB); PG8_STAGE(PG8_SA(0, 0), cA, voffA); PG8_STAGE(PG8_SB(0, 1), cB + hstep, voffB); PG8_STAGE(PG8_SA(0, 1), cA + hstep, voffA);
        if (wr == 1) PG8_BAR;
        PG8_WAIT_V(4); PG8_BAR;
        PG8_STAGE(PG8_SB(1, 0), cB + kstep, voffB); PG8_STAGE(PG8_SA(1, 0), cA + kstep, voffA); PG8_STAGE(PG8_SB(1, 1), cB + hstep + kstep, voffB);
        PG8_WAIT_V(6); PG8_BAR;
    }
    for (;;) {
        const bool has_next = S.next(ui + 1, nxt);
        const char* nA = has_next ? (const char*)g.A + (size_t)nxt.pm * tstep : cA; const char* nB = has_next ? (const char*)g.Bt + (size_t)nxt.pn * tstep : cB;
        for (int t = 0; t < nt; t += 2) {
            const bool last = (t == nt - 2);
            const char* a1 = cA + (size_t)(t + 1) * kstep;
            const char* a2 = last ? nA : cA + (size_t)(t + 2) * kstep; const char* b2 = last ? nB : cB + (size_t)(t + 2) * kstep;
            const char* a3 = a2 + kstep; const char* b3 = b2 + kstep;
            if (last && has_next) S.a_ready(nxt);
            if constexpr (SP2) {
            PG8_LDB(B0, 0, 0); PG8_LDB(B1, 0, 1); PG8_SCHED; PG8_LDA(At, 0, 0); PG8_STAGE(PG8_SA(1, 1), a1 + hstep, voffA);
            PG8_WAIT_V(8); PG8_WAIT_L(0); PG8_BAR; PG8_MMA(0, 0, At, B0); PG8_MMA(0, 1, At, B1); PG8_BAR; PG8_SCHED;
            PG8_LDA(At, 0, 1); PG8_STAGE(PG8_SB(0, 0), b2, voffB); PG8_STAGE(PG8_SB(0, 1), b2 + hstep, voffB); PG8_STAGE(PG8_SA(0, 0), a2, voffA);
            PG8_WAIT_V(8); PG8_WAIT_L(0); PG8_BAR; PG8_MMA(1, 0, At, B0); PG8_MMA(1, 1, At, B1); PG8_BAR; PG8_SCHED;
            PG8_LDB(B0, 1, 0); PG8_LDB(B1, 1, 1); PG8_SCHED; PG8_LDA(At, 1, 0); PG8_STAGE(PG8_SA(0, 1), a2 + hstep, voffA);
            PG8_WAIT_V(8); PG8_WAIT_L(0); PG8_BAR; PG8_MMA(0, 0, At, B0); PG8_MMA(0, 1, At, B1); PG8_BAR; PG8_SCHED;
            PG8_LDA(At, 1, 1); PG8_STAGE(PG8_SB(1, 0), b3, voffB); PG8_STAGE(PG8_SB(1, 1), b3 + hstep, voffB); PG8_STAGE(PG8_SA(1, 0), a3, voffA);
            PG8_WAIT_V(8); PG8_WAIT_L(0); PG8_BAR; PG8_MMA(1, 0, At, B0); PG8_MMA(1, 1, At, B1); PG8_BAR; PG8_SCHED;
            } else {
            PG8_LDB(B0, 0, 0); PG8_SCHED; PG8_LDA(At, 0, 0); PG8_STAGE(PG8_SA(1, 1), a1 + hstep, voffA);
            PG8_WAIT_L(8); PG8_BAR; PG8_WAIT_L(0); PG8_MMA(0, 0, At, B0); PG8_BAR; PG8_SCHED;
            PG8_LDB(B1, 0, 1); PG8_STAGE(PG8_SB(0, 0), b2, voffB);
            PG8_BAR; PG8_WAIT_L(0); PG8_MMA(0, 1, At, B1); PG8_BAR;
            PG8_LDA(At, 0, 1); PG8_STAGE(PG8_SA(0, 0), a2, voffA);
            PG8_BAR; PG8_WAIT_L(0); PG8_MMA(1, 0, At, B0); PG8_BAR; PG8_SCHED;
            PG8_STAGE(PG8_SB(0, 1), b2 + hstep, voffB);
            PG8_WAIT_V(6); PG8_BAR; PG8_MMA(1, 1, At, B1); PG8_BAR;
            PG8_LDB(B0, 1, 0); PG8_SCHED; PG8_LDA(At, 1, 0); PG8_STAGE(PG8_SA(0, 1), a2 + hstep, voffA);
            PG8_WAIT_L(8); PG8_BAR; PG8_WAIT_L(0); PG8_MMA(0, 0, At, B0); PG8_BAR; PG8_SCHED;
            PG8_LDB(B1, 1, 1); PG8_STAGE(PG8_SB(1, 0), b3, voffB);
            PG8_BAR; PG8_WAIT_L(0); PG8_MMA(0, 1, At, B1); PG8_BAR;
            PG8_LDA(At, 1, 1); PG8_STAGE(PG8_SA(1, 0), a3, voffA);
            PG8_BAR; PG8_WAIT_L(0); PG8_MMA(1, 0, At, B0); PG8_BAR; PG8_SCHED;
            PG8_STAGE(PG8_SB(1, 1), b3 + hstep, voffB);
            PG8_WAIT_V(6); PG8_BAR; PG8_MMA(1, 1, At, B1); PG8_BAR;
            }
        }
        if constexpr (ALIGN_EPI) { if (wr == 0) PG8_BAR; }
        if constexpr (!Epi::AFTER_DRAIN) { E(acc, cur, wr, wc, fr, fq); S.done(cur); }
        if (!has_next) break;
#pragma unroll
        for (int a = 0; a < 2; ++a)
#pragma unroll
            for (int b = 0; b < 2; ++b)
#pragma unroll
                for (int m = 0; m < 4; ++m)
#pragma unroll
                    for (int n = 0; n < 2; ++n) acc[a][b][m][n] = (f32x4){0.f, 0.f, 0.f, 0.f};
        cur = nxt; cA = nA; cB = nB; ++ui;
        if constexpr (ALIGN_EPI) { if (wr == 1) PG8_BAR; }
    }
    PG8_WAIT_V(0);
    if constexpr (!ALIGN_EPI) { if (wr == 0) PG8_BAR; }
    PG8_BAR;
    if constexpr (Epi::AFTER_DRAIN) { E.fused(acc, cur, wr, wc, fr, fq, lds, wid, lane); S.done(cur); }
#undef PG8_SA
#undef PG8_SB
#undef PG8_STAGE
#undef PG8_LDA
#undef PG8_LDB
#undef PG8_MMA
#undef PG8_WAIT_V
#undef PG8_WAIT_L
#undef PG8_BAR
#undef PG8_SCHED
}
}
constexpr int DM = 1024, SEQ = 2048, NB = 32, DECL = 64, DFF = 2816, INW = 2816;
constexpr int MP = NB * SEQ, MS = NB * DECL, MT = MP + MS;
constexpr int NGRP = MT / 64;
constexpr int NTM = MT / 256;
constexpr float EPS = 1e-6f;
constexpr size_t OFF_Y = 0;
constexpr size_t OFF_PRET = (size_t)MT * DM;
constexpr size_t OFF_PK = OFF_PRET + (size_t)NB * 4 * 128 * 128;
constexpr size_t OFF_PV = OFF_PK + (size_t)NB * 128 * 128;
constexpr size_t OFF_PCONV = OFF_PV + (size_t)NB * 128 * 128;
constexpr size_t OFF_SRET = OFF_PCONV + (size_t)NB * 2 * DFF;
constexpr size_t OFF_SK = OFF_SRET + (size_t)NB * 4 * 128 * 128;
constexpr size_t OFF_SV = OFF_SK + (size_t)NB * 64 * 128;
constexpr size_t OFF_SCONV = OFF_SV + (size_t)NB * 64 * 128;
constexpr size_t OUT_TOTAL = OFF_SCONV + (size_t)NB * 2 * DFF;
constexpr size_t MiB = 1u << 20;
constexpr size_t WS_WIN = 0;
constexpr size_t WS_WUP = WS_WIN + (size_t)INW * DM * 2;
constexpr size_t WS_WOUT = WS_WUP + (size_t)2 * DFF * DM * 2;
constexpr size_t WS_WDN = WS_WOUT + (size_t)DM * DM * 2;
constexpr size_t WS_MODP = 24 * MiB;
constexpr size_t WS_MOD = 32 * MiB;
constexpr size_t WS_SHW = 34 * MiB;
constexpr size_t WS_SS1 = 36 * MiB;
constexpr size_t WS_SS2 = 41 * MiB;
constexpr size_t WS_R0 = 48 * MiB;
constexpr size_t WS_R1 = WS_R0 + 133 * MiB;
constexpr size_t WS_R2 = WS_R1 + 363 * MiB;
constexpr size_t HT_STRIDE = (size_t)NGRP * 2 * DFF;
constexpr size_t WS_END = WS_R2 + 363 * MiB;
constexpr size_t WS_X1B = WS_R1 + 128 * MiB;
static_assert(3 * HT_STRIDE * 4 <= 128 * MiB && WS_X1B + (size_t)MT * DM * 2 <= WS_R2, "ws map");
static_assert(WS_WDN + (size_t)DM * DFF * 2 <= WS_MODP, "ws map");
static_assert((size_t)(MT + 256) * DM * 2 <= 133 * MiB && (size_t)MT * DFF * 2 <= 363 * MiB, "ws map");

constexpr size_t WS_BAR = 46 * MiB;
constexpr size_t WS_TICKET = 46 * MiB + 32768;
constexpr size_t WS_CNT7 = 46 * MiB + 65536;
constexpr int LDS_MISC = 155648;
constexpr int LDS_BYTES = 155648 + 64;

#define LAS __attribute__((address_space(3)))
typedef unsigned short bf16;
typedef float f32x4 __attribute__((ext_vector_type(4)));
typedef float f32x2 __attribute__((ext_vector_type(2)));
typedef short bf16x8 __attribute__((ext_vector_type(8)));
typedef unsigned u32x4 __attribute__((ext_vector_type(4)));
typedef unsigned u32x2 __attribute__((ext_vector_type(2)));
typedef __bf16 bf16x2_t __attribute__((ext_vector_type(2)));
#define LDS_WAIT() asm volatile("s_waitcnt lgkmcnt(0)" ::: "memory")

__device__ __forceinline__ unsigned pk2(float lo, float hi) { f32x2 v = {lo, hi}; bf16x2_t b = __builtin_convertvector(v, bf16x2_t); return __builtin_bit_cast(unsigned, b); }
__device__ __forceinline__ float bflo(unsigned w) { return __uint_as_float(w << 16); }
__device__ __forceinline__ float bfhi(unsigned w) { return __uint_as_float(w & 0xffff0000u); }
__device__ __forceinline__ float wave_sum(float v) {
#pragma unroll
    for (int o = 1; o < 64; o <<= 1) v += __shfl_xor(v, o);
    return v;
}
__device__ __forceinline__ float wave_sum_dpp(float v) {
    v += __int_as_float(__builtin_amdgcn_update_dpp(__float_as_int(v), __float_as_int(v), 0x128, 0xf, 0xf, false));
    v += __int_as_float(__builtin_amdgcn_update_dpp(__float_as_int(v), __float_as_int(v), 0x124, 0xf, 0xf, false));
    v += __int_as_float(__builtin_amdgcn_update_dpp(__float_as_int(v), __float_as_int(v), 0x122, 0xf, 0xf, false));
    v += __int_as_float(__builtin_amdgcn_update_dpp(__float_as_int(v), __float_as_int(v), 0x121, 0xf, 0xf, false));
    const int i = __float_as_int(v);
    return (__int_as_float(__builtin_amdgcn_readlane(i, 0)) + __int_as_float(__builtin_amdgcn_readlane(i, 16))) + (__int_as_float(__builtin_amdgcn_readlane(i, 32)) + __int_as_float(__builtin_amdgcn_readlane(i, 48)));
}
__device__ __forceinline__ float silu_f(float x) { return x * __builtin_amdgcn_rcpf(1.0f + __builtin_amdgcn_exp2f(-1.4426950408889634f * x)); }
__device__ __forceinline__ void unpack8(const u32x4 w, float (&f)[8]) { f[0] = bflo(w.x); f[1] = bfhi(w.x); f[2] = bflo(w.y); f[3] = bfhi(w.y); f[4] = bflo(w.z); f[5] = bfhi(w.z); f[6] = bflo(w.w); f[7] = bfhi(w.w); }
__device__ __forceinline__ int grp_bs(int g) { return g < 1024 ? (g >> 5) : 32 + (g - 1024); }

struct Params {
    const float *x_p, *x_s, *cache_k, *cache_v, *state_ret, *state_conv, *c_p, *c_s, *ln1, *ln2, *w_ada, *b_ada, *w_in, *w_out, *sinks, *w_up, *conv_w, *conv_b, *w_down, *normf, *w_ada_f, *b_ada_f;
    float* out; unsigned char* ws;
};

__device__ __forceinline__ void transpose_item(const float* W, int K, int N, bf16* WT, int dst_row0, int k0, int n0, LAS float* scr, int lane) {
#pragma unroll 8
    for (int i = 0; i < 32; ++i) { const int kk = 2 * i + (lane >> 5); scr[kk * 33 + (lane & 31)] = W[(size_t)(k0 + kk) * N + n0 + (lane & 31)]; }
    LDS_WAIT(); asm volatile("" ::: "memory");
    const int c = lane & 7;
#pragma unroll
    for (int j = 0; j < 4; ++j) { const int n = (lane >> 3) + 8 * j; const LAS float* s = scr + (8 * c) * 33 + n;
        u32x4 o; o.x = pk2(s[0 * 33], s[1 * 33]); o.y = pk2(s[2 * 33], s[3 * 33]); o.z = pk2(s[4 * 33], s[5 * 33]); o.w = pk2(s[6 * 33], s[7 * 33]);
        *(u32x4*)(WT + (size_t)(dst_row0 + n) * K + k0 + 8 * c) = o; }
    LDS_WAIT(); asm volatile("" ::: "memory");
}
__device__ __forceinline__ void mod_item(const Params& P, int it, LAS float* scr, int lane) {
    const int ct = it >> 2, ks = it & 3, c0 = ct * 64;
    const float* W; const float* bias; int ldw;
    if (c0 < 6144) { W = P.w_ada + c0; bias = P.b_ada + c0; ldw = 6144; } else { W = P.w_ada_f + (c0 - 6144); bias = P.b_ada_f + (c0 - 6144); ldw = 2048; }
    float acc[64];
#pragma unroll
    for (int r = 0; r < 64; ++r) acc[r] = 0.f;
    const float* crow = (lane < 32 ? P.c_p + (size_t)lane * DM : P.c_s + (size_t)(lane - 32) * DM) + ks * 256;
    for (int kc = 0; kc < 8; ++kc) {
#pragma unroll
        for (int q = 0; q < 8; ++q) { f32x4 v = *(const f32x4*)(crow + kc * 32 + 4 * q);
            v.x = silu_f(v.x); v.y = silu_f(v.y); v.z = silu_f(v.z); v.w = silu_f(v.w);
            *(LAS f32x4*)(scr + lane * 36 + 4 * q) = v; }
        LDS_WAIT(); asm volatile("" ::: "memory");
        const float* wk = W + (size_t)(ks * 256 + kc * 32) * ldw + lane;
        for (int k4 = 0; k4 < 8; ++k4) {
            const float w0 = wk[(size_t)(4 * k4 + 0) * ldw], w1 = wk[(size_t)(4 * k4 + 1) * ldw], w2 = wk[(size_t)(4 * k4 + 2) * ldw], w3 = wk[(size_t)(4 * k4 + 3) * ldw];
#pragma unroll
            for (int r = 0; r < 64; ++r) { const f32x4 s = *(const LAS f32x4*)(scr + r * 36 + 4 * k4); acc[r] += (s.x * w0 + s.y * w1) + (s.z * w2 + s.w * w3); }
        }
        LDS_WAIT(); asm volatile("" ::: "memory");
    }
    float* dst = (float*)(P.ws + WS_MODP) + (size_t)ks * 64 * 8192 + c0 + lane;
    const float bv = (ks == 0) ? bias[lane] : 0.f;
#pragma unroll
    for (int r = 0; r < 64; ++r) dst[(size_t)r * 8192] = acc[r] + bv;
}
__device__ __forceinline__ void phase0(const Params& P, LAS unsigned char* lds, int wave, int lane) {
    LAS float* scr = (LAS float*)(lds + wave * 16384);
    const int gw = wave * gridDim.x + blockIdx.x, NGW = gridDim.x * 8;
    constexpr int I_MOD = 512, I_IN = 16 * 88, I_UP = 16 * 176, I_OUT = 16 * 32, I_DN = 44 * 32;
    constexpr int NIT = I_MOD + I_IN + I_UP + I_OUT + I_DN;
    for (int it = gw; it < NIT; it += NGW) {
        int r = it;
        if (r < I_MOD) { mod_item(P, r, scr, lane); continue; } r -= I_MOD;
        if (r < I_IN) { const int kb = r / 88, nb = r % 88; transpose_item(P.w_in, DM, INW, (bf16*)(P.ws + WS_WIN), nb * 32, kb * 64, nb * 32, scr, lane); continue; } r -= I_IN;
        if (r < I_UP) { const int kb = r / 176, nb = r % 176, n0 = nb * 32, isb = n0 >= DFF, j0 = n0 - isb * DFF;
            transpose_item(P.w_up, DM, 2 * DFF, (bf16*)(P.ws + WS_WUP), 256 * (j0 >> 7) + 128 * isb + (j0 & 127), kb * 64, n0, scr, lane); continue; } r -= I_UP;
        if (r < I_OUT) { const int kb = r / 32, nb = r % 32; transpose_item(P.w_out, DM, DM, (bf16*)(P.ws + WS_WOUT), nb * 32, kb * 64, nb * 32, scr, lane); continue; } r -= I_OUT;
        { const int kb = r / 32, nb = r % 32; transpose_item(P.w_down, DFF, DM, (bf16*)(P.ws + WS_WDN), nb * 32, kb * 64, nb * 32, scr, lane); }
    }
}

__device__ __forceinline__ void phase1(const Params& P, LAS unsigned char* lds, int tid, int wave, int lane) {
    const float* modp = (const float*)(P.ws + WS_MODP);
    float* mod = (float*)(P.ws + WS_MOD);
    bf16* H1 = (bf16*)(P.ws + WS_R0);
    for (int idx = blockIdx.x * 512 + tid; idx < 64 * 8192; idx += gridDim.x * 512) {
        const float s = (modp[idx] + modp[idx + 524288]) + (modp[idx + 2 * 524288] + modp[idx + 3 * 524288]);
        mod[idx] = s;
        const int col = idx & 8191, bs = idx >> 13;
        if (col >= 3072 && col < 4096) H1[(size_t)(MT + bs) * DM + (col - 3072)] = (bf16)(pk2(s, 0.f) & 0xffffu);
    }
    LAS float* lv = (LAS float*)lds;
    const int rpb = (MT + (int)gridDim.x - 1) / (int)gridDim.x, rbeg = (int)blockIdx.x * rpb, rend = (rbeg + rpb < MT) ? rbeg + rpb : MT;
    if (rbeg < rend) {
        const int bs0 = rbeg < MP ? (rbeg >> 11) : 32 + ((rbeg - MP) >> 6), bs1 = (rend - 1) < MP ? ((rend - 1) >> 11) : 32 + ((rend - 1 - MP) >> 6);
        const int nsl = bs1 - bs0 + 1;
        __syncthreads();
        for (int i = tid; i < nsl * 2048; i += 512) { const int sl = i >> 11, which = (i >> 10) & 1, col = i & 1023; const size_t o = (size_t)(bs0 + sl) * 8192 + which * 1024 + col;
            float sv = (modp[o] + modp[o + 524288]) + (modp[o + 2 * 524288] + modp[o + 3 * 524288]);
            if (which) sv = P.ln1[col] * (1.f + sv);
            lv[i] = sv; }
        __syncthreads();
#pragma unroll 2
        for (int row = rbeg + wave; row < rend; row += 8) {
            const int bs = row < MP ? (row >> 11) : 32 + ((row - MP) >> 6);
            const LAS float* lvs = lv + (bs - bs0) * 2048;
            const float* xr = (row < MP ? P.x_p + (size_t)row * DM : P.x_s + (size_t)(row - MP) * DM) + 4 * lane;
            f32x4 v[4]; float ss = 0.f;
#pragma unroll
            for (int j = 0; j < 4; ++j) { v[j] = *(const f32x4*)(xr + 256 * j); ss += (v[j].x * v[j].x + v[j].y * v[j].y) + (v[j].z * v[j].z + v[j].w * v[j].w); }
            const float rstd = rsqrtf(wave_sum(ss) * (1.f / DM) + EPS);
            bf16* hr = H1 + (size_t)row * DM + 4 * lane;
#pragma unroll
            for (int j = 0; j < 4; ++j) { const f32x4 sh = *(const LAS f32x4*)(lvs + 256 * j + 4 * lane), gs = *(const LAS f32x4*)(lvs + 1024 + 256 * j + 4 * lane);
                const f32x4 h = v[j] * rstd * gs + sh; u32x2 w; w.x = pk2(h.x, h.y); w.y = pk2(h.z, h.w); *(u32x2*)(hr + 256 * j) = w; }
        }
    }
}

struct OrderX {
    pg8::StaticOrder S; int nX, xpm, xpn0;
    __device__ __forceinline__ bool next(int i, pg8::Unit& u) const {
        const long L = (long)i * S.G + S.c;
        int pm = 0, pn = 0; bool ok = false;
        if (L < S.nwg) { pg8::Unit t; t.pm = 0; t.pn = 0; t.seq = 0; (void)S.next(i, t); pm = t.pm; pn = t.pn; ok = true; }
        else if (L < S.nwg + nX) { pm = xpm; pn = xpn0 + (int)(L - S.nwg); ok = true; }
        u.pm = pm; u.pn = pn; u.seq = i;
        return ok;
    }
    __device__ __forceinline__ void a_ready(const pg8::Unit&) const {}
    __device__ __forceinline__ void done(const pg8::Unit&) const {}
};
struct OrderPub : pg8::StaticOrder {
    unsigned* cnt;
    __device__ __forceinline__ void done(const pg8::Unit& u) const {
        asm volatile("s_waitcnt vmcnt(0)" ::: "memory");
        if ((threadIdx.x & 63) == 0) __hip_atomic_fetch_add(cnt + 64 * u.pm, 1u, __ATOMIC_RELAXED, __HIP_MEMORY_SCOPE_AGENT);
    }
};
typedef const f32x4 (&AccRef)[2][2][4][2];
struct Epi1 {
    static constexpr bool PERM = true, AFTER_DRAIN = false;
    bf16* proj; float* shw; float* out;
    __device__ __forceinline__ void operator()(AccRef acc, const pg8::Unit& u, int wr, int wc, int fr, int fq) const {
        if (u.pm == NTM) {
            if (wr == 0) {
#pragma unroll
                for (int m = 0; m < 4; ++m) { float* d = shw + (size_t)(16 * m + fr) * (2 * DFF) + 256 * (u.pn - 11) + 32 * wc + 8 * fq;
#pragma unroll
                    for (int bj = 0; bj < 2; ++bj)
#pragma unroll
                        for (int n = 0; n < 2; ++n) *(f32x4*)(d + 128 * bj + 4 * n) = acc[0][bj][m][n]; }
            }
            return;
        }
        const unsigned row0 = u.pm * 256 + wr * 64 + fr, col0 = u.pn * 256 + wc * 32 + 8 * fq;
#pragma unroll
        for (int ai = 0; ai < 2; ++ai)
#pragma unroll
            for (int m = 0; m < 4; ++m) { const unsigned o = (row0 + 128 * ai + 16 * m) * (unsigned)INW + col0;
#pragma unroll
                for (int bj = 0; bj < 2; ++bj) { const f32x4 v0 = acc[ai][bj][m][0], v1 = acc[ai][bj][m][1];
                    u32x4 w; w.x = pk2(v0[0], v0[1]); w.y = pk2(v0[2], v0[3]); w.z = pk2(v1[0], v1[1]); w.w = pk2(v1[2], v1[3]);
                    *(u32x4*)(proj + (o + 128 * bj)) = w; }
                asm volatile("" ::: "memory"); }
        if (u.pn == 10) {
            const unsigned c = 32 * wc + 8 * fq;
#pragma unroll
            for (int ai = 0; ai < 2; ++ai)
#pragma unroll
                for (int m = 0; m < 4; ++m) { const unsigned row = row0 + 128 * ai + 16 * m; unsigned ok, ov;
                    if (row < (unsigned)MP) { const unsigned t = row & 2047; if (t < SEQ - 128) continue; const unsigned o = ((row >> 11) * 128 + (t - (SEQ - 128))) * 128 + c; ok = (unsigned)OFF_PK + o; ov = (unsigned)OFF_PV + o; }
                    else { const unsigned o = (row - MP) * 128 + c; ok = (unsigned)OFF_SK + o; ov = (unsigned)OFF_SV + o; }
                    *(f32x4*)(out + ok) = acc[ai][0][m][0]; *(f32x4*)(out + ok + 4) = acc[ai][0][m][1];
                    *(f32x4*)(out + ov) = acc[ai][1][m][0]; *(f32x4*)(out + ov + 4) = acc[ai][1][m][1];
                    asm volatile("" ::: "memory"); }
        }
    }
};
struct Epi2 {
    static constexpr bool PERM = true, AFTER_DRAIN = false;
    const float *xp, *xs, *mod, *ln2; bf16* x1; bf16* a2; float* ss;
    __device__ __forceinline__ void operator()(AccRef acc, const pg8::Unit& u, int wr, int wc, int fr, int fq) const {
        const int col0 = u.pn * 256 + wc * 32 + 8 * fq;
#pragma unroll
        for (int ai = 0; ai < 2; ++ai) {
            const int bs = grp_bs(4 * u.pm + 2 * ai + wr);
            const float* mb = mod + (size_t)bs * 8192;
            f32x4 g1v[2][2], gsv[2][2];
#pragma unroll
            for (int bj = 0; bj < 2; ++bj)
#pragma unroll
                for (int n = 0; n < 2; ++n) { const int c = col0 + 128 * bj + 4 * n; g1v[bj][n] = *(const f32x4*)(mb + 2048 + c);
                    gsv[bj][n] = *(const f32x4*)(ln2 + c) * (*(const f32x4*)(mb + 4096 + c) + 1.0f); }
#pragma unroll
            for (int m = 0; m < 4; ++m) {
                const int row = u.pm * 256 + 128 * ai + 64 * wr + 16 * m + fr;
                const float* xr = row < MP ? xp + (size_t)row * DM : xs + (size_t)(row - MP) * DM;
                float s = 0.f;
#pragma unroll
                for (int bj = 0; bj < 2; ++bj) { f32x4 a[2]; f32x4 xb[2];
#pragma unroll
                    for (int n = 0; n < 2; ++n) { const int c = col0 + 128 * bj + 4 * n; const f32x4 xv = *(const f32x4*)(xr + c); const f32x4 v = xv + g1v[bj][n] * acc[ai][bj][m][n];
                        xb[n] = v; s += (v.x * v.x + v.y * v.y) + (v.z * v.z + v.w * v.w); a[n] = v * gsv[bj][n]; }
                    u32x4 w; w.x = pk2(a[0].x, a[0].y); w.y = pk2(a[0].z, a[0].w); w.z = pk2(a[1].x, a[1].y); w.w = pk2(a[1].z, a[1].w);
                    *(u32x4*)(a2 + (size_t)row * DM + col0 + 128 * bj) = w;
                    w.x = pk2(xb[0].x, xb[0].y); w.y = pk2(xb[0].z, xb[0].w); w.z = pk2(xb[1].x, xb[1].y); w.w = pk2(xb[1].z, xb[1].w);
                    *(u32x4*)(x1 + (size_t)row * DM + col0 + 128 * bj) = w; }
                s += __shfl_xor(s, 16); s += __shfl_xor(s, 32);
                if (fq == 0) ss[(size_t)row * 16 + 4 * u.pn + wc] = s;
            }
        }
    }
};
struct Epi3 {
    static constexpr bool PERM = true, AFTER_DRAIN = false;
    const LAS float* rtab; const float* shw; bf16 *ua, *ub; float* out;
    __device__ __forceinline__ void operator()(AccRef acc, const pg8::Unit& u, int wr, int wc, int fr, int fq) const {
        const unsigned j0 = u.pn * 128 + wc * 32 + 8 * fq, pc0 = u.pn * 256 + wc * 32 + 8 * fq;
#pragma unroll
        for (int ai = 0; ai < 2; ++ai) {
            const unsigned grp = 4 * u.pm + 2 * ai + wr, bs = grp_bs((int)grp);
            const unsigned so = bs * (2 * DFF) + pc0;
            const f32x4 sa0 = *(const f32x4*)(shw + so), sa1 = *(const f32x4*)(shw + so + 4), sb0 = *(const f32x4*)(shw + so + 128), sb1 = *(const f32x4*)(shw + so + 132);
#pragma unroll
            for (int m = 0; m < 4; ++m) {
                const float rstd = rtab[u.seq * 256 + 128 * ai + 64 * wr + 16 * m + fr];
                const unsigned row = grp * 64 + 16 * m + fr;
                const f32x4 a0 = acc[ai][0][m][0] * rstd + sa0, a1 = acc[ai][0][m][1] * rstd + sa1, b0 = acc[ai][1][m][0] * rstd + sb0, b1 = acc[ai][1][m][1] * rstd + sb1;
                u32x4 w; w.x = pk2(a0[0], a0[1]); w.y = pk2(a0[2], a0[3]); w.z = pk2(a1[0], a1[1]); w.w = pk2(a1[2], a1[3]);
                *(u32x4*)(ua + (row * (unsigned)DFF + j0)) = w;
                w.x = pk2(b0[0], b0[1]); w.y = pk2(b0[2], b0[3]); w.z = pk2(b1[0], b1[1]); w.w = pk2(b1[2], b1[3]);
                *(u32x4*)(ub + (row * (unsigned)DFF + j0)) = w;
                if (m == 3 && fr >= 14) {
                    if (grp >= 1024) { float* d = out + OFF_SCONV + ((size_t)(grp - 1024) * 2 + (fr - 14)) * DFF + j0; *(f32x4*)d = a0; *(f32x4*)(d + 4) = a1; }
                    else if ((grp & 31) == 31) { float* d = out + OFF_PCONV + ((size_t)(grp >> 5) * 2 + (fr - 14)) * DFF + j0; *(f32x4*)d = a0; *(f32x4*)(d + 4) = a1; }
                }
            }
        }
    }
};
#ifdef CONV_FUSED
struct Epi3C {
    static constexpr bool PERM = true, AFTER_DRAIN = false;
    const LAS float* rtab; const float *shw, *cw, *cb; bf16* act; float *headA, *headB, *tailA;
    __device__ __forceinline__ void operator()(AccRef acc, const pg8::Unit& u, int wr, int wc, int fr, int fq) const {
        const unsigned j0 = u.pn * 128 + wc * 32 + 8 * fq, pc0 = u.pn * 256 + wc * 32 + 8 * fq;
        f32x4 w0[2], w1[2], w2[2], cbv[2];
#pragma unroll
        for (int n = 0; n < 2; ++n) { w0[n] = *(const f32x4*)(cw + j0 + 4 * n); w1[n] = *(const f32x4*)(cw + DFF + j0 + 4 * n); w2[n] = *(const f32x4*)(cw + 2 * DFF + j0 + 4 * n); cbv[n] = *(const f32x4*)(cb + j0 + 4 * n); }
#pragma unroll
        for (int ai = 0; ai < 2; ++ai) {
            asm volatile("" ::: "memory");
            const unsigned grp = 4 * u.pm + 2 * ai + wr, bs = grp_bs((int)grp);
            const unsigned so = bs * (2 * DFF) + pc0, ho = (grp * 2 + (fr & 1)) * DFF + j0;
            u32x2 ap[4][2], bp[4][2];
            {
                f32x4 sa[2], sb[2];
#pragma unroll
                for (int n = 0; n < 2; ++n) { sa[n] = *(const f32x4*)(shw + so + 4 * n); sb[n] = *(const f32x4*)(shw + so + 128 + 4 * n); }
#pragma unroll
                for (int m = 0; m < 4; ++m) {
                    const float rs = rtab[u.seq * 256 + 128 * ai + 64 * wr + 16 * m + fr];
#pragma unroll
                    for (int n = 0; n < 2; ++n) {
                        const f32x4 av = acc[ai][0][m][n] * rs + sa[n], bv = acc[ai][1][m][n] * rs + sb[n];
                        if (m == 0) { if (fr < 2) { *(f32x4*)(headA + ho + 4 * n) = av; *(f32x4*)(headB + ho + 4 * n) = bv; } }
                        if (m == 3) { if (fr >= 14) *(f32x4*)(tailA + ho + 4 * n) = av; }
                        ap[m][n].x = pk2(av.x, av.y); ap[m][n].y = pk2(av.z, av.w); bp[m][n].x = pk2(bv.x, bv.y); bp[m][n].y = pk2(bv.z, bv.w);
                    }
                }
            }
            asm volatile("" ::: "memory");
#pragma unroll
            for (int n = 0; n < 2; ++n)
#pragma unroll
                for (int h = 0; h < 2; ++h) {
                    unsigned q1 = 0u, q2 = 0u;
#pragma unroll
                    for (int m = 0; m < 4; ++m) {
                        const unsigned a = ap[m][n][h];
                        const unsigned s1 = (unsigned)__builtin_amdgcn_update_dpp((int)a, (int)a, 0x121, 0xf, 0xf, false);
                        const unsigned s2 = (unsigned)__builtin_amdgcn_update_dpp((int)a, (int)a, 0x122, 0xf, 0xf, false);
                        const unsigned pr1 = fr >= 1 ? s1 : q1, pr2 = fr >= 2 ? s2 : q2;
                        q1 = s1; q2 = s2;
                        const float c0 = cbv[n][2 * h] + w0[n][2 * h] * bflo(pr2) + w1[n][2 * h] * bflo(pr1) + w2[n][2 * h] * bflo(a);
                        const float c1 = cbv[n][2 * h + 1] + w0[n][2 * h + 1] * bfhi(pr2) + w1[n][2 * h + 1] * bfhi(pr1) + w2[n][2 * h + 1] * bfhi(a);
                        const unsigned bw = bp[m][n][h];
                        bp[m][n][h] = pk2(silu_f(c0) * bflo(bw), silu_f(c1) * bfhi(bw));
                    }
                    __builtin_amdgcn_sched_barrier(0);
                }
            asm volatile("" ::: "memory");
#pragma unroll
            for (int m = 0; m < 4; ++m) {
                if (m == 0 && fr < 2) continue;
                const unsigned row = grp * 64 + 16 * m + fr;
                const u32x4 w = (u32x4){bp[m][0].x, bp[m][0].y, bp[m][1].x, bp[m][1].y};
                *(u32x4*)(act + (row * (unsigned)DFF + j0)) = w;
            }
        }
    }
};
#endif
struct Epi4 {
    static constexpr bool PERM = true, AFTER_DRAIN = false;
    const float* mod; const bf16* x1; bf16* x2;
    __device__ __forceinline__ void operator()(AccRef acc, const pg8::Unit& u, int wr, int wc, int fr, int fq) const {
        const int col0 = u.pn * 256 + wc * 32 + 8 * fq;
#pragma unroll
        for (int ai = 0; ai < 2; ++ai) {
            const int bs = grp_bs(4 * u.pm + 2 * ai + wr);
            const float* mb = mod + (size_t)bs * 8192 + 5120;
            f32x4 g2v[2][2];
#pragma unroll
            for (int bj = 0; bj < 2; ++bj)
#pragma unroll
                for (int n = 0; n < 2; ++n) g2v[bj][n] = *(const f32x4*)(mb + col0 + 128 * bj + 4 * n);
#pragma unroll
            for (int m = 0; m < 4; ++m) {
                const unsigned ro = (unsigned)(u.pm * 256 + 128 * ai + 64 * wr + 16 * m + fr) * DM + col0;
#pragma unroll
                for (int bj = 0; bj < 2; ++bj) { const u32x4 xw = *(const u32x4*)(x1 + ro + 128 * bj);
                    const f32x4 v0 = (f32x4){bflo(xw.x), bfhi(xw.x), bflo(xw.y), bfhi(xw.y)} + g2v[bj][0] * acc[ai][bj][m][0];
                    const f32x4 v1 = (f32x4){bflo(xw.z), bfhi(xw.z), bflo(xw.w), bfhi(xw.w)} + g2v[bj][1] * acc[ai][bj][m][1];
                    u32x4 w; w.x = pk2(v0.x, v0.y); w.y = pk2(v0.z, v0.w); w.z = pk2(v1.x, v1.y); w.w = pk2(v1.z, v1.w);
                    *(u32x4*)(x2 + ro + 128 * bj) = w; }
            }
        }
    }
};
#define GAS __attribute__((address_space(1)))
#define RLX_AGENT __ATOMIC_RELAXED, __HIP_MEMORY_SCOPE_AGENT
#define XB_TMO      128
#define XB_XCNT(j)  (256  + 64 * (j))
#define XB_XSUB(j)  (1280 + 64 * (j))
#define XB_XGEN(j)  (2304 + 64 * (j))
#define XB_TOP      3328
#define XB_TOPGEN   3392
#define XCD_BAR_WORDS 3456
#define XB_SPIN_CAP (1u << 18)

__device__ __forceinline__ unsigned xb_ld(unsigned* p)              { return __hip_atomic_load(p, __ATOMIC_RELAXED, __HIP_MEMORY_SCOPE_AGENT); }
__device__ __forceinline__ unsigned xb_add(unsigned* p, unsigned v) { return __hip_atomic_fetch_add(p, v, __ATOMIC_RELAXED, __HIP_MEMORY_SCOPE_AGENT); }
__device__ __forceinline__ unsigned xb_xcc_id() { return (unsigned)__builtin_amdgcn_s_getreg((3 << 11) | 20) & 0xFu; }
#define XB_SPIN(cond, bar) do { unsigned _sp = 0; while (cond) { __builtin_amdgcn_s_sleep(1); \
    if ((++_sp & 255u) == 0u) { if (xb_ld(&(bar)[XB_TMO])) break; if (_sp > XB_SPIN_CAP) { atomicAdd(&(bar)[XB_TMO], 1u); break; } } } } while (0)

struct XcdBarrier {
    unsigned* bar; unsigned x;
    volatile LAS unsigned* st;
};

__device__ __forceinline__ XcdBarrier xcd_barrier_post(unsigned* bar, volatile LAS unsigned* st) {
    XcdBarrier b; b.bar = bar; b.x = xb_xcc_id(); b.st = st;
    if (threadIdx.x == 0) (void)xb_add(&bar[XB_XCNT(b.x)], 1u);
    return b;
}
__device__ __forceinline__ void xcd_barrier_complete(unsigned* bar, unsigned x, unsigned& nloc, unsigned& nx) {
    const unsigned G = gridDim.x * gridDim.y * gridDim.z;
    unsigned sum, cnt, mine, sp = 0u;
    for (;;) {
        sum = 0u; cnt = 0u; mine = 0u;
#pragma unroll
        for (unsigned j = 0; j < 16; ++j) { const unsigned c = xb_ld(&bar[XB_XCNT(j)]); sum += c; cnt += (c > 0u) ? 1u : 0u; mine = (j == x) ? c : mine; }
        if (sum == G) break;
        __builtin_amdgcn_s_sleep(1);
        if ((++sp & 255u) == 0u) { if (xb_ld(&bar[XB_TMO])) break; if (sp > XB_SPIN_CAP) { atomicAdd(&bar[XB_TMO], 1u); break; } }
    }
    nloc = mine > 0u ? mine : 1u; nx = cnt > 0u ? cnt : 1u;
}

__device__ __forceinline__ void xcd_barrier(const XcdBarrier& b) {
    asm volatile("s_waitcnt vmcnt(0)" ::: "memory");
    __syncthreads();
    if (threadIdx.x == 0) {
        unsigned* bar = b.bar;
        __builtin_amdgcn_s_waitcnt(0);
        unsigned nloc = b.st[0], nx = b.st[1];
        if (nloc == 0u) { xcd_barrier_complete(bar, b.x, nloc, nx); b.st[0] = nloc; b.st[1] = nx; }
        const unsigned old = xb_add(&bar[XB_XSUB(b.x)], 1u);
        const unsigned gen = old / nloc;
        if (old + 1u == (gen + 1u) * nloc) {
            __builtin_amdgcn_fence(__ATOMIC_RELEASE, "agent");
            asm volatile("s_waitcnt vmcnt(0)" ::: "memory");
            const unsigned og = xb_add(&bar[XB_TOP], 1u);
            const unsigned tg = og / nx;
            if (og + 1u == (tg + 1u) * nx) xb_add(&bar[XB_TOPGEN], 1u);
            else XB_SPIN(xb_ld(&bar[XB_TOPGEN]) == tg, bar);
            __builtin_amdgcn_fence(__ATOMIC_ACQUIRE, "agent");
            xb_add(&bar[XB_XGEN(b.x)], 1u);
            asm volatile("s_waitcnt vmcnt(0)" ::: "memory");
        } else {
            XB_SPIN(xb_ld(&bar[XB_XGEN(b.x)]) == gen, bar);
            __builtin_amdgcn_fence(__ATOMIC_ACQUIRE, "agent");
            asm volatile("s_waitcnt vmcnt(0)" ::: "memory");
        }
    }
    __syncthreads();
}
#define MFMA16(a, b, c) __builtin_amdgcn_mfma_f32_16x16x32_bf16((a), (b), (c), 0, 0, 0)
constexpr int RQ = 0, RK = 17408, RKT = 34816, RVT = 53248, RP = 71680, RST = 80896, RO = 115712;
__device__ __forceinline__ void ret_item(const Params& P, LAS unsigned char* lds, int tid, int wave, int lane, int h, int row0, int nchunks, const float* st_in, bool has_in, float* st_out) {
    const bf16* proj = (const bf16*)(P.ws + WS_R1);
    bf16* mix = (bf16*)(P.ws + WS_R2);
    const int fr = lane & 15, fq = lane >> 4;
    const float lg2 = log2f(1.0f - exp2f(-5.0f - (float)h));
    const float kscale = 0.08838834764831845f;
    LAS bf16* Qs = (LAS bf16*)(lds + RQ); LAS bf16* Ks = (LAS bf16*)(lds + RK); LAS bf16* KT = (LAS bf16*)(lds + RKT); LAS bf16* VT = (LAS bf16*)(lds + RVT);
    LAS bf16* Ps = (LAS bf16*)(lds + RP); LAS bf16* ST = (LAS bf16*)(lds + RST); LAS float* Os = (LAS float*)(lds + RO);
    f32x4 st[8];
#pragma unroll
    for (int et = 0; et < 8; ++et) {
        f32x4 v;
#pragma unroll
        for (int r = 0; r < 4; ++r) v[r] = st_in[(size_t)(16 * wave + 4 * fq + r) * 128 + 16 * et + fr];
        asm volatile("" : "+v"(v));
#pragma unroll
        for (int r = 0; r < 4; ++r) v[r] = has_in ? v[r] : 0.f;
        st[et] = v;
    }
    __syncthreads();
#pragma unroll
    for (int et = 0; et < 8; ++et) { u32x2 w; w.x = pk2(st[et][0], st[et][1]); w.y = pk2(st[et][2], st[et][3]); *(LAS u32x2*)(ST + (16 * et + fr) * 136 + 16 * wave + 4 * fq) = w; }
    const size_t goff = (size_t)lane * INW + h * 128 + wave * 16;
    u32x4 pq[2], pk[2], pv[2];
    { const bf16* g = proj + (size_t)row0 * INW + goff;
      pq[0] = *(const u32x4*)(g); pq[1] = *(const u32x4*)(g + 8); pk[0] = *(const u32x4*)(g + 512); pk[1] = *(const u32x4*)(g + 520); pv[0] = *(const u32x4*)(g + 1024); pv[1] = *(const u32x4*)(g + 1032); }
    const float kf = kscale * exp2f(lg2 * (float)(63 - lane));
    const float g64 = exp2f(lg2 * 64.0f);
    for (int c = 0; c < nchunks; ++c) {
        const int rowc = row0 + 64 * c;
        *(LAS u32x4*)(Qs + lane * 136 + wave * 16) = pq[0]; *(LAS u32x4*)(Qs + lane * 136 + wave * 16 + 8) = pq[1];
        *(LAS u32x4*)(Ks + lane * 136 + wave * 16) = pk[0]; *(LAS u32x4*)(Ks + lane * 136 + wave * 16 + 8) = pk[1];
#pragma unroll
        for (int i = 0; i < 2; ++i)
#pragma unroll
            for (int j = 0; j < 4; ++j) { const unsigned wk = pk[i][j], wv = pv[i][j]; const int d = wave * 16 + i * 8 + j * 2;
                const unsigned kk = pk2(bflo(wk) * kf, bfhi(wk) * kf);
                KT[(d) * 72 + lane] = (bf16)(kk & 0xffffu); KT[(d + 1) * 72 + lane] = (bf16)(kk >> 16);
                VT[(d) * 72 + lane] = (bf16)(wv & 0xffffu); VT[(d + 1) * 72 + lane] = (bf16)(wv >> 16); }
        if (c + 1 < nchunks) { const bf16* g = proj + (size_t)(rowc + 64) * INW + goff;
            pq[0] = *(const u32x4*)(g); pq[1] = *(const u32x4*)(g + 8); pk[0] = *(const u32x4*)(g + 512); pk[1] = *(const u32x4*)(g + 520); pv[0] = *(const u32x4*)(g + 1024); pv[1] = *(const u32x4*)(g + 1032); }
        __syncthreads();
        { const int mi = wave >> 1;
#pragma unroll
          for (int jj = 0; jj < 2; ++jj) { const int lj = 2 * (wave & 1) + jj; f32x4 s = (f32x4){0.f, 0.f, 0.f, 0.f};
#pragma unroll
            for (int ks = 0; ks < 4; ++ks) { const bf16x8 a = *(const LAS bf16x8*)(Ks + (16 * mi + fr) * 136 + 32 * ks + 8 * fq), b = *(const LAS bf16x8*)(Qs + (16 * lj + fr) * 136 + 32 * ks + 8 * fq); s = MFMA16(a, b, s); }
            const int l = 16 * lj + fr; float pvv[4];
#pragma unroll
            for (int r = 0; r < 4; ++r) { const int m = 16 * mi + 4 * fq + r; const int dlt = l - m; pvv[r] = dlt >= 0 ? s[r] * kscale * exp2f(lg2 * (float)dlt) : 0.f; }
            u32x2 w; w.x = pk2(pvv[0], pvv[1]); w.y = pk2(pvv[2], pvv[3]); *(LAS u32x2*)(Ps + l * 72 + 16 * mi + 4 * fq) = w; } }
#pragma unroll
        for (int et = 0; et < 8; ++et) st[et] = st[et] * g64;
#pragma unroll
        for (int ks = 0; ks < 2; ++ks) { const bf16x8 a = *(const LAS bf16x8*)(KT + (16 * wave + fr) * 72 + 32 * ks + 8 * fq);
#pragma unroll
            for (int et = 0; et < 8; ++et) { const bf16x8 b = *(const LAS bf16x8*)(VT + (16 * et + fr) * 72 + 32 * ks + 8 * fq); st[et] = MFMA16(a, b, st[et]); } }
        __syncthreads();
        { f32x4 oi[4], oc[4];
#pragma unroll
          for (int lt = 0; lt < 4; ++lt) { oi[lt] = (f32x4){0.f, 0.f, 0.f, 0.f}; oc[lt] = (f32x4){0.f, 0.f, 0.f, 0.f}; }
#pragma unroll
          for (int ks = 0; ks < 2; ++ks) { const bf16x8 b = *(const LAS bf16x8*)(VT + (16 * wave + fr) * 72 + 32 * ks + 8 * fq);
#pragma unroll
            for (int lt = 0; lt < 4; ++lt) { const bf16x8 a = *(const LAS bf16x8*)(Ps + (16 * lt + fr) * 72 + 32 * ks + 8 * fq); oi[lt] = MFMA16(a, b, oi[lt]); } }
#pragma unroll
          for (int ks = 0; ks < 4; ++ks) { const bf16x8 b = *(const LAS bf16x8*)(ST + (16 * wave + fr) * 136 + 32 * ks + 8 * fq);
#pragma unroll
            for (int lt = 0; lt < 4; ++lt) { const bf16x8 a = *(const LAS bf16x8*)(Qs + (16 * lt + fr) * 136 + 32 * ks + 8 * fq); oc[lt] = MFMA16(a, b, oc[lt]); } }
#pragma unroll
          for (int lt = 0; lt < 4; ++lt)
#pragma unroll
            for (int r = 0; r < 4; ++r) { const int l = 16 * lt + 4 * fq + r; Os[l * 132 + 16 * wave + fr] = oi[lt][r] + exp2f(lg2 * (float)(l + 1)) * oc[lt][r]; } }
        __syncthreads();
#pragma unroll
        for (int et = 0; et < 8; ++et) { u32x2 w; w.x = pk2(st[et][0], st[et][1]); w.y = pk2(st[et][2], st[et][3]); *(LAS u32x2*)(ST + (16 * et + fr) * 136 + 16 * wave + 4 * fq) = w; }
        { unsigned gv[8];
#pragma unroll
          for (int i = 0; i < 8; ++i) gv[i] = *(const unsigned*)(proj + (size_t)(rowc + 8 * wave + i) * INW + 1536 + h * 128 + 2 * lane);
#pragma unroll
          for (int i = 0; i < 8; ++i) { const int l = 8 * wave + i; const f32x2 o = *(const LAS f32x2*)(Os + l * 132 + 2 * lane);
            const float ssq = wave_sum_dpp(o.x * o.x + o.y * o.y); const float rstd = rsqrtf(ssq * (1.f / 128.f) + EPS);
            const float g0 = bflo(gv[i]), g1 = bfhi(gv[i]);
            *(unsigned*)(mix + (size_t)(rowc + l) * DM + h * 128 + 2 * lane) = pk2(silu_f(g0) * o.x * rstd, silu_f(g1) * o.y * rstd); } }
    }
#pragma unroll
    for (int et = 0; et < 8; ++et)
#pragma unroll
        for (int r = 0; r < 4; ++r) st_out[(size_t)(16 * wave + 4 * fq + r) * 128 + 16 * et + fr] = st[et][r];
}
constexpr int AK = 0, AVT = 27648;
__device__ __forceinline__ void att_item(const Params& P, LAS unsigned char* lds, int tid, int wave, int lane, bool sample, int b, int n, int g) {
    const bf16* proj = (const bf16*)(P.ws + WS_R1);
    bf16* mix = (bf16*)(P.ws + WS_R2);
    const int fr = lane & 15, fq = lane >> 4;
    LAS bf16* Kl = (LAS bf16*)(lds + AK); LAS bf16* VTl = (LAS bf16*)(lds + AVT);
    const int qrow0 = sample ? MP + 64 * b : b * SEQ + 64 * n;
    const int jmin = sample ? 0 : (n >= 2 ? 0 : 64 * (2 - n));
    __syncthreads();
#pragma unroll
    for (int i = 0; i < 3; ++i) { const int p = tid + 512 * i, j = p >> 3, c8 = p & 7; u32x4 w = (u32x4){0u, 0u, 0u, 0u};
        if (j >= jmin) {
            if (sample && j < 128) { const float* s = P.cache_k + ((size_t)(b * 128 + j) * 2 + g) * 64 + 8 * c8; const f32x4 a = *(const f32x4*)s, bb = *(const f32x4*)(s + 4);
                w.x = pk2(a.x, a.y); w.y = pk2(a.z, a.w); w.z = pk2(bb.x, bb.y); w.w = pk2(bb.z, bb.w); }
            else { const int row = sample ? MP + 64 * b + (j - 128) : b * SEQ + 64 * (n - 2) + j; w = *(const u32x4*)(proj + (size_t)row * INW + 2560 + g * 64 + 8 * c8); } }
        *(LAS u32x4*)(Kl + j * 72 + 8 * c8) = w; }
#pragma unroll
    for (int i = 0; i < 3; ++i) { const int j = 64 * i + lane; u32x4 w = (u32x4){0u, 0u, 0u, 0u};
        if (j >= jmin) {
            if (sample && j < 128) { const float* s = P.cache_v + ((size_t)(b * 128 + j) * 2 + g) * 64 + 8 * wave; const f32x4 a = *(const f32x4*)s, bb = *(const f32x4*)(s + 4);
                w.x = pk2(a.x, a.y); w.y = pk2(a.z, a.w); w.z = pk2(bb.x, bb.y); w.w = pk2(bb.z, bb.w); }
            else { const int row = sample ? MP + 64 * b + (j - 128) : b * SEQ + 64 * (n - 2) + j; w = *(const u32x4*)(proj + (size_t)row * INW + 2688 + g * 64 + 8 * wave); } }
#pragma unroll
        for (int e = 0; e < 4; ++e) { VTl[(8 * wave + 2 * e) * 200 + j] = (bf16)(w[e] & 0xffffu); VTl[(8 * wave + 2 * e + 1) * 200 + j] = (bf16)(w[e] >> 16); } }
    const int r = wave >> 1, qh = wave & 1, head = 4 * g + r;
    const float slope = exp2f(-(float)(head + 1));
    const float sink = P.sinks[head];
    const float L2E = 1.4426950408889634f;
    __syncthreads();
#pragma unroll 1
    for (int qt = 0; qt < 2; ++qt) {
        asm volatile("" ::: "memory");
        const int qi = 32 * qh + 16 * qt + fr;
        bf16x8 qf[2];
#pragma unroll
        for (int ks = 0; ks < 2; ++ks) qf[ks] = *(const bf16x8*)(proj + (size_t)(qrow0 + qi) * INW + 2048 + head * 64 + 32 * ks + 8 * fq);
        f32x4 s[12];
#pragma unroll
        for (int kt = 0; kt < 12; ++kt) { s[kt] = (f32x4){0.f, 0.f, 0.f, 0.f};
#pragma unroll
            for (int ks = 0; ks < 2; ++ks) { const bf16x8 a = *(const LAS bf16x8*)(Kl + (16 * kt + fr) * 72 + 32 * ks + 8 * fq); s[kt] = MFMA16(a, qf[ks], s[kt]); } }
        float mx = sink;
#pragma unroll
        for (int kt = 0; kt < 12; ++kt)
#pragma unroll
            for (int rr = 0; rr < 4; ++rr) { const int j = 16 * kt + 4 * fq + rr; const int dist = 128 + qi - j;
                float v = s[kt][rr] * 0.125f - slope * fabsf((float)dist);
                v = j >= jmin ? v : -INFINITY; s[kt][rr] = v; mx = fmaxf(mx, v); }
        mx = fmaxf(mx, __shfl_xor(mx, 16)); mx = fmaxf(mx, __shfl_xor(mx, 32));
        float ls = 0.f;
#pragma unroll
        for (int kt = 0; kt < 12; ++kt)
#pragma unroll
            for (int rr = 0; rr < 4; ++rr) { const float p = exp2f((s[kt][rr] - mx) * L2E); s[kt][rr] = p; ls += p; }
        ls += __shfl_xor(ls, 16); ls += __shfl_xor(ls, 32);
        const float inv = 1.0f / (ls + exp2f((sink - mx) * L2E));
        f32x4 o[4];
#pragma unroll
        for (int dt = 0; dt < 4; ++dt) o[dt] = (f32x4){0.f, 0.f, 0.f, 0.f};
#pragma unroll
        for (int kk = 0; kk < 6; ++kk) {
            u32x4 w; w.x = pk2(s[2 * kk][0], s[2 * kk][1]); w.y = pk2(s[2 * kk][2], s[2 * kk][3]); w.z = pk2(s[2 * kk + 1][0], s[2 * kk + 1][1]); w.w = pk2(s[2 * kk + 1][2], s[2 * kk + 1][3]);
            const bf16x8 pb = __builtin_bit_cast(bf16x8, w);
#pragma unroll
            for (int dt = 0; dt < 4; ++dt) { const LAS bf16* vp = VTl + (16 * dt + fr) * 200 + 32 * kk + 4 * fq;
                const u32x2 lo = *(const LAS u32x2*)vp, hi = *(const LAS u32x2*)(vp + 16);
                const u32x4 aw = (u32x4){lo.x, lo.y, hi.x, hi.y}; const bf16x8 a = __builtin_bit_cast(bf16x8, aw);
                o[dt] = MFMA16(a, pb, o[dt]); }
        }
        bf16* mp = mix + (size_t)(qrow0 + qi) * DM + 512 + head * 64 + 4 * fq;
#pragma unroll
        for (int dt = 0; dt < 4; ++dt) { const f32x4 v = o[dt] * inv; u32x2 w; w.x = pk2(v[0], v[1]); w.y = pk2(v[2], v[3]); *(u32x2*)(mp + 16 * dt) = w; }
    }
}
__device__ __forceinline__ void phase3(const Params& P, LAS unsigned char* lds, int tid, int wave, int lane) {
    const int G = gridDim.x, NR = G / 2, blk = blockIdx.x;
    if (blk < NR) {
#ifndef NO_RET
#ifdef PROBE_RETX2
        for (int rep = 0; rep < 2; ++rep)
#endif
        for (int it = blk; it < 256; it += NR) {
            const bool sample = it >= 128; const int bh = it & 127, b = bh >> 2, h = bh & 3;
            ret_item(P, lds, tid, wave, lane, h, sample ? MP + 64 * b : b * SEQ, sample ? 1 : 32, P.state_ret + (size_t)bh * 16384, sample, P.out + (sample ? OFF_SRET : OFF_PRET) + (size_t)bh * 16384);
        }
#endif
    } else {
#ifndef NO_ATT
#ifdef PROBE_ATTX2
        for (int rep = 0; rep < 2; ++rep)
#endif
        for (int it = blk - NR; it < 2112; it += G - NR) {
            const bool sample = it >= 2048;
            att_item(P, lds, tid, wave, lane, sample, sample ? (it - 2048) >> 1 : it >> 6, sample ? 2 : (it >> 1) & 31, it & 1);
        }
#endif
    }
}

__device__ __forceinline__ void phase6(const Params& P, int tid) {
    const bf16* ua = (const bf16*)(P.ws + WS_R1); bf16* ub = (bf16*)(P.ws + WS_R2);
    constexpr int CH = DFF / 8;
    const int total = MT * CH;
    for (int idx = blockIdx.x * 512 + tid; idx < total; idx += gridDim.x * 512) {
        const int row = idx / CH, j = (idx - row * CH) * 8;
        const bool smp = row >= MP; const int t = smp ? ((row - MP) & 63) : (row & 2047);
        float a[8], p1[8], p2[8], bb[8];
        unpack8(*(const u32x4*)(ua + (size_t)row * DFF + j), a);
        unpack8(*(const u32x4*)(ub + (size_t)row * DFF + j), bb);
        if (t >= 1) unpack8(*(const u32x4*)(ua + (size_t)(row - 1) * DFF + j), p1);
        else if (smp) { const float* s = P.state_conv + ((size_t)((row - MP) >> 6) * 2 + 1) * DFF + j; const f32x4 x = *(const f32x4*)s, y = *(const f32x4*)(s + 4); p1[0] = x.x; p1[1] = x.y; p1[2] = x.z; p1[3] = x.w; p1[4] = y.x; p1[5] = y.y; p1[6] = y.z; p1[7] = y.w; }
        else {
#pragma unroll
            for (int e = 0; e < 8; ++e) p1[e] = 0.f; }
        if (t >= 2) unpack8(*(const u32x4*)(ua + (size_t)(row - 2) * DFF + j), p2);
        else if (smp) { const float* s = P.state_conv + ((size_t)((row - MP) >> 6) * 2 + t) * DFF + j; const f32x4 x = *(const f32x4*)s, y = *(const f32x4*)(s + 4); p2[0] = x.x; p2[1] = x.y; p2[2] = x.z; p2[3] = x.w; p2[4] = y.x; p2[5] = y.y; p2[6] = y.z; p2[7] = y.w; }
        else {
#pragma unroll
            for (int e = 0; e < 8; ++e) p2[e] = 0.f; }
        float r[8];
#pragma unroll
        for (int h = 0; h < 2; ++h) { const f32x4 w0 = *(const f32x4*)(P.conv_w + j + 4 * h), w1 = *(const f32x4*)(P.conv_w + DFF + j + 4 * h), w2 = *(const f32x4*)(P.conv_w + 2 * DFF + j + 4 * h), cb = *(const f32x4*)(P.conv_b + j + 4 * h);
#pragma unroll
            for (int e = 0; e < 4; ++e) { const float cv = cb[e] + w0[e] * p2[4 * h + e] + w1[e] * p1[4 * h + e] + w2[e] * a[4 * h + e]; r[4 * h + e] = silu_f(cv) * bb[4 * h + e]; } }
        u32x4 w; w.x = pk2(r[0], r[1]); w.y = pk2(r[2], r[3]); w.z = pk2(r[4], r[5]); w.w = pk2(r[6], r[7]);
        *(u32x4*)(ub + (size_t)row * DFF + j) = w;
    }
}
#ifdef CONV_FUSED
__device__ __forceinline__ void phase6c(const Params& P, int tid) {
    const float* headA = (const float*)(P.ws + WS_R1); const float* headB = headA + HT_STRIDE; const float* tailA = headA + 2 * HT_STRIDE;
    bf16* act = (bf16*)(P.ws + WS_R2);
    const int total = NGRP * DFF;
    for (int idx = blockIdx.x * 512 + tid; idx < total; idx += gridDim.x * 512) {
        const int g = idx / DFF, j = idx - g * DFF;
        float p0, p1;
        if (g < 1024) { if ((g & 31) == 0) { p0 = 0.f; p1 = 0.f; } else { p0 = tailA[((size_t)(g - 1) * 2) * DFF + j]; p1 = tailA[((size_t)(g - 1) * 2 + 1) * DFF + j]; } }
        else { p0 = P.state_conv[((size_t)(g - 1024) * 2) * DFF + j]; p1 = P.state_conv[((size_t)(g - 1024) * 2 + 1) * DFF + j]; }
        const float a0 = headA[((size_t)g * 2) * DFF + j], a1 = headA[((size_t)g * 2 + 1) * DFF + j];
        const float b0 = headB[((size_t)g * 2) * DFF + j], b1 = headB[((size_t)g * 2 + 1) * DFF + j];
        const float w0 = P.conv_w[j], w1 = P.conv_w[DFF + j], w2 = P.conv_w[2 * DFF + j], cb = P.conv_b[j];
        const float c0 = cb + w0 * p0 + w1 * p1 + w2 * a0, c1 = cb + w0 * p1 + w1 * a0 + w2 * a1;
        act[(size_t)(64 * g) * DFF + j] = (bf16)(pk2(silu_f(c0) * b0, 0.f) & 0xffffu);
        act[(size_t)(64 * g + 1) * DFF + j] = (bf16)(pk2(silu_f(c1) * b1, 0.f) & 0xffffu);
        const float t0 = tailA[((size_t)g * 2) * DFF + j], t1 = tailA[((size_t)g * 2 + 1) * DFF + j];
        if (g < 1024) { if ((g & 31) == 31) { P.out[OFF_PCONV + ((size_t)(g >> 5) * 2) * DFF + j] = t0; P.out[OFF_PCONV + ((size_t)(g >> 5) * 2 + 1) * DFF + j] = t1; } }
        else { P.out[OFF_SCONV + ((size_t)(g - 1024) * 2) * DFF + j] = t0; P.out[OFF_SCONV + ((size_t)(g - 1024) * 2 + 1) * DFF + j] = t1; }
    }
}
#endif
__device__ __forceinline__ void phase8(const Params& P, int wave, int lane) {
    const float* mod = (const float*)(P.ws + WS_MOD); const bf16* x2 = (const bf16*)(P.ws + WS_R0);
    const int gw = blockIdx.x * 8 + wave, NGW = gridDim.x * 8;
#pragma unroll 2
    for (int row = gw; row < MT; row += NGW) {
        const int bs = row < MP ? (row >> 11) : 32 + ((row - MP) >> 6);
        float* yr = P.out + (size_t)row * DM + 8 * lane;
        const float* mb = mod + (size_t)bs * 8192 + 6144 + 8 * lane;
        const bf16* xr = x2 + (size_t)row * DM + 8 * lane;
        float v[2][8]; float ss = 0.f;
#pragma unroll
        for (int j = 0; j < 2; ++j) { unpack8(*(const u32x4*)(xr + 512 * j), v[j]);
#pragma unroll
            for (int e = 0; e < 8; ++e) ss += v[j][e] * v[j][e]; }
        const float rstd = rsqrtf(wave_sum(ss) * (1.f / DM) + EPS);
#pragma unroll
        for (int j = 0; j < 2; ++j)
#pragma unroll
            for (int h = 0; h < 2; ++h) { const int o = 512 * j + 4 * h; const f32x4 sh = *(const f32x4*)(mb + o), sc = *(const f32x4*)(mb + 1024 + o), gn = *(const f32x4*)(P.normf + 8 * lane + o);
                const f32x4 x = (f32x4){v[j][4 * h], v[j][4 * h + 1], v[j][4 * h + 2], v[j][4 * h + 3]};
                *(f32x4*)(yr + o) = x * rstd * gn * (sc + 1.0f) + sh; }
    }
}
__device__ __forceinline__ void phase8q(const Params& P, LAS unsigned char* lds, int tid, int wave, int lane) {
    const float* mod = (const float*)(P.ws + WS_MOD);
    unsigned* cnt = (unsigned*)(P.ws + WS_CNT7); unsigned* ticket = (unsigned*)(P.ws + WS_TICKET);
    LAS int* ord = (LAS int*)(lds + 131072);
    LAS int* flag = ord + 272;
    pg8::StaticOrder S; S.init(MT, DM, (int)gridDim.x, 0);
    for (int i = tid; i < NTM; i += 512) flag[i] = 0;
    __syncthreads();
    { const int full = (S.nwg / S.G) * S.G; for (int L = full + tid; L < S.nwg; L += 512) { pg8::Unit u; S.map(L, u); flag[u.pm] = 1; } }
    __syncthreads();
    if (tid == 0) { int k = 0; for (int i = 0; i < NTM; ++i) if (!flag[i]) ord[k++] = i; for (int i = 0; i < NTM; ++i) if (flag[i]) ord[k++] = i; }
    __syncthreads();
    for (;;) {
        if (tid == 0) flag[268] = (int)__hip_atomic_fetch_add(ticket, 1u, __ATOMIC_RELAXED, __HIP_MEMORY_SCOPE_AGENT);
        __syncthreads();
        const int tk = flag[268];
        if (tk >= NTM * 4) break;
        const int pm = ord[tk >> 2], rb = tk & 3;
        if (wave == 0) {
            unsigned spins = 0;
            while ((unsigned)__builtin_amdgcn_readfirstlane(__hip_atomic_load(cnt + 64 * pm, __ATOMIC_RELAXED, __HIP_MEMORY_SCOPE_AGENT)) < 32u) { __builtin_amdgcn_s_sleep(4); if (++spins > (1u << 22)) break; }
            __builtin_amdgcn_fence(__ATOMIC_ACQUIRE, "agent");
            asm volatile("s_waitcnt vmcnt(0)" ::: "memory");
        }
        __syncthreads();
#pragma unroll 2
        for (int i = 0; i < 8; ++i) {
            const int row = pm * 256 + rb * 64 + wave * 8 + i;
            const int bs = row < MP ? (row >> 11) : 32 + ((row - MP) >> 6);
            float* yr = P.out + (size_t)row * DM + 4 * lane;
            const float* mb = mod + (size_t)bs * 8192 + 6144 + 4 * lane;
            f32x4 v[4]; float ss = 0.f;
#pragma unroll
            for (int j = 0; j < 4; ++j) { v[j] = *(const f32x4*)(yr + 256 * j); ss += (v[j].x * v[j].x + v[j].y * v[j].y) + (v[j].z * v[j].z + v[j].w * v[j].w); }
            const float rstd = rsqrtf(wave_sum(ss) * (1.f / DM) + EPS);
#pragma unroll
            for (int j = 0; j < 4; ++j) { const f32x4 sh = *(const f32x4*)(mb + 256 * j), sc = *(const f32x4*)(mb + 1024 + 256 * j), gn = *(const f32x4*)(P.normf + 4 * lane + 256 * j);
                *(f32x4*)(yr + 256 * j) = v[j] * rstd * gn * (sc + 1.0f) + sh; }
        }
    }
}

#ifndef N_LAUNCH
#define N_LAUNCH 1
#endif
#define LAUNDER_TID() int tid = threadIdx.x; asm volatile("" : "+v"(tid)); const int lane = tid & 63, wave = __builtin_amdgcn_readfirstlane(tid >> 6); (void)lane; (void)wave
template <int PHM>
__global__ void __launch_bounds__(512) fwd_mega(Params P) {
    extern __shared__ __attribute__((aligned(16))) unsigned char lds_raw[];
    LAS unsigned char* lds = (LAS unsigned char*)lds_raw;
    const int G = gridDim.x;
    unsigned char* ws = P.ws;
    volatile LAS unsigned* misc = (volatile LAS unsigned*)(lds + LDS_MISC);
    if (threadIdx.x < 2) misc[threadIdx.x] = 0u;
    __syncthreads();
    XcdBarrier bar; bar.bar = (unsigned*)(ws + WS_BAR); bar.x = 0; bar.st = misc;
#define GSYNC(a, b) do { if ((PHM & (a)) && (PHM & (b))) xcd_barrier(bar); } while (0)
    if constexpr ((PHM & 1) != 0) { LAUNDER_TID(); phase0(P, lds, wave, lane);
      if (blockIdx.x == 0) for (int i = tid; i < XCD_BAR_WORDS; i += 512) ((unsigned*)(ws + WS_BAR))[i] = 0u;
      if (blockIdx.x == 1) { for (int i = tid; i < NTM * 64; i += 512) ((unsigned*)(ws + WS_CNT7))[i] = 0u; if (tid < 64) ((unsigned*)(ws + WS_TICKET))[tid] = 0u; } }
    if constexpr ((PHM & 1) != 0 && (PHM & 2) != 0) {
      cg::this_grid().sync();
      bar = xcd_barrier_post((unsigned*)(ws + WS_BAR), misc); }
    if constexpr ((PHM & 2) != 0) { LAUNDER_TID(); phase1(P, lds, tid, wave, lane); }
    GSYNC(2, 4);
    if constexpr ((PHM & 4) != 0) {
      pg8::Gemm g{(const bf16*)(ws + WS_R0), (const bf16*)(ws + WS_WIN), MT, INW, DM};
      OrderX S; S.S.init(MT, INW, G, (int)blockIdx.x); S.nX = 22; S.xpm = NTM; S.xpn0 = 11;
      Epi1 E{(bf16*)(ws + WS_R1), (float*)(ws + WS_SHW), P.out};
      pg8::gemm_phase<Epi1, OrderX, true, true>(lds, g, S, E); }
    GSYNC(4, 8);
    if constexpr ((PHM & 8) != 0) { LAUNDER_TID(); phase3(P, lds, tid, wave, lane);
#ifdef PROBE_P3X2
      cg::this_grid().sync(); phase3(P, lds, tid, wave, lane);
#endif
    }
    GSYNC(8, 16);
    if constexpr ((PHM & 16) != 0) {
      pg8::Gemm g{(const bf16*)(ws + WS_R2), (const bf16*)(ws + WS_WOUT), MT, DM, DM};
      pg8::StaticOrder S; S.init(MT, DM, G, (int)blockIdx.x);
      Epi2 E{P.x_p, P.x_s, (const float*)(ws + WS_MOD), P.ln2, (bf16*)(ws + WS_X1B), (bf16*)(ws + WS_R0), (float*)(ws + WS_SS1)};
      pg8::gemm_phase<Epi2, pg8::StaticOrder, true, true>(lds, g, S, E); }
    GSYNC(16, 32);
    if constexpr ((PHM & 32) != 0) {
      LAUNDER_TID();
      pg8::Gemm g{(const bf16*)(ws + WS_R0), (const bf16*)(ws + WS_WUP), MT, 2 * DFF, DM};
      pg8::StaticOrder S; S.init(MT, 2 * DFF, G, (int)blockIdx.x);
      LAS float* rtab = (LAS float*)(lds + 131072);
      { pg8::Unit u; const float* ss = (const float*)(ws + WS_SS1);
        for (int i = 0; S.next(i, u) && i < 24; ++i) if (tid < 256) { const f32x4* sp = (const f32x4*)(ss + (size_t)(u.pm * 256 + tid) * 16);
            const f32x4 q0 = sp[0], q1 = sp[1], q2 = sp[2], q3 = sp[3];
            const float tot = ((q0.x + q0.y) + (q0.z + q0.w)) + ((q1.x + q1.y) + (q1.z + q1.w)) + ((q2.x + q2.y) + (q2.z + q2.w)) + ((q3.x + q3.y) + (q3.z + q3.w));
            rtab[i * 256 + tid] = rsqrtf(tot * (1.f / DM) + EPS); }
        __syncthreads(); }
#ifdef CONV_FUSED
      float* hA = (float*)(ws + WS_R1);
      Epi3C E{rtab, (const float*)(ws + WS_SHW), P.conv_w, P.conv_b, (bf16*)(ws + WS_R2), hA, hA + HT_STRIDE, hA + 2 * HT_STRIDE};
      pg8::gemm_phase<Epi3C, pg8::StaticOrder, true, true>(lds, g, S, E);
#else
      Epi3 E{rtab, (const float*)(ws + WS_SHW), (bf16*)(ws + WS_R1), (bf16*)(ws + WS_R2), P.out};
      pg8::gemm_phase<Epi3, pg8::StaticOrder, true, true>(lds, g, S, E);
#endif
#ifdef PROBE_P5X2
      cg::this_grid().sync(); pg8::gemm_phase<Epi3, pg8::StaticOrder, true, true>(lds, g, S, E);
#endif
    }
    GSYNC(32, 64);
#ifdef CONV_FUSED
    if constexpr ((PHM & 64) != 0) { LAUNDER_TID(); phase6c(P, tid); }
#else
    if constexpr ((PHM & 64) != 0) { LAUNDER_TID(); phase6(P, tid); }
#endif
    GSYNC(64, 128);
    if constexpr ((PHM & 128) != 0) {
      pg8::Gemm g{(const bf16*)(ws + WS_R2), (const bf16*)(ws + WS_WDN), MT, DM, DFF};
#ifdef P8_QUEUE
      OrderPub S; S.init(MT, DM, G, (int)blockIdx.x); S.cnt = (unsigned*)(ws + WS_CNT7);
      Epi4 E{(const float*)(ws + WS_MOD), (const bf16*)(ws + WS_X1B), (bf16*)(ws + WS_R0)};
      pg8::gemm_phase<Epi4, OrderPub, true, true>(lds, g, S, E); }
    if constexpr ((PHM & 256) != 0) { LAUNDER_TID(); phase8q(P, lds, tid, wave, lane); }
#else
      pg8::StaticOrder S; S.init(MT, DM, G, (int)blockIdx.x);
      Epi4 E{(const float*)(ws + WS_MOD), (const bf16*)(ws + WS_X1B), (bf16*)(ws + WS_R0)};
      pg8::gemm_phase<Epi4, pg8::StaticOrder, true, true>(lds, g, S, E); }
    GSYNC(128, 256);
    if constexpr ((PHM & 256) != 0) { LAUNDER_TID(); phase8(P, wave, lane); }
#endif
}

template <int PHM> static bool launch_one(const Params& p, int grid, bool coop, hipStream_t stream) {
    static bool attr_done = false;
    if (!attr_done) { if (hipFuncSetAttribute((const void*)fwd_mega<PHM>, hipFuncAttributeMaxDynamicSharedMemorySize, LDS_BYTES) != hipSuccess) { fprintf(stderr, "kernel_launch: hipFuncSetAttribute failed\n"); return false; } attr_done = true; }
    hipError_t e;
    if (coop) { Params pc = p; void* args[] = {&pc}; e = hipLaunchCooperativeKernel((const void*)fwd_mega<PHM>, dim3(grid), dim3(512), args, LDS_BYTES, stream); }
    else { hipLaunchKernelGGL(fwd_mega<PHM>, dim3(grid), dim3(512), LDS_BYTES, stream, p); e = hipPeekAtLastError(); }
    if (e != hipSuccess) { fprintf(stderr, "launch (mask %d) failed: %s (grid %d)\n", PHM, hipGetErrorString(e), grid); return false; }
    return true;
}
extern "C" void kernel_launch(void* const* d_in, const int* in_sizes, int n_in, void* d_out, int out_size, void* d_ws, size_t ws_size, hipStream_t stream) {
    static int grid = 0;
    if (grid == 0) {
        if (n_in != 22 || (size_t)out_size != OUT_TOTAL || ws_size < WS_END) { fprintf(stderr, "kernel_launch: unexpected sizes n_in %d out %d ws %zu\n", n_in, out_size, ws_size); grid = -1; return; }
        int dev = 0, cus = 0;
        (void)hipGetDevice(&dev);
        (void)hipDeviceGetAttribute(&cus, hipDeviceAttributeMultiprocessorCount, dev);
        grid = cus;
        if (grid > 256) grid = 256;
        if (grid < 2) grid = -1;
    }
    if (grid < 0) return;
    Params p{};
    const float** pp = (const float**)&p;
    for (int i = 0; i < 22; ++i) pp[i] = (const float*)d_in[i];
    p.out = (float*)d_out; p.ws = (unsigned char*)d_ws;
#if N_LAUNCH == 1
    launch_one<511>(p, grid, true, stream);
#else
    launch_one<1>(p, grid, false, stream) && launch_one<2>(p, grid, false, stream) && launch_one<4>(p, grid, false, stream) && launch_one<8>(p, grid, false, stream) &&
    launch_one<16>(p, grid, false, stream) && launch_one<32>(p, grid, false, stream) && launch_one<64>(p, grid, false, stream) && launch_one<128>(p, grid, false, stream) && launch_one<256>(p, grid, false, stream);
#endif
}
```

```cpp
#define CONV_FUSED 1
#include <hip/hip_runtime.h>
#include <hip/hip_cooperative_groups.h>
#include <cstdio>
#include <cstdint>
namespace cg = cooperative_groups;
namespace pg8 {
#define PG8_LAS __attribute__((address_space(3)))
typedef unsigned short bf16_t;
typedef short bf16x8 __attribute__((ext_vector_type(8)));
typedef float f32x4 __attribute__((ext_vector_type(4)));
typedef unsigned u32x4 __attribute__((ext_vector_type(4)));
constexpr int BM = 256, BK = 64, HALF = 128, HTB = HALF * BK * 2  , STAGE_BYTES = 8 * HTB, NXCD = 8, WGM = 8;

__host__ __device__ __forceinline__ int lds_byte(int r, int c) { const int st = (r >> 4) * 2 + (c >> 5), rr = r & 15, cc = c & 31, ob = rr * 64 + cc * 2; return st * 1024 + (ob ^ (((ob >> 9) & 1) << 5)); }
__host__ __device__ __forceinline__ void stage_rc(int b, int& R, int& C) { const int st = b / 1024, sb = b % 1024, swz = sb ^ (((sb >> 9) & 1) << 5); R = (st >> 1) * 16 + swz / 64; C = (st & 1) * 32 + (swz % 64) / 2; }
__host__ __device__ __forceinline__ int perm32(int rho) { const int n = rho >> 4, i = rho & 15; return 8 * (i >> 2) + 4 * n + (i & 3); }

struct Unit { int pm, pn, seq; };
struct Gemm { const bf16_t* A; const bf16_t* Bt; int M, N, K; };

struct StaticOrder {
    int nM, nN, nwg, G, c;
    __host__ __device__ __forceinline__ void init(int M, int N, int G_, int c_) { nM = M / BM; nN = N / BM; nwg = nM * nN; G = G_; c = c_; }
    __host__ __device__ __forceinline__ bool next(int i, Unit& u) const {
        const long L = (long)i * G + c; if (L >= nwg) return false; u.seq = i; map(L, u); return true; }
    __host__ __device__ __forceinline__ void map(long L, Unit& u) const {
        int wgid = (int)L; { const int q = nwg / NXCD, r = nwg % NXCD, xcd = wgid % NXCD, off = wgid / NXCD; wgid = (xcd < r ? xcd * (q + 1) : r * (q + 1) + (xcd - r) * q) + off; }
        const int nig = WGM * nN, gid = wgid / nig, fm = gid * WGM, gsz = (nM - fm) < WGM ? (nM - fm) : WGM;
        u.pm = fm + ((wgid % nig) % gsz); u.pn = (wgid % nig) / gsz;
    }
    __device__ __forceinline__ void a_ready(const Unit&) const {}
    __device__ __forceinline__ void done(const Unit&) const {}
};

__device__ __forceinline__ unsigned cvt_pk_bf16(float lo, float hi) { unsigned r; asm volatile("v_cvt_pk_bf16_f32 %0, %1, %2" : "=v"(r) : "v"(lo), "v"(hi)); return r; }

template <class Epi, class Sched, bool ALIGN_EPI = false, bool SP2 = false>
__device__ __forceinline__ void gemm_phase(PG8_LAS unsigned char* lds, const Gemm g, const Sched& S, const Epi& E) {
    int tid_ = threadIdx.x; asm volatile("" : "+v"(tid_));
    const int tid = tid_, wid = __builtin_amdgcn_readfirstlane(tid >> 6), lane = tid & 63, wr = wid >> 2, wc = wid & 3, fr = lane & 15, fq = lane >> 4;
    const int K = g.K, nt = K / BK;
    unsigned voffA[2], voffB[2];
#pragma unroll
    for (int i = 0; i < 2; ++i) { int R, C; stage_rc(tid * 16 + i * 8192, R, C); const int Rb = Epi::PERM ? ((R & ~31) + perm32(R & 31)) : R;
        voffA[i] = (unsigned)(R * K + C) * 2u; voffB[i] = (unsigned)(Rb * K + C) * 2u; }
    const size_t kstep = (size_t)(BK * 2);
    const size_t hstep = (size_t)HALF * K * 2;
    const size_t tstep = 2 * hstep;
    const unsigned ldsw = (unsigned)wid * 1024u;
    const int aoff = lds_byte(wr * 64 + fr, fq * 8), boff = lds_byte(wc * 32 + fr, fq * 8);
#define PG8_SA(b, h) (((b) * 2 + (h)) * HTB)
#define PG8_SB(b, h) ((4 + (b) * 2 + (h)) * HTB)
#define PG8_STAGE(bufoff, gbase, voff) do { _Pragma("unroll") for (int _i = 0; _i < 2; ++_i) \
        __builtin_amdgcn_global_load_lds((const unsigned*)((const char*)(gbase) + (voff)[_i]), (PG8_LAS unsigned*)(lds + (bufoff) + ldsw + _i * 8192), 16, 0, 0); } while (0)
#define PG8_LDA(dst, b, h) do { _Pragma("unroll") for (int m = 0; m < 4; ++m) _Pragma("unroll") for (int k = 0; k < 2; ++k) dst[m][k] = *(const PG8_LAS bf16x8*)(lds + PG8_SA(b, h) + aoff + m * 2048 + k * 1024); } while (0)
#define PG8_LDB(dst, b, h) do { _Pragma("unroll") for (int n = 0; n < 2; ++n) _Pragma("unroll") for (int k = 0; k < 2; ++k) dst[n][k] = *(const PG8_LAS bf16x8*)(lds + PG8_SB(b, h) + boff + n * 2048 + k * 1024); } while (0)
#define PG8_MMA(ai, bj, At, Bt) do { __builtin_amdgcn_s_setprio(1); _Pragma("unroll") for (int m = 0; m < 4; ++m) _Pragma("unroll") for (int n = 0; n < 2; ++n) _Pragma("unroll") for (int k = 0; k < 2; ++k) \
        acc[ai][bj][m][n] = __builtin_amdgcn_mfma_f32_16x16x32_bf16(Bt[n][k], At[m][k], acc[ai][bj][m][n], 0, 0, 0); __builtin_amdgcn_s_setprio(0); } while (0)
#define PG8_WAIT_V(n) asm volatile("s_waitcnt vmcnt(" #n ")" ::: "memory")
#define PG8_WAIT_L(n) asm volatile("s_waitcnt lgkmcnt(" #n ")" ::: "memory")
#define PG8_BAR __builtin_amdgcn_s_barrier()
#define PG8_SCHED __builtin_amdgcn_sched_barrier(0)
    Unit cur, nxt; int ui = 0;
    if (!S.next(0, cur)) return;
    f32x4 acc[2][2][4][2];
#pragma unroll
    for (int a = 0; a < 2; ++a)
#pragma unroll
        for (int b = 0; b < 2; ++b)
#pragma unroll
            for (int m = 0; m < 4; ++m)
#pragma unroll
                for (int n = 0; n < 2; ++n) acc[a][b][m][n] = (f32x4){0.f, 0.f, 0.f, 0.f};
    bf16x8 At[4][2], B0[2][2], B1[2][2];
    const char* cA = (const char*)g.A + (size_t)cur.pm * tstep; const char* cB = (const char*)g.Bt + (size_t)cur.pn * tstep;
    S.a_ready(cur);
    if constexpr (SP2) {
        PG8_STAGE(PG8_SB(0, 0), cB, voffB); PG8_STAGE(PG8_SB(0, 1), cB + hstep, voffB); PG8_STAGE(PG8_SA(0, 0), cA, voffA); PG8_STAGE(PG8_SA(0, 1), cA + hstep, voffA);
        if (wr == 1) PG8_BAR;
        PG8_WAIT_V(2); PG8_BAR;
        PG8_STAGE(PG8_SB(1, 0), cB + kstep, voffB); PG8_STAGE(PG8_SA(1, 0), cA + kstep, voffA); PG8_STAGE(PG8_SB(1, 1), cB + hstep + kstep, voffB);
        PG8_WAIT_V(6); PG8_BAR;
    } else {
        PG8_STAGE(PG8_SB(0, 0), cB, voffB); PG8_STAGE(PG8_SA(0, 0), cA, voffA); PG8_STAGE(PG8_SB(0, 1), cB + hstep, voffB); PG8_STAGE(PG8_SA(0, 1), cA + hstep, voffA);
        if (wr == 1) PG8_BAR;
        PG8_WAIT_V(4); PG8_BAR;
        PG8_STAGE(PG8_SB(1, 0), cB + kstep, voffB); PG8_STAGE(PG8_SA(1, 0), cA + kstep, voffA); PG8_STAGE(PG8_SB(1, 1), cB + hstep + kstep, voffB);
        PG8_WAIT_V(6); PG8_BAR;
    }
    for (;;) {
        const bool has_next = S.next(ui + 1, nxt);
        const char* nA = has_next ? (const char*)g.A + (size_t)nxt.pm * tstep : cA; const char* nB = has_next ? (const char*)g.Bt + (size_t)nxt.pn * tstep : cB;
        for (int t = 0; t < nt; t += 2) {
            const bool last = (t == nt - 2);
            const char* a1 = cA + (size_t)(t + 1) * kstep;
            const char* a2 = last ? nA : cA + (size_t)(t + 2) * kstep; const char* b2 = last ? nB : cB + (size_t)(t + 2) * kstep;
            const char* a3 = a2 + kstep; const char* b3 = b2 + kstep;
            if (last && has_next) S.a_ready(nxt);
            if constexpr (SP2) {
            PG8_LDB(B0, 0, 0); PG8_LDB(B1, 0, 1); PG8_SCHED; PG8_LDA(At, 0, 0); PG8_STAGE(PG8_SA(1, 1), a1 + hstep, voffA);
            PG8_WAIT_V(8); PG8_WAIT_L(0); PG8_BAR; PG8_MMA(0, 0, At, B0); PG8_MMA(0, 1, At, B1); PG8_BAR; PG8_SCHED;
            PG8_LDA(At, 0, 1); PG8_STAGE(PG8_SB(0, 0), b2, voffB); PG8_STAGE(PG8_SB(0, 1), b2 + hstep, voffB); PG8_STAGE(PG8_SA(0, 0), a2, voffA);
            PG8_WAIT_V(8); PG8_WAIT_L(0); PG8_BAR; PG8_MMA(1, 0, At, B0); PG8_MMA(1, 1, At, B1); PG8_BAR; PG8_SCHED;
            PG8_LDB(B0, 1, 0); PG8_LDB(B1, 1, 1); PG8_SCHED; PG8_LDA(At, 1, 0); PG8_STAGE(PG8_SA(0, 1), a2 + hstep, voffA);
            PG8_WAIT_V(8); PG8_WAIT_L(0); PG8_BAR; PG8_MMA(0, 0, At, B0); PG8_MMA(0, 1, At, B1); PG8_BAR; PG8_SCHED;
            PG8_LDA(At, 1, 1); PG8_STAGE(PG8_SB(1, 0), b3, voffB); PG8_STAGE(PG8_SB(1, 1), b3 + hstep, voffB); PG8_STAGE(PG8_SA(1, 0), a3, voffA);
            PG8_WAIT_V(8); PG8_WAIT_L(0); PG8_BAR; PG8_MMA(1, 0, At, B0); PG8_MMA(1, 1, At, B1); PG8_BAR; PG8_SCHED;
            } else {
            PG8_LDB(B0, 0, 0); PG8_SCHED; PG8_LDA(At, 0, 0); PG8_STAGE(PG8_SA(1, 1), a1 + hstep, voffA);
            PG8_WAIT_L(8); PG8_BAR; PG8_WAIT_L(0); PG8_MMA(0, 0, At, B0); PG8_BAR; PG8_SCHED;
            PG8_LDB(B1, 0, 1); PG8_STAGE(PG8_SB(0, 0), b2, voffB);
            PG8_BAR; PG8_WAIT_L(0); PG8_MMA(0, 1, At, B1); PG8_BAR;
            PG8_LDA(At, 0, 1); PG8_STAGE(PG8_SA(0, 0), a2, voffA);
            PG8_BAR; PG8_WAIT_L(0); PG8_MMA(1, 0, At, B0); PG8_BAR; PG8_SCHED;
            PG8_STAGE(PG8_SB(0, 1), b2 + hstep, voffB);
            PG8_WAIT_V(6); PG8_BAR; PG8_MMA(1, 1, At, B1); PG8_BAR;
            PG8_LDB(B0, 1, 0); PG8_SCHED; PG8_LDA(At, 1, 0); PG8_STAGE(PG8_SA(0, 1), a2 + hstep, voffA);
            PG8_WAIT_L(8); PG8_BAR; PG8_WAIT_L(0); PG8_MMA(0, 0, At, B0); PG8_BAR; PG8_SCHED;
            PG8_LDB(B1, 1, 1); PG8_STAGE(PG8_SB(1, 0), b3, voffB);
            PG8_BAR; PG8_WAIT_L(0); PG8_MMA(0, 1, At, B1); PG8_BAR;
            PG8_LDA(At, 1, 1); PG8_STAGE(PG8_SA(1, 0), a3, voffA);
            PG8_BAR; PG8_WAIT_L(0); PG8_MMA(1, 0, At, B0); PG8_BAR; PG8_SCHED;
            PG8_STAGE(PG8_SB(1, 1), b3 + hstep, voffB);
            PG8_WAIT_V(6); PG8_BAR; PG8_MMA(1, 1, At, B1); PG8_BAR;
            }
        }
        if constexpr (ALIGN_EPI) { if (wr == 0) PG8_BAR; }
        if constexpr (!Epi::AFTER_DRAIN) { E(acc, cur, wr, wc, fr, fq); S.done(cur); }
        if (!has_next) break;
#pragma unroll
        for (int a = 0; a < 2; ++a)
#pragma unroll
            for (int b = 0; b < 2; ++b)
#pragma unroll
                for (int m = 0; m < 4; ++m)
#pragma unroll
                    for (int n = 0; n < 2; ++n) acc[a][b][m][n] = (f32x4){0.f, 0.f, 0.f, 0.f};
        cur = nxt; cA = nA; cB = nB; ++ui;
        if constexpr (ALIGN_EPI) { if (wr == 1) PG8_BAR; }
    }
    PG8_WAIT_V(0);
    if constexpr (!ALIGN_EPI) { if (wr == 0) PG8_BAR; }
    PG8_BAR;
    if constexpr (Epi::AFTER_DRAIN) { E.fused(acc, cur, wr, wc, fr, fq, lds, wid, lane); S.done(cur); }
#undef PG8_SA
#undef PG8_SB
#undef PG8_STAGE
#undef PG8_LDA
#undef PG8_LDB
#undef PG8_MMA
#undef PG8_WAIT_V
#undef PG8_WAIT_L
#undef PG8_BAR
#undef PG8_SCHED
}
}
constexpr int DM = 1024, SEQ = 2048, NB = 32, DECL = 64, DFF = 2816, INW = 2816;
constexpr int MP = NB * SEQ, MS = NB * DECL, MT = MP + MS;
constexpr int NGRP = MT / 64;
constexpr int NTM = MT / 256;
constexpr float EPS = 1e-6f;
constexpr size_t OFF_Y = 0;
constexpr size_t OFF_PRET = (size_t)MT * DM;
constexpr size_t OFF_PK = OFF_PRET + (size_t)NB * 4 * 128 * 128;
constexpr size_t OFF_PV = OFF_PK + (size_t)NB * 128 * 128;
constexpr size_t OFF_PCONV = OFF_PV + (size_t)NB * 128 * 128;
constexpr size_t OFF_SRET = OFF_PCONV + (size_t)NB * 2 * DFF;
constexpr size_t OFF_SK = OFF_SRET + (size_t)NB * 4 * 128 * 128;
constexpr size_t OFF_SV = OFF_SK + (size_t)NB * 64 * 128;
constexpr size_t OFF_SCONV = OFF_SV + (size_t)NB * 64 * 128;
constexpr size_t OUT_TOTAL = OFF_SCONV + (size_t)NB * 2 * DFF;
constexpr size_t MiB = 1u << 20;
constexpr size_t WS_WIN = 0;
constexpr size_t WS_WUP = WS_WIN + (size_t)INW * DM * 2;
constexpr size_t WS_WOUT = WS_WUP + (size_t)2 * DFF * DM * 2;
constexpr size_t WS_WDN = WS_WOUT + (size_t)DM * DM * 2;
constexpr size_t WS_MODP = 24 * MiB;
constexpr size_t WS_MOD = 32 * MiB;
constexpr size_t WS_SHW = 34 * MiB;
constexpr size_t WS_SS1 = 36 * MiB;
constexpr size_t WS_SS2 = 41 * MiB;
constexpr size_t WS_R0 = 48 * MiB;
constexpr size_t WS_R1 = WS_R0 + 133 * MiB;
constexpr size_t WS_R2 = WS_R1 + 363 * MiB;
constexpr size_t HT_STRIDE = (size_t)NGRP * 2 * DFF;
constexpr size_t WS_END = WS_R2 + 363 * MiB;
constexpr size_t WS_X1B = WS_R1 + 128 * MiB;
static_assert(3 * HT_STRIDE * 4 <= 128 * MiB && WS_X1B + (size_t)MT * DM * 2 <= WS_R2, "ws map");
static_assert(WS_WDN + (size_t)DM * DFF * 2 <= WS_MODP, "ws map");
static_assert((size_t)(MT + 256) * DM * 2 <= 133 * MiB && (size_t)MT * DFF * 2 <= 363 * MiB, "ws map");

constexpr size_t WS_BAR = 46 * MiB;
constexpr size_t WS_TICKET = 46 * MiB + 32768;
constexpr size_t WS_CNT7 = 46 * MiB + 65536;
constexpr int LDS_MISC = 155648;
constexpr int LDS_BYTES = 155648 + 64;

#define LAS __attribute__((address_space(3)))
typedef unsigned short bf16;
typedef float f32x4 __attribute__((ext_vector_type(4)));
typedef float f32x2 __attribute__((ext_vector_type(2)));
typedef short bf16x8 __attribute__((ext_vector_type(8)));
typedef unsigned u32x4 __attribute__((ext_vector_type(4)));
typedef unsigned u32x2 __attribute__((ext_vector_type(2)));
typedef __bf16 bf16x2_t __attribute__((ext_vector_type(2)));
#define LDS_WAIT() asm volatile("s_waitcnt lgkmcnt(0)" ::: "memory")

__device__ __forceinline__ unsigned pk2(float lo, float hi) { f32x2 v = {lo, hi}; bf16x2_t b = __builtin_convertvector(v, bf16x2_t); return __builtin_bit_cast(unsigned, b); }
__device__ __forceinline__ float bflo(unsigned w) { return __uint_as_float(w << 16); }
__device__ __forceinline__ float bfhi(unsigned w) { return __uint_as_float(w & 0xffff0000u); }
__device__ __forceinline__ float wave_sum(float v) {
#pragma unroll
    for (int o = 1; o < 64; o <<= 1) v += __shfl_xor(v, o);
    return v;
}
__device__ __forceinline__ float wave_sum_dpp(float v) {
    v += __int_as_float(__builtin_amdgcn_update_dpp(__float_as_int(v), __float_as_int(v), 0x128, 0xf, 0xf, false));
    v += __int_as_float(__builtin_amdgcn_update_dpp(__float_as_int(v), __float_as_int(v), 0x124, 0xf, 0xf, false));
    v += __int_as_float(__builtin_amdgcn_update_dpp(__float_as_int(v), __float_as_int(v), 0x122, 0xf, 0xf, false));
    v += __int_as_float(__builtin_amdgcn_update_dpp(__float_as_int(v), __float_as_int(v), 0x121, 0xf, 0xf, false));
    const int i = __float_as_int(v);
    return (__int_as_float(__builtin_amdgcn_readlane(i, 0)) + __int_as_float(__builtin_amdgcn_readlane(i, 16))) + (__int_as_float(__builtin_amdgcn_readlane(i, 32)) + __int_as_float(__builtin_amdgcn_readlane(i, 48)));
}
__device__ __forceinline__ float silu_f(float x) { return x * __builtin_amdgcn_rcpf(1.0f + __builtin_amdgcn_exp2f(-1.4426950408889634f * x)); }
__device__ __forceinline__ void unpack8(const u32x4 w, float (&f)[8]) { f[0] = bflo(w.x); f[1] = bfhi(w.x); f[2] = bflo(w.y); f[3] = bfhi(w.y); f[4] = bflo(w.z); f[5] = bfhi(w.z); f[6] = bflo(w.w); f[7] = bfhi(w.w); }
__device__ __forceinline__ int grp_bs(int g) { return g < 1024 ? (g >> 5) : 32 + (g - 1024); }

struct Params {
    const float *x_p, *x_s, *cache_k, *cache_v, *state_ret, *state_conv, *c_p, *c_s, *ln1, *ln2, *w_ada, *b_ada, *w_in, *w_out, *sinks, *w_up, *conv_w, *conv_b, *w_down, *normf, *w_ada_f, *b_ada_f;
    float* out; unsigned char* ws;
};

__device__ __forceinline__ void transpose_item(const float* W, int K, int N, bf16* WT, int dst_row0, int k0, int n0, LAS float* scr, int lane) {
#pragma unroll 8
    for (int i = 0; i < 32; ++i) { const int kk = 2 * i + (lane >> 5); scr[kk * 33 + (lane & 31)] = W[(size_t)(k0 + kk) * N + n0 + (lane & 31)]; }
    LDS_WAIT(); asm volatile("" ::: "memory");
    const int c = lane & 7;
#pragma unroll
    for (int j = 0; j < 4; ++j) { const int n = (lane >> 3) + 8 * j; const LAS float* s = scr + (8 * c) * 33 + n;
        u32x4 o; o.x = pk2(s[0 * 33], s[1 * 33]); o.y = pk2(s[2 * 33], s[3 * 33]); o.z = pk2(s[4 * 33], s[5 * 33]); o.w = pk2(s[6 * 33], s[7 * 33]);
        *(u32x4*)(WT + (size_t)(dst_row0 + n) * K + k0 + 8 * c) = o; }
    LDS_WAIT(); asm volatile("" ::: "memory");
}
__device__ __forceinline__ void mod_item(const Params& P, int it, LAS float* scr, int lane) {
    const int ct = it >> 2, ks = it & 3, c0 = ct * 64;
    const float* W; const float* bias; int ldw;
    if (c0 < 6144) { W = P.w_ada + c0; bias = P.b_ada + c0; ldw = 6144; } else { W = P.w_ada_f + (c0 - 6144); bias = P.b_ada_f + (c0 - 6144); ldw = 2048; }
    float acc[64];
#pragma unroll
    for (int r = 0; r < 64; ++r) acc[r] = 0.f;
    const float* crow = (lane < 32 ? P.c_p + (size_t)lane * DM : P.c_s + (size_t)(lane - 32) * DM) + ks * 256;
    for (int kc = 0; kc < 8; ++kc) {
#pragma unroll
        for (int q = 0; q < 8; ++q) { f32x4 v = *(const f32x4*)(crow + kc * 32 + 4 * q);
            v.x = silu_f(v.x); v.y = silu_f(v.y); v.z = silu_f(v.z); v.w = silu_f(v.w);
            *(LAS f32x4*)(scr + lane * 36 + 4 * q) = v; }
        LDS_WAIT(); asm volatile("" ::: "memory");
        const float* wk = W + (size_t)(ks * 256 + kc * 32) * ldw + lane;
        for (int k4 = 0; k4 < 8; ++k4) {
            const float w0 = wk[(size_t)(4 * k4 + 0) * ldw], w1 = wk[(size_t)(4 * k4 + 1) * ldw], w2 = wk[(size_t)(4 * k4 + 2) * ldw], w3 = wk[(size_t)(4 * k4 + 3) * ldw];
#pragma unroll
            for (int r = 0; r < 64; ++r) { const f32x4 s = *(const LAS f32x4*)(scr + r * 36 + 4 * k4); acc[r] += (s.x * w0 + s.y * w1) + (s.z * w2 + s.w * w3); }
        }
        LDS_WAIT(); asm volatile("" ::: "memory");
    }
    float* dst = (float*)(P.ws + WS_MODP) + (size_t)ks * 64 * 8192 + c0 + lane;
    const float bv = (ks == 0) ? bias[lane] : 0.f;
#pragma unroll
    for (int r = 0; r < 64; ++r) dst[(size_t)r * 8192] = acc[r] + bv;
}
__device__ __forceinline__ void phase0(const Params& P, LAS unsigned char* lds, int wave, int lane) {
    LAS float* scr = (LAS float*)(lds + wave * 16384);
    const int gw = wave * gridDim.x + blockIdx.x, NGW = gridDim.x * 8;
    constexpr int I_MOD = 512, I_IN = 16 * 88, I_UP = 16 * 176, I_OUT = 16 * 32, I_DN = 44 * 32;
    constexpr int NIT = I_MOD + I_IN + I_UP + I_OUT + I_DN;
    for (int it = gw; it < NIT; it += NGW) {
        int r = it;
        if (r < I_MOD) { mod_item(P, r, scr, lane); continue; } r -= I_MOD;
        if (r < I_IN) { const int kb = r / 88, nb = r % 88; transpose_item(P.w_in, DM, INW, (bf16*)(P.ws + WS_WIN), nb * 32, kb * 64, nb * 32, scr, lane); continue; } r -= I_IN;
        if (r < I_UP) { const int kb = r / 176, nb = r % 176, n0 = nb * 32, isb = n0 >= DFF, j0 = n0 - isb * DFF;
            transpose_item(P.w_up, DM, 2 * DFF, (bf16*)(P.ws + WS_WUP), 256 * (j0 >> 7) + 128 * isb + (j0 & 127), kb * 64, n0, scr, lane); continue; } r -= I_UP;
        if (r < I_OUT) { const int kb = r / 32, nb = r % 32; transpose_item(P.w_out, DM, DM, (bf16*)(P.ws + WS_WOUT), nb * 32, kb * 64, nb * 32, scr, lane); continue; } r -= I_OUT;
        { const int kb = r / 32, nb = r % 32; transpose_item(P.w_down, DFF, DM, (bf16*)(P.ws + WS_WDN), nb * 32, kb * 64, nb * 32, scr, lane); }
    }
}

__device__ __forceinline__ void phase1(const Params& P, LAS unsigned char* lds, int tid, int wave, int lane) {
    const float* modp = (const float*)(P.ws + WS_MODP);
    float* mod = (float*)(P.ws + WS_MOD);
    bf16* H1 = (bf16*)(P.ws + WS_R0);
    for (int idx = blockIdx.x * 512 + tid; idx < 64 * 8192; idx += gridDim.x * 512) {
        const float s = (modp[idx] + modp[idx + 524288]) + (modp[idx + 2 * 524288] + modp[idx + 3 * 524288]);
        mod[idx] = s;
        const int col = idx & 8191, bs = idx >> 13;
        if (col >= 3072 && col < 4096) H1[(size_t)(MT + bs) * DM + (col - 3072)] = (bf16)(pk2(s, 0.f) & 0xffffu);
    }
    LAS float* lv = (LAS float*)lds;
    const int rpb = (MT + (int)gridDim.x - 1) / (int)gridDim.x, rbeg = (int)blockIdx.x * rpb, rend = (rbeg + rpb < MT) ? rbeg + rpb : MT;
    if (rbeg < rend) {
        const int bs0 = rbeg < MP ? (rbeg >> 11) : 32 + ((rbeg - MP) >> 6), bs1 = (rend - 1) < MP ? ((rend - 1) >> 11) : 32 + ((rend - 1 - MP) >> 6);
        const int nsl = bs1 - bs0 + 1;
        __syncthreads();
        for (int i = tid; i < nsl * 2048; i += 512) { const int sl = i >> 11, which = (i >> 10) & 1, col = i & 1023; const size_t o = (size_t)(bs0 + sl) * 8192 + which * 1024 + col;
            float sv = (modp[o] + modp[o + 524288]) + (modp[o + 2 * 524288] + modp[o + 3 * 524288]);
            if (which) sv = P.ln1[col] * (1.f + sv);
            lv[i] = sv; }
        __syncthreads();
#pragma unroll 2
        for (int row = rbeg + wave; row < rend; row += 8) {
            const int bs = row < MP ? (row >> 11) : 32 + ((row - MP) >> 6);
            const LAS float* lvs = lv + (bs - bs0) * 2048;
            const float* xr = (row < MP ? P.x_p + (size_t)row * DM : P.x_s + (size_t)(row - MP) * DM) + 4 * lane;
            f32x4 v[4]; float ss = 0.f;
#pragma unroll
            for (int j = 0; j < 4; ++j) { v[j] = *(const f32x4*)(xr + 256 * j); ss += (v[j].x * v[j].x + v[j].y * v[j].y) + (v[j].z * v[j].z + v[j].w * v[j].w); }
            const float rstd = rsqrtf(wave_sum(ss) * (1.f / DM) + EPS);
            bf16* hr = H1 + (size_t)row * DM + 4 * lane;
#pragma unroll
            for (int j = 0; j < 4; ++j) { const f32x4 sh = *(const LAS f32x4*)(lvs + 256 * j + 4 * lane), gs = *(const LAS f32x4*)(lvs + 1024 + 256 * j + 4 * lane);
                const f32x4 h = v[j] * rstd * gs + sh; u32x2 w; w.x = pk2(h.x, h.y); w.y = pk2(h.z, h.w); *(u32x2*)(hr + 256 * j) = w; }
        }
    }
}

struct OrderX {
    pg8::StaticOrder S; int nX, xpm, xpn0;
    __device__ __forceinline__ bool next(int i, pg8::Unit& u) const {
        const long L = (long)i * S.G + S.c;
        int pm = 0, pn = 0; bool ok = false;
        if (L < S.nwg) { pg8::Unit t; t.pm = 0; t.pn = 0; t.seq = 0; (void)S.next(i, t); pm = t.pm; pn = t.pn; ok = true; }
        else if (L < S.nwg + nX) { pm = xpm; pn = xpn0 + (int)(L - S.nwg); ok = true; }
        u.pm = pm; u.pn = pn; u.seq = i;
        return ok;
    }
    __device__ __forceinline__ void a_ready(const pg8::Unit&) const {}
    __device__ __forceinline__ void done(const pg8::Unit&) const {}
};
struct OrderPub : pg8::StaticOrder {
    unsigned* cnt;
    __device__ __forceinline__ void done(const pg8::Unit& u) const {
        asm volatile("s_waitcnt vmcnt(0)" ::: "memory");
        if ((threadIdx.x & 63) == 0) __hip_atomic_fetch_add(cnt + 64 * u.pm, 1u, __ATOMIC_RELAXED, __HIP_MEMORY_SCOPE_AGENT);
    }
};
typedef const f32x4 (&AccRef)[2][2][4][2];
struct Epi1 {
    static constexpr bool PERM = true, AFTER_DRAIN = false;
    bf16* proj; float* shw; float* out;
    __device__ __forceinline__ void operator()(AccRef acc, const pg8::Unit& u, int wr, int wc, int fr, int fq) const {
        if (u.pm == NTM) {
            if (wr == 0) {
#pragma unroll
                for (int m = 0; m < 4; ++m) { float* d = shw + (size_t)(16 * m + fr) * (2 * DFF) + 256 * (u.pn - 11) + 32 * wc + 8 * fq;
#pragma unroll
                    for (int bj = 0; bj < 2; ++bj)
#pragma unroll
                        for (int n = 0; n < 2; ++n) *(f32x4*)(d + 128 * bj + 4 * n) = acc[0][bj][m][n]; }
            }
            return;
        }
        const unsigned row0 = u.pm * 256 + wr * 64 + fr, col0 = u.pn * 256 + wc * 32 + 8 * fq;
#pragma unroll
        for (int ai = 0; ai < 2; ++ai)
#pragma unroll
            for (int m = 0; m < 4; ++m) { const unsigned o = (row0 + 128 * ai + 16 * m) * (unsigned)INW + col0;
#pragma unroll
                for (int bj = 0; bj < 2; ++bj) { const f32x4 v0 = acc[ai][bj][m][0], v1 = acc[ai][bj][m][1];
                    u32x4 w; w.x = pk2(v0[0], v0[1]); w.y = pk2(v0[2], v0[3]); w.z = pk2(v1[0], v1[1]); w.w = pk2(v1[2], v1[3]);
                    *(u32x4*)(proj + (o + 128 * bj)) = w; }
                asm volatile("" ::: "memory"); }
        if (u.pn == 10) {
            const unsigned c = 32 * wc + 8 * fq;
#pragma unroll
            for (int ai = 0; ai < 2; ++ai)
#pragma unroll
                for (int m = 0; m < 4; ++m) { const unsigned row = row0 + 128 * ai + 16 * m; unsigned ok, ov;
                    if (row < (unsigned)MP) { const unsigned t = row & 2047; if (t < SEQ - 128) continue; const unsigned o = ((row >> 11) * 128 + (t - (SEQ - 128))) * 128 + c; ok = (unsigned)OFF_PK + o; ov = (unsigned)OFF_PV + o; }
                    else { const unsigned o = (row - MP) * 128 + c; ok = (unsigned)OFF_SK + o; ov = (unsigned)OFF_SV + o; }
                    *(f32x4*)(out + ok) = acc[ai][0][m][0]; *(f32x4*)(out + ok + 4) = acc[ai][0][m][1];
                    *(f32x4*)(out + ov) = acc[ai][1][m][0]; *(f32x4*)(out + ov + 4) = acc[ai][1][m][1];
                    asm volatile("" ::: "memory"); }
        }
    }
};
struct Epi2 {
    static constexpr bool PERM = true, AFTER_DRAIN = false;
    const float *xp, *xs, *mod, *ln2; bf16* x1; bf16* a2; float* ss;
    __device__ __forceinline__ void operator()(AccRef acc, const pg8::Unit& u, int wr, int wc, int fr, int fq) const {
        const int col0 = u.pn * 256 + wc * 32 + 8 * fq;
#pragma unroll
        for (int ai = 0; ai < 2; ++ai) {
            const int bs = grp_bs(4 * u.pm + 2 * ai + wr);
            const float* mb = mod + (size_t)bs * 8192;
            f32x4 g1v[2][2], gsv[2][2];
#pragma unroll
            for (int bj = 0; bj < 2; ++bj)
#pragma unroll
                for (int n = 0; n < 2; ++n) { const int c = col0 + 128 * bj + 4 * n; g1v[bj][n] = *(const f32x4*)(mb + 2048 + c);
                    gsv[bj][n] = *(const f32x4*)(ln2 + c) * (*(const f32x4*)(mb + 4096 + c) + 1.0f); }
#pragma unroll
            for (int m = 0; m < 4; ++m) {
                const int row = u.pm * 256 + 128 * ai + 64 * wr + 16 * m + fr;
                const float* xr = row < MP ? xp + (size_t)row * DM : xs + (size_t)(row - MP) * DM;
                float s = 0.f;
#pragma unroll
                for (int bj = 0; bj < 2; ++bj) { f32x4 a[2]; f32x4 xb[2];
#pragma unroll
                    for (int n = 0; n < 2; ++n) { const int c = col0 + 128 * bj + 4 * n; const f32x4 xv = *(const f32x4*)(xr + c); const f32x4 v = xv + g1v[bj][n] * acc[ai][bj][m][n];
                        xb[n] = v; s += (v.x * v.x + v.y * v.y) + (v.z * v.z + v.w * v.w); a[n] = v * gsv[bj][n]; }
                    u32x4 w; w.x = pk2(a[0].x, a[0].y); w.y = pk2(a[0].z, a[0].w); w.z = pk2(a[1].x, a[1].y); w.w = pk2(a[1].z, a[1].w);
                    *(u32x4*)(a2 + (size_t)row * DM + col0 + 128 * bj) = w;
                    w.x = pk2(xb[0].x, xb[0].y); w.y = pk2(xb[0].z, xb[0].w); w.z = pk2(xb[1].x, xb[1].y); w.w = pk2(xb[1].z, xb[1].w);
                    *(u32x4*)(x1 + (size_t)row * DM + col0 + 128 * bj) = w; }
                s += __shfl_xor(s, 16); s += __shfl_xor(s, 32);
                if (fq == 0) ss[(size_t)row * 16 + 4 * u.pn + wc] = s;
            }
        }
    }
};
struct Epi3 {
    static constexpr bool PERM = true, AFTER_DRAIN = false;
    const LAS float* rtab; const float* shw; bf16 *ua, *ub; float* out;
    __device__ __forceinline__ void operator()(AccRef acc, const pg8::Unit& u, int wr, int wc, int fr, int fq) const {
        const unsigned j0 = u.pn * 128 + wc * 32 + 8 * fq, pc0 = u.pn * 256 + wc * 32 + 8 * fq;
#pragma unroll
        for (int ai = 0; ai < 2; ++ai) {
            const unsigned grp = 4 * u.pm + 2 * ai + wr, bs = grp_bs((int)grp);
            const unsigned so = bs * (2 * DFF) + pc0;
            const f32x4 sa0 = *(const f32x4*)(shw + so), sa1 = *(const f32x4*)(shw + so + 4), sb0 = *(const f32x4*)(shw + so + 128), sb1 = *(const f32x4*)(shw + so + 132);
#pragma unroll
            for (int m = 0; m < 4; ++m) {
                const float rstd = rtab[u.seq * 256 + 128 * ai + 64 * wr + 16 * m + fr];
                const unsigned row = grp * 64 + 16 * m + fr;
                const f32x4 a0 = acc[ai][0][m][0] * rstd + sa0, a1 = acc[ai][0][m][1] * rstd + sa1, b0 = acc[ai][1][m][0] * rstd + sb0, b1 = acc[ai][1][m][1] * rstd + sb1;
                u32x4 w; w.x = pk2(a0[0], a0[1]); w.y = pk2(a0[2], a0[3]); w.z = pk2(a1[0], a1[1]); w.w = pk2(a1[2], a1[3]);
                *(u32x4*)(ua + (row * (unsigned)DFF + j0)) = w;
                w.x = pk2(b0[0], b0[1]); w.y = pk2(b0[2], b0[3]); w.z = pk2(b1[0], b1[1]); w.w = pk2(b1[2], b1[3]);
                *(u32x4*)(ub + (row * (unsigned)DFF + j0)) = w;
                if (m == 3 && fr >= 14) {
                    if (grp >= 1024) { float* d = out + OFF_SCONV + ((size_t)(grp - 1024) * 2 + (fr - 14)) * DFF + j0; *(f32x4*)d = a0; *(f32x4*)(d + 4) = a1; }
                    else if ((grp & 31) == 31) { float* d = out + OFF_PCONV + ((size_t)(grp >> 5) * 2 + (fr - 14)) * DFF + j0; *(f32x4*)d = a0; *(f32x4*)(d + 4) = a1; }
                }
            }
        }
    }
};
#ifdef CONV_FUSED
struct Epi3C {
    static constexpr bool PERM = true, AFTER_DRAIN = false;
    const LAS float* rtab; const float *shw, *cw, *cb; bf16* act; float *headA, *headB, *tailA;
    __device__ __forceinline__ void operator()(AccRef acc, const pg8::Unit& u, int wr, int wc, int fr, int fq) const {
        const unsigned j0 = u.pn * 128 + wc * 32 + 8 * fq, pc0 = u.pn * 256 + wc * 32 + 8 * fq;
        f32x4 w0[2], w1[2], w2[2], cbv[2];
#pragma unroll
        for (int n = 0; n < 2; ++n) { w0[n] = *(const f32x4*)(cw + j0 + 4 * n); w1[n] = *(const f32x4*)(cw + DFF + j0 + 4 * n); w2[n] = *(const f32x4*)(cw + 2 * DFF + j0 + 4 * n); cbv[n] = *(const f32x4*)(cb + j0 + 4 * n); }
#pragma unroll
        for (int ai = 0; ai < 2; ++ai) {
            asm volatile("" ::: "memory");
            const unsigned grp = 4 * u.pm + 2 * ai + wr, bs = grp_bs((int)grp);
            const unsigned so = bs * (2 * DFF) + pc0, ho = (grp * 2 + (fr & 1)) * DFF + j0;
            u32x2 ap[4][2], bp[4][2];
            {
                f32x4 sa[2], sb[2];
#pragma unroll
                for (int n = 0; n < 2; ++n) { sa[n] = *(const f32x4*)(shw + so + 4 * n); sb[n] = *(const f32x4*)(shw + so + 128 + 4 * n); }
#pragma unroll
                for (int m = 0; m < 4; ++m) {
                    const float rs = rtab[u.seq * 256 + 128 * ai + 64 * wr + 16 * m + fr];
#pragma unroll
                    for (int n = 0; n < 2; ++n) {
                        const f32x4 av = acc[ai][0][m][n] * rs + sa[n], bv = acc[ai][1][m][n] * rs + sb[n];
                        if (m == 0) { if (fr < 2) { *(f32x4*)(headA + ho + 4 * n) = av; *(f32x4*)(headB + ho + 4 * n) = bv; } }
                        if (m == 3) { if (fr >= 14) *(f32x4*)(tailA + ho + 4 * n) = av; }
                        ap[m][n].x = pk2(av.x, av.y); ap[m][n].y = pk2(av.z, av.w); bp[m][n].x = pk2(bv.x, bv.y); bp[m][n].y = pk2(bv.z, bv.w);
                    }
                }
            }
            asm volatile("" ::: "memory");
#pragma unroll
            for (int n = 0; n < 2; ++n)
#pragma unroll
                for (int h = 0; h < 2; ++h) {
                    unsigned q1 = 0u, q2 = 0u;
#pragma unroll
                    for (int m = 0; m < 4; ++m) {
                        const unsigned a = ap[m][n][h];
                        const unsigned s1 = (unsigned)__builtin_amdgcn_update_dpp((int)a, (int)a, 0x121, 0xf, 0xf, false);
                        const unsigned s2 = (unsigned)__builtin_amdgcn_update_dpp((int)a, (int)a, 0x122, 0xf, 0xf, false);
                        const unsigned pr1 = fr >= 1 ? s1 : q1, pr2 = fr >= 2 ? s2 : q2;
                        q1 = s1; q2 = s2;
                        const float c0 = cbv[n][2 * h] + w0[n][2 * h] * bflo(pr2) + w1[n][2 * h] * bflo(pr1) + w2[n][2 * h] * bflo(a);
                        const float c1 = cbv[n][2 * h + 1] + w0[n][2 * h + 1] * bfhi(pr2) + w1[n][2 * h + 1] * bfhi(pr1) + w2[n][2 * h + 1] * bfhi(a);
                        const unsigned bw = bp[m][n][h];
                        bp[m][n][h] = pk2(silu_f(c0) * bflo(bw), silu_f(c1) * bfhi(bw));
                    }
                    __builtin_amdgcn_sched_barrier(0);
                }
            asm volatile("" ::: "memory");
#pragma unroll
            for (int m = 0; m < 4; ++m) {
                if (m == 0 && fr < 2) continue;
                const unsigned row = grp * 64 + 16 * m + fr;
                const u32x4 w = (u32x4){bp[m][0].x, bp[m][0].y, bp[m][1].x, bp[m][1].y};
                *(u32x4*)(act + (row * (unsigned)DFF + j0)) = w;
            }
        }
    }
};
#endif
struct Epi4 {
    static constexpr bool PERM = true, AFTER_DRAIN = false;
    const float* mod; const bf16* x1; bf16* x2;
    __device__ __forceinline__ void operator()(AccRef acc, const pg8::Unit& u, int wr, int wc, int fr, int fq) const {
        const int col0 = u.pn * 256 + wc * 32 + 8 * fq;
#pragma unroll
        for (int ai = 0; ai < 2; ++ai) {
            const int bs = grp_bs(4 * u.pm + 2 * ai + wr);
            const float* mb = mod + (size_t)bs * 8192 + 5120;
            f32x4 g2v[2][2];
#pragma unroll
            for (int bj = 0; bj < 2; ++bj)
#pragma unroll
                for (int n = 0; n < 2; ++n) g2v[bj][n] = *(const f32x4*)(mb + col0 + 128 * bj + 4 * n);
#pragma unroll
            for (int m = 0; m < 4; ++m) {
                const unsigned ro = (unsigned)(u.pm * 256 + 128 * ai + 64 * wr + 16 * m + fr) * DM + col0;
#pragma unroll
                for (int bj = 0; bj < 2; ++bj) { const u32x4 xw = *(const u32x4*)(x1 + ro + 128 * bj);
                    const f32x4 v0 = (f32x4){bflo(xw.x), bfhi(xw.x), bflo(xw.y), bfhi(xw.y)} + g2v[bj][0] * acc[ai][bj][m][0];
                    const f32x4 v1 = (f32x4){bflo(xw.z), bfhi(xw.z), bflo(xw.w), bfhi(xw.w)} + g2v[bj][1] * acc[ai][bj][m][1];
                    u32x4 w; w.x = pk2(v0.x, v0.y); w.y = pk2(v0.z, v0.w); w.z = pk2(v1.x, v1.y); w.w = pk2(v1.z, v1.w);
                    *(u32x4*)(x2 + ro + 128 * bj) = w; }
            }
        }
    }
};
#define GAS __attribute__((address_space(1)))
#define RLX_AGENT __ATOMIC_RELAXED, __HIP_MEMORY_SCOPE_AGENT
#define XB_TMO      128
#define XB_XCNT(j)  (256  + 64 * (j))
#define XB_XSUB(j)  (1280 + 64 * (j))
#define XB_XGEN(j)  (2304 + 64 * (j))
#define XB_TOP      3328
#define XB_TOPGEN   3392
#define XCD_BAR_WORDS 3456
#define XB_SPIN_CAP (1u << 18)

__device__ __forceinline__ unsigned xb_ld(unsigned* p)              { return __hip_atomic_load(p, __ATOMIC_RELAXED, __HIP_MEMORY_SCOPE_AGENT); }
__device__ __forceinline__ unsigned xb_add(unsigned* p, unsigned v) { return __hip_atomic_fetch_add(p, v, __ATOMIC_RELAXED, __HIP_MEMORY_SCOPE_AGENT); }
__device__ __forceinline__ unsigned xb_xcc_id() { return (unsigned)__builtin_amdgcn_s_getreg((3 << 11) | 20) & 0xFu; }
#define XB_SPIN(cond, bar) do { unsigned _sp = 0; while (cond) { __builtin_amdgcn_s_sleep(1); \
    if ((++_sp & 255u) == 0u) { if (xb_ld(&(bar)[XB_TMO])) break; if (_sp > XB_SPIN_CAP) { atomicAdd(&(bar)[XB_TMO], 1u); break; } } } } while (0)

struct XcdBarrier {
    unsigned* bar; unsigned x;
    volatile LAS unsigned* st;
};

__device__ __forceinline__ XcdBarrier xcd_barrier_post(unsigned* bar, volatile LAS unsigned* st) {
    XcdBarrier b; b.bar = bar; b.x = xb_xcc_id(); b.st = st;
    if (threadIdx.x == 0) (void)xb_add(&bar[XB_XCNT(b.x)], 1u);
    return b;
}
__device__ __forceinline__ void xcd_barrier_complete(unsigned* bar, unsigned x, unsigned& nloc, unsigned& nx) {
    const unsigned G = gridDim.x * gridDim.y * gridDim.z;
    unsigned sum, cnt, mine, sp = 0u;
    for (;;) {
        sum = 0u; cnt = 0u; mine = 0u;
#pragma unroll
        for (unsigned j = 0; j < 16; ++j) { const unsigned c = xb_ld(&bar[XB_XCNT(j)]); sum += c; cnt += (c > 0u) ? 1u : 0u; mine = (j == x) ? c : mine; }
        if (sum == G) break;
        __builtin_amdgcn_s_sleep(1);
        if ((++sp & 255u) == 0u) { if (xb_ld(&bar[XB_TMO])) break; if (sp > XB_SPIN_CAP) { atomicAdd(&bar[XB_TMO], 1u); break; } }
    }
    nloc = mine > 0u ? mine : 1u; nx = cnt > 0u ? cnt : 1u;
}

__device__ __forceinline__ void xcd_barrier(const XcdBarrier& b) {
    asm volatile("s_waitcnt vmcnt(0)" ::: "memory");
    __syncthreads();
    if (threadIdx.x == 0) {
        unsigned* bar = b.bar;
        __builtin_amdgcn_s_waitcnt(0);
        unsigned nloc = b.st[0], nx = b.st[1];
        if (nloc == 0u) { xcd_barrier_complete(bar, b.x, nloc, nx); b.st[0] = nloc; b.st[1] = nx; }
        const unsigned old = xb_add(&bar[XB_XSUB(b.x)], 1u);
        const unsigned gen = old / nloc;
        if (old + 1u == (gen + 1u) * nloc) {
            __builtin_amdgcn_fence(__ATOMIC_RELEASE, "agent");
            asm volatile("s_waitcnt vmcnt(0)" ::: "memory");
            const unsigned og = xb_add(&bar[XB_TOP], 1u);
            const unsigned tg = og / nx;
            if (og + 1u == (tg + 1u) * nx) xb_add(&bar[XB_TOPGEN], 1u);
            else XB_SPIN(xb_ld(&bar[XB_TOPGEN]) == tg, bar);
            __builtin_amdgcn_fence(__ATOMIC_ACQUIRE, "agent");
            xb_add(&bar[XB_XGEN(b.x)], 1u);
            asm volatile("s_waitcnt vmcnt(0)" ::: "memory");
        } else {
            XB_SPIN(xb_ld(&bar[XB_XGEN(b.x)]) == gen, bar);
            __builtin_amdgcn_fence(__ATOMIC_ACQUIRE, "agent");
            asm volatile("s_waitcnt vmcnt(0)" ::: "memory");
        }
    }
    __syncthreads();
}
#define MFMA16(a, b, c) __builtin_amdgcn_mfma_f32_16x16x32_bf16((a), (b), (c), 0, 0, 0)
constexpr int RQ = 0, RK = 17408, RKT = 34816, RVT = 53248, RP = 71680, RST = 80896, RO = 115712;
__device__ __forceinline__ void ret_item(const Params& P, LAS unsigned char* lds, int tid, int wave, int lane, int h, int row0, int nchunks, const float* st_in, bool has_in, float* st_out) {
    const bf16* proj = (const bf16*)(P.ws + WS_R1);
    bf16* mix = (bf16*)(P.ws + WS_R2);
    const int fr = lane & 15, fq = lane >> 4;
    const float lg2 = log2f(1.0f - exp2f(-5.0f - (float)h));
    const float kscale = 0.08838834764831845f;
    LAS bf16* Qs = (LAS bf16*)(lds + RQ); LAS bf16* Ks = (LAS bf16*)(lds + RK); LAS bf16* KT = (LAS bf16*)(lds + RKT); LAS bf16* VT = (LAS bf16*)(lds + RVT);
    LAS bf16* Ps = (LAS bf16*)(lds + RP); LAS bf16* ST = (LAS bf16*)(lds + RST); LAS float* Os = (LAS float*)(lds + RO);
    f32x4 st[8];
#pragma unroll
    for (int et = 0; et < 8; ++et) {
        f32x4 v;
#pragma unroll
        for (int r = 0; r < 4; ++r) v[r] = st_in[(size_t)(16 * wave + 4 * fq + r) * 128 + 16 * et + fr];
        asm volatile("" : "+v"(v));
#pragma unroll
        for (int r = 0; r < 4; ++r) v[r] = has_in ? v[r] : 0.f;
        st[et] = v;
    }
    __syncthreads();
#pragma unroll
    for (int et = 0; et < 8; ++et) { u32x2 w; w.x = pk2(st[et][0], st[et][1]); w.y = pk2(st[et][2], st[et][3]); *(LAS u32x2*)(ST + (16 * et + fr) * 136 + 16 * wave + 4 * fq) = w; }
    const size_t goff = (size_t)lane * INW + h * 128 + wave * 16;
    u32x4 pq[2], pk[2], pv[2];
    { const bf16* g = proj + (size_t)row0 * INW + goff;
      pq[0] = *(const u32x4*)(g); pq[1] = *(const u32x4*)(g + 8); pk[0] = *(const u32x4*)(g + 512); pk[1] = *(const u32x4*)(g + 520); pv[0] = *(const u32x4*)(g + 1024); pv[1] = *(const u32x4*)(g + 1032); }
    const float kf = kscale * exp2f(lg2 * (float)(63 - lane));
    const float g64 = exp2f(lg2 * 64.0f);
    for (int c = 0; c < nchunks; ++c) {
        const int rowc = row0 + 64 * c;
        *(LAS u32x4*)(Qs + lane * 136 + wave * 16) = pq[0]; *(LAS u32x4*)(Qs + lane * 136 + wave * 16 + 8) = pq[1];
        *(LAS u32x4*)(Ks + lane * 136 + wave * 16) = pk[0]; *(LAS u32x4*)(Ks + lane * 136 + wave * 16 + 8) = pk[1];
#pragma unroll
        for (int i = 0; i < 2; ++i)
#pragma unroll
            for (int j = 0; j < 4; ++j) { const unsigned wk = pk[i][j], wv = pv[i][j]; const int d = wave * 16 + i * 8 + j * 2;
                const unsigned kk = pk2(bflo(wk) * kf, bfhi(wk) * kf);
                KT[(d) * 72 + lane] = (bf16)(kk & 0xffffu); KT[(d + 1) * 72 + lane] = (bf16)(kk >> 16);
                VT[(d) * 72 + lane] = (bf16)(wv & 0xffffu); VT[(d + 1) * 72 + lane] = (bf16)(wv >> 16); }
        if (c + 1 < nchunks) { const bf16* g = proj + (size_t)(rowc + 64) * INW + goff;
            pq[0] = *(const u32x4*)(g); pq[1] = *(const u32x4*)(g + 8); pk[0] = *(const u32x4*)(g + 512); pk[1] = *(const u32x4*)(g + 520); pv[0] = *(const u32x4*)(g + 1024); pv[1] = *(const u32x4*)(g + 1032); }
        __syncthreads();
        { const int mi = wave >> 1;
#pragma unroll
          for (int jj = 0; jj < 2; ++jj) { const int lj = 2 * (wave & 1) + jj; f32x4 s = (f32x4){0.f, 0.f, 0.f, 0.f};
#pragma unroll
            for (int ks = 0; ks < 4; ++ks) { const bf16x8 a = *(const LAS bf16x8*)(Ks + (16 * mi + fr) * 136 + 32 * ks + 8 * fq), b = *(const LAS bf16x8*)(Qs + (16 * lj + fr) * 136 + 32 * ks + 8 * fq); s = MFMA16(a, b, s); }
            const int l = 16 * lj + fr; float pvv[4];
#pragma unroll
            for (int r = 0; r < 4; ++r) { const int m = 16 * mi + 4 * fq + r; const int dlt = l - m; pvv[r] = dlt >= 0 ? s[r] * kscale * exp2f(lg2 * (float)dlt) : 0.f; }
            u32x2 w; w.x = pk2(pvv[0], pvv[1]); w.y = pk2(pvv[2], pvv[3]); *(LAS u32x2*)(Ps + l * 72 + 16 * mi + 4 * fq) = w; } }
#pragma unroll
        for (int et = 0; et < 8; ++et) st[et] = st[et] * g64;
#pragma unroll
        for (int ks = 0; ks < 2; ++ks) { const bf16x8 a = *(const LAS bf16x8*)(KT + (16 * wave + fr) * 72 + 32 * ks + 8 * fq);
#pragma unroll
            for (int et = 0; et < 8; ++et) { const bf16x8 b = *(const LAS bf16x8*)(VT + (16 * et + fr) * 72 + 32 * ks + 8 * fq); st[et] = MFMA16(a, b, st[et]); } }
        __syncthreads();
        { f32x4 oi[4], oc[4];
#pragma unroll
          for (int lt = 0; lt < 4; ++lt) { oi[lt] = (f32x4){0.f, 0.f, 0.f, 0.f}; oc[lt] = (f32x4){0.f, 0.f, 0.f, 0.f}; }
#pragma unroll
          for (int ks = 0; ks < 2; ++ks) { const bf16x8 b = *(const LAS bf16x8*)(VT + (16 * wave + fr) * 72 + 32 * ks + 8 * fq);
#pragma unroll
            for (int lt = 0; lt < 4; ++lt) { const bf16x8 a = *(const LAS bf16x8*)(Ps + (16 * lt + fr) * 72 + 32 * ks + 8 * fq); oi[lt] = MFMA16(a, b, oi[lt]); } }
#pragma unroll
          for (int ks = 0; ks < 4; ++ks) { const bf16x8 b = *(const LAS bf16x8*)(ST + (16 * wave + fr) * 136 + 32 * ks + 8 * fq);
#pragma unroll
            for (int lt = 0; lt < 4; ++lt) { const bf16x8 a = *(const LAS bf16x8*)(Qs + (16 * lt + fr) * 136 + 32 * ks + 8 * fq); oc[lt] = MFMA16(a, b, oc[lt]); } }
#pragma unroll
          for (int lt = 0; lt < 4; ++lt)
#pragma unroll
            for (int r = 0; r < 4; ++r) { const int l = 16 * lt + 4 * fq + r; Os[l * 132 + 16 * wave + fr] = oi[lt][r] + exp2f(lg2 * (float)(l + 1)) * oc[lt][r]; } }
        __syncthreads();
#pragma unroll
        for (int et = 0; et < 8; ++et) { u32x2 w; w.x = pk2(st[et][0], st[et][1]); w.y = pk2(st[et][2], st[et][3]); *(LAS u32x2*)(ST + (16 * et + fr) * 136 + 16 * wave + 4 * fq) = w; }
        { unsigned gv[8];
#pragma unroll
          for (int i = 0; i < 8; ++i) gv[i] = *(const unsigned*)(proj + (size_t)(rowc + 8 * wave + i) * INW + 1536 + h * 128 + 2 * lane);
#pragma unroll
          for (int i = 0; i < 8; ++i) { const int l = 8 * wave + i; const f32x2 o = *(const LAS f32x2*)(Os + l * 132 + 2 * lane);
            const float ssq = wave_sum_dpp(o.x * o.x + o.y * o.y); const float rstd = rsqrtf(ssq * (1.f / 128.f) + EPS);
            const float g0 = bflo(gv[i]), g1 = bfhi(gv[i]);
            *(unsigned*)(mix + (size_t)(rowc + l) * DM + h * 128 + 2 * lane) = pk2(silu_f(g0) * o.x * rstd, silu_f(g1) * o.y * rstd); } }
    }
#pragma unroll
    for (int et = 0; et < 8; ++et)
#pragma unroll
        for (int r = 0; r < 4; ++r) st_out[(size_t)(16 * wave + 4 * fq + r) * 128 + 16 * et + fr] = st[et][r];
}
constexpr int AK = 0, AVT = 27648;
__device__ __forceinline__ void att_item(const Params& P, LAS unsigned char* lds, int tid, int wave, int lane, bool sample, int b, int n, int g) {
    const bf16* proj = (const bf16*)(P.ws + WS_R1);
    bf16* mix = (bf16*)(P.ws + WS_R2);
    const int fr = lane & 15, fq = lane >> 4;
    LAS bf16* Kl = (LAS bf16*)(lds + AK); LAS bf16* VTl = (LAS bf16*)(lds + AVT);
    const int qrow0 = sample ? MP + 64 * b : b * SEQ + 64 * n;
    const int jmin = sample ? 0 : (n >= 2 ? 0 : 64 * (2 - n));
    __syncthreads();
    {
        u32x4 kw[3], vw[3];
        if (!sample) {
#pragma unroll
            for (int i = 0; i < 3; ++i) { const bool ok = 64 * i >= jmin;
                const int rb = ok ? b * SEQ + 64 * (n - 2) + 64 * i : qrow0;
                kw[i] = *(const u32x4*)(proj + (size_t)(rb + (tid >> 3)) * INW + 2560 + g * 64 + 8 * (tid & 7));
                vw[i] = *(const u32x4*)(proj + (size_t)(rb + lane) * INW + 2688 + g * 64 + 8 * wave);
                if (!ok) { kw[i] = (u32x4){0u, 0u, 0u, 0u}; vw[i] = (u32x4){0u, 0u, 0u, 0u}; } }
        } else {
            f32x4 kc[2][2], vc[2][2];
#pragma unroll
            for (int i = 0; i < 2; ++i) { const float* sk = P.cache_k + ((size_t)(b * 128 + 64 * i + (tid >> 3)) * 2 + g) * 64 + 8 * (tid & 7); const float* sv = P.cache_v + ((size_t)(b * 128 + 64 * i + lane) * 2 + g) * 64 + 8 * wave;
                kc[i][0] = *(const f32x4*)sk; kc[i][1] = *(const f32x4*)(sk + 4); vc[i][0] = *(const f32x4*)sv; vc[i][1] = *(const f32x4*)(sv + 4); }
            kw[2] = *(const u32x4*)(proj + (size_t)(MP + 64 * b + (tid >> 3)) * INW + 2560 + g * 64 + 8 * (tid & 7));
            vw[2] = *(const u32x4*)(proj + (size_t)(MP + 64 * b + lane) * INW + 2688 + g * 64 + 8 * wave);
#pragma unroll
            for (int i = 0; i < 2; ++i) { kw[i].x = pk2(kc[i][0].x, kc[i][0].y); kw[i].y = pk2(kc[i][0].z, kc[i][0].w); kw[i].z = pk2(kc[i][1].x, kc[i][1].y); kw[i].w = pk2(kc[i][1].z, kc[i][1].w);
                vw[i].x = pk2(vc[i][0].x, vc[i][0].y); vw[i].y = pk2(vc[i][0].z, vc[i][0].w); vw[i].z = pk2(vc[i][1].x, vc[i][1].y); vw[i].w = pk2(vc[i][1].z, vc[i][1].w); }
        }
#pragma unroll
        for (int i = 0; i < 3; ++i) { *(LAS u32x4*)(Kl + (64 * i + (tid >> 3)) * 72 + 8 * (tid & 7)) = kw[i];
            const int j = 64 * i + lane;
#pragma unroll
            for (int e = 0; e < 4; ++e) { VTl[(8 * wave + 2 * e) * 200 + j] = (bf16)(vw[i][e] & 0xffffu); VTl[(8 * wave + 2 * e + 1) * 200 + j] = (bf16)(vw[i][e] >> 16); } }
    }
    const int r = wave >> 1, qh = wave & 1, head = 4 * g + r;
    const float slope = exp2f(-(float)(head + 1));
    const float sink = P.sinks[head];
    const float L2E = 1.4426950408889634f;
    __syncthreads();
#pragma unroll 1
    for (int qt = 0; qt < 2; ++qt) {
        asm volatile("" ::: "memory");
        const int qi = 32 * qh + 16 * qt + fr;
        bf16x8 qf[2];
#pragma unroll
        for (int ks = 0; ks < 2; ++ks) qf[ks] = *(const bf16x8*)(proj + (size_t)(qrow0 + qi) * INW + 2048 + head * 64 + 32 * ks + 8 * fq);
        f32x4 s[12];
#pragma unroll
        for (int kt = 0; kt < 12; ++kt) { s[kt] = (f32x4){0.f, 0.f, 0.f, 0.f};
#pragma unroll
            for (int ks = 0; ks < 2; ++ks) { const bf16x8 a = *(const LAS bf16x8*)(Kl + (16 * kt + fr) * 72 + 32 * ks + 8 * fq); s[kt] = MFMA16(a, qf[ks], s[kt]); } }
        float mx = sink;
#pragma unroll
        for (int kt = 0; kt < 12; ++kt)
#pragma unroll
            for (int rr = 0; rr < 4; ++rr) { const int j = 16 * kt + 4 * fq + rr; const int dist = 128 + qi - j;
                float v = s[kt][rr] * 0.125f - slope * fabsf((float)dist);
                v = j >= jmin ? v : -INFINITY; s[kt][rr] = v; mx = fmaxf(mx, v); }
        mx = fmaxf(mx, __shfl_xor(mx, 16)); mx = fmaxf(mx, __shfl_xor(mx, 32));
        float ls = 0.f;
#pragma unroll
        for (int kt = 0; kt < 12; ++kt)
#pragma unroll
            for (int rr = 0; rr < 4; ++rr) { const float p = exp2f((s[kt][rr] - mx) * L2E); s[kt][rr] = p; ls += p; }
        ls += __shfl_xor(ls, 16); ls += __shfl_xor(ls, 32);
        const float inv = 1.0f / (ls + exp2f((sink - mx) * L2E));
        f32x4 o[4];
#pragma unroll
        for (int dt = 0; dt < 4; ++dt) o[dt] = (f32x4){0.f, 0.f, 0.f, 0.f};
#pragma unroll
        for (int kk = 0; kk < 6; ++kk) {
            u32x4 w; w.x = pk2(s[2 * kk][0], s[2 * kk][1]); w.y = pk2(s[2 * kk][2], s[2 * kk][3]); w.z = pk2(s[2 * kk + 1][0], s[2 * kk + 1][1]); w.w = pk2(s[2 * kk + 1][2], s[2 * kk + 1][3]);
            const bf16x8 pb = __builtin_bit_cast(bf16x8, w);
#pragma unroll
            for (int dt = 0; dt < 4; ++dt) { const LAS bf16* vp = VTl + (16 * dt + fr) * 200 + 32 * kk + 4 * fq;
                const u32x2 lo = *(const LAS u32x2*)vp, hi = *(const LAS u32x2*)(vp + 16);
                const u32x4 aw = (u32x4){lo.x, lo.y, hi.x, hi.y}; const bf16x8 a = __builtin_bit_cast(bf16x8, aw);
                o[dt] = MFMA16(a, pb, o[dt]); }
        }
        bf16* mp = mix + (size_t)(qrow0 + qi) * DM + 512 + head * 64 + 4 * fq;
#pragma unroll
        for (int dt = 0; dt < 4; ++dt) { const f32x4 v = o[dt] * inv; u32x2 w; w.x = pk2(v[0], v[1]); w.y = pk2(v[2], v[3]); *(u32x2*)(mp + 16 * dt) = w; }
    }
}
__device__ __forceinline__ void phase3(const Params& P, LAS unsigned char* lds, int tid, int wave, int lane) {
    const int G = gridDim.x, NR = G / 2, blk = blockIdx.x;
    if (blk < NR) {
#ifndef NO_RET
#ifdef PROBE_RETX2
        for (int rep = 0; rep < 2; ++rep)
#endif
        for (int it = blk; it < 256; it += NR) {
            const bool sample = it >= 128; const int bh = it & 127, b = bh >> 2, h = bh & 3;
            ret_item(P, lds, tid, wave, lane, h, sample ? MP + 64 * b : b * SEQ, sample ? 1 : 32, P.state_ret + (size_t)bh * 16384, sample, P.out + (sample ? OFF_SRET : OFF_PRET) + (size_t)bh * 16384);
        }
#endif
    } else {
#ifndef NO_ATT
#ifdef PROBE_ATTX2
        for (int rep = 0; rep < 2; ++rep)
#endif
        for (int it = blk - NR; it < 2112; it += G - NR) {
            const bool sample = it >= 2048;
            att_item(P, lds, tid, wave, lane, sample, sample ? (it - 2048) >> 1 : it >> 6, sample ? 2 : (it >> 1) & 31, it & 1);
        }
#endif
    }
}

__device__ __forceinline__ void phase6(const Params& P, int tid) {
    const bf16* ua = (const bf16*)(P.ws + WS_R1); bf16* ub = (bf16*)(P.ws + WS_R2);
    constexpr int CH = DFF / 8;
    const int total = MT * CH;
    for (int idx = blockIdx.x * 512 + tid; idx < total; idx += gridDim.x * 512) {
        const int row = idx / CH, j = (idx - row * CH) * 8;
        const bool smp = row >= MP; const int t = smp ? ((row - MP) & 63) : (row & 2047);
        float a[8], p1[8], p2[8], bb[8];
        unpack8(*(const u32x4*)(ua + (size_t)row * DFF + j), a);
        unpack8(*(const u32x4*)(ub + (size_t)row * DFF + j), bb);
        if (t >= 1) unpack8(*(const u32x4*)(ua + (size_t)(row - 1) * DFF + j), p1);
        else if (smp) { const float* s = P.state_conv + ((size_t)((row - MP) >> 6) * 2 + 1) * DFF + j; const f32x4 x = *(const f32x4*)s, y = *(const f32x4*)(s + 4); p1[0] = x.x; p1[1] = x.y; p1[2] = x.z; p1[3] = x.w; p1[4] = y.x; p1[5] = y.y; p1[6] = y.z; p1[7] = y.w; }
        else {
#pragma unroll
            for (int e = 0; e < 8; ++e) p1[e] = 0.f; }
        if (t >= 2) unpack8(*(const u32x4*)(ua + (size_t)(row - 2) * DFF + j), p2);
        else if (smp) { const float* s = P.state_conv + ((size_t)((row - MP) >> 6) * 2 + t) * DFF + j; const f32x4 x = *(const f32x4*)s, y = *(const f32x4*)(s + 4); p2[0] = x.x; p2[1] = x.y; p2[2] = x.z; p2[3] = x.w; p2[4] = y.x; p2[5] = y.y; p2[6] = y.z; p2[7] = y.w; }
        else {
#pragma unroll
            for (int e = 0; e < 8; ++e) p2[e] = 0.f; }
        float r[8];
#pragma unroll
        for (int h = 0; h < 2; ++h) { const f32x4 w0 = *(const f32x4*)(P.conv_w + j + 4 * h), w1 = *(const f32x4*)(P.conv_w + DFF + j + 4 * h), w2 = *(const f32x4*)(P.conv_w + 2 * DFF + j + 4 * h), cb = *(const f32x4*)(P.conv_b + j + 4 * h);
#pragma unroll
            for (int e = 0; e < 4; ++e) { const float cv = cb[e] + w0[e] * p2[4 * h + e] + w1[e] * p1[4 * h + e] + w2[e] * a[4 * h + e]; r[4 * h + e] = silu_f(cv) * bb[4 * h + e]; } }
        u32x4 w; w.x = pk2(r[0], r[1]); w.y = pk2(r[2], r[3]); w.z = pk2(r[4], r[5]); w.w = pk2(r[6], r[7]);
        *(u32x4*)(ub + (size_t)row * DFF + j) = w;
    }
}
#ifdef CONV_FUSED
__device__ __forceinline__ void phase6c(const Params& P, int tid) {
    const float* headA = (const float*)(P.ws + WS_R1); const float* headB = headA + HT_STRIDE; const float* tailA = headA + 2 * HT_STRIDE;
    bf16* act = (bf16*)(P.ws + WS_R2);
    const int total = NGRP * DFF;
    for (int idx = blockIdx.x * 512 + tid; idx < total; idx += gridDim.x * 512) {
        const int g = idx / DFF, j = idx - g * DFF;
        float p0, p1;
        if (g < 1024) { if ((g & 31) == 0) { p0 = 0.f; p1 = 0.f; } else { p0 = tailA[((size_t)(g - 1) * 2) * DFF + j]; p1 = tailA[((size_t)(g - 1) * 2 + 1) * DFF + j]; } }
        else { p0 = P.state_conv[((size_t)(g - 1024) * 2) * DFF + j]; p1 = P.state_conv[((size_t)(g - 1024) * 2 + 1) * DFF + j]; }
        const float a0 = headA[((size_t)g * 2) * DFF + j], a1 = headA[((size_t)g * 2 + 1) * DFF + j];
        const float b0 = headB[((size_t)g * 2) * DFF + j], b1 = headB[((size_t)g * 2 + 1) * DFF + j];
        const float w0 = P.conv_w[j], w1 = P.conv_w[DFF + j], w2 = P.conv_w[2 * DFF + j], cb = P.conv_b[j];
        const float c0 = cb + w0 * p0 + w1 * p1 + w2 * a0, c1 = cb + w0 * p1 + w1 * a0 + w2 * a1;
        act[(size_t)(64 * g) * DFF + j] = (bf16)(pk2(silu_f(c0) * b0, 0.f) & 0xffffu);
        act[(size_t)(64 * g + 1) * DFF + j] = (bf16)(pk2(silu_f(c1) * b1, 0.f) & 0xffffu);
        const float t0 = tailA[((size_t)g * 2) * DFF + j], t1 = tailA[((size_t)g * 2 + 1) * DFF + j];
        if (g < 1024) { if ((g & 31) == 31) { P.out[OFF_PCONV + ((size_t)(g >> 5) * 2) * DFF + j] = t0; P.out[OFF_PCONV + ((size_t)(g >> 5) * 2 + 1) * DFF + j] = t1; } }
        else { P.out[OFF_SCONV + ((size_t)(g - 1024) * 2) * DFF + j] = t0; P.out[OFF_SCONV + ((size_t)(g - 1024) * 2 + 1) * DFF + j] = t1; }
    }
}
#endif
__device__ __forceinline__ void phase8(const Params& P, int wave, int lane) {
    const float* mod = (const float*)(P.ws + WS_MOD); const bf16* x2 = (const bf16*)(P.ws + WS_R0);
    const int gw = blockIdx.x * 8 + wave, NGW = gridDim.x * 8;
#pragma unroll 2
    for (int row = gw; row < MT; row += NGW) {
        const int bs = row < MP ? (row >> 11) : 32 + ((row - MP) >> 6);
        float* yr = P.out + (size_t)row * DM + 8 * lane;
        const float* mb = mod + (size_t)bs * 8192 + 6144 + 8 * lane;
        const bf16* xr = x2 + (size_t)row * DM + 8 * lane;
        float v[2][8]; float ss = 0.f;
#pragma unroll
        for (int j = 0; j < 2; ++j) { unpack8(*(const u32x4*)(xr + 512 * j), v[j]);
#pragma unroll
            for (int e = 0; e < 8; ++e) ss += v[j][e] * v[j][e]; }
        const float rstd = rsqrtf(wave_sum(ss) * (1.f / DM) + EPS);
#pragma unroll
        for (int j = 0; j < 2; ++j)
#pragma unroll
            for (int h = 0; h < 2; ++h) { const int o = 512 * j + 4 * h; const f32x4 sh = *(const f32x4*)(mb + o), sc = *(const f32x4*)(mb + 1024 + o), gn = *(const f32x4*)(P.normf + 8 * lane + o);
                const f32x4 x = (f32x4){v[j][4 * h], v[j][4 * h + 1], v[j][4 * h + 2], v[j][4 * h + 3]};
                *(f32x4*)(yr + o) = x * rstd * gn * (sc + 1.0f) + sh; }
    }
}
__device__ __forceinline__ void phase8q(const Params& P, LAS unsigned char* lds, int tid, int wave, int lane) {
    const float* mod = (const float*)(P.ws + WS_MOD);
    unsigned* cnt = (unsigned*)(P.ws + WS_CNT7); unsigned* ticket = (unsigned*)(P.ws + WS_TICKET);
    LAS int* ord = (LAS int*)(lds + 131072);
    LAS int* flag = ord + 272;
    pg8::StaticOrder S; S.init(MT, DM, (int)gridDim.x, 0);
    for (int i = tid; i < NTM; i += 512) flag[i] = 0;
    __syncthreads();
    { const int full = (S.nwg / S.G) * S.G; for (int L = full + tid; L < S.nwg; L += 512) { pg8::Unit u; S.map(L, u); flag[u.pm] = 1; } }
    __syncthreads();
    if (tid == 0) { int k = 0; for (int i = 0; i < NTM; ++i) if (!flag[i]) ord[k++] = i; for (int i = 0; i < NTM; ++i) if (flag[i]) ord[k++] = i; }
    __syncthreads();
    for (;;) {
        if (tid == 0) flag[268] = (int)__hip_atomic_fetch_add(ticket, 1u, __ATOMIC_RELAXED, __HIP_MEMORY_SCOPE_AGENT);
        __syncthreads();
        const int tk = flag[268];
        if (tk >= NTM * 4) break;
        const int pm = ord[tk >> 2], rb = tk & 3;
        if (wave == 0) {
            unsigned spins = 0;
            while ((unsigned)__builtin_amdgcn_readfirstlane(__hip_atomic_load(cnt + 64 * pm, __ATOMIC_RELAXED, __HIP_MEMORY_SCOPE_AGENT)) < 32u) { __builtin_amdgcn_s_sleep(4); if (++spins > (1u << 22)) break; }
            __builtin_amdgcn_fence(__ATOMIC_ACQUIRE, "agent");
            asm volatile("s_waitcnt vmcnt(0)" ::: "memory");
        }
        __syncthreads();
#pragma unroll 2
        for (int i = 0; i < 8; ++i) {
            const int row = pm * 256 + rb * 64 + wave * 8 + i;
            const int bs = row < MP ? (row >> 11) : 32 + ((row - MP) >> 6);
            float* yr = P.out + (size_t)row * DM + 4 * lane;
            const float* mb = mod + (size_t)bs * 8192 + 6144 + 4 * lane;
            f32x4 v[4]; float ss = 0.f;
#pragma unroll
            for (int j = 0; j < 4; ++j) { v[j] = *(const f32x4*)(yr + 256 * j); ss += (v[j].x * v[j].x + v[j].y * v[j].y) + (v[j].z * v[j].z + v[j].w * v[j].w); }
            const float rstd = rsqrtf(wave_sum(ss) * (1.f / DM) + EPS);
#pragma unroll
            for (int j = 0; j < 4; ++j) { const f32x4 sh = *(const f32x4*)(mb + 256 * j), sc = *(const f32x4*)(mb + 1024 + 256 * j), gn = *(const f32x4*)(P.normf + 4 * lane + 256 * j);
                *(f32x4*)(yr + 256 * j) = v[j] * rstd * gn * (sc + 1.0f) + sh; }
        }
    }
}

#ifndef N_LAUNCH
#define N_LAUNCH 1
#endif
#define LAUNDER_TID() int tid = threadIdx.x; asm volatile("" : "+v"(tid)); const int lane = tid & 63, wave = __builtin_amdgcn_readfirstlane(tid >> 6); (void)lane; (void)wave
template <int PHM>
__global__ void __launch_bounds__(512) fwd_mega(Params P) {
    extern __shared__ __attribute__((aligned(16))) unsigned char lds_raw[];
    LAS unsigned char* lds = (LAS unsigned char*)lds_raw;
    const int G = gridDim.x;
    unsigned char* ws = P.ws;
    volatile LAS unsigned* misc = (volatile LAS unsigned*)(lds + LDS_MISC);
    if (threadIdx.x < 2) misc[threadIdx.x] = 0u;
    __syncthreads();
    XcdBarrier bar; bar.bar = (unsigned*)(ws + WS_BAR); bar.x = 0; bar.st = misc;
#define GSYNC(a, b) do { if ((PHM & (a)) && (PHM & (b))) xcd_barrier(bar); } while (0)
    if constexpr (PHM == 511) {
      if (blockIdx.x == 0) for (int i = threadIdx.x; i < XCD_BAR_WORDS; i += 512) ((unsigned*)(ws + WS_BAR))[i] = 0u;
      if (blockIdx.x == 1) { for (int i = threadIdx.x; i < NTM * 64; i += 512) ((unsigned*)(ws + WS_CNT7))[i] = 0u; if (threadIdx.x < 64) ((unsigned*)(ws + WS_TICKET))[threadIdx.x] = 0u; }
      cg::this_grid().sync();
      bar = xcd_barrier_post((unsigned*)(ws + WS_BAR), misc); }
    if constexpr ((PHM & 1) != 0) { LAUNDER_TID(); phase0(P, lds, wave, lane); }
    GSYNC(1, 2);
    if constexpr ((PHM & 2) != 0) { LAUNDER_TID(); phase1(P, lds, tid, wave, lane); }
    GSYNC(2, 4);
    if constexpr ((PHM & 4) != 0) {
      pg8::Gemm g{(const bf16*)(ws + WS_R0), (const bf16*)(ws + WS_WIN), MT, INW, DM};
      OrderX S; S.S.init(MT, INW, G, (int)blockIdx.x); S.nX = 22; S.xpm = NTM; S.xpn0 = 11;
      Epi1 E{(bf16*)(ws + WS_R1), (float*)(ws + WS_SHW), P.out};
      pg8::gemm_phase<Epi1, OrderX, true, true>(lds, g, S, E); }
    GSYNC(4, 8);
    if constexpr ((PHM & 8) != 0) { LAUNDER_TID(); phase3(P, lds, tid, wave, lane);
#ifdef PROBE_P3X2
      cg::this_grid().sync(); phase3(P, lds, tid, wave, lane);
#endif
    }
    GSYNC(8, 16);
    if constexpr ((PHM & 16) != 0) {
      pg8::Gemm g{(const bf16*)(ws + WS_R2), (const bf16*)(ws + WS_WOUT), MT, DM, DM};
      pg8::StaticOrder S; S.init(MT, DM, G, (int)blockIdx.x);
      Epi2 E{P.x_p, P.x_s, (const float*)(ws + WS_MOD), P.ln2, (bf16*)(ws + WS_X1B), (bf16*)(ws + WS_R0), (float*)(ws + WS_SS1)};
      pg8::gemm_phase<Epi2, pg8::StaticOrder, true, true>(lds, g, S, E); }
    GSYNC(16, 32);
    if constexpr ((PHM & 32) != 0) {
      LAUNDER_TID();
      pg8::Gemm g{(const bf16*)(ws + WS_R0), (const bf16*)(ws + WS_WUP), MT, 2 * DFF, DM};
      pg8::StaticOrder S; S.init(MT, 2 * DFF, G, (int)blockIdx.x);
      LAS float* rtab = (LAS float*)(lds + 131072);
      { pg8::Unit u; const float* ss = (const float*)(ws + WS_SS1);
        for (int i = 0; S.next(i, u) && i < 24; ++i) if (tid < 256) { const f32x4* sp = (const f32x4*)(ss + (size_t)(u.pm * 256 + tid) * 16);
            const f32x4 q0 = sp[0], q1 = sp[1], q2 = sp[2], q3 = sp[3];
            const float tot = ((q0.x + q0.y) + (q0.z + q0.w)) + ((q1.x + q1.y) + (q1.z + q1.w)) + ((q2.x + q2.y) + (q2.z + q2.w)) + ((q3.x + q3.y) + (q3.z + q3.w));
            rtab[i * 256 + tid] = rsqrtf(tot * (1.f / DM) + EPS); }
        __syncthreads(); }
#ifdef CONV_FUSED
      float* hA = (float*)(ws + WS_R1);
      Epi3C E{rtab, (const float*)(ws + WS_SHW), P.conv_w, P.conv_b, (bf16*)(ws + WS_R2), hA, hA + HT_STRIDE, hA + 2 * HT_STRIDE};
      pg8::gemm_phase<Epi3C, pg8::StaticOrder, true, true>(lds, g, S, E);
#else
      Epi3 E{rtab, (const float*)(ws + WS_SHW), (bf16*)(ws + WS_R1), (bf16*)(ws + WS_R2), P.out};
      pg8::gemm_phase<Epi3, pg8::StaticOrder, true, true>(lds, g, S, E);
#endif
#ifdef PROBE_P5X2
      cg::this_grid().sync(); pg8::gemm_phase<Epi3, pg8::StaticOrder, true, true>(lds, g, S, E);
#endif
    }
    GSYNC(32, 64);
#ifdef CONV_FUSED
    if constexpr ((PHM & 64) != 0) { LAUNDER_TID(); phase6c(P, tid); }
#else
    if constexpr ((PHM & 64) != 0) { LAUNDER_TID(); phase6(P, tid); }
#endif
    GSYNC(64, 128);
    if constexpr ((PHM & 128) != 0) {
      pg8::Gemm g{(const bf16*)(ws + WS_R2), (const bf16*)(ws + WS_WDN), MT, DM, DFF};
#ifdef P8_QUEUE
      OrderPub S; S.init(MT, DM, G, (int)blockIdx.x); S.cnt = (unsigned*)(ws + WS_CNT7);
      Epi4 E{(const float*)(ws + WS_MOD), (const bf16*)(ws + WS_X1B), (bf16*)(ws + WS_R0)};
      pg8::gemm_phase<Epi4, OrderPub, true, true>(lds, g, S, E); }
    if constexpr ((PHM & 256) != 0) { LAUNDER_TID(); phase8q(P, lds, tid, wave, lane); }
#else
      pg8::StaticOrder S; S.init(MT, DM, G, (int)blockIdx.x);
      Epi4 E{(const float*)(ws + WS_MOD), (const bf16*)(ws + WS_X1B), (bf16*)(ws + WS_R0)};
      pg8::gemm_phase<Epi4, pg8::StaticOrder, true, true>(lds, g, S, E); }
    GSYNC(128, 256);
    if constexpr ((PHM & 256) != 0) { LAUNDER_TID(); phase8(P, wave, lane); }
#endif
}

template <int PHM> static bool launch_one(const Params& p, int grid, bool coop, hipStream_t stream) {
    static bool attr_done = false;
    if (!attr_done) { if (hipFuncSetAttribute((const void*)fwd_mega<PHM>, hipFuncAttributeMaxDynamicSharedMemorySize, LDS_BYTES) != hipSuccess) { fprintf(stderr, "kernel_launch: hipFuncSetAttribute failed\n"); return false; } attr_done = true; }
    hipError_t e;
    if (coop) { Params pc = p; void* args[] = {&pc}; e = hipLaunchCooperativeKernel((const void*)fwd_mega<PHM>, dim3(grid), dim3(512), args, LDS_BYTES, stream); }
    else { hipLaunchKernelGGL(fwd_mega<PHM>, dim3(grid), dim3(512), LDS_BYTES, stream, p); e = hipPeekAtLastError(); }
    if (e != hipSuccess) { fprintf(stderr, "launch (mask %d) failed: %s (grid %d)\n", PHM, hipGetErrorString(e), grid); return false; }
    return true;
}
extern "C" void kernel_launch(void* const* d_in, const int* in_sizes, int n_in, void* d_out, int out_size, void* d_ws, size_t ws_size, hipStream_t stream) {
    static int grid = 0;
    if (grid == 0) {
        if (n_in != 22 || (size_t)out_size != OUT_TOTAL || ws_size < WS_END) { fprintf(stderr, "kernel_launch: unexpected sizes n_in %d out %d ws %zu\n", n_in, out_size, ws_size); grid = -1; return; }
        int dev = 0, cus = 0;
        (void)hipGetDevice(&dev);
        (void)hipDeviceGetAttribute(&cus, hipDeviceAttributeMultiprocessorCount, dev);
        grid = cus;
        if (grid > 256) grid = 256;
        if (grid < 2) grid = -1;
    }
    if (grid < 0) return;
    Params p{};
    const float** pp = (const float**)&p;
    for (int i = 0; i < 22; ++i) pp[i] = (const float*)d_in[i];
    p.out = (float*)d_out; p.ws = (unsigned char*)d_ws;
#if N_LAUNCH == 1
    launch_one<511>(p, grid, true, stream);
#else
    launch_one<1>(p, grid, false, stream) && launch_one<2>(p, grid, false, stream) && launch_one<4>(p, grid, false, stream) && launch_one<8>(p, grid, false, stream) &&
    launch_one<16>(p, grid, false, stream) && launch_one<32>(p, grid, false, stream) && launch_one<64>(p, grid, false, stream) && launch_one<128>(p, grid, false, stream) && launch_one<256>(p, grid, false, stream);
#endif
}
```

```cpp
#define CONV_FUSED 1
#include <hip/hip_runtime.h>
#include <hip/hip_cooperative_groups.h>
#include <cstdio>
#include <cstdint>
namespace cg = cooperative_groups;
namespace pg8 {
#define PG8_LAS __attribute__((address_space(3)))
typedef unsigned short bf16_t;
typedef short bf16x8 __attribute__((ext_vector_type(8)));
typedef float f32x4 __attribute__((ext_vector_type(4)));
typedef unsigned u32x4 __attribute__((ext_vector_type(4)));
constexpr int BM = 256, BK = 64, HALF = 128, HTB = HALF * BK * 2  , STAGE_BYTES = 8 * HTB, NXCD = 8, WGM = 8;

__host__ __device__ __forceinline__ int lds_byte(int r, int c) { const int st = (r >> 4) * 2 + (c >> 5), rr = r & 15, cc = c & 31, ob = rr * 64 + cc * 2; return st * 1024 + (ob ^ (((ob >> 9) & 1) << 5)); }
__host__ __device__ __forceinline__ void stage_rc(int b, int& R, int& C) { const int st = b / 1024, sb = b % 1024, swz = sb ^ (((sb >> 9) & 1) << 5); R = (st >> 1) * 16 + swz / 64; C = (st & 1) * 32 + (swz % 64) / 2; }
__host__ __device__ __forceinline__ int perm32(int rho) { const int n = rho >> 4, i = rho & 15; return 8 * (i >> 2) + 4 * n + (i & 3); }

struct Unit { int pm, pn, seq, kt0, nt; };
struct Gemm { const bf16_t* A; const bf16_t* Bt; int M, N, K; };

struct StaticOrder {
    int nM, nN, nwg, G, c;
    __host__ __device__ __forceinline__ void init(int M, int N, int G_, int c_) { nM = M / BM; nN = N / BM; nwg = nM * nN; G = G_; c = c_; }
    __host__ __device__ __forceinline__ bool next(int i, Unit& u) const {
        const long L = (long)i * G + c; if (L >= nwg) return false; u.seq = i; u.kt0 = 0; u.nt = 0; map(L, u); return true; }
    __host__ __device__ __forceinline__ void map(long L, Unit& u) const {
        int wgid = (int)L; { const int q = nwg / NXCD, r = nwg % NXCD, xcd = wgid % NXCD, off = wgid / NXCD; wgid = (xcd < r ? xcd * (q + 1) : r * (q + 1) + (xcd - r) * q) + off; }
        const int nig = WGM * nN, gid = wgid / nig, fm = gid * WGM, gsz = (nM - fm) < WGM ? (nM - fm) : WGM;
        u.pm = fm + ((wgid % nig) % gsz); u.pn = (wgid % nig) / gsz;
    }
    __device__ __forceinline__ void a_ready(const Unit&) const {}
    __device__ __forceinline__ void done(const Unit&) const {}
};

__device__ __forceinline__ unsigned cvt_pk_bf16(float lo, float hi) { unsigned r; asm volatile("v_cvt_pk_bf16_f32 %0, %1, %2" : "=v"(r) : "v"(lo), "v"(hi)); return r; }

template <class Epi, class Sched, bool ALIGN_EPI = false, bool SP2 = false>
__device__ __forceinline__ void gemm_phase(PG8_LAS unsigned char* lds, const Gemm g, const Sched& S, const Epi& E) {
    int tid_ = threadIdx.x; asm volatile("" : "+v"(tid_));
    const int tid = tid_, wid = __builtin_amdgcn_readfirstlane(tid >> 6), lane = tid & 63, wr = wid >> 2, wc = wid & 3, fr = lane & 15, fq = lane >> 4;
    const int K = g.K, nt = K / BK;
    unsigned voffA[2], voffB[2];
#pragma unroll
    for (int i = 0; i < 2; ++i) { int R, C; stage_rc(tid * 16 + i * 8192, R, C); const int Rb = Epi::PERM ? ((R & ~31) + perm32(R & 31)) : R;
        voffA[i] = (unsigned)(R * K + C) * 2u; voffB[i] = (unsigned)(Rb * K + C) * 2u; }
    const size_t kstep = (size_t)(BK * 2);
    const size_t hstep = (size_t)HALF * K * 2;
    const size_t tstep = 2 * hstep;
    const unsigned ldsw = (unsigned)wid * 1024u;
    const int aoff = lds_byte(wr * 64 + fr, fq * 8), boff = lds_byte(wc * 32 + fr, fq * 8);
#define PG8_SA(b, h) (((b) * 2 + (h)) * HTB)
#define PG8_SB(b, h) ((4 + (b) * 2 + (h)) * HTB)
#define PG8_STAGE(bufoff, gbase, voff) do { _Pragma("unroll") for (int _i = 0; _i < 2; ++_i) \
        __builtin_amdgcn_global_load_lds((const unsigned*)((const char*)(gbase) + (voff)[_i]), (PG8_LAS unsigned*)(lds + (bufoff) + ldsw + _i * 8192), 16, 0, 0); } while (0)
#define PG8_LDA(dst, b, h) do { _Pragma("unroll") for (int m = 0; m < 4; ++m) _Pragma("unroll") for (int k = 0; k < 2; ++k) dst[m][k] = *(const PG8_LAS bf16x8*)(lds + PG8_SA(b, h) + aoff + m * 2048 + k * 1024); } while (0)
#define PG8_LDB(dst, b, h) do { _Pragma("unroll") for (int n = 0; n < 2; ++n) _Pragma("unroll") for (int k = 0; k < 2; ++k) dst[n][k] = *(const PG8_LAS bf16x8*)(lds + PG8_SB(b, h) + boff + n * 2048 + k * 1024); } while (0)
#define PG8_MMA(ai, bj, At, Bt) do { __builtin_amdgcn_s_setprio(1); _Pragma("unroll") for (int m = 0; m < 4; ++m) _Pragma("unroll") for (int n = 0; n < 2; ++n) _Pragma("unroll") for (int k = 0; k < 2; ++k) \
        acc[ai][bj][m][n] = __builtin_amdgcn_mfma_f32_16x16x32_bf16(Bt[n][k], At[m][k], acc[ai][bj][m][n], 0, 0, 0); __builtin_amdgcn_s_setprio(0); } while (0)
#define PG8_WAIT_V(n) asm volatile("s_waitcnt vmcnt(" #n ")" ::: "memory")
#define PG8_WAIT_L(n) asm volatile("s_waitcnt lgkmcnt(" #n ")" ::: "memory")
#define PG8_BAR __builtin_amdgcn_s_barrier()
#define PG8_SCHED __builtin_amdgcn_sched_barrier(0)
    Unit cur, nxt; int ui = 0;
    if (!S.next(0, cur)) return;
    f32x4 acc[2][2][4][2];
#pragma unroll
    for (int a = 0; a < 2; ++a)
#pragma unroll
        for (int b = 0; b < 2; ++b)
#pragma unroll
            for (int m = 0; m < 4; ++m)
#pragma unroll
                for (int n = 0; n < 2; ++n) acc[a][b][m][n] = (f32x4){0.f, 0.f, 0.f, 0.f};
    bf16x8 At[4][2], B0[2][2], B1[2][2];
    const char* cA = (const char*)g.A + (size_t)cur.pm * tstep + (size_t)cur.kt0 * (BK * 2); const char* cB = (const char*)g.Bt + (size_t)cur.pn * tstep + (size_t)cur.kt0 * (BK * 2);
    S.a_ready(cur);
    if constexpr (SP2) {
        PG8_STAGE(PG8_SB(0, 0), cB, voffB); PG8_STAGE(PG8_SB(0, 1), cB + hstep, voffB); PG8_STAGE(PG8_SA(0, 0), cA, voffA); PG8_STAGE(PG8_SA(0, 1), cA + hstep, voffA);
        if (wr == 1) PG8_BAR;
        PG8_WAIT_V(2); PG8_BAR;
        PG8_STAGE(PG8_SB(1, 0), cB + kstep, voffB); PG8_STAGE(PG8_SA(1, 0), cA + kstep, voffA); PG8_STAGE(PG8_SB(1, 1), cB + hstep + kstep, voffB);
        PG8_WAIT_V(6); PG8_BAR;
    } else {
        PG8_STAGE(PG8_SB(0, 0), cB, voffB); PG8_STAGE(PG8_SA(0, 0), cA, voffA); PG8_STAGE(PG8_SB(0, 1), cB + hstep, voffB); PG8_STAGE(PG8_SA(0, 1), cA + hstep, voffA);
        if (wr == 1) PG8_BAR;
        PG8_WAIT_V(4); PG8_BAR;
        PG8_STAGE(PG8_SB(1, 0), cB + kstep, voffB); PG8_STAGE(PG8_SA(1, 0), cA + kstep, voffA); PG8_STAGE(PG8_SB(1, 1), cB + hstep + kstep, voffB);
        PG8_WAIT_V(6); PG8_BAR;
    }
    for (;;) {
        const bool has_next = S.next(ui + 1, nxt);
        const char* nA = has_next ? (const char*)g.A + (size_t)nxt.pm * tstep + (size_t)nxt.kt0 * (BK * 2) : cA; const char* nB = has_next ? (const char*)g.Bt + (size_t)nxt.pn * tstep + (size_t)nxt.kt0 * (BK * 2) : cB;
        const int ntu = cur.nt ? cur.nt : nt;
        for (int t = 0; t < ntu; t += 2) {
            const bool last = (t == ntu - 2);
            const char* a1 = cA + (size_t)(t + 1) * kstep;
            const char* a2 = last ? nA : cA + (size_t)(t + 2) * kstep; const char* b2 = last ? nB : cB + (size_t)(t + 2) * kstep;
            const char* a3 = a2 + kstep; const char* b3 = b2 + kstep;
            if (last && has_next) S.a_ready(nxt);
            if constexpr (SP2) {
            PG8_LDB(B0, 0, 0); PG8_LDB(B1, 0, 1); PG8_SCHED; PG8_LDA(At, 0, 0); PG8_STAGE(PG8_SA(1, 1), a1 + hstep, voffA);
            PG8_WAIT_V(8); PG8_WAIT_L(0); PG8_BAR; PG8_MMA(0, 0, At, B0); PG8_MMA(0, 1, At, B1); PG8_BAR; PG8_SCHED;
            PG8_LDA(At, 0, 1); PG8_STAGE(PG8_SB(0, 0), b2, voffB); PG8_STAGE(PG8_SB(0, 1), b2 + hstep, voffB); PG8_STAGE(PG8_SA(0, 0), a2, voffA);
            PG8_WAIT_V(8); PG8_WAIT_L(0); PG8_BAR; PG8_MMA(1, 0, At, B0); PG8_MMA(1, 1, At, B1); PG8_BAR; PG8_SCHED;
            PG8_LDB(B0, 1, 0); PG8_LDB(B1, 1, 1); PG8_SCHED; PG8_LDA(At, 1, 0); PG8_STAGE(PG8_SA(0, 1), a2 + hstep, voffA);
            PG8_WAIT_V(8); PG8_WAIT_L(0); PG8_BAR; PG8_MMA(0, 0, At, B0); PG8_MMA(0, 1, At, B1); PG8_BAR; PG8_SCHED;
            PG8_LDA(At, 1, 1); PG8_STAGE(PG8_SB(1, 0), b3, voffB); PG8_STAGE(PG8_SB(1, 1), b3 + hstep, voffB); PG8_STAGE(PG8_SA(1, 0), a3, voffA);
            PG8_WAIT_V(8); PG8_WAIT_L(0); PG8_BAR; PG8_MMA(1, 0, At, B0); PG8_MMA(1, 1, At, B1); PG8_BAR; PG8_SCHED;
            } else {
            PG8_LDB(B0, 0, 0); PG8_SCHED; PG8_LDA(At, 0, 0); PG8_STAGE(PG8_SA(1, 1), a1 + hstep, voffA);
            PG8_WAIT_L(8); PG8_BAR; PG8_WAIT_L(0); PG8_MMA(0, 0, At, B0); PG8_BAR; PG8_SCHED;
            PG8_LDB(B1, 0, 1); PG8_STAGE(PG8_SB(0, 0), b2, voffB);
            PG8_BAR; PG8_WAIT_L(0); PG8_MMA(0, 1, At, B1); PG8_BAR;
            PG8_LDA(At, 0, 1); PG8_STAGE(PG8_SA(0, 0), a2, voffA);
            PG8_BAR; PG8_WAIT_L(0); PG8_MMA(1, 0, At, B0); PG8_BAR; PG8_SCHED;
            PG8_STAGE(PG8_SB(0, 1), b2 + hstep, voffB);
            PG8_WAIT_V(6); PG8_BAR; PG8_MMA(1, 1, At, B1); PG8_BAR;
            PG8_LDB(B0, 1, 0); PG8_SCHED; PG8_LDA(At, 1, 0); PG8_STAGE(PG8_SA(0, 1), a2 + hstep, voffA);
            PG8_WAIT_L(8); PG8_BAR; PG8_WAIT_L(0); PG8_MMA(0, 0, At, B0); PG8_BAR; PG8_SCHED;
            PG8_LDB(B1, 1, 1); PG8_STAGE(PG8_SB(1, 0), b3, voffB);
            PG8_BAR; PG8_WAIT_L(0); PG8_MMA(0, 1, At, B1); PG8_BAR;
            PG8_LDA(At, 1, 1); PG8_STAGE(PG8_SA(1, 0), a3, voffA);
            PG8_BAR; PG8_WAIT_L(0); PG8_MMA(1, 0, At, B0); PG8_BAR; PG8_SCHED;
            PG8_STAGE(PG8_SB(1, 1), b3 + hstep, voffB);
            PG8_WAIT_V(6); PG8_BAR; PG8_MMA(1, 1, At, B1); PG8_BAR;
            }
        }
        if constexpr (ALIGN_EPI) { if (wr == 0) PG8_BAR; }
        if constexpr (!Epi::AFTER_DRAIN) { E(acc, cur, wr, wc, fr, fq); S.done(cur); }
        if (!has_next) break;
#pragma unroll
        for (int a = 0; a < 2; ++a)
#pragma unroll
            for (int b = 0; b < 2; ++b)
#pragma unroll
                for (int m = 0; m < 4; ++m)
#pragma unroll
                    for (int n = 0; n < 2; ++n) acc[a][b][m][n] = (f32x4){0.f, 0.f, 0.f, 0.f};
        cur = nxt; cA = nA; cB = nB; ++ui;
        if constexpr (ALIGN_EPI) { if (wr == 1) PG8_BAR; }
    }
    PG8_WAIT_V(0);
    if constexpr (!ALIGN_EPI) { if (wr == 0) PG8_BAR; }
    PG8_BAR;
    if constexpr (Epi::AFTER_DRAIN) { E.fused(acc, cur, wr, wc, fr, fq, lds, wid, lane); S.done(cur); }
#undef PG8_SA
#undef PG8_SB
#undef PG8_STAGE
#undef PG8_LDA
#undef PG8_LDB
#undef PG8_MMA
#undef PG8_WAIT_V
#undef PG8_WAIT_L
#undef PG8_BAR
#undef PG8_SCHED
}
}
constexpr int DM = 1024, SEQ = 2048, NB = 32, DECL = 64, DFF = 2816, INW = 2816;
constexpr int MP = NB * SEQ, MS = NB * DECL, MT = MP + MS;
constexpr int NGRP = MT / 64;
constexpr int NTM = MT / 256;
constexpr float EPS = 1e-6f;
constexpr size_t OFF_Y = 0;
constexpr size_t OFF_PRET = (size_t)MT * DM;
constexpr size_t OFF_PK = OFF_PRET + (size_t)NB * 4 * 128 * 128;
constexpr size_t OFF_PV = OFF_PK + (size_t)NB * 128 * 128;
constexpr size_t OFF_PCONV = OFF_PV + (size_t)NB * 128 * 128;
constexpr size_t OFF_SRET = OFF_PCONV + (size_t)NB * 2 * DFF;
constexpr size_t OFF_SK = OFF_SRET + (size_t)NB * 4 * 128 * 128;
constexpr size_t OFF_SV = OFF_SK + (size_t)NB * 64 * 128;
constexpr size_t OFF_SCONV = OFF_SV + (size_t)NB * 64 * 128;
constexpr size_t OUT_TOTAL = OFF_SCONV + (size_t)NB * 2 * DFF;
constexpr size_t MiB = 1u << 20;
constexpr size_t WS_WIN = 0;
constexpr size_t WS_WUP = WS_WIN + (size_t)INW * DM * 2;
constexpr size_t WS_WOUT = WS_WUP + (size_t)2 * DFF * DM * 2;
constexpr size_t WS_WDN = WS_WOUT + (size_t)DM * DM * 2;
constexpr size_t WS_MODP = 24 * MiB;
constexpr size_t WS_MOD = 32 * MiB;
constexpr size_t WS_SHW = 34 * MiB;
constexpr size_t WS_SS1 = 36 * MiB;
constexpr size_t WS_SS2 = 41 * MiB;
constexpr size_t WS_R0 = 48 * MiB;
constexpr size_t WS_R1 = WS_R0 + 133 * MiB;
constexpr size_t WS_R2 = WS_R1 + 363 * MiB;
constexpr size_t HT_STRIDE = (size_t)NGRP * 2 * DFF;
constexpr size_t WS_END = WS_R2 + 363 * MiB;
constexpr size_t WS_SLAB = WS_R1 + 264 * MiB;
constexpr size_t WS_X1B = WS_R1 + 128 * MiB;
static_assert(3 * HT_STRIDE * 4 <= 128 * MiB && WS_X1B + (size_t)MT * DM * 2 <= WS_R2, "ws map");
static_assert(WS_WDN + (size_t)DM * DFF * 2 <= WS_MODP, "ws map");
static_assert((size_t)(MT + 256) * DM * 2 <= 133 * MiB && (size_t)MT * DFF * 2 <= 363 * MiB, "ws map");

constexpr size_t WS_BAR = 46 * MiB;
constexpr size_t WS_TICKET = 46 * MiB + 32768;
constexpr size_t WS_CNT7 = 46 * MiB + 65536;
constexpr int LDS_MISC = 155648;
constexpr int LDS_BYTES = 155648 + 64;

#define LAS __attribute__((address_space(3)))
typedef unsigned short bf16;
typedef float f32x4 __attribute__((ext_vector_type(4)));
typedef float f32x2 __attribute__((ext_vector_type(2)));
typedef short bf16x8 __attribute__((ext_vector_type(8)));
typedef unsigned u32x4 __attribute__((ext_vector_type(4)));
typedef unsigned u32x2 __attribute__((ext_vector_type(2)));
typedef __bf16 bf16x2_t __attribute__((ext_vector_type(2)));
#define LDS_WAIT() asm volatile("s_waitcnt lgkmcnt(0)" ::: "memory")

__device__ __forceinline__ unsigned pk2(float lo, float hi) { f32x2 v = {lo, hi}; bf16x2_t b = __builtin_convertvector(v, bf16x2_t); return __builtin_bit_cast(unsigned, b); }
__device__ __forceinline__ float bflo(unsigned w) { return __uint_as_float(w << 16); }
__device__ __forceinline__ float bfhi(unsigned w) { return __uint_as_float(w & 0xffff0000u); }
__device__ __forceinline__ float wave_sum(float v) {
#pragma unroll
    for (int o = 1; o < 64; o <<= 1) v += __shfl_xor(v, o);
    return v;
}
__device__ __forceinline__ float wave_sum_dpp(float v) {
    v += __int_as_float(__builtin_amdgcn_update_dpp(__float_as_int(v), __float_as_int(v), 0x128, 0xf, 0xf, false));
    v += __int_as_float(__builtin_amdgcn_update_dpp(__float_as_int(v), __float_as_int(v), 0x124, 0xf, 0xf, false));
    v += __int_as_float(__builtin_amdgcn_update_dpp(__float_as_int(v), __float_as_int(v), 0x122, 0xf, 0xf, false));
    v += __int_as_float(__builtin_amdgcn_update_dpp(__float_as_int(v), __float_as_int(v), 0x121, 0xf, 0xf, false));
    const int i = __float_as_int(v);
    return (__int_as_float(__builtin_amdgcn_readlane(i, 0)) + __int_as_float(__builtin_amdgcn_readlane(i, 16))) + (__int_as_float(__builtin_amdgcn_readlane(i, 32)) + __int_as_float(__builtin_amdgcn_readlane(i, 48)));
}
__device__ __forceinline__ float silu_f(float x) { return x * __builtin_amdgcn_rcpf(1.0f + __builtin_amdgcn_exp2f(-1.4426950408889634f * x)); }
__device__ __forceinline__ void unpack8(const u32x4 w, float (&f)[8]) { f[0] = bflo(w.x); f[1] = bfhi(w.x); f[2] = bflo(w.y); f[3] = bfhi(w.y); f[4] = bflo(w.z); f[5] = bfhi(w.z); f[6] = bflo(w.w); f[7] = bfhi(w.w); }
__device__ __forceinline__ int grp_bs(int g) { return g < 1024 ? (g >> 5) : 32 + (g - 1024); }

struct Params {
    const float *x_p, *x_s, *cache_k, *cache_v, *state_ret, *state_conv, *c_p, *c_s, *ln1, *ln2, *w_ada, *b_ada, *w_in, *w_out, *sinks, *w_up, *conv_w, *conv_b, *w_down, *normf, *w_ada_f, *b_ada_f;
    float* out; unsigned char* ws;
};

__device__ __forceinline__ void transpose_item(const float* W, int K, int N, bf16* WT, int dst_row0, int k0, int n0, LAS float* scr, int lane) {
#pragma unroll 8
    for (int i = 0; i < 32; ++i) { const int kk = 2 * i + (lane >> 5); scr[kk * 33 + (lane & 31)] = W[(size_t)(k0 + kk) * N + n0 + (lane & 31)]; }
    LDS_WAIT(); asm volatile("" ::: "memory");
    const int c = lane & 7;
#pragma unroll
    for (int j = 0; j < 4; ++j) { const int n = (lane >> 3) + 8 * j; const LAS float* s = scr + (8 * c) * 33 + n;
        u32x4 o; o.x = pk2(s[0 * 33], s[1 * 33]); o.y = pk2(s[2 * 33], s[3 * 33]); o.z = pk2(s[4 * 33], s[5 * 33]); o.w = pk2(s[6 * 33], s[7 * 33]);
        *(u32x4*)(WT + (size_t)(dst_row0 + n) * K + k0 + 8 * c) = o; }
    LDS_WAIT(); asm volatile("" ::: "memory");
}
__device__ __forceinline__ void mod_item(const Params& P, int it, LAS float* scr, int lane) {
    const int ct = it >> 2, ks = it & 3, c0 = ct * 64;
    const float* W; const float* bias; int ldw;
    if (c0 < 6144) { W = P.w_ada + c0; bias = P.b_ada + c0; ldw = 6144; } else { W = P.w_ada_f + (c0 - 6144); bias = P.b_ada_f + (c0 - 6144); ldw = 2048; }
    float acc[64];
#pragma unroll
    for (int r = 0; r < 64; ++r) acc[r] = 0.f;
    const float* crow = (lane < 32 ? P.c_p + (size_t)lane * DM : P.c_s + (size_t)(lane - 32) * DM) + ks * 256;
    for (int kc = 0; kc < 8; ++kc) {
#pragma unroll
        for (int q = 0; q < 8; ++q) { f32x4 v = *(const f32x4*)(crow + kc * 32 + 4 * q);
            v.x = silu_f(v.x); v.y = silu_f(v.y); v.z = silu_f(v.z); v.w = silu_f(v.w);
            *(LAS f32x4*)(scr + lane * 36 + 4 * q) = v; }
        LDS_WAIT(); asm volatile("" ::: "memory");
        const float* wk = W + (size_t)(ks * 256 + kc * 32) * ldw + lane;
        for (int k4 = 0; k4 < 8; ++k4) {
            const float w0 = wk[(size_t)(4 * k4 + 0) * ldw], w1 = wk[(size_t)(4 * k4 + 1) * ldw], w2 = wk[(size_t)(4 * k4 + 2) * ldw], w3 = wk[(size_t)(4 * k4 + 3) * ldw];
#pragma unroll
            for (int r = 0; r < 64; ++r) { const f32x4 s = *(const LAS f32x4*)(scr + r * 36 + 4 * k4); acc[r] += (s.x * w0 + s.y * w1) + (s.z * w2 + s.w * w3); }
        }
        LDS_WAIT(); asm volatile("" ::: "memory");
    }
    float* dst = (float*)(P.ws + WS_MODP) + (size_t)ks * 64 * 8192 + c0 + lane;
    const float bv = (ks == 0) ? bias[lane] : 0.f;
#pragma unroll
    for (int r = 0; r < 64; ++r) dst[(size_t)r * 8192] = acc[r] + bv;
}
__device__ __forceinline__ void phase0(const Params& P, LAS unsigned char* lds, int wave, int lane) {
    LAS float* scr = (LAS float*)(lds + wave * 16384);
    const int gw = wave * gridDim.x + blockIdx.x, NGW = gridDim.x * 8;
    constexpr int I_MOD = 512, I_IN = 16 * 88, I_UP = 16 * 176, I_OUT = 16 * 32, I_DN = 44 * 32;
    constexpr int NIT = I_MOD + I_IN + I_UP + I_OUT + I_DN;
    for (int it = gw; it < NIT; it += NGW) {
        int r = it;
        if (r < I_MOD) { mod_item(P, r, scr, lane); continue; } r -= I_MOD;
        if (r < I_IN) { const int kb = r / 88, nb = r % 88; transpose_item(P.w_in, DM, INW, (bf16*)(P.ws + WS_WIN), nb * 32, kb * 64, nb * 32, scr, lane); continue; } r -= I_IN;
        if (r < I_UP) { const int kb = r / 176, nb = r % 176, n0 = nb * 32, isb = n0 >= DFF, j0 = n0 - isb * DFF;
            transpose_item(P.w_up, DM, 2 * DFF, (bf16*)(P.ws + WS_WUP), 256 * (j0 >> 7) + 128 * isb + (j0 & 127), kb * 64, n0, scr, lane); continue; } r -= I_UP;
        if (r < I_OUT) { const int kb = r / 32, nb = r % 32; transpose_item(P.w_out, DM, DM, (bf16*)(P.ws + WS_WOUT), nb * 32, kb * 64, nb * 32, scr, lane); continue; } r -= I_OUT;
        { const int kb = r / 32, nb = r % 32; transpose_item(P.w_down, DFF, DM, (bf16*)(P.ws + WS_WDN), nb * 32, kb * 64, nb * 32, scr, lane); }
    }
}

__device__ __forceinline__ void phase1(const Params& P, LAS unsigned char* lds, int tid, int wave, int lane) {
    const float* modp = (const float*)(P.ws + WS_MODP);
    float* mod = (float*)(P.ws + WS_MOD);
    bf16* H1 = (bf16*)(P.ws + WS_R0);
    for (int idx = blockIdx.x * 512 + tid; idx < 64 * 8192; idx += gridDim.x * 512) {
        const float s = (modp[idx] + modp[idx + 524288]) + (modp[idx + 2 * 524288] + modp[idx + 3 * 524288]);
        mod[idx] = s;
        const int col = idx & 8191, bs = idx >> 13;
        if (col >= 3072 && col < 4096) H1[(size_t)(MT + bs) * DM + (col - 3072)] = (bf16)(pk2(s, 0.f) & 0xffffu);
    }
    LAS float* lv = (LAS float*)lds;
    const int rpb = (MT + (int)gridDim.x - 1) / (int)gridDim.x, rbeg = (int)blockIdx.x * rpb, rend = (rbeg + rpb < MT) ? rbeg + rpb : MT;
    if (rbeg < rend) {
        const int bs0 = rbeg < MP ? (rbeg >> 11) : 32 + ((rbeg - MP) >> 6), bs1 = (rend - 1) < MP ? ((rend - 1) >> 11) : 32 + ((rend - 1 - MP) >> 6);
        const int nsl = bs1 - bs0 + 1;
        __syncthreads();
        for (int i = tid; i < nsl * 2048; i += 512) { const int sl = i >> 11, which = (i >> 10) & 1, col = i & 1023; const size_t o = (size_t)(bs0 + sl) * 8192 + which * 1024 + col;
            float sv = (modp[o] + modp[o + 524288]) + (modp[o + 2 * 524288] + modp[o + 3 * 524288]);
            if (which) sv = P.ln1[col] * (1.f + sv);
            lv[i] = sv; }
        __syncthreads();
#pragma unroll 2
        for (int row = rbeg + wave; row < rend; row += 8) {
            const int bs = row < MP ? (row >> 11) : 32 + ((row - MP) >> 6);
            const LAS float* lvs = lv + (bs - bs0) * 2048;
            const float* xr = (row < MP ? P.x_p + (size_t)row * DM : P.x_s + (size_t)(row - MP) * DM) + 4 * lane;
            f32x4 v[4]; float ss = 0.f;
#pragma unroll
            for (int j = 0; j < 4; ++j) { v[j] = *(const f32x4*)(xr + 256 * j); ss += (v[j].x * v[j].x + v[j].y * v[j].y) + (v[j].z * v[j].z + v[j].w * v[j].w); }
            const float rstd = rsqrtf(wave_sum(ss) * (1.f / DM) + EPS);
            bf16* hr = H1 + (size_t)row * DM + 4 * lane;
#pragma unroll
            for (int j = 0; j < 4; ++j) { const f32x4 sh = *(const LAS f32x4*)(lvs + 256 * j + 4 * lane), gs = *(const LAS f32x4*)(lvs + 1024 + 256 * j + 4 * lane);
                const f32x4 h = v[j] * rstd * gs + sh; u32x2 w; w.x = pk2(h.x, h.y); w.y = pk2(h.z, h.w); *(u32x2*)(hr + 256 * j) = w; }
        }
    }
}

struct OrderX {
    pg8::StaticOrder S; int nX, xpm, xpn0;
    __device__ __forceinline__ bool next(int i, pg8::Unit& u) const {
        const long L = (long)i * S.G + S.c;
        int pm = 0, pn = 0; bool ok = false;
        if (L < S.nwg) { pg8::Unit t; t.pm = 0; t.pn = 0; t.seq = 0; t.kt0 = 0; t.nt = 0; (void)S.next(i, t); pm = t.pm; pn = t.pn; ok = true; }
        else if (L < S.nwg + nX) { pm = xpm; pn = xpn0 + (int)(L - S.nwg); ok = true; }
        u.pm = pm; u.pn = pn; u.seq = i; u.kt0 = 0; u.nt = 0;
        return ok;
    }
    __device__ __forceinline__ void a_ready(const pg8::Unit&) const {}
    __device__ __forceinline__ void done(const pg8::Unit&) const {}
};
struct OrderPub : pg8::StaticOrder {
    unsigned* cnt;
    __device__ __forceinline__ void done(const pg8::Unit& u) const {
        asm volatile("s_waitcnt vmcnt(0)" ::: "memory");
        if ((threadIdx.x & 63) == 0) __hip_atomic_fetch_add(cnt + 64 * u.pm, 1u, __ATOMIC_RELAXED, __HIP_MEMORY_SCOPE_AGENT);
    }
};
struct OrderDown {
    pg8::StaticOrder S;
    __device__ __forceinline__ bool next(int i, pg8::Unit& u) const {
        const long L = (long)i * S.G + S.c;
        int pm = 0, pn = 0, kt0 = 0, nt = 0; bool ok = false;
        if (L < S.nwg) { pg8::Unit t; t.pm = 0; t.pn = 0; t.seq = 0; t.kt0 = 0; t.nt = 0; (void)S.next(i, t); pm = t.pm; pn = t.pn; ok = true; }
        else if (L < S.nwg + 128) { const int q = (int)(L - S.nwg), tu = q >> 2, part = q & 3; pm = (MP / 256) + (tu & 7); pn = tu >> 3; kt0 = part < 2 ? 12 * part : 24 + 10 * (part - 2); nt = part < 2 ? 12 : 10; ok = true; }
        u.pm = pm; u.pn = pn; u.seq = i; u.kt0 = kt0; u.nt = nt;
        return ok;
    }
    __device__ __forceinline__ void a_ready(const pg8::Unit&) const {}
    __device__ __forceinline__ void done(const pg8::Unit&) const {}
};
typedef const f32x4 (&AccRef)[2][2][4][2];
struct Epi1 {
    static constexpr bool PERM = true, AFTER_DRAIN = false;
    bf16* proj; float* shw; float* out;
    __device__ __forceinline__ void operator()(AccRef acc, const pg8::Unit& u, int wr, int wc, int fr, int fq) const {
        if (u.pm == NTM) {
            if (wr == 0) {
#pragma unroll
                for (int m = 0; m < 4; ++m) { float* d = shw + (size_t)(16 * m + fr) * (2 * DFF) + 256 * (u.pn - 11) + 32 * wc + 8 * fq;
#pragma unroll
                    for (int bj = 0; bj < 2; ++bj)
#pragma unroll
                        for (int n = 0; n < 2; ++n) *(f32x4*)(d + 128 * bj + 4 * n) = acc[0][bj][m][n]; }
            }
            return;
        }
        const unsigned row0 = u.pm * 256 + wr * 64 + fr, col0 = u.pn * 256 + wc * 32 + 8 * fq;
#pragma unroll
        for (int ai = 0; ai < 2; ++ai)
#pragma unroll
            for (int m = 0; m < 4; ++m) { const unsigned o = (row0 + 128 * ai + 16 * m) * (unsigned)INW + col0;
#pragma unroll
                for (int bj = 0; bj < 2; ++bj) { const f32x4 v0 = acc[ai][bj][m][0], v1 = acc[ai][bj][m][1];
                    u32x4 w; w.x = pk2(v0[0], v0[1]); w.y = pk2(v0[2], v0[3]); w.z = pk2(v1[0], v1[1]); w.w = pk2(v1[2], v1[3]);
                    *(u32x4*)(proj + (o + 128 * bj)) = w; }
                asm volatile("" ::: "memory"); }
        if (u.pn == 10) {
            const unsigned c = 32 * wc + 8 * fq;
#pragma unroll
            for (int ai = 0; ai < 2; ++ai)
#pragma unroll
                for (int m = 0; m < 4; ++m) { const unsigned row = row0 + 128 * ai + 16 * m; unsigned ok, ov;
                    if (row < (unsigned)MP) { const unsigned t = row & 2047; if (t < SEQ - 128) continue; const unsigned o = ((row >> 11) * 128 + (t - (SEQ - 128))) * 128 + c; ok = (unsigned)OFF_PK + o; ov = (unsigned)OFF_PV + o; }
                    else { const unsigned o = (row - MP) * 128 + c; ok = (unsigned)OFF_SK + o; ov = (unsigned)OFF_SV + o; }
                    *(f32x4*)(out + ok) = acc[ai][0][m][0]; *(f32x4*)(out + ok + 4) = acc[ai][0][m][1];
                    *(f32x4*)(out + ov) = acc[ai][1][m][0]; *(f32x4*)(out + ov + 4) = acc[ai][1][m][1];
                    asm volatile("" ::: "memory"); }
        }
    }
};
struct Epi2 {
    static constexpr bool PERM = true, AFTER_DRAIN = false;
    const float *xp, *xs, *mod, *ln2; bf16* x1; bf16* a2; float* ss;
    __device__ __forceinline__ void operator()(AccRef acc, const pg8::Unit& u, int wr, int wc, int fr, int fq) const {
        const int col0 = u.pn * 256 + wc * 32 + 8 * fq;
#pragma unroll
        for (int ai = 0; ai < 2; ++ai) {
            const int bs = grp_bs(4 * u.pm + 2 * ai + wr);
            const float* mb = mod + (size_t)bs * 8192;
            f32x4 g1v[2][2], gsv[2][2];
#pragma unroll
            for (int bj = 0; bj < 2; ++bj)
#pragma unroll
                for (int n = 0; n < 2; ++n) { const int c = col0 + 128 * bj + 4 * n; g1v[bj][n] = *(const f32x4*)(mb + 2048 + c);
                    gsv[bj][n] = *(const f32x4*)(ln2 + c) * (*(const f32x4*)(mb + 4096 + c) + 1.0f); }
#pragma unroll
            for (int m = 0; m < 4; ++m) {
                const int row = u.pm * 256 + 128 * ai + 64 * wr + 16 * m + fr;
                const float* xr = row < MP ? xp + (size_t)row * DM : xs + (size_t)(row - MP) * DM;
                float s = 0.f;
#pragma unroll
                for (int bj = 0; bj < 2; ++bj) { f32x4 a[2]; f32x4 xb[2];
#pragma unroll
                    for (int n = 0; n < 2; ++n) { const int c = col0 + 128 * bj + 4 * n; const f32x4 xv = *(const f32x4*)(xr + c); const f32x4 v = xv + g1v[bj][n] * acc[ai][bj][m][n];
                        xb[n] = v; s += (v.x * v.x + v.y * v.y) + (v.z * v.z + v.w * v.w); a[n] = v * gsv[bj][n]; }
                    u32x4 w; w.x = pk2(a[0].x, a[0].y); w.y = pk2(a[0].z, a[0].w); w.z = pk2(a[1].x, a[1].y); w.w = pk2(a[1].z, a[1].w);
                    *(u32x4*)(a2 + (size_t)row * DM + col0 + 128 * bj) = w;
                    w.x = pk2(xb[0].x, xb[0].y); w.y = pk2(xb[0].z, xb[0].w); w.z = pk2(xb[1].x, xb[1].y); w.w = pk2(xb[1].z, xb[1].w);
                    *(u32x4*)(x1 + (size_t)row * DM + col0 + 128 * bj) = w; }
                s += __shfl_xor(s, 16); s += __shfl_xor(s, 32);
                if (fq == 0) ss[(size_t)row * 16 + 4 * u.pn + wc] = s;
            }
        }
    }
};
struct Epi3 {
    static constexpr bool PERM = true, AFTER_DRAIN = false;
    const LAS float* rtab; const float* shw; bf16 *ua, *ub; float* out;
    __device__ __forceinline__ void operator()(AccRef acc, const pg8::Unit& u, int wr, int wc, int fr, int fq) const {
        const unsigned j0 = u.pn * 128 + wc * 32 + 8 * fq, pc0 = u.pn * 256 + wc * 32 + 8 * fq;
#pragma unroll
        for (int ai = 0; ai < 2; ++ai) {
            const unsigned grp = 4 * u.pm + 2 * ai + wr, bs = grp_bs((int)grp);
            const unsigned so = bs * (2 * DFF) + pc0;
            const f32x4 sa0 = *(const f32x4*)(shw + so), sa1 = *(const f32x4*)(shw + so + 4), sb0 = *(const f32x4*)(shw + so + 128), sb1 = *(const f32x4*)(shw + so + 132);
#pragma unroll
            for (int m = 0; m < 4; ++m) {
                const float rstd = rtab[u.seq * 256 + 128 * ai + 64 * wr + 16 * m + fr];
                const unsigned row = grp * 64 + 16 * m + fr;
                const f32x4 a0 = acc[ai][0][m][0] * rstd + sa0, a1 = acc[ai][0][m][1] * rstd + sa1, b0 = acc[ai][1][m][0] * rstd + sb0, b1 = acc[ai][1][m][1] * rstd + sb1;
                u32x4 w; w.x = pk2(a0[0], a0[1]); w.y = pk2(a0[2], a0[3]); w.z = pk2(a1[0], a1[1]); w.w = pk2(a1[2], a1[3]);
                *(u32x4*)(ua + (row * (unsigned)DFF + j0)) = w;
                w.x = pk2(b0[0], b0[1]); w.y = pk2(b0[2], b0[3]); w.z = pk2(b1[0], b1[1]); w.w = pk2(b1[2], b1[3]);
                *(u32x4*)(ub + (row * (unsigned)DFF + j0)) = w;
                if (m == 3 && fr >= 14) {
                    if (grp >= 1024) { float* d = out + OFF_SCONV + ((size_t)(grp - 1024) * 2 + (fr - 14)) * DFF + j0; *(f32x4*)d = a0; *(f32x4*)(d + 4) = a1; }
                    else if ((grp & 31) == 31) { float* d = out + OFF_PCONV + ((size_t)(grp >> 5) * 2 + (fr - 14)) * DFF + j0; *(f32x4*)d = a0; *(f32x4*)(d + 4) = a1; }
                }
            }
        }
    }
};
#ifdef CONV_FUSED
struct Epi3C {
    static constexpr bool PERM = true, AFTER_DRAIN = false;
    const LAS float* rtab; const float *shw, *cw, *cb; bf16* act; float *headA, *headB, *tailA;
    __device__ __forceinline__ void operator()(AccRef acc, const pg8::Unit& u, int wr, int wc, int fr, int fq) const {
        const unsigned j0 = u.pn * 128 + wc * 32 + 8 * fq, pc0 = u.pn * 256 + wc * 32 + 8 * fq;
        f32x4 w0[2], w1[2], w2[2], cbv[2];
#pragma unroll
        for (int n = 0; n < 2; ++n) { w0[n] = *(const f32x4*)(cw + j0 + 4 * n); w1[n] = *(const f32x4*)(cw + DFF + j0 + 4 * n); w2[n] = *(const f32x4*)(cw + 2 * DFF + j0 + 4 * n); cbv[n] = *(const f32x4*)(cb + j0 + 4 * n); }
#pragma unroll
        for (int ai = 0; ai < 2; ++ai) {
            asm volatile("" ::: "memory");
            const unsigned grp = 4 * u.pm + 2 * ai + wr, bs = grp_bs((int)grp);
            const unsigned so = bs * (2 * DFF) + pc0, ho = (grp * 2 + (fr & 1)) * DFF + j0;
            u32x2 ap[4][2], bp[4][2];
            {
                f32x4 sa[2], sb[2];
#pragma unroll
                for (int n = 0; n < 2; ++n) { sa[n] = *(const f32x4*)(shw + so + 4 * n); sb[n] = *(const f32x4*)(shw + so + 128 + 4 * n); }
#pragma unroll
                for (int m = 0; m < 4; ++m) {
                    const float rs = rtab[u.seq * 256 + 128 * ai + 64 * wr + 16 * m + fr];
#pragma unroll
                    for (int n = 0; n < 2; ++n) {
                        const f32x4 av = acc[ai][0][m][n] * rs + sa[n], bv = acc[ai][1][m][n] * rs + sb[n];
                        if (m == 0) { if (fr < 2) { *(f32x4*)(headA + ho + 4 * n) = av; *(f32x4*)(headB + ho + 4 * n) = bv; } }
                        if (m == 3) { if (fr >= 14) *(f32x4*)(tailA + ho + 4 * n) = av; }
                        ap[m][n].x = pk2(av.x, av.y); ap[m][n].y = pk2(av.z, av.w); bp[m][n].x = pk2(bv.x, bv.y); bp[m][n].y = pk2(bv.z, bv.w);
                    }
                }
            }
            asm volatile("" ::: "memory");
#pragma unroll
            for (int n = 0; n < 2; ++n)
#pragma unroll
                for (int h = 0; h < 2; ++h) {
                    unsigned q1 = 0u, q2 = 0u;
#pragma unroll
                    for (int m = 0; m < 4; ++m) {
                        const unsigned a = ap[m][n][h];
                        const unsigned s1 = (unsigned)__builtin_amdgcn_update_dpp((int)a, (int)a, 0x121, 0xf, 0xf, false);
                        const unsigned s2 = (unsigned)__builtin_amdgcn_update_dpp((int)a, (int)a, 0x122, 0xf, 0xf, false);
                        const unsigned pr1 = fr >= 1 ? s1 : q1, pr2 = fr >= 2 ? s2 : q2;
                        q1 = s1; q2 = s2;
                        const float c0 = cbv[n][2 * h] + w0[n][2 * h] * bflo(pr2) + w1[n][2 * h] * bflo(pr1) + w2[n][2 * h] * bflo(a);
                        const float c1 = cbv[n][2 * h + 1] + w0[n][2 * h + 1] * bfhi(pr2) + w1[n][2 * h + 1] * bfhi(pr1) + w2[n][2 * h + 1] * bfhi(a);
                        const unsigned bw = bp[m][n][h];
                        bp[m][n][h] = pk2(silu_f(c0) * bflo(bw), silu_f(c1) * bfhi(bw));
                    }
                    __builtin_amdgcn_sched_barrier(0);
                }
            asm volatile("" ::: "memory");
#pragma unroll
            for (int m = 0; m < 4; ++m) {
                if (m == 0 && fr < 2) continue;
                const unsigned row = grp * 64 + 16 * m + fr;
                const u32x4 w = (u32x4){bp[m][0].x, bp[m][0].y, bp[m][1].x, bp[m][1].y};
                *(u32x4*)(act + (row * (unsigned)DFF + j0)) = w;
            }
        }
    }
};
#endif
struct Epi4 {
    static constexpr bool PERM = true, AFTER_DRAIN = false;
    const float* mod; const bf16* x1; bf16* x2; float* slab;
    __device__ __forceinline__ void operator()(AccRef acc, const pg8::Unit& u, int wr, int wc, int fr, int fq) const {
        const int col0 = u.pn * 256 + wc * 32 + 8 * fq;
        if (u.nt != 0) {
            const int part = u.kt0 == 0 ? 0 : (u.kt0 == 12 ? 1 : (u.kt0 == 24 ? 2 : 3));
            float* sb = slab + (size_t)part * MS * DM;
#pragma unroll
            for (int ai = 0; ai < 2; ++ai)
#pragma unroll
                for (int m = 0; m < 4; ++m) { const unsigned ro = (unsigned)(u.pm * 256 - MP + 128 * ai + 64 * wr + 16 * m + fr) * DM + col0;
#pragma unroll
                    for (int bj = 0; bj < 2; ++bj) { *(f32x4*)(sb + ro + 128 * bj) = acc[ai][bj][m][0]; *(f32x4*)(sb + ro + 128 * bj + 4) = acc[ai][bj][m][1]; } }
            return;
        }
#pragma unroll
        for (int ai = 0; ai < 2; ++ai) {
            const int bs = grp_bs(4 * u.pm + 2 * ai + wr);
            const float* mb = mod + (size_t)bs * 8192 + 5120;
            f32x4 g2v[2][2];
#pragma unroll
            for (int bj = 0; bj < 2; ++bj)
#pragma unroll
                for (int n = 0; n < 2; ++n) g2v[bj][n] = *(const f32x4*)(mb + col0 + 128 * bj + 4 * n);
#pragma unroll
            for (int m = 0; m < 4; ++m) {
                const unsigned ro = (unsigned)(u.pm * 256 + 128 * ai + 64 * wr + 16 * m + fr) * DM + col0;
#pragma unroll
                for (int bj = 0; bj < 2; ++bj) { const u32x4 xw = *(const u32x4*)(x1 + ro + 128 * bj);
                    const f32x4 v0 = (f32x4){bflo(xw.x), bfhi(xw.x), bflo(xw.y), bfhi(xw.y)} + g2v[bj][0] * acc[ai][bj][m][0];
                    const f32x4 v1 = (f32x4){bflo(xw.z), bfhi(xw.z), bflo(xw.w), bfhi(xw.w)} + g2v[bj][1] * acc[ai][bj][m][1];
                    u32x4 w; w.x = pk2(v0.x, v0.y); w.y = pk2(v0.z, v0.w); w.z = pk2(v1.x, v1.y); w.w = pk2(v1.z, v1.w);
                    *(u32x4*)(x2 + ro + 128 * bj) = w; }
            }
        }
    }
};
#define GAS __attribute__((address_space(1)))
#define RLX_AGENT __ATOMIC_RELAXED, __HIP_MEMORY_SCOPE_AGENT
#define XB_TMO      128
#define XB_XCNT(j)  (256  + 64 * (j))
#define XB_XSUB(j)  (1280 + 64 * (j))
#define XB_XGEN(j)  (2304 + 64 * (j))
#define XB_TOP      3328
#define XB_TOPGEN   3392
#define XCD_BAR_WORDS 3456
#define XB_SPIN_CAP (1u << 18)

__device__ __forceinline__ unsigned xb_ld(unsigned* p)              { return __hip_atomic_load(p, __ATOMIC_RELAXED, __HIP_MEMORY_SCOPE_AGENT); }
__device__ __forceinline__ unsigned xb_add(unsigned* p, unsigned v) { return __hip_atomic_fetch_add(p, v, __ATOMIC_RELAXED, __HIP_MEMORY_SCOPE_AGENT); }
__device__ __forceinline__ unsigned xb_xcc_id() { return (unsigned)__builtin_amdgcn_s_getreg((3 << 11) | 20) & 0xFu; }
#define XB_SPIN(cond, bar) do { unsigned _sp = 0; while (cond) { __builtin_amdgcn_s_sleep(1); \
    if ((++_sp & 255u) == 0u) { if (xb_ld(&(bar)[XB_TMO])) break; if (_sp > XB_SPIN_CAP) { atomicAdd(&(bar)[XB_TMO], 1u); break; } } } } while (0)

struct XcdBarrier {
    unsigned* bar; unsigned x;
    volatile LAS unsigned* st;
};

__device__ __forceinline__ XcdBarrier xcd_barrier_post(unsigned* bar, volatile LAS unsigned* st) {
    XcdBarrier b; b.bar = bar; b.x = xb_xcc_id(); b.st = st;
    if (threadIdx.x == 0) (void)xb_add(&bar[XB_XCNT(b.x)], 1u);
    return b;
}
__device__ __forceinline__ void xcd_barrier_complete(unsigned* bar, unsigned x, unsigned& nloc, unsigned& nx) {
    const unsigned G = gridDim.x * gridDim.y * gridDim.z;
    unsigned sum, cnt, mine, sp = 0u;
    for (;;) {
        sum = 0u; cnt = 0u; mine = 0u;
#pragma unroll
        for (unsigned j = 0; j < 16; ++j) { const unsigned c = xb_ld(&bar[XB_XCNT(j)]); sum += c; cnt += (c > 0u) ? 1u : 0u; mine = (j == x) ? c : mine; }
        if (sum == G) break;
        __builtin_amdgcn_s_sleep(1);
        if ((++sp & 255u) == 0u) { if (xb_ld(&bar[XB_TMO])) break; if (sp > XB_SPIN_CAP) { atomicAdd(&bar[XB_TMO], 1u); break; } }
    }
    nloc = mine > 0u ? mine : 1u; nx = cnt > 0u ? cnt : 1u;
}

__device__ __forceinline__ void xcd_barrier(const XcdBarrier& b) {
    asm volatile("s_waitcnt vmcnt(0)" ::: "memory");
    __syncthreads();
    if (threadIdx.x == 0) {
        unsigned* bar = b.bar;
        __builtin_amdgcn_s_waitcnt(0);
        unsigned nloc = b.st[0], nx = b.st[1];
        if (nloc == 0u) { xcd_barrier_complete(bar, b.x, nloc, nx); b.st[0] = nloc; b.st[1] = nx; }
        const unsigned old = xb_add(&bar[XB_XSUB(b.x)], 1u);
        const unsigned gen = old / nloc;
        if (old + 1u == (gen + 1u) * nloc) {
            __builtin_amdgcn_fence(__ATOMIC_RELEASE, "agent");
            asm volatile("s_waitcnt vmcnt(0)" ::: "memory");
            const unsigned og = xb_add(&bar[XB_TOP], 1u);
            const unsigned tg = og / nx;
            if (og + 1u == (tg + 1u) * nx) xb_add(&bar[XB_TOPGEN], 1u);
            else XB_SPIN(xb_ld(&bar[XB_TOPGEN]) == tg, bar);
            __builtin_amdgcn_fence(__ATOMIC_ACQUIRE, "agent");
            xb_add(&bar[XB_XGEN(b.x)], 1u);
            asm volatile("s_waitcnt vmcnt(0)" ::: "memory");
        } else {
            XB_SPIN(xb_ld(&bar[XB_XGEN(b.x)]) == gen, bar);
            __builtin_amdgcn_fence(__ATOMIC_ACQUIRE, "agent");
            asm volatile("s_waitcnt vmcnt(0)" ::: "memory");
        }
    }
    __syncthreads();
}
#define MFMA16(a, b, c) __builtin_amdgcn_mfma_f32_16x16x32_bf16((a), (b), (c), 0, 0, 0)
constexpr int RQ = 0, RK = 17408, RKT = 34816, RVT = 53248, RP = 71680, RST = 80896, RO = 115712;
__device__ __forceinline__ void ret_item(const Params& P, LAS unsigned char* lds, int tid, int wave, int lane, int h, int row0, int nchunks, const float* st_in, bool has_in, float* st_out) {
    const bf16* proj = (const bf16*)(P.ws + WS_R1);
    bf16* mix = (bf16*)(P.ws + WS_R2);
    const int fr = lane & 15, fq = lane >> 4;
    const float lg2 = log2f(1.0f - exp2f(-5.0f - (float)h));
    const float kscale = 0.08838834764831845f;
    LAS bf16* Qs = (LAS bf16*)(lds + RQ); LAS bf16* Ks = (LAS bf16*)(lds + RK); LAS bf16* KT = (LAS bf16*)(lds + RKT); LAS bf16* VT = (LAS bf16*)(lds + RVT);
    LAS bf16* Ps = (LAS bf16*)(lds + RP); LAS bf16* ST = (LAS bf16*)(lds + RST); LAS float* Os = (LAS float*)(lds + RO);
    f32x4 st[8];
#pragma unroll
    for (int et = 0; et < 8; ++et) {
        f32x4 v;
#pragma unroll
        for (int r = 0; r < 4; ++r) v[r] = st_in[(size_t)(16 * wave + 4 * fq + r) * 128 + 16 * et + fr];
        asm volatile("" : "+v"(v));
#pragma unroll
        for (int r = 0; r < 4; ++r) v[r] = has_in ? v[r] : 0.f;
        st[et] = v;
    }
    __syncthreads();
#pragma unroll
    for (int et = 0; et < 8; ++et) { u32x2 w; w.x = pk2(st[et][0], st[et][1]); w.y = pk2(st[et][2], st[et][3]); *(LAS u32x2*)(ST + (16 * et + fr) * 136 + 16 * wave + 4 * fq) = w; }
    const size_t goff = (size_t)lane * INW + h * 128 + wave * 16;
    u32x4 pq[2], pk[2], pv[2];
    { const bf16* g = proj + (size_t)row0 * INW + goff;
      pq[0] = *(const u32x4*)(g); pq[1] = *(const u32x4*)(g + 8); pk[0] = *(const u32x4*)(g + 512); pk[1] = *(const u32x4*)(g + 520); pv[0] = *(const u32x4*)(g + 1024); pv[1] = *(const u32x4*)(g + 1032); }
    const float kf = kscale * exp2f(lg2 * (float)(63 - lane));
    const float g64 = exp2f(lg2 * 64.0f);
    for (int c = 0; c < nchunks; ++c) {
        const int rowc = row0 + 64 * c;
        *(LAS u32x4*)(Qs + lane * 136 + wave * 16) = pq[0]; *(LAS u32x4*)(Qs + lane * 136 + wave * 16 + 8) = pq[1];
        *(LAS u32x4*)(Ks + lane * 136 + wave * 16) = pk[0]; *(LAS u32x4*)(Ks + lane * 136 + wave * 16 + 8) = pk[1];
#pragma unroll
        for (int i = 0; i < 2; ++i)
#pragma unroll
            for (int j = 0; j < 4; ++j) { const unsigned wk = pk[i][j], wv = pv[i][j]; const int d = wave * 16 + i * 8 + j * 2;
                const unsigned kk = pk2(bflo(wk) * kf, bfhi(wk) * kf);
                KT[(d) * 72 + lane] = (bf16)(kk & 0xffffu); KT[(d + 1) * 72 + lane] = (bf16)(kk >> 16);
                VT[(d) * 72 + lane] = (bf16)(wv & 0xffffu); VT[(d + 1) * 72 + lane] = (bf16)(wv >> 16); }
        if (c + 1 < nchunks) { const bf16* g = proj + (size_t)(rowc + 64) * INW + goff;
            pq[0] = *(const u32x4*)(g); pq[1] = *(const u32x4*)(g + 8); pk[0] = *(const u32x4*)(g + 512); pk[1] = *(const u32x4*)(g + 520); pv[0] = *(const u32x4*)(g + 1024); pv[1] = *(const u32x4*)(g + 1032); }
        __syncthreads();
        { const int mi = wave >> 1;
#pragma unroll
          for (int jj = 0; jj < 2; ++jj) { const int lj = 2 * (wave & 1) + jj; f32x4 s = (f32x4){0.f, 0.f, 0.f, 0.f};
#pragma unroll
            for (int ks = 0; ks < 4; ++ks) { const bf16x8 a = *(const LAS bf16x8*)(Ks + (16 * mi + fr) * 136 + 32 * ks + 8 * fq), b = *(const LAS bf16x8*)(Qs + (16 * lj + fr) * 136 + 32 * ks + 8 * fq); s = MFMA16(a, b, s); }
            const int l = 16 * lj + fr; float pvv[4];
#pragma unroll
            for (int r = 0; r < 4; ++r) { const int m = 16 * mi + 4 * fq + r; const int dlt = l - m; pvv[r] = dlt >= 0 ? s[r] * kscale * exp2f(lg2 * (float)dlt) : 0.f; }
            u32x2 w; w.x = pk2(pvv[0], pvv[1]); w.y = pk2(pvv[2], pvv[3]); *(LAS u32x2*)(Ps + l * 72 + 16 * mi + 4 * fq) = w; } }
#pragma unroll
        for (int et = 0; et < 8; ++et) st[et] = st[et] * g64;
#pragma unroll
        for (int ks = 0; ks < 2; ++ks) { const bf16x8 a = *(const LAS bf16x8*)(KT + (16 * wave + fr) * 72 + 32 * ks + 8 * fq);
#pragma unroll
            for (int et = 0; et < 8; ++et) { const bf16x8 b = *(const LAS bf16x8*)(VT + (16 * et + fr) * 72 + 32 * ks + 8 * fq); st[et] = MFMA16(a, b, st[et]); } }
        __syncthreads();
        { f32x4 oi[4], oc[4];
#pragma unroll
          for (int lt = 0; lt < 4; ++lt) { oi[lt] = (f32x4){0.f, 0.f, 0.f, 0.f}; oc[lt] = (f32x4){0.f, 0.f, 0.f, 0.f}; }
#pragma unroll
          for (int ks = 0; ks < 2; ++ks) { const bf16x8 b = *(const LAS bf16x8*)(VT + (16 * wave + fr) * 72 + 32 * ks + 8 * fq);
#pragma unroll
            for (int lt = 0; lt < 4; ++lt) { const bf16x8 a = *(const LAS bf16x8*)(Ps + (16 * lt + fr) * 72 + 32 * ks + 8 * fq); oi[lt] = MFMA16(a, b, oi[lt]); } }
#pragma unroll
          for (int ks = 0; ks < 4; ++ks) { const bf16x8 b = *(const LAS bf16x8*)(ST + (16 * wave + fr) * 136 + 32 * ks + 8 * fq);
#pragma unroll
            for (int lt = 0; lt < 4; ++lt) { const bf16x8 a = *(const LAS bf16x8*)(Qs + (16 * lt + fr) * 136 + 32 * ks + 8 * fq); oc[lt] = MFMA16(a, b, oc[lt]); } }
#pragma unroll
          for (int lt = 0; lt < 4; ++lt)
#pragma unroll
            for (int r = 0; r < 4; ++r) { const int l = 16 * lt + 4 * fq + r; Os[l * 132 + 16 * wave + fr] = oi[lt][r] + exp2f(lg2 * (float)(l + 1)) * oc[lt][r]; } }
        __syncthreads();
#pragma unroll
        for (int et = 0; et < 8; ++et) { u32x2 w; w.x = pk2(st[et][0], st[et][1]); w.y = pk2(st[et][2], st[et][3]); *(LAS u32x2*)(ST + (16 * et + fr) * 136 + 16 * wave + 4 * fq) = w; }
        { unsigned gv[8];
#pragma unroll
          for (int i = 0; i < 8; ++i) gv[i] = *(const unsigned*)(proj + (size_t)(rowc + 8 * wave + i) * INW + 1536 + h * 128 + 2 * lane);
#pragma unroll
          for (int i = 0; i < 8; ++i) { const int l = 8 * wave + i; const f32x2 o = *(const LAS f32x2*)(Os + l * 132 + 2 * lane);
            const float ssq = wave_sum_dpp(o.x * o.x + o.y * o.y); const float rstd = rsqrtf(ssq * (1.f / 128.f) + EPS);
            const float g0 = bflo(gv[i]), g1 = bfhi(gv[i]);
            *(unsigned*)(mix + (size_t)(rowc + l) * DM + h * 128 + 2 * lane) = pk2(silu_f(g0) * o.x * rstd, silu_f(g1) * o.y * rstd); } }
    }
#pragma unroll
    for (int et = 0; et < 8; ++et)
#pragma unroll
        for (int r = 0; r < 4; ++r) st_out[(size_t)(16 * wave + 4 * fq + r) * 128 + 16 * et + fr] = st[et][r];
}
constexpr int AK = 0, AVT = 27648;
__device__ __forceinline__ void att_item(const Params& P, LAS unsigned char* lds, int tid, int wave, int lane, bool sample, int b, int n, int g) {
    const bf16* proj = (const bf16*)(P.ws + WS_R1);
    bf16* mix = (bf16*)(P.ws + WS_R2);
    const int fr = lane & 15, fq = lane >> 4;
    LAS bf16* Kl = (LAS bf16*)(lds + AK); LAS bf16* VTl = (LAS bf16*)(lds + AVT);
    const int qrow0 = sample ? MP + 64 * b : b * SEQ + 64 * n;
    const int jmin = sample ? 0 : (n >= 2 ? 0 : 64 * (2 - n));
    __syncthreads();
    {
        u32x4 kw[3], vw[3];
        if (!sample) {
#pragma unroll
            for (int i = 0; i < 3; ++i) { const bool ok = 64 * i >= jmin;
                const int rb = ok ? b * SEQ + 64 * (n - 2) + 64 * i : qrow0;
                kw[i] = *(const u32x4*)(proj + (size_t)(rb + (tid >> 3)) * INW + 2560 + g * 64 + 8 * (tid & 7));
                vw[i] = *(const u32x4*)(proj + (size_t)(rb + lane) * INW + 2688 + g * 64 + 8 * wave);
                if (!ok) { kw[i] = (u32x4){0u, 0u, 0u, 0u}; vw[i] = (u32x4){0u, 0u, 0u, 0u}; } }
        } else {
            f32x4 kc[2][2], vc[2][2];
#pragma unroll
            for (int i = 0; i < 2; ++i) { const float* sk = P.cache_k + ((size_t)(b * 128 + 64 * i + (tid >> 3)) * 2 + g) * 64 + 8 * (tid & 7); const float* sv = P.cache_v + ((size_t)(b * 128 + 64 * i + lane) * 2 + g) * 64 + 8 * wave;
                kc[i][0] = *(const f32x4*)sk; kc[i][1] = *(const f32x4*)(sk + 4); vc[i][0] = *(const f32x4*)sv; vc[i][1] = *(const f32x4*)(sv + 4); }
            kw[2] = *(const u32x4*)(proj + (size_t)(MP + 64 * b + (tid >> 3)) * INW + 2560 + g * 64 + 8 * (tid & 7));
            vw[2] = *(const u32x4*)(proj + (size_t)(MP + 64 * b + lane) * INW + 2688 + g * 64 + 8 * wave);
#pragma unroll
            for (int i = 0; i < 2; ++i) { kw[i].x = pk2(kc[i][0].x, kc[i][0].y); kw[i].y = pk2(kc[i][0].z, kc[i][0].w); kw[i].z = pk2(kc[i][1].x, kc[i][1].y); kw[i].w = pk2(kc[i][1].z, kc[i][1].w);
                vw[i].x = pk2(vc[i][0].x, vc[i][0].y); vw[i].y = pk2(vc[i][0].z, vc[i][0].w); vw[i].z = pk2(vc[i][1].x, vc[i][1].y); vw[i].w = pk2(vc[i][1].z, vc[i][1].w); }
        }
#pragma unroll
        for (int i = 0; i < 3; ++i) { *(LAS u32x4*)(Kl + (64 * i + (tid >> 3)) * 72 + 8 * (tid & 7)) = kw[i];
            const int j = 64 * i + lane;
#pragma unroll
            for (int e = 0; e < 4; ++e) { VTl[(8 * wave + 2 * e) * 200 + j] = (bf16)(vw[i][e] & 0xffffu); VTl[(8 * wave + 2 * e + 1) * 200 + j] = (bf16)(vw[i][e] >> 16); } }
    }
    const int r = wave >> 1, qh = wave & 1, head = 4 * g + r;
    const float slope = exp2f(-(float)(head + 1));
    const float sink = P.sinks[head];
    const float L2E = 1.4426950408889634f;
    __syncthreads();
#pragma unroll 1
    for (int qt = 0; qt < 2; ++qt) {
        asm volatile("" ::: "memory");
        const int qi = 32 * qh + 16 * qt + fr;
        bf16x8 qf[2];
#pragma unroll
        for (int ks = 0; ks < 2; ++ks) qf[ks] = *(const bf16x8*)(proj + (size_t)(qrow0 + qi) * INW + 2048 + head * 64 + 32 * ks + 8 * fq);
        f32x4 s[12];
#pragma unroll
        for (int kt = 0; kt < 12; ++kt) { s[kt] = (f32x4){0.f, 0.f, 0.f, 0.f};
#pragma unroll
            for (int ks = 0; ks < 2; ++ks) { const bf16x8 a = *(const LAS bf16x8*)(Kl + (16 * kt + fr) * 72 + 32 * ks + 8 * fq); s[kt] = MFMA16(a, qf[ks], s[kt]); } }
        float mx = sink;
#pragma unroll
        for (int kt = 0; kt < 12; ++kt)
#pragma unroll
            for (int rr = 0; rr < 4; ++rr) { const int j = 16 * kt + 4 * fq + rr; const int dist = 128 + qi - j;
                float v = s[kt][rr] * 0.125f - slope * fabsf((float)dist);
                v = j >= jmin ? v : -INFINITY; s[kt][rr] = v; mx = fmaxf(mx, v); }
        mx = fmaxf(mx, __shfl_xor(mx, 16)); mx = fmaxf(mx, __shfl_xor(mx, 32));
        float ls = 0.f;
#pragma unroll
        for (int kt = 0; kt < 12; ++kt)
#pragma unroll
            for (int rr = 0; rr < 4; ++rr) { const float p = exp2f((s[kt][rr] - mx) * L2E); s[kt][rr] = p; ls += p; }
        ls += __shfl_xor(ls, 16); ls += __shfl_xor(ls, 32);
        const float inv = 1.0f / (ls + exp2f((sink - mx) * L2E));
        f32x4 o[4];
#pragma unroll
        for (int dt = 0; dt < 4; ++dt) o[dt] = (f32x4){0.f, 0.f, 0.f, 0.f};
#pragma unroll
        for (int kk = 0; kk < 6; ++kk) {
            u32x4 w; w.x = pk2(s[2 * kk][0], s[2 * kk][1]); w.y = pk2(s[2 * kk][2], s[2 * kk][3]); w.z = pk2(s[2 * kk + 1][0], s[2 * kk + 1][1]); w.w = pk2(s[2 * kk + 1][2], s[2 * kk + 1][3]);
            const bf16x8 pb = __builtin_bit_cast(bf16x8, w);
#pragma unroll
            for (int dt = 0; dt < 4; ++dt) { const LAS bf16* vp = VTl + (16 * dt + fr) * 200 + 32 * kk + 4 * fq;
                const u32x2 lo = *(const LAS u32x2*)vp, hi = *(const LAS u32x2*)(vp + 16);
                const u32x4 aw = (u32x4){lo.x, lo.y, hi.x, hi.y}; const bf16x8 a = __builtin_bit_cast(bf16x8, aw);
                o[dt] = MFMA16(a, pb, o[dt]); }
        }
        bf16* mp = mix + (size_t)(qrow0 + qi) * DM + 512 + head * 64 + 4 * fq;
#pragma unroll
        for (int dt = 0; dt < 4; ++dt) { const f32x4 v = o[dt] * inv; u32x2 w; w.x = pk2(v[0], v[1]); w.y = pk2(v[2], v[3]); *(u32x2*)(mp + 16 * dt) = w; }
    }
}
__device__ __forceinline__ void phase3(const Params& P, LAS unsigned char* lds, int tid, int wave, int lane) {
    const int G = gridDim.x, NR = G / 2, blk = blockIdx.x;
    if (blk < NR) {
#ifndef NO_RET
#ifdef PROBE_RETX2
        for (int rep = 0; rep < 2; ++rep)
#endif
        for (int it = blk; it < 256; it += NR) {
            const bool sample = it >= 128; const int bh = it & 127, b = bh >> 2, h = bh & 3;
            ret_item(P, lds, tid, wave, lane, h, sample ? MP + 64 * b : b * SEQ, sample ? 1 : 32, P.state_ret + (size_t)bh * 16384, sample, P.out + (sample ? OFF_SRET : OFF_PRET) + (size_t)bh * 16384);
        }
#endif
    } else {
#ifndef NO_ATT
#ifdef PROBE_ATTX2
        for (int rep = 0; rep < 2; ++rep)
#endif
        for (int it = blk - NR; it < 2112; it += G - NR) {
            const bool sample = it >= 2048;
            att_item(P, lds, tid, wave, lane, sample, sample ? (it - 2048) >> 1 : it >> 6, sample ? 2 : (it >> 1) & 31, it & 1);
        }
#endif
    }
}

__device__ __forceinline__ void phase6(const Params& P, int tid) {
    const bf16* ua = (const bf16*)(P.ws + WS_R1); bf16* ub = (bf16*)(P.ws + WS_R2);
    constexpr int CH = DFF / 8;
    const int total = MT * CH;
    for (int idx = blockIdx.x * 512 + tid; idx < total; idx += gridDim.x * 512) {
        const int row = idx / CH, j = (idx - row * CH) * 8;
        const bool smp = row >= MP; const int t = smp ? ((row - MP) & 63) : (row & 2047);
        float a[8], p1[8], p2[8], bb[8];
        unpack8(*(const u32x4*)(ua + (size_t)row * DFF + j), a);
        unpack8(*(const u32x4*)(ub + (size_t)row * DFF + j), bb);
        if (t >= 1) unpack8(*(const u32x4*)(ua + (size_t)(row - 1) * DFF + j), p1);
        else if (smp) { const float* s = P.state_conv + ((size_t)((row - MP) >> 6) * 2 + 1) * DFF + j; const f32x4 x = *(const f32x4*)s, y = *(const f32x4*)(s + 4); p1[0] = x.x; p1[1] = x.y; p1[2] = x.z; p1[3] = x.w; p1[4] = y.x; p1[5] = y.y; p1[6] = y.z; p1[7] = y.w; }
        else {
#pragma unroll
            for (int e = 0; e < 8; ++e) p1[e] = 0.f; }
        if (t >= 2) unpack8(*(const u32x4*)(ua + (size_t)(row - 2) * DFF + j), p2);
        else if (smp) { const float* s = P.state_conv + ((size_t)((row - MP) >> 6) * 2 + t) * DFF + j; const f32x4 x = *(const f32x4*)s, y = *(const f32x4*)(s + 4); p2[0] = x.x; p2[1] = x.y; p2[2] = x.z; p2[3] = x.w; p2[4] = y.x; p2[5] = y.y; p2[6] = y.z; p2[7] = y.w; }
        else {
#pragma unroll
            for (int e = 0; e < 8; ++e) p2[e] = 0.f; }
        float r[8];
#pragma unroll
        for (int h = 0; h < 2; ++h) { const f32x4 w0 = *(const f32x4*)(P.conv_w + j + 4 * h), w1 = *(const f32x4*)(P.conv_w + DFF + j + 4 * h), w2 = *(const f32x4*)(P.conv_w + 2 * DFF + j + 4 * h), cb = *(const f32x4*)(P.conv_b + j + 4 * h);
#pragma unroll
            for (int e = 0; e < 4; ++e) { const float cv = cb[e] + w0[e] * p2[4 * h + e] + w1[e] * p1[4 * h + e] + w2[e] * a[4 * h + e]; r[4 * h + e] = silu_f(cv) * bb[4 * h + e]; } }
        u32x4 w; w.x = pk2(r[0], r[1]); w.y = pk2(r[2], r[3]); w.z = pk2(r[4], r[5]); w.w = pk2(r[6], r[7]);
        *(u32x4*)(ub + (size_t)row * DFF + j) = w;
    }
}
#ifdef CONV_FUSED
__device__ __forceinline__ void phase6c(const Params& P, int tid) {
    const float* headA = (const float*)(P.ws + WS_R1); const float* headB = headA + HT_STRIDE; const float* tailA = headA + 2 * HT_STRIDE;
    bf16* act = (bf16*)(P.ws + WS_R2);
    const int total = NGRP * DFF;
    for (int idx = blockIdx.x * 512 + tid; idx < total; idx += gridDim.x * 512) {
        const int g = idx / DFF, j = idx - g * DFF;
        float p0, p1;
        if (g < 1024) { if ((g & 31) == 0) { p0 = 0.f; p1 = 0.f; } else { p0 = tailA[((size_t)(g - 1) * 2) * DFF + j]; p1 = tailA[((size_t)(g - 1) * 2 + 1) * DFF + j]; } }
        else { p0 = P.state_conv[((size_t)(g - 1024) * 2) * DFF + j]; p1 = P.state_conv[((size_t)(g - 1024) * 2 + 1) * DFF + j]; }
        const float a0 = headA[((size_t)g * 2) * DFF + j], a1 = headA[((size_t)g * 2 + 1) * DFF + j];
        const float b0 = headB[((size_t)g * 2) * DFF + j], b1 = headB[((size_t)g * 2 + 1) * DFF + j];
        const float w0 = P.conv_w[j], w1 = P.conv_w[DFF + j], w2 = P.conv_w[2 * DFF + j], cb = P.conv_b[j];
        const float c0 = cb + w0 * p0 + w1 * p1 + w2 * a0, c1 = cb + w0 * p1 + w1 * a0 + w2 * a1;
        act[(size_t)(64 * g) * DFF + j] = (bf16)(pk2(silu_f(c0) * b0, 0.f) & 0xffffu);
        act[(size_t)(64 * g + 1) * DFF + j] = (bf16)(pk2(silu_f(c1) * b1, 0.f) & 0xffffu);
        const float t0 = tailA[((size_t)g * 2) * DFF + j], t1 = tailA[((size_t)g * 2 + 1) * DFF + j];
        if (g < 1024) { if ((g & 31) == 31) { P.out[OFF_PCONV + ((size_t)(g >> 5) * 2) * DFF + j] = t0; P.out[OFF_PCONV + ((size_t)(g >> 5) * 2 + 1) * DFF + j] = t1; } }
        else { P.out[OFF_SCONV + ((size_t)(g - 1024) * 2) * DFF + j] = t0; P.out[OFF_SCONV + ((size_t)(g - 1024) * 2 + 1) * DFF + j] = t1; }
    }
}
#endif
__device__ __forceinline__ void phase8(const Params& P, int wave, int lane) {
    const float* mod = (const float*)(P.ws + WS_MOD); const bf16* x2 = (const bf16*)(P.ws + WS_R0);
    const int gw = blockIdx.x * 8 + wave, NGW = gridDim.x * 8;
#pragma unroll 2
    for (int row = gw; row < MT; row += NGW) {
        const int bs = row < MP ? (row >> 11) : 32 + ((row - MP) >> 6);
        float* yr = P.out + (size_t)row * DM + 8 * lane;
        const float* mb = mod + (size_t)bs * 8192 + 6144 + 8 * lane;
        float v[2][8]; float ss = 0.f;
        if (row < MP) {
            const bf16* xr = x2 + (size_t)row * DM + 8 * lane;
#pragma unroll
            for (int j = 0; j < 2; ++j) unpack8(*(const u32x4*)(xr + 512 * j), v[j]);
        } else {
            const bf16* xr = (const bf16*)(P.ws + WS_X1B) + (size_t)row * DM + 8 * lane;
            const float* sl = (const float*)(P.ws + WS_SLAB) + (size_t)(row - MP) * DM + 8 * lane;
            const float* g2 = mod + (size_t)bs * 8192 + 5120 + 8 * lane;
#pragma unroll
            for (int j = 0; j < 2; ++j) { unpack8(*(const u32x4*)(xr + 512 * j), v[j]);
#pragma unroll
                for (int h = 0; h < 2; ++h) { const int o = 512 * j + 4 * h; f32x4 a = *(const f32x4*)(sl + o);
#pragma unroll
                    for (int p = 1; p < 4; ++p) a += *(const f32x4*)(sl + (size_t)p * MS * DM + o);
                    const f32x4 g = *(const f32x4*)(g2 + o);
#pragma unroll
                    for (int e = 0; e < 4; ++e) v[j][4 * h + e] += g[e] * a[e]; } }
        }
#pragma unroll
        for (int j = 0; j < 2; ++j)
#pragma unroll
            for (int e = 0; e < 8; ++e) ss += v[j][e] * v[j][e];
        const float rstd = rsqrtf(wave_sum(ss) * (1.f / DM) + EPS);
#pragma unroll
        for (int j = 0; j < 2; ++j)
#pragma unroll
            for (int h = 0; h < 2; ++h) { const int o = 512 * j + 4 * h; const f32x4 sh = *(const f32x4*)(mb + o), sc = *(const f32x4*)(mb + 1024 + o), gn = *(const f32x4*)(P.normf + 8 * lane + o);
                const f32x4 x = (f32x4){v[j][4 * h], v[j][4 * h + 1], v[j][4 * h + 2], v[j][4 * h + 3]};
                *(f32x4*)(yr + o) = x * rstd * gn * (sc + 1.0f) + sh; }
    }
}
__device__ __forceinline__ void phase8q(const Params& P, LAS unsigned char* lds, int tid, int wave, int lane) {
    const float* mod = (const float*)(P.ws + WS_MOD);
    unsigned* cnt = (unsigned*)(P.ws + WS_CNT7); unsigned* ticket = (unsigned*)(P.ws + WS_TICKET);
    LAS int* ord = (LAS int*)(lds + 131072);
    LAS int* flag = ord + 272;
    pg8::StaticOrder S; S.init(MT, DM, (int)gridDim.x, 0);
    for (int i = tid; i < NTM; i += 512) flag[i] = 0;
    __syncthreads();
    { const int full = (S.nwg / S.G) * S.G; for (int L = full + tid; L < S.nwg; L += 512) { pg8::Unit u; S.map(L, u); flag[u.pm] = 1; } }
    __syncthreads();
    if (tid == 0) { int k = 0; for (int i = 0; i < NTM; ++i) if (!flag[i]) ord[k++] = i; for (int i = 0; i < NTM; ++i) if (flag[i]) ord[k++] = i; }
    __syncthreads();
    for (;;) {
        if (tid == 0) flag[268] = (int)__hip_atomic_fetch_add(ticket, 1u, __ATOMIC_RELAXED, __HIP_MEMORY_SCOPE_AGENT);
        __syncthreads();
        const int tk = flag[268];
        if (tk >= NTM * 4) break;
        const int pm = ord[tk >> 2], rb = tk & 3;
        if (wave == 0) {
            unsigned spins = 0;
            while ((unsigned)__builtin_amdgcn_readfirstlane(__hip_atomic_load(cnt + 64 * pm, __ATOMIC_RELAXED, __HIP_MEMORY_SCOPE_AGENT)) < 32u) { __builtin_amdgcn_s_sleep(4); if (++spins > (1u << 22)) break; }
            __builtin_amdgcn_fence(__ATOMIC_ACQUIRE, "agent");
            asm volatile("s_waitcnt vmcnt(0)" ::: "memory");
        }
        __syncthreads();
#pragma unroll 2
        for (int i = 0; i < 8; ++i) {
            const int row = pm * 256 + rb * 64 + wave * 8 + i;
            const int bs = row < MP ? (row >> 11) : 32 + ((row - MP) >> 6);
            float* yr = P.out + (size_t)row * DM + 4 * lane;
            const float* mb = mod + (size_t)bs * 8192 + 6144 + 4 * lane;
            f32x4 v[4]; float ss = 0.f;
#pragma unroll
            for (int j = 0; j < 4; ++j) { v[j] = *(const f32x4*)(yr + 256 * j); ss += (v[j].x * v[j].x + v[j].y * v[j].y) + (v[j].z * v[j].z + v[j].w * v[j].w); }
            const float rstd = rsqrtf(wave_sum(ss) * (1.f / DM) + EPS);
#pragma unroll
            for (int j = 0; j < 4; ++j) { const f32x4 sh = *(const f32x4*)(mb + 256 * j), sc = *(const f32x4*)(mb + 1024 + 256 * j), gn = *(const f32x4*)(P.normf + 4 * lane + 256 * j);
                *(f32x4*)(yr + 256 * j) = v[j] * rstd * gn * (sc + 1.0f) + sh; }
        }
    }
}

#ifndef N_LAUNCH
#define N_LAUNCH 1
#endif
#define LAUNDER_TID() int tid = threadIdx.x; asm volatile("" : "+v"(tid)); const int lane = tid & 63, wave = __builtin_amdgcn_readfirstlane(tid >> 6); (void)lane; (void)wave
template <int PHM>
__global__ void __launch_bounds__(512) fwd_mega(Params P) {
    extern __shared__ __attribute__((aligned(16))) unsigned char lds_raw[];
    LAS unsigned char* lds = (LAS unsigned char*)lds_raw;
    const int G = gridDim.x;
    unsigned char* ws = P.ws;
    volatile LAS unsigned* misc = (volatile LAS unsigned*)(lds + LDS_MISC);
    if (threadIdx.x < 2) misc[threadIdx.x] = 0u;
    __syncthreads();
    XcdBarrier bar; bar.bar = (unsigned*)(ws + WS_BAR); bar.x = 0; bar.st = misc;
#define GSYNC(a, b) do { if ((PHM & (a)) && (PHM & (b))) xcd_barrier(bar); } while (0)
    if constexpr (PHM == 511) {
      if (blockIdx.x == 0) for (int i = threadIdx.x; i < XCD_BAR_WORDS; i += 512) ((unsigned*)(ws + WS_BAR))[i] = 0u;
      if (blockIdx.x == 1) { for (int i = threadIdx.x; i < NTM * 64; i += 512) ((unsigned*)(ws + WS_CNT7))[i] = 0u; if (threadIdx.x < 64) ((unsigned*)(ws + WS_TICKET))[threadIdx.x] = 0u; }
      cg::this_grid().sync();
      bar = xcd_barrier_post((unsigned*)(ws + WS_BAR), misc); }
    if constexpr ((PHM & 1) != 0) { LAUNDER_TID(); phase0(P, lds, wave, lane); }
    GSYNC(1, 2);
    if constexpr ((PHM & 2) != 0) { LAUNDER_TID(); phase1(P, lds, tid, wave, lane); }
    GSYNC(2, 4);
    if constexpr ((PHM & 4) != 0) {
      pg8::Gemm g{(const bf16*)(ws + WS_R0), (const bf16*)(ws + WS_WIN), MT, INW, DM};
      OrderX S; S.S.init(MT, INW, G, (int)blockIdx.x); S.nX = 22; S.xpm = NTM; S.xpn0 = 11;
      Epi1 E{(bf16*)(ws + WS_R1), (float*)(ws + WS_SHW), P.out};
      pg8::gemm_phase<Epi1, OrderX, true, true>(lds, g, S, E); }
    GSYNC(4, 8);
    if constexpr ((PHM & 8) != 0) { LAUNDER_TID(); phase3(P, lds, tid, wave, lane);
#ifdef PROBE_P3X2
      cg::this_grid().sync(); phase3(P, lds, tid, wave, lane);
#endif
    }
    GSYNC(8, 16);
    if constexpr ((PHM & 16) != 0) {
      pg8::Gemm g{(const bf16*)(ws + WS_R2), (const bf16*)(ws + WS_WOUT), MT, DM, DM};
      pg8::StaticOrder S; S.init(MT, DM, G, (int)blockIdx.x);
      Epi2 E{P.x_p, P.x_s, (const float*)(ws + WS_MOD), P.ln2, (bf16*)(ws + WS_X1B), (bf16*)(ws + WS_R0), (float*)(ws + WS_SS1)};
      pg8::gemm_phase<Epi2, pg8::StaticOrder, true, true>(lds, g, S, E); }
    GSYNC(16, 32);
    if constexpr ((PHM & 32) != 0) {
      LAUNDER_TID();
      pg8::Gemm g{(const bf16*)(ws + WS_R0), (const bf16*)(ws + WS_WUP), MT, 2 * DFF, DM};
      pg8::StaticOrder S; S.init(MT, 2 * DFF, G, (int)blockIdx.x);
      LAS float* rtab = (LAS float*)(lds + 131072);
      { pg8::Unit u; const float* ss = (const float*)(ws + WS_SS1);
        for (int i = 0; S.next(i, u) && i < 24; ++i) if (tid < 256) { const f32x4* sp = (const f32x4*)(ss + (size_t)(u.pm * 256 + tid) * 16);
            const f32x4 q0 = sp[0], q1 = sp[1], q2 = sp[2], q3 = sp[3];
            const float tot = ((q0.x + q0.y) + (q0.z + q0.w)) + ((q1.x + q1.y) + (q1.z + q1.w)) + ((q2.x + q2.y) + (q2.z + q2.w)) + ((q3.x + q3.y) + (q3.z + q3.w));
            rtab[i * 256 + tid] = rsqrtf(tot * (1.f / DM) + EPS); }
        __syncthreads(); }
#ifdef CONV_FUSED
      float* hA = (float*)(ws + WS_R1);
      Epi3C E{rtab, (const float*)(ws + WS_SHW), P.conv_w, P.conv_b, (bf16*)(ws + WS_R2), hA, hA + HT_STRIDE, hA + 2 * HT_STRIDE};
      pg8::gemm_phase<Epi3C, pg8::StaticOrder, true, true>(lds, g, S, E);
#else
      Epi3 E{rtab, (const float*)(ws + WS_SHW), (bf16*)(ws + WS_R1), (bf16*)(ws + WS_R2), P.out};
      pg8::gemm_phase<Epi3, pg8::StaticOrder, true, true>(lds, g, S, E);
#endif
#ifdef PROBE_P5X2
      cg::this_grid().sync(); pg8::gemm_phase<Epi3, pg8::StaticOrder, true, true>(lds, g, S, E);
#endif
    }
    GSYNC(32, 64);
#ifdef CONV_FUSED
    if constexpr ((PHM & 64) != 0) { LAUNDER_TID(); phase6c(P, tid); }
#else
    if constexpr ((PHM & 64) != 0) { LAUNDER_TID(); phase6(P, tid); }
#endif
    GSYNC(64, 128);
    if constexpr ((PHM & 128) != 0) {
      pg8::Gemm g{(const bf16*)(ws + WS_R2), (const bf16*)(ws + WS_WDN), MT, DM, DFF};
#ifdef P8_QUEUE
      OrderPub S; S.init(MT, DM, G, (int)blockIdx.x); S.cnt = (unsigned*)(ws + WS_CNT7);
      Epi4 E{(const float*)(ws + WS_MOD), (const bf16*)(ws + WS_X1B), (bf16*)(ws + WS_R0), (float*)(ws + WS_SLAB)};
      pg8::gemm_phase<Epi4, OrderPub, true, true>(lds, g, S, E); }
    if constexpr ((PHM & 256) != 0) { LAUNDER_TID(); phase8q(P, lds, tid, wave, lane); }
#else
      OrderDown S; S.S.init(MP, DM, G, (int)blockIdx.x);
      Epi4 E{(const float*)(ws + WS_MOD), (const bf16*)(ws + WS_X1B), (bf16*)(ws + WS_R0), (float*)(ws + WS_SLAB)};
      pg8::gemm_phase<Epi4, OrderDown, true, true>(lds, g, S, E); }
    GSYNC(128, 256);
    if constexpr ((PHM & 256) != 0) { LAUNDER_TID(); phase8(P, wave, lane); }
#endif
}

template <int PHM> static bool launch_one(const Params& p, int grid, bool coop, hipStream_t stream) {
    static bool attr_done = false;
    if (!attr_done) { if (hipFuncSetAttribute((const void*)fwd_mega<PHM>, hipFuncAttributeMaxDynamicSharedMemorySize, LDS_BYTES) != hipSuccess) { fprintf(stderr, "kernel_launch: hipFuncSetAttribute failed\n"); return false; } attr_done = true; }
    hipError_t e;
    if (coop) { Params pc = p; void* args[] = {&pc}; e = hipLaunchCooperativeKernel((const void*)fwd_mega<PHM>, dim3(grid), dim3(512), args, LDS_BYTES, stream); }
    else { hipLaunchKernelGGL(fwd_mega<PHM>, dim3(grid), dim3(512), LDS_BYTES, stream, p); e = hipPeekAtLastError(); }
    if (e != hipSuccess) { fprintf(stderr, "launch (mask %d) failed: %s (grid %d)\n", PHM, hipGetErrorString(e), grid); return false; }
    return true;
}
extern "C" void kernel_launch(void* const* d_in, const int* in_sizes, int n_in, void* d_out, int out_size, void* d_ws, size_t ws_size, hipStream_t stream) {
    static int grid = 0;
    if (grid == 0) {
        if (n_in != 22 || (size_t)out_size != OUT_TOTAL || ws_size < WS_END) { fprintf(stderr, "kernel_launch: unexpected sizes n_in %d out %d ws %zu\n", n_in, out_size, ws_size); grid = -1; return; }
        int dev = 0, cus = 0;
        (void)hipGetDevice(&dev);
        (void)hipDeviceGetAttribute(&cus, hipDeviceAttributeMultiprocessorCount, dev);
        grid = cus;
        if (grid > 256) grid = 256;
        if (grid < 2) grid = -1;
    }
    if (grid < 0) return;
    Params p{};
    const float** pp = (const float**)&p;
    for (int i = 0; i < 22; ++i) pp[i] = (const float*)d_in[i];
    p.out = (float*)d_out; p.ws = (unsigned char*)d_ws;
#if N_LAUNCH == 1
    launch_one<511>(p, grid, true, stream);
#else
    launch_one<1>(p, grid, false, stream) && launch_one<2>(p, grid, false, stream) && launch_one<4>(p, grid, false, stream) && launch_one<8>(p, grid, false, stream) &&
    launch_one<16>(p, grid, false, stream) && launch_one<32>(p, grid, false, stream) && launch_one<64>(p, grid, false, stream) && launch_one<128>(p, grid, false, stream) && launch_one<256>(p, grid, false, stream);
#endif
}
```

```cpp
#define CONV_FUSED 1
#include <hip/hip_runtime.h>
#include <hip/hip_cooperative_groups.h>
#include <cstdio>
#include <cstdint>
namespace cg = cooperative_groups;
namespace pg8 {
#define PG8_LAS __attribute__((address_space(3)))
typedef unsigned short bf16_t;
typedef short bf16x8 __attribute__((ext_vector_type(8)));
typedef float f32x4 __attribute__((ext_vector_type(4)));
typedef unsigned u32x4 __attribute__((ext_vector_type(4)));
constexpr int BM = 256, BK = 64, HALF = 128, HTB = HALF * BK * 2  , STAGE_BYTES = 8 * HTB, NXCD = 8, WGM = 8;

__host__ __device__ __forceinline__ int lds_byte(int r, int c) { const int st = (r >> 4) * 2 + (c >> 5), rr = r & 15, cc = c & 31, ob = rr * 64 + cc * 2; return st * 1024 + (ob ^ (((ob >> 9) & 1) << 5)); }
__host__ __device__ __forceinline__ void stage_rc(int b, int& R, int& C) { const int st = b / 1024, sb = b % 1024, swz = sb ^ (((sb >> 9) & 1) << 5); R = (st >> 1) * 16 + swz / 64; C = (st & 1) * 32 + (swz % 64) / 2; }
__host__ __device__ __forceinline__ int perm32(int rho) { const int n = rho >> 4, i = rho & 15; return 8 * (i >> 2) + 4 * n + (i & 3); }

struct Unit { int pm, pn, seq, kt0, nt; };
struct Gemm { const bf16_t* A; const bf16_t* Bt; int M, N, K; };

struct StaticOrder {
    int nM, nN, nwg, G, c;
    __host__ __device__ __forceinline__ void init(int M, int N, int G_, int c_) { nM = M / BM; nN = N / BM; nwg = nM * nN; G = G_; c = c_; }
    __host__ __device__ __forceinline__ bool next(int i, Unit& u) const {
        const long L = (long)i * G + c; if (L >= nwg) return false; u.seq = i; u.kt0 = 0; u.nt = 0; map(L, u); return true; }
    __host__ __device__ __forceinline__ void map(long L, Unit& u) const {
        int wgid = (int)L; { const int q = nwg / NXCD, r = nwg % NXCD, xcd = wgid % NXCD, off = wgid / NXCD; wgid = (xcd < r ? xcd * (q + 1) : r * (q + 1) + (xcd - r) * q) + off; }
        const int nig = WGM * nN, gid = wgid / nig, fm = gid * WGM, gsz = (nM - fm) < WGM ? (nM - fm) : WGM;
        u.pm = fm + ((wgid % nig) % gsz); u.pn = (wgid % nig) / gsz;
    }
    __device__ __forceinline__ void a_ready(const Unit&) const {}
    __device__ __forceinline__ void done(const Unit&) const {}
};

__device__ __forceinline__ unsigned cvt_pk_bf16(float lo, float hi) { unsigned r; asm volatile("v_cvt_pk_bf16_f32 %0, %1, %2" : "=v"(r) : "v"(lo), "v"(hi)); return r; }

template <class Epi, class Sched, bool ALIGN_EPI = false, bool SP2 = false>
__device__ __forceinline__ void gemm_phase(PG8_LAS unsigned char* lds, const Gemm g, const Sched& S, const Epi& E) {
    int tid_ = threadIdx.x; asm volatile("" : "+v"(tid_));
    const int tid = tid_, wid = __builtin_amdgcn_readfirstlane(tid >> 6), lane = tid & 63, wr = wid >> 2, wc = wid & 3, fr = lane & 15, fq = lane >> 4;
    const int K = g.K, nt = K / BK;
    unsigned voffA[2], voffB[2];
#pragma unroll
    for (int i = 0; i < 2; ++i) { int R, C; stage_rc(tid * 16 + i * 8192, R, C); const int Rb = Epi::PERM ? ((R & ~31) + perm32(R & 31)) : R;
        voffA[i] = (unsigned)(R * K + C) * 2u; voffB[i] = (unsigned)(Rb * K + C) * 2u; }
    const size_t kstep = (size_t)(BK * 2);
    const size_t hstep = (size_t)HALF * K * 2;
    const size_t tstep = 2 * hstep;
    const unsigned ldsw = (unsigned)wid * 1024u;
    const int aoff = lds_byte(wr * 64 + fr, fq * 8), boff = lds_byte(wc * 32 + fr, fq * 8);
#define PG8_SA(b, h) (((b) * 2 + (h)) * HTB)
#define PG8_SB(b, h) ((4 + (b) * 2 + (h)) * HTB)
#define PG8_STAGE(bufoff, gbase, voff) do { _Pragma("unroll") for (int _i = 0; _i < 2; ++_i) \
        __builtin_amdgcn_global_load_lds((const unsigned*)((const char*)(gbase) + (voff)[_i]), (PG8_LAS unsigned*)(lds + (bufoff) + ldsw + _i * 8192), 16, 0, 0); } while (0)
#define PG8_LDA(dst, b, h) do { _Pragma("unroll") for (int m = 0; m < 4; ++m) _Pragma("unroll") for (int k = 0; k < 2; ++k) dst[m][k] = *(const PG8_LAS bf16x8*)(lds + PG8_SA(b, h) + aoff + m * 2048 + k * 1024); } while (0)
#define PG8_LDB(dst, b, h) do { _Pragma("unroll") for (int n = 0; n < 2; ++n) _Pragma("unroll") for (int k = 0; k < 2; ++k) dst[n][k] = *(const PG8_LAS bf16x8*)(lds + PG8_SB(b, h) + boff + n * 2048 + k * 1024); } while (0)
#define PG8_MMA(ai, bj, At, Bt) do { __builtin_amdgcn_s_setprio(1); _Pragma("unroll") for (int m = 0; m < 4; ++m) _Pragma("unroll") for (int n = 0; n < 2; ++n) _Pragma("unroll") for (int k = 0; k < 2; ++k) \
        acc[ai][bj][m][n] = __builtin_amdgcn_mfma_f32_16x16x32_bf16(Bt[n][k], At[m][k], acc[ai][bj][m][n], 0, 0, 0); __builtin_amdgcn_s_setprio(0); } while (0)
#define PG8_WAIT_V(n) asm volatile("s_waitcnt vmcnt(" #n ")" ::: "memory")
#define PG8_WAIT_L(n) asm volatile("s_waitcnt lgkmcnt(" #n ")" ::: "memory")
#define PG8_BAR __builtin_amdgcn_s_barrier()
#define PG8_SCHED __builtin_amdgcn_sched_barrier(0)
    Unit cur, nxt; int ui = 0;
    if (!S.next(0, cur)) return;
    f32x4 acc[2][2][4][2];
#pragma unroll
    for (int a = 0; a < 2; ++a)
#pragma unroll
        for (int b = 0; b < 2; ++b)
#pragma unroll
            for (int m = 0; m < 4; ++m)
#pragma unroll
                for (int n = 0; n < 2; ++n) acc[a][b][m][n] = (f32x4){0.f, 0.f, 0.f, 0.f};
    bf16x8 At[4][2], B0[2][2], B1[2][2];
    const char* cA = (const char*)g.A + (size_t)cur.pm * tstep + (size_t)cur.kt0 * (BK * 2); const char* cB = (const char*)g.Bt + (size_t)cur.pn * tstep + (size_t)cur.kt0 * (BK * 2);
    S.a_ready(cur);
    if constexpr (SP2) {
        PG8_STAGE(PG8_SB(0, 0), cB, voffB); PG8_STAGE(PG8_SB(0, 1), cB + hstep, voffB); PG8_STAGE(PG8_SA(0, 0), cA, voffA); PG8_STAGE(PG8_SA(0, 1), cA + hstep, voffA);
        if (wr == 1) PG8_BAR;
        PG8_WAIT_V(2); PG8_BAR;
        PG8_STAGE(PG8_SB(1, 0), cB + kstep, voffB); PG8_STAGE(PG8_SA(1, 0), cA + kstep, voffA); PG8_STAGE(PG8_SB(1, 1), cB + hstep + kstep, voffB);
        PG8_WAIT_V(6); PG8_BAR;
    } else {
        PG8_STAGE(PG8_SB(0, 0), cB, voffB); PG8_STAGE(PG8_SA(0, 0), cA, voffA); PG8_STAGE(PG8_SB(0, 1), cB + hstep, voffB); PG8_STAGE(PG8_SA(0, 1), cA + hstep, voffA);
        if (wr == 1) PG8_BAR;
        PG8_WAIT_V(4); PG8_BAR;
        PG8_STAGE(PG8_SB(1, 0), cB + kstep, voffB); PG8_STAGE(PG8_SA(1, 0), cA + kstep, voffA); PG8_STAGE(PG8_SB(1, 1), cB + hstep + kstep, voffB);
        PG8_WAIT_V(6); PG8_BAR;
    }
    for (;;) {
        const bool has_next = S.next(ui + 1, nxt);
        const char* nA = has_next ? (const char*)g.A + (size_t)nxt.pm * tstep + (size_t)nxt.kt0 * (BK * 2) : cA; const char* nB = has_next ? (const char*)g.Bt + (size_t)nxt.pn * tstep + (size_t)nxt.kt0 * (BK * 2) : cB;
        const int ntu = cur.nt ? cur.nt : nt;
        for (int t = 0; t < ntu; t += 2) {
            const bool last = (t == ntu - 2);
            const char* a1 = cA + (size_t)(t + 1) * kstep;
            const char* a2 = last ? nA : cA + (size_t)(t + 2) * kstep; const char* b2 = last ? nB : cB + (size_t)(t + 2) * kstep;
            const char* a3 = a2 + kstep; const char* b3 = b2 + kstep;
            if (last && has_next) S.a_ready(nxt);
            if constexpr (SP2) {
            PG8_LDB(B0, 0, 0); PG8_LDB(B1, 0, 1); PG8_SCHED; PG8_LDA(At, 0, 0); PG8_STAGE(PG8_SA(1, 1), a1 + hstep, voffA);
            PG8_WAIT_V(8); PG8_WAIT_L(0); PG8_BAR; PG8_MMA(0, 0, At, B0); PG8_MMA(0, 1, At, B1); PG8_BAR; PG8_SCHED;
            PG8_LDA(At, 0, 1); PG8_STAGE(PG8_SB(0, 0), b2, voffB); PG8_STAGE(PG8_SB(0, 1), b2 + hstep, voffB); PG8_STAGE(PG8_SA(0, 0), a2, voffA);
            PG8_WAIT_V(8); PG8_WAIT_L(0); PG8_BAR; PG8_MMA(1, 0, At, B0); PG8_MMA(1, 1, At, B1); PG8_BAR; PG8_SCHED;
            PG8_LDB(B0, 1, 0); PG8_LDB(B1, 1, 1); PG8_SCHED; PG8_LDA(At, 1, 0); PG8_STAGE(PG8_SA(0, 1), a2 + hstep, voffA);
            PG8_WAIT_V(8); PG8_WAIT_L(0); PG8_BAR; PG8_MMA(0, 0, At, B0); PG8_MMA(0, 1, At, B1); PG8_BAR; PG8_SCHED;
            PG8_LDA(At, 1, 1); PG8_STAGE(PG8_SB(1, 0), b3, voffB); PG8_STAGE(PG8_SB(1, 1), b3 + hstep, voffB); PG8_STAGE(PG8_SA(1, 0), a3, voffA);
            PG8_WAIT_V(8); PG8_WAIT_L(0); PG8_BAR; PG8_MMA(1, 0, At, B0); PG8_MMA(1, 1, At, B1); PG8_BAR; PG8_SCHED;
            } else {
            PG8_LDB(B0, 0, 0); PG8_SCHED; PG8_LDA(At, 0, 0); PG8_STAGE(PG8_SA(1, 1), a1 + hstep, voffA);
            PG8_WAIT_L(8); PG8_BAR; PG8_WAIT_L(0); PG8_MMA(0, 0, At, B0); PG8_BAR; PG8_SCHED;
            PG8_LDB(B1, 0, 1); PG8_STAGE(PG8_SB(0, 0), b2, voffB);
            PG8_BAR; PG8_WAIT_L(0); PG8_MMA(0, 1, At, B1); PG8_BAR;
            PG8_LDA(At, 0, 1); PG8_STAGE(PG8_SA(0, 0), a2, voffA);
            PG8_BAR; PG8_WAIT_L(0); PG8_MMA(1, 0, At, B0); PG8_BAR; PG8_SCHED;
            PG8_STAGE(PG8_SB(0, 1), b2 + hstep, voffB);
            PG8_WAIT_V(6); PG8_BAR; PG8_MMA(1, 1, At, B1); PG8_BAR;
            PG8_LDB(B0, 1, 0); PG8_SCHED; PG8_LDA(At, 1, 0); PG8_STAGE(PG8_SA(0, 1), a2 + hstep, voffA);
            PG8_WAIT_L(8); PG8_BAR; PG8_WAIT_L(0); PG8_MMA(0, 0, At, B0); PG8_BAR; PG8_SCHED;
            PG8_LDB(B1, 1, 1); PG8_STAGE(PG8_SB(1, 0), b3, voffB);
            PG8_BAR; PG8_WAIT_L(0); PG8_MMA(0, 1, At, B1); PG8_BAR;
            PG8_LDA(At, 1, 1); PG8_STAGE(PG8_SA(1, 0), a3, voffA);
            PG8_BAR; PG8_WAIT_L(0); PG8_MMA(1, 0, At, B0); PG8_BAR; PG8_SCHED;
            PG8_STAGE(PG8_SB(1, 1), b3 + hstep, voffB);
            PG8_WAIT_V(6); PG8_BAR; PG8_MMA(1, 1, At, B1); PG8_BAR;
            }
        }
        if constexpr (ALIGN_EPI) { if (wr == 0) PG8_BAR; }
        if constexpr (!Epi::AFTER_DRAIN) { E(acc, cur, wr, wc, fr, fq); S.done(cur); }
        if (!has_next) break;
#pragma unroll
        for (int a = 0; a < 2; ++a)
#pragma unroll
            for (int b = 0; b < 2; ++b)
#pragma unroll
                for (int m = 0; m < 4; ++m)
#pragma unroll
                    for (int n = 0; n < 2; ++n) acc[a][b][m][n] = (f32x4){0.f, 0.f, 0.f, 0.f};
        cur = nxt; cA = nA; cB = nB; ++ui;
        if constexpr (ALIGN_EPI) { if (wr == 1) PG8_BAR; }
    }
    PG8_WAIT_V(0);
    if constexpr (!ALIGN_EPI) { if (wr == 0) PG8_BAR; }
    PG8_BAR;
    if constexpr (Epi::AFTER_DRAIN) { E.fused(acc, cur, wr, wc, fr, fq, lds, wid, lane); S.done(cur); }
#undef PG8_SA
#undef PG8_SB
#undef PG8_STAGE
#undef PG8_LDA
#undef PG8_LDB
#undef PG8_MMA
#undef PG8_WAIT_V
#undef PG8_WAIT_L
#undef PG8_BAR
#undef PG8_SCHED
}
}
constexpr int DM = 1024, SEQ = 2048, NB = 32, DECL = 64, DFF = 2816, INW = 2816;
constexpr int MP = NB * SEQ, MS = NB * DECL, MT = MP + MS;
constexpr int NGRP = MT / 64;
constexpr int NTM = MT / 256;
constexpr float EPS = 1e-6f;
constexpr size_t OFF_Y = 0;
constexpr size_t OFF_PRET = (size_t)MT * DM;
constexpr size_t OFF_PK = OFF_PRET + (size_t)NB * 4 * 128 * 128;
constexpr size_t OFF_PV = OFF_PK + (size_t)NB * 128 * 128;
constexpr size_t OFF_PCONV = OFF_PV + (size_t)NB * 128 * 128;
constexpr size_t OFF_SRET = OFF_PCONV + (size_t)NB * 2 * DFF;
constexpr size_t OFF_SK = OFF_SRET + (size_t)NB * 4 * 128 * 128;
constexpr size_t OFF_SV = OFF_SK + (size_t)NB * 64 * 128;
constexpr size_t OFF_SCONV = OFF_SV + (size_t)NB * 64 * 128;
constexpr size_t OUT_TOTAL = OFF_SCONV + (size_t)NB * 2 * DFF;
constexpr size_t MiB = 1u << 20;
constexpr size_t WS_WIN = 0;
constexpr size_t WS_WUP = WS_WIN + (size_t)INW * DM * 2;
constexpr size_t WS_WOUT = WS_WUP + (size_t)2 * DFF * DM * 2;
constexpr size_t WS_WDN = WS_WOUT + (size_t)DM * DM * 2;
constexpr size_t WS_MODP = 24 * MiB;
constexpr size_t WS_MOD = 32 * MiB;
constexpr size_t WS_SHW = 34 * MiB;
constexpr size_t WS_SS1 = 36 * MiB;
constexpr size_t WS_SS2 = 41 * MiB;
constexpr size_t WS_R0 = 48 * MiB;
constexpr size_t WS_R1 = WS_R0 + 133 * MiB;
constexpr size_t WS_R2 = WS_R1 + 363 * MiB;
constexpr size_t HT_STRIDE = (size_t)NGRP * 2 * DFF;
constexpr size_t WS_END = WS_R2 + 363 * MiB;
constexpr size_t WS_SLAB = WS_R1 + 264 * MiB;
constexpr size_t WS_SLAB4 = WS_R1 + 300 * MiB;
constexpr size_t WS_X1B = WS_R1 + 128 * MiB;
static_assert(3 * HT_STRIDE * 4 <= 128 * MiB && WS_X1B + (size_t)MT * DM * 2 <= WS_R2, "ws map");
static_assert(WS_WDN + (size_t)DM * DFF * 2 <= WS_MODP, "ws map");
static_assert((size_t)(MT + 256) * DM * 2 <= 133 * MiB && (size_t)MT * DFF * 2 <= 363 * MiB, "ws map");

constexpr size_t WS_BAR = 46 * MiB;
constexpr size_t WS_TICKET = 46 * MiB + 32768;
constexpr size_t WS_CNT7 = 46 * MiB + 65536;
constexpr int LDS_MISC = 155648;
constexpr int LDS_BYTES = 155648 + 64;

#define LAS __attribute__((address_space(3)))
typedef unsigned short bf16;
typedef float f32x4 __attribute__((ext_vector_type(4)));
typedef float f32x2 __attribute__((ext_vector_type(2)));
typedef short bf16x8 __attribute__((ext_vector_type(8)));
typedef unsigned u32x4 __attribute__((ext_vector_type(4)));
typedef unsigned u32x2 __attribute__((ext_vector_type(2)));
typedef __bf16 bf16x2_t __attribute__((ext_vector_type(2)));
#define LDS_WAIT() asm volatile("s_waitcnt lgkmcnt(0)" ::: "memory")

__device__ __forceinline__ unsigned pk2(float lo, float hi) { f32x2 v = {lo, hi}; bf16x2_t b = __builtin_convertvector(v, bf16x2_t); return __builtin_bit_cast(unsigned, b); }
__device__ __forceinline__ float bflo(unsigned w) { return __uint_as_float(w << 16); }
__device__ __forceinline__ float bfhi(unsigned w) { return __uint_as_float(w & 0xffff0000u); }
__device__ __forceinline__ float wave_sum(float v) {
#pragma unroll
    for (int o = 1; o < 64; o <<= 1) v += __shfl_xor(v, o);
    return v;
}
__device__ __forceinline__ float wave_sum_dpp(float v) {
    v += __int_as_float(__builtin_amdgcn_update_dpp(__float_as_int(v), __float_as_int(v), 0x128, 0xf, 0xf, false));
    v += __int_as_float(__builtin_amdgcn_update_dpp(__float_as_int(v), __float_as_int(v), 0x124, 0xf, 0xf, false));
    v += __int_as_float(__builtin_amdgcn_update_dpp(__float_as_int(v), __float_as_int(v), 0x122, 0xf, 0xf, false));
    v += __int_as_float(__builtin_amdgcn_update_dpp(__float_as_int(v), __float_as_int(v), 0x121, 0xf, 0xf, false));
    const int i = __float_as_int(v);
    return (__int_as_float(__builtin_amdgcn_readlane(i, 0)) + __int_as_float(__builtin_amdgcn_readlane(i, 16))) + (__int_as_float(__builtin_amdgcn_readlane(i, 32)) + __int_as_float(__builtin_amdgcn_readlane(i, 48)));
}
__device__ __forceinline__ float silu_f(float x) { return x * __builtin_amdgcn_rcpf(1.0f + __builtin_amdgcn_exp2f(-1.4426950408889634f * x)); }
__device__ __forceinline__ void unpack8(const u32x4 w, float (&f)[8]) { f[0] = bflo(w.x); f[1] = bfhi(w.x); f[2] = bflo(w.y); f[3] = bfhi(w.y); f[4] = bflo(w.z); f[5] = bfhi(w.z); f[6] = bflo(w.w); f[7] = bfhi(w.w); }
__device__ __forceinline__ int grp_bs(int g) { return g < 1024 ? (g >> 5) : 32 + (g - 1024); }

struct Params {
    const float *x_p, *x_s, *cache_k, *cache_v, *state_ret, *state_conv, *c_p, *c_s, *ln1, *ln2, *w_ada, *b_ada, *w_in, *w_out, *sinks, *w_up, *conv_w, *conv_b, *w_down, *normf, *w_ada_f, *b_ada_f;
    float* out; unsigned char* ws;
};

__device__ __forceinline__ void transpose_item(const float* W, int K, int N, bf16* WT, int dst_row0, int k0, int n0, LAS float* scr, int lane) {
#pragma unroll 8
    for (int i = 0; i < 32; ++i) { const int kk = 2 * i + (lane >> 5); scr[kk * 33 + (lane & 31)] = W[(size_t)(k0 + kk) * N + n0 + (lane & 31)]; }
    LDS_WAIT(); asm volatile("" ::: "memory");
    const int c = lane & 7;
#pragma unroll
    for (int j = 0; j < 4; ++j) { const int n = (lane >> 3) + 8 * j; const LAS float* s = scr + (8 * c) * 33 + n;
        u32x4 o; o.x = pk2(s[0 * 33], s[1 * 33]); o.y = pk2(s[2 * 33], s[3 * 33]); o.z = pk2(s[4 * 33], s[5 * 33]); o.w = pk2(s[6 * 33], s[7 * 33]);
        *(u32x4*)(WT + (size_t)(dst_row0 + n) * K + k0 + 8 * c) = o; }
    LDS_WAIT(); asm volatile("" ::: "memory");
}
__device__ __forceinline__ void mod_item(const Params& P, int it, LAS float* scr, int lane) {
    const int ct = it >> 2, ks = it & 3, c0 = ct * 64;
    const float* W; const float* bias; int ldw;
    if (c0 < 6144) { W = P.w_ada + c0; bias = P.b_ada + c0; ldw = 6144; } else { W = P.w_ada_f + (c0 - 6144); bias = P.b_ada_f + (c0 - 6144); ldw = 2048; }
    float acc[64];
#pragma unroll
    for (int r = 0; r < 64; ++r) acc[r] = 0.f;
    const float* crow = (lane < 32 ? P.c_p + (size_t)lane * DM : P.c_s + (size_t)(lane - 32) * DM) + ks * 256;
    for (int kc = 0; kc < 8; ++kc) {
#pragma unroll
        for (int q = 0; q < 8; ++q) { f32x4 v = *(const f32x4*)(crow + kc * 32 + 4 * q);
            v.x = silu_f(v.x); v.y = silu_f(v.y); v.z = silu_f(v.z); v.w = silu_f(v.w);
            *(LAS f32x4*)(scr + lane * 36 + 4 * q) = v; }
        LDS_WAIT(); asm volatile("" ::: "memory");
        const float* wk = W + (size_t)(ks * 256 + kc * 32) * ldw + lane;
        for (int k4 = 0; k4 < 8; ++k4) {
            const float w0 = wk[(size_t)(4 * k4 + 0) * ldw], w1 = wk[(size_t)(4 * k4 + 1) * ldw], w2 = wk[(size_t)(4 * k4 + 2) * ldw], w3 = wk[(size_t)(4 * k4 + 3) * ldw];
#pragma unroll
            for (int r = 0; r < 64; ++r) { const f32x4 s = *(const LAS f32x4*)(scr + r * 36 + 4 * k4); acc[r] += (s.x * w0 + s.y * w1) + (s.z * w2 + s.w * w3); }
        }
        LDS_WAIT(); asm volatile("" ::: "memory");
    }
    float* dst = (float*)(P.ws + WS_MODP) + (size_t)ks * 64 * 8192 + c0 + lane;
    const float bv = (ks == 0) ? bias[lane] : 0.f;
#pragma unroll
    for (int r = 0; r < 64; ++r) dst[(size_t)r * 8192] = acc[r] + bv;
}
__device__ __forceinline__ void phase0(const Params& P, LAS unsigned char* lds, int wave, int lane) {
    LAS float* scr = (LAS float*)(lds + wave * 16384);
    const int gw = wave * gridDim.x + blockIdx.x, NGW = gridDim.x * 8;
    constexpr int I_MOD = 512, I_IN = 16 * 88, I_UP = 16 * 176, I_OUT = 16 * 32, I_DN = 44 * 32;
    constexpr int NIT = I_MOD + I_IN + I_UP + I_OUT + I_DN;
    for (int it = gw; it < NIT; it += NGW) {
        int r = it;
        if (r < I_MOD) { mod_item(P, r, scr, lane); continue; } r -= I_MOD;
        if (r < I_IN) { const int kb = r / 88, nb = r % 88; transpose_item(P.w_in, DM, INW, (bf16*)(P.ws + WS_WIN), nb * 32, kb * 64, nb * 32, scr, lane); continue; } r -= I_IN;
        if (r < I_UP) { const int kb = r / 176, nb = r % 176, n0 = nb * 32, isb = n0 >= DFF, j0 = n0 - isb * DFF;
            transpose_item(P.w_up, DM, 2 * DFF, (bf16*)(P.ws + WS_WUP), 256 * (j0 >> 7) + 128 * isb + (j0 & 127), kb * 64, n0, scr, lane); continue; } r -= I_UP;
        if (r < I_OUT) { const int kb = r / 32, nb = r % 32; transpose_item(P.w_out, DM, DM, (bf16*)(P.ws + WS_WOUT), nb * 32, kb * 64, nb * 32, scr, lane); continue; } r -= I_OUT;
        { const int kb = r / 32, nb = r % 32; transpose_item(P.w_down, DFF, DM, (bf16*)(P.ws + WS_WDN), nb * 32, kb * 64, nb * 32, scr, lane); }
    }
}

__device__ __forceinline__ void phase1(const Params& P, LAS unsigned char* lds, int tid, int wave, int lane) {
    const float* modp = (const float*)(P.ws + WS_MODP);
    float* mod = (float*)(P.ws + WS_MOD);
    bf16* H1 = (bf16*)(P.ws + WS_R0);
    for (int idx = blockIdx.x * 512 + tid; idx < 64 * 8192; idx += gridDim.x * 512) {
        const float s = (modp[idx] + modp[idx + 524288]) + (modp[idx + 2 * 524288] + modp[idx + 3 * 524288]);
        mod[idx] = s;
        const int col = idx & 8191, bs = idx >> 13;
        if (col >= 3072 && col < 4096) H1[(size_t)(MT + bs) * DM + (col - 3072)] = (bf16)(pk2(s, 0.f) & 0xffffu);
    }
    LAS float* lv = (LAS float*)lds;
    const int rpb = (MT + (int)gridDim.x - 1) / (int)gridDim.x, rbeg = (int)blockIdx.x * rpb, rend = (rbeg + rpb < MT) ? rbeg + rpb : MT;
    if (rbeg < rend) {
        const int bs0 = rbeg < MP ? (rbeg >> 11) : 32 + ((rbeg - MP) >> 6), bs1 = (rend - 1) < MP ? ((rend - 1) >> 11) : 32 + ((rend - 1 - MP) >> 6);
        const int nsl = bs1 - bs0 + 1;
        __syncthreads();
        for (int i = tid; i < nsl * 2048; i += 512) { const int sl = i >> 11, which = (i >> 10) & 1, col = i & 1023; const size_t o = (size_t)(bs0 + sl) * 8192 + which * 1024 + col;
            float sv = (modp[o] + modp[o + 524288]) + (modp[o + 2 * 524288] + modp[o + 3 * 524288]);
            if (which) sv = P.ln1[col] * (1.f + sv);
            lv[i] = sv; }
        __syncthreads();
#pragma unroll 2
        for (int row = rbeg + wave; row < rend; row += 8) {
            const int bs = row < MP ? (row >> 11) : 32 + ((row - MP) >> 6);
            const LAS float* lvs = lv + (bs - bs0) * 2048;
            const float* xr = (row < MP ? P.x_p + (size_t)row * DM : P.x_s + (size_t)(row - MP) * DM) + 4 * lane;
            f32x4 v[4]; float ss = 0.f;
#pragma unroll
            for (int j = 0; j < 4; ++j) { v[j] = *(const f32x4*)(xr + 256 * j); ss += (v[j].x * v[j].x + v[j].y * v[j].y) + (v[j].z * v[j].z + v[j].w * v[j].w); }
            const float rstd = rsqrtf(wave_sum(ss) * (1.f / DM) + EPS);
            bf16* hr = H1 + (size_t)row * DM + 4 * lane;
#pragma unroll
            for (int j = 0; j < 4; ++j) { const f32x4 sh = *(const LAS f32x4*)(lvs + 256 * j + 4 * lane), gs = *(const LAS f32x4*)(lvs + 1024 + 256 * j + 4 * lane);
                const f32x4 h = v[j] * rstd * gs + sh; u32x2 w; w.x = pk2(h.x, h.y); w.y = pk2(h.z, h.w); *(u32x2*)(hr + 256 * j) = w; }
        }
    }
}

struct OrderX {
    pg8::StaticOrder S; int nX, xpm, xpn0;
    __device__ __forceinline__ bool next(int i, pg8::Unit& u) const {
        const long L = (long)i * S.G + S.c;
        int pm = 0, pn = 0; bool ok = false;
        if (L < S.nwg) { pg8::Unit t; t.pm = 0; t.pn = 0; t.seq = 0; t.kt0 = 0; t.nt = 0; (void)S.next(i, t); pm = t.pm; pn = t.pn; ok = true; }
        else if (L < S.nwg + nX) { pm = xpm; pn = xpn0 + (int)(L - S.nwg); ok = true; }
        u.pm = pm; u.pn = pn; u.seq = i; u.kt0 = 0; u.nt = 0;
        return ok;
    }
    __device__ __forceinline__ void a_ready(const pg8::Unit&) const {}
    __device__ __forceinline__ void done(const pg8::Unit&) const {}
};
struct OrderPub : pg8::StaticOrder {
    unsigned* cnt;
    __device__ __forceinline__ void done(const pg8::Unit& u) const {
        asm volatile("s_waitcnt vmcnt(0)" ::: "memory");
        if ((threadIdx.x & 63) == 0) __hip_atomic_fetch_add(cnt + 64 * u.pm, 1u, __ATOMIC_RELAXED, __HIP_MEMORY_SCOPE_AGENT);
    }
};
struct OrderDown {
    pg8::StaticOrder S;
    int ka, kb;
    __device__ __forceinline__ bool next(int i, pg8::Unit& u) const {
        const long L = (long)i * S.G + S.c;
        int pm = 0, pn = 0, kt0 = 0, nt = 0; bool ok = false;
        if (L < S.nwg) { pg8::Unit t; t.pm = 0; t.pn = 0; t.seq = 0; t.kt0 = 0; t.nt = 0; (void)S.next(i, t); pm = t.pm; pn = t.pn; ok = true; }
        else if (L < S.nwg + 128) { const int q = (int)(L - S.nwg), tu = q >> 2, part = q & 3; pm = (MP / 256) + (tu & 7); pn = tu >> 3; kt0 = part < 2 ? ka * part : 2 * ka + kb * (part - 2); nt = part < 2 ? ka : kb; ok = true; }
        u.pm = pm; u.pn = pn; u.seq = i; u.kt0 = kt0; u.nt = nt;
        return ok;
    }
    __device__ __forceinline__ void a_ready(const pg8::Unit&) const {}
    __device__ __forceinline__ void done(const pg8::Unit&) const {}
};
typedef const f32x4 (&AccRef)[2][2][4][2];
struct Epi1 {
    static constexpr bool PERM = true, AFTER_DRAIN = false;
    bf16* proj; float* shw; float* out;
    __device__ __forceinline__ void operator()(AccRef acc, const pg8::Unit& u, int wr, int wc, int fr, int fq) const {
        if (u.pm == NTM) {
            if (wr == 0) {
#pragma unroll
                for (int m = 0; m < 4; ++m) { float* d = shw + (size_t)(16 * m + fr) * (2 * DFF) + 256 * (u.pn - 11) + 32 * wc + 8 * fq;
#pragma unroll
                    for (int bj = 0; bj < 2; ++bj)
#pragma unroll
                        for (int n = 0; n < 2; ++n) *(f32x4*)(d + 128 * bj + 4 * n) = acc[0][bj][m][n]; }
            }
            return;
        }
        const unsigned row0 = u.pm * 256 + wr * 64 + fr, col0 = u.pn * 256 + wc * 32 + 8 * fq;
#pragma unroll
        for (int ai = 0; ai < 2; ++ai)
#pragma unroll
            for (int m = 0; m < 4; ++m) { const unsigned o = (row0 + 128 * ai + 16 * m) * (unsigned)INW + col0;
#pragma unroll
                for (int bj = 0; bj < 2; ++bj) { const f32x4 v0 = acc[ai][bj][m][0], v1 = acc[ai][bj][m][1];
                    u32x4 w; w.x = pk2(v0[0], v0[1]); w.y = pk2(v0[2], v0[3]); w.z = pk2(v1[0], v1[1]); w.w = pk2(v1[2], v1[3]);
                    *(u32x4*)(proj + (o + 128 * bj)) = w; }
                asm volatile("" ::: "memory"); }
        if (u.pn == 10) {
            const unsigned c = 32 * wc + 8 * fq;
#pragma unroll
            for (int ai = 0; ai < 2; ++ai)
#pragma unroll
                for (int m = 0; m < 4; ++m) { const unsigned row = row0 + 128 * ai + 16 * m; unsigned ok, ov;
                    if (row < (unsigned)MP) { const unsigned t = row & 2047; if (t < SEQ - 128) continue; const unsigned o = ((row >> 11) * 128 + (t - (SEQ - 128))) * 128 + c; ok = (unsigned)OFF_PK + o; ov = (unsigned)OFF_PV + o; }
                    else { const unsigned o = (row - MP) * 128 + c; ok = (unsigned)OFF_SK + o; ov = (unsigned)OFF_SV + o; }
                    *(f32x4*)(out + ok) = acc[ai][0][m][0]; *(f32x4*)(out + ok + 4) = acc[ai][0][m][1];
                    *(f32x4*)(out + ov) = acc[ai][1][m][0]; *(f32x4*)(out + ov + 4) = acc[ai][1][m][1];
                    asm volatile("" ::: "memory"); }
        }
    }
};
struct Epi2 {
    static constexpr bool PERM = true, AFTER_DRAIN = false;
    const float *xp, *xs, *mod, *ln2; bf16* x1; bf16* a2; float* ss; float* slab;
    __device__ __forceinline__ void operator()(AccRef acc, const pg8::Unit& u, int wr, int wc, int fr, int fq) const {
        const int col0 = u.pn * 256 + wc * 32 + 8 * fq;
        if (u.nt != 0) {
            float* sb = slab + (size_t)(u.kt0 >> 2) * MS * DM;
#pragma unroll
            for (int ai = 0; ai < 2; ++ai)
#pragma unroll
                for (int m = 0; m < 4; ++m) { const unsigned ro = (unsigned)(u.pm * 256 - MP + 128 * ai + 64 * wr + 16 * m + fr) * DM + col0;
#pragma unroll
                    for (int bj = 0; bj < 2; ++bj) { *(f32x4*)(sb + ro + 128 * bj) = acc[ai][bj][m][0]; *(f32x4*)(sb + ro + 128 * bj + 4) = acc[ai][bj][m][1]; } }
            return;
        }
#pragma unroll
        for (int ai = 0; ai < 2; ++ai) {
            const int bs = grp_bs(4 * u.pm + 2 * ai + wr);
            const float* mb = mod + (size_t)bs * 8192;
            f32x4 g1v[2][2], gsv[2][2];
#pragma unroll
            for (int bj = 0; bj < 2; ++bj)
#pragma unroll
                for (int n = 0; n < 2; ++n) { const int c = col0 + 128 * bj + 4 * n; g1v[bj][n] = *(const f32x4*)(mb + 2048 + c);
                    gsv[bj][n] = *(const f32x4*)(ln2 + c) * (*(const f32x4*)(mb + 4096 + c) + 1.0f); }
#pragma unroll
            for (int m = 0; m < 4; ++m) {
                const int row = u.pm * 256 + 128 * ai + 64 * wr + 16 * m + fr;
                const float* xr = row < MP ? xp + (size_t)row * DM : xs + (size_t)(row - MP) * DM;
                float s = 0.f;
#pragma unroll
                for (int bj = 0; bj < 2; ++bj) { f32x4 a[2]; f32x4 xb[2];
#pragma unroll
                    for (int n = 0; n < 2; ++n) { const int c = col0 + 128 * bj + 4 * n; const f32x4 xv = *(const f32x4*)(xr + c); const f32x4 v = xv + g1v[bj][n] * acc[ai][bj][m][n];
                        xb[n] = v; s += (v.x * v.x + v.y * v.y) + (v.z * v.z + v.w * v.w); a[n] = v * gsv[bj][n]; }
                    u32x4 w; w.x = pk2(a[0].x, a[0].y); w.y = pk2(a[0].z, a[0].w); w.z = pk2(a[1].x, a[1].y); w.w = pk2(a[1].z, a[1].w);
                    *(u32x4*)(a2 + (size_t)row * DM + col0 + 128 * bj) = w;
                    w.x = pk2(xb[0].x, xb[0].y); w.y = pk2(xb[0].z, xb[0].w); w.z = pk2(xb[1].x, xb[1].y); w.w = pk2(xb[1].z, xb[1].w);
                    *(u32x4*)(x1 + (size_t)row * DM + col0 + 128 * bj) = w; }
                s += __shfl_xor(s, 16); s += __shfl_xor(s, 32);
                if (fq == 0) ss[(size_t)row * 16 + 4 * u.pn + wc] = s;
            }
        }
    }
};
struct Epi3 {
    static constexpr bool PERM = true, AFTER_DRAIN = false;
    const LAS float* rtab; const float* shw; bf16 *ua, *ub; float* out;
    __device__ __forceinline__ void operator()(AccRef acc, const pg8::Unit& u, int wr, int wc, int fr, int fq) const {
        const unsigned j0 = u.pn * 128 + wc * 32 + 8 * fq, pc0 = u.pn * 256 + wc * 32 + 8 * fq;
#pragma unroll
        for (int ai = 0; ai < 2; ++ai) {
            const unsigned grp = 4 * u.pm + 2 * ai + wr, bs = grp_bs((int)grp);
            const unsigned so = bs * (2 * DFF) + pc0;
            const f32x4 sa0 = *(const f32x4*)(shw + so), sa1 = *(const f32x4*)(shw + so + 4), sb0 = *(const f32x4*)(shw + so + 128), sb1 = *(const f32x4*)(shw + so + 132);
#pragma unroll
            for (int m = 0; m < 4; ++m) {
                const float rstd = rtab[u.seq * 256 + 128 * ai + 64 * wr + 16 * m + fr];
                const unsigned row = grp * 64 + 16 * m + fr;
                const f32x4 a0 = acc[ai][0][m][0] * rstd + sa0, a1 = acc[ai][0][m][1] * rstd + sa1, b0 = acc[ai][1][m][0] * rstd + sb0, b1 = acc[ai][1][m][1] * rstd + sb1;
                u32x4 w; w.x = pk2(a0[0], a0[1]); w.y = pk2(a0[2], a0[3]); w.z = pk2(a1[0], a1[1]); w.w = pk2(a1[2], a1[3]);
                *(u32x4*)(ua + (row * (unsigned)DFF + j0)) = w;
                w.x = pk2(b0[0], b0[1]); w.y = pk2(b0[2], b0[3]); w.z = pk2(b1[0], b1[1]); w.w = pk2(b1[2], b1[3]);
                *(u32x4*)(ub + (row * (unsigned)DFF + j0)) = w;
                if (m == 3 && fr >= 14) {
                    if (grp >= 1024) { float* d = out + OFF_SCONV + ((size_t)(grp - 1024) * 2 + (fr - 14)) * DFF + j0; *(f32x4*)d = a0; *(f32x4*)(d + 4) = a1; }
                    else if ((grp & 31) == 31) { float* d = out + OFF_PCONV + ((size_t)(grp >> 5) * 2 + (fr - 14)) * DFF + j0; *(f32x4*)d = a0; *(f32x4*)(d + 4) = a1; }
                }
            }
        }
    }
};
#ifdef CONV_FUSED
struct Epi3C {
    static constexpr bool PERM = true, AFTER_DRAIN = false;
    const LAS float* rtab; const float *shw, *cw, *cb; bf16* act; float *headA, *headB, *tailA;
    __device__ __forceinline__ void operator()(AccRef acc, const pg8::Unit& u, int wr, int wc, int fr, int fq) const {
        const unsigned j0 = u.pn * 128 + wc * 32 + 8 * fq, pc0 = u.pn * 256 + wc * 32 + 8 * fq;
        f32x4 w0[2], w1[2], w2[2], cbv[2];
#pragma unroll
        for (int n = 0; n < 2; ++n) { w0[n] = *(const f32x4*)(cw + j0 + 4 * n); w1[n] = *(const f32x4*)(cw + DFF + j0 + 4 * n); w2[n] = *(const f32x4*)(cw + 2 * DFF + j0 + 4 * n); cbv[n] = *(const f32x4*)(cb + j0 + 4 * n); }
#pragma unroll
        for (int ai = 0; ai < 2; ++ai) {
            asm volatile("" ::: "memory");
            const unsigned grp = 4 * u.pm + 2 * ai + wr, bs = grp_bs((int)grp);
            const unsigned so = bs * (2 * DFF) + pc0, ho = (grp * 2 + (fr & 1)) * DFF + j0;
            u32x2 ap[4][2], bp[4][2];
            {
                f32x4 sa[2], sb[2];
#pragma unroll
                for (int n = 0; n < 2; ++n) { sa[n] = *(const f32x4*)(shw + so + 4 * n); sb[n] = *(const f32x4*)(shw + so + 128 + 4 * n); }
#pragma unroll
                for (int m = 0; m < 4; ++m) {
                    const float rs = rtab[u.seq * 256 + 128 * ai + 64 * wr + 16 * m + fr];
#pragma unroll
                    for (int n = 0; n < 2; ++n) {
                        const f32x4 av = acc[ai][0][m][n] * rs + sa[n], bv = acc[ai][1][m][n] * rs + sb[n];
                        if (m == 0) { if (fr < 2) { *(f32x4*)(headA + ho + 4 * n) = av; *(f32x4*)(headB + ho + 4 * n) = bv; } }
                        if (m == 3) { if (fr >= 14) *(f32x4*)(tailA + ho + 4 * n) = av; }
                        ap[m][n].x = pk2(av.x, av.y); ap[m][n].y = pk2(av.z, av.w); bp[m][n].x = pk2(bv.x, bv.y); bp[m][n].y = pk2(bv.z, bv.w);
                    }
                }
            }
            asm volatile("" ::: "memory");
#pragma unroll
            for (int n = 0; n < 2; ++n)
#pragma unroll
                for (int h = 0; h < 2; ++h) {
                    unsigned q1 = 0u, q2 = 0u;
#pragma unroll
                    for (int m = 0; m < 4; ++m) {
                        const unsigned a = ap[m][n][h];
                        const unsigned s1 = (unsigned)__builtin_amdgcn_update_dpp((int)a, (int)a, 0x121, 0xf, 0xf, false);
                        const unsigned s2 = (unsigned)__builtin_amdgcn_update_dpp((int)a, (int)a, 0x122, 0xf, 0xf, false);
                        const unsigned pr1 = fr >= 1 ? s1 : q1, pr2 = fr >= 2 ? s2 : q2;
                        q1 = s1; q2 = s2;
                        const float c0 = cbv[n][2 * h] + w0[n][2 * h] * bflo(pr2) + w1[n][2 * h] * bflo(pr1) + w2[n][2 * h] * bflo(a);
                        const float c1 = cbv[n][2 * h + 1] + w0[n][2 * h + 1] * bfhi(pr2) + w1[n][2 * h + 1] * bfhi(pr1) + w2[n][2 * h + 1] * bfhi(a);
                        const unsigned bw = bp[m][n][h];
                        bp[m][n][h] = pk2(silu_f(c0) * bflo(bw), silu_f(c1) * bfhi(bw));
                    }
                    __builtin_amdgcn_sched_barrier(0);
                }
            asm volatile("" ::: "memory");
#pragma unroll
            for (int m = 0; m < 4; ++m) {
                if (m == 0 && fr < 2) continue;
                const unsigned row = grp * 64 + 16 * m + fr;
                const u32x4 w = (u32x4){bp[m][0].x, bp[m][0].y, bp[m][1].x, bp[m][1].y};
                *(u32x4*)(act + (row * (unsigned)DFF + j0)) = w;
            }
        }
    }
};
#endif
struct Epi4 {
    static constexpr bool PERM = true, AFTER_DRAIN = false;
    const float* mod; const bf16* x1; bf16* x2; float* slab;
    __device__ __forceinline__ void operator()(AccRef acc, const pg8::Unit& u, int wr, int wc, int fr, int fq) const {
        const int col0 = u.pn * 256 + wc * 32 + 8 * fq;
        if (u.nt != 0) {
            const int part = u.kt0 == 0 ? 0 : (u.kt0 == 12 ? 1 : (u.kt0 == 24 ? 2 : 3));
            float* sb = slab + (size_t)part * MS * DM;
#pragma unroll
            for (int ai = 0; ai < 2; ++ai)
#pragma unroll
                for (int m = 0; m < 4; ++m) { const unsigned ro = (unsigned)(u.pm * 256 - MP + 128 * ai + 64 * wr + 16 * m + fr) * DM + col0;
#pragma unroll
                    for (int bj = 0; bj < 2; ++bj) { *(f32x4*)(sb + ro + 128 * bj) = acc[ai][bj][m][0]; *(f32x4*)(sb + ro + 128 * bj + 4) = acc[ai][bj][m][1]; } }
            return;
        }
#pragma unroll
        for (int ai = 0; ai < 2; ++ai) {
            const int bs = grp_bs(4 * u.pm + 2 * ai + wr);
            const float* mb = mod + (size_t)bs * 8192 + 5120;
            f32x4 g2v[2][2];
#pragma unroll
            for (int bj = 0; bj < 2; ++bj)
#pragma unroll
                for (int n = 0; n < 2; ++n) g2v[bj][n] = *(const f32x4*)(mb + col0 + 128 * bj + 4 * n);
#pragma unroll
            for (int m = 0; m < 4; ++m) {
                const unsigned ro = (unsigned)(u.pm * 256 + 128 * ai + 64 * wr + 16 * m + fr) * DM + col0;
#pragma unroll
                for (int bj = 0; bj < 2; ++bj) { const u32x4 xw = *(const u32x4*)(x1 + ro + 128 * bj);
                    const f32x4 v0 = (f32x4){bflo(xw.x), bfhi(xw.x), bflo(xw.y), bfhi(xw.y)} + g2v[bj][0] * acc[ai][bj][m][0];
                    const f32x4 v1 = (f32x4){bflo(xw.z), bfhi(xw.z), bflo(xw.w), bfhi(xw.w)} + g2v[bj][1] * acc[ai][bj][m][1];
                    u32x4 w; w.x = pk2(v0.x, v0.y); w.y = pk2(v0.z, v0.w); w.z = pk2(v1.x, v1.y); w.w = pk2(v1.z, v1.w);
                    *(u32x4*)(x2 + ro + 128 * bj) = w; }
            }
        }
    }
};
#define GAS __attribute__((address_space(1)))
#define RLX_AGENT __ATOMIC_RELAXED, __HIP_MEMORY_SCOPE_AGENT
#define XB_TMO      128
#define XB_XCNT(j)  (256  + 64 * (j))
#define XB_XSUB(j)  (1280 + 64 * (j))
#define XB_XGEN(j)  (2304 + 64 * (j))
#define XB_TOP      3328
#define XB_TOPGEN   3392
#define XCD_BAR_WORDS 3456
#define XB_SPIN_CAP (1u << 18)

__device__ __forceinline__ unsigned xb_ld(unsigned* p)              { return __hip_atomic_load(p, __ATOMIC_RELAXED, __HIP_MEMORY_SCOPE_AGENT); }
__device__ __forceinline__ unsigned xb_add(unsigned* p, unsigned v) { return __hip_atomic_fetch_add(p, v, __ATOMIC_RELAXED, __HIP_MEMORY_SCOPE_AGENT); }
__device__ __forceinline__ unsigned xb_xcc_id() { return (unsigned)__builtin_amdgcn_s_getreg((3 << 11) | 20) & 0xFu; }
#define XB_SPIN(cond, bar) do { unsigned _sp = 0; while (cond) { __builtin_amdgcn_s_sleep(1); \
    if ((++_sp & 255u) == 0u) { if (xb_ld(&(bar)[XB_TMO])) break; if (_sp > XB_SPIN_CAP) { atomicAdd(&(bar)[XB_TMO], 1u); break; } } } } while (0)

struct XcdBarrier {
    unsigned* bar; unsigned x;
    volatile LAS unsigned* st;
};

__device__ __forceinline__ XcdBarrier xcd_barrier_post(unsigned* bar, volatile LAS unsigned* st) {
    XcdBarrier b; b.bar = bar; b.x = xb_xcc_id(); b.st = st;
    if (threadIdx.x == 0) (void)xb_add(&bar[XB_XCNT(b.x)], 1u);
    return b;
}
__device__ __forceinline__ void xcd_barrier_complete(unsigned* bar, unsigned x, unsigned& nloc, unsigned& nx) {
    const unsigned G = gridDim.x * gridDim.y * gridDim.z;
    unsigned sum, cnt, mine, sp = 0u;
    for (;;) {
        sum = 0u; cnt = 0u; mine = 0u;
#pragma unroll
        for (unsigned j = 0; j < 16; ++j) { const unsigned c = xb_ld(&bar[XB_XCNT(j)]); sum += c; cnt += (c > 0u) ? 1u : 0u; mine = (j == x) ? c : mine; }
        if (sum == G) break;
        __builtin_amdgcn_s_sleep(1);
        if ((++sp & 255u) == 0u) { if (xb_ld(&bar[XB_TMO])) break; if (sp > XB_SPIN_CAP) { atomicAdd(&bar[XB_TMO], 1u); break; } }
    }
    nloc = mine > 0u ? mine : 1u; nx = cnt > 0u ? cnt : 1u;
}

__device__ __forceinline__ void xcd_barrier(const XcdBarrier& b) {
    asm volatile("s_waitcnt vmcnt(0)" ::: "memory");
    __syncthreads();
    if (threadIdx.x == 0) {
        unsigned* bar = b.bar;
        __builtin_amdgcn_s_waitcnt(0);
        unsigned nloc = b.st[0], nx = b.st[1];
        if (nloc == 0u) { xcd_barrier_complete(bar, b.x, nloc, nx); b.st[0] = nloc; b.st[1] = nx; }
        const unsigned old = xb_add(&bar[XB_XSUB(b.x)], 1u);
        const unsigned gen = old / nloc;
        if (old + 1u == (gen + 1u) * nloc) {
            __builtin_amdgcn_fence(__ATOMIC_RELEASE, "agent");
            asm volatile("s_waitcnt vmcnt(0)" ::: "memory");
            const unsigned og = xb_add(&bar[XB_TOP], 1u);
            const unsigned tg = og / nx;
            if (og + 1u == (tg + 1u) * nx) xb_add(&bar[XB_TOPGEN], 1u);
            else XB_SPIN(xb_ld(&bar[XB_TOPGEN]) == tg, bar);
            __builtin_amdgcn_fence(__ATOMIC_ACQUIRE, "agent");
            xb_add(&bar[XB_XGEN(b.x)], 1u);
            asm volatile("s_waitcnt vmcnt(0)" ::: "memory");
        } else {
            XB_SPIN(xb_ld(&bar[XB_XGEN(b.x)]) == gen, bar);
            __builtin_amdgcn_fence(__ATOMIC_ACQUIRE, "agent");
            asm volatile("s_waitcnt vmcnt(0)" ::: "memory");
        }
    }
    __syncthreads();
}
#define MFMA16(a, b, c) __builtin_amdgcn_mfma_f32_16x16x32_bf16((a), (b), (c), 0, 0, 0)
constexpr int RQ = 0, RK = 17408, RKT = 34816, RVT = 53248, RP = 71680, RST = 80896, RO = 115712;
__device__ __forceinline__ void ret_item(const Params& P, LAS unsigned char* lds, int tid, int wave, int lane, int h, int row0, int nchunks, const float* st_in, bool has_in, float* st_out) {
    const bf16* proj = (const bf16*)(P.ws + WS_R1);
    bf16* mix = (bf16*)(P.ws + WS_R2);
    const int fr = lane & 15, fq = lane >> 4;
    const float lg2 = log2f(1.0f - exp2f(-5.0f - (float)h));
    const float kscale = 0.08838834764831845f;
    LAS bf16* Qs = (LAS bf16*)(lds + RQ); LAS bf16* Ks = (LAS bf16*)(lds + RK); LAS bf16* KT = (LAS bf16*)(lds + RKT); LAS bf16* VT = (LAS bf16*)(lds + RVT);
    LAS bf16* Ps = (LAS bf16*)(lds + RP); LAS bf16* ST = (LAS bf16*)(lds + RST); LAS float* Os = (LAS float*)(lds + RO);
    f32x4 st[8];
#pragma unroll
    for (int et = 0; et < 8; ++et) {
        f32x4 v;
#pragma unroll
        for (int r = 0; r < 4; ++r) v[r] = st_in[(size_t)(16 * wave + 4 * fq + r) * 128 + 16 * et + fr];
        asm volatile("" : "+v"(v));
#pragma unroll
        for (int r = 0; r < 4; ++r) v[r] = has_in ? v[r] : 0.f;
        st[et] = v;
    }
    __syncthreads();
#pragma unroll
    for (int et = 0; et < 8; ++et) { u32x2 w; w.x = pk2(st[et][0], st[et][1]); w.y = pk2(st[et][2], st[et][3]); *(LAS u32x2*)(ST + (16 * et + fr) * 136 + 16 * wave + 4 * fq) = w; }
    const size_t goff = (size_t)lane * INW + h * 128 + wave * 16;
    u32x4 pq[2], pk[2], pv[2];
    { const bf16* g = proj + (size_t)row0 * INW + goff;
      pq[0] = *(const u32x4*)(g); pq[1] = *(const u32x4*)(g + 8); pk[0] = *(const u32x4*)(g + 512); pk[1] = *(const u32x4*)(g + 520); pv[0] = *(const u32x4*)(g + 1024); pv[1] = *(const u32x4*)(g + 1032); }
    const float kf = kscale * exp2f(lg2 * (float)(63 - lane));
    const float g64 = exp2f(lg2 * 64.0f);
    for (int c = 0; c < nchunks; ++c) {
        const int rowc = row0 + 64 * c;
        *(LAS u32x4*)(Qs + lane * 136 + wave * 16) = pq[0]; *(LAS u32x4*)(Qs + lane * 136 + wave * 16 + 8) = pq[1];
        *(LAS u32x4*)(Ks + lane * 136 + wave * 16) = pk[0]; *(LAS u32x4*)(Ks + lane * 136 + wave * 16 + 8) = pk[1];
#pragma unroll
        for (int i = 0; i < 2; ++i)
#pragma unroll
            for (int j = 0; j < 4; ++j) { const unsigned wk = pk[i][j], wv = pv[i][j]; const int d = wave * 16 + i * 8 + j * 2;
                const unsigned kk = pk2(bflo(wk) * kf, bfhi(wk) * kf);
                KT[(d) * 72 + lane] = (bf16)(kk & 0xffffu); KT[(d + 1) * 72 + lane] = (bf16)(kk >> 16);
                VT[(d) * 72 + lane] = (bf16)(wv & 0xffffu); VT[(d + 1) * 72 + lane] = (bf16)(wv >> 16); }
        if (c + 1 < nchunks) { const bf16* g = proj + (size_t)(rowc + 64) * INW + goff;
            pq[0] = *(const u32x4*)(g); pq[1] = *(const u32x4*)(g + 8); pk[0] = *(const u32x4*)(g + 512); pk[1] = *(const u32x4*)(g + 520); pv[0] = *(const u32x4*)(g + 1024); pv[1] = *(const u32x4*)(g + 1032); }
        __syncthreads();
        { const int mi = wave >> 1;
#pragma unroll
          for (int jj = 0; jj < 2; ++jj) { const int lj = 2 * (wave & 1) + jj; f32x4 s = (f32x4){0.f, 0.f, 0.f, 0.f};
#pragma unroll
            for (int ks = 0; ks < 4; ++ks) { const bf16x8 a = *(const LAS bf16x8*)(Ks + (16 * mi + fr) * 136 + 32 * ks + 8 * fq), b = *(const LAS bf16x8*)(Qs + (16 * lj + fr) * 136 + 32 * ks + 8 * fq); s = MFMA16(a, b, s); }
            const int l = 16 * lj + fr; float pvv[4];
#pragma unroll
            for (int r = 0; r < 4; ++r) { const int m = 16 * mi + 4 * fq + r; const int dlt = l - m; pvv[r] = dlt >= 0 ? s[r] * kscale * exp2f(lg2 * (float)dlt) : 0.f; }
            u32x2 w; w.x = pk2(pvv[0], pvv[1]); w.y = pk2(pvv[2], pvv[3]); *(LAS u32x2*)(Ps + l * 72 + 16 * mi + 4 * fq) = w; } }
#pragma unroll
        for (int et = 0; et < 8; ++et) st[et] = st[et] * g64;
#pragma unroll
        for (int ks = 0; ks < 2; ++ks) { const bf16x8 a = *(const LAS bf16x8*)(KT + (16 * wave + fr) * 72 + 32 * ks + 8 * fq);
#pragma unroll
            for (int et = 0; et < 8; ++et) { const bf16x8 b = *(const LAS bf16x8*)(VT + (16 * et + fr) * 72 + 32 * ks + 8 * fq); st[et] = MFMA16(a, b, st[et]); } }
        __syncthreads();
        { f32x4 oi[4], oc[4];
#pragma unroll
          for (int lt = 0; lt < 4; ++lt) { oi[lt] = (f32x4){0.f, 0.f, 0.f, 0.f}; oc[lt] = (f32x4){0.f, 0.f, 0.f, 0.f}; }
#pragma unroll
          for (int ks = 0; ks < 2; ++ks) { const bf16x8 b = *(const LAS bf16x8*)(VT + (16 * wave + fr) * 72 + 32 * ks + 8 * fq);
#pragma unroll
            for (int lt = 0; lt < 4; ++lt) { const bf16x8 a = *(const LAS bf16x8*)(Ps + (16 * lt + fr) * 72 + 32 * ks + 8 * fq); oi[lt] = MFMA16(a, b, oi[lt]); } }
#pragma unroll
          for (int ks = 0; ks < 4; ++ks) { const bf16x8 b = *(const LAS bf16x8*)(ST + (16 * wave + fr) * 136 + 32 * ks + 8 * fq);
#pragma unroll
            for (int lt = 0; lt < 4; ++lt) { const bf16x8 a = *(const LAS bf16x8*)(Qs + (16 * lt + fr) * 136 + 32 * ks + 8 * fq); oc[lt] = MFMA16(a, b, oc[lt]); } }
#pragma unroll
          for (int lt = 0; lt < 4; ++lt)
#pragma unroll
            for (int r = 0; r < 4; ++r) { const int l = 16 * lt + 4 * fq + r; Os[l * 132 + 16 * wave + fr] = oi[lt][r] + exp2f(lg2 * (float)(l + 1)) * oc[lt][r]; } }
        __syncthreads();
#pragma unroll
        for (int et = 0; et < 8; ++et) { u32x2 w; w.x = pk2(st[et][0], st[et][1]); w.y = pk2(st[et][2], st[et][3]); *(LAS u32x2*)(ST + (16 * et + fr) * 136 + 16 * wave + 4 * fq) = w; }
        { unsigned gv[8];
#pragma unroll
          for (int i = 0; i < 8; ++i) gv[i] = *(const unsigned*)(proj + (size_t)(rowc + 8 * wave + i) * INW + 1536 + h * 128 + 2 * lane);
#pragma unroll
          for (int i = 0; i < 8; ++i) { const int l = 8 * wave + i; const f32x2 o = *(const LAS f32x2*)(Os + l * 132 + 2 * lane);
            const float ssq = wave_sum_dpp(o.x * o.x + o.y * o.y); const float rstd = rsqrtf(ssq * (1.f / 128.f) + EPS);
            const float g0 = bflo(gv[i]), g1 = bfhi(gv[i]);
            *(unsigned*)(mix + (size_t)(rowc + l) * DM + h * 128 + 2 * lane) = pk2(silu_f(g0) * o.x * rstd, silu_f(g1) * o.y * rstd); } }
    }
#pragma unroll
    for (int et = 0; et < 8; ++et)
#pragma unroll
        for (int r = 0; r < 4; ++r) st_out[(size_t)(16 * wave + 4 * fq + r) * 128 + 16 * et + fr] = st[et][r];
}
constexpr int AK = 0, AVT = 27648;
__device__ __forceinline__ void att_item(const Params& P, LAS unsigned char* lds, int tid, int wave, int lane, bool sample, int b, int n, int g) {
    const bf16* proj = (const bf16*)(P.ws + WS_R1);
    bf16* mix = (bf16*)(P.ws + WS_R2);
    const int fr = lane & 15, fq = lane >> 4;
    LAS bf16* Kl = (LAS bf16*)(lds + AK); LAS bf16* VTl = (LAS bf16*)(lds + AVT);
    const int qrow0 = sample ? MP + 64 * b : b * SEQ + 64 * n;
    const int jmin = sample ? 0 : (n >= 2 ? 0 : 64 * (2 - n));
    __syncthreads();
    {
        u32x4 kw[3], vw[3];
        if (!sample) {
#pragma unroll
            for (int i = 0; i < 3; ++i) { const bool ok = 64 * i >= jmin;
                const int rb = ok ? b * SEQ + 64 * (n - 2) + 64 * i : qrow0;
                kw[i] = *(const u32x4*)(proj + (size_t)(rb + (tid >> 3)) * INW + 2560 + g * 64 + 8 * (tid & 7));
                vw[i] = *(const u32x4*)(proj + (size_t)(rb + lane) * INW + 2688 + g * 64 + 8 * wave);
                if (!ok) { kw[i] = (u32x4){0u, 0u, 0u, 0u}; vw[i] = (u32x4){0u, 0u, 0u, 0u}; } }
        } else {
            f32x4 kc[2][2], vc[2][2];
#pragma unroll
            for (int i = 0; i < 2; ++i) { const float* sk = P.cache_k + ((size_t)(b * 128 + 64 * i + (tid >> 3)) * 2 + g) * 64 + 8 * (tid & 7); const float* sv = P.cache_v + ((size_t)(b * 128 + 64 * i + lane) * 2 + g) * 64 + 8 * wave;
                kc[i][0] = *(const f32x4*)sk; kc[i][1] = *(const f32x4*)(sk + 4); vc[i][0] = *(const f32x4*)sv; vc[i][1] = *(const f32x4*)(sv + 4); }
            kw[2] = *(const u32x4*)(proj + (size_t)(MP + 64 * b + (tid >> 3)) * INW + 2560 + g * 64 + 8 * (tid & 7));
            vw[2] = *(const u32x4*)(proj + (size_t)(MP + 64 * b + lane) * INW + 2688 + g * 64 + 8 * wave);
#pragma unroll
            for (int i = 0; i < 2; ++i) { kw[i].x = pk2(kc[i][0].x, kc[i][0].y); kw[i].y = pk2(kc[i][0].z, kc[i][0].w); kw[i].z = pk2(kc[i][1].x, kc[i][1].y); kw[i].w = pk2(kc[i][1].z, kc[i][1].w);
                vw[i].x = pk2(vc[i][0].x, vc[i][0].y); vw[i].y = pk2(vc[i][0].z, vc[i][0].w); vw[i].z = pk2(vc[i][1].x, vc[i][1].y); vw[i].w = pk2(vc[i][1].z, vc[i][1].w); }
        }
#pragma unroll
        for (int i = 0; i < 3; ++i) { *(LAS u32x4*)(Kl + (64 * i + (tid >> 3)) * 72 + 8 * (tid & 7)) = kw[i];
            const int j = 64 * i + lane;
#pragma unroll
            for (int e = 0; e < 4; ++e) { VTl[(8 * wave + 2 * e) * 200 + j] = (bf16)(vw[i][e] & 0xffffu); VTl[(8 * wave + 2 * e + 1) * 200 + j] = (bf16)(vw[i][e] >> 16); } }
    }
    const int r = wave >> 1, qh = wave & 1, head = 4 * g + r;
    const float slope = exp2f(-(float)(head + 1));
    const float sink = P.sinks[head];
    const float L2E = 1.4426950408889634f;
    __syncthreads();
#pragma unroll 1
    for (int qt = 0; qt < 2; ++qt) {
        asm volatile("" ::: "memory");
        const int qi = 32 * qh + 16 * qt + fr;
        bf16x8 qf[2];
#pragma unroll
        for (int ks = 0; ks < 2; ++ks) qf[ks] = *(const bf16x8*)(proj + (size_t)(qrow0 + qi) * INW + 2048 + head * 64 + 32 * ks + 8 * fq);
        f32x4 s[12];
#pragma unroll
        for (int kt = 0; kt < 12; ++kt) { s[kt] = (f32x4){0.f, 0.f, 0.f, 0.f};
#pragma unroll
            for (int ks = 0; ks < 2; ++ks) { const bf16x8 a = *(const LAS bf16x8*)(Kl + (16 * kt + fr) * 72 + 32 * ks + 8 * fq); s[kt] = MFMA16(a, qf[ks], s[kt]); } }
        float mx = sink;
#pragma unroll
        for (int kt = 0; kt < 12; ++kt)
#pragma unroll
            for (int rr = 0; rr < 4; ++rr) { const int j = 16 * kt + 4 * fq + rr; const int dist = 128 + qi - j;
                float v = s[kt][rr] * 0.125f - slope * fabsf((float)dist);
                v = j >= jmin ? v : -INFINITY; s[kt][rr] = v; mx = fmaxf(mx, v); }
        mx = fmaxf(mx, __shfl_xor(mx, 16)); mx = fmaxf(mx, __shfl_xor(mx, 32));
        float ls = 0.f;
#pragma unroll
        for (int kt = 0; kt < 12; ++kt)
#pragma unroll
            for (int rr = 0; rr < 4; ++rr) { const float p = exp2f((s[kt][rr] - mx) * L2E); s[kt][rr] = p; ls += p; }
        ls += __shfl_xor(ls, 16); ls += __shfl_xor(ls, 32);
        const float inv = 1.0f / (ls + exp2f((sink - mx) * L2E));
        f32x4 o[4];
#pragma unroll
        for (int dt = 0; dt < 4; ++dt) o[dt] = (f32x4){0.f, 0.f, 0.f, 0.f};
#pragma unroll
        for (int kk = 0; kk < 6; ++kk) {
            u32x4 w; w.x = pk2(s[2 * kk][0], s[2 * kk][1]); w.y = pk2(s[2 * kk][2], s[2 * kk][3]); w.z = pk2(s[2 * kk + 1][0], s[2 * kk + 1][1]); w.w = pk2(s[2 * kk + 1][2], s[2 * kk + 1][3]);
            const bf16x8 pb = __builtin_bit_cast(bf16x8, w);
#pragma unroll
            for (int dt = 0; dt < 4; ++dt) { const LAS bf16* vp = VTl + (16 * dt + fr) * 200 + 32 * kk + 4 * fq;
                const u32x2 lo = *(const LAS u32x2*)vp, hi = *(const LAS u32x2*)(vp + 16);
                const u32x4 aw = (u32x4){lo.x, lo.y, hi.x, hi.y}; const bf16x8 a = __builtin_bit_cast(bf16x8, aw);
                o[dt] = MFMA16(a, pb, o[dt]); }
        }
        bf16* mp = mix + (size_t)(qrow0 + qi) * DM + 512 + head * 64 + 4 * fq;
#pragma unroll
        for (int dt = 0; dt < 4; ++dt) { const f32x4 v = o[dt] * inv; u32x2 w; w.x = pk2(v[0], v[1]); w.y = pk2(v[2], v[3]); *(u32x2*)(mp + 16 * dt) = w; }
    }
}
__device__ __forceinline__ void phase3(const Params& P, LAS unsigned char* lds, int tid, int wave, int lane) {
    const int G = gridDim.x, NR = G / 2, blk = blockIdx.x;
    if (blk < NR) {
#ifndef NO_RET
#ifdef PROBE_RETX2
        for (int rep = 0; rep < 2; ++rep)
#endif
        for (int it = blk; it < 256; it += NR) {
            const bool sample = it >= 128; const int bh = it & 127, b = bh >> 2, h = bh & 3;
            ret_item(P, lds, tid, wave, lane, h, sample ? MP + 64 * b : b * SEQ, sample ? 1 : 32, P.state_ret + (size_t)bh * 16384, sample, P.out + (sample ? OFF_SRET : OFF_PRET) + (size_t)bh * 16384);
        }
#endif
    } else {
#ifndef NO_ATT
#ifdef PROBE_ATTX2
        for (int rep = 0; rep < 2; ++rep)
#endif
        for (int it = blk - NR; it < 2112; it += G - NR) {
            const bool sample = it >= 2048;
            att_item(P, lds, tid, wave, lane, sample, sample ? (it - 2048) >> 1 : it >> 6, sample ? 2 : (it >> 1) & 31, it & 1);
        }
#endif
    }
}

__device__ __forceinline__ void phase6(const Params& P, int tid) {
    const bf16* ua = (const bf16*)(P.ws + WS_R1); bf16* ub = (bf16*)(P.ws + WS_R2);
    constexpr int CH = DFF / 8;
    const int total = MT * CH;
    for (int idx = blockIdx.x * 512 + tid; idx < total; idx += gridDim.x * 512) {
        const int row = idx / CH, j = (idx - row * CH) * 8;
        const bool smp = row >= MP; const int t = smp ? ((row - MP) & 63) : (row & 2047);
        float a[8], p1[8], p2[8], bb[8];
        unpack8(*(const u32x4*)(ua + (size_t)row * DFF + j), a);
        unpack8(*(const u32x4*)(ub + (size_t)row * DFF + j), bb);
        if (t >= 1) unpack8(*(const u32x4*)(ua + (size_t)(row - 1) * DFF + j), p1);
        else if (smp) { const float* s = P.state_conv + ((size_t)((row - MP) >> 6) * 2 + 1) * DFF + j; const f32x4 x = *(const f32x4*)s, y = *(const f32x4*)(s + 4); p1[0] = x.x; p1[1] = x.y; p1[2] = x.z; p1[3] = x.w; p1[4] = y.x; p1[5] = y.y; p1[6] = y.z; p1[7] = y.w; }
        else {
#pragma unroll
            for (int e = 0; e < 8; ++e) p1[e] = 0.f; }
        if (t >= 2) unpack8(*(const u32x4*)(ua + (size_t)(row - 2) * DFF + j), p2);
        else if (smp) { const float* s = P.state_conv + ((size_t)((row - MP) >> 6) * 2 + t) * DFF + j; const f32x4 x = *(const f32x4*)s, y = *(const f32x4*)(s + 4); p2[0] = x.x; p2[1] = x.y; p2[2] = x.z; p2[3] = x.w; p2[4] = y.x; p2[5] = y.y; p2[6] = y.z; p2[7] = y.w; }
        else {
#pragma unroll
            for (int e = 0; e < 8; ++e) p2[e] = 0.f; }
        float r[8];
#pragma unroll
        for (int h = 0; h < 2; ++h) { const f32x4 w0 = *(const f32x4*)(P.conv_w + j + 4 * h), w1 = *(const f32x4*)(P.conv_w + DFF + j + 4 * h), w2 = *(const f32x4*)(P.conv_w + 2 * DFF + j + 4 * h), cb = *(const f32x4*)(P.conv_b + j + 4 * h);
#pragma unroll
            for (int e = 0; e < 4; ++e) { const float cv = cb[e] + w0[e] * p2[4 * h + e] + w1[e] * p1[4 * h + e] + w2[e] * a[4 * h + e]; r[4 * h + e] = silu_f(cv) * bb[4 * h + e]; } }
        u32x4 w; w.x = pk2(r[0], r[1]); w.y = pk2(r[2], r[3]); w.z = pk2(r[4], r[5]); w.w = pk2(r[6], r[7]);
        *(u32x4*)(ub + (size_t)row * DFF + j) = w;
    }
}
#ifdef CONV_FUSED
__device__ __forceinline__ void phase6c(const Params& P, int tid) {
    const float* headA = (const float*)(P.ws + WS_R1); const float* headB = headA + HT_STRIDE; const float* tailA = headA + 2 * HT_STRIDE;
    bf16* act = (bf16*)(P.ws + WS_R2);
    const int total = NGRP * DFF;
    for (int idx = blockIdx.x * 512 + tid; idx < total; idx += gridDim.x * 512) {
        const int g = idx / DFF, j = idx - g * DFF;
        float p0, p1;
        if (g < 1024) { if ((g & 31) == 0) { p0 = 0.f; p1 = 0.f; } else { p0 = tailA[((size_t)(g - 1) * 2) * DFF + j]; p1 = tailA[((size_t)(g - 1) * 2 + 1) * DFF + j]; } }
        else { p0 = P.state_conv[((size_t)(g - 1024) * 2) * DFF + j]; p1 = P.state_conv[((size_t)(g - 1024) * 2 + 1) * DFF + j]; }
        const float a0 = headA[((size_t)g * 2) * DFF + j], a1 = headA[((size_t)g * 2 + 1) * DFF + j];
        const float b0 = headB[((size_t)g * 2) * DFF + j], b1 = headB[((size_t)g * 2 + 1) * DFF + j];
        const float w0 = P.conv_w[j], w1 = P.conv_w[DFF + j], w2 = P.conv_w[2 * DFF + j], cb = P.conv_b[j];
        const float c0 = cb + w0 * p0 + w1 * p1 + w2 * a0, c1 = cb + w0 * p1 + w1 * a0 + w2 * a1;
        act[(size_t)(64 * g) * DFF + j] = (bf16)(pk2(silu_f(c0) * b0, 0.f) & 0xffffu);
        act[(size_t)(64 * g + 1) * DFF + j] = (bf16)(pk2(silu_f(c1) * b1, 0.f) & 0xffffu);
        const float t0 = tailA[((size_t)g * 2) * DFF + j], t1 = tailA[((size_t)g * 2 + 1) * DFF + j];
        if (g < 1024) { if ((g & 31) == 31) { P.out[OFF_PCONV + ((size_t)(g >> 5) * 2) * DFF + j] = t0; P.out[OFF_PCONV + ((size_t)(g >> 5) * 2 + 1) * DFF + j] = t1; } }
        else { P.out[OFF_SCONV + ((size_t)(g - 1024) * 2) * DFF + j] = t0; P.out[OFF_SCONV + ((size_t)(g - 1024) * 2 + 1) * DFF + j] = t1; }
    }
}
#endif
__device__ __forceinline__ void phase8(const Params& P, int wave, int lane) {
    const float* mod = (const float*)(P.ws + WS_MOD); const bf16* x2 = (const bf16*)(P.ws + WS_R0);
    const int gw = blockIdx.x * 8 + wave, NGW = gridDim.x * 8;
#pragma unroll 2
    for (int row = gw; row < MT; row += NGW) {
        const int bs = row < MP ? (row >> 11) : 32 + ((row - MP) >> 6);
        float* yr = P.out + (size_t)row * DM + 8 * lane;
        const float* mb = mod + (size_t)bs * 8192 + 6144 + 8 * lane;
        float v[2][8]; float ss = 0.f;
        if (row < MP) {
            const bf16* xr = x2 + (size_t)row * DM + 8 * lane;
#pragma unroll
            for (int j = 0; j < 2; ++j) unpack8(*(const u32x4*)(xr + 512 * j), v[j]);
        } else {
            const bf16* xr = (const bf16*)(P.ws + WS_X1B) + (size_t)row * DM + 8 * lane;
            const float* sl = (const float*)(P.ws + WS_SLAB) + (size_t)(row - MP) * DM + 8 * lane;
            const float* g2 = mod + (size_t)bs * 8192 + 5120 + 8 * lane;
#pragma unroll
            for (int j = 0; j < 2; ++j) { unpack8(*(const u32x4*)(xr + 512 * j), v[j]);
#pragma unroll
                for (int h = 0; h < 2; ++h) { const int o = 512 * j + 4 * h; f32x4 a = *(const f32x4*)(sl + o);
#pragma unroll
                    for (int p = 1; p < 4; ++p) a += *(const f32x4*)(sl + (size_t)p * MS * DM + o);
                    const f32x4 g = *(const f32x4*)(g2 + o);
#pragma unroll
                    for (int e = 0; e < 4; ++e) v[j][4 * h + e] += g[e] * a[e]; } }
        }
#pragma unroll
        for (int j = 0; j < 2; ++j)
#pragma unroll
            for (int e = 0; e < 8; ++e) ss += v[j][e] * v[j][e];
        const float rstd = rsqrtf(wave_sum(ss) * (1.f / DM) + EPS);
#pragma unroll
        for (int j = 0; j < 2; ++j)
#pragma unroll
            for (int h = 0; h < 2; ++h) { const int o = 512 * j + 4 * h; const f32x4 sh = *(const f32x4*)(mb + o), sc = *(const f32x4*)(mb + 1024 + o), gn = *(const f32x4*)(P.normf + 8 * lane + o);
                const f32x4 x = (f32x4){v[j][4 * h], v[j][4 * h + 1], v[j][4 * h + 2], v[j][4 * h + 3]};
                *(f32x4*)(yr + o) = x * rstd * gn * (sc + 1.0f) + sh; }
    }
}
__device__ __forceinline__ void phase8q(const Params& P, LAS unsigned char* lds, int tid, int wave, int lane) {
    const float* mod = (const float*)(P.ws + WS_MOD);
    unsigned* cnt = (unsigned*)(P.ws + WS_CNT7); unsigned* ticket = (unsigned*)(P.ws + WS_TICKET);
    LAS int* ord = (LAS int*)(lds + 131072);
    LAS int* flag = ord + 272;
    pg8::StaticOrder S; S.init(MT, DM, (int)gridDim.x, 0);
    for (int i = tid; i < NTM; i += 512) flag[i] = 0;
    __syncthreads();
    { const int full = (S.nwg / S.G) * S.G; for (int L = full + tid; L < S.nwg; L += 512) { pg8::Unit u; S.map(L, u); flag[u.pm] = 1; } }
    __syncthreads();
    if (tid == 0) { int k = 0; for (int i = 0; i < NTM; ++i) if (!flag[i]) ord[k++] = i; for (int i = 0; i < NTM; ++i) if (flag[i]) ord[k++] = i; }
    __syncthreads();
    for (;;) {
        if (tid == 0) flag[268] = (int)__hip_atomic_fetch_add(ticket, 1u, __ATOMIC_RELAXED, __HIP_MEMORY_SCOPE_AGENT);
        __syncthreads();
        const int tk = flag[268];
        if (tk >= NTM * 4) break;
        const int pm = ord[tk >> 2], rb = tk & 3;
        if (wave == 0) {
            unsigned spins = 0;
            while ((unsigned)__builtin_amdgcn_readfirstlane(__hip_atomic_load(cnt + 64 * pm, __ATOMIC_RELAXED, __HIP_MEMORY_SCOPE_AGENT)) < 32u) { __builtin_amdgcn_s_sleep(4); if (++spins > (1u << 22)) break; }
            __builtin_amdgcn_fence(__ATOMIC_ACQUIRE, "agent");
            asm volatile("s_waitcnt vmcnt(0)" ::: "memory");
        }
        __syncthreads();
#pragma unroll 2
        for (int i = 0; i < 8; ++i) {
            const int row = pm * 256 + rb * 64 + wave * 8 + i;
            const int bs = row < MP ? (row >> 11) : 32 + ((row - MP) >> 6);
            float* yr = P.out + (size_t)row * DM + 4 * lane;
            const float* mb = mod + (size_t)bs * 8192 + 6144 + 4 * lane;
            f32x4 v[4]; float ss = 0.f;
#pragma unroll
            for (int j = 0; j < 4; ++j) { v[j] = *(const f32x4*)(yr + 256 * j); ss += (v[j].x * v[j].x + v[j].y * v[j].y) + (v[j].z * v[j].z + v[j].w * v[j].w); }
            const float rstd = rsqrtf(wave_sum(ss) * (1.f / DM) + EPS);
#pragma unroll
            for (int j = 0; j < 4; ++j) { const f32x4 sh = *(const f32x4*)(mb + 256 * j), sc = *(const f32x4*)(mb + 1024 + 256 * j), gn = *(const f32x4*)(P.normf + 4 * lane + 256 * j);
                *(f32x4*)(yr + 256 * j) = v[j] * rstd * gn * (sc + 1.0f) + sh; }
        }
    }
}

__device__ __forceinline__ void sample_fix(const Params& P, int wave, int lane) {
    const float* mod = (const float*)(P.ws + WS_MOD); const float* sl0 = (const float*)(P.ws + WS_SLAB4);
    bf16* a2 = (bf16*)(P.ws + WS_R0); bf16* x1b = (bf16*)(P.ws + WS_X1B); float* ss1 = (float*)(P.ws + WS_SS1);
    const int gw = blockIdx.x * 8 + wave, NGW = gridDim.x * 8;
    for (int r = gw; r < MS; r += NGW) {
        const int row = MP + r, bs = 32 + (r >> 6);
        const float* xr = P.x_s + (size_t)r * DM + 8 * lane; const float* sl = sl0 + (size_t)r * DM + 8 * lane; const float* mb = mod + (size_t)bs * 8192 + 8 * lane;
        float v[2][8], a[2][8]; float ss = 0.f;
#pragma unroll
        for (int j = 0; j < 2; ++j)
#pragma unroll
            for (int h = 0; h < 2; ++h) { const int o = 512 * j + 4 * h; f32x4 acc = *(const f32x4*)(sl + o);
#pragma unroll
                for (int p = 1; p < 4; ++p) acc += *(const f32x4*)(sl + (size_t)p * MS * DM + o);
                const f32x4 x = *(const f32x4*)(xr + o) + *(const f32x4*)(mb + 2048 + o) * acc;
                const f32x4 gs = *(const f32x4*)(P.ln2 + 8 * lane + o) * (*(const f32x4*)(mb + 4096 + o) + 1.0f);
#pragma unroll
                for (int e = 0; e < 4; ++e) { v[j][4 * h + e] = x[e]; a[j][4 * h + e] = x[e] * gs[e]; ss += x[e] * x[e]; } }
        ss = wave_sum(ss);
#pragma unroll
        for (int j = 0; j < 2; ++j) { u32x4 w; w.x = pk2(v[j][0], v[j][1]); w.y = pk2(v[j][2], v[j][3]); w.z = pk2(v[j][4], v[j][5]); w.w = pk2(v[j][6], v[j][7]);
            *(u32x4*)(x1b + (size_t)row * DM + 8 * lane + 512 * j) = w;
            w.x = pk2(a[j][0], a[j][1]); w.y = pk2(a[j][2], a[j][3]); w.z = pk2(a[j][4], a[j][5]); w.w = pk2(a[j][6], a[j][7]);
            *(u32x4*)(a2 + (size_t)row * DM + 8 * lane + 512 * j) = w; }
        if (lane < 16) ss1[(size_t)row * 16 + lane] = lane == 0 ? ss : 0.f;
    }
}

#ifndef N_LAUNCH
#define N_LAUNCH 1
#endif
#define LAUNDER_TID() int tid = threadIdx.x; asm volatile("" : "+v"(tid)); const int lane = tid & 63, wave = __builtin_amdgcn_readfirstlane(tid >> 6); (void)lane; (void)wave
template <int PHM>
__global__ void __launch_bounds__(512) fwd_mega(Params P) {
    extern __shared__ __attribute__((aligned(16))) unsigned char lds_raw[];
    LAS unsigned char* lds = (LAS unsigned char*)lds_raw;
    const int G = gridDim.x;
    unsigned char* ws = P.ws;
    volatile LAS unsigned* misc = (volatile LAS unsigned*)(lds + LDS_MISC);
    if (threadIdx.x < 2) misc[threadIdx.x] = 0u;
    __syncthreads();
    XcdBarrier bar; bar.bar = (unsigned*)(ws + WS_BAR); bar.x = 0; bar.st = misc;
#define GSYNC(a, b) do { if ((PHM & (a)) && (PHM & (b))) xcd_barrier(bar); } while (0)
    if constexpr (PHM == 511) {
      if (blockIdx.x == 0) for (int i = threadIdx.x; i < XCD_BAR_WORDS; i += 512) ((unsigned*)(ws + WS_BAR))[i] = 0u;
      if (blockIdx.x == 1) { for (int i = threadIdx.x; i < NTM * 64; i += 512) ((unsigned*)(ws + WS_CNT7))[i] = 0u; if (threadIdx.x < 64) ((unsigned*)(ws + WS_TICKET))[threadIdx.x] = 0u; }
      cg::this_grid().sync();
      bar = xcd_barrier_post((unsigned*)(ws + WS_BAR), misc); }
    if constexpr ((PHM & 1) != 0) { LAUNDER_TID(); phase0(P, lds, wave, lane); }
    GSYNC(1, 2);
    if constexpr ((PHM & 2) != 0) { LAUNDER_TID(); phase1(P, lds, tid, wave, lane); }
    GSYNC(2, 4);
    if constexpr ((PHM & 4) != 0) {
      pg8::Gemm g{(const bf16*)(ws + WS_R0), (const bf16*)(ws + WS_WIN), MT, INW, DM};
      OrderX S; S.S.init(MT, INW, G, (int)blockIdx.x); S.nX = 22; S.xpm = NTM; S.xpn0 = 11;
      Epi1 E{(bf16*)(ws + WS_R1), (float*)(ws + WS_SHW), P.out};
      pg8::gemm_phase<Epi1, OrderX, true, true>(lds, g, S, E); }
    GSYNC(4, 8);
    if constexpr ((PHM & 8) != 0) { LAUNDER_TID(); phase3(P, lds, tid, wave, lane);
#ifdef PROBE_P3X2
      cg::this_grid().sync(); phase3(P, lds, tid, wave, lane);
#endif
    }
    GSYNC(8, 16);
    if constexpr ((PHM & 16) != 0) {
      pg8::Gemm g{(const bf16*)(ws + WS_R2), (const bf16*)(ws + WS_WOUT), MT, DM, DM};
      OrderDown S; S.S.init(MP, DM, G, (int)blockIdx.x); S.ka = 4; S.kb = 4;
      Epi2 E{P.x_p, P.x_s, (const float*)(ws + WS_MOD), P.ln2, (bf16*)(ws + WS_X1B), (bf16*)(ws + WS_R0), (float*)(ws + WS_SS1), (float*)(ws + WS_SLAB4)};
      pg8::gemm_phase<Epi2, OrderDown, true, true>(lds, g, S, E); }
    GSYNC(16, 32);
    if constexpr ((PHM & 32) != 0) {
      LAUNDER_TID();
      sample_fix(P, wave, lane);
      if constexpr (PHM == 511) xcd_barrier(bar);
      pg8::Gemm g{(const bf16*)(ws + WS_R0), (const bf16*)(ws + WS_WUP), MT, 2 * DFF, DM};
      pg8::StaticOrder S; S.init(MT, 2 * DFF, G, (int)blockIdx.x);
      LAS float* rtab = (LAS float*)(lds + 131072);
      { pg8::Unit u; const float* ss = (const float*)(ws + WS_SS1);
        for (int i = 0; S.next(i, u) && i < 24; ++i) if (tid < 256) { const f32x4* sp = (const f32x4*)(ss + (size_t)(u.pm * 256 + tid) * 16);
            const f32x4 q0 = sp[0], q1 = sp[1], q2 = sp[2], q3 = sp[3];
            const float tot = ((q0.x + q0.y) + (q0.z + q0.w)) + ((q1.x + q1.y) + (q1.z + q1.w)) + ((q2.x + q2.y) + (q2.z + q2.w)) + ((q3.x + q3.y) + (q3.z + q3.w));
            rtab[i * 256 + tid] = rsqrtf(tot * (1.f / DM) + EPS); }
        __syncthreads(); }
#ifdef CONV_FUSED
      float* hA = (float*)(ws + WS_R1);
      Epi3C E{rtab, (const float*)(ws + WS_SHW), P.conv_w, P.conv_b, (bf16*)(ws + WS_R2), hA, hA + HT_STRIDE, hA + 2 * HT_STRIDE};
      pg8::gemm_phase<Epi3C, pg8::StaticOrder, true, true>(lds, g, S, E);
#else
      Epi3 E{rtab, (const float*)(ws + WS_SHW), (bf16*)(ws + WS_R1), (bf16*)(ws + WS_R2), P.out};
      pg8::gemm_phase<Epi3, pg8::StaticOrder, true, true>(lds, g, S, E);
#endif
#ifdef PROBE_P5X2
      cg::this_grid().sync(); pg8::gemm_phase<Epi3, pg8::StaticOrder, true, true>(lds, g, S, E);
#endif
    }
    GSYNC(32, 64);
#ifdef CONV_FUSED
    if constexpr ((PHM & 64) != 0) { LAUNDER_TID(); phase6c(P, tid); }
#else
    if constexpr ((PHM & 64) != 0) { LAUNDER_TID(); phase6(P, tid); }
#endif
    GSYNC(64, 128);
    if constexpr ((PHM & 128) != 0) {
      pg8::Gemm g{(const bf16*)(ws + WS_R2), (const bf16*)(ws + WS_WDN), MT, DM, DFF};
#ifdef P8_QUEUE
      OrderPub S; S.init(MT, DM, G, (int)blockIdx.x); S.cnt = (unsigned*)(ws + WS_CNT7);
      Epi4 E{(const float*)(ws + WS_MOD), (const bf16*)(ws + WS_X1B), (bf16*)(ws + WS_R0), (float*)(ws + WS_SLAB)};
      pg8::gemm_phase<Epi4, OrderPub, true, true>(lds, g, S, E); }
    if constexpr ((PHM & 256) != 0) { LAUNDER_TID(); phase8q(P, lds, tid, wave, lane); }
#else
      OrderDown S; S.S.init(MP, DM, G, (int)blockIdx.x); S.ka = 12; S.kb = 10;
      Epi4 E{(const float*)(ws + WS_MOD), (const bf16*)(ws + WS_X1B), (bf16*)(ws + WS_R0), (float*)(ws + WS_SLAB)};
      pg8::gemm_phase<Epi4, OrderDown, true, true>(lds, g, S, E); }
    GSYNC(128, 256);
    if constexpr ((PHM & 256) != 0) { LAUNDER_TID(); phase8(P, wave, lane); }
#endif
}

template <int PHM> static bool launch_one(const Params& p, int grid, bool coop, hipStream_t stream) {
    static bool attr_done = false;
    if (!attr_done) { if (hipFuncSetAttribute((const void*)fwd_mega<PHM>, hipFuncAttributeMaxDynamicSharedMemorySize, LDS_BYTES) != hipSuccess) { fprintf(stderr, "kernel_launch: hipFuncSetAttribute failed\n"); return false; } attr_done = true; }
    hipError_t e;
    if (coop) { Params pc = p; void* args[] = {&pc}; e = hipLaunchCooperativeKernel((const void*)fwd_mega<PHM>, dim3(grid), dim3(512), args, LDS_BYTES, stream); }
    else { hipLaunchKernelGGL(fwd_mega<PHM>, dim3(grid), dim3(512), LDS_BYTES, stream, p); e = hipPeekAtLastError(); }
    if (e != hipSuccess) { fprintf(stderr, "launch (mask %d) failed: %s (grid %d)\n", PHM, hipGetErrorString(e), grid); return false; }
    return true;
}
extern "C" void kernel_launch(void* const* d_in, const int* in_sizes, int n_in, void* d_out, int out_size, void* d_ws, size_t ws_size, hipStream_t stream) {
    static int grid = 0;
    if (grid == 0) {
        if (n_in != 22 || (size_t)out_size != OUT_TOTAL || ws_size < WS_END) { fprintf(stderr, "kernel_launch: unexpected sizes n_in %d out %d ws %zu\n", n_in, out_size, ws_size); grid = -1; return; }
        int dev = 0, cus = 0;
        (void)hipGetDevice(&dev);
        (void)hipDeviceGetAttribute(&cus, hipDeviceAttributeMultiprocessorCount, dev);
        grid = cus;
        if (grid > 256) grid = 256;
        if (grid < 2) grid = -1;
    }
    if (grid < 0) return;
    Params p{};
    const float** pp = (const float**)&p;
    for (int i = 0; i < 22; ++i) pp[i] = (const float*)d_in[i];
    p.out = (float*)d_out; p.ws = (unsigned char*)d_ws;
#if N_LAUNCH == 1
    launch_one<511>(p, grid, true, stream);
#else
    launch_one<1>(p, grid, false, stream) && launch_one<2>(p, grid, false, stream) && launch_one<4>(p, grid, false, stream) && launch_one<8>(p, grid, false, stream) &&
    launch_one<16>(p, grid, false, stream) && launch_one<32>(p, grid, false, stream) && launch_one<64>(p, grid, false, stream) && launch_one<128>(p, grid, false, stream) && launch_one<256>(p, grid, false, stream);
#endif
}
```

```cpp
#define CONV_FUSED 1
#include <hip/hip_runtime.h>
#include <hip/hip_cooperative_groups.h>
#include <cstdio>
#include <cstdint>
namespace cg = cooperative_groups;
namespace pg8 {
#define PG8_LAS __attribute__((address_space(3)))
typedef unsigned short bf16_t;
typedef short bf16x8 __attribute__((ext_vector_type(8)));
typedef float f32x4 __attribute__((ext_vector_type(4)));
typedef unsigned u32x4 __attribute__((ext_vector_type(4)));
constexpr int BM = 256, BK = 64, HALF = 128, HTB = HALF * BK * 2  , STAGE_BYTES = 8 * HTB, NXCD = 8, WGM = 8;

__host__ __device__ __forceinline__ int lds_byte(int r, int c) { const int st = (r >> 4) * 2 + (c >> 5), rr = r & 15, cc = c & 31, ob = rr * 64 + cc * 2; return st * 1024 + (ob ^ (((ob >> 9) & 1) << 5)); }
__host__ __device__ __forceinline__ void stage_rc(int b, int& R, int& C) { const int st = b / 1024, sb = b % 1024, swz = sb ^ (((sb >> 9) & 1) << 5); R = (st >> 1) * 16 + swz / 64; C = (st & 1) * 32 + (swz % 64) / 2; }
__host__ __device__ __forceinline__ int perm32(int rho) { const int n = rho >> 4, i = rho & 15; return 8 * (i >> 2) + 4 * n + (i & 3); }

struct Unit { int pm, pn, seq, kt0, nt; };
struct Gemm { const bf16_t* A; const bf16_t* Bt; int M, N, K; };

struct StaticOrder {
    int nM, nN, nwg, G, c;
    __host__ __device__ __forceinline__ void init(int M, int N, int G_, int c_) { nM = M / BM; nN = N / BM; nwg = nM * nN; G = G_; c = c_; }
    __host__ __device__ __forceinline__ bool next(int i, Unit& u) const {
        const long L = (long)i * G + c; if (L >= nwg) return false; u.seq = i; u.kt0 = 0; u.nt = 0; map(L, u); return true; }
    __host__ __device__ __forceinline__ void map(long L, Unit& u) const {
        int wgid = (int)L; { const int q = nwg / NXCD, r = nwg % NXCD, xcd = wgid % NXCD, off = wgid / NXCD; wgid = (xcd < r ? xcd * (q + 1) : r * (q + 1) + (xcd - r) * q) + off; }
        const int nig = WGM * nN, gid = wgid / nig, fm = gid * WGM, gsz = (nM - fm) < WGM ? (nM - fm) : WGM;
        u.pm = fm + ((wgid % nig) % gsz); u.pn = (wgid % nig) / gsz;
    }
    __device__ __forceinline__ void a_ready(const Unit&) const {}
    __device__ __forceinline__ void done(const Unit&) const {}
};

__device__ __forceinline__ unsigned cvt_pk_bf16(float lo, float hi) { unsigned r; asm volatile("v_cvt_pk_bf16_f32 %0, %1, %2" : "=v"(r) : "v"(lo), "v"(hi)); return r; }

template <class Epi, class Sched, bool ALIGN_EPI = false, bool SP2 = false>
__device__ __forceinline__ void gemm_phase(PG8_LAS unsigned char* lds, const Gemm g, const Sched& S, const Epi& E) {
    int tid_ = threadIdx.x; asm volatile("" : "+v"(tid_));
    const int tid = tid_, wid = __builtin_amdgcn_readfirstlane(tid >> 6), lane = tid & 63, wr = wid >> 2, wc = wid & 3, fr = lane & 15, fq = lane >> 4;
    const int K = g.K, nt = K / BK;
    unsigned voffA[2], voffB[2];
#pragma unroll
    for (int i = 0; i < 2; ++i) { int R, C; stage_rc(tid * 16 + i * 8192, R, C); const int Rb = Epi::PERM ? ((R & ~31) + perm32(R & 31)) : R;
        voffA[i] = (unsigned)(R * K + C) * 2u; voffB[i] = (unsigned)(Rb * K + C) * 2u; }
    const size_t kstep = (size_t)(BK * 2);
    const size_t hstep = (size_t)HALF * K * 2;
    const size_t tstep = 2 * hstep;
    const unsigned ldsw = (unsigned)wid * 1024u;
    const int aoff = lds_byte(wr * 64 + fr, fq * 8), boff = lds_byte(wc * 32 + fr, fq * 8);
#define PG8_SA(b, h) (((b) * 2 + (h)) * HTB)
#define PG8_SB(b, h) ((4 + (b) * 2 + (h)) * HTB)
#define PG8_STAGE(bufoff, gbase, voff) do { _Pragma("unroll") for (int _i = 0; _i < 2; ++_i) \
        __builtin_amdgcn_global_load_lds((const unsigned*)((const char*)(gbase) + (voff)[_i]), (PG8_LAS unsigned*)(lds + (bufoff) + ldsw + _i * 8192), 16, 0, 0); } while (0)
#define PG8_LDA(dst, b, h) do { _Pragma("unroll") for (int m = 0; m < 4; ++m) _Pragma("unroll") for (int k = 0; k < 2; ++k) dst[m][k] = *(const PG8_LAS bf16x8*)(lds + PG8_SA(b, h) + aoff + m * 2048 + k * 1024); } while (0)
#define PG8_LDB(dst, b, h) do { _Pragma("unroll") for (int n = 0; n < 2; ++n) _Pragma("unroll") for (int k = 0; k < 2; ++k) dst[n][k] = *(const PG8_LAS bf16x8*)(lds + PG8_SB(b, h) + boff + n * 2048 + k * 1024); } while (0)
#define PG8_MMA(ai, bj, At, Bt) do { __builtin_amdgcn_s_setprio(1); _Pragma("unroll") for (int m = 0; m < 4; ++m) _Pragma("unroll") for (int n = 0; n < 2; ++n) _Pragma("unroll") for (int k = 0; k < 2; ++k) \
        acc[ai][bj][m][n] = __builtin_amdgcn_mfma_f32_16x16x32_bf16(Bt[n][k], At[m][k], acc[ai][bj][m][n], 0, 0, 0); __builtin_amdgcn_s_setprio(0); } while (0)
#define PG8_WAIT_V(n) asm volatile("s_waitcnt vmcnt(" #n ")" ::: "memory")
#define PG8_WAIT_L(n) asm volatile("s_waitcnt lgkmcnt(" #n ")" ::: "memory")
#define PG8_BAR __builtin_amdgcn_s_barrier()
#define PG8_SCHED __builtin_amdgcn_sched_barrier(0)
    Unit cur, nxt; int ui = 0;
    if (!S.next(0, cur)) return;
    f32x4 acc[2][2][4][2];
#pragma unroll
    for (int a = 0; a < 2; ++a)
#pragma unroll
        for (int b = 0; b < 2; ++b)
#pragma unroll
            for (int m = 0; m < 4; ++m)
#pragma unroll
                for (int n = 0; n < 2; ++n) acc[a][b][m][n] = (f32x4){0.f, 0.f, 0.f, 0.f};
    bf16x8 At[4][2], B0[2][2], B1[2][2];
    const char* cA = (const char*)g.A + (size_t)cur.pm * tstep + (size_t)cur.kt0 * (BK * 2); const char* cB = (const char*)g.Bt + (size_t)cur.pn * tstep + (size_t)cur.kt0 * (BK * 2);
    S.a_ready(cur);
    if constexpr (SP2) {
        PG8_STAGE(PG8_SB(0, 0), cB, voffB); PG8_STAGE(PG8_SB(0, 1), cB + hstep, voffB); PG8_STAGE(PG8_SA(0, 0), cA, voffA); PG8_STAGE(PG8_SA(0, 1), cA + hstep, voffA);
        if (wr == 1) PG8_BAR;
        PG8_WAIT_V(2); PG8_BAR;
        PG8_STAGE(PG8_SB(1, 0), cB + kstep, voffB); PG8_STAGE(PG8_SA(1, 0), cA + kstep, voffA); PG8_STAGE(PG8_SB(1, 1), cB + hstep + kstep, voffB);
        PG8_WAIT_V(6); PG8_BAR;
    } else {
        PG8_STAGE(PG8_SB(0, 0), cB, voffB); PG8_STAGE(PG8_SA(0, 0), cA, voffA); PG8_STAGE(PG8_SB(0, 1), cB + hstep, voffB); PG8_STAGE(PG8_SA(0, 1), cA + hstep, voffA);
        if (wr == 1) PG8_BAR;
        PG8_WAIT_V(4); PG8_BAR;
        PG8_STAGE(PG8_SB(1, 0), cB + kstep, voffB); PG8_STAGE(PG8_SA(1, 0), cA + kstep, voffA); PG8_STAGE(PG8_SB(1, 1), cB + hstep + kstep, voffB);
        PG8_WAIT_V(6); PG8_BAR;
    }
    for (;;) {
        const bool has_next = S.next(ui + 1, nxt);
        const char* nA = has_next ? (const char*)g.A + (size_t)nxt.pm * tstep + (size_t)nxt.kt0 * (BK * 2) : cA; const char* nB = has_next ? (const char*)g.Bt + (size_t)nxt.pn * tstep + (size_t)nxt.kt0 * (BK * 2) : cB;
        const int ntu = cur.nt ? cur.nt : nt;
        for (int t = 0; t < ntu; t += 2) {
            const bool last = (t == ntu - 2);
            const char* a1 = cA + (size_t)(t + 1) * kstep;
            const char* a2 = last ? nA : cA + (size_t)(t + 2) * kstep; const char* b2 = last ? nB : cB + (size_t)(t + 2) * kstep;
            const char* a3 = a2 + kstep; const char* b3 = b2 + kstep;
            if (last && has_next) S.a_ready(nxt);
            if constexpr (SP2) {
            PG8_LDB(B0, 0, 0); PG8_LDB(B1, 0, 1); PG8_SCHED; PG8_LDA(At, 0, 0); PG8_STAGE(PG8_SA(1, 1), a1 + hstep, voffA);
            PG8_WAIT_V(8); PG8_WAIT_L(0); PG8_BAR; PG8_MMA(0, 0, At, B0); PG8_MMA(0, 1, At, B1); PG8_BAR; PG8_SCHED;
            PG8_LDA(At, 0, 1); PG8_STAGE(PG8_SB(0, 0), b2, voffB); PG8_STAGE(PG8_SB(0, 1), b2 + hstep, voffB); PG8_STAGE(PG8_SA(0, 0), a2, voffA);
            PG8_WAIT_V(8); PG8_WAIT_L(0); PG8_BAR; PG8_MMA(1, 0, At, B0); PG8_MMA(1, 1, At, B1); PG8_BAR; PG8_SCHED;
            PG8_LDB(B0, 1, 0); PG8_LDB(B1, 1, 1); PG8_SCHED; PG8_LDA(At, 1, 0); PG8_STAGE(PG8_SA(0, 1), a2 + hstep, voffA);
            PG8_WAIT_V(8); PG8_WAIT_L(0); PG8_BAR; PG8_MMA(0, 0, At, B0); PG8_MMA(0, 1, At, B1); PG8_BAR; PG8_SCHED;
            PG8_LDA(At, 1, 1); PG8_STAGE(PG8_SB(1, 0), b3, voffB); PG8_STAGE(PG8_SB(1, 1), b3 + hstep, voffB); PG8_STAGE(PG8_SA(1, 0), a3, voffA);
            PG8_WAIT_V(8); PG8_WAIT_L(0); PG8_BAR; PG8_MMA(1, 0, At, B0); PG8_MMA(1, 1, At, B1); PG8_BAR; PG8_SCHED;
            } else {
            PG8_LDB(B0, 0, 0); PG8_SCHED; PG8_LDA(At, 0, 0); PG8_STAGE(PG8_SA(1, 1), a1 + hstep, voffA);
            PG8_WAIT_L(8); PG8_BAR; PG8_WAIT_L(0); PG8_MMA(0, 0, At, B0); PG8_BAR; PG8_SCHED;
            PG8_LDB(B1, 0, 1); PG8_STAGE(PG8_SB(0, 0), b2, voffB);
            PG8_BAR; PG8_WAIT_L(0); PG8_MMA(0, 1, At, B1); PG8_BAR;
            PG8_LDA(At, 0, 1); PG8_STAGE(PG8_SA(0, 0), a2, voffA);
            PG8_BAR; PG8_WAIT_L(0); PG8_MMA(1, 0, At, B0); PG8_BAR; PG8_SCHED;
            PG8_STAGE(PG8_SB(0, 1), b2 + hstep, voffB);
            PG8_WAIT_V(6); PG8_BAR; PG8_MMA(1, 1, At, B1); PG8_BAR;
            PG8_LDB(B0, 1, 0); PG8_SCHED; PG8_LDA(At, 1, 0); PG8_STAGE(PG8_SA(0, 1), a2 + hstep, voffA);
            PG8_WAIT_L(8); PG8_BAR; PG8_WAIT_L(0); PG8_MMA(0, 0, At, B0); PG8_BAR; PG8_SCHED;
            PG8_LDB(B1, 1, 1); PG8_STAGE(PG8_SB(1, 0), b3, voffB);
            PG8_BAR; PG8_WAIT_L(0); PG8_MMA(0, 1, At, B1); PG8_BAR;
            PG8_LDA(At, 1, 1); PG8_STAGE(PG8_SA(1, 0), a3, voffA);
            PG8_BAR; PG8_WAIT_L(0); PG8_MMA(1, 0, At, B0); PG8_BAR; PG8_SCHED;
            PG8_STAGE(PG8_SB(1, 1), b3 + hstep, voffB);
            PG8_WAIT_V(6); PG8_BAR; PG8_MMA(1, 1, At, B1); PG8_BAR;
            }
        }
        if constexpr (ALIGN_EPI) { if (wr == 0) PG8_BAR; }
        if constexpr (!Epi::AFTER_DRAIN) { E(acc, cur, wr, wc, fr, fq); S.done(cur); }
        if (!has_next) break;
#pragma unroll
        for (int a = 0; a < 2; ++a)
#pragma unroll
            for (int b = 0; b < 2; ++b)
#pragma unroll
                for (int m = 0; m < 4; ++m)
#pragma unroll
                    for (int n = 0; n < 2; ++n) acc[a][b][m][n] = (f32x4){0.f, 0.f, 0.f, 0.f};
        cur = nxt; cA = nA; cB = nB; ++ui;
        if constexpr (ALIGN_EPI) { if (wr == 1) PG8_BAR; }
    }
    PG8_WAIT_V(0);
    if constexpr (!ALIGN_EPI) { if (wr == 0) PG8_BAR; }
    PG8_BAR;
    if constexpr (Epi::AFTER_DRAIN) { E.fused(acc, cur, wr, wc, fr, fq, lds, wid, lane); S.done(cur); }
#undef PG8_SA
#undef PG8_SB
#undef PG8_STAGE
#undef PG8_LDA
#undef PG8_LDB
#undef PG8_MMA
#undef PG8_WAIT_V
#undef PG8_WAIT_L
#undef PG8_BAR
#undef PG8_SCHED
}
}
constexpr int DM = 1024, SEQ = 2048, NB = 32, DECL = 64, DFF = 2816, INW = 2816;
constexpr int MP = NB * SEQ, MS = NB * DECL, MT = MP + MS;
constexpr int NGRP = MT / 64;
constexpr int NTM = MT / 256;
constexpr float EPS = 1e-6f;
constexpr size_t OFF_Y = 0;
constexpr size_t OFF_PRET = (size_t)MT * DM;
constexpr size_t OFF_PK = OFF_PRET + (size_t)NB * 4 * 128 * 128;
constexpr size_t OFF_PV = OFF_PK + (size_t)NB * 128 * 128;
constexpr size_t OFF_PCONV = OFF_PV + (size_t)NB * 128 * 128;
constexpr size_t OFF_SRET = OFF_PCONV + (size_t)NB * 2 * DFF;
constexpr size_t OFF_SK = OFF_SRET + (size_t)NB * 4 * 128 * 128;
constexpr size_t OFF_SV = OFF_SK + (size_t)NB * 64 * 128;
constexpr size_t OFF_SCONV = OFF_SV + (size_t)NB * 64 * 128;
constexpr size_t OUT_TOTAL = OFF_SCONV + (size_t)NB * 2 * DFF;
constexpr size_t MiB = 1u << 20;
constexpr size_t WS_WIN = 0;
constexpr size_t WS_WUP = WS_WIN + (size_t)INW * DM * 2;
constexpr size_t WS_WOUT = WS_WUP + (size_t)2 * DFF * DM * 2;
constexpr size_t WS_WDN = WS_WOUT + (size_t)DM * DM * 2;
constexpr size_t WS_MODP = 24 * MiB;
constexpr size_t WS_MOD = 32 * MiB;
constexpr size_t WS_SHW = 34 * MiB;
constexpr size_t WS_SS1 = 36 * MiB;
constexpr size_t WS_SS2 = 41 * MiB;
constexpr size_t WS_R0 = 48 * MiB;
constexpr size_t WS_R1 = WS_R0 + 133 * MiB;
constexpr size_t WS_R2 = WS_R1 + 363 * MiB;
constexpr size_t HT_STRIDE = (size_t)NGRP * 2 * DFF;
constexpr size_t WS_END = WS_R2 + 363 * MiB;
constexpr size_t WS_SLAB = WS_R1 + 264 * MiB;
constexpr size_t WS_SLAB4 = WS_R1 + 300 * MiB;
constexpr size_t WS_X1B = WS_R1 + 128 * MiB;
static_assert(3 * HT_STRIDE * 4 <= 128 * MiB && WS_X1B + (size_t)MT * DM * 2 <= WS_R2, "ws map");
static_assert(WS_WDN + (size_t)DM * DFF * 2 <= WS_MODP, "ws map");
static_assert((size_t)(MT + 256) * DM * 2 <= 133 * MiB && (size_t)MT * DFF * 2 <= 363 * MiB, "ws map");

constexpr size_t WS_BAR = 46 * MiB;
constexpr size_t WS_TICKET = 46 * MiB + 32768;
constexpr size_t WS_CNT7 = 46 * MiB + 65536;
constexpr int LDS_MISC = 155648;
constexpr int LDS_BYTES = 155648 + 64;

#define LAS __attribute__((address_space(3)))
typedef unsigned short bf16;
typedef float f32x4 __attribute__((ext_vector_type(4)));
typedef float f32x2 __attribute__((ext_vector_type(2)));
typedef short bf16x8 __attribute__((ext_vector_type(8)));
typedef unsigned u32x4 __attribute__((ext_vector_type(4)));
typedef unsigned u32x2 __attribute__((ext_vector_type(2)));
typedef __bf16 bf16x2_t __attribute__((ext_vector_type(2)));
#define LDS_WAIT() asm volatile("s_waitcnt lgkmcnt(0)" ::: "memory")

__device__ __forceinline__ unsigned pk2(float lo, float hi) { f32x2 v = {lo, hi}; bf16x2_t b = __builtin_convertvector(v, bf16x2_t); return __builtin_bit_cast(unsigned, b); }
__device__ __forceinline__ float bflo(unsigned w) { return __uint_as_float(w << 16); }
__device__ __forceinline__ float bfhi(unsigned w) { return __uint_as_float(w & 0xffff0000u); }
__device__ __forceinline__ float wave_sum(float v) {
#pragma unroll
    for (int o = 1; o < 64; o <<= 1) v += __shfl_xor(v, o);
    return v;
}
__device__ __forceinline__ float wave_sum_dpp(float v) {
    v += __int_as_float(__builtin_amdgcn_update_dpp(__float_as_int(v), __float_as_int(v), 0x128, 0xf, 0xf, false));
    v += __int_as_float(__builtin_amdgcn_update_dpp(__float_as_int(v), __float_as_int(v), 0x124, 0xf, 0xf, false));
    v += __int_as_float(__builtin_amdgcn_update_dpp(__float_as_int(v), __float_as_int(v), 0x122, 0xf, 0xf, false));
    v += __int_as_float(__builtin_amdgcn_update_dpp(__float_as_int(v), __float_as_int(v), 0x121, 0xf, 0xf, false));
    const int i = __float_as_int(v);
    return (__int_as_float(__builtin_amdgcn_readlane(i, 0)) + __int_as_float(__builtin_amdgcn_readlane(i, 16))) + (__int_as_float(__builtin_amdgcn_readlane(i, 32)) + __int_as_float(__builtin_amdgcn_readlane(i, 48)));
}
__device__ __forceinline__ float silu_f(float x) { return x * __builtin_amdgcn_rcpf(1.0f + __builtin_amdgcn_exp2f(-1.4426950408889634f * x)); }
__device__ __forceinline__ void unpack8(const u32x4 w, float (&f)[8]) { f[0] = bflo(w.x); f[1] = bfhi(w.x); f[2] = bflo(w.y); f[3] = bfhi(w.y); f[4] = bflo(w.z); f[5] = bfhi(w.z); f[6] = bflo(w.w); f[7] = bfhi(w.w); }
__device__ __forceinline__ int grp_bs(int g) { return g < 1024 ? (g >> 5) : 32 + (g - 1024); }

struct Params {
    const float *x_p, *x_s, *cache_k, *cache_v, *state_ret, *state_conv, *c_p, *c_s, *ln1, *ln2, *w_ada, *b_ada, *w_in, *w_out, *sinks, *w_up, *conv_w, *conv_b, *w_down, *normf, *w_ada_f, *b_ada_f;
    float* out; unsigned char* ws;
};

__device__ __forceinline__ void transpose_item(const float* W, int K, int N, bf16* WT, int dst_row0, int k0, int n0, LAS float* scr, int lane) {
#pragma unroll 8
    for (int i = 0; i < 32; ++i) { const int kk = 2 * i + (lane >> 5); scr[kk * 33 + (lane & 31)] = W[(size_t)(k0 + kk) * N + n0 + (lane & 31)]; }
    LDS_WAIT(); asm volatile("" ::: "memory");
    const int c = lane & 7;
#pragma unroll
    for (int j = 0; j < 4; ++j) { const int n = (lane >> 3) + 8 * j; const LAS float* s = scr + (8 * c) * 33 + n;
        u32x4 o; o.x = pk2(s[0 * 33], s[1 * 33]); o.y = pk2(s[2 * 33], s[3 * 33]); o.z = pk2(s[4 * 33], s[5 * 33]); o.w = pk2(s[6 * 33], s[7 * 33]);
        *(u32x4*)(WT + (size_t)(dst_row0 + n) * K + k0 + 8 * c) = o; }
    LDS_WAIT(); asm volatile("" ::: "memory");
}
__device__ __forceinline__ void mod_item(const Params& P, int it, LAS float* scr, int lane) {
    const int ct = it >> 2, ks = it & 3, c0 = ct * 64;
    const float* W; const float* bias; int ldw;
    if (c0 < 6144) { W = P.w_ada + c0; bias = P.b_ada + c0; ldw = 6144; } else { W = P.w_ada_f + (c0 - 6144); bias = P.b_ada_f + (c0 - 6144); ldw = 2048; }
    float acc[64];
#pragma unroll
    for (int r = 0; r < 64; ++r) acc[r] = 0.f;
    const float* crow = (lane < 32 ? P.c_p + (size_t)lane * DM : P.c_s + (size_t)(lane - 32) * DM) + ks * 256;
    for (int kc = 0; kc < 8; ++kc) {
#pragma unroll
        for (int q = 0; q < 8; ++q) { f32x4 v = *(const f32x4*)(crow + kc * 32 + 4 * q);
            v.x = silu_f(v.x); v.y = silu_f(v.y); v.z = silu_f(v.z); v.w = silu_f(v.w);
            *(LAS f32x4*)(scr + lane * 36 + 4 * q) = v; }
        LDS_WAIT(); asm volatile("" ::: "memory");
        const float* wk = W + (size_t)(ks * 256 + kc * 32) * ldw + lane;
        for (int k4 = 0; k4 < 8; ++k4) {
            const float w0 = wk[(size_t)(4 * k4 + 0) * ldw], w1 = wk[(size_t)(4 * k4 + 1) * ldw], w2 = wk[(size_t)(4 * k4 + 2) * ldw], w3 = wk[(size_t)(4 * k4 + 3) * ldw];
#pragma unroll
            for (int r = 0; r < 64; ++r) { const f32x4 s = *(const LAS f32x4*)(scr + r * 36 + 4 * k4); acc[r] += (s.x * w0 + s.y * w1) + (s.z * w2 + s.w * w3); }
        }
        LDS_WAIT(); asm volatile("" ::: "memory");
    }
    float* dst = (float*)(P.ws + WS_MODP) + (size_t)ks * 64 * 8192 + c0 + lane;
    const float bv = (ks == 0) ? bias[lane] : 0.f;
#pragma unroll
    for (int r = 0; r < 64; ++r) dst[(size_t)r * 8192] = acc[r] + bv;
}
__device__ __forceinline__ void phase0(const Params& P, LAS unsigned char* lds, int wave, int lane) {
    LAS float* scr = (LAS float*)(lds + wave * 16384);
    const int gw = wave * gridDim.x + blockIdx.x, NGW = gridDim.x * 8;
    constexpr int I_MOD = 512, I_IN = 16 * 88, I_UP = 16 * 176, I_OUT = 16 * 32, I_DN = 44 * 32;
    constexpr int NIT = I_MOD + I_IN + I_UP + I_OUT + I_DN;
    for (int it = gw; it < NIT; it += NGW) {
        int r = it;
        if (r < I_MOD) { mod_item(P, r, scr, lane); continue; } r -= I_MOD;
        if (r < I_IN) { const int kb = r / 88, nb = r % 88; transpose_item(P.w_in, DM, INW, (bf16*)(P.ws + WS_WIN), nb * 32, kb * 64, nb * 32, scr, lane); continue; } r -= I_IN;
        if (r < I_UP) { const int kb = r / 176, nb = r % 176, n0 = nb * 32, isb = n0 >= DFF, j0 = n0 - isb * DFF;
            transpose_item(P.w_up, DM, 2 * DFF, (bf16*)(P.ws + WS_WUP), 256 * (j0 >> 7) + 128 * isb + (j0 & 127), kb * 64, n0, scr, lane); continue; } r -= I_UP;
        if (r < I_OUT) { const int kb = r / 32, nb = r % 32; transpose_item(P.w_out, DM, DM, (bf16*)(P.ws + WS_WOUT), nb * 32, kb * 64, nb * 32, scr, lane); continue; } r -= I_OUT;
        { const int kb = r / 32, nb = r % 32; transpose_item(P.w_down, DFF, DM, (bf16*)(P.ws + WS_WDN), nb * 32, kb * 64, nb * 32, scr, lane); }
    }
}

__device__ __forceinline__ void phase1(const Params& P, LAS unsigned char* lds, int tid, int wave, int lane) {
    const float* modp = (const float*)(P.ws + WS_MODP);
    float* mod = (float*)(P.ws + WS_MOD);
    bf16* H1 = (bf16*)(P.ws + WS_R0);
    for (int idx = blockIdx.x * 512 + tid; idx < 64 * 8192; idx += gridDim.x * 512) {
        const float s = (modp[idx] + modp[idx + 524288]) + (modp[idx + 2 * 524288] + modp[idx + 3 * 524288]);
        mod[idx] = s;
        const int col = idx & 8191, bs = idx >> 13;
        if (col >= 3072 && col < 4096) H1[(size_t)(MT + bs) * DM + (col - 3072)] = (bf16)(pk2(s, 0.f) & 0xffffu);
    }
    LAS float* lv = (LAS float*)lds;
    const int rpb = (MT + (int)gridDim.x - 1) / (int)gridDim.x, rbeg = (int)blockIdx.x * rpb, rend = (rbeg + rpb < MT) ? rbeg + rpb : MT;
    if (rbeg < rend) {
        const int bs0 = rbeg < MP ? (rbeg >> 11) : 32 + ((rbeg - MP) >> 6), bs1 = (rend - 1) < MP ? ((rend - 1) >> 11) : 32 + ((rend - 1 - MP) >> 6);
        const int nsl = bs1 - bs0 + 1;
        __syncthreads();
        for (int i = tid; i < nsl * 2048; i += 512) { const int sl = i >> 11, which = (i >> 10) & 1, col = i & 1023; const size_t o = (size_t)(bs0 + sl) * 8192 + which * 1024 + col;
            float sv = (modp[o] + modp[o + 524288]) + (modp[o + 2 * 524288] + modp[o + 3 * 524288]);
            if (which) sv = P.ln1[col] * (1.f + sv);
            lv[i] = sv; }
        __syncthreads();
#pragma unroll 4
        for (int row = rbeg + wave; row < rend; row += 8) {
            const int bs = row < MP ? (row >> 11) : 32 + ((row - MP) >> 6);
            const LAS float* lvs = lv + (bs - bs0) * 2048;
            const float* xr = (row < MP ? P.x_p + (size_t)row * DM : P.x_s + (size_t)(row - MP) * DM) + 4 * lane;
            f32x4 v[4]; float ss = 0.f;
#pragma unroll
            for (int j = 0; j < 4; ++j) { v[j] = *(const f32x4*)(xr + 256 * j); ss += (v[j].x * v[j].x + v[j].y * v[j].y) + (v[j].z * v[j].z + v[j].w * v[j].w); }
            const float rstd = __builtin_amdgcn_rsqf(wave_sum_dpp(ss) * (1.f / DM) + EPS);
            bf16* hr = H1 + (size_t)row * DM + 4 * lane;
#pragma unroll
            for (int j = 0; j < 4; ++j) { const f32x4 sh = *(const LAS f32x4*)(lvs + 256 * j + 4 * lane), gs = *(const LAS f32x4*)(lvs + 1024 + 256 * j + 4 * lane);
                const f32x4 h = v[j] * rstd * gs + sh; u32x2 w; w.x = pk2(h.x, h.y); w.y = pk2(h.z, h.w); *(u32x2*)(hr + 256 * j) = w; }
        }
    }
}

struct OrderX {
    pg8::StaticOrder S; int nX, xpm, xpn0;
    __device__ __forceinline__ bool next(int i, pg8::Unit& u) const {
        const long L = (long)i * S.G + S.c;
        int pm = 0, pn = 0; bool ok = false;
        if (L < S.nwg) { pg8::Unit t; t.pm = 0; t.pn = 0; t.seq = 0; t.kt0 = 0; t.nt = 0; (void)S.next(i, t); pm = t.pm; pn = t.pn; ok = true; }
        else if (L < S.nwg + nX) { pm = xpm; pn = xpn0 + (int)(L - S.nwg); ok = true; }
        u.pm = pm; u.pn = pn; u.seq = i; u.kt0 = 0; u.nt = 0;
        return ok;
    }
    __device__ __forceinline__ void a_ready(const pg8::Unit&) const {}
    __device__ __forceinline__ void done(const pg8::Unit&) const {}
};
struct OrderPub : pg8::StaticOrder {
    unsigned* cnt;
    __device__ __forceinline__ void done(const pg8::Unit& u) const {
        asm volatile("s_waitcnt vmcnt(0)" ::: "memory");
        if ((threadIdx.x & 63) == 0) __hip_atomic_fetch_add(cnt + 64 * u.pm, 1u, __ATOMIC_RELAXED, __HIP_MEMORY_SCOPE_AGENT);
    }
};
struct OrderDown {
    pg8::StaticOrder S;
    int ka, kb;
    __device__ __forceinline__ bool next(int i, pg8::Unit& u) const {
        const long L = (long)i * S.G + S.c;
        int pm = 0, pn = 0, kt0 = 0, nt = 0; bool ok = false;
        if (L < S.nwg) { pg8::Unit t; t.pm = 0; t.pn = 0; t.seq = 0; t.kt0 = 0; t.nt = 0; (void)S.next(i, t); pm = t.pm; pn = t.pn; ok = true; }
        else if (L < S.nwg + 128) { const int q = (int)(L - S.nwg), tu = q >> 2, part = q & 3; pm = (MP / 256) + (tu & 7); pn = tu >> 3; kt0 = part < 2 ? ka * part : 2 * ka + kb * (part - 2); nt = part < 2 ? ka : kb; ok = true; }
        u.pm = pm; u.pn = pn; u.seq = i; u.kt0 = kt0; u.nt = nt;
        return ok;
    }
    __device__ __forceinline__ void a_ready(const pg8::Unit&) const {}
    __device__ __forceinline__ void done(const pg8::Unit&) const {}
};
typedef const f32x4 (&AccRef)[2][2][4][2];
struct Epi1 {
    static constexpr bool PERM = true, AFTER_DRAIN = false;
    bf16* proj; float* shw; float* out;
    __device__ __forceinline__ void operator()(AccRef acc, const pg8::Unit& u, int wr, int wc, int fr, int fq) const {
        if (u.pm == NTM) {
            if (wr == 0) {
#pragma unroll
                for (int m = 0; m < 4; ++m) { float* d = shw + (size_t)(16 * m + fr) * (2 * DFF) + 256 * (u.pn - 11) + 32 * wc + 8 * fq;
#pragma unroll
                    for (int bj = 0; bj < 2; ++bj)
#pragma unroll
                        for (int n = 0; n < 2; ++n) *(f32x4*)(d + 128 * bj + 4 * n) = acc[0][bj][m][n]; }
            }
            return;
        }
        const unsigned row0 = u.pm * 256 + wr * 64 + fr, col0 = u.pn * 256 + wc * 32 + 8 * fq;
#pragma unroll
        for (int ai = 0; ai < 2; ++ai)
#pragma unroll
            for (int m = 0; m < 4; ++m) { const unsigned o = (row0 + 128 * ai + 16 * m) * (unsigned)INW + col0;
#pragma unroll
                for (int bj = 0; bj < 2; ++bj) { const f32x4 v0 = acc[ai][bj][m][0], v1 = acc[ai][bj][m][1];
                    u32x4 w; w.x = pk2(v0[0], v0[1]); w.y = pk2(v0[2], v0[3]); w.z = pk2(v1[0], v1[1]); w.w = pk2(v1[2], v1[3]);
                    *(u32x4*)(proj + (o + 128 * bj)) = w; }
                asm volatile("" ::: "memory"); }
        if (u.pn == 10) {
            const unsigned c = 32 * wc + 8 * fq;
#pragma unroll
            for (int ai = 0; ai < 2; ++ai)
#pragma unroll
                for (int m = 0; m < 4; ++m) { const unsigned row = row0 + 128 * ai + 16 * m; unsigned ok, ov;
                    if (row < (unsigned)MP) { const unsigned t = row & 2047; if (t < SEQ - 128) continue; const unsigned o = ((row >> 11) * 128 + (t - (SEQ - 128))) * 128 + c; ok = (unsigned)OFF_PK + o; ov = (unsigned)OFF_PV + o; }
                    else { const unsigned o = (row - MP) * 128 + c; ok = (unsigned)OFF_SK + o; ov = (unsigned)OFF_SV + o; }
                    *(f32x4*)(out + ok) = acc[ai][0][m][0]; *(f32x4*)(out + ok + 4) = acc[ai][0][m][1];
                    *(f32x4*)(out + ov) = acc[ai][1][m][0]; *(f32x4*)(out + ov + 4) = acc[ai][1][m][1];
                    asm volatile("" ::: "memory"); }
        }
    }
};
struct Epi2 {
    static constexpr bool PERM = true, AFTER_DRAIN = false;
    const float *xp, *xs, *mod, *ln2; bf16* x1; bf16* a2; float* ss; float* slab;
    __device__ __forceinline__ void operator()(AccRef acc, const pg8::Unit& u, int wr, int wc, int fr, int fq) const {
        const int col0 = u.pn * 256 + wc * 32 + 8 * fq;
        if (u.nt != 0) {
            float* sb = slab + (size_t)(u.kt0 >> 2) * MS * DM;
#pragma unroll
            for (int ai = 0; ai < 2; ++ai)
#pragma unroll
                for (int m = 0; m < 4; ++m) { const unsigned ro = (unsigned)(u.pm * 256 - MP + 128 * ai + 64 * wr + 16 * m + fr) * DM + col0;
#pragma unroll
                    for (int bj = 0; bj < 2; ++bj) { *(f32x4*)(sb + ro + 128 * bj) = acc[ai][bj][m][0]; *(f32x4*)(sb + ro + 128 * bj + 4) = acc[ai][bj][m][1]; } }
            return;
        }
#pragma unroll
        for (int ai = 0; ai < 2; ++ai) {
            const int bs = grp_bs(4 * u.pm + 2 * ai + wr);
            const float* mb = mod + (size_t)bs * 8192;
            f32x4 g1v[2][2], gsv[2][2];
#pragma unroll
            for (int bj = 0; bj < 2; ++bj)
#pragma unroll
                for (int n = 0; n < 2; ++n) { const int c = col0 + 128 * bj + 4 * n; g1v[bj][n] = *(const f32x4*)(mb + 2048 + c);
                    gsv[bj][n] = *(const f32x4*)(ln2 + c) * (*(const f32x4*)(mb + 4096 + c) + 1.0f); }
#pragma unroll
            for (int m = 0; m < 4; ++m) {
                const int row = u.pm * 256 + 128 * ai + 64 * wr + 16 * m + fr;
                const float* xr = row < MP ? xp + (size_t)row * DM : xs + (size_t)(row - MP) * DM;
                float s = 0.f;
#pragma unroll
                for (int bj = 0; bj < 2; ++bj) { f32x4 a[2]; f32x4 xb[2];
#pragma unroll
                    for (int n = 0; n < 2; ++n) { const int c = col0 + 128 * bj + 4 * n; const f32x4 xv = *(const f32x4*)(xr + c); const f32x4 v = xv + g1v[bj][n] * acc[ai][bj][m][n];
                        xb[n] = v; s += (v.x * v.x + v.y * v.y) + (v.z * v.z + v.w * v.w); a[n] = v * gsv[bj][n]; }
                    u32x4 w; w.x = pk2(a[0].x, a[0].y); w.y = pk2(a[0].z, a[0].w); w.z = pk2(a[1].x, a[1].y); w.w = pk2(a[1].z, a[1].w);
                    *(u32x4*)(a2 + (size_t)row * DM + col0 + 128 * bj) = w;
                    w.x = pk2(xb[0].x, xb[0].y); w.y = pk2(xb[0].z, xb[0].w); w.z = pk2(xb[1].x, xb[1].y); w.w = pk2(xb[1].z, xb[1].w);
                    *(u32x4*)(x1 + (size_t)row * DM + col0 + 128 * bj) = w; }
                s += __shfl_xor(s, 16); s += __shfl_xor(s, 32);
                if (fq == 0) ss[(size_t)row * 16 + 4 * u.pn + wc] = s;
            }
        }
    }
};
struct Epi3 {
    static constexpr bool PERM = true, AFTER_DRAIN = false;
    const LAS float* rtab; const float* shw; bf16 *ua, *ub; float* out;
    __device__ __forceinline__ void operator()(AccRef acc, const pg8::Unit& u, int wr, int wc, int fr, int fq) const {
        const unsigned j0 = u.pn * 128 + wc * 32 + 8 * fq, pc0 = u.pn * 256 + wc * 32 + 8 * fq;
#pragma unroll
        for (int ai = 0; ai < 2; ++ai) {
            const unsigned grp = 4 * u.pm + 2 * ai + wr, bs = grp_bs((int)grp);
            const unsigned so = bs * (2 * DFF) + pc0;
            const f32x4 sa0 = *(const f32x4*)(shw + so), sa1 = *(const f32x4*)(shw + so + 4), sb0 = *(const f32x4*)(shw + so + 128), sb1 = *(const f32x4*)(shw + so + 132);
#pragma unroll
            for (int m = 0; m < 4; ++m) {
                const float rstd = rtab[u.seq * 256 + 128 * ai + 64 * wr + 16 * m + fr];
                const unsigned row = grp * 64 + 16 * m + fr;
                const f32x4 a0 = acc[ai][0][m][0] * rstd + sa0, a1 = acc[ai][0][m][1] * rstd + sa1, b0 = acc[ai][1][m][0] * rstd + sb0, b1 = acc[ai][1][m][1] * rstd + sb1;
                u32x4 w; w.x = pk2(a0[0], a0[1]); w.y = pk2(a0[2], a0[3]); w.z = pk2(a1[0], a1[1]); w.w = pk2(a1[2], a1[3]);
                *(u32x4*)(ua + (row * (unsigned)DFF + j0)) = w;
                w.x = pk2(b0[0], b0[1]); w.y = pk2(b0[2], b0[3]); w.z = pk2(b1[0], b1[1]); w.w = pk2(b1[2], b1[3]);
                *(u32x4*)(ub + (row * (unsigned)DFF + j0)) = w;
                if (m == 3 && fr >= 14) {
                    if (grp >= 1024) { float* d = out + OFF_SCONV + ((size_t)(grp - 1024) * 2 + (fr - 14)) * DFF + j0; *(f32x4*)d = a0; *(f32x4*)(d + 4) = a1; }
                    else if ((grp & 31) == 31) { float* d = out + OFF_PCONV + ((size_t)(grp >> 5) * 2 + (fr - 14)) * DFF + j0; *(f32x4*)d = a0; *(f32x4*)(d + 4) = a1; }
                }
            }
        }
    }
};
#ifdef CONV_FUSED
struct Epi3C {
    static constexpr bool PERM = true, AFTER_DRAIN = false;
    const LAS float* rtab; const float *shw, *cw, *cb; bf16* act; float *headA, *headB, *tailA;
    __device__ __forceinline__ void operator()(AccRef acc, const pg8::Unit& u, int wr, int wc, int fr, int fq) const {
        const unsigned j0 = u.pn * 128 + wc * 32 + 8 * fq, pc0 = u.pn * 256 + wc * 32 + 8 * fq;
        f32x4 w0[2], w1[2], w2[2], cbv[2];
#pragma unroll
        for (int n = 0; n < 2; ++n) { w0[n] = *(const f32x4*)(cw + j0 + 4 * n); w1[n] = *(const f32x4*)(cw + DFF + j0 + 4 * n); w2[n] = *(const f32x4*)(cw + 2 * DFF + j0 + 4 * n); cbv[n] = *(const f32x4*)(cb + j0 + 4 * n); }
#pragma unroll
        for (int ai = 0; ai < 2; ++ai) {
            asm volatile("" ::: "memory");
            const unsigned grp = 4 * u.pm + 2 * ai + wr, bs = grp_bs((int)grp);
            const unsigned so = bs * (2 * DFF) + pc0, ho = (grp * 2 + (fr & 1)) * DFF + j0;
            u32x2 ap[4][2], bp[4][2];
            {
                f32x4 sa[2], sb[2];
#pragma unroll
                for (int n = 0; n < 2; ++n) { sa[n] = *(const f32x4*)(shw + so + 4 * n); sb[n] = *(const f32x4*)(shw + so + 128 + 4 * n); }
#pragma unroll
                for (int m = 0; m < 4; ++m) {
                    const float rs = rtab[u.seq * 256 + 128 * ai + 64 * wr + 16 * m + fr];
#pragma unroll
                    for (int n = 0; n < 2; ++n) {
                        const f32x4 av = acc[ai][0][m][n] * rs + sa[n], bv = acc[ai][1][m][n] * rs + sb[n];
                        if (m == 0) { if (fr < 2) { *(f32x4*)(headA + ho + 4 * n) = av; *(f32x4*)(headB + ho + 4 * n) = bv; } }
                        if (m == 3) { if (fr >= 14) *(f32x4*)(tailA + ho + 4 * n) = av; }
                        ap[m][n].x = pk2(av.x, av.y); ap[m][n].y = pk2(av.z, av.w); bp[m][n].x = pk2(bv.x, bv.y); bp[m][n].y = pk2(bv.z, bv.w);
                    }
                }
            }
            asm volatile("" ::: "memory");
#pragma unroll
            for (int n = 0; n < 2; ++n)
#pragma unroll
                for (int h = 0; h < 2; ++h) {
                    unsigned q1 = 0u, q2 = 0u;
#pragma unroll
                    for (int m = 0; m < 4; ++m) {
                        const unsigned a = ap[m][n][h];
                        const unsigned s1 = (unsigned)__builtin_amdgcn_update_dpp((int)a, (int)a, 0x121, 0xf, 0xf, false);
                        const unsigned s2 = (unsigned)__builtin_amdgcn_update_dpp((int)a, (int)a, 0x122, 0xf, 0xf, false);
                        const unsigned pr1 = fr >= 1 ? s1 : q1, pr2 = fr >= 2 ? s2 : q2;
                        q1 = s1; q2 = s2;
                        const float c0 = cbv[n][2 * h] + w0[n][2 * h] * bflo(pr2) + w1[n][2 * h] * bflo(pr1) + w2[n][2 * h] * bflo(a);
                        const float c1 = cbv[n][2 * h + 1] + w0[n][2 * h + 1] * bfhi(pr2) + w1[n][2 * h + 1] * bfhi(pr1) + w2[n][2 * h + 1] * bfhi(a);
                        const unsigned bw = bp[m][n][h];
                        bp[m][n][h] = pk2(silu_f(c0) * bflo(bw), silu_f(c1) * bfhi(bw));
                    }
                    __builtin_amdgcn_sched_barrier(0);
                }
            asm volatile("" ::: "memory");
#pragma unroll
            for (int m = 0; m < 4; ++m) {
                if (m == 0 && fr < 2) continue;
                const unsigned row = grp * 64 + 16 * m + fr;
                const u32x4 w = (u32x4){bp[m][0].x, bp[m][0].y, bp[m][1].x, bp[m][1].y};
                *(u32x4*)(act + (row * (unsigned)DFF + j0)) = w;
            }
        }
    }
};
#endif
struct Epi4 {
    static constexpr bool PERM = true, AFTER_DRAIN = false;
    const float* mod; const bf16* x1; bf16* x2; float* slab;
    __device__ __forceinline__ void operator()(AccRef acc, const pg8::Unit& u, int wr, int wc, int fr, int fq) const {
        const int col0 = u.pn * 256 + wc * 32 + 8 * fq;
        if (u.nt != 0) {
            const int part = u.kt0 == 0 ? 0 : (u.kt0 == 12 ? 1 : (u.kt0 == 24 ? 2 : 3));
            float* sb = slab + (size_t)part * MS * DM;
#pragma unroll
            for (int ai = 0; ai < 2; ++ai)
#pragma unroll
                for (int m = 0; m < 4; ++m) { const unsigned ro = (unsigned)(u.pm * 256 - MP + 128 * ai + 64 * wr + 16 * m + fr) * DM + col0;
#pragma unroll
                    for (int bj = 0; bj < 2; ++bj) { *(f32x4*)(sb + ro + 128 * bj) = acc[ai][bj][m][0]; *(f32x4*)(sb + ro + 128 * bj + 4) = acc[ai][bj][m][1]; } }
            return;
        }
#pragma unroll
        for (int ai = 0; ai < 2; ++ai) {
            const int bs = grp_bs(4 * u.pm + 2 * ai + wr);
            const float* mb = mod + (size_t)bs * 8192 + 5120;
            f32x4 g2v[2][2];
#pragma unroll
            for (int bj = 0; bj < 2; ++bj)
#pragma unroll
                for (int n = 0; n < 2; ++n) g2v[bj][n] = *(const f32x4*)(mb + col0 + 128 * bj + 4 * n);
#pragma unroll
            for (int m = 0; m < 4; ++m) {
                const unsigned ro = (unsigned)(u.pm * 256 + 128 * ai + 64 * wr + 16 * m + fr) * DM + col0;
#pragma unroll
                for (int bj = 0; bj < 2; ++bj) { const u32x4 xw = *(const u32x4*)(x1 + ro + 128 * bj);
                    const f32x4 v0 = (f32x4){bflo(xw.x), bfhi(xw.x), bflo(xw.y), bfhi(xw.y)} + g2v[bj][0] * acc[ai][bj][m][0];
                    const f32x4 v1 = (f32x4){bflo(xw.z), bfhi(xw.z), bflo(xw.w), bfhi(xw.w)} + g2v[bj][1] * acc[ai][bj][m][1];
                    u32x4 w; w.x = pk2(v0.x, v0.y); w.y = pk2(v0.z, v0.w); w.z = pk2(v1.x, v1.y); w.w = pk2(v1.z, v1.w);
                    *(u32x4*)(x2 + ro + 128 * bj) = w; }
            }
        }
    }
};
#define GAS __attribute__((address_space(1)))
#define RLX_AGENT __ATOMIC_RELAXED, __HIP_MEMORY_SCOPE_AGENT
#define XB_TMO      128
#define XB_XCNT(j)  (256  + 64 * (j))
#define XB_XSUB(j)  (1280 + 64 * (j))
#define XB_XGEN(j)  (2304 + 64 * (j))
#define XB_TOP      3328
#define XB_TOPGEN   3392
#define XCD_BAR_WORDS 3456
#define XB_SPIN_CAP (1u << 18)

__device__ __forceinline__ unsigned xb_ld(unsigned* p)              { return __hip_atomic_load(p, __ATOMIC_RELAXED, __HIP_MEMORY_SCOPE_AGENT); }
__device__ __forceinline__ unsigned xb_add(unsigned* p, unsigned v) { return __hip_atomic_fetch_add(p, v, __ATOMIC_RELAXED, __HIP_MEMORY_SCOPE_AGENT); }
__device__ __forceinline__ unsigned xb_xcc_id() { return (unsigned)__builtin_amdgcn_s_getreg((3 << 11) | 20) & 0xFu; }
#define XB_SPIN(cond, bar) do { unsigned _sp = 0; while (cond) { __builtin_amdgcn_s_sleep(1); \
    if ((++_sp & 255u) == 0u) { if (xb_ld(&(bar)[XB_TMO])) break; if (_sp > XB_SPIN_CAP) { atomicAdd(&(bar)[XB_TMO], 1u); break; } } } } while (0)

struct XcdBarrier {
    unsigned* bar; unsigned x;
    volatile LAS unsigned* st;
};

__device__ __forceinline__ XcdBarrier xcd_barrier_post(unsigned* bar, volatile LAS unsigned* st) {
    XcdBarrier b; b.bar = bar; b.x = xb_xcc_id(); b.st = st;
    if (threadIdx.x == 0) (void)xb_add(&bar[XB_XCNT(b.x)], 1u);
    return b;
}
__device__ __forceinline__ void xcd_barrier_complete(unsigned* bar, unsigned x, unsigned& nloc, unsigned& nx) {
    const unsigned G = gridDim.x * gridDim.y * gridDim.z;
    unsigned sum, cnt, mine, sp = 0u;
    for (;;) {
        sum = 0u; cnt = 0u; mine = 0u;
#pragma unroll
        for (unsigned j = 0; j < 16; ++j) { const unsigned c = xb_ld(&bar[XB_XCNT(j)]); sum += c; cnt += (c > 0u) ? 1u : 0u; mine = (j == x) ? c : mine; }
        if (sum == G) break;
        __builtin_amdgcn_s_sleep(1);
        if ((++sp & 255u) == 0u) { if (xb_ld(&bar[XB_TMO])) break; if (sp > XB_SPIN_CAP) { atomicAdd(&bar[XB_TMO], 1u); break; } }
    }
    nloc = mine > 0u ? mine : 1u; nx = cnt > 0u ? cnt : 1u;
}

__device__ __forceinline__ void xcd_barrier(const XcdBarrier& b) {
    asm volatile("s_waitcnt vmcnt(0)" ::: "memory");
    __syncthreads();
    if (threadIdx.x == 0) {
        unsigned* bar = b.bar;
        __builtin_amdgcn_s_waitcnt(0);
        unsigned nloc = b.st[0], nx = b.st[1];
        if (nloc == 0u) { xcd_barrier_complete(bar, b.x, nloc, nx); b.st[0] = nloc; b.st[1] = nx; }
        const unsigned old = xb_add(&bar[XB_XSUB(b.x)], 1u);
        const unsigned gen = old / nloc;
        if (old + 1u == (gen + 1u) * nloc) {
            __builtin_amdgcn_fence(__ATOMIC_RELEASE, "agent");
            asm volatile("s_waitcnt vmcnt(0)" ::: "memory");
            const unsigned og = xb_add(&bar[XB_TOP], 1u);
            const unsigned tg = og / nx;
            if (og + 1u == (tg + 1u) * nx) xb_add(&bar[XB_TOPGEN], 1u);
            else XB_SPIN(xb_ld(&bar[XB_TOPGEN]) == tg, bar);
            __builtin_amdgcn_fence(__ATOMIC_ACQUIRE, "agent");
            xb_add(&bar[XB_XGEN(b.x)], 1u);
            asm volatile("s_waitcnt vmcnt(0)" ::: "memory");
        } else {
            XB_SPIN(xb_ld(&bar[XB_XGEN(b.x)]) == gen, bar);
            __builtin_amdgcn_fence(__ATOMIC_ACQUIRE, "agent");
            asm volatile("s_waitcnt vmcnt(0)" ::: "memory");
        }
    }
    __syncthreads();
}
#define MFMA16(a, b, c) __builtin_amdgcn_mfma_f32_16x16x32_bf16((a), (b), (c), 0, 0, 0)
constexpr int RQ = 0, RK = 17408, RKT = 34816, RVT = 53248, RP = 71680, RST = 80896, RO = 115712;
__device__ __forceinline__ void ret_item(const Params& P, LAS unsigned char* lds, int tid, int wave, int lane, int h, int row0, int nchunks, const float* st_in, bool has_in, float* st_out) {
    const bf16* proj = (const bf16*)(P.ws + WS_R1);
    bf16* mix = (bf16*)(P.ws + WS_R2);
    const int fr = lane & 15, fq = lane >> 4;
    const float lg2 = log2f(1.0f - exp2f(-5.0f - (float)h));
    const float kscale = 0.08838834764831845f;
    LAS bf16* Qs = (LAS bf16*)(lds + RQ); LAS bf16* Ks = (LAS bf16*)(lds + RK); LAS bf16* KT = (LAS bf16*)(lds + RKT); LAS bf16* VT = (LAS bf16*)(lds + RVT);
    LAS bf16* Ps = (LAS bf16*)(lds + RP); LAS bf16* ST = (LAS bf16*)(lds + RST); LAS float* Os = (LAS float*)(lds + RO);
    f32x4 st[8];
#pragma unroll
    for (int et = 0; et < 8; ++et) {
        f32x4 v;
#pragma unroll
        for (int r = 0; r < 4; ++r) v[r] = st_in[(size_t)(16 * wave + 4 * fq + r) * 128 + 16 * et + fr];
        asm volatile("" : "+v"(v));
#pragma unroll
        for (int r = 0; r < 4; ++r) v[r] = has_in ? v[r] : 0.f;
        st[et] = v;
    }
    __syncthreads();
#pragma unroll
    for (int et = 0; et < 8; ++et) { u32x2 w; w.x = pk2(st[et][0], st[et][1]); w.y = pk2(st[et][2], st[et][3]); *(LAS u32x2*)(ST + (16 * et + fr) * 136 + 16 * wave + 4 * fq) = w; }
    const size_t goff = (size_t)lane * INW + h * 128 + wave * 16;
    u32x4 pq[2], pk[2], pv[2];
    { const bf16* g = proj + (size_t)row0 * INW + goff;
      pq[0] = *(const u32x4*)(g); pq[1] = *(const u32x4*)(g + 8); pk[0] = *(const u32x4*)(g + 512); pk[1] = *(const u32x4*)(g + 520); pv[0] = *(const u32x4*)(g + 1024); pv[1] = *(const u32x4*)(g + 1032); }
    const float kf = kscale * exp2f(lg2 * (float)(63 - lane));
    const float g64 = exp2f(lg2 * 64.0f);
    for (int c = 0; c < nchunks; ++c) {
        const int rowc = row0 + 64 * c;
        *(LAS u32x4*)(Qs + lane * 136 + wave * 16) = pq[0]; *(LAS u32x4*)(Qs + lane * 136 + wave * 16 + 8) = pq[1];
        *(LAS u32x4*)(Ks + lane * 136 + wave * 16) = pk[0]; *(LAS u32x4*)(Ks + lane * 136 + wave * 16 + 8) = pk[1];
#pragma unroll
        for (int i = 0; i < 2; ++i)
#pragma unroll
            for (int j = 0; j < 4; ++j) { const unsigned wk = pk[i][j], wv = pv[i][j]; const int d = wave * 16 + i * 8 + j * 2;
                const unsigned kk = pk2(bflo(wk) * kf, bfhi(wk) * kf);
                KT[(d) * 72 + lane] = (bf16)(kk & 0xffffu); KT[(d + 1) * 72 + lane] = (bf16)(kk >> 16);
                VT[(d) * 72 + lane] = (bf16)(wv & 0xffffu); VT[(d + 1) * 72 + lane] = (bf16)(wv >> 16); }
        if (c + 1 < nchunks) { const bf16* g = proj + (size_t)(rowc + 64) * INW + goff;
            pq[0] = *(const u32x4*)(g); pq[1] = *(const u32x4*)(g + 8); pk[0] = *(const u32x4*)(g + 512); pk[1] = *(const u32x4*)(g + 520); pv[0] = *(const u32x4*)(g + 1024); pv[1] = *(const u32x4*)(g + 1032); }
        __syncthreads();
        { const int mi = wave >> 1;
#pragma unroll
          for (int jj = 0; jj < 2; ++jj) { const int lj = 2 * (wave & 1) + jj; f32x4 s = (f32x4){0.f, 0.f, 0.f, 0.f};
#pragma unroll
            for (int ks = 0; ks < 4; ++ks) { const bf16x8 a = *(const LAS bf16x8*)(Ks + (16 * mi + fr) * 136 + 32 * ks + 8 * fq), b = *(const LAS bf16x8*)(Qs + (16 * lj + fr) * 136 + 32 * ks + 8 * fq); s = MFMA16(a, b, s); }
            const int l = 16 * lj + fr; float pvv[4];
#pragma unroll
            for (int r = 0; r < 4; ++r) { const int m = 16 * mi + 4 * fq + r; const int dlt = l - m; pvv[r] = dlt >= 0 ? s[r] * kscale * exp2f(lg2 * (float)dlt) : 0.f; }
            u32x2 w; w.x = pk2(pvv[0], pvv[1]); w.y = pk2(pvv[2], pvv[3]); *(LAS u32x2*)(Ps + l * 72 + 16 * mi + 4 * fq) = w; } }
#pragma unroll
        for (int et = 0; et < 8; ++et) st[et] = st[et] * g64;
#pragma unroll
        for (int ks = 0; ks < 2; ++ks) { const bf16x8 a = *(const LAS bf16x8*)(KT + (16 * wave + fr) * 72 + 32 * ks + 8 * fq);
#pragma unroll
            for (int et = 0; et < 8; ++et) { const bf16x8 b = *(const LAS bf16x8*)(VT + (16 * et + fr) * 72 + 32 * ks + 8 * fq); st[et] = MFMA16(a, b, st[et]); } }
        __syncthreads();
        { f32x4 oi[4], oc[4];
#pragma unroll
          for (int lt = 0; lt < 4; ++lt) { oi[lt] = (f32x4){0.f, 0.f, 0.f, 0.f}; oc[lt] = (f32x4){0.f, 0.f, 0.f, 0.f}; }
#pragma unroll
          for (int ks = 0; ks < 2; ++ks) { const bf16x8 b = *(const LAS bf16x8*)(VT + (16 * wave + fr) * 72 + 32 * ks + 8 * fq);
#pragma unroll
            for (int lt = 0; lt < 4; ++lt) { const bf16x8 a = *(const LAS bf16x8*)(Ps + (16 * lt + fr) * 72 + 32 * ks + 8 * fq); oi[lt] = MFMA16(a, b, oi[lt]); } }
#pragma unroll
          for (int ks = 0; ks < 4; ++ks) { const bf16x8 b = *(const LAS bf16x8*)(ST + (16 * wave + fr) * 136 + 32 * ks + 8 * fq);
#pragma unroll
            for (int lt = 0; lt < 4; ++lt) { const bf16x8 a = *(const LAS bf16x8*)(Qs + (16 * lt + fr) * 136 + 32 * ks + 8 * fq); oc[lt] = MFMA16(a, b, oc[lt]); } }
#pragma unroll
          for (int lt = 0; lt < 4; ++lt)
#pragma unroll
            for (int r = 0; r < 4; ++r) { const int l = 16 * lt + 4 * fq + r; Os[l * 132 + 16 * wave + fr] = oi[lt][r] + exp2f(lg2 * (float)(l + 1)) * oc[lt][r]; } }
        __syncthreads();
#pragma unroll
        for (int et = 0; et < 8; ++et) { u32x2 w; w.x = pk2(st[et][0], st[et][1]); w.y = pk2(st[et][2], st[et][3]); *(LAS u32x2*)(ST + (16 * et + fr) * 136 + 16 * wave + 4 * fq) = w; }
        { unsigned gv[8];
#pragma unroll
          for (int i = 0; i < 8; ++i) gv[i] = *(const unsigned*)(proj + (size_t)(rowc + 8 * wave + i) * INW + 1536 + h * 128 + 2 * lane);
#pragma unroll
          for (int i = 0; i < 8; ++i) { const int l = 8 * wave + i; const f32x2 o = *(const LAS f32x2*)(Os + l * 132 + 2 * lane);
            const float ssq = wave_sum_dpp(o.x * o.x + o.y * o.y); const float rstd = rsqrtf(ssq * (1.f / 128.f) + EPS);
            const float g0 = bflo(gv[i]), g1 = bfhi(gv[i]);
            *(unsigned*)(mix + (size_t)(rowc + l) * DM + h * 128 + 2 * lane) = pk2(silu_f(g0) * o.x * rstd, silu_f(g1) * o.y * rstd); } }
    }
#pragma unroll
    for (int et = 0; et < 8; ++et)
#pragma unroll
        for (int r = 0; r < 4; ++r) st_out[(size_t)(16 * wave + 4 * fq + r) * 128 + 16 * et + fr] = st[et][r];
}
constexpr int AK = 0, AVT = 27648;
__device__ __forceinline__ void att_item(const Params& P, LAS unsigned char* lds, int tid, int wave, int lane, bool sample, int b, int n, int g) {
    const bf16* proj = (const bf16*)(P.ws + WS_R1);
    bf16* mix = (bf16*)(P.ws + WS_R2);
    const int fr = lane & 15, fq = lane >> 4;
    LAS bf16* Kl = (LAS bf16*)(lds + AK); LAS bf16* VTl = (LAS bf16*)(lds + AVT);
    const int qrow0 = sample ? MP + 64 * b : b * SEQ + 64 * n;
    const int jmin = sample ? 0 : (n >= 2 ? 0 : 64 * (2 - n));
    __syncthreads();
    {
        u32x4 kw[3], vw[3];
        if (!sample) {
#pragma unroll
            for (int i = 0; i < 3; ++i) { const bool ok = 64 * i >= jmin;
                const int rb = ok ? b * SEQ + 64 * (n - 2) + 64 * i : qrow0;
                kw[i] = *(const u32x4*)(proj + (size_t)(rb + (tid >> 3)) * INW + 2560 + g * 64 + 8 * (tid & 7));
                vw[i] = *(const u32x4*)(proj + (size_t)(rb + lane) * INW + 2688 + g * 64 + 8 * wave);
                if (!ok) { kw[i] = (u32x4){0u, 0u, 0u, 0u}; vw[i] = (u32x4){0u, 0u, 0u, 0u}; } }
        } else {
            f32x4 kc[2][2], vc[2][2];
#pragma unroll
            for (int i = 0; i < 2; ++i) { const float* sk = P.cache_k + ((size_t)(b * 128 + 64 * i + (tid >> 3)) * 2 + g) * 64 + 8 * (tid & 7); const float* sv = P.cache_v + ((size_t)(b * 128 + 64 * i + lane) * 2 + g) * 64 + 8 * wave;
                kc[i][0] = *(const f32x4*)sk; kc[i][1] = *(const f32x4*)(sk + 4); vc[i][0] = *(const f32x4*)sv; vc[i][1] = *(const f32x4*)(sv + 4); }
            kw[2] = *(const u32x4*)(proj + (size_t)(MP + 64 * b + (tid >> 3)) * INW + 2560 + g * 64 + 8 * (tid & 7));
            vw[2] = *(const u32x4*)(proj + (size_t)(MP + 64 * b + lane) * INW + 2688 + g * 64 + 8 * wave);
#pragma unroll
            for (int i = 0; i < 2; ++i) { kw[i].x = pk2(kc[i][0].x, kc[i][0].y); kw[i].y = pk2(kc[i][0].z, kc[i][0].w); kw[i].z = pk2(kc[i][1].x, kc[i][1].y); kw[i].w = pk2(kc[i][1].z, kc[i][1].w);
                vw[i].x = pk2(vc[i][0].x, vc[i][0].y); vw[i].y = pk2(vc[i][0].z, vc[i][0].w); vw[i].z = pk2(vc[i][1].x, vc[i][1].y); vw[i].w = pk2(vc[i][1].z, vc[i][1].w); }
        }
#pragma unroll
        for (int i = 0; i < 3; ++i) { *(LAS u32x4*)(Kl + (64 * i + (tid >> 3)) * 72 + 8 * (tid & 7)) = kw[i];
            const int j = 64 * i + lane;
#pragma unroll
            for (int e = 0; e < 4; ++e) { VTl[(8 * wave + 2 * e) * 200 + j] = (bf16)(vw[i][e] & 0xffffu); VTl[(8 * wave + 2 * e + 1) * 200 + j] = (bf16)(vw[i][e] >> 16); } }
    }
    const int r = wave >> 1, qh = wave & 1, head = 4 * g + r;
    const float slope = exp2f(-(float)(head + 1));
    const float sink = P.sinks[head];
    const float L2E = 1.4426950408889634f;
    __syncthreads();
#pragma unroll 1
    for (int qt = 0; qt < 2; ++qt) {
        asm volatile("" ::: "memory");
        const int qi = 32 * qh + 16 * qt + fr;
        bf16x8 qf[2];
#pragma unroll
        for (int ks = 0; ks < 2; ++ks) qf[ks] = *(const bf16x8*)(proj + (size_t)(qrow0 + qi) * INW + 2048 + head * 64 + 32 * ks + 8 * fq);
        f32x4 s[12];
#pragma unroll
        for (int kt = 0; kt < 12; ++kt) { s[kt] = (f32x4){0.f, 0.f, 0.f, 0.f};
#pragma unroll
            for (int ks = 0; ks < 2; ++ks) { const bf16x8 a = *(const LAS bf16x8*)(Kl + (16 * kt + fr) * 72 + 32 * ks + 8 * fq); s[kt] = MFMA16(a, qf[ks], s[kt]); } }
        float mx = sink;
#pragma unroll
        for (int kt = 0; kt < 12; ++kt)
#pragma unroll
            for (int rr = 0; rr < 4; ++rr) { const int j = 16 * kt + 4 * fq + rr; const int dist = 128 + qi - j;
                float v = s[kt][rr] * 0.125f - slope * fabsf((float)dist);
                v = j >= jmin ? v : -INFINITY; s[kt][rr] = v; mx = fmaxf(mx, v); }
        mx = fmaxf(mx, __shfl_xor(mx, 16)); mx = fmaxf(mx, __shfl_xor(mx, 32));
        float ls = 0.f;
#pragma unroll
        for (int kt = 0; kt < 12; ++kt)
#pragma unroll
            for (int rr = 0; rr < 4; ++rr) { const float p = exp2f((s[kt][rr] - mx) * L2E); s[kt][rr] = p; ls += p; }
        ls += __shfl_xor(ls, 16); ls += __shfl_xor(ls, 32);
        const float inv = 1.0f / (ls + exp2f((sink - mx) * L2E));
        f32x4 o[4];
#pragma unroll
        for (int dt = 0; dt < 4; ++dt) o[dt] = (f32x4){0.f, 0.f, 0.f, 0.f};
#pragma unroll
        for (int kk = 0; kk < 6; ++kk) {
            u32x4 w; w.x = pk2(s[2 * kk][0], s[2 * kk][1]); w.y = pk2(s[2 * kk][2], s[2 * kk][3]); w.z = pk2(s[2 * kk + 1][0], s[2 * kk + 1][1]); w.w = pk2(s[2 * kk + 1][2], s[2 * kk + 1][3]);
            const bf16x8 pb = __builtin_bit_cast(bf16x8, w);
#pragma unroll
            for (int dt = 0; dt < 4; ++dt) { const LAS bf16* vp = VTl + (16 * dt + fr) * 200 + 32 * kk + 4 * fq;
                const u32x2 lo = *(const LAS u32x2*)vp, hi = *(const LAS u32x2*)(vp + 16);
                const u32x4 aw = (u32x4){lo.x, lo.y, hi.x, hi.y}; const bf16x8 a = __builtin_bit_cast(bf16x8, aw);
                o[dt] = MFMA16(a, pb, o[dt]); }
        }
        bf16* mp = mix + (size_t)(qrow0 + qi) * DM + 512 + head * 64 + 4 * fq;
#pragma unroll
        for (int dt = 0; dt < 4; ++dt) { const f32x4 v = o[dt] * inv; u32x2 w; w.x = pk2(v[0], v[1]); w.y = pk2(v[2], v[3]); *(u32x2*)(mp + 16 * dt) = w; }
    }
}
__device__ __forceinline__ void phase3(const Params& P, LAS unsigned char* lds, int tid, int wave, int lane) {
    const int G = gridDim.x, NR = G / 2, blk = blockIdx.x;
    if (blk < NR) {
#ifndef NO_RET
#ifdef PROBE_RETX2
        for (int rep = 0; rep < 2; ++rep)
#endif
        for (int it = blk; it < 256; it += NR) {
            const bool sample = it >= 128; const int bh = it & 127, b = bh >> 2, h = bh & 3;
            ret_item(P, lds, tid, wave, lane, h, sample ? MP + 64 * b : b * SEQ, sample ? 1 : 32, P.state_ret + (size_t)bh * 16384, sample, P.out + (sample ? OFF_SRET : OFF_PRET) + (size_t)bh * 16384);
        }
#endif
    } else {
#ifndef NO_ATT
#ifdef PROBE_ATTX2
        for (int rep = 0; rep < 2; ++rep)
#endif
        for (int it = blk - NR; it < 2112; it += G - NR) {
            const bool sample = it >= 2048;
            att_item(P, lds, tid, wave, lane, sample, sample ? (it - 2048) >> 1 : it >> 6, sample ? 2 : (it >> 1) & 31, it & 1);
        }
#endif
    }
}

__device__ __forceinline__ void phase6(const Params& P, int tid) {
    const bf16* ua = (const bf16*)(P.ws + WS_R1); bf16* ub = (bf16*)(P.ws + WS_R2);
    constexpr int CH = DFF / 8;
    const int total = MT * CH;
    for (int idx = blockIdx.x * 512 + tid; idx < total; idx += gridDim.x * 512) {
        const int row = idx / CH, j = (idx - row * CH) * 8;
        const bool smp = row >= MP; const int t = smp ? ((row - MP) & 63) : (row & 2047);
        float a[8], p1[8], p2[8], bb[8];
        unpack8(*(const u32x4*)(ua + (size_t)row * DFF + j), a);
        unpack8(*(const u32x4*)(ub + (size_t)row * DFF + j), bb);
        if (t >= 1) unpack8(*(const u32x4*)(ua + (size_t)(row - 1) * DFF + j), p1);
        else if (smp) { const float* s = P.state_conv + ((size_t)((row - MP) >> 6) * 2 + 1) * DFF + j; const f32x4 x = *(const f32x4*)s, y = *(const f32x4*)(s + 4); p1[0] = x.x; p1[1] = x.y; p1[2] = x.z; p1[3] = x.w; p1[4] = y.x; p1[5] = y.y; p1[6] = y.z; p1[7] = y.w; }
        else {
#pragma unroll
            for (int e = 0; e < 8; ++e) p1[e] = 0.f; }
        if (t >= 2) unpack8(*(const u32x4*)(ua + (size_t)(row - 2) * DFF + j), p2);
        else if (smp) { const float* s = P.state_conv + ((size_t)((row - MP) >> 6) * 2 + t) * DFF + j; const f32x4 x = *(const f32x4*)s, y = *(const f32x4*)(s + 4); p2[0] = x.x; p2[1] = x.y; p2[2] = x.z; p2[3] = x.w; p2[4] = y.x; p2[5] = y.y; p2[6] = y.z; p2[7] = y.w; }
        else {
#pragma unroll
            for (int e = 0; e < 8; ++e) p2[e] = 0.f; }
        float r[8];
#pragma unroll
        for (int h = 0; h < 2; ++h) { const f32x4 w0 = *(const f32x4*)(P.conv_w + j + 4 * h), w1 = *(const f32x4*)(P.conv_w + DFF + j + 4 * h), w2 = *(const f32x4*)(P.conv_w + 2 * DFF + j + 4 * h), cb = *(const f32x4*)(P.conv_b + j + 4 * h);
#pragma unroll
            for (int e = 0; e < 4; ++e) { const float cv = cb[e] + w0[e] * p2[4 * h + e] + w1[e] * p1[4 * h + e] + w2[e] * a[4 * h + e]; r[4 * h + e] = silu_f(cv) * bb[4 * h + e]; } }
        u32x4 w; w.x = pk2(r[0], r[1]); w.y = pk2(r[2], r[3]); w.z = pk2(r[4], r[5]); w.w = pk2(r[6], r[7]);
        *(u32x4*)(ub + (size_t)row * DFF + j) = w;
    }
}
#ifdef CONV_FUSED
__device__ __forceinline__ void phase6c(const Params& P, int tid) {
    const float* headA = (const float*)(P.ws + WS_R1); const float* headB = headA + HT_STRIDE; const float* tailA = headA + 2 * HT_STRIDE;
    bf16* act = (bf16*)(P.ws + WS_R2);
    const int total = NGRP * DFF;
    for (int idx = blockIdx.x * 512 + tid; idx < total; idx += gridDim.x * 512) {
        const int g = idx / DFF, j = idx - g * DFF;
        float p0, p1;
        if (g < 1024) { if ((g & 31) == 0) { p0 = 0.f; p1 = 0.f; } else { p0 = tailA[((size_t)(g - 1) * 2) * DFF + j]; p1 = tailA[((size_t)(g - 1) * 2 + 1) * DFF + j]; } }
        else { p0 = P.state_conv[((size_t)(g - 1024) * 2) * DFF + j]; p1 = P.state_conv[((size_t)(g - 1024) * 2 + 1) * DFF + j]; }
        const float a0 = headA[((size_t)g * 2) * DFF + j], a1 = headA[((size_t)g * 2 + 1) * DFF + j];
        const float b0 = headB[((size_t)g * 2) * DFF + j], b1 = headB[((size_t)g * 2 + 1) * DFF + j];
        const float w0 = P.conv_w[j], w1 = P.conv_w[DFF + j], w2 = P.conv_w[2 * DFF + j], cb = P.conv_b[j];
        const float c0 = cb + w0 * p0 + w1 * p1 + w2 * a0, c1 = cb + w0 * p1 + w1 * a0 + w2 * a1;
        act[(size_t)(64 * g) * DFF + j] = (bf16)(pk2(silu_f(c0) * b0, 0.f) & 0xffffu);
        act[(size_t)(64 * g + 1) * DFF + j] = (bf16)(pk2(silu_f(c1) * b1, 0.f) & 0xffffu);
        const float t0 = tailA[((size_t)g * 2) * DFF + j], t1 = tailA[((size_t)g * 2 + 1) * DFF + j];
        if (g < 1024) { if ((g & 31) == 31) { P.out[OFF_PCONV + ((size_t)(g >> 5) * 2) * DFF + j] = t0; P.out[OFF_PCONV + ((size_t)(g >> 5) * 2 + 1) * DFF + j] = t1; } }
        else { P.out[OFF_SCONV + ((size_t)(g - 1024) * 2) * DFF + j] = t0; P.out[OFF_SCONV + ((size_t)(g - 1024) * 2 + 1) * DFF + j] = t1; }
    }
}
#endif
__device__ __forceinline__ void phase8n(const Params& P, LAS unsigned char* lds, int tid, int wave, int lane) {
    const float* mod = (const float*)(P.ws + WS_MOD); const bf16* x2 = (const bf16*)(P.ws + WS_R0);
    LAS float* lv = (LAS float*)lds;
    const int b = blockIdx.x, bsP = b >> 3, bsS = 32 + (b >> 3);
    __syncthreads();
    for (int i = tid; i < 4096; i += 512) { const int sl = i >> 11, which = (i >> 10) & 1, col = i & 1023; const float* mb = mod + (size_t)(sl ? bsS : bsP) * 8192 + 6144;
        lv[i] = which ? P.normf[col] * (1.f + mb[1024 + col]) : mb[col]; }
    __syncthreads();
#pragma unroll 4
    for (int r = wave; r < 256; r += 8) {
        const int row = 256 * b + r;
        const bf16* xr = x2 + (size_t)row * DM + 4 * lane;
        f32x4 v[4]; float ss = 0.f;
#pragma unroll
        for (int j = 0; j < 4; ++j) { const u32x2 w = *(const u32x2*)(xr + 256 * j); v[j] = (f32x4){bflo(w.x), bfhi(w.x), bflo(w.y), bfhi(w.y)};
            ss += (v[j].x * v[j].x + v[j].y * v[j].y) + (v[j].z * v[j].z + v[j].w * v[j].w); }
        const float rstd = __builtin_amdgcn_rsqf(wave_sum_dpp(ss) * (1.f / DM) + EPS);
        float* yr = P.out + (size_t)row * DM + 4 * lane;
#pragma unroll
        for (int j = 0; j < 4; ++j) { const f32x4 sh = *(const LAS f32x4*)(lv + 256 * j + 4 * lane), gs = *(const LAS f32x4*)(lv + 1024 + 256 * j + 4 * lane);
            *(f32x4*)(yr + 256 * j) = v[j] * rstd * gs + sh; }
    }
    {
        const int r = 8 * b + wave, row = MP + r;
        const bf16* xr = (const bf16*)(P.ws + WS_X1B) + (size_t)row * DM + 4 * lane;
        const float* sl = (const float*)(P.ws + WS_SLAB) + (size_t)r * DM + 4 * lane;
        const float* g2 = mod + (size_t)bsS * 8192 + 5120 + 4 * lane;
        f32x4 v[4]; float ss = 0.f;
#pragma unroll
        for (int j = 0; j < 4; ++j) { const u32x2 w = *(const u32x2*)(xr + 256 * j); f32x4 a = *(const f32x4*)(sl + 256 * j);
#pragma unroll
            for (int p = 1; p < 4; ++p) a += *(const f32x4*)(sl + (size_t)p * MS * DM + 256 * j);
            v[j] = (f32x4){bflo(w.x), bfhi(w.x), bflo(w.y), bfhi(w.y)} + *(const f32x4*)(g2 + 256 * j) * a;
            ss += (v[j].x * v[j].x + v[j].y * v[j].y) + (v[j].z * v[j].z + v[j].w * v[j].w); }
        const float rstd = __builtin_amdgcn_rsqf(wave_sum_dpp(ss) * (1.f / DM) + EPS);
        float* yr = P.out + (size_t)row * DM + 4 * lane;
#pragma unroll
        for (int j = 0; j < 4; ++j) { const f32x4 sh = *(const LAS f32x4*)(lv + 2048 + 256 * j + 4 * lane), gs = *(const LAS f32x4*)(lv + 3072 + 256 * j + 4 * lane);
            *(f32x4*)(yr + 256 * j) = v[j] * rstd * gs + sh; }
    }
}
__device__ __forceinline__ void phase8(const Params& P, int wave, int lane) {
    const float* mod = (const float*)(P.ws + WS_MOD); const bf16* x2 = (const bf16*)(P.ws + WS_R0);
    const int gw = blockIdx.x * 8 + wave, NGW = gridDim.x * 8;
#pragma unroll 2
    for (int row = gw; row < MT; row += NGW) {
        const int bs = row < MP ? (row >> 11) : 32 + ((row - MP) >> 6);
        float* yr = P.out + (size_t)row * DM + 8 * lane;
        const float* mb = mod + (size_t)bs * 8192 + 6144 + 8 * lane;
        float v[2][8]; float ss = 0.f;
        if (row < MP) {
            const bf16* xr = x2 + (size_t)row * DM + 8 * lane;
#pragma unroll
            for (int j = 0; j < 2; ++j) unpack8(*(const u32x4*)(xr + 512 * j), v[j]);
        } else {
            const bf16* xr = (const bf16*)(P.ws + WS_X1B) + (size_t)row * DM + 8 * lane;
            const float* sl = (const float*)(P.ws + WS_SLAB) + (size_t)(row - MP) * DM + 8 * lane;
            const float* g2 = mod + (size_t)bs * 8192 + 5120 + 8 * lane;
#pragma unroll
            for (int j = 0; j < 2; ++j) { unpack8(*(const u32x4*)(xr + 512 * j), v[j]);
#pragma unroll
                for (int h = 0; h < 2; ++h) { const int o = 512 * j + 4 * h; f32x4 a = *(const f32x4*)(sl + o);
#pragma unroll
                    for (int p = 1; p < 4; ++p) a += *(const f32x4*)(sl + (size_t)p * MS * DM + o);
                    const f32x4 g = *(const f32x4*)(g2 + o);
#pragma unroll
                    for (int e = 0; e < 4; ++e) v[j][4 * h + e] += g[e] * a[e]; } }
        }
#pragma unroll
        for (int j = 0; j < 2; ++j)
#pragma unroll
            for (int e = 0; e < 8; ++e) ss += v[j][e] * v[j][e];
        const float rstd = rsqrtf(wave_sum(ss) * (1.f / DM) + EPS);
#pragma unroll
        for (int j = 0; j < 2; ++j)
#pragma unroll
            for (int h = 0; h < 2; ++h) { const int o = 512 * j + 4 * h; const f32x4 sh = *(const f32x4*)(mb + o), sc = *(const f32x4*)(mb + 1024 + o), gn = *(const f32x4*)(P.normf + 8 * lane + o);
                const f32x4 x = (f32x4){v[j][4 * h], v[j][4 * h + 1], v[j][4 * h + 2], v[j][4 * h + 3]};
                *(f32x4*)(yr + o) = x * rstd * gn * (sc + 1.0f) + sh; }
    }
}
__device__ __forceinline__ void phase8q(const Params& P, LAS unsigned char* lds, int tid, int wave, int lane) {
    const float* mod = (const float*)(P.ws + WS_MOD);
    unsigned* cnt = (unsigned*)(P.ws + WS_CNT7); unsigned* ticket = (unsigned*)(P.ws + WS_TICKET);
    LAS int* ord = (LAS int*)(lds + 131072);
    LAS int* flag = ord + 272;
    pg8::StaticOrder S; S.init(MT, DM, (int)gridDim.x, 0);
    for (int i = tid; i < NTM; i += 512) flag[i] = 0;
    __syncthreads();
    { const int full = (S.nwg / S.G) * S.G; for (int L = full + tid; L < S.nwg; L += 512) { pg8::Unit u; S.map(L, u); flag[u.pm] = 1; } }
    __syncthreads();
    if (tid == 0) { int k = 0; for (int i = 0; i < NTM; ++i) if (!flag[i]) ord[k++] = i; for (int i = 0; i < NTM; ++i) if (flag[i]) ord[k++] = i; }
    __syncthreads();
    for (;;) {
        if (tid == 0) flag[268] = (int)__hip_atomic_fetch_add(ticket, 1u, __ATOMIC_RELAXED, __HIP_MEMORY_SCOPE_AGENT);
        __syncthreads();
        const int tk = flag[268];
        if (tk >= NTM * 4) break;
        const int pm = ord[tk >> 2], rb = tk & 3;
        if (wave == 0) {
            unsigned spins = 0;
            while ((unsigned)__builtin_amdgcn_readfirstlane(__hip_atomic_load(cnt + 64 * pm, __ATOMIC_RELAXED, __HIP_MEMORY_SCOPE_AGENT)) < 32u) { __builtin_amdgcn_s_sleep(4); if (++spins > (1u << 22)) break; }
            __builtin_amdgcn_fence(__ATOMIC_ACQUIRE, "agent");
            asm volatile("s_waitcnt vmcnt(0)" ::: "memory");
        }
        __syncthreads();
#pragma unroll 2
        for (int i = 0; i < 8; ++i) {
            const int row = pm * 256 + rb * 64 + wave * 8 + i;
            const int bs = row < MP ? (row >> 11) : 32 + ((row - MP) >> 6);
            float* yr = P.out + (size_t)row * DM + 4 * lane;
            const float* mb = mod + (size_t)bs * 8192 + 6144 + 4 * lane;
            f32x4 v[4]; float ss = 0.f;
#pragma unroll
            for (int j = 0; j < 4; ++j) { v[j] = *(const f32x4*)(yr + 256 * j); ss += (v[j].x * v[j].x + v[j].y * v[j].y) + (v[j].z * v[j].z + v[j].w * v[j].w); }
            const float rstd = rsqrtf(wave_sum(ss) * (1.f / DM) + EPS);
#pragma unroll
            for (int j = 0; j < 4; ++j) { const f32x4 sh = *(const f32x4*)(mb + 256 * j), sc = *(const f32x4*)(mb + 1024 + 256 * j), gn = *(const f32x4*)(P.normf + 4 * lane + 256 * j);
                *(f32x4*)(yr + 256 * j) = v[j] * rstd * gn * (sc + 1.0f) + sh; }
        }
    }
}

__device__ __forceinline__ void sample_fix(const Params& P, int wave, int lane) {
    const float* mod = (const float*)(P.ws + WS_MOD); const float* sl0 = (const float*)(P.ws + WS_SLAB4);
    bf16* a2 = (bf16*)(P.ws + WS_R0); bf16* x1b = (bf16*)(P.ws + WS_X1B); float* ss1 = (float*)(P.ws + WS_SS1);
    const int gw = blockIdx.x * 8 + wave, NGW = gridDim.x * 8;
    for (int r = gw; r < MS; r += NGW) {
        const int row = MP + r, bs = 32 + (r >> 6);
        const float* xr = P.x_s + (size_t)r * DM + 8 * lane; const float* sl = sl0 + (size_t)r * DM + 8 * lane; const float* mb = mod + (size_t)bs * 8192 + 8 * lane;
        float v[2][8], a[2][8]; float ss = 0.f;
#pragma unroll
        for (int j = 0; j < 2; ++j)
#pragma unroll
            for (int h = 0; h < 2; ++h) { const int o = 512 * j + 4 * h; f32x4 acc = *(const f32x4*)(sl + o);
#pragma unroll
                for (int p = 1; p < 4; ++p) acc += *(const f32x4*)(sl + (size_t)p * MS * DM + o);
                const f32x4 x = *(const f32x4*)(xr + o) + *(const f32x4*)(mb + 2048 + o) * acc;
                const f32x4 gs = *(const f32x4*)(P.ln2 + 8 * lane + o) * (*(const f32x4*)(mb + 4096 + o) + 1.0f);
#pragma unroll
                for (int e = 0; e < 4; ++e) { v[j][4 * h + e] = x[e]; a[j][4 * h + e] = x[e] * gs[e]; ss += x[e] * x[e]; } }
        ss = wave_sum(ss);
#pragma unroll
        for (int j = 0; j < 2; ++j) { u32x4 w; w.x = pk2(v[j][0], v[j][1]); w.y = pk2(v[j][2], v[j][3]); w.z = pk2(v[j][4], v[j][5]); w.w = pk2(v[j][6], v[j][7]);
            *(u32x4*)(x1b + (size_t)row * DM + 8 * lane + 512 * j) = w;
            w.x = pk2(a[j][0], a[j][1]); w.y = pk2(a[j][2], a[j][3]); w.z = pk2(a[j][4], a[j][5]); w.w = pk2(a[j][6], a[j][7]);
            *(u32x4*)(a2 + (size_t)row * DM + 8 * lane + 512 * j) = w; }
        if (lane < 16) ss1[(size_t)row * 16 + lane] = lane == 0 ? ss : 0.f;
    }
}

#ifndef N_LAUNCH
#define N_LAUNCH 1
#endif
#define LAUNDER_TID() int tid = threadIdx.x; asm volatile("" : "+v"(tid)); const int lane = tid & 63, wave = __builtin_amdgcn_readfirstlane(tid >> 6); (void)lane; (void)wave
template <int PHM>
__global__ void __launch_bounds__(512) fwd_mega(Params P) {
    extern __shared__ __attribute__((aligned(16))) unsigned char lds_raw[];
    LAS unsigned char* lds = (LAS unsigned char*)lds_raw;
    const int G = gridDim.x;
    unsigned char* ws = P.ws;
    volatile LAS unsigned* misc = (volatile LAS unsigned*)(lds + LDS_MISC);
    if (threadIdx.x < 2) misc[threadIdx.x] = 0u;
    __syncthreads();
    XcdBarrier bar; bar.bar = (unsigned*)(ws + WS_BAR); bar.x = 0; bar.st = misc;
#define GSYNC(a, b) do { if ((PHM & (a)) && (PHM & (b))) xcd_barrier(bar); } while (0)
    if constexpr (PHM == 511) {
      if (blockIdx.x == 0) for (int i = threadIdx.x; i < XCD_BAR_WORDS; i += 512) ((unsigned*)(ws + WS_BAR))[i] = 0u;
      if (blockIdx.x == 1) { for (int i = threadIdx.x; i < NTM * 64; i += 512) ((unsigned*)(ws + WS_CNT7))[i] = 0u; if (threadIdx.x < 64) ((unsigned*)(ws + WS_TICKET))[threadIdx.x] = 0u; }
      cg::this_grid().sync();
      bar = xcd_barrier_post((unsigned*)(ws + WS_BAR), misc); }
    if constexpr ((PHM & 1) != 0) { LAUNDER_TID(); phase0(P, lds, wave, lane); }
    GSYNC(1, 2);
    if constexpr ((PHM & 2) != 0) { LAUNDER_TID(); phase1(P, lds, tid, wave, lane); }
    GSYNC(2, 4);
    if constexpr ((PHM & 4) != 0) {
      pg8::Gemm g{(const bf16*)(ws + WS_R0), (const bf16*)(ws + WS_WIN), MT, INW, DM};
      OrderX S; S.S.init(MT, INW, G, (int)blockIdx.x); S.nX = 22; S.xpm = NTM; S.xpn0 = 11;
      Epi1 E{(bf16*)(ws + WS_R1), (float*)(ws + WS_SHW), P.out};
      pg8::gemm_phase<Epi1, OrderX, true, true>(lds, g, S, E); }
    GSYNC(4, 8);
    if constexpr ((PHM & 8) != 0) { LAUNDER_TID(); phase3(P, lds, tid, wave, lane);
#ifdef PROBE_P3X2
      cg::this_grid().sync(); phase3(P, lds, tid, wave, lane);
#endif
    }
    GSYNC(8, 16);
    if constexpr ((PHM & 16) != 0) {
      pg8::Gemm g{(const bf16*)(ws + WS_R2), (const bf16*)(ws + WS_WOUT), MT, DM, DM};
      OrderDown S; S.S.init(MP, DM, G, (int)blockIdx.x); S.ka = 4; S.kb = 4;
      Epi2 E{P.x_p, P.x_s, (const float*)(ws + WS_MOD), P.ln2, (bf16*)(ws + WS_X1B), (bf16*)(ws + WS_R0), (float*)(ws + WS_SS1), (float*)(ws + WS_SLAB4)};
      pg8::gemm_phase<Epi2, OrderDown, true, true>(lds, g, S, E); }
    GSYNC(16, 32);
    if constexpr ((PHM & 32) != 0) {
      LAUNDER_TID();
      sample_fix(P, wave, lane);
      if constexpr (PHM == 511) xcd_barrier(bar);
      pg8::Gemm g{(const bf16*)(ws + WS_R0), (const bf16*)(ws + WS_WUP), MT, 2 * DFF, DM};
      pg8::StaticOrder S; S.init(MT, 2 * DFF, G, (int)blockIdx.x);
      LAS float* rtab = (LAS float*)(lds + 131072);
      { pg8::Unit u; const float* ss = (const float*)(ws + WS_SS1);
        for (int i = 0; S.next(i, u) && i < 24; ++i) if (tid < 256) { const f32x4* sp = (const f32x4*)(ss + (size_t)(u.pm * 256 + tid) * 16);
            const f32x4 q0 = sp[0], q1 = sp[1], q2 = sp[2], q3 = sp[3];
            const float tot = ((q0.x + q0.y) + (q0.z + q0.w)) + ((q1.x + q1.y) + (q1.z + q1.w)) + ((q2.x + q2.y) + (q2.z + q2.w)) + ((q3.x + q3.y) + (q3.z + q3.w));
            rtab[i * 256 + tid] = rsqrtf(tot * (1.f / DM) + EPS); }
        __syncthreads(); }
#ifdef CONV_FUSED
      float* hA = (float*)(ws + WS_R1);
      Epi3C E{rtab, (const float*)(ws + WS_SHW), P.conv_w, P.conv_b, (bf16*)(ws + WS_R2), hA, hA + HT_STRIDE, hA + 2 * HT_STRIDE};
      pg8::gemm_phase<Epi3C, pg8::StaticOrder, true, true>(lds, g, S, E);
#else
      Epi3 E{rtab, (const float*)(ws + WS_SHW), (bf16*)(ws + WS_R1), (bf16*)(ws + WS_R2), P.out};
      pg8::gemm_phase<Epi3, pg8::StaticOrder, true, true>(lds, g, S, E);
#endif
#ifdef PROBE_P5X2
      cg::this_grid().sync(); pg8::gemm_phase<Epi3, pg8::StaticOrder, true, true>(lds, g, S, E);
#endif
    }
    GSYNC(32, 64);
#ifdef CONV_FUSED
    if constexpr ((PHM & 64) != 0) { LAUNDER_TID(); phase6c(P, tid); }
#else
    if constexpr ((PHM & 64) != 0) { LAUNDER_TID(); phase6(P, tid); }
#endif
    GSYNC(64, 128);
    if constexpr ((PHM & 128) != 0) {
      pg8::Gemm g{(const bf16*)(ws + WS_R2), (const bf16*)(ws + WS_WDN), MT, DM, DFF};
#ifdef P8_QUEUE
      OrderPub S; S.init(MT, DM, G, (int)blockIdx.x); S.cnt = (unsigned*)(ws + WS_CNT7);
      Epi4 E{(const float*)(ws + WS_MOD), (const bf16*)(ws + WS_X1B), (bf16*)(ws + WS_R0), (float*)(ws + WS_SLAB)};
      pg8::gemm_phase<Epi4, OrderPub, true, true>(lds, g, S, E); }
    if constexpr ((PHM & 256) != 0) { LAUNDER_TID(); phase8q(P, lds, tid, wave, lane); }
#else
      OrderDown S; S.S.init(MP, DM, G, (int)blockIdx.x); S.ka = 12; S.kb = 10;
      Epi4 E{(const float*)(ws + WS_MOD), (const bf16*)(ws + WS_X1B), (bf16*)(ws + WS_R0), (float*)(ws + WS_SLAB)};
      pg8::gemm_phase<Epi4, OrderDown, true, true>(lds, g, S, E); }
    GSYNC(128, 256);
    if constexpr ((PHM & 256) != 0) { LAUNDER_TID(); if (gridDim.x == 256) phase8n(P, lds, tid, wave, lane); else phase8(P, wave, lane); }
#endif
}

template <int PHM> static bool launch_one(const Params& p, int grid, bool coop, hipStream_t stream) {
    static bool attr_done = false;
    if (!attr_done) { if (hipFuncSetAttribute((const void*)fwd_mega<PHM>, hipFuncAttributeMaxDynamicSharedMemorySize, LDS_BYTES) != hipSuccess) { fprintf(stderr, "kernel_launch: hipFuncSetAttribute failed\n"); return false; } attr_done = true; }
    hipError_t e;
    if (coop) { Params pc = p; void* args[] = {&pc}; e = hipLaunchCooperativeKernel((const void*)fwd_mega<PHM>, dim3(grid), dim3(512), args, LDS_BYTES, stream); }
    else { hipLaunchKernelGGL(fwd_mega<PHM>, dim3(grid), dim3(512), LDS_BYTES, stream, p); e = hipPeekAtLastError(); }
    if (e != hipSuccess) { fprintf(stderr, "launch (mask %d) failed: %s (grid %d)\n", PHM, hipGetErrorString(e), grid); return false; }
    return true;
}
extern "C" void kernel_launch(void* const* d_in, const int* in_sizes, int n_in, void* d_out, int out_size, void* d_ws, size_t ws_size, hipStream_t stream) {
    static int grid = 0;
    if (grid == 0) {
        if (n_in != 22 || (size_t)out_size != OUT_TOTAL || ws_size < WS_END) { fprintf(stderr, "kernel_launch: unexpected sizes n_in %d out %d ws %zu\n", n_in, out_size, ws_size); grid = -1; return; }
        int dev = 0, cus = 0;
        (void)hipGetDevice(&dev);
        (void)hipDeviceGetAttribute(&cus, hipDeviceAttributeMultiprocessorCount, dev);
        grid = cus;
        if (grid > 256) grid = 256;
        if (grid < 2) grid = -1;
    }
    if (grid < 0) return;
    Params p{};
    const float** pp = (const float**)&p;
    for (int i = 0; i < 22; ++i) pp[i] = (const float*)d_in[i];
    p.out = (float*)d_out; p.ws = (unsigned char*)d_ws;
#if N_LAUNCH == 1
    launch_one<511>(p, grid, true, stream);
#else
    launch_one<1>(p, grid, false, stream) && launch_one<2>(p, grid, false, stream) && launch_one<4>(p, grid, false, stream) && launch_one<8>(p, grid, false, stream) &&
    launch_one<16>(p, grid, false, stream) && launch_one<32>(p, grid, false, stream) && launch_one<64>(p, grid, false, stream) && launch_one<128>(p, grid, false, stream) && launch_one<256>(p, grid, false, stream);
#endif
}
```

```cpp
#define CONV_FUSED 1
#include <hip/hip_runtime.h>
#include <hip/hip_cooperative_groups.h>
#include <cstdio>
#include <cstdint>
namespace cg = cooperative_groups;
namespace pg8 {
#define PG8_LAS __attribute__((address_space(3)))
typedef unsigned short bf16_t;
typedef short bf16x8 __attribute__((ext_vector_type(8)));
typedef float f32x4 __attribute__((ext_vector_type(4)));
typedef unsigned u32x4 __attribute__((ext_vector_type(4)));
constexpr int BM = 256, BK = 64, HALF = 128, HTB = HALF * BK * 2  , STAGE_BYTES = 8 * HTB, NXCD = 8, WGM = 8;

__host__ __device__ __forceinline__ int lds_byte(int r, int c) { const int st = (r >> 4) * 2 + (c >> 5), rr = r & 15, cc = c & 31, ob = rr * 64 + cc * 2; return st * 1024 + (ob ^ (((ob >> 9) & 1) << 5)); }
__host__ __device__ __forceinline__ void stage_rc(int b, int& R, int& C) { const int st = b / 1024, sb = b % 1024, swz = sb ^ (((sb >> 9) & 1) << 5); R = (st >> 1) * 16 + swz / 64; C = (st & 1) * 32 + (swz % 64) / 2; }
__host__ __device__ __forceinline__ int perm32(int rho) { const int n = rho >> 4, i = rho & 15; return 8 * (i >> 2) + 4 * n + (i & 3); }

struct Unit { int pm, pn, seq, kt0, nt; };
struct Gemm { const bf16_t* A; const bf16_t* Bt; int M, N, K; };

struct StaticOrder {
    int nM, nN, nwg, G, c;
    __host__ __device__ __forceinline__ void init(int M, int N, int G_, int c_) { nM = M / BM; nN = N / BM; nwg = nM * nN; G = G_; c = c_; }
    __host__ __device__ __forceinline__ bool next(int i, Unit& u) const {
        const long L = (long)i * G + c; if (L >= nwg) return false; u.seq = i; u.kt0 = 0; u.nt = 0; map(L, u); return true; }
    __host__ __device__ __forceinline__ void map(long L, Unit& u) const {
        int wgid = (int)L; { const int q = nwg / NXCD, r = nwg % NXCD, xcd = wgid % NXCD, off = wgid / NXCD; wgid = (xcd < r ? xcd * (q + 1) : r * (q + 1) + (xcd - r) * q) + off; }
        const int nig = WGM * nN, gid = wgid / nig, fm = gid * WGM, gsz = (nM - fm) < WGM ? (nM - fm) : WGM;
        u.pm = fm + ((wgid % nig) % gsz); u.pn = (wgid % nig) / gsz;
    }
    __device__ __forceinline__ void a_ready(const Unit&) const {}
    __device__ __forceinline__ void done(const Unit&) const {}
};

__device__ __forceinline__ unsigned cvt_pk_bf16(float lo, float hi) { unsigned r; asm volatile("v_cvt_pk_bf16_f32 %0, %1, %2" : "=v"(r) : "v"(lo), "v"(hi)); return r; }

template <class Epi, class Sched, bool ALIGN_EPI = false, bool SP2 = false>
__device__ __forceinline__ void gemm_phase(PG8_LAS unsigned char* lds, const Gemm g, const Sched& S, const Epi& E) {
    int tid_ = threadIdx.x; asm volatile("" : "+v"(tid_));
    const int tid = tid_, wid = __builtin_amdgcn_readfirstlane(tid >> 6), lane = tid & 63, wr = wid >> 2, wc = wid & 3, fr = lane & 15, fq = lane >> 4;
    const int K = g.K, nt = K / BK;
    unsigned voffA[2], voffB[2];
#pragma unroll
    for (int i = 0; i < 2; ++i) { int R, C; stage_rc(tid * 16 + i * 8192, R, C); const int Rb = Epi::PERM ? ((R & ~31) + perm32(R & 31)) : R;
        voffA[i] = (unsigned)(R * K + C) * 2u; voffB[i] = (unsigned)(Rb * K + C) * 2u; }
    const size_t kstep = (size_t)(BK * 2);
    const size_t hstep = (size_t)HALF * K * 2;
    const size_t tstep = 2 * hstep;
    const unsigned ldsw = (unsigned)wid * 1024u;
    const int aoff = lds_byte(wr * 64 + fr, fq * 8), boff = lds_byte(wc * 32 + fr, fq * 8);
#define PG8_SA(b, h) (((b) * 2 + (h)) * HTB)
#define PG8_SB(b, h) ((4 + (b) * 2 + (h)) * HTB)
#define PG8_STAGE(bufoff, gbase, voff) do { _Pragma("unroll") for (int _i = 0; _i < 2; ++_i) \
        __builtin_amdgcn_global_load_lds((const unsigned*)((const char*)(gbase) + (voff)[_i]), (PG8_LAS unsigned*)(lds + (bufoff) + ldsw + _i * 8192), 16, 0, 0); } while (0)
#define PG8_LDA(dst, b, h) do { _Pragma("unroll") for (int m = 0; m < 4; ++m) _Pragma("unroll") for (int k = 0; k < 2; ++k) dst[m][k] = *(const PG8_LAS bf16x8*)(lds + PG8_SA(b, h) + aoff + m * 2048 + k * 1024); } while (0)
#define PG8_LDB(dst, b, h) do { _Pragma("unroll") for (int n = 0; n < 2; ++n) _Pragma("unroll") for (int k = 0; k < 2; ++k) dst[n][k] = *(const PG8_LAS bf16x8*)(lds + PG8_SB(b, h) + boff + n * 2048 + k * 1024); } while (0)
#define PG8_MMA(ai, bj, At, Bt) do { __builtin_amdgcn_s_setprio(1); _Pragma("unroll") for (int m = 0; m < 4; ++m) _Pragma("unroll") for (int n = 0; n < 2; ++n) _Pragma("unroll") for (int k = 0; k < 2; ++k) \
        acc[ai][bj][m][n] = __builtin_amdgcn_mfma_f32_16x16x32_bf16(Bt[n][k], At[m][k], acc[ai][bj][m][n], 0, 0, 0); __builtin_amdgcn_s_setprio(0); } while (0)
#define PG8_WAIT_V(n) asm volatile("s_waitcnt vmcnt(" #n ")" ::: "memory")
#define PG8_WAIT_L(n) asm volatile("s_waitcnt lgkmcnt(" #n ")" ::: "memory")
#define PG8_BAR __builtin_amdgcn_s_barrier()
#define PG8_SCHED __builtin_amdgcn_sched_barrier(0)
    Unit cur, nxt; int ui = 0;
    if (!S.next(0, cur)) return;
    f32x4 acc[2][2][4][2];
#pragma unroll
    for (int a = 0; a < 2; ++a)
#pragma unroll
        for (int b = 0; b < 2; ++b)
#pragma unroll
            for (int m = 0; m < 4; ++m)
#pragma unroll
                for (int n = 0; n < 2; ++n) acc[a][b][m][n] = (f32x4){0.f, 0.f, 0.f, 0.f};
    bf16x8 At[4][2], B0[2][2], B1[2][2];
    const char* cA = (const char*)g.A + (size_t)cur.pm * tstep + (size_t)cur.kt0 * (BK * 2); const char* cB = (const char*)g.Bt + (size_t)cur.pn * tstep + (size_t)cur.kt0 * (BK * 2);
    S.a_ready(cur);
    if constexpr (SP2) {
        PG8_STAGE(PG8_SB(0, 0), cB, voffB); PG8_STAGE(PG8_SB(0, 1), cB + hstep, voffB); PG8_STAGE(PG8_SA(0, 0), cA, voffA); PG8_STAGE(PG8_SA(0, 1), cA + hstep, voffA);
        if (wr == 1) PG8_BAR;
        PG8_WAIT_V(2); PG8_BAR;
        PG8_STAGE(PG8_SB(1, 0), cB + kstep, voffB); PG8_STAGE(PG8_SA(1, 0), cA + kstep, voffA); PG8_STAGE(PG8_SB(1, 1), cB + hstep + kstep, voffB);
        PG8_WAIT_V(6); PG8_BAR;
    } else {
        PG8_STAGE(PG8_SB(0, 0), cB, voffB); PG8_STAGE(PG8_SA(0, 0), cA, voffA); PG8_STAGE(PG8_SB(0, 1), cB + hstep, voffB); PG8_STAGE(PG8_SA(0, 1), cA + hstep, voffA);
        if (wr == 1) PG8_BAR;
        PG8_WAIT_V(4); PG8_BAR;
        PG8_STAGE(PG8_SB(1, 0), cB + kstep, voffB); PG8_STAGE(PG8_SA(1, 0), cA + kstep, voffA); PG8_STAGE(PG8_SB(1, 1), cB + hstep + kstep, voffB);
        PG8_WAIT_V(6); PG8_BAR;
    }
    for (;;) {
        const bool has_next = S.next(ui + 1, nxt);
        const char* nA = has_next ? (const char*)g.A + (size_t)nxt.pm * tstep + (size_t)nxt.kt0 * (BK * 2) : cA; const char* nB = has_next ? (const char*)g.Bt + (size_t)nxt.pn * tstep + (size_t)nxt.kt0 * (BK * 2) : cB;
        const int ntu = cur.nt ? cur.nt : nt;
        for (int t = 0; t < ntu; t += 2) {
            const bool last = (t == ntu - 2);
            const char* a1 = cA + (size_t)(t + 1) * kstep;
            const char* a2 = last ? nA : cA + (size_t)(t + 2) * kstep; const char* b2 = last ? nB : cB + (size_t)(t + 2) * kstep;
            const char* a3 = a2 + kstep; const char* b3 = b2 + kstep;
            if (last && has_next) S.a_ready(nxt);
            if constexpr (SP2) {
            PG8_LDB(B0, 0, 0); PG8_LDB(B1, 0, 1); PG8_SCHED; PG8_LDA(At, 0, 0); PG8_STAGE(PG8_SA(1, 1), a1 + hstep, voffA);
            PG8_WAIT_V(8); PG8_WAIT_L(0); PG8_BAR; PG8_MMA(0, 0, At, B0); PG8_MMA(0, 1, At, B1); PG8_BAR; PG8_SCHED;
            PG8_LDA(At, 0, 1); PG8_STAGE(PG8_SB(0, 0), b2, voffB); PG8_STAGE(PG8_SB(0, 1), b2 + hstep, voffB); PG8_STAGE(PG8_SA(0, 0), a2, voffA);
            PG8_WAIT_V(8); PG8_WAIT_L(0); PG8_BAR; PG8_MMA(1, 0, At, B0); PG8_MMA(1, 1, At, B1); PG8_BAR; PG8_SCHED;
            PG8_LDB(B0, 1, 0); PG8_LDB(B1, 1, 1); PG8_SCHED; PG8_LDA(At, 1, 0); PG8_STAGE(PG8_SA(0, 1), a2 + hstep, voffA);
            PG8_WAIT_V(8); PG8_WAIT_L(0); PG8_BAR; PG8_MMA(0, 0, At, B0); PG8_MMA(0, 1, At, B1); PG8_BAR; PG8_SCHED;
            PG8_LDA(At, 1, 1); PG8_STAGE(PG8_SB(1, 0), b3, voffB); PG8_STAGE(PG8_SB(1, 1), b3 + hstep, voffB); PG8_STAGE(PG8_SA(1, 0), a3, voffA);
            PG8_WAIT_V(8); PG8_WAIT_L(0); PG8_BAR; PG8_MMA(1, 0, At, B0); PG8_MMA(1, 1, At, B1); PG8_BAR; PG8_SCHED;
            } else {
            PG8_LDB(B0, 0, 0); PG8_SCHED; PG8_LDA(At, 0, 0); PG8_STAGE(PG8_SA(1, 1), a1 + hstep, voffA);
            PG8_WAIT_L(8); PG8_BAR; PG8_WAIT_L(0); PG8_MMA(0, 0, At, B0); PG8_BAR; PG8_SCHED;
            PG8_LDB(B1, 0, 1); PG8_STAGE(PG8_SB(0, 0), b2, voffB);
            PG8_BAR; PG8_WAIT_L(0); PG8_MMA(0, 1, At, B1); PG8_BAR;
            PG8_LDA(At, 0, 1); PG8_STAGE(PG8_SA(0, 0), a2, voffA);
            PG8_BAR; PG8_WAIT_L(0); PG8_MMA(1, 0, At, B0); PG8_BAR; PG8_SCHED;
            PG8_STAGE(PG8_SB(0, 1), b2 + hstep, voffB);
            PG8_WAIT_V(6); PG8_BAR; PG8_MMA(1, 1, At, B1); PG8_BAR;
            PG8_LDB(B0, 1, 0); PG8_SCHED; PG8_LDA(At, 1, 0); PG8_STAGE(PG8_SA(0, 1), a2 + hstep, voffA);
            PG8_WAIT_L(8); PG8_BAR; PG8_WAIT_L(0); PG8_MMA(0, 0, At, B0); PG8_BAR; PG8_SCHED;
            PG8_LDB(B1, 1, 1); PG8_STAGE(PG8_SB(1, 0), b3, voffB);
            PG8_BAR; PG8_WAIT_L(0); PG8_MMA(0, 1, At, B1); PG8_BAR;
            PG8_LDA(At, 1, 1); PG8_STAGE(PG8_SA(1, 0), a3, voffA);
            PG8_BAR; PG8_WAIT_L(0); PG8_MMA(1, 0, At, B0); PG8_BAR; PG8_SCHED;
            PG8_STAGE(PG8_SB(1, 1), b3 + hstep, voffB);
            PG8_WAIT_V(6); PG8_BAR; PG8_MMA(1, 1, At, B1); PG8_BAR;
            }
        }
        if constexpr (ALIGN_EPI) { if (wr == 0) PG8_BAR; }
        if constexpr (!Epi::AFTER_DRAIN) { E(acc, cur, wr, wc, fr, fq); S.done(cur); }
        if (!has_next) break;
#pragma unroll
        for (int a = 0; a < 2; ++a)
#pragma unroll
            for (int b = 0; b < 2; ++b)
#pragma unroll
                for (int m = 0; m < 4; ++m)
#pragma unroll
                    for (int n = 0; n < 2; ++n) acc[a][b][m][n] = (f32x4){0.f, 0.f, 0.f, 0.f};
        cur = nxt; cA = nA; cB = nB; ++ui;
        if constexpr (ALIGN_EPI) { if (wr == 1) PG8_BAR; }
    }
    PG8_WAIT_V(0);
    if constexpr (!ALIGN_EPI) { if (wr == 0) PG8_BAR; }
    PG8_BAR;
    if constexpr (Epi::AFTER_DRAIN) { E.fused(acc, cur, wr, wc, fr, fq, lds, wid, lane); S.done(cur); }
#undef PG8_SA
#undef PG8_SB
#undef PG8_STAGE
#undef PG8_LDA
#undef PG8_LDB
#undef PG8_MMA
#undef PG8_WAIT_V
#undef PG8_WAIT_L
#undef PG8_BAR
#undef PG8_SCHED
}
}
constexpr int DM = 1024, SEQ = 2048, NB = 32, DECL = 64, DFF = 2816, INW = 2816;
constexpr int MP = NB * SEQ, MS = NB * DECL, MT = MP + MS;
constexpr int NGRP = MT / 64;
constexpr int NTM = MT / 256;
constexpr float EPS = 1e-6f;
constexpr size_t OFF_Y = 0;
constexpr size_t OFF_PRET = (size_t)MT * DM;
constexpr size_t OFF_PK = OFF_PRET + (size_t)NB * 4 * 128 * 128;
constexpr size_t OFF_PV = OFF_PK + (size_t)NB * 128 * 128;
constexpr size_t OFF_PCONV = OFF_PV + (size_t)NB * 128 * 128;
constexpr size_t OFF_SRET = OFF_PCONV + (size_t)NB * 2 * DFF;
constexpr size_t OFF_SK = OFF_SRET + (size_t)NB * 4 * 128 * 128;
constexpr size_t OFF_SV = OFF_SK + (size_t)NB * 64 * 128;
constexpr size_t OFF_SCONV = OFF_SV + (size_t)NB * 64 * 128;
constexpr size_t OUT_TOTAL = OFF_SCONV + (size_t)NB * 2 * DFF;
constexpr size_t MiB = 1u << 20;
constexpr size_t WS_WIN = 0;
constexpr size_t WS_WUP = WS_WIN + (size_t)INW * DM * 2;
constexpr size_t WS_WOUT = WS_WUP + (size_t)2 * DFF * DM * 2;
constexpr size_t WS_WDN = WS_WOUT + (size_t)DM * DM * 2;
constexpr size_t WS_MODP = 48 * MiB + 133 * MiB + 363 * MiB + 200 * MiB;
constexpr size_t WS_MOD = 32 * MiB;
constexpr size_t WS_SHW = 34 * MiB;
constexpr size_t WS_SS1 = 36 * MiB;
constexpr size_t WS_SS2 = 41 * MiB;
constexpr size_t WS_R0 = 48 * MiB;
constexpr size_t WS_R1 = WS_R0 + 133 * MiB;
constexpr size_t WS_R2 = WS_R1 + 363 * MiB;
constexpr size_t HT_STRIDE = (size_t)NGRP * 2 * DFF;
constexpr size_t WS_END = WS_R2 + 363 * MiB;
constexpr size_t WS_SLAB = WS_R1 + 264 * MiB;
constexpr size_t WS_SLAB4 = WS_R1 + 300 * MiB;
constexpr size_t WS_X1B = WS_R1 + 128 * MiB;
static_assert(3 * HT_STRIDE * 4 <= 128 * MiB && WS_X1B + (size_t)MT * DM * 2 <= WS_R2, "ws map");
static_assert(WS_WDN + (size_t)DM * DFF * 2 <= WS_MODP, "ws map");
static_assert((size_t)(MT + 256) * DM * 2 <= 133 * MiB && (size_t)MT * DFF * 2 <= 363 * MiB, "ws map");

constexpr size_t WS_BAR = 46 * MiB;
constexpr size_t WS_TICKET = 46 * MiB + 32768;
constexpr size_t WS_CNT7 = 46 * MiB + 65536;
constexpr int LDS_MISC = 155648;
constexpr int LDS_BYTES = 155648 + 64;

#define LAS __attribute__((address_space(3)))
typedef unsigned short bf16;
typedef float f32x4 __attribute__((ext_vector_type(4)));
typedef float f32x2 __attribute__((ext_vector_type(2)));
typedef short bf16x8 __attribute__((ext_vector_type(8)));
typedef unsigned u32x4 __attribute__((ext_vector_type(4)));
typedef unsigned u32x2 __attribute__((ext_vector_type(2)));
typedef __bf16 bf16x2_t __attribute__((ext_vector_type(2)));
#define LDS_WAIT() asm volatile("s_waitcnt lgkmcnt(0)" ::: "memory")

__device__ __forceinline__ unsigned pk2(float lo, float hi) { f32x2 v = {lo, hi}; bf16x2_t b = __builtin_convertvector(v, bf16x2_t); return __builtin_bit_cast(unsigned, b); }
__device__ __forceinline__ float bflo(unsigned w) { return __uint_as_float(w << 16); }
__device__ __forceinline__ float bfhi(unsigned w) { return __uint_as_float(w & 0xffff0000u); }
__device__ __forceinline__ float wave_sum(float v) {
#pragma unroll
    for (int o = 1; o < 64; o <<= 1) v += __shfl_xor(v, o);
    return v;
}
__device__ __forceinline__ float wave_sum_dpp(float v) {
    v += __int_as_float(__builtin_amdgcn_update_dpp(__float_as_int(v), __float_as_int(v), 0x128, 0xf, 0xf, false));
    v += __int_as_float(__builtin_amdgcn_update_dpp(__float_as_int(v), __float_as_int(v), 0x124, 0xf, 0xf, false));
    v += __int_as_float(__builtin_amdgcn_update_dpp(__float_as_int(v), __float_as_int(v), 0x122, 0xf, 0xf, false));
    v += __int_as_float(__builtin_amdgcn_update_dpp(__float_as_int(v), __float_as_int(v), 0x121, 0xf, 0xf, false));
    const int i = __float_as_int(v);
    return (__int_as_float(__builtin_amdgcn_readlane(i, 0)) + __int_as_float(__builtin_amdgcn_readlane(i, 16))) + (__int_as_float(__builtin_amdgcn_readlane(i, 32)) + __int_as_float(__builtin_amdgcn_readlane(i, 48)));
}
__device__ __forceinline__ float silu_f(float x) { return x * __builtin_amdgcn_rcpf(1.0f + __builtin_amdgcn_exp2f(-1.4426950408889634f * x)); }
__device__ __forceinline__ void unpack8(const u32x4 w, float (&f)[8]) { f[0] = bflo(w.x); f[1] = bfhi(w.x); f[2] = bflo(w.y); f[3] = bfhi(w.y); f[4] = bflo(w.z); f[5] = bfhi(w.z); f[6] = bflo(w.w); f[7] = bfhi(w.w); }
__device__ __forceinline__ int grp_bs(int g) { return g < 1024 ? (g >> 5) : 32 + (g - 1024); }

struct Params {
    const float *x_p, *x_s, *cache_k, *cache_v, *state_ret, *state_conv, *c_p, *c_s, *ln1, *ln2, *w_ada, *b_ada, *w_in, *w_out, *sinks, *w_up, *conv_w, *conv_b, *w_down, *normf, *w_ada_f, *b_ada_f;
    float* out; unsigned char* ws;
};

__device__ __forceinline__ void transpose_item(const float* W, int K, int N, bf16* WT, int dst_row0, int k0, int n0, LAS float* scr, int lane) {
    { f32x4 t[8];
#pragma unroll
      for (int i = 0; i < 8; ++i) t[i] = *(const f32x4*)(W + (size_t)(k0 + 8 * i + (lane >> 3)) * N + n0 + 4 * (lane & 7));
#pragma unroll
      for (int i = 0; i < 8; ++i) { LAS float* d = scr + (8 * i + (lane >> 3)) * 33 + 4 * (lane & 7); d[0] = t[i].x; d[1] = t[i].y; d[2] = t[i].z; d[3] = t[i].w; } }
    LDS_WAIT(); asm volatile("" ::: "memory");
    const int c = lane & 7;
#pragma unroll
    for (int j = 0; j < 4; ++j) { const int n = (lane >> 3) + 8 * j; const LAS float* s = scr + (8 * c) * 33 + n;
        u32x4 o; o.x = pk2(s[0 * 33], s[1 * 33]); o.y = pk2(s[2 * 33], s[3 * 33]); o.z = pk2(s[4 * 33], s[5 * 33]); o.w = pk2(s[6 * 33], s[7 * 33]);
        *(u32x4*)(WT + (size_t)(dst_row0 + n) * K + k0 + 8 * c) = o; }
    LDS_WAIT(); asm volatile("" ::: "memory");
}
constexpr int MOD_KS = 8, MOD_KC = 1024 / MOD_KS / 32;
__device__ __forceinline__ void mod_item(const Params& P, int it, LAS float* scr, int lane) {
    const int ct = it / MOD_KS, ks = it % MOD_KS, c0 = ct * 64;
    const float* W; const float* bias; int ldw;
    if (c0 < 6144) { W = P.w_ada + c0; bias = P.b_ada + c0; ldw = 6144; } else { W = P.w_ada_f + (c0 - 6144); bias = P.b_ada_f + (c0 - 6144); ldw = 2048; }
    float acc[64];
#pragma unroll
    for (int r = 0; r < 64; ++r) acc[r] = 0.f;
    const float* crow = (lane < 32 ? P.c_p + (size_t)lane * DM : P.c_s + (size_t)(lane - 32) * DM) + ks * (1024 / MOD_KS);
    const float* wk0 = W + (size_t)(ks * (1024 / MOD_KS)) * ldw + lane;
    f32x4 cv[8], cn[8];
#pragma unroll
    for (int q = 0; q < 8; ++q) cv[q] = *(const f32x4*)(crow + 4 * q);
    constexpr int NK4 = (1024 / MOD_KS) / 4;
    float w0 = wk0[0], w1 = wk0[(size_t)ldw], w2 = wk0[(size_t)2 * ldw], w3 = wk0[(size_t)3 * ldw];
    for (int kc = 0; kc < MOD_KC; ++kc) {
#pragma unroll
        for (int q = 0; q < 8; ++q) { f32x4 v = cv[q]; v.x = silu_f(v.x); v.y = silu_f(v.y); v.z = silu_f(v.z); v.w = silu_f(v.w); *(LAS f32x4*)(scr + lane * 36 + 4 * q) = v; }
        LDS_WAIT(); asm volatile("" ::: "memory");
        { const int kn = kc + 1 < MOD_KC ? kc + 1 : kc;
#pragma unroll
          for (int q = 0; q < 8; ++q) cn[q] = *(const f32x4*)(crow + kn * 32 + 4 * q); }
        for (int k4 = 0; k4 < 8; ++k4) {
            const int gk = kc * 8 + k4, gn = gk + 1 < NK4 ? gk + 1 : gk;
            const float* wn = wk0 + (size_t)(4 * gn) * ldw;
            const float n0 = wn[0], n1 = wn[(size_t)ldw], n2 = wn[(size_t)2 * ldw], n3 = wn[(size_t)3 * ldw];
#pragma unroll
            for (int r = 0; r < 64; ++r) { const f32x4 sv = *(const LAS f32x4*)(scr + r * 36 + 4 * k4);
                acc[r] = fmaf(sv.x, w0, acc[r]); acc[r] = fmaf(sv.y, w1, acc[r]); acc[r] = fmaf(sv.z, w2, acc[r]); acc[r] = fmaf(sv.w, w3, acc[r]); }
            w0 = n0; w1 = n1; w2 = n2; w3 = n3;
        }
        LDS_WAIT(); asm volatile("" ::: "memory");
#pragma unroll
        for (int q = 0; q < 8; ++q) cv[q] = cn[q];
    }
    float* dst = (float*)(P.ws + WS_MODP) + (size_t)ks * 64 * 8192 + c0 + lane;
    const float bv = (ks == 0) ? bias[lane] : 0.f;
#pragma unroll
    for (int r = 0; r < 64; ++r) dst[(size_t)r * 8192] = acc[r] + bv;
}
__device__ __forceinline__ void phase0(const Params& P, LAS unsigned char* lds, int wave, int lane) {
    LAS float* scr = (LAS float*)(lds + wave * 16384);
    const int gw = wave * gridDim.x + blockIdx.x, NGW = gridDim.x * 8;
    constexpr int I_MOD = 128 * MOD_KS, I_IN = 16 * 88, I_UP = 16 * 176, I_OUT = 16 * 32, I_DN = 44 * 32;
    constexpr int NIT = I_MOD + I_IN + I_UP + I_OUT + I_DN;
    for (int it = gw; it < NIT; it += NGW) {
        int r = it;
        if (r < I_MOD) { mod_item(P, r, scr, lane); continue; } r -= I_MOD;
        if (r < I_IN) { const int kb = r / 88, nb = r % 88; transpose_item(P.w_in, DM, INW, (bf16*)(P.ws + WS_WIN), nb * 32, kb * 64, nb * 32, scr, lane); continue; } r -= I_IN;
        if (r < I_UP) { const int kb = r / 176, nb = r % 176, n0 = nb * 32, isb = n0 >= DFF, j0 = n0 - isb * DFF;
            transpose_item(P.w_up, DM, 2 * DFF, (bf16*)(P.ws + WS_WUP), 256 * (j0 >> 7) + 128 * isb + (j0 & 127), kb * 64, n0, scr, lane); continue; } r -= I_UP;
        if (r < I_OUT) { const int kb = r / 32, nb = r % 32; transpose_item(P.w_out, DM, DM, (bf16*)(P.ws + WS_WOUT), nb * 32, kb * 64, nb * 32, scr, lane); continue; } r -= I_OUT;
        { const int kb = r / 32, nb = r % 32; transpose_item(P.w_down, DFF, DM, (bf16*)(P.ws + WS_WDN), nb * 32, kb * 64, nb * 32, scr, lane); }
    }
}

__device__ __forceinline__ void phase1(const Params& P, LAS unsigned char* lds, int tid, int wave, int lane) {
    const float* modp = (const float*)(P.ws + WS_MODP);
    float* mod = (float*)(P.ws + WS_MOD);
    bf16* H1 = (bf16*)(P.ws + WS_R0);
    for (int idx = blockIdx.x * 512 + tid; idx < 64 * 8192; idx += gridDim.x * 512) {
        float s = 0.f;
#pragma unroll
        for (int p_ = 0; p_ < MOD_KS; ++p_) s += modp[idx + (size_t)p_ * 524288];
        mod[idx] = s;
        const int col = idx & 8191, bs = idx >> 13;
        if (col >= 3072 && col < 4096) H1[(size_t)(MT + bs) * DM + (col - 3072)] = (bf16)(pk2(s, 0.f) & 0xffffu);
    }
    LAS float* lv = (LAS float*)lds;
    const int rpb = (MT + (int)gridDim.x - 1) / (int)gridDim.x, rbeg = (int)blockIdx.x * rpb, rend = (rbeg + rpb < MT) ? rbeg + rpb : MT;
    if (rbeg < rend) {
        const int bs0 = rbeg < MP ? (rbeg >> 11) : 32 + ((rbeg - MP) >> 6), bs1 = (rend - 1) < MP ? ((rend - 1) >> 11) : 32 + ((rend - 1 - MP) >> 6);
        const int nsl = bs1 - bs0 + 1;
        __syncthreads();
        for (int i = tid; i < nsl * 2048; i += 512) { const int sl = i >> 11, which = (i >> 10) & 1, col = i & 1023; const size_t o = (size_t)(bs0 + sl) * 8192 + which * 1024 + col;
            float sv = 0.f;
#pragma unroll
            for (int p_ = 0; p_ < MOD_KS; ++p_) sv += modp[o + (size_t)p_ * 524288];
            if (which) sv = P.ln1[col] * (1.f + sv);
            lv[i] = sv; }
        __syncthreads();
#pragma unroll 4
        for (int row = rbeg + wave; row < rend; row += 8) {
            const int bs = row < MP ? (row >> 11) : 32 + ((row - MP) >> 6);
            const LAS float* lvs = lv + (bs - bs0) * 2048;
            const float* xr = (row < MP ? P.x_p + (size_t)row * DM : P.x_s + (size_t)(row - MP) * DM) + 4 * lane;
            f32x4 v[4]; float ss = 0.f;
#pragma unroll
            for (int j = 0; j < 4; ++j) { v[j] = *(const f32x4*)(xr + 256 * j); ss += (v[j].x * v[j].x + v[j].y * v[j].y) + (v[j].z * v[j].z + v[j].w * v[j].w); }
            const float rstd = __builtin_amdgcn_rsqf(wave_sum_dpp(ss) * (1.f / DM) + EPS);
            bf16* hr = H1 + (size_t)row * DM + 4 * lane;
#pragma unroll
            for (int j = 0; j < 4; ++j) { const f32x4 sh = *(const LAS f32x4*)(lvs + 256 * j + 4 * lane), gs = *(const LAS f32x4*)(lvs + 1024 + 256 * j + 4 * lane);
                const f32x4 h = v[j] * rstd * gs + sh; u32x2 w; w.x = pk2(h.x, h.y); w.y = pk2(h.z, h.w); *(u32x2*)(hr + 256 * j) = w; }
        }
    }
}

struct OrderX {
    pg8::StaticOrder S; int nX, xpm, xpn0;
    __device__ __forceinline__ bool next(int i, pg8::Unit& u) const {
        const long L = (long)i * S.G + S.c;
        int pm = 0, pn = 0; bool ok = false;
        if (L < S.nwg) { pg8::Unit t; t.pm = 0; t.pn = 0; t.seq = 0; t.kt0 = 0; t.nt = 0; (void)S.next(i, t); pm = t.pm; pn = t.pn; ok = true; }
        else if (L < S.nwg + nX) { pm = xpm; pn = xpn0 + (int)(L - S.nwg); ok = true; }
        u.pm = pm; u.pn = pn; u.seq = i; u.kt0 = 0; u.nt = 0;
        return ok;
    }
    __device__ __forceinline__ void a_ready(const pg8::Unit&) const {}
    __device__ __forceinline__ void done(const pg8::Unit&) const {}
};
struct OrderPub : pg8::StaticOrder {
    unsigned* cnt;
    __device__ __forceinline__ void done(const pg8::Unit& u) const {
        asm volatile("s_waitcnt vmcnt(0)" ::: "memory");
        if ((threadIdx.x & 63) == 0) __hip_atomic_fetch_add(cnt + 64 * u.pm, 1u, __ATOMIC_RELAXED, __HIP_MEMORY_SCOPE_AGENT);
    }
};
struct OrderDown {
    pg8::StaticOrder S;
    int ka, kb;
    __device__ __forceinline__ bool next(int i, pg8::Unit& u) const {
        const long L = (long)i * S.G + S.c;
        int pm = 0, pn = 0, kt0 = 0, nt = 0; bool ok = false;
        if (L < S.nwg) { pg8::Unit t; t.pm = 0; t.pn = 0; t.seq = 0; t.kt0 = 0; t.nt = 0; (void)S.next(i, t); pm = t.pm; pn = t.pn; ok = true; }
        else if (L < S.nwg + 128) { const int q = (int)(L - S.nwg), tu = q >> 2, part = q & 3; pm = (MP / 256) + (tu & 7); pn = tu >> 3; kt0 = part < 2 ? ka * part : 2 * ka + kb * (part - 2); nt = part < 2 ? ka : kb; ok = true; }
        u.pm = pm; u.pn = pn; u.seq = i; u.kt0 = kt0; u.nt = nt;
        return ok;
    }
    __device__ __forceinline__ void a_ready(const pg8::Unit&) const {}
    __device__ __forceinline__ void done(const pg8::Unit&) const {}
};
typedef const f32x4 (&AccRef)[2][2][4][2];
struct Epi1 {
    static constexpr bool PERM = true, AFTER_DRAIN = false;
    bf16* proj; float* shw; float* out;
    __device__ __forceinline__ void operator()(AccRef acc, const pg8::Unit& u, int wr, int wc, int fr, int fq) const {
        if (u.pm == NTM) {
            if (wr == 0) {
#pragma unroll
                for (int m = 0; m < 4; ++m) { float* d = shw + (size_t)(16 * m + fr) * (2 * DFF) + 256 * (u.pn - 11) + 32 * wc + 8 * fq;
#pragma unroll
                    for (int bj = 0; bj < 2; ++bj)
#pragma unroll
                        for (int n = 0; n < 2; ++n) *(f32x4*)(d + 128 * bj + 4 * n) = acc[0][bj][m][n]; }
            }
            return;
        }
        const unsigned row0 = u.pm * 256 + wr * 64 + fr, col0 = u.pn * 256 + wc * 32 + 8 * fq;
#pragma unroll
        for (int ai = 0; ai < 2; ++ai)
#pragma unroll
            for (int m = 0; m < 4; ++m) { const unsigned o = (row0 + 128 * ai + 16 * m) * (unsigned)INW + col0;
#pragma unroll
                for (int bj = 0; bj < 2; ++bj) { const f32x4 v0 = acc[ai][bj][m][0], v1 = acc[ai][bj][m][1];
                    u32x4 w; w.x = pk2(v0[0], v0[1]); w.y = pk2(v0[2], v0[3]); w.z = pk2(v1[0], v1[1]); w.w = pk2(v1[2], v1[3]);
                    *(u32x4*)(proj + (o + 128 * bj)) = w; }
                asm volatile("" ::: "memory"); }
        if (u.pn == 10) {
            const unsigned c = 32 * wc + 8 * fq;
#pragma unroll
            for (int ai = 0; ai < 2; ++ai)
#pragma unroll
                for (int m = 0; m < 4; ++m) { const unsigned row = row0 + 128 * ai + 16 * m; unsigned ok, ov;
                    if (row < (unsigned)MP) { const unsigned t = row & 2047; if (t < SEQ - 128) continue; const unsigned o = ((row >> 11) * 128 + (t - (SEQ - 128))) * 128 + c; ok = (unsigned)OFF_PK + o; ov = (unsigned)OFF_PV + o; }
                    else { const unsigned o = (row - MP) * 128 + c; ok = (unsigned)OFF_SK + o; ov = (unsigned)OFF_SV + o; }
                    *(f32x4*)(out + ok) = acc[ai][0][m][0]; *(f32x4*)(out + ok + 4) = acc[ai][0][m][1];
                    *(f32x4*)(out + ov) = acc[ai][1][m][0]; *(f32x4*)(out + ov + 4) = acc[ai][1][m][1];
                    asm volatile("" ::: "memory"); }
        }
    }
};
struct Epi2 {
    static constexpr bool PERM = true, AFTER_DRAIN = false;
    const float *xp, *xs, *mod, *ln2; bf16* x1; bf16* a2; float* ss; float* slab;
    __device__ __forceinline__ void operator()(AccRef acc, const pg8::Unit& u, int wr, int wc, int fr, int fq) const {
        const int col0 = u.pn * 256 + wc * 32 + 8 * fq;
        if (u.nt != 0) {
            float* sb = slab + (size_t)(u.kt0 >> 2) * MS * DM;
#pragma unroll
            for (int ai = 0; ai < 2; ++ai)
#pragma unroll
                for (int m = 0; m < 4; ++m) { const unsigned ro = (unsigned)(u.pm * 256 - MP + 128 * ai + 64 * wr + 16 * m + fr) * DM + col0;
#pragma unroll
                    for (int bj = 0; bj < 2; ++bj) { *(f32x4*)(sb + ro + 128 * bj) = acc[ai][bj][m][0]; *(f32x4*)(sb + ro + 128 * bj + 4) = acc[ai][bj][m][1]; } }
            return;
        }
#pragma unroll
        for (int ai = 0; ai < 2; ++ai) {
            const int bs = grp_bs(4 * u.pm + 2 * ai + wr);
            const float* mb = mod + (size_t)bs * 8192;
            f32x4 g1v[2][2], gsv[2][2];
#pragma unroll
            for (int bj = 0; bj < 2; ++bj)
#pragma unroll
                for (int n = 0; n < 2; ++n) { const int c = col0 + 128 * bj + 4 * n; g1v[bj][n] = *(const f32x4*)(mb + 2048 + c);
                    gsv[bj][n] = *(const f32x4*)(ln2 + c) * (*(const f32x4*)(mb + 4096 + c) + 1.0f); }
#pragma unroll
            for (int m = 0; m < 4; ++m) {
                const int row = u.pm * 256 + 128 * ai + 64 * wr + 16 * m + fr;
                const float* xr = row < MP ? xp + (size_t)row * DM : xs + (size_t)(row - MP) * DM;
                float s = 0.f;
#pragma unroll
                for (int bj = 0; bj < 2; ++bj) { f32x4 a[2]; f32x4 xb[2];
#pragma unroll
                    for (int n = 0; n < 2; ++n) { const int c = col0 + 128 * bj + 4 * n; const f32x4 xv = *(const f32x4*)(xr + c); const f32x4 v = xv + g1v[bj][n] * acc[ai][bj][m][n];
                        xb[n] = v; s += (v.x * v.x + v.y * v.y) + (v.z * v.z + v.w * v.w); a[n] = v * gsv[bj][n]; }
                    u32x4 w; w.x = pk2(a[0].x, a[0].y); w.y = pk2(a[0].z, a[0].w); w.z = pk2(a[1].x, a[1].y); w.w = pk2(a[1].z, a[1].w);
                    *(u32x4*)(a2 + (size_t)row * DM + col0 + 128 * bj) = w;
                    w.x = pk2(xb[0].x, xb[0].y); w.y = pk2(xb[0].z, xb[0].w); w.z = pk2(xb[1].x, xb[1].y); w.w = pk2(xb[1].z, xb[1].w);
                    *(u32x4*)(x1 + (size_t)row * DM + col0 + 128 * bj) = w; }
                s += __shfl_xor(s, 16); s += __shfl_xor(s, 32);
                if (fq == 0) ss[(size_t)row * 16 + 4 * u.pn + wc] = s;
            }
        }
    }
};
struct Epi3 {
    static constexpr bool PERM = true, AFTER_DRAIN = false;
    const LAS float* rtab; const float* shw; bf16 *ua, *ub; float* out;
    __device__ __forceinline__ void operator()(AccRef acc, const pg8::Unit& u, int wr, int wc, int fr, int fq) const {
        const unsigned j0 = u.pn * 128 + wc * 32 + 8 * fq, pc0 = u.pn * 256 + wc * 32 + 8 * fq;
#pragma unroll
        for (int ai = 0; ai < 2; ++ai) {
            const unsigned grp = 4 * u.pm + 2 * ai + wr, bs = grp_bs((int)grp);
            const unsigned so = bs * (2 * DFF) + pc0;
            const f32x4 sa0 = *(const f32x4*)(shw + so), sa1 = *(const f32x4*)(shw + so + 4), sb0 = *(const f32x4*)(shw + so + 128), sb1 = *(const f32x4*)(shw + so + 132);
#pragma unroll
            for (int m = 0; m < 4; ++m) {
                const float rstd = rtab[u.seq * 256 + 128 * ai + 64 * wr + 16 * m + fr];
                const unsigned row = grp * 64 + 16 * m + fr;
                const f32x4 a0 = acc[ai][0][m][0] * rstd + sa0, a1 = acc[ai][0][m][1] * rstd + sa1, b0 = acc[ai][1][m][0] * rstd + sb0, b1 = acc[ai][1][m][1] * rstd + sb1;
                u32x4 w; w.x = pk2(a0[0], a0[1]); w.y = pk2(a0[2], a0[3]); w.z = pk2(a1[0], a1[1]); w.w = pk2(a1[2], a1[3]);
                *(u32x4*)(ua + (row * (unsigned)DFF + j0)) = w;
                w.x = pk2(b0[0], b0[1]); w.y = pk2(b0[2], b0[3]); w.z = pk2(b1[0], b1[1]); w.w = pk2(b1[2], b1[3]);
                *(u32x4*)(ub + (row * (unsigned)DFF + j0)) = w;
                if (m == 3 && fr >= 14) {
                    if (grp >= 1024) { float* d = out + OFF_SCONV + ((size_t)(grp - 1024) * 2 + (fr - 14)) * DFF + j0; *(f32x4*)d = a0; *(f32x4*)(d + 4) = a1; }
                    else if ((grp & 31) == 31) { float* d = out + OFF_PCONV + ((size_t)(grp >> 5) * 2 + (fr - 14)) * DFF + j0; *(f32x4*)d = a0; *(f32x4*)(d + 4) = a1; }
                }
            }
        }
    }
};
#ifdef CONV_FUSED
struct Epi3C {
    static constexpr bool PERM = true, AFTER_DRAIN = false;
    const LAS float* rtab; const float *shw, *cw, *cb; bf16* act; float *headA, *headB, *tailA;
    __device__ __forceinline__ void operator()(AccRef acc, const pg8::Unit& u, int wr, int wc, int fr, int fq) const {
        const unsigned j0 = u.pn * 128 + wc * 32 + 8 * fq, pc0 = u.pn * 256 + wc * 32 + 8 * fq;
        f32x4 w0[2], w1[2], w2[2], cbv[2];
#pragma unroll
        for (int n = 0; n < 2; ++n) { w0[n] = *(const f32x4*)(cw + j0 + 4 * n); w1[n] = *(const f32x4*)(cw + DFF + j0 + 4 * n); w2[n] = *(const f32x4*)(cw + 2 * DFF + j0 + 4 * n); cbv[n] = *(const f32x4*)(cb + j0 + 4 * n); }
#pragma unroll
        for (int ai = 0; ai < 2; ++ai) {
            asm volatile("" ::: "memory");
            const unsigned grp = 4 * u.pm + 2 * ai + wr, bs = grp_bs((int)grp);
            const unsigned so = bs * (2 * DFF) + pc0, ho = (grp * 2 + (fr & 1)) * DFF + j0;
            u32x2 ap[4][2], bp[4][2];
            {
                f32x4 sa[2], sb[2];
#pragma unroll
                for (int n = 0; n < 2; ++n) { sa[n] = *(const f32x4*)(shw + so + 4 * n); sb[n] = *(const f32x4*)(shw + so + 128 + 4 * n); }
#pragma unroll
                for (int m = 0; m < 4; ++m) {
                    const float rs = rtab[u.seq * 256 + 128 * ai + 64 * wr + 16 * m + fr];
#pragma unroll
                    for (int n = 0; n < 2; ++n) {
                        const f32x4 av = acc[ai][0][m][n] * rs + sa[n], bv = acc[ai][1][m][n] * rs + sb[n];
                        if (m == 0) { if (fr < 2) { *(f32x4*)(headA + ho + 4 * n) = av; *(f32x4*)(headB + ho + 4 * n) = bv; } }
                        if (m == 3) { if (fr >= 14) *(f32x4*)(tailA + ho + 4 * n) = av; }
                        ap[m][n].x = pk2(av.x, av.y); ap[m][n].y = pk2(av.z, av.w); bp[m][n].x = pk2(bv.x, bv.y); bp[m][n].y = pk2(bv.z, bv.w);
                    }
                }
            }
            asm volatile("" ::: "memory");
#pragma unroll
            for (int n = 0; n < 2; ++n)
#pragma unroll
                for (int h = 0; h < 2; ++h) {
                    unsigned q1 = 0u, q2 = 0u;
#pragma unroll
                    for (int m = 0; m < 4; ++m) {
                        const unsigned a = ap[m][n][h];
                        const unsigned s1 = (unsigned)__builtin_amdgcn_update_dpp((int)a, (int)a, 0x121, 0xf, 0xf, false);
                        const unsigned s2 = (unsigned)__builtin_amdgcn_update_dpp((int)a, (int)a, 0x122, 0xf, 0xf, false);
                        const unsigned pr1 = fr >= 1 ? s1 : q1, pr2 = fr >= 2 ? s2 : q2;
                        q1 = s1; q2 = s2;
                        const float c0 = cbv[n][2 * h] + w0[n][2 * h] * bflo(pr2) + w1[n][2 * h] * bflo(pr1) + w2[n][2 * h] * bflo(a);
                        const float c1 = cbv[n][2 * h + 1] + w0[n][2 * h + 1] * bfhi(pr2) + w1[n][2 * h + 1] * bfhi(pr1) + w2[n][2 * h + 1] * bfhi(a);
                        const unsigned bw = bp[m][n][h];
                        bp[m][n][h] = pk2(silu_f(c0) * bflo(bw), silu_f(c1) * bfhi(bw));
                    }
                    __builtin_amdgcn_sched_barrier(0);
                }
            asm volatile("" ::: "memory");
#pragma unroll
            for (int m = 0; m < 4; ++m) {
                if (m == 0 && fr < 2) continue;
                const unsigned row = grp * 64 + 16 * m + fr;
                const u32x4 w = (u32x4){bp[m][0].x, bp[m][0].y, bp[m][1].x, bp[m][1].y};
                *(u32x4*)(act + (row * (unsigned)DFF + j0)) = w;
            }
        }
    }
};
#endif
struct Epi4 {
    static constexpr bool PERM = true, AFTER_DRAIN = false;
    const float* mod; const bf16* x1; bf16* x2; float* slab;
    __device__ __forceinline__ void operator()(AccRef acc, const pg8::Unit& u, int wr, int wc, int fr, int fq) const {
        const int col0 = u.pn * 256 + wc * 32 + 8 * fq;
        if (u.nt != 0) {
            const int part = u.kt0 == 0 ? 0 : (u.kt0 == 12 ? 1 : (u.kt0 == 24 ? 2 : 3));
            float* sb = slab + (size_t)part * MS * DM;
#pragma unroll
            for (int ai = 0; ai < 2; ++ai)
#pragma unroll
                for (int m = 0; m < 4; ++m) { const unsigned ro = (unsigned)(u.pm * 256 - MP + 128 * ai + 64 * wr + 16 * m + fr) * DM + col0;
#pragma unroll
                    for (int bj = 0; bj < 2; ++bj) { *(f32x4*)(sb + ro + 128 * bj) = acc[ai][bj][m][0]; *(f32x4*)(sb + ro + 128 * bj + 4) = acc[ai][bj][m][1]; } }
            return;
        }
#pragma unroll
        for (int ai = 0; ai < 2; ++ai) {
            const int bs = grp_bs(4 * u.pm + 2 * ai + wr);
            const float* mb = mod + (size_t)bs * 8192 + 5120;
            f32x4 g2v[2][2];
#pragma unroll
            for (int bj = 0; bj < 2; ++bj)
#pragma unroll
                for (int n = 0; n < 2; ++n) g2v[bj][n] = *(const f32x4*)(mb + col0 + 128 * bj + 4 * n);
#pragma unroll
            for (int m = 0; m < 4; ++m) {
                const unsigned ro = (unsigned)(u.pm * 256 + 128 * ai + 64 * wr + 16 * m + fr) * DM + col0;
#pragma unroll
                for (int bj = 0; bj < 2; ++bj) { const u32x4 xw = *(const u32x4*)(x1 + ro + 128 * bj);
                    const f32x4 v0 = (f32x4){bflo(xw.x), bfhi(xw.x), bflo(xw.y), bfhi(xw.y)} + g2v[bj][0] * acc[ai][bj][m][0];
                    const f32x4 v1 = (f32x4){bflo(xw.z), bfhi(xw.z), bflo(xw.w), bfhi(xw.w)} + g2v[bj][1] * acc[ai][bj][m][1];
                    u32x4 w; w.x = pk2(v0.x, v0.y); w.y = pk2(v0.z, v0.w); w.z = pk2(v1.x, v1.y); w.w = pk2(v1.z, v1.w);
                    *(u32x4*)(x2 + ro + 128 * bj) = w; }
            }
        }
    }
};
#define GAS __attribute__((address_space(1)))
#define RLX_AGENT __ATOMIC_RELAXED, __HIP_MEMORY_SCOPE_AGENT
#define XB_TMO      128
#define XB_XCNT(j)  (256  + 64 * (j))
#define XB_XSUB(j)  (1280 + 64 * (j))
#define XB_XGEN(j)  (2304 + 64 * (j))
#define XB_TOP      3328
#define XB_TOPGEN   3392
#define XCD_BAR_WORDS 3456
#define XB_SPIN_CAP (1u << 18)

__device__ __forceinline__ unsigned xb_ld(unsigned* p)              { return __hip_atomic_load(p, __ATOMIC_RELAXED, __HIP_MEMORY_SCOPE_AGENT); }
__device__ __forceinline__ unsigned xb_add(unsigned* p, unsigned v) { return __hip_atomic_fetch_add(p, v, __ATOMIC_RELAXED, __HIP_MEMORY_SCOPE_AGENT); }
__device__ __forceinline__ unsigned xb_xcc_id() { return (unsigned)__builtin_amdgcn_s_getreg((3 << 11) | 20) & 0xFu; }
#define XB_SPIN(cond, bar) do { unsigned _sp = 0; while (cond) { __builtin_amdgcn_s_sleep(1); \
    if ((++_sp & 255u) == 0u) { if (xb_ld(&(bar)[XB_TMO])) break; if (_sp > XB_SPIN_CAP) { atomicAdd(&(bar)[XB_TMO], 1u); break; } } } } while (0)

struct XcdBarrier {
    unsigned* bar; unsigned x;
    volatile LAS unsigned* st;
};

__device__ __forceinline__ XcdBarrier xcd_barrier_post(unsigned* bar, volatile LAS unsigned* st) {
    XcdBarrier b; b.bar = bar; b.x = xb_xcc_id(); b.st = st;
    if (threadIdx.x == 0) (void)xb_add(&bar[XB_XCNT(b.x)], 1u);
    return b;
}
__device__ __forceinline__ void xcd_barrier_complete(unsigned* bar, unsigned x, unsigned& nloc, unsigned& nx) {
    const unsigned G = gridDim.x * gridDim.y * gridDim.z;
    unsigned sum, cnt, mine, sp = 0u;
    for (;;) {
        sum = 0u; cnt = 0u; mine = 0u;
#pragma unroll
        for (unsigned j = 0; j < 16; ++j) { const unsigned c = xb_ld(&bar[XB_XCNT(j)]); sum += c; cnt += (c > 0u) ? 1u : 0u; mine = (j == x) ? c : mine; }
        if (sum == G) break;
        __builtin_amdgcn_s_sleep(1);
        if ((++sp & 255u) == 0u) { if (xb_ld(&bar[XB_TMO])) break; if (sp > XB_SPIN_CAP) { atomicAdd(&bar[XB_TMO], 1u); break; } }
    }
    nloc = mine > 0u ? mine : 1u; nx = cnt > 0u ? cnt : 1u;
}

__device__ __forceinline__ void xcd_barrier(const XcdBarrier& b) {
    asm volatile("s_waitcnt vmcnt(0)" ::: "memory");
    __syncthreads();
    if (threadIdx.x == 0) {
        unsigned* bar = b.bar;
        __builtin_amdgcn_s_waitcnt(0);
        unsigned nloc = b.st[0], nx = b.st[1];
        if (nloc == 0u) { xcd_barrier_complete(bar, b.x, nloc, nx); b.st[0] = nloc; b.st[1] = nx; }
        const unsigned old = xb_add(&bar[XB_XSUB(b.x)], 1u);
        const unsigned gen = old / nloc;
        if (old + 1u == (gen + 1u) * nloc) {
            __builtin_amdgcn_fence(__ATOMIC_RELEASE, "agent");
            asm volatile("s_waitcnt vmcnt(0)" ::: "memory");
            const unsigned og = xb_add(&bar[XB_TOP], 1u);
            const unsigned tg = og / nx;
            if (og + 1u == (tg + 1u) * nx) xb_add(&bar[XB_TOPGEN], 1u);
            else XB_SPIN(xb_ld(&bar[XB_TOPGEN]) == tg, bar);
            __builtin_amdgcn_fence(__ATOMIC_ACQUIRE, "agent");
            xb_add(&bar[XB_XGEN(b.x)], 1u);
            asm volatile("s_waitcnt vmcnt(0)" ::: "memory");
        } else {
            XB_SPIN(xb_ld(&bar[XB_XGEN(b.x)]) == gen, bar);
            __builtin_amdgcn_fence(__ATOMIC_ACQUIRE, "agent");
            asm volatile("s_waitcnt vmcnt(0)" ::: "memory");
        }
    }
    __syncthreads();
}
#define MFMA16(a, b, c) __builtin_amdgcn_mfma_f32_16x16x32_bf16((a), (b), (c), 0, 0, 0)
constexpr int RQ = 0, RK = 17408, RKT = 34816, RVT = 53248, RP = 71680, RST = 80896, RO = 115712;
__device__ __forceinline__ void ret_item(const Params& P, LAS unsigned char* lds, int tid, int wave, int lane, int h, int row0, int nchunks, const float* st_in, bool has_in, float* st_out) {
    const bf16* proj = (const bf16*)(P.ws + WS_R1);
    bf16* mix = (bf16*)(P.ws + WS_R2);
    const int fr = lane & 15, fq = lane >> 4;
    const float lg2 = log2f(1.0f - exp2f(-5.0f - (float)h));
    const float kscale = 0.08838834764831845f;
    LAS bf16* Qs = (LAS bf16*)(lds + RQ); LAS bf16* Ks = (LAS bf16*)(lds + RK); LAS bf16* KT = (LAS bf16*)(lds + RKT); LAS bf16* VT = (LAS bf16*)(lds + RVT);
    LAS bf16* Ps = (LAS bf16*)(lds + RP); LAS bf16* ST = (LAS bf16*)(lds + RST); LAS float* Os = (LAS float*)(lds + RO);
    f32x4 st[8];
#pragma unroll
    for (int et = 0; et < 8; ++et) {
        f32x4 v;
#pragma unroll
        for (int r = 0; r < 4; ++r) v[r] = st_in[(size_t)(16 * wave + 4 * fq + r) * 128 + 16 * et + fr];
        asm volatile("" : "+v"(v));
#pragma unroll
        for (int r = 0; r < 4; ++r) v[r] = has_in ? v[r] : 0.f;
        st[et] = v;
    }
    __syncthreads();
#pragma unroll
    for (int et = 0; et < 8; ++et) { u32x2 w; w.x = pk2(st[et][0], st[et][1]); w.y = pk2(st[et][2], st[et][3]); *(LAS u32x2*)(ST + (16 * et + fr) * 136 + 16 * wave + 4 * fq) = w; }
    const size_t goff = (size_t)lane * INW + h * 128 + wave * 16;
    u32x4 pq[2], pk[2], pv[2];
    { const bf16* g = proj + (size_t)row0 * INW + goff;
      pq[0] = *(const u32x4*)(g); pq[1] = *(const u32x4*)(g + 8); pk[0] = *(const u32x4*)(g + 512); pk[1] = *(const u32x4*)(g + 520); pv[0] = *(const u32x4*)(g + 1024); pv[1] = *(const u32x4*)(g + 1032); }
    const float kf = kscale * exp2f(lg2 * (float)(63 - lane));
    const float g64 = exp2f(lg2 * 64.0f);
    for (int c = 0; c < nchunks; ++c) {
        const int rowc = row0 + 64 * c;
        *(LAS u32x4*)(Qs + lane * 136 + wave * 16) = pq[0]; *(LAS u32x4*)(Qs + lane * 136 + wave * 16 + 8) = pq[1];
        *(LAS u32x4*)(Ks + lane * 136 + wave * 16) = pk[0]; *(LAS u32x4*)(Ks + lane * 136 + wave * 16 + 8) = pk[1];
#pragma unroll
        for (int i = 0; i < 2; ++i)
#pragma unroll
            for (int j = 0; j < 4; ++j) { const unsigned wk = pk[i][j], wv = pv[i][j]; const int d = wave * 16 + i * 8 + j * 2;
                const unsigned kk = pk2(bflo(wk) * kf, bfhi(wk) * kf);
                KT[(d) * 72 + lane] = (bf16)(kk & 0xffffu); KT[(d + 1) * 72 + lane] = (bf16)(kk >> 16);
                VT[(d) * 72 + lane] = (bf16)(wv & 0xffffu); VT[(d + 1) * 72 + lane] = (bf16)(wv >> 16); }
        if (c + 1 < nchunks) { const bf16* g = proj + (size_t)(rowc + 64) * INW + goff;
            pq[0] = *(const u32x4*)(g); pq[1] = *(const u32x4*)(g + 8); pk[0] = *(const u32x4*)(g + 512); pk[1] = *(const u32x4*)(g + 520); pv[0] = *(const u32x4*)(g + 1024); pv[1] = *(const u32x4*)(g + 1032); }
        __syncthreads();
        { const int mi = wave >> 1;
#pragma unroll
          for (int jj = 0; jj < 2; ++jj) { const int lj = 2 * (wave & 1) + jj; f32x4 s = (f32x4){0.f, 0.f, 0.f, 0.f};
#pragma unroll
            for (int ks = 0; ks < 4; ++ks) { const bf16x8 a = *(const LAS bf16x8*)(Ks + (16 * mi + fr) * 136 + 32 * ks + 8 * fq), b = *(const LAS bf16x8*)(Qs + (16 * lj + fr) * 136 + 32 * ks + 8 * fq); s = MFMA16(a, b, s); }
            const int l = 16 * lj + fr; float pvv[4];
#pragma unroll
            for (int r = 0; r < 4; ++r) { const int m = 16 * mi + 4 * fq + r; const int dlt = l - m; pvv[r] = dlt >= 0 ? s[r] * kscale * exp2f(lg2 * (float)dlt) : 0.f; }
            u32x2 w; w.x = pk2(pvv[0], pvv[1]); w.y = pk2(pvv[2], pvv[3]); *(LAS u32x2*)(Ps + l * 72 + 16 * mi + 4 * fq) = w; } }
#pragma unroll
        for (int et = 0; et < 8; ++et) st[et] = st[et] * g64;
#pragma unroll
        for (int ks = 0; ks < 2; ++ks) { const bf16x8 a = *(const LAS bf16x8*)(KT + (16 * wave + fr) * 72 + 32 * ks + 8 * fq);
#pragma unroll
            for (int et = 0; et < 8; ++et) { const bf16x8 b = *(const LAS bf16x8*)(VT + (16 * et + fr) * 72 + 32 * ks + 8 * fq); st[et] = MFMA16(a, b, st[et]); } }
        __syncthreads();
        { f32x4 oi[4], oc[4];
#pragma unroll
          for (int lt = 0; lt < 4; ++lt) { oi[lt] = (f32x4){0.f, 0.f, 0.f, 0.f}; oc[lt] = (f32x4){0.f, 0.f, 0.f, 0.f}; }
#pragma unroll
          for (int ks = 0; ks < 2; ++ks) { const bf16x8 b = *(const LAS bf16x8*)(VT + (16 * wave + fr) * 72 + 32 * ks + 8 * fq);
#pragma unroll
            for (int lt = 0; lt < 4; ++lt) { const bf16x8 a = *(const LAS bf16x8*)(Ps + (16 * lt + fr) * 72 + 32 * ks + 8 * fq); oi[lt] = MFMA16(a, b, oi[lt]); } }
#pragma unroll
          for (int ks = 0; ks < 4; ++ks) { const bf16x8 b = *(const LAS bf16x8*)(ST + (16 * wave + fr) * 136 + 32 * ks + 8 * fq);
#pragma unroll
            for (int lt = 0; lt < 4; ++lt) { const bf16x8 a = *(const LAS bf16x8*)(Qs + (16 * lt + fr) * 136 + 32 * ks + 8 * fq); oc[lt] = MFMA16(a, b, oc[lt]); } }
#pragma unroll
          for (int lt = 0; lt < 4; ++lt)
#pragma unroll
            for (int r = 0; r < 4; ++r) { const int l = 16 * lt + 4 * fq + r; Os[l * 132 + 16 * wave + fr] = oi[lt][r] + exp2f(lg2 * (float)(l + 1)) * oc[lt][r]; } }
        __syncthreads();
#pragma unroll
        for (int et = 0; et < 8; ++et) { u32x2 w; w.x = pk2(st[et][0], st[et][1]); w.y = pk2(st[et][2], st[et][3]); *(LAS u32x2*)(ST + (16 * et + fr) * 136 + 16 * wave + 4 * fq) = w; }
        { unsigned gv[8];
#pragma unroll
          for (int i = 0; i < 8; ++i) gv[i] = *(const unsigned*)(proj + (size_t)(rowc + 8 * wave + i) * INW + 1536 + h * 128 + 2 * lane);
#pragma unroll
          for (int i = 0; i < 8; ++i) { const int l = 8 * wave + i; const f32x2 o = *(const LAS f32x2*)(Os + l * 132 + 2 * lane);
            const float ssq = wave_sum_dpp(o.x * o.x + o.y * o.y); const float rstd = rsqrtf(ssq * (1.f / 128.f) + EPS);
            const float g0 = bflo(gv[i]), g1 = bfhi(gv[i]);
            *(unsigned*)(mix + (size_t)(rowc + l) * DM + h * 128 + 2 * lane) = pk2(silu_f(g0) * o.x * rstd, silu_f(g1) * o.y * rstd); } }
    }
#pragma unroll
    for (int et = 0; et < 8; ++et)
#pragma unroll
        for (int r = 0; r < 4; ++r) st_out[(size_t)(16 * wave + 4 * fq + r) * 128 + 16 * et + fr] = st[et][r];
}
constexpr int AK = 0, AVT = 27648;
__device__ __forceinline__ void att_item(const Params& P, LAS unsigned char* lds, int tid, int wave, int lane, bool sample, int b, int n, int g) {
    const bf16* proj = (const bf16*)(P.ws + WS_R1);
    bf16* mix = (bf16*)(P.ws + WS_R2);
    const int fr = lane & 15, fq = lane >> 4;
    LAS bf16* Kl = (LAS bf16*)(lds + AK); LAS bf16* VTl = (LAS bf16*)(lds + AVT);
    const int qrow0 = sample ? MP + 64 * b : b * SEQ + 64 * n;
    const int jmin = sample ? 0 : (n >= 2 ? 0 : 64 * (2 - n));
    __syncthreads();
    {
        u32x4 kw[3], vw[3];
        if (!sample) {
#pragma unroll
            for (int i = 0; i < 3; ++i) { const bool ok = 64 * i >= jmin;
                const int rb = ok ? b * SEQ + 64 * (n - 2) + 64 * i : qrow0;
                kw[i] = *(const u32x4*)(proj + (size_t)(rb + (tid >> 3)) * INW + 2560 + g * 64 + 8 * (tid & 7));
                vw[i] = *(const u32x4*)(proj + (size_t)(rb + lane) * INW + 2688 + g * 64 + 8 * wave);
                if (!ok) { kw[i] = (u32x4){0u, 0u, 0u, 0u}; vw[i] = (u32x4){0u, 0u, 0u, 0u}; } }
        } else {
            f32x4 kc[2][2], vc[2][2];
#pragma unroll
            for (int i = 0; i < 2; ++i) { const float* sk = P.cache_k + ((size_t)(b * 128 + 64 * i + (tid >> 3)) * 2 + g) * 64 + 8 * (tid & 7); const float* sv = P.cache_v + ((size_t)(b * 128 + 64 * i + lane) * 2 + g) * 64 + 8 * wave;
                kc[i][0] = *(const f32x4*)sk; kc[i][1] = *(const f32x4*)(sk + 4); vc[i][0] = *(const f32x4*)sv; vc[i][1] = *(const f32x4*)(sv + 4); }
            kw[2] = *(const u32x4*)(proj + (size_t)(MP + 64 * b + (tid >> 3)) * INW + 2560 + g * 64 + 8 * (tid & 7));
            vw[2] = *(const u32x4*)(proj + (size_t)(MP + 64 * b + lane) * INW + 2688 + g * 64 + 8 * wave);
#pragma unroll
            for (int i = 0; i < 2; ++i) { kw[i].x = pk2(kc[i][0].x, kc[i][0].y); kw[i].y = pk2(kc[i][0].z, kc[i][0].w); kw[i].z = pk2(kc[i][1].x, kc[i][1].y); kw[i].w = pk2(kc[i][1].z, kc[i][1].w);
                vw[i].x = pk2(vc[i][0].x, vc[i][0].y); vw[i].y = pk2(vc[i][0].z, vc[i][0].w); vw[i].z = pk2(vc[i][1].x, vc[i][1].y); vw[i].w = pk2(vc[i][1].z, vc[i][1].w); }
        }
#pragma unroll
        for (int i = 0; i < 3; ++i) { *(LAS u32x4*)(Kl + (64 * i + (tid >> 3)) * 72 + 8 * (tid & 7)) = kw[i];
            const int j = 64 * i + lane;
#pragma unroll
            for (int e = 0; e < 4; ++e) { VTl[(8 * wave + 2 * e) * 200 + j] = (bf16)(vw[i][e] & 0xffffu); VTl[(8 * wave + 2 * e + 1) * 200 + j] = (bf16)(vw[i][e] >> 16); } }
    }
    const int r = wave >> 1, qh = wave & 1, head = 4 * g + r;
    const float slope = exp2f(-(float)(head + 1));
    const float sink = P.sinks[head];
    const float L2E = 1.4426950408889634f;
    __syncthreads();
#pragma unroll 1
    for (int qt = 0; qt < 2; ++qt) {
        asm volatile("" ::: "memory");
        const int qi = 32 * qh + 16 * qt + fr;
        bf16x8 qf[2];
#pragma unroll
        for (int ks = 0; ks < 2; ++ks) qf[ks] = *(const bf16x8*)(proj + (size_t)(qrow0 + qi) * INW + 2048 + head * 64 + 32 * ks + 8 * fq);
        f32x4 s[12];
#pragma unroll
        for (int kt = 0; kt < 12; ++kt) { s[kt] = (f32x4){0.f, 0.f, 0.f, 0.f};
#pragma unroll
            for (int ks = 0; ks < 2; ++ks) { const bf16x8 a = *(const LAS bf16x8*)(Kl + (16 * kt + fr) * 72 + 32 * ks + 8 * fq); s[kt] = MFMA16(a, qf[ks], s[kt]); } }
        float mx = sink;
#pragma unroll
        for (int kt = 0; kt < 12; ++kt)
#pragma unroll
            for (int rr = 0; rr < 4; ++rr) { const int j = 16 * kt + 4 * fq + rr; const int dist = 128 + qi - j;
                float v = s[kt][rr] * 0.125f - slope * fabsf((float)dist);
                v = j >= jmin ? v : -INFINITY; s[kt][rr] = v; mx = fmaxf(mx, v); }
        mx = fmaxf(mx, __shfl_xor(mx, 16)); mx = fmaxf(mx, __shfl_xor(mx, 32));
        float ls = 0.f;
#pragma unroll
        for (int kt = 0; kt < 12; ++kt)
#pragma unroll
            for (int rr = 0; rr < 4; ++rr) { const float p = exp2f((s[kt][rr] - mx) * L2E); s[kt][rr] = p; ls += p; }
        ls += __shfl_xor(ls, 16); ls += __shfl_xor(ls, 32);
        const float inv = 1.0f / (ls + exp2f((sink - mx) * L2E));
        f32x4 o[4];
#pragma unroll
        for (int dt = 0; dt < 4; ++dt) o[dt] = (f32x4){0.f, 0.f, 0.f, 0.f};
#pragma unroll
        for (int kk = 0; kk < 6; ++kk) {
            u32x4 w; w.x = pk2(s[2 * kk][0], s[2 * kk][1]); w.y = pk2(s[2 * kk][2], s[2 * kk][3]); w.z = pk2(s[2 * kk + 1][0], s[2 * kk + 1][1]); w.w = pk2(s[2 * kk + 1][2], s[2 * kk + 1][3]);
            const bf16x8 pb = __builtin_bit_cast(bf16x8, w);
#pragma unroll
            for (int dt = 0; dt < 4; ++dt) { const LAS bf16* vp = VTl + (16 * dt + fr) * 200 + 32 * kk + 4 * fq;
                const u32x2 lo = *(const LAS u32x2*)vp, hi = *(const LAS u32x2*)(vp + 16);
                const u32x4 aw = (u32x4){lo.x, lo.y, hi.x, hi.y}; const bf16x8 a = __builtin_bit_cast(bf16x8, aw);
                o[dt] = MFMA16(a, pb, o[dt]); }
        }
        bf16* mp = mix + (size_t)(qrow0 + qi) * DM + 512 + head * 64 + 4 * fq;
#pragma unroll
        for (int dt = 0; dt < 4; ++dt) { const f32x4 v = o[dt] * inv; u32x2 w; w.x = pk2(v[0], v[1]); w.y = pk2(v[2], v[3]); *(u32x2*)(mp + 16 * dt) = w; }
    }
}
__device__ __forceinline__ void phase3(const Params& P, LAS unsigned char* lds, int tid, int wave, int lane) {
    const int G = gridDim.x, NR = G / 2, blk = blockIdx.x;
    if (blk < NR) {
#ifndef NO_RET
#ifdef PROBE_RETX2
        for (int rep = 0; rep < 2; ++rep)
#endif
        for (int it = blk; it < 256; it += NR) {
            const bool sample = it >= 128; const int bh = it & 127, b = bh >> 2, h = bh & 3;
            ret_item(P, lds, tid, wave, lane, h, sample ? MP + 64 * b : b * SEQ, sample ? 1 : 32, P.state_ret + (size_t)bh * 16384, sample, P.out + (sample ? OFF_SRET : OFF_PRET) + (size_t)bh * 16384);
        }
#endif
    } else {
#ifndef NO_ATT
#ifdef PROBE_ATTX2
        for (int rep = 0; rep < 2; ++rep)
#endif
        for (int it = blk - NR; it < 2112; it += G - NR) {
            const bool sample = it >= 2048;
            att_item(P, lds, tid, wave, lane, sample, sample ? (it - 2048) >> 1 : it >> 6, sample ? 2 : (it >> 1) & 31, it & 1);
        }
#endif
    }
}

__device__ __forceinline__ void phase6(const Params& P, int tid) {
    const bf16* ua = (const bf16*)(P.ws + WS_R1); bf16* ub = (bf16*)(P.ws + WS_R2);
    constexpr int CH = DFF / 8;
    const int total = MT * CH;
    for (int idx = blockIdx.x * 512 + tid; idx < total; idx += gridDim.x * 512) {
        const int row = idx / CH, j = (idx - row * CH) * 8;
        const bool smp = row >= MP; const int t = smp ? ((row - MP) & 63) : (row & 2047);
        float a[8], p1[8], p2[8], bb[8];
        unpack8(*(const u32x4*)(ua + (size_t)row * DFF + j), a);
        unpack8(*(const u32x4*)(ub + (size_t)row * DFF + j), bb);
        if (t >= 1) unpack8(*(const u32x4*)(ua + (size_t)(row - 1) * DFF + j), p1);
        else if (smp) { const float* s = P.state_conv + ((size_t)((row - MP) >> 6) * 2 + 1) * DFF + j; const f32x4 x = *(const f32x4*)s, y = *(const f32x4*)(s + 4); p1[0] = x.x; p1[1] = x.y; p1[2] = x.z; p1[3] = x.w; p1[4] = y.x; p1[5] = y.y; p1[6] = y.z; p1[7] = y.w; }
        else {
#pragma unroll
            for (int e = 0; e < 8; ++e) p1[e] = 0.f; }
        if (t >= 2) unpack8(*(const u32x4*)(ua + (size_t)(row - 2) * DFF + j), p2);
        else if (smp) { const float* s = P.state_conv + ((size_t)((row - MP) >> 6) * 2 + t) * DFF + j; const f32x4 x = *(const f32x4*)s, y = *(const f32x4*)(s + 4); p2[0] = x.x; p2[1] = x.y; p2[2] = x.z; p2[3] = x.w; p2[4] = y.x; p2[5] = y.y; p2[6] = y.z; p2[7] = y.w; }
        else {
#pragma unroll
            for (int e = 0; e < 8; ++e) p2[e] = 0.f; }
        float r[8];
#pragma unroll
        for (int h = 0; h < 2; ++h) { const f32x4 w0 = *(const f32x4*)(P.conv_w + j + 4 * h), w1 = *(const f32x4*)(P.conv_w + DFF + j + 4 * h), w2 = *(const f32x4*)(P.conv_w + 2 * DFF + j + 4 * h), cb = *(const f32x4*)(P.conv_b + j + 4 * h);
#pragma unroll
            for (int e = 0; e < 4; ++e) { const float cv = cb[e] + w0[e] * p2[4 * h + e] + w1[e] * p1[4 * h + e] + w2[e] * a[4 * h + e]; r[4 * h + e] = silu_f(cv) * bb[4 * h + e]; } }
        u32x4 w; w.x = pk2(r[0], r[1]); w.y = pk2(r[2], r[3]); w.z = pk2(r[4], r[5]); w.w = pk2(r[6], r[7]);
        *(u32x4*)(ub + (size_t)row * DFF + j) = w;
    }
}
#ifdef CONV_FUSED
__device__ __forceinline__ void phase6c(const Params& P, int tid) {
    const float* headA = (const float*)(P.ws + WS_R1); const float* headB = headA + HT_STRIDE; const float* tailA = headA + 2 * HT_STRIDE;
    bf16* act = (bf16*)(P.ws + WS_R2);
    constexpr int CH = DFF / 4;
    const int total = NGRP * CH;
    for (int idx = blockIdx.x * 512 + tid; idx < total; idx += gridDim.x * 512) {
        const int g = idx / CH, j = (idx - g * CH) * 4;
        const bool smp = g >= 1024, first = !smp && (g & 31) == 0;
        const float* pp = smp ? P.state_conv + ((size_t)(g - 1024) * 2) * DFF + j : tailA + ((size_t)(first ? g : g - 1) * 2) * DFF + j;
        f32x4 p0 = *(const f32x4*)pp, p1 = *(const f32x4*)(pp + DFF);
        const f32x4 a0 = *(const f32x4*)(headA + ((size_t)g * 2) * DFF + j), a1 = *(const f32x4*)(headA + ((size_t)g * 2 + 1) * DFF + j);
        const f32x4 b0 = *(const f32x4*)(headB + ((size_t)g * 2) * DFF + j), b1 = *(const f32x4*)(headB + ((size_t)g * 2 + 1) * DFF + j);
        const f32x4 t0 = *(const f32x4*)(tailA + ((size_t)g * 2) * DFF + j), t1 = *(const f32x4*)(tailA + ((size_t)g * 2 + 1) * DFF + j);
        const f32x4 w0 = *(const f32x4*)(P.conv_w + j), w1 = *(const f32x4*)(P.conv_w + DFF + j), w2 = *(const f32x4*)(P.conv_w + 2 * DFF + j), cb = *(const f32x4*)(P.conv_b + j);
        if (first) { p0 = (f32x4){0.f, 0.f, 0.f, 0.f}; p1 = (f32x4){0.f, 0.f, 0.f, 0.f}; }
        const f32x4 c0 = cb + w0 * p0 + w1 * p1 + w2 * a0, c1 = cb + w0 * p1 + w1 * a0 + w2 * a1;
        u32x2 r0, r1;
        r0.x = pk2(silu_f(c0.x) * b0.x, silu_f(c0.y) * b0.y); r0.y = pk2(silu_f(c0.z) * b0.z, silu_f(c0.w) * b0.w);
        r1.x = pk2(silu_f(c1.x) * b1.x, silu_f(c1.y) * b1.y); r1.y = pk2(silu_f(c1.z) * b1.z, silu_f(c1.w) * b1.w);
        *(u32x2*)(act + (size_t)(64 * g) * DFF + j) = r0;
        *(u32x2*)(act + (size_t)(64 * g + 1) * DFF + j) = r1;
        if (smp) { float* d = P.out + OFF_SCONV + ((size_t)(g - 1024) * 2) * DFF + j; *(f32x4*)d = t0; *(f32x4*)(d + DFF) = t1; }
        else if ((g & 31) == 31) { float* d = P.out + OFF_PCONV + ((size_t)(g >> 5) * 2) * DFF + j; *(f32x4*)d = t0; *(f32x4*)(d + DFF) = t1; }
    }
}
#endif
__device__ __forceinline__ void phase8n(const Params& P, LAS unsigned char* lds, int tid, int wave, int lane) {
    const float* mod = (const float*)(P.ws + WS_MOD); const bf16* x2 = (const bf16*)(P.ws + WS_R0);
    LAS float* lv = (LAS float*)lds;
    const int b = blockIdx.x, bsP = b >> 3, bsS = 32 + (b >> 3);
    __syncthreads();
    for (int i = tid; i < 4096; i += 512) { const int sl = i >> 11, which = (i >> 10) & 1, col = i & 1023; const float* mb = mod + (size_t)(sl ? bsS : bsP) * 8192 + 6144;
        lv[i] = which ? P.normf[col] * (1.f + mb[1024 + col]) : mb[col]; }
    __syncthreads();
#pragma unroll 4
    for (int r = wave; r < 256; r += 8) {
        const int row = 256 * b + r;
        const bf16* xr = x2 + (size_t)row * DM + 4 * lane;
        f32x4 v[4]; float ss = 0.f;
#pragma unroll
        for (int j = 0; j < 4; ++j) { const u32x2 w = *(const u32x2*)(xr + 256 * j); v[j] = (f32x4){bflo(w.x), bfhi(w.x), bflo(w.y), bfhi(w.y)};
            ss += (v[j].x * v[j].x + v[j].y * v[j].y) + (v[j].z * v[j].z + v[j].w * v[j].w); }
        const float rstd = __builtin_amdgcn_rsqf(wave_sum_dpp(ss) * (1.f / DM) + EPS);
        float* yr = P.out + (size_t)row * DM + 4 * lane;
#pragma unroll
        for (int j = 0; j < 4; ++j) { const f32x4 sh = *(const LAS f32x4*)(lv + 256 * j + 4 * lane), gs = *(const LAS f32x4*)(lv + 1024 + 256 * j + 4 * lane);
            *(f32x4*)(yr + 256 * j) = v[j] * rstd * gs + sh; }
    }
    {
        const int r = 8 * b + wave, row = MP + r;
        const bf16* xr = (const bf16*)(P.ws + WS_X1B) + (size_t)row * DM + 4 * lane;
        const float* sl = (const float*)(P.ws + WS_SLAB) + (size_t)r * DM + 4 * lane;
        const float* g2 = mod + (size_t)bsS * 8192 + 5120 + 4 * lane;
        f32x4 v[4]; float ss = 0.f;
#pragma unroll
        for (int j = 0; j < 4; ++j) { const u32x2 w = *(const u32x2*)(xr + 256 * j); f32x4 a = *(const f32x4*)(sl + 256 * j);
#pragma unroll
            for (int p = 1; p < 4; ++p) a += *(const f32x4*)(sl + (size_t)p * MS * DM + 256 * j);
            v[j] = (f32x4){bflo(w.x), bfhi(w.x), bflo(w.y), bfhi(w.y)} + *(const f32x4*)(g2 + 256 * j) * a;
            ss += (v[j].x * v[j].x + v[j].y * v[j].y) + (v[j].z * v[j].z + v[j].w * v[j].w); }
        const float rstd = __builtin_amdgcn_rsqf(wave_sum_dpp(ss) * (1.f / DM) + EPS);
        float* yr = P.out + (size_t)row * DM + 4 * lane;
#pragma unroll
        for (int j = 0; j < 4; ++j) { const f32x4 sh = *(const LAS f32x4*)(lv + 2048 + 256 * j + 4 * lane), gs = *(const LAS f32x4*)(lv + 3072 + 256 * j + 4 * lane);
            *(f32x4*)(yr + 256 * j) = v[j] * rstd * gs + sh; }
    }
}
__device__ __forceinline__ void phase8(const Params& P, int wave, int lane) {
    const float* mod = (const float*)(P.ws + WS_MOD); const bf16* x2 = (const bf16*)(P.ws + WS_R0);
    const int gw = blockIdx.x * 8 + wave, NGW = gridDim.x * 8;
#pragma unroll 2
    for (int row = gw; row < MT; row += NGW) {
        const int bs = row < MP ? (row >> 11) : 32 + ((row - MP) >> 6);
        float* yr = P.out + (size_t)row * DM + 8 * lane;
        const float* mb = mod + (size_t)bs * 8192 + 6144 + 8 * lane;
        float v[2][8]; float ss = 0.f;
        if (row < MP) {
            const bf16* xr = x2 + (size_t)row * DM + 8 * lane;
#pragma unroll
            for (int j = 0; j < 2; ++j) unpack8(*(const u32x4*)(xr + 512 * j), v[j]);
        } else {
            const bf16* xr = (const bf16*)(P.ws + WS_X1B) + (size_t)row * DM + 8 * lane;
            const float* sl = (const float*)(P.ws + WS_SLAB) + (size_t)(row - MP) * DM + 8 * lane;
            const float* g2 = mod + (size_t)bs * 8192 + 5120 + 8 * lane;
#pragma unroll
            for (int j = 0; j < 2; ++j) { unpack8(*(const u32x4*)(xr + 512 * j), v[j]);
#pragma unroll
                for (int h = 0; h < 2; ++h) { const int o = 512 * j + 4 * h; f32x4 a = *(const f32x4*)(sl + o);
#pragma unroll
                    for (int p = 1; p < 4; ++p) a += *(const f32x4*)(sl + (size_t)p * MS * DM + o);
                    const f32x4 g = *(const f32x4*)(g2 + o);
#pragma unroll
                    for (int e = 0; e < 4; ++e) v[j][4 * h + e] += g[e] * a[e]; } }
        }
#pragma unroll
        for (int j = 0; j < 2; ++j)
#pragma unroll
            for (int e = 0; e < 8; ++e) ss += v[j][e] * v[j][e];
        const float rstd = rsqrtf(wave_sum(ss) * (1.f / DM) + EPS);
#pragma unroll
        for (int j = 0; j < 2; ++j)
#pragma unroll
            for (int h = 0; h < 2; ++h) { const int o = 512 * j + 4 * h; const f32x4 sh = *(const f32x4*)(mb + o), sc = *(const f32x4*)(mb + 1024 + o), gn = *(const f32x4*)(P.normf + 8 * lane + o);
                const f32x4 x = (f32x4){v[j][4 * h], v[j][4 * h + 1], v[j][4 * h + 2], v[j][4 * h + 3]};
                *(f32x4*)(yr + o) = x * rstd * gn * (sc + 1.0f) + sh; }
    }
}
__device__ __forceinline__ void phase8q(const Params& P, LAS unsigned char* lds, int tid, int wave, int lane) {
    const float* mod = (const float*)(P.ws + WS_MOD);
    unsigned* cnt = (unsigned*)(P.ws + WS_CNT7); unsigned* ticket = (unsigned*)(P.ws + WS_TICKET);
    LAS int* ord = (LAS int*)(lds + 131072);
    LAS int* flag = ord + 272;
    pg8::StaticOrder S; S.init(MT, DM, (int)gridDim.x, 0);
    for (int i = tid; i < NTM; i += 512) flag[i] = 0;
    __syncthreads();
    { const int full = (S.nwg / S.G) * S.G; for (int L = full + tid; L < S.nwg; L += 512) { pg8::Unit u; S.map(L, u); flag[u.pm] = 1; } }
    __syncthreads();
    if (tid == 0) { int k = 0; for (int i = 0; i < NTM; ++i) if (!flag[i]) ord[k++] = i; for (int i = 0; i < NTM; ++i) if (flag[i]) ord[k++] = i; }
    __syncthreads();
    for (;;) {
        if (tid == 0) flag[268] = (int)__hip_atomic_fetch_add(ticket, 1u, __ATOMIC_RELAXED, __HIP_MEMORY_SCOPE_AGENT);
        __syncthreads();
        const int tk = flag[268];
        if (tk >= NTM * 4) break;
        const int pm = ord[tk >> 2], rb = tk & 3;
        if (wave == 0) {
            unsigned spins = 0;
            while ((unsigned)__builtin_amdgcn_readfirstlane(__hip_atomic_load(cnt + 64 * pm, __ATOMIC_RELAXED, __HIP_MEMORY_SCOPE_AGENT)) < 32u) { __builtin_amdgcn_s_sleep(4); if (++spins > (1u << 22)) break; }
            __builtin_amdgcn_fence(__ATOMIC_ACQUIRE, "agent");
            asm volatile("s_waitcnt vmcnt(0)" ::: "memory");
        }
        __syncthreads();
#pragma unroll 2
        for (int i = 0; i < 8; ++i) {
            const int row = pm * 256 + rb * 64 + wave * 8 + i;
            const int bs = row < MP ? (row >> 11) : 32 + ((row - MP) >> 6);
            float* yr = P.out + (size_t)row * DM + 4 * lane;
            const float* mb = mod + (size_t)bs * 8192 + 6144 + 4 * lane;
            f32x4 v[4]; float ss = 0.f;
#pragma unroll
            for (int j = 0; j < 4; ++j) { v[j] = *(const f32x4*)(yr + 256 * j); ss += (v[j].x * v[j].x + v[j].y * v[j].y) + (v[j].z * v[j].z + v[j].w * v[j].w); }
            const float rstd = rsqrtf(wave_sum(ss) * (1.f / DM) + EPS);
#pragma unroll
            for (int j = 0; j < 4; ++j) { const f32x4 sh = *(const f32x4*)(mb + 256 * j), sc = *(const f32x4*)(mb + 1024 + 256 * j), gn = *(const f32x4*)(P.normf + 4 * lane + 256 * j);
                *(f32x4*)(yr + 256 * j) = v[j] * rstd * gn * (sc + 1.0f) + sh; }
        }
    }
}

__device__ __forceinline__ void sample_fix(const Params& P, int wave, int lane) {
    const float* mod = (const float*)(P.ws + WS_MOD); const float* sl0 = (const float*)(P.ws + WS_SLAB4);
    bf16* a2 = (bf16*)(P.ws + WS_R0); bf16* x1b = (bf16*)(P.ws + WS_X1B); float* ss1 = (float*)(P.ws + WS_SS1);
    const int gw = blockIdx.x * 8 + wave, NGW = gridDim.x * 8;
    for (int r = gw; r < MS; r += NGW) {
        const int row = MP + r, bs = 32 + (r >> 6);
        const float* xr = P.x_s + (size_t)r * DM + 8 * lane; const float* sl = sl0 + (size_t)r * DM + 8 * lane; const float* mb = mod + (size_t)bs * 8192 + 8 * lane;
        float v[2][8], a[2][8]; float ss = 0.f;
#pragma unroll
        for (int j = 0; j < 2; ++j)
#pragma unroll
            for (int h = 0; h < 2; ++h) { const int o = 512 * j + 4 * h; f32x4 acc = *(const f32x4*)(sl + o);
#pragma unroll
                for (int p = 1; p < 4; ++p) acc += *(const f32x4*)(sl + (size_t)p * MS * DM + o);
                const f32x4 x = *(const f32x4*)(xr + o) + *(const f32x4*)(mb + 2048 + o) * acc;
                const f32x4 gs = *(const f32x4*)(P.ln2 + 8 * lane + o) * (*(const f32x4*)(mb + 4096 + o) + 1.0f);
#pragma unroll
                for (int e = 0; e < 4; ++e) { v[j][4 * h + e] = x[e]; a[j][4 * h + e] = x[e] * gs[e]; ss += x[e] * x[e]; } }
        ss = wave_sum(ss);
#pragma unroll
        for (int j = 0; j < 2; ++j) { u32x4 w; w.x = pk2(v[j][0], v[j][1]); w.y = pk2(v[j][2], v[j][3]); w.z = pk2(v[j][4], v[j][5]); w.w = pk2(v[j][6], v[j][7]);
            *(u32x4*)(x1b + (size_t)row * DM + 8 * lane + 512 * j) = w;
            w.x = pk2(a[j][0], a[j][1]); w.y = pk2(a[j][2], a[j][3]); w.z = pk2(a[j][4], a[j][5]); w.w = pk2(a[j][6], a[j][7]);
            *(u32x4*)(a2 + (size_t)row * DM + 8 * lane + 512 * j) = w; }
        if (lane < 16) ss1[(size_t)row * 16 + lane] = lane == 0 ? ss : 0.f;
    }
}

#ifndef N_LAUNCH
#define N_LAUNCH 1
#endif
#define LAUNDER_TID() int tid = threadIdx.x; asm volatile("" : "+v"(tid)); const int lane = tid & 63, wave = __builtin_amdgcn_readfirstlane(tid >> 6); (void)lane; (void)wave
template <int PHM>
__global__ void __launch_bounds__(512) fwd_mega(Params P) {
    extern __shared__ __attribute__((aligned(16))) unsigned char lds_raw[];
    LAS unsigned char* lds = (LAS unsigned char*)lds_raw;
    const int G = gridDim.x;
    unsigned char* ws = P.ws;
    volatile LAS unsigned* misc = (volatile LAS unsigned*)(lds + LDS_MISC);
    if (threadIdx.x < 2) misc[threadIdx.x] = 0u;
    __syncthreads();
    XcdBarrier bar; bar.bar = (unsigned*)(ws + WS_BAR); bar.x = 0; bar.st = misc;
#define GSYNC(a, b) do { if ((PHM & (a)) && (PHM & (b))) xcd_barrier(bar); } while (0)
    if constexpr (PHM == 511) {
      if (blockIdx.x == 0) for (int i = threadIdx.x; i < XCD_BAR_WORDS; i += 512) ((unsigned*)(ws + WS_BAR))[i] = 0u;
      if (blockIdx.x == 1) { for (int i = threadIdx.x; i < NTM * 64; i += 512) ((unsigned*)(ws + WS_CNT7))[i] = 0u; if (threadIdx.x < 64) ((unsigned*)(ws + WS_TICKET))[threadIdx.x] = 0u; }
      cg::this_grid().sync();
      bar = xcd_barrier_post((unsigned*)(ws + WS_BAR), misc); }
    if constexpr ((PHM & 1) != 0) { LAUNDER_TID(); phase0(P, lds, wave, lane); }
    GSYNC(1, 2);
    if constexpr ((PHM & 2) != 0) { LAUNDER_TID(); phase1(P, lds, tid, wave, lane); }
    GSYNC(2, 4);
    if constexpr ((PHM & 4) != 0) {
      pg8::Gemm g{(const bf16*)(ws + WS_R0), (const bf16*)(ws + WS_WIN), MT, INW, DM};
      OrderX S; S.S.init(MT, INW, G, (int)blockIdx.x); S.nX = 22; S.xpm = NTM; S.xpn0 = 11;
      Epi1 E{(bf16*)(ws + WS_R1), (float*)(ws + WS_SHW), P.out};
      pg8::gemm_phase<Epi1, OrderX, true, true>(lds, g, S, E); }
    GSYNC(4, 8);
    if constexpr ((PHM & 8) != 0) { LAUNDER_TID(); phase3(P, lds, tid, wave, lane);
#ifdef PROBE_P3X2
      cg::this_grid().sync(); phase3(P, lds, tid, wave, lane);
#endif
    }
    GSYNC(8, 16);
    if constexpr ((PHM & 16) != 0) {
      pg8::Gemm g{(const bf16*)(ws + WS_R2), (const bf16*)(ws + WS_WOUT), MT, DM, DM};
      OrderDown S; S.S.init(MP, DM, G, (int)blockIdx.x); S.ka = 4; S.kb = 4;
      Epi2 E{P.x_p, P.x_s, (const float*)(ws + WS_MOD), P.ln2, (bf16*)(ws + WS_X1B), (bf16*)(ws + WS_R0), (float*)(ws + WS_SS1), (float*)(ws + WS_SLAB4)};
      pg8::gemm_phase<Epi2, OrderDown, true, true>(lds, g, S, E); }
    GSYNC(16, 32);
    if constexpr ((PHM & 32) != 0) {
      LAUNDER_TID();
      sample_fix(P, wave, lane);
      if constexpr (PHM == 511) xcd_barrier(bar);
      pg8::Gemm g{(const bf16*)(ws + WS_R0), (const bf16*)(ws + WS_WUP), MT, 2 * DFF, DM};
      pg8::StaticOrder S; S.init(MT, 2 * DFF, G, (int)blockIdx.x);
      LAS float* rtab = (LAS float*)(lds + 131072);
      { pg8::Unit u; const float* ss = (const float*)(ws + WS_SS1);
        for (int i = 0; S.next(i, u) && i < 24; ++i) if (tid < 256) { const f32x4* sp = (const f32x4*)(ss + (size_t)(u.pm * 256 + tid) * 16);
            const f32x4 q0 = sp[0], q1 = sp[1], q2 = sp[2], q3 = sp[3];
            const float tot = ((q0.x + q0.y) + (q0.z + q0.w)) + ((q1.x + q1.y) + (q1.z + q1.w)) + ((q2.x + q2.y) + (q2.z + q2.w)) + ((q3.x + q3.y) + (q3.z + q3.w));
            rtab[i * 256 + tid] = rsqrtf(tot * (1.f / DM) + EPS); }
        __syncthreads(); }
#ifdef CONV_FUSED
      float* hA = (float*)(ws + WS_R1);
      Epi3C E{rtab, (const float*)(ws + WS_SHW), P.conv_w, P.conv_b, (bf16*)(ws + WS_R2), hA, hA + HT_STRIDE, hA + 2 * HT_STRIDE};
      pg8::gemm_phase<Epi3C, pg8::StaticOrder, true, true>(lds, g, S, E);
#else
      Epi3 E{rtab, (const float*)(ws + WS_SHW), (bf16*)(ws + WS_R1), (bf16*)(ws + WS_R2), P.out};
      pg8::gemm_phase<Epi3, pg8::StaticOrder, true, true>(lds, g, S, E);
#endif
#ifdef PROBE_P5X2
      cg::this_grid().sync(); pg8::gemm_phase<Epi3, pg8::StaticOrder, true, true>(lds, g, S, E);
#endif
    }
    GSYNC(32, 64);
#ifdef CONV_FUSED
    if constexpr ((PHM & 64) != 0) { LAUNDER_TID(); phase6c(P, tid); }
#else
    if constexpr ((PHM & 64) != 0) { LAUNDER_TID(); phase6(P, tid); }
#endif
    GSYNC(64, 128);
    if constexpr ((PHM & 128) != 0) {
      pg8::Gemm g{(const bf16*)(ws + WS_R2), (const bf16*)(ws + WS_WDN), MT, DM, DFF};
#ifdef P8_QUEUE
      OrderPub S; S.init(MT, DM, G, (int)blockIdx.x); S.cnt = (unsigned*)(ws + WS_CNT7);
      Epi4 E{(const float*)(ws + WS_MOD), (const bf16*)(ws + WS_X1B), (bf16*)(ws + WS_R0), (float*)(ws + WS_SLAB)};
      pg8::gemm_phase<Epi4, OrderPub, true, true>(lds, g, S, E); }
    if constexpr ((PHM & 256) != 0) { LAUNDER_TID(); phase8q(P, lds, tid, wave, lane); }
#else
      OrderDown S; S.S.init(MP, DM, G, (int)blockIdx.x); S.ka = 12; S.kb = 10;
      Epi4 E{(const float*)(ws + WS_MOD), (const bf16*)(ws + WS_X1B), (bf16*)(ws + WS_R0), (float*)(ws + WS_SLAB)};
      pg8::gemm_phase<Epi4, OrderDown, true, true>(lds, g, S, E); }
    GSYNC(128, 256);
    if constexpr ((PHM & 256) != 0) { LAUNDER_TID(); if (gridDim.x == 256) phase8n(P, lds, tid, wave, lane); else phase8(P, wave, lane); }
#endif
}

template <int PHM> static bool launch_one(const Params& p, int grid, bool coop, hipStream_t stream) {
    static bool attr_done = false;
    if (!attr_done) { if (hipFuncSetAttribute((const void*)fwd_mega<PHM>, hipFuncAttributeMaxDynamicSharedMemorySize, LDS_BYTES) != hipSuccess) { fprintf(stderr, "kernel_launch: hipFuncSetAttribute failed\n"); return false; } attr_done = true; }
    hipError_t e;
    if (coop) { Params pc = p; void* args[] = {&pc}; e = hipLaunchCooperativeKernel((const void*)fwd_mega<PHM>, dim3(grid), dim3(512), args, LDS_BYTES, stream); }
    else { hipLaunchKernelGGL(fwd_mega<PHM>, dim3(grid), dim3(512), LDS_BYTES, stream, p); e = hipPeekAtLastError(); }
    if (e != hipSuccess) { fprintf(stderr, "launch (mask %d) failed: %s (grid %d)\n", PHM, hipGetErrorString(e), grid); return false; }
    return true;
}
extern "C" void kernel_launch(void* const* d_in, const int* in_sizes, int n_in, void* d_out, int out_size, void* d_ws, size_t ws_size, hipStream_t stream) {
    static int grid = 0;
    if (grid == 0) {
        if (n_in != 22 || (size_t)out_size != OUT_TOTAL || ws_size < WS_END) { fprintf(stderr, "kernel_launch: unexpected sizes n_in %d out %d ws %zu\n", n_in, out_size, ws_size); grid = -1; return; }
        int dev = 0, cus = 0;
        (void)hipGetDevice(&dev);
        (void)hipDeviceGetAttribute(&cus, hipDeviceAttributeMultiprocessorCount, dev);
        grid = cus;
        if (grid > 256) grid = 256;
        if (grid < 2) grid = -1;
    }
    if (grid < 0) return;
    Params p{};
    const float** pp = (const float**)&p;
    for (int i = 0; i < 22; ++i) pp[i] = (const float*)d_in[i];
    p.out = (float*)d_out; p.ws = (unsigned char*)d_ws;
#if N_LAUNCH == 1
    launch_one<511>(p, grid, true, stream);
#else
    launch_one<1>(p, grid, false, stream) && launch_one<2>(p, grid, false, stream) && launch_one<4>(p, grid, false, stream) && launch_one<8>(p, grid, false, stream) &&
    launch_one<16>(p, grid, false, stream) && launch_one<32>(p, grid, false, stream) && launch_one<64>(p, grid, false, stream) && launch_one<128>(p, grid, false, stream) && launch_one<256>(p, grid, false, stream);
#endif
}
```

```cpp
#define CONV_FUSED 1
#include <hip/hip_runtime.h>
#include <hip/hip_cooperative_groups.h>
#include <cstdio>
#include <cstdint>
namespace cg = cooperative_groups;
namespace pg8 {
#define PG8_LAS __attribute__((address_space(3)))
typedef unsigned short bf16_t;
typedef short bf16x8 __attribute__((ext_vector_type(8)));
typedef float f32x4 __attribute__((ext_vector_type(4)));
typedef unsigned u32x4 __attribute__((ext_vector_type(4)));
constexpr int BM = 256, BK = 64, HALF = 128, HTB = HALF * BK * 2  , STAGE_BYTES = 8 * HTB, NXCD = 8, WGM = 8;

__host__ __device__ __forceinline__ int lds_byte(int r, int c) { const int st = (r >> 4) * 2 + (c >> 5), rr = r & 15, cc = c & 31, ob = rr * 64 + cc * 2; return st * 1024 + (ob ^ (((ob >> 9) & 1) << 5)); }
__host__ __device__ __forceinline__ void stage_rc(int b, int& R, int& C) { const int st = b / 1024, sb = b % 1024, swz = sb ^ (((sb >> 9) & 1) << 5); R = (st >> 1) * 16 + swz / 64; C = (st & 1) * 32 + (swz % 64) / 2; }
__host__ __device__ __forceinline__ int perm32(int rho) { const int n = rho >> 4, i = rho & 15; return 8 * (i >> 2) + 4 * n + (i & 3); }

struct Unit { int pm, pn, seq, kt0, nt; };
struct Gemm { const bf16_t* A; const bf16_t* Bt; int M, N, K; };

struct StaticOrder {
    int nM, nN, nwg, G, c;
    __host__ __device__ __forceinline__ void init(int M, int N, int G_, int c_) { nM = M / BM; nN = N / BM; nwg = nM * nN; G = G_; c = c_; }
    __host__ __device__ __forceinline__ bool next(int i, Unit& u) const {
        const long L = (long)i * G + c; if (L >= nwg) return false; u.seq = i; u.kt0 = 0; u.nt = 0; map(L, u); return true; }
    __host__ __device__ __forceinline__ void map(long L, Unit& u) const {
        int wgid = (int)L; { const int q = nwg / NXCD, r = nwg % NXCD, xcd = wgid % NXCD, off = wgid / NXCD; wgid = (xcd < r ? xcd * (q + 1) : r * (q + 1) + (xcd - r) * q) + off; }
        const int nig = WGM * nN, gid = wgid / nig, fm = gid * WGM, gsz = (nM - fm) < WGM ? (nM - fm) : WGM;
        u.pm = fm + ((wgid % nig) % gsz); u.pn = (wgid % nig) / gsz;
    }
    __device__ __forceinline__ void a_ready(const Unit&) const {}
    __device__ __forceinline__ void done(const Unit&) const {}
};

__device__ __forceinline__ unsigned cvt_pk_bf16(float lo, float hi) { unsigned r; asm volatile("v_cvt_pk_bf16_f32 %0, %1, %2" : "=v"(r) : "v"(lo), "v"(hi)); return r; }

template <class Epi, class Sched, bool ALIGN_EPI = false, bool SP2 = false>
__device__ __forceinline__ void gemm_phase(PG8_LAS unsigned char* lds, const Gemm g, const Sched& S, const Epi& E) {
    int tid_ = threadIdx.x; asm volatile("" : "+v"(tid_));
    const int tid = tid_, wid = __builtin_amdgcn_readfirstlane(tid >> 6), lane = tid & 63, wr = wid >> 2, wc = wid & 3, fr = lane & 15, fq = lane >> 4;
    const int K = g.K, nt = K / BK;
    unsigned voffA[2], voffB[2];
#pragma unroll
    for (int i = 0; i < 2; ++i) { int R, C; stage_rc(tid * 16 + i * 8192, R, C); const int Rb = Epi::PERM ? ((R & ~31) + perm32(R & 31)) : R;
        voffA[i] = (unsigned)(R * K + C) * 2u; voffB[i] = (unsigned)(Rb * K + C) * 2u; }
    const size_t kstep = (size_t)(BK * 2);
    const size_t hstep = (size_t)HALF * K * 2;
    const size_t tstep = 2 * hstep;
    const unsigned ldsw = (unsigned)wid * 1024u;
    const int aoff = lds_byte(wr * 64 + fr, fq * 8), boff = lds_byte(wc * 32 + fr, fq * 8);
#define PG8_SA(b, h) (((b) * 2 + (h)) * HTB)
#define PG8_SB(b, h) ((4 + (b) * 2 + (h)) * HTB)
#define PG8_STAGE(bufoff, gbase, voff) do { _Pragma("unroll") for (int _i = 0; _i < 2; ++_i) \
        __builtin_amdgcn_global_load_lds((const unsigned*)((const char*)(gbase) + (voff)[_i]), (PG8_LAS unsigned*)(lds + (bufoff) + ldsw + _i * 8192), 16, 0, 0); } while (0)
#define PG8_LDA(dst, b, h) do { _Pragma("unroll") for (int m = 0; m < 4; ++m) _Pragma("unroll") for (int k = 0; k < 2; ++k) dst[m][k] = *(const PG8_LAS bf16x8*)(lds + PG8_SA(b, h) + aoff + m * 2048 + k * 1024); } while (0)
#define PG8_LDB(dst, b, h) do { _Pragma("unroll") for (int n = 0; n < 2; ++n) _Pragma("unroll") for (int k = 0; k < 2; ++k) dst[n][k] = *(const PG8_LAS bf16x8*)(lds + PG8_SB(b, h) + boff + n * 2048 + k * 1024); } while (0)
#define PG8_MMA(ai, bj, At, Bt) do { __builtin_amdgcn_s_setprio(1); _Pragma("unroll") for (int m = 0; m < 4; ++m) _Pragma("unroll") for (int n = 0; n < 2; ++n) _Pragma("unroll") for (int k = 0; k < 2; ++k) \
        acc[ai][bj][m][n] = __builtin_amdgcn_mfma_f32_16x16x32_bf16(Bt[n][k], At[m][k], acc[ai][bj][m][n], 0, 0, 0); __builtin_amdgcn_s_setprio(0); } while (0)
#define PG8_WAIT_V(n) asm volatile("s_waitcnt vmcnt(" #n ")" ::: "memory")
#define PG8_WAIT_L(n) asm volatile("s_waitcnt lgkmcnt(" #n ")" ::: "memory")
#define PG8_BAR __builtin_amdgcn_s_barrier()
#define PG8_SCHED __builtin_amdgcn_sched_barrier(0)
    Unit cur, nxt; int ui = 0;
    if (!S.next(0, cur)) return;
    f32x4 acc[2][2][4][2];
#pragma unroll
    for (int a = 0; a < 2; ++a)
#pragma unroll
        for (int b = 0; b < 2; ++b)
#pragma unroll
            for (int m = 0; m < 4; ++m)
#pragma unroll
                for (int n = 0; n < 2; ++n) acc[a][b][m][n] = (f32x4){0.f, 0.f, 0.f, 0.f};
    bf16x8 At[4][2], B0[2][2], B1[2][2];
    const char* cA = (const char*)g.A + (size_t)cur.pm * tstep + (size_t)cur.kt0 * (BK * 2); const char* cB = (const char*)g.Bt + (size_t)cur.pn * tstep + (size_t)cur.kt0 * (BK * 2);
    S.a_ready(cur);
    if constexpr (SP2) {
        PG8_STAGE(PG8_SB(0, 0), cB, voffB); PG8_STAGE(PG8_SB(0, 1), cB + hstep, voffB); PG8_STAGE(PG8_SA(0, 0), cA, voffA); PG8_STAGE(PG8_SA(0, 1), cA + hstep, voffA);
        if (wr == 1) PG8_BAR;
        PG8_WAIT_V(2); PG8_BAR;
        PG8_STAGE(PG8_SB(1, 0), cB + kstep, voffB); PG8_STAGE(PG8_SA(1, 0), cA + kstep, voffA); PG8_STAGE(PG8_SB(1, 1), cB + hstep + kstep, voffB);
        PG8_WAIT_V(6); PG8_BAR;
    } else {
        PG8_STAGE(PG8_SB(0, 0), cB, voffB); PG8_STAGE(PG8_SA(0, 0), cA, voffA); PG8_STAGE(PG8_SB(0, 1), cB + hstep, voffB); PG8_STAGE(PG8_SA(0, 1), cA + hstep, voffA);
        if (wr == 1) PG8_BAR;
        PG8_WAIT_V(4); PG8_BAR;
        PG8_STAGE(PG8_SB(1, 0), cB + kstep, voffB); PG8_STAGE(PG8_SA(1, 0), cA + kstep, voffA); PG8_STAGE(PG8_SB(1, 1), cB + hstep + kstep, voffB);
        PG8_WAIT_V(6); PG8_BAR;
    }
    for (;;) {
        const bool has_next = S.next(ui + 1, nxt);
        const char* nA = has_next ? (const char*)g.A + (size_t)nxt.pm * tstep + (size_t)nxt.kt0 * (BK * 2) : cA; const char* nB = has_next ? (const char*)g.Bt + (size_t)nxt.pn * tstep + (size_t)nxt.kt0 * (BK * 2) : cB;
        const int ntu = cur.nt ? cur.nt : nt;
        for (int t = 0; t < ntu; t += 2) {
            const bool last = (t == ntu - 2);
            const char* a1 = cA + (size_t)(t + 1) * kstep;
            const char* a2 = last ? nA : cA + (size_t)(t + 2) * kstep; const char* b2 = last ? nB : cB + (size_t)(t + 2) * kstep;
            const char* a3 = a2 + kstep; const char* b3 = b2 + kstep;
            if (last && has_next) S.a_ready(nxt);
            if constexpr (SP2) {
            PG8_LDB(B0, 0, 0); PG8_LDB(B1, 0, 1); PG8_SCHED; PG8_LDA(At, 0, 0); PG8_STAGE(PG8_SA(1, 1), a1 + hstep, voffA);
            PG8_WAIT_V(8); PG8_WAIT_L(0); PG8_BAR; PG8_MMA(0, 0, At, B0); PG8_MMA(0, 1, At, B1); PG8_BAR; PG8_SCHED;
            PG8_LDA(At, 0, 1); PG8_STAGE(PG8_SB(0, 0), b2, voffB); PG8_STAGE(PG8_SB(0, 1), b2 + hstep, voffB); PG8_STAGE(PG8_SA(0, 0), a2, voffA);
            PG8_WAIT_V(8); PG8_WAIT_L(0); PG8_BAR; PG8_MMA(1, 0, At, B0); PG8_MMA(1, 1, At, B1); PG8_BAR; PG8_SCHED;
            PG8_LDB(B0, 1, 0); PG8_LDB(B1, 1, 1); PG8_SCHED; PG8_LDA(At, 1, 0); PG8_STAGE(PG8_SA(0, 1), a2 + hstep, voffA);
            PG8_WAIT_V(8); PG8_WAIT_L(0); PG8_BAR; PG8_MMA(0, 0, At, B0); PG8_MMA(0, 1, At, B1); PG8_BAR; PG8_SCHED;
            PG8_LDA(At, 1, 1); PG8_STAGE(PG8_SB(1, 0), b3, voffB); PG8_STAGE(PG8_SB(1, 1), b3 + hstep, voffB); PG8_STAGE(PG8_SA(1, 0), a3, voffA);
            PG8_WAIT_V(8); PG8_WAIT_L(0); PG8_BAR; PG8_MMA(1, 0, At, B0); PG8_MMA(1, 1, At, B1); PG8_BAR; PG8_SCHED;
            } else {
            PG8_LDB(B0, 0, 0); PG8_SCHED; PG8_LDA(At, 0, 0); PG8_STAGE(PG8_SA(1, 1), a1 + hstep, voffA);
            PG8_WAIT_L(8); PG8_BAR; PG8_WAIT_L(0); PG8_MMA(0, 0, At, B0); PG8_BAR; PG8_SCHED;
            PG8_LDB(B1, 0, 1); PG8_STAGE(PG8_SB(0, 0), b2, voffB);
            PG8_BAR; PG8_WAIT_L(0); PG8_MMA(0, 1, At, B1); PG8_BAR;
            PG8_LDA(At, 0, 1); PG8_STAGE(PG8_SA(0, 0), a2, voffA);
            PG8_BAR; PG8_WAIT_L(0); PG8_MMA(1, 0, At, B0); PG8_BAR; PG8_SCHED;
            PG8_STAGE(PG8_SB(0, 1), b2 + hstep, voffB);
            PG8_WAIT_V(6); PG8_BAR; PG8_MMA(1, 1, At, B1); PG8_BAR;
            PG8_LDB(B0, 1, 0); PG8_SCHED; PG8_LDA(At, 1, 0); PG8_STAGE(PG8_SA(0, 1), a2 + hstep, voffA);
            PG8_WAIT_L(8); PG8_BAR; PG8_WAIT_L(0); PG8_MMA(0, 0, At, B0); PG8_BAR; PG8_SCHED;
            PG8_LDB(B1, 1, 1); PG8_STAGE(PG8_SB(1, 0), b3, voffB);
            PG8_BAR; PG8_WAIT_L(0); PG8_MMA(0, 1, At, B1); PG8_BAR;
            PG8_LDA(At, 1, 1); PG8_STAGE(PG8_SA(1, 0), a3, voffA);
            PG8_BAR; PG8_WAIT_L(0); PG8_MMA(1, 0, At, B0); PG8_BAR; PG8_SCHED;
            PG8_STAGE(PG8_SB(1, 1), b3 + hstep, voffB);
            PG8_WAIT_V(6); PG8_BAR; PG8_MMA(1, 1, At, B1); PG8_BAR;
            }
        }
        if constexpr (ALIGN_EPI) { if (wr == 0) PG8_BAR; }
        if constexpr (!Epi::AFTER_DRAIN) { E(acc, cur, wr, wc, fr, fq); S.done(cur); }
        if (!has_next) break;
#pragma unroll
        for (int a = 0; a < 2; ++a)
#pragma unroll
            for (int b = 0; b < 2; ++b)
#pragma unroll
                for (int m = 0; m < 4; ++m)
#pragma unroll
                    for (int n = 0; n < 2; ++n) acc[a][b][m][n] = (f32x4){0.f, 0.f, 0.f, 0.f};
        cur = nxt; cA = nA; cB = nB; ++ui;
        if constexpr (ALIGN_EPI) { if (wr == 1) PG8_BAR; }
    }
    PG8_WAIT_V(0);
    if constexpr (!ALIGN_EPI) { if (wr == 0) PG8_BAR; }
    PG8_BAR;
    if constexpr (Epi::AFTER_DRAIN) { E.fused(acc, cur, wr, wc, fr, fq, lds, wid, lane); S.done(cur); }
#undef PG8_SA
#undef PG8_SB
#undef PG8_STAGE
#undef PG8_LDA
#undef PG8_LDB
#undef PG8_MMA
#undef PG8_WAIT_V
#undef PG8_WAIT_L
#undef PG8_BAR
#undef PG8_SCHED
}
}
constexpr int DM = 1024, SEQ = 2048, NB = 32, DECL = 64, DFF = 2816, INW = 2816;
constexpr int MP = NB * SEQ, MS = NB * DECL, MT = MP + MS;
constexpr int NGRP = MT / 64;
constexpr int NTM = MT / 256;
constexpr float EPS = 1e-6f;
constexpr size_t OFF_Y = 0;
constexpr size_t OFF_PRET = (size_t)MT * DM;
constexpr size_t OFF_PK = OFF_PRET + (size_t)NB * 4 * 128 * 128;
constexpr size_t OFF_PV = OFF_PK + (size_t)NB * 128 * 128;
constexpr size_t OFF_PCONV = OFF_PV + (size_t)NB * 128 * 128;
constexpr size_t OFF_SRET = OFF_PCONV + (size_t)NB * 2 * DFF;
constexpr size_t OFF_SK = OFF_SRET + (size_t)NB * 4 * 128 * 128;
constexpr size_t OFF_SV = OFF_SK + (size_t)NB * 64 * 128;
constexpr size_t OFF_SCONV = OFF_SV + (size_t)NB * 64 * 128;
constexpr size_t OUT_TOTAL = OFF_SCONV + (size_t)NB * 2 * DFF;
constexpr size_t MiB = 1u << 20;
constexpr size_t WS_WIN = 0;
constexpr size_t WS_WUP = WS_WIN + (size_t)INW * DM * 2;
constexpr size_t WS_WOUT = WS_WUP + (size_t)2 * DFF * DM * 2;
constexpr size_t WS_WDN = WS_WOUT + (size_t)DM * DM * 2;
constexpr size_t WS_MODP = 48 * MiB + 133 * MiB + 363 * MiB + 200 * MiB;
constexpr size_t WS_MOD = 32 * MiB;
constexpr size_t WS_SHW = 34 * MiB;
constexpr size_t WS_SS1 = 36 * MiB;
constexpr size_t WS_SS2 = 41 * MiB;
constexpr size_t WS_R0 = 48 * MiB;
constexpr size_t WS_R1 = WS_R0 + 133 * MiB;
constexpr size_t WS_R2 = WS_R1 + 363 * MiB;
constexpr size_t HT_STRIDE = (size_t)NGRP * 2 * DFF;
constexpr size_t WS_END = WS_R2 + 363 * MiB;
constexpr size_t WS_SLAB = WS_R1 + 264 * MiB;
constexpr size_t WS_SLAB4 = WS_R1 + 300 * MiB;
constexpr size_t WS_X1B = WS_R1 + 128 * MiB;
static_assert(3 * HT_STRIDE * 4 <= 128 * MiB && WS_X1B + (size_t)MT * DM * 2 <= WS_R2, "ws map");
static_assert(WS_WDN + (size_t)DM * DFF * 2 <= WS_MODP, "ws map");
static_assert((size_t)(MT + 256) * DM * 2 <= 133 * MiB && (size_t)MT * DFF * 2 <= 363 * MiB, "ws map");

constexpr size_t WS_BAR = 46 * MiB;
constexpr size_t WS_TICKET = 46 * MiB + 32768;
constexpr size_t WS_CNT7 = 46 * MiB + 65536;
constexpr int LDS_MISC = 155648;
constexpr int LDS_BYTES = 155648 + 64;

#define LAS __attribute__((address_space(3)))
typedef unsigned short bf16;
typedef float f32x4 __attribute__((ext_vector_type(4)));
typedef float f32x2 __attribute__((ext_vector_type(2)));
typedef short bf16x8 __attribute__((ext_vector_type(8)));
typedef unsigned u32x4 __attribute__((ext_vector_type(4)));
typedef unsigned u32x2 __attribute__((ext_vector_type(2)));
typedef __bf16 bf16x2_t __attribute__((ext_vector_type(2)));
#define LDS_WAIT() asm volatile("s_waitcnt lgkmcnt(0)" ::: "memory")

__device__ __forceinline__ unsigned pk2(float lo, float hi) { f32x2 v = {lo, hi}; bf16x2_t b = __builtin_convertvector(v, bf16x2_t); return __builtin_bit_cast(unsigned, b); }
__device__ __forceinline__ float bflo(unsigned w) { return __uint_as_float(w << 16); }
__device__ __forceinline__ float bfhi(unsigned w) { return __uint_as_float(w & 0xffff0000u); }
__device__ __forceinline__ float wave_sum(float v) {
#pragma unroll
    for (int o = 1; o < 64; o <<= 1) v += __shfl_xor(v, o);
    return v;
}
__device__ __forceinline__ float wave_sum_dpp(float v) {
    v += __int_as_float(__builtin_amdgcn_update_dpp(__float_as_int(v), __float_as_int(v), 0x128, 0xf, 0xf, false));
    v += __int_as_float(__builtin_amdgcn_update_dpp(__float_as_int(v), __float_as_int(v), 0x124, 0xf, 0xf, false));
    v += __int_as_float(__builtin_amdgcn_update_dpp(__float_as_int(v), __float_as_int(v), 0x122, 0xf, 0xf, false));
    v += __int_as_float(__builtin_amdgcn_update_dpp(__float_as_int(v), __float_as_int(v), 0x121, 0xf, 0xf, false));
    const int i = __float_as_int(v);
    return (__int_as_float(__builtin_amdgcn_readlane(i, 0)) + __int_as_float(__builtin_amdgcn_readlane(i, 16))) + (__int_as_float(__builtin_amdgcn_readlane(i, 32)) + __int_as_float(__builtin_amdgcn_readlane(i, 48)));
}
__device__ __forceinline__ float silu_f(float x) { return x * __builtin_amdgcn_rcpf(1.0f + __builtin_amdgcn_exp2f(-1.4426950408889634f * x)); }
__device__ __forceinline__ void unpack8(const u32x4 w, float (&f)[8]) { f[0] = bflo(w.x); f[1] = bfhi(w.x); f[2] = bflo(w.y); f[3] = bfhi(w.y); f[4] = bflo(w.z); f[5] = bfhi(w.z); f[6] = bflo(w.w); f[7] = bfhi(w.w); }
__device__ __forceinline__ int grp_bs(int g) { return g < 1024 ? (g >> 5) : 32 + (g - 1024); }

struct Params {
    const float *x_p, *x_s, *cache_k, *cache_v, *state_ret, *state_conv, *c_p, *c_s, *ln1, *ln2, *w_ada, *b_ada, *w_in, *w_out, *sinks, *w_up, *conv_w, *conv_b, *w_down, *normf, *w_ada_f, *b_ada_f;
    float* out; unsigned char* ws;
};

__device__ __forceinline__ void transpose_item(const float* W, int K, int N, bf16* WT, int dst_row0, int k0, int n0, LAS float* scr, int lane) {
    { f32x4 t[8];
#pragma unroll
      for (int i = 0; i < 8; ++i) t[i] = *(const f32x4*)(W + (size_t)(k0 + 8 * i + (lane >> 3)) * N + n0 + 4 * (lane & 7));
#pragma unroll
      for (int i = 0; i < 8; ++i) { LAS float* d = scr + (8 * i + (lane >> 3)) * 33 + 4 * (lane & 7); d[0] = t[i].x; d[1] = t[i].y; d[2] = t[i].z; d[3] = t[i].w; } }
    LDS_WAIT(); asm volatile("" ::: "memory");
    const int c = lane & 7;
#pragma unroll
    for (int j = 0; j < 4; ++j) { const int n = (lane >> 3) + 8 * j; const LAS float* s = scr + (8 * c) * 33 + n;
        u32x4 o; o.x = pk2(s[0 * 33], s[1 * 33]); o.y = pk2(s[2 * 33], s[3 * 33]); o.z = pk2(s[4 * 33], s[5 * 33]); o.w = pk2(s[6 * 33], s[7 * 33]);
        *(u32x4*)(WT + (size_t)(dst_row0 + n) * K + k0 + 8 * c) = o; }
    LDS_WAIT(); asm volatile("" ::: "memory");
}
constexpr int MOD_KS = 8, MOD_KC = 1024 / MOD_KS / 32;
__device__ __forceinline__ void mod_item(const Params& P, int it, LAS float* scr, int lane) {
    const int ct = it / MOD_KS, ks = it % MOD_KS, c0 = ct * 64;
    const float* W; const float* bias; int ldw;
    if (c0 < 6144) { W = P.w_ada + c0; bias = P.b_ada + c0; ldw = 6144; } else { W = P.w_ada_f + (c0 - 6144); bias = P.b_ada_f + (c0 - 6144); ldw = 2048; }
    float acc[64];
#pragma unroll
    for (int r = 0; r < 64; ++r) acc[r] = 0.f;
    const float* crow = (lane < 32 ? P.c_p + (size_t)lane * DM : P.c_s + (size_t)(lane - 32) * DM) + ks * (1024 / MOD_KS);
    const float* wk0 = W + (size_t)(ks * (1024 / MOD_KS)) * ldw + lane;
    f32x4 cv[8], cn[8];
#pragma unroll
    for (int q = 0; q < 8; ++q) cv[q] = *(const f32x4*)(crow + 4 * q);
    constexpr int NK4 = (1024 / MOD_KS) / 4;
    float w0 = wk0[0], w1 = wk0[(size_t)ldw], w2 = wk0[(size_t)2 * ldw], w3 = wk0[(size_t)3 * ldw];
    for (int kc = 0; kc < MOD_KC; ++kc) {
#pragma unroll
        for (int q = 0; q < 8; ++q) { f32x4 v = cv[q]; v.x = silu_f(v.x); v.y = silu_f(v.y); v.z = silu_f(v.z); v.w = silu_f(v.w); *(LAS f32x4*)(scr + lane * 36 + 4 * q) = v; }
        LDS_WAIT(); asm volatile("" ::: "memory");
        { const int kn = kc + 1 < MOD_KC ? kc + 1 : kc;
#pragma unroll
          for (int q = 0; q < 8; ++q) cn[q] = *(const f32x4*)(crow + kn * 32 + 4 * q); }
        for (int k4 = 0; k4 < 8; ++k4) {
            const int gk = kc * 8 + k4, gn = gk + 1 < NK4 ? gk + 1 : gk;
            const float* wn = wk0 + (size_t)(4 * gn) * ldw;
            const float n0 = wn[0], n1 = wn[(size_t)ldw], n2 = wn[(size_t)2 * ldw], n3 = wn[(size_t)3 * ldw];
#pragma unroll
            for (int r = 0; r < 64; ++r) { const f32x4 sv = *(const LAS f32x4*)(scr + r * 36 + 4 * k4);
                acc[r] = fmaf(sv.x, w0, acc[r]); acc[r] = fmaf(sv.y, w1, acc[r]); acc[r] = fmaf(sv.z, w2, acc[r]); acc[r] = fmaf(sv.w, w3, acc[r]); }
            w0 = n0; w1 = n1; w2 = n2; w3 = n3;
        }
        LDS_WAIT(); asm volatile("" ::: "memory");
#pragma unroll
        for (int q = 0; q < 8; ++q) cv[q] = cn[q];
    }
    float* dst = (float*)(P.ws + WS_MODP) + (size_t)ks * 64 * 8192 + c0 + lane;
    const float bv = (ks == 0) ? bias[lane] : 0.f;
#pragma unroll
    for (int r = 0; r < 64; ++r) dst[(size_t)r * 8192] = acc[r] + bv;
}
__device__ __forceinline__ void phase0(const Params& P, LAS unsigned char* lds, int wave, int lane) {
    LAS float* scr = (LAS float*)(lds + wave * 16384);
    const int gw = wave * gridDim.x + blockIdx.x, NGW = gridDim.x * 8;
    constexpr int I_MOD = 128 * MOD_KS, I_IN = 16 * 88, I_UP = 16 * 176, I_OUT = 16 * 32, I_DN = 44 * 32;
    constexpr int NIT = I_MOD + I_IN + I_UP + I_OUT + I_DN;
    for (int it = gw; it < NIT; it += NGW) {
        int r = it;
        if (r < I_MOD) { mod_item(P, r, scr, lane); continue; } r -= I_MOD;
        if (r < I_IN) { const int kb = r / 88, nb = r % 88; transpose_item(P.w_in, DM, INW, (bf16*)(P.ws + WS_WIN), nb * 32, kb * 64, nb * 32, scr, lane); continue; } r -= I_IN;
        if (r < I_UP) { const int kb = r / 176, nb = r % 176, n0 = nb * 32, isb = n0 >= DFF, j0 = n0 - isb * DFF;
            transpose_item(P.w_up, DM, 2 * DFF, (bf16*)(P.ws + WS_WUP), 256 * (j0 >> 7) + 128 * isb + (j0 & 127), kb * 64, n0, scr, lane); continue; } r -= I_UP;
        if (r < I_OUT) { const int kb = r / 32, nb = r % 32; transpose_item(P.w_out, DM, DM, (bf16*)(P.ws + WS_WOUT), nb * 32, kb * 64, nb * 32, scr, lane); continue; } r -= I_OUT;
        { const int kb = r / 32, nb = r % 32; transpose_item(P.w_down, DFF, DM, (bf16*)(P.ws + WS_WDN), nb * 32, kb * 64, nb * 32, scr, lane); }
    }
}

__device__ __forceinline__ void phase1(const Params& P, LAS unsigned char* lds, int tid, int wave, int lane) {
    const float* modp = (const float*)(P.ws + WS_MODP);
    float* mod = (float*)(P.ws + WS_MOD);
    bf16* H1 = (bf16*)(P.ws + WS_R0);
    for (int idx = blockIdx.x * 512 + tid; idx < 64 * 8192; idx += gridDim.x * 512) {
        float s = 0.f;
#pragma unroll
        for (int p_ = 0; p_ < MOD_KS; ++p_) s += modp[idx + (size_t)p_ * 524288];
        mod[idx] = s;
        const int col = idx & 8191, bs = idx >> 13;
        if (col >= 3072 && col < 4096) H1[(size_t)(MT + bs) * DM + (col - 3072)] = (bf16)(pk2(s, 0.f) & 0xffffu);
    }
    LAS float* lv = (LAS float*)lds;
    const int rpb = (MT + (int)gridDim.x - 1) / (int)gridDim.x, rbeg = (int)blockIdx.x * rpb, rend = (rbeg + rpb < MT) ? rbeg + rpb : MT;
    if (rbeg < rend) {
        const int bs0 = rbeg < MP ? (rbeg >> 11) : 32 + ((rbeg - MP) >> 6), bs1 = (rend - 1) < MP ? ((rend - 1) >> 11) : 32 + ((rend - 1 - MP) >> 6);
        const int nsl = bs1 - bs0 + 1;
        __syncthreads();
        for (int i = tid; i < nsl * 2048; i += 512) { const int sl = i >> 11, which = (i >> 10) & 1, col = i & 1023; const size_t o = (size_t)(bs0 + sl) * 8192 + which * 1024 + col;
            float sv = 0.f;
#pragma unroll
            for (int p_ = 0; p_ < MOD_KS; ++p_) sv += modp[o + (size_t)p_ * 524288];
            if (which) sv = P.ln1[col] * (1.f + sv);
            lv[i] = sv; }
        __syncthreads();
#pragma unroll 4
        for (int row = rbeg + wave; row < rend; row += 8) {
            const int bs = row < MP ? (row >> 11) : 32 + ((row - MP) >> 6);
            const LAS float* lvs = lv + (bs - bs0) * 2048;
            const float* xr = (row < MP ? P.x_p + (size_t)row * DM : P.x_s + (size_t)(row - MP) * DM) + 4 * lane;
            f32x4 v[4]; float ss = 0.f;
#pragma unroll
            for (int j = 0; j < 4; ++j) { v[j] = *(const f32x4*)(xr + 256 * j); ss += (v[j].x * v[j].x + v[j].y * v[j].y) + (v[j].z * v[j].z + v[j].w * v[j].w); }
            const float rstd = __builtin_amdgcn_rsqf(wave_sum_dpp(ss) * (1.f / DM) + EPS);
            bf16* hr = H1 + (size_t)row * DM + 4 * lane;
#pragma unroll
            for (int j = 0; j < 4; ++j) { const f32x4 sh = *(const LAS f32x4*)(lvs + 256 * j + 4 * lane), gs = *(const LAS f32x4*)(lvs + 1024 + 256 * j + 4 * lane);
                const f32x4 h = v[j] * rstd * gs + sh; u32x2 w; w.x = pk2(h.x, h.y); w.y = pk2(h.z, h.w); *(u32x2*)(hr + 256 * j) = w; }
        }
    }
}

struct OrderX {
    pg8::StaticOrder S; int nX, xpm, xpn0;
    __device__ __forceinline__ bool next(int i, pg8::Unit& u) const {
        const long L = (long)i * S.G + S.c;
        int pm = 0, pn = 0; bool ok = false;
        if (L < S.nwg) { pg8::Unit t; t.pm = 0; t.pn = 0; t.seq = 0; t.kt0 = 0; t.nt = 0; (void)S.next(i, t); pm = t.pm; pn = t.pn; ok = true; }
        else if (L < S.nwg + nX) { pm = xpm; pn = xpn0 + (int)(L - S.nwg); ok = true; }
        u.pm = pm; u.pn = pn; u.seq = i; u.kt0 = 0; u.nt = 0;
        return ok;
    }
    __device__ __forceinline__ void a_ready(const pg8::Unit&) const {}
    __device__ __forceinline__ void done(const pg8::Unit&) const {}
};
struct OrderPub : pg8::StaticOrder {
    unsigned* cnt;
    __device__ __forceinline__ void done(const pg8::Unit& u) const {
        asm volatile("s_waitcnt vmcnt(0)" ::: "memory");
        if ((threadIdx.x & 63) == 0) __hip_atomic_fetch_add(cnt + 64 * u.pm, 1u, __ATOMIC_RELAXED, __HIP_MEMORY_SCOPE_AGENT);
    }
};
struct OrderDown {
    pg8::StaticOrder S;
    int ka, kb;
    __device__ __forceinline__ bool next(int i, pg8::Unit& u) const {
        const long L = (long)i * S.G + S.c;
        int pm = 0, pn = 0, kt0 = 0, nt = 0; bool ok = false;
        if (L < S.nwg) { pg8::Unit t; t.pm = 0; t.pn = 0; t.seq = 0; t.kt0 = 0; t.nt = 0; (void)S.next(i, t); pm = t.pm; pn = t.pn; ok = true; }
        else if (L < S.nwg + 128) { const int q = (int)(L - S.nwg), tu = q >> 2, part = q & 3; pm = (MP / 256) + (tu & 7); pn = tu >> 3; kt0 = part < 2 ? ka * part : 2 * ka + kb * (part - 2); nt = part < 2 ? ka : kb; ok = true; }
        u.pm = pm; u.pn = pn; u.seq = i; u.kt0 = kt0; u.nt = nt;
        return ok;
    }
    __device__ __forceinline__ void a_ready(const pg8::Unit&) const {}
    __device__ __forceinline__ void done(const pg8::Unit&) const {}
};
typedef const f32x4 (&AccRef)[2][2][4][2];
struct Epi1 {
    static constexpr bool PERM = true, AFTER_DRAIN = false;
    bf16* proj; float* shw; float* out;
    __device__ __forceinline__ void operator()(AccRef acc, const pg8::Unit& u, int wr, int wc, int fr, int fq) const {
        if (u.pm == NTM) {
            if (wr == 0) {
#pragma unroll
                for (int m = 0; m < 4; ++m) { float* d = shw + (size_t)(16 * m + fr) * (2 * DFF) + 256 * (u.pn - 11) + 32 * wc + 8 * fq;
#pragma unroll
                    for (int bj = 0; bj < 2; ++bj)
#pragma unroll
                        for (int n = 0; n < 2; ++n) *(f32x4*)(d + 128 * bj + 4 * n) = acc[0][bj][m][n]; }
            }
            return;
        }
        const unsigned row0 = u.pm * 256 + wr * 64 + fr, col0 = u.pn * 256 + wc * 32 + 8 * fq;
#pragma unroll
        for (int ai = 0; ai < 2; ++ai)
#pragma unroll
            for (int m = 0; m < 4; ++m) { const unsigned o = (row0 + 128 * ai + 16 * m) * (unsigned)INW + col0;
#pragma unroll
                for (int bj = 0; bj < 2; ++bj) { const f32x4 v0 = acc[ai][bj][m][0], v1 = acc[ai][bj][m][1];
                    u32x4 w; w.x = pk2(v0[0], v0[1]); w.y = pk2(v0[2], v0[3]); w.z = pk2(v1[0], v1[1]); w.w = pk2(v1[2], v1[3]);
                    *(u32x4*)(proj + (o + 128 * bj)) = w; }
                asm volatile("" ::: "memory"); }
        if (u.pn == 10) {
            const unsigned c = 32 * wc + 8 * fq;
#pragma unroll
            for (int ai = 0; ai < 2; ++ai)
#pragma unroll
                for (int m = 0; m < 4; ++m) { const unsigned row = row0 + 128 * ai + 16 * m; unsigned ok, ov;
                    if (row < (unsigned)MP) { const unsigned t = row & 2047; if (t < SEQ - 128) continue; const unsigned o = ((row >> 11) * 128 + (t - (SEQ - 128))) * 128 + c; ok = (unsigned)OFF_PK + o; ov = (unsigned)OFF_PV + o; }
                    else { const unsigned o = (row - MP) * 128 + c; ok = (unsigned)OFF_SK + o; ov = (unsigned)OFF_SV + o; }
                    *(f32x4*)(out + ok) = acc[ai][0][m][0]; *(f32x4*)(out + ok + 4) = acc[ai][0][m][1];
                    *(f32x4*)(out + ov) = acc[ai][1][m][0]; *(f32x4*)(out + ov + 4) = acc[ai][1][m][1];
                    asm volatile("" ::: "memory"); }
        }
    }
};
struct Epi2 {
    static constexpr bool PERM = true, AFTER_DRAIN = false;
    const float *xp, *xs, *mod, *ln2; bf16* x1; bf16* a2; float* ss; float* slab;
    __device__ __forceinline__ void operator()(AccRef acc, const pg8::Unit& u, int wr, int wc, int fr, int fq) const {
        const int col0 = u.pn * 256 + wc * 32 + 8 * fq;
        if (u.nt != 0) {
            float* sb = slab + (size_t)(u.kt0 >> 2) * MS * DM;
#pragma unroll
            for (int ai = 0; ai < 2; ++ai)
#pragma unroll
                for (int m = 0; m < 4; ++m) { const unsigned ro = (unsigned)(u.pm * 256 - MP + 128 * ai + 64 * wr + 16 * m + fr) * DM + col0;
#pragma unroll
                    for (int bj = 0; bj < 2; ++bj) { *(f32x4*)(sb + ro + 128 * bj) = acc[ai][bj][m][0]; *(f32x4*)(sb + ro + 128 * bj + 4) = acc[ai][bj][m][1]; } }
            return;
        }
#pragma unroll
        for (int ai = 0; ai < 2; ++ai) {
            const int bs = grp_bs(4 * u.pm + 2 * ai + wr);
            const float* mb = mod + (size_t)bs * 8192;
            f32x4 g1v[2][2], gsv[2][2];
#pragma unroll
            for (int bj = 0; bj < 2; ++bj)
#pragma unroll
                for (int n = 0; n < 2; ++n) { const int c = col0 + 128 * bj + 4 * n; g1v[bj][n] = *(const f32x4*)(mb + 2048 + c);
                    gsv[bj][n] = *(const f32x4*)(ln2 + c) * (*(const f32x4*)(mb + 4096 + c) + 1.0f); }
#pragma unroll
            for (int m = 0; m < 4; ++m) {
                const int row = u.pm * 256 + 128 * ai + 64 * wr + 16 * m + fr;
                const float* xr = row < MP ? xp + (size_t)row * DM : xs + (size_t)(row - MP) * DM;
                float s = 0.f;
#pragma unroll
                for (int bj = 0; bj < 2; ++bj) { f32x4 a[2]; f32x4 xb[2];
#pragma unroll
                    for (int n = 0; n < 2; ++n) { const int c = col0 + 128 * bj + 4 * n; const f32x4 xv = *(const f32x4*)(xr + c); const f32x4 v = xv + g1v[bj][n] * acc[ai][bj][m][n];
                        xb[n] = v; s += (v.x * v.x + v.y * v.y) + (v.z * v.z + v.w * v.w); a[n] = v * gsv[bj][n]; }
                    u32x4 w; w.x = pk2(a[0].x, a[0].y); w.y = pk2(a[0].z, a[0].w); w.z = pk2(a[1].x, a[1].y); w.w = pk2(a[1].z, a[1].w);
                    *(u32x4*)(a2 + (size_t)row * DM + col0 + 128 * bj) = w;
                    w.x = pk2(xb[0].x, xb[0].y); w.y = pk2(xb[0].z, xb[0].w); w.z = pk2(xb[1].x, xb[1].y); w.w = pk2(xb[1].z, xb[1].w);
                    *(u32x4*)(x1 + (size_t)row * DM + col0 + 128 * bj) = w; }
                s += __shfl_xor(s, 16); s += __shfl_xor(s, 32);
                if (fq == 0) ss[(size_t)row * 16 + 4 * u.pn + wc] = s;
            }
        }
    }
};
struct Epi3 {
    static constexpr bool PERM = true, AFTER_DRAIN = false;
    const LAS float* rtab; const float* shw; bf16 *ua, *ub; float* out;
    __device__ __forceinline__ void operator()(AccRef acc, const pg8::Unit& u, int wr, int wc, int fr, int fq) const {
        const unsigned j0 = u.pn * 128 + wc * 32 + 8 * fq, pc0 = u.pn * 256 + wc * 32 + 8 * fq;
#pragma unroll
        for (int ai = 0; ai < 2; ++ai) {
            const unsigned grp = 4 * u.pm + 2 * ai + wr, bs = grp_bs((int)grp);
            const unsigned so = bs * (2 * DFF) + pc0;
            const f32x4 sa0 = *(const f32x4*)(shw + so), sa1 = *(const f32x4*)(shw + so + 4), sb0 = *(const f32x4*)(shw + so + 128), sb1 = *(const f32x4*)(shw + so + 132);
#pragma unroll
            for (int m = 0; m < 4; ++m) {
                const float rstd = rtab[u.seq * 256 + 128 * ai + 64 * wr + 16 * m + fr];
                const unsigned row = grp * 64 + 16 * m + fr;
                const f32x4 a0 = acc[ai][0][m][0] * rstd + sa0, a1 = acc[ai][0][m][1] * rstd + sa1, b0 = acc[ai][1][m][0] * rstd + sb0, b1 = acc[ai][1][m][1] * rstd + sb1;
                u32x4 w; w.x = pk2(a0[0], a0[1]); w.y = pk2(a0[2], a0[3]); w.z = pk2(a1[0], a1[1]); w.w = pk2(a1[2], a1[3]);
                *(u32x4*)(ua + (row * (unsigned)DFF + j0)) = w;
                w.x = pk2(b0[0], b0[1]); w.y = pk2(b0[2], b0[3]); w.z = pk2(b1[0], b1[1]); w.w = pk2(b1[2], b1[3]);
                *(u32x4*)(ub + (row * (unsigned)DFF + j0)) = w;
                if (m == 3 && fr >= 14) {
                    if (grp >= 1024) { float* d = out + OFF_SCONV + ((size_t)(grp - 1024) * 2 + (fr - 14)) * DFF + j0; *(f32x4*)d = a0; *(f32x4*)(d + 4) = a1; }
                    else if ((grp & 31) == 31) { float* d = out + OFF_PCONV + ((size_t)(grp >> 5) * 2 + (fr - 14)) * DFF + j0; *(f32x4*)d = a0; *(f32x4*)(d + 4) = a1; }
                }
            }
        }
    }
};
#ifdef CONV_FUSED
struct Epi3C {
    static constexpr bool PERM = true, AFTER_DRAIN = false;
    const LAS float* rtab; const float *shw, *cw, *cb; bf16* act; float *headA, *headB, *tailA;
    __device__ __forceinline__ void operator()(AccRef acc, const pg8::Unit& u, int wr, int wc, int fr, int fq) const {
        const unsigned j0 = u.pn * 128 + wc * 32 + 8 * fq, pc0 = u.pn * 256 + wc * 32 + 8 * fq;
        f32x4 w0[2], w1[2], w2[2], cbv[2];
#pragma unroll
        for (int n = 0; n < 2; ++n) { w0[n] = *(const f32x4*)(cw + j0 + 4 * n); w1[n] = *(const f32x4*)(cw + DFF + j0 + 4 * n); w2[n] = *(const f32x4*)(cw + 2 * DFF + j0 + 4 * n); cbv[n] = *(const f32x4*)(cb + j0 + 4 * n); }
#pragma unroll
        for (int ai = 0; ai < 2; ++ai) {
            asm volatile("" ::: "memory");
            const unsigned grp = 4 * u.pm + 2 * ai + wr, bs = grp_bs((int)grp);
            const unsigned so = bs * (2 * DFF) + pc0, ho = (grp * 2 + (fr & 1)) * DFF + j0;
            u32x2 ap[4][2], bp[4][2];
            {
                f32x4 sa[2], sb[2];
#pragma unroll
                for (int n = 0; n < 2; ++n) { sa[n] = *(const f32x4*)(shw + so + 4 * n); sb[n] = *(const f32x4*)(shw + so + 128 + 4 * n); }
#pragma unroll
                for (int m = 0; m < 4; ++m) {
                    const float rs = rtab[u.seq * 256 + 128 * ai + 64 * wr + 16 * m + fr];
#pragma unroll
                    for (int n = 0; n < 2; ++n) {
                        const f32x4 av = acc[ai][0][m][n] * rs + sa[n], bv = acc[ai][1][m][n] * rs + sb[n];
                        if (m == 0) { if (fr < 2) { *(f32x4*)(headA + ho + 4 * n) = av; *(f32x4*)(headB + ho + 4 * n) = bv; } }
                        if (m == 3) { if (fr >= 14) *(f32x4*)(tailA + ho + 4 * n) = av; }
                        ap[m][n].x = pk2(av.x, av.y); ap[m][n].y = pk2(av.z, av.w); bp[m][n].x = pk2(bv.x, bv.y); bp[m][n].y = pk2(bv.z, bv.w);
                    }
                }
            }
            asm volatile("" ::: "memory");
#pragma unroll
            for (int n = 0; n < 2; ++n)
#pragma unroll
                for (int h = 0; h < 2; ++h) {
                    unsigned q1 = 0u, q2 = 0u;
#pragma unroll
                    for (int m = 0; m < 4; ++m) {
                        const unsigned a = ap[m][n][h];
                        const unsigned s1 = (unsigned)__builtin_amdgcn_update_dpp((int)a, (int)a, 0x121, 0xf, 0xf, false);
                        const unsigned s2 = (unsigned)__builtin_amdgcn_update_dpp((int)a, (int)a, 0x122, 0xf, 0xf, false);
                        const unsigned pr1 = fr >= 1 ? s1 : q1, pr2 = fr >= 2 ? s2 : q2;
                        q1 = s1; q2 = s2;
                        const float c0 = cbv[n][2 * h] + w0[n][2 * h] * bflo(pr2) + w1[n][2 * h] * bflo(pr1) + w2[n][2 * h] * bflo(a);
                        const float c1 = cbv[n][2 * h + 1] + w0[n][2 * h + 1] * bfhi(pr2) + w1[n][2 * h + 1] * bfhi(pr1) + w2[n][2 * h + 1] * bfhi(a);
                        const unsigned bw = bp[m][n][h];
                        bp[m][n][h] = pk2(silu_f(c0) * bflo(bw), silu_f(c1) * bfhi(bw));
                    }
                    __builtin_amdgcn_sched_barrier(0);
                }
            asm volatile("" ::: "memory");
#pragma unroll
            for (int m = 0; m < 4; ++m) {
                if (m == 0 && fr < 2) continue;
                const unsigned row = grp * 64 + 16 * m + fr;
                const u32x4 w = (u32x4){bp[m][0].x, bp[m][0].y, bp[m][1].x, bp[m][1].y};
                *(u32x4*)(act + (row * (unsigned)DFF + j0)) = w;
            }
        }
    }
};
#endif
struct Epi4 {
    static constexpr bool PERM = true, AFTER_DRAIN = false;
    const float* mod; const bf16* x1; bf16* x2; float* slab;
    __device__ __forceinline__ void operator()(AccRef acc, const pg8::Unit& u, int wr, int wc, int fr, int fq) const {
        const int col0 = u.pn * 256 + wc * 32 + 8 * fq;
        if (u.nt != 0) {
            const int part = u.kt0 == 0 ? 0 : (u.kt0 == 12 ? 1 : (u.kt0 == 24 ? 2 : 3));
            float* sb = slab + (size_t)part * MS * DM;
#pragma unroll
            for (int ai = 0; ai < 2; ++ai)
#pragma unroll
                for (int m = 0; m < 4; ++m) { const unsigned ro = (unsigned)(u.pm * 256 - MP + 128 * ai + 64 * wr + 16 * m + fr) * DM + col0;
#pragma unroll
                    for (int bj = 0; bj < 2; ++bj) { *(f32x4*)(sb + ro + 128 * bj) = acc[ai][bj][m][0]; *(f32x4*)(sb + ro + 128 * bj + 4) = acc[ai][bj][m][1]; } }
            return;
        }
#pragma unroll
        for (int ai = 0; ai < 2; ++ai) {
            const int bs = grp_bs(4 * u.pm + 2 * ai + wr);
            const float* mb = mod + (size_t)bs * 8192 + 5120;
            f32x4 g2v[2][2];
#pragma unroll
            for (int bj = 0; bj < 2; ++bj)
#pragma unroll
                for (int n = 0; n < 2; ++n) g2v[bj][n] = *(const f32x4*)(mb + col0 + 128 * bj + 4 * n);
#pragma unroll
            for (int m = 0; m < 4; ++m) {
                const unsigned ro = (unsigned)(u.pm * 256 + 128 * ai + 64 * wr + 16 * m + fr) * DM + col0;
#pragma unroll
                for (int bj = 0; bj < 2; ++bj) { const u32x4 xw = *(const u32x4*)(x1 + ro + 128 * bj);
                    const f32x4 v0 = (f32x4){bflo(xw.x), bfhi(xw.x), bflo(xw.y), bfhi(xw.y)} + g2v[bj][0] * acc[ai][bj][m][0];
                    const f32x4 v1 = (f32x4){bflo(xw.z), bfhi(xw.z), bflo(xw.w), bfhi(xw.w)} + g2v[bj][1] * acc[ai][bj][m][1];
                    u32x4 w; w.x = pk2(v0.x, v0.y); w.y = pk2(v0.z, v0.w); w.z = pk2(v1.x, v1.y); w.w = pk2(v1.z, v1.w);
                    *(u32x4*)(x2 + ro + 128 * bj) = w; }
            }
        }
    }
};
#define GAS __attribute__((address_space(1)))
#define RLX_AGENT __ATOMIC_RELAXED, __HIP_MEMORY_SCOPE_AGENT
#define XB_TMO      128
#define XB_XCNT(j)  (256  + 64 * (j))
#define XB_XSUB(j)  (1280 + 64 * (j))
#define XB_XGEN(j)  (2304 + 64 * (j))
#define XB_TOP      3328
#define XB_TOPGEN   3392
#define XCD_BAR_WORDS 3456
#define XB_SPIN_CAP (1u << 18)

__device__ __forceinline__ unsigned xb_ld(unsigned* p)              { return __hip_atomic_load(p, __ATOMIC_RELAXED, __HIP_MEMORY_SCOPE_AGENT); }
__device__ __forceinline__ unsigned xb_add(unsigned* p, unsigned v) { return __hip_atomic_fetch_add(p, v, __ATOMIC_RELAXED, __HIP_MEMORY_SCOPE_AGENT); }
__device__ __forceinline__ unsigned xb_xcc_id() { return (unsigned)__builtin_amdgcn_s_getreg((3 << 11) | 20) & 0xFu; }
#define XB_SPIN(cond, bar) do { unsigned _sp = 0; while (cond) { __builtin_amdgcn_s_sleep(1); \
    if ((++_sp & 255u) == 0u) { if (xb_ld(&(bar)[XB_TMO])) break; if (_sp > XB_SPIN_CAP) { atomicAdd(&(bar)[XB_TMO], 1u); break; } } } } while (0)

struct XcdBarrier {
    unsigned* bar; unsigned x;
    volatile LAS unsigned* st;
};

__device__ __forceinline__ XcdBarrier xcd_barrier_post(unsigned* bar, volatile LAS unsigned* st) {
    XcdBarrier b; b.bar = bar; b.x = xb_xcc_id(); b.st = st;
    if (threadIdx.x == 0) (void)xb_add(&bar[XB_XCNT(b.x)], 1u);
    return b;
}
__device__ __forceinline__ void xcd_barrier_complete(unsigned* bar, unsigned x, unsigned& nloc, unsigned& nx) {
    const unsigned G = gridDim.x * gridDim.y * gridDim.z;
    unsigned sum, cnt, mine, sp = 0u;
    for (;;) {
        sum = 0u; cnt = 0u; mine = 0u;
#pragma unroll
        for (unsigned j = 0; j < 16; ++j) { const unsigned c = xb_ld(&bar[XB_XCNT(j)]); sum += c; cnt += (c > 0u) ? 1u : 0u; mine = (j == x) ? c : mine; }
        if (sum == G) break;
        __builtin_amdgcn_s_sleep(1);
        if ((++sp & 255u) == 0u) { if (xb_ld(&bar[XB_TMO])) break; if (sp > XB_SPIN_CAP) { atomicAdd(&bar[XB_TMO], 1u); break; } }
    }
    nloc = mine > 0u ? mine : 1u; nx = cnt > 0u ? cnt : 1u;
}

__device__ __forceinline__ void xcd_barrier(const XcdBarrier& b) {
    asm volatile("s_waitcnt vmcnt(0)" ::: "memory");
    __syncthreads();
    if (threadIdx.x == 0) {
        unsigned* bar = b.bar;
        __builtin_amdgcn_s_waitcnt(0);
        unsigned nloc = b.st[0], nx = b.st[1];
        if (nloc == 0u) { xcd_barrier_complete(bar, b.x, nloc, nx); b.st[0] = nloc; b.st[1] = nx; }
        const unsigned old = xb_add(&bar[XB_XSUB(b.x)], 1u);
        const unsigned gen = old / nloc;
        if (old + 1u == (gen + 1u) * nloc) {
            __builtin_amdgcn_fence(__ATOMIC_RELEASE, "agent");
            asm volatile("s_waitcnt vmcnt(0)" ::: "memory");
            const unsigned og = xb_add(&bar[XB_TOP], 1u);
            const unsigned tg = og / nx;
            if (og + 1u == (tg + 1u) * nx) xb_add(&bar[XB_TOPGEN], 1u);
            else XB_SPIN(xb_ld(&bar[XB_TOPGEN]) == tg, bar);
            __builtin_amdgcn_fence(__ATOMIC_ACQUIRE, "agent");
            xb_add(&bar[XB_XGEN(b.x)], 1u);
            asm volatile("s_waitcnt vmcnt(0)" ::: "memory");
        } else {
            XB_SPIN(xb_ld(&bar[XB_XGEN(b.x)]) == gen, bar);
            __builtin_amdgcn_fence(__ATOMIC_ACQUIRE, "agent");
            asm volatile("s_waitcnt vmcnt(0)" ::: "memory");
        }
    }
    __syncthreads();
}
#define MFMA16(a, b, c) __builtin_amdgcn_mfma_f32_16x16x32_bf16((a), (b), (c), 0, 0, 0)
constexpr int RQ = 0, RK = 17408, RKT = 34816, RVT = 53248, RP = 71680, RST = 80896, RO = 115712;
__device__ __forceinline__ void ret_item(const Params& P, LAS unsigned char* lds, int tid, int wave, int lane, int h, int row0, int nchunks, const float* st_in, bool has_in, float* st_out) {
    const bf16* proj = (const bf16*)(P.ws + WS_R1);
    bf16* mix = (bf16*)(P.ws + WS_R2);
    const int fr = lane & 15, fq = lane >> 4;
    const float lg2 = log2f(1.0f - exp2f(-5.0f - (float)h));
    const float kscale = 0.08838834764831845f;
    LAS bf16* Qs = (LAS bf16*)(lds + RQ); LAS bf16* Ks = (LAS bf16*)(lds + RK); LAS bf16* KT = (LAS bf16*)(lds + RKT); LAS bf16* VT = (LAS bf16*)(lds + RVT);
    LAS bf16* Ps = (LAS bf16*)(lds + RP); LAS bf16* ST = (LAS bf16*)(lds + RST); LAS float* Os = (LAS float*)(lds + RO);
    f32x4 st[8];
#pragma unroll
    for (int et = 0; et < 8; ++et) {
        f32x4 v;
#pragma unroll
        for (int r = 0; r < 4; ++r) v[r] = st_in[(size_t)(16 * wave + 4 * fq + r) * 128 + 16 * et + fr];
        asm volatile("" : "+v"(v));
#pragma unroll
        for (int r = 0; r < 4; ++r) v[r] = has_in ? v[r] : 0.f;
        st[et] = v;
    }
    __syncthreads();
#pragma unroll
    for (int et = 0; et < 8; ++et) { u32x2 w; w.x = pk2(st[et][0], st[et][1]); w.y = pk2(st[et][2], st[et][3]); *(LAS u32x2*)(ST + (16 * et + fr) * 136 + 16 * wave + 4 * fq) = w; }
    const size_t goff = (size_t)lane * INW + h * 128 + wave * 16;
    u32x4 pq[2], pk[2], pv[2];
    { const bf16* g = proj + (size_t)row0 * INW + goff;
      pq[0] = *(const u32x4*)(g); pq[1] = *(const u32x4*)(g + 8); pk[0] = *(const u32x4*)(g + 512); pk[1] = *(const u32x4*)(g + 520); pv[0] = *(const u32x4*)(g + 1024); pv[1] = *(const u32x4*)(g + 1032); }
    unsigned gv[8], gn[8];
    const size_t ggoff = (size_t)(8 * wave) * INW + 1536 + h * 128 + 2 * lane;
#pragma unroll
    for (int i = 0; i < 8; ++i) gn[i] = *(const unsigned*)(proj + (size_t)(row0 + i) * INW + ggoff);
    const float kf = kscale * exp2f(lg2 * (float)(63 - lane));
    const float g64 = exp2f(lg2 * 64.0f);
    for (int c = 0; c < nchunks; ++c) {
        const int rowc = row0 + 64 * c;
        *(LAS u32x4*)(Qs + lane * 136 + wave * 16) = pq[0]; *(LAS u32x4*)(Qs + lane * 136 + wave * 16 + 8) = pq[1];
        *(LAS u32x4*)(Ks + lane * 136 + wave * 16) = pk[0]; *(LAS u32x4*)(Ks + lane * 136 + wave * 16 + 8) = pk[1];
#pragma unroll
        for (int i = 0; i < 2; ++i)
#pragma unroll
            for (int j = 0; j < 4; ++j) { const unsigned wk = pk[i][j], wv = pv[i][j]; const int d = wave * 16 + i * 8 + j * 2;
                const unsigned kk = pk2(bflo(wk) * kf, bfhi(wk) * kf);
                KT[(d) * 72 + lane] = (bf16)(kk & 0xffffu); KT[(d + 1) * 72 + lane] = (bf16)(kk >> 16);
                VT[(d) * 72 + lane] = (bf16)(wv & 0xffffu); VT[(d + 1) * 72 + lane] = (bf16)(wv >> 16); }
#pragma unroll
        for (int i = 0; i < 8; ++i) gv[i] = gn[i];
        if (c + 1 < nchunks) { const bf16* g = proj + (size_t)(rowc + 64) * INW + goff;
            pq[0] = *(const u32x4*)(g); pq[1] = *(const u32x4*)(g + 8); pk[0] = *(const u32x4*)(g + 512); pk[1] = *(const u32x4*)(g + 520); pv[0] = *(const u32x4*)(g + 1024); pv[1] = *(const u32x4*)(g + 1032);
#pragma unroll
            for (int i = 0; i < 8; ++i) gn[i] = *(const unsigned*)(proj + (size_t)(rowc + 64 + i) * INW + ggoff); }
        __syncthreads();
        { const int mi = wave >> 1;
#pragma unroll
          for (int jj = 0; jj < 2; ++jj) { const int lj = 2 * (wave & 1) + jj; f32x4 s = (f32x4){0.f, 0.f, 0.f, 0.f};
#pragma unroll
            for (int ks = 0; ks < 4; ++ks) { const bf16x8 a = *(const LAS bf16x8*)(Ks + (16 * mi + fr) * 136 + 32 * ks + 8 * fq), b = *(const LAS bf16x8*)(Qs + (16 * lj + fr) * 136 + 32 * ks + 8 * fq); s = MFMA16(a, b, s); }
            const int l = 16 * lj + fr; float pvv[4];
#pragma unroll
            for (int r = 0; r < 4; ++r) { const int m = 16 * mi + 4 * fq + r; const int dlt = l - m; pvv[r] = dlt >= 0 ? s[r] * kscale * exp2f(lg2 * (float)dlt) : 0.f; }
            u32x2 w; w.x = pk2(pvv[0], pvv[1]); w.y = pk2(pvv[2], pvv[3]); *(LAS u32x2*)(Ps + l * 72 + 16 * mi + 4 * fq) = w; } }
#pragma unroll
        for (int et = 0; et < 8; ++et) st[et] = st[et] * g64;
#pragma unroll
        for (int ks = 0; ks < 2; ++ks) { const bf16x8 a = *(const LAS bf16x8*)(KT + (16 * wave + fr) * 72 + 32 * ks + 8 * fq);
#pragma unroll
            for (int et = 0; et < 8; ++et) { const bf16x8 b = *(const LAS bf16x8*)(VT + (16 * et + fr) * 72 + 32 * ks + 8 * fq); st[et] = MFMA16(a, b, st[et]); } }
        __syncthreads();
        { f32x4 oi[4], oc[4];
#pragma unroll
          for (int lt = 0; lt < 4; ++lt) { oi[lt] = (f32x4){0.f, 0.f, 0.f, 0.f}; oc[lt] = (f32x4){0.f, 0.f, 0.f, 0.f}; }
#pragma unroll
          for (int ks = 0; ks < 2; ++ks) { const bf16x8 b = *(const LAS bf16x8*)(VT + (16 * wave + fr) * 72 + 32 * ks + 8 * fq);
#pragma unroll
            for (int lt = 0; lt < 4; ++lt) { const bf16x8 a = *(const LAS bf16x8*)(Ps + (16 * lt + fr) * 72 + 32 * ks + 8 * fq); oi[lt] = MFMA16(a, b, oi[lt]); } }
#pragma unroll
          for (int ks = 0; ks < 4; ++ks) { const bf16x8 b = *(const LAS bf16x8*)(ST + (16 * wave + fr) * 136 + 32 * ks + 8 * fq);
#pragma unroll
            for (int lt = 0; lt < 4; ++lt) { const bf16x8 a = *(const LAS bf16x8*)(Qs + (16 * lt + fr) * 136 + 32 * ks + 8 * fq); oc[lt] = MFMA16(a, b, oc[lt]); } }
#pragma unroll
          for (int lt = 0; lt < 4; ++lt)
#pragma unroll
            for (int r = 0; r < 4; ++r) { const int l = 16 * lt + 4 * fq + r; Os[l * 132 + 16 * wave + fr] = oi[lt][r] + exp2f(lg2 * (float)(l + 1)) * oc[lt][r]; } }
        __syncthreads();
#pragma unroll
        for (int et = 0; et < 8; ++et) { u32x2 w; w.x = pk2(st[et][0], st[et][1]); w.y = pk2(st[et][2], st[et][3]); *(LAS u32x2*)(ST + (16 * et + fr) * 136 + 16 * wave + 4 * fq) = w; }
        {
#pragma unroll
          for (int i = 0; i < 8; ++i) { const int l = 8 * wave + i; const f32x2 o = *(const LAS f32x2*)(Os + l * 132 + 2 * lane);
            const float ssq = wave_sum_dpp(o.x * o.x + o.y * o.y); const float rstd = rsqrtf(ssq * (1.f / 128.f) + EPS);
            const float g0 = bflo(gv[i]), g1 = bfhi(gv[i]);
            *(unsigned*)(mix + (size_t)(rowc + l) * DM + h * 128 + 2 * lane) = pk2(silu_f(g0) * o.x * rstd, silu_f(g1) * o.y * rstd); } }
    }
#pragma unroll
    for (int et = 0; et < 8; ++et)
#pragma unroll
        for (int r = 0; r < 4; ++r) st_out[(size_t)(16 * wave + 4 * fq + r) * 128 + 16 * et + fr] = st[et][r];
}
constexpr int AK = 0, AVT = 27648;
__device__ __forceinline__ void att_item(const Params& P, LAS unsigned char* lds, int tid, int wave, int lane, bool sample, int b, int n, int g) {
    const bf16* proj = (const bf16*)(P.ws + WS_R1);
    bf16* mix = (bf16*)(P.ws + WS_R2);
    const int fr = lane & 15, fq = lane >> 4;
    LAS bf16* Kl = (LAS bf16*)(lds + AK); LAS bf16* VTl = (LAS bf16*)(lds + AVT);
    const int qrow0 = sample ? MP + 64 * b : b * SEQ + 64 * n;
    const int jmin = sample ? 0 : (n >= 2 ? 0 : 64 * (2 - n));
    __syncthreads();
    bf16x8 qa[2][2];
    { const int hd_ = 4 * g + (wave >> 1), qh_ = wave & 1;
#pragma unroll
      for (int qt = 0; qt < 2; ++qt)
#pragma unroll
        for (int ks = 0; ks < 2; ++ks) qa[qt][ks] = *(const bf16x8*)(proj + (size_t)(qrow0 + 32 * qh_ + 16 * qt + fr) * INW + 2048 + hd_ * 64 + 32 * ks + 8 * fq); }
    {
        u32x4 kw[3], vw[3];
        if (!sample) {
#pragma unroll
            for (int i = 0; i < 3; ++i) { const bool ok = 64 * i >= jmin;
                const int rb = ok ? b * SEQ + 64 * (n - 2) + 64 * i : qrow0;
                kw[i] = *(const u32x4*)(proj + (size_t)(rb + (tid >> 3)) * INW + 2560 + g * 64 + 8 * (tid & 7));
                vw[i] = *(const u32x4*)(proj + (size_t)(rb + lane) * INW + 2688 + g * 64 + 8 * wave);
                if (!ok) { kw[i] = (u32x4){0u, 0u, 0u, 0u}; vw[i] = (u32x4){0u, 0u, 0u, 0u}; } }
        } else {
            f32x4 kc[2][2], vc[2][2];
#pragma unroll
            for (int i = 0; i < 2; ++i) { const float* sk = P.cache_k + ((size_t)(b * 128 + 64 * i + (tid >> 3)) * 2 + g) * 64 + 8 * (tid & 7); const float* sv = P.cache_v + ((size_t)(b * 128 + 64 * i + lane) * 2 + g) * 64 + 8 * wave;
                kc[i][0] = *(const f32x4*)sk; kc[i][1] = *(const f32x4*)(sk + 4); vc[i][0] = *(const f32x4*)sv; vc[i][1] = *(const f32x4*)(sv + 4); }
            kw[2] = *(const u32x4*)(proj + (size_t)(MP + 64 * b + (tid >> 3)) * INW + 2560 + g * 64 + 8 * (tid & 7));
            vw[2] = *(const u32x4*)(proj + (size_t)(MP + 64 * b + lane) * INW + 2688 + g * 64 + 8 * wave);
#pragma unroll
            for (int i = 0; i < 2; ++i) { kw[i].x = pk2(kc[i][0].x, kc[i][0].y); kw[i].y = pk2(kc[i][0].z, kc[i][0].w); kw[i].z = pk2(kc[i][1].x, kc[i][1].y); kw[i].w = pk2(kc[i][1].z, kc[i][1].w);
                vw[i].x = pk2(vc[i][0].x, vc[i][0].y); vw[i].y = pk2(vc[i][0].z, vc[i][0].w); vw[i].z = pk2(vc[i][1].x, vc[i][1].y); vw[i].w = pk2(vc[i][1].z, vc[i][1].w); }
        }
#pragma unroll
        for (int i = 0; i < 3; ++i) { *(LAS u32x4*)(Kl + (64 * i + (tid >> 3)) * 72 + 8 * (tid & 7)) = kw[i];
            const int j = 64 * i + lane;
#pragma unroll
            for (int e = 0; e < 4; ++e) { VTl[(8 * wave + 2 * e) * 200 + j] = (bf16)(vw[i][e] & 0xffffu); VTl[(8 * wave + 2 * e + 1) * 200 + j] = (bf16)(vw[i][e] >> 16); } }
    }
    const int r = wave >> 1, qh = wave & 1, head = 4 * g + r;
    const float nb8 = -8.0f * exp2f(-(float)(head + 1));
    const float sink8 = 8.0f * P.sinks[head];
    const float c1 = 0.125f * 1.4426950408889634f;
    __syncthreads();
#pragma unroll 1
    for (int qt = 0; qt < 2; ++qt) {
        asm volatile("" ::: "memory");
        const int qi = 32 * qh + 16 * qt + fr;
        bf16x8 qf[2];
#pragma unroll
        for (int ks = 0; ks < 2; ++ks) { const u32x4 x0 = __builtin_bit_cast(u32x4, qa[0][ks]), x1 = __builtin_bit_cast(u32x4, qa[1][ks]); u32x4 xs;
#pragma unroll
            for (int e = 0; e < 4; ++e) xs[e] = qt ? x1[e] : x0[e];
            qf[ks] = __builtin_bit_cast(bf16x8, xs); }
        const float basef = (float)(128 + qi - 4 * fq);
        f32x4 s[12];
#pragma unroll
        for (int kt = 0; kt < 12; ++kt) {
#pragma unroll
            for (int rr = 0; rr < 4; ++rr) s[kt][rr] = fabsf(basef - (float)(16 * kt + rr)) * nb8;
#pragma unroll
            for (int ks = 0; ks < 2; ++ks) { const bf16x8 a = *(const LAS bf16x8*)(Kl + (16 * kt + fr) * 72 + 32 * ks + 8 * fq); s[kt] = MFMA16(a, qf[ks], s[kt]); } }
        if (jmin > 0) {
#pragma unroll
            for (int kt = 0; kt < 12; ++kt)
#pragma unroll
                for (int rr = 0; rr < 4; ++rr) s[kt][rr] = (16 * kt + 4 * fq + rr) >= jmin ? s[kt][rr] : -INFINITY;
        }
        float mx = sink8;
#pragma unroll
        for (int kt = 0; kt < 12; ++kt)
#pragma unroll
            for (int rr = 0; rr < 4; ++rr) mx = fmaxf(mx, s[kt][rr]);
        mx = fmaxf(mx, __shfl_xor(mx, 16)); mx = fmaxf(mx, __shfl_xor(mx, 32));
        const float mxc = mx * c1;
        float ls = 0.f;
#pragma unroll
        for (int kt = 0; kt < 12; ++kt)
#pragma unroll
            for (int rr = 0; rr < 4; ++rr) { const float p = __builtin_amdgcn_exp2f(s[kt][rr] * c1 - mxc); s[kt][rr] = p; ls += p; }
        ls += __shfl_xor(ls, 16); ls += __shfl_xor(ls, 32);
        const float inv = 1.0f / (ls + __builtin_amdgcn_exp2f(sink8 * c1 - mxc));
        f32x4 o[4];
#pragma unroll
        for (int dt = 0; dt < 4; ++dt) o[dt] = (f32x4){0.f, 0.f, 0.f, 0.f};
#pragma unroll
        for (int kk = 0; kk < 6; ++kk) {
            u32x4 w; w.x = pk2(s[2 * kk][0], s[2 * kk][1]); w.y = pk2(s[2 * kk][2], s[2 * kk][3]); w.z = pk2(s[2 * kk + 1][0], s[2 * kk + 1][1]); w.w = pk2(s[2 * kk + 1][2], s[2 * kk + 1][3]);
            const bf16x8 pb = __builtin_bit_cast(bf16x8, w);
#pragma unroll
            for (int dt = 0; dt < 4; ++dt) { const LAS bf16* vp = VTl + (16 * dt + fr) * 200 + 32 * kk + 4 * fq;
                const u32x2 lo = *(const LAS u32x2*)vp, hi = *(const LAS u32x2*)(vp + 16);
                const u32x4 aw = (u32x4){lo.x, lo.y, hi.x, hi.y}; const bf16x8 a = __builtin_bit_cast(bf16x8, aw);
                o[dt] = MFMA16(a, pb, o[dt]); }
        }
        bf16* mp = mix + (size_t)(qrow0 + qi) * DM + 512 + head * 64 + 4 * fq;
#pragma unroll
        for (int dt = 0; dt < 4; ++dt) { const f32x4 v = o[dt] * inv; u32x2 w; w.x = pk2(v[0], v[1]); w.y = pk2(v[2], v[3]); *(u32x2*)(mp + 16 * dt) = w; }
    }
}
__device__ __forceinline__ void phase3(const Params& P, LAS unsigned char* lds, int tid, int wave, int lane) {
    const int G = gridDim.x, NR = G / 2, blk = blockIdx.x;
    if (blk < NR) {
#ifndef NO_RET
#ifdef PROBE_RETX2
        for (int rep = 0; rep < 2; ++rep)
#endif
        for (int it = blk; it < 256; it += NR) {
            const bool sample = it >= 128; const int bh = it & 127, b = bh >> 2, h = bh & 3;
            ret_item(P, lds, tid, wave, lane, h, sample ? MP + 64 * b : b * SEQ, sample ? 1 : 32, P.state_ret + (size_t)bh * 16384, sample, P.out + (sample ? OFF_SRET : OFF_PRET) + (size_t)bh * 16384);
        }
#endif
    } else {
#ifndef NO_ATT
#ifdef PROBE_ATTX2
        for (int rep = 0; rep < 2; ++rep)
#endif
        for (int it = blk - NR; it < 2112; it += G - NR) {
            const bool sample = it >= 2048;
            att_item(P, lds, tid, wave, lane, sample, sample ? (it - 2048) >> 1 : it >> 6, sample ? 2 : (it >> 1) & 31, it & 1);
        }
#endif
    }
}

__device__ __forceinline__ void phase6(const Params& P, int tid) {
    const bf16* ua = (const bf16*)(P.ws + WS_R1); bf16* ub = (bf16*)(P.ws + WS_R2);
    constexpr int CH = DFF / 8;
    const int total = MT * CH;
    for (int idx = blockIdx.x * 512 + tid; idx < total; idx += gridDim.x * 512) {
        const int row = idx / CH, j = (idx - row * CH) * 8;
        const bool smp = row >= MP; const int t = smp ? ((row - MP) & 63) : (row & 2047);
        float a[8], p1[8], p2[8], bb[8];
        unpack8(*(const u32x4*)(ua + (size_t)row * DFF + j), a);
        unpack8(*(const u32x4*)(ub + (size_t)row * DFF + j), bb);
        if (t >= 1) unpack8(*(const u32x4*)(ua + (size_t)(row - 1) * DFF + j), p1);
        else if (smp) { const float* s = P.state_conv + ((size_t)((row - MP) >> 6) * 2 + 1) * DFF + j; const f32x4 x = *(const f32x4*)s, y = *(const f32x4*)(s + 4); p1[0] = x.x; p1[1] = x.y; p1[2] = x.z; p1[3] = x.w; p1[4] = y.x; p1[5] = y.y; p1[6] = y.z; p1[7] = y.w; }
        else {
#pragma unroll
            for (int e = 0; e < 8; ++e) p1[e] = 0.f; }
        if (t >= 2) unpack8(*(const u32x4*)(ua + (size_t)(row - 2) * DFF + j), p2);
        else if (smp) { const float* s = P.state_conv + ((size_t)((row - MP) >> 6) * 2 + t) * DFF + j; const f32x4 x = *(const f32x4*)s, y = *(const f32x4*)(s + 4); p2[0] = x.x; p2[1] = x.y; p2[2] = x.z; p2[3] = x.w; p2[4] = y.x; p2[5] = y.y; p2[6] = y.z; p2[7] = y.w; }
        else {
#pragma unroll
            for (int e = 0; e < 8; ++e) p2[e] = 0.f; }
        float r[8];
#pragma unroll
        for (int h = 0; h < 2; ++h) { const f32x4 w0 = *(const f32x4*)(P.conv_w + j + 4 * h), w1 = *(const f32x4*)(P.conv_w + DFF + j + 4 * h), w2 = *(const f32x4*)(P.conv_w + 2 * DFF + j + 4 * h), cb = *(const f32x4*)(P.conv_b + j + 4 * h);
#pragma unroll
            for (int e = 0; e < 4; ++e) { const float cv = cb[e] + w0[e] * p2[4 * h + e] + w1[e] * p1[4 * h + e] + w2[e] * a[4 * h + e]; r[4 * h + e] = silu_f(cv) * bb[4 * h + e]; } }
        u32x4 w; w.x = pk2(r[0], r[1]); w.y = pk2(r[2], r[3]); w.z = pk2(r[4], r[5]); w.w = pk2(r[6], r[7]);
        *(u32x4*)(ub + (size_t)row * DFF + j) = w;
    }
}
#ifdef CONV_FUSED
__device__ __forceinline__ void phase6c(const Params& P, int tid) {
    const float* headA = (const float*)(P.ws + WS_R1); const float* headB = headA + HT_STRIDE; const float* tailA = headA + 2 * HT_STRIDE;
    bf16* act = (bf16*)(P.ws + WS_R2);
    constexpr int CH = DFF / 4;
    const int total = NGRP * CH;
    for (int idx = blockIdx.x * 512 + tid; idx < total; idx += gridDim.x * 512) {
        const int g = idx / CH, j = (idx - g * CH) * 4;
        const bool smp = g >= 1024, first = !smp && (g & 31) == 0;
        const float* pp = smp ? P.state_conv + ((size_t)(g - 1024) * 2) * DFF + j : tailA + ((size_t)(first ? g : g - 1) * 2) * DFF + j;
        f32x4 p0 = *(const f32x4*)pp, p1 = *(const f32x4*)(pp + DFF);
        const f32x4 a0 = *(const f32x4*)(headA + ((size_t)g * 2) * DFF + j), a1 = *(const f32x4*)(headA + ((size_t)g * 2 + 1) * DFF + j);
        const f32x4 b0 = *(const f32x4*)(headB + ((size_t)g * 2) * DFF + j), b1 = *(const f32x4*)(headB + ((size_t)g * 2 + 1) * DFF + j);
        const f32x4 t0 = *(const f32x4*)(tailA + ((size_t)g * 2) * DFF + j), t1 = *(const f32x4*)(tailA + ((size_t)g * 2 + 1) * DFF + j);
        const f32x4 w0 = *(const f32x4*)(P.conv_w + j), w1 = *(const f32x4*)(P.conv_w + DFF + j), w2 = *(const f32x4*)(P.conv_w + 2 * DFF + j), cb = *(const f32x4*)(P.conv_b + j);
        if (first) { p0 = (f32x4){0.f, 0.f, 0.f, 0.f}; p1 = (f32x4){0.f, 0.f, 0.f, 0.f}; }
        const f32x4 c0 = cb + w0 * p0 + w1 * p1 + w2 * a0, c1 = cb + w0 * p1 + w1 * a0 + w2 * a1;
        u32x2 r0, r1;
        r0.x = pk2(silu_f(c0.x) * b0.x, silu_f(c0.y) * b0.y); r0.y = pk2(silu_f(c0.z) * b0.z, silu_f(c0.w) * b0.w);
        r1.x = pk2(silu_f(c1.x) * b1.x, silu_f(c1.y) * b1.y); r1.y = pk2(silu_f(c1.z) * b1.z, silu_f(c1.w) * b1.w);
        *(u32x2*)(act + (size_t)(64 * g) * DFF + j) = r0;
        *(u32x2*)(act + (size_t)(64 * g + 1) * DFF + j) = r1;
        if (smp) { float* d = P.out + OFF_SCONV + ((size_t)(g - 1024) * 2) * DFF + j; *(f32x4*)d = t0; *(f32x4*)(d + DFF) = t1; }
        else if ((g & 31) == 31) { float* d = P.out + OFF_PCONV + ((size_t)(g >> 5) * 2) * DFF + j; *(f32x4*)d = t0; *(f32x4*)(d + DFF) = t1; }
    }
}
#endif
__device__ __forceinline__ void phase8n(const Params& P, LAS unsigned char* lds, int tid, int wave, int lane) {
    const float* mod = (const float*)(P.ws + WS_MOD); const bf16* x2 = (const bf16*)(P.ws + WS_R0);
    LAS float* lv = (LAS float*)lds;
    const int b = blockIdx.x, bsP = b >> 3, bsS = 32 + (b >> 3);
    __syncthreads();
    for (int i = tid; i < 4096; i += 512) { const int sl = i >> 11, which = (i >> 10) & 1, col = i & 1023; const float* mb = mod + (size_t)(sl ? bsS : bsP) * 8192 + 6144;
        lv[i] = which ? P.normf[col] * (1.f + mb[1024 + col]) : mb[col]; }
    __syncthreads();
#pragma unroll 4
    for (int r = wave; r < 256; r += 8) {
        const int row = 256 * b + r;
        const bf16* xr = x2 + (size_t)row * DM + 4 * lane;
        f32x4 v[4]; float ss = 0.f;
#pragma unroll
        for (int j = 0; j < 4; ++j) { const u32x2 w = *(const u32x2*)(xr + 256 * j); v[j] = (f32x4){bflo(w.x), bfhi(w.x), bflo(w.y), bfhi(w.y)};
            ss += (v[j].x * v[j].x + v[j].y * v[j].y) + (v[j].z * v[j].z + v[j].w * v[j].w); }
        const float rstd = __builtin_amdgcn_rsqf(wave_sum_dpp(ss) * (1.f / DM) + EPS);
        float* yr = P.out + (size_t)row * DM + 4 * lane;
#pragma unroll
        for (int j = 0; j < 4; ++j) { const f32x4 sh = *(const LAS f32x4*)(lv + 256 * j + 4 * lane), gs = *(const LAS f32x4*)(lv + 1024 + 256 * j + 4 * lane);
            *(f32x4*)(yr + 256 * j) = v[j] * rstd * gs + sh; }
    }
    {
        const int r = 8 * b + wave, row = MP + r;
        const bf16* xr = (const bf16*)(P.ws + WS_X1B) + (size_t)row * DM + 4 * lane;
        const float* sl = (const float*)(P.ws + WS_SLAB) + (size_t)r * DM + 4 * lane;
        const float* g2 = mod + (size_t)bsS * 8192 + 5120 + 4 * lane;
        f32x4 v[4]; float ss = 0.f;
#pragma unroll
        for (int j = 0; j < 4; ++j) { const u32x2 w = *(const u32x2*)(xr + 256 * j); f32x4 a = *(const f32x4*)(sl + 256 * j);
#pragma unroll
            for (int p = 1; p < 4; ++p) a += *(const f32x4*)(sl + (size_t)p * MS * DM + 256 * j);
            v[j] = (f32x4){bflo(w.x), bfhi(w.x), bflo(w.y), bfhi(w.y)} + *(const f32x4*)(g2 + 256 * j) * a;
            ss += (v[j].x * v[j].x + v[j].y * v[j].y) + (v[j].z * v[j].z + v[j].w * v[j].w); }
        const float rstd = __builtin_amdgcn_rsqf(wave_sum_dpp(ss) * (1.f / DM) + EPS);
        float* yr = P.out + (size_t)row * DM + 4 * lane;
#pragma unroll
        for (int j = 0; j < 4; ++j) { const f32x4 sh = *(const LAS f32x4*)(lv + 2048 + 256 * j + 4 * lane), gs = *(const LAS f32x4*)(lv + 3072 + 256 * j + 4 * lane);
            *(f32x4*)(yr + 256 * j) = v[j] * rstd * gs + sh; }
    }
}
__device__ __forceinline__ void phase8(const Params& P, int wave, int lane) {
    const float* mod = (const float*)(P.ws + WS_MOD); const bf16* x2 = (const bf16*)(P.ws + WS_R0);
    const int gw = blockIdx.x * 8 + wave, NGW = gridDim.x * 8;
#pragma unroll 2
    for (int row = gw; row < MT; row += NGW) {
        const int bs = row < MP ? (row >> 11) : 32 + ((row - MP) >> 6);
        float* yr = P.out + (size_t)row * DM + 8 * lane;
        const float* mb = mod + (size_t)bs * 8192 + 6144 + 8 * lane;
        float v[2][8]; float ss = 0.f;
        if (row < MP) {
            const bf16* xr = x2 + (size_t)row * DM + 8 * lane;
#pragma unroll
            for (int j = 0; j < 2; ++j) unpack8(*(const u32x4*)(xr + 512 * j), v[j]);
        } else {
            const bf16* xr = (const bf16*)(P.ws + WS_X1B) + (size_t)row * DM + 8 * lane;
            const float* sl = (const float*)(P.ws + WS_SLAB) + (size_t)(row - MP) * DM + 8 * lane;
            const float* g2 = mod + (size_t)bs * 8192 + 5120 + 8 * lane;
#pragma unroll
            for (int j = 0; j < 2; ++j) { unpack8(*(const u32x4*)(xr + 512 * j), v[j]);
#pragma unroll
                for (int h = 0; h < 2; ++h) { const int o = 512 * j + 4 * h; f32x4 a = *(const f32x4*)(sl + o);
#pragma unroll
                    for (int p = 1; p < 4; ++p) a += *(const f32x4*)(sl + (size_t)p * MS * DM + o);
                    const f32x4 g = *(const f32x4*)(g2 + o);
#pragma unroll
                    for (int e = 0; e < 4; ++e) v[j][4 * h + e] += g[e] * a[e]; } }
        }
#pragma unroll
        for (int j = 0; j < 2; ++j)
#pragma unroll
            for (int e = 0; e < 8; ++e) ss += v[j][e] * v[j][e];
        const float rstd = rsqrtf(wave_sum(ss) * (1.f / DM) + EPS);
#pragma unroll
        for (int j = 0; j < 2; ++j)
#pragma unroll
            for (int h = 0; h < 2; ++h) { const int o = 512 * j + 4 * h; const f32x4 sh = *(const f32x4*)(mb + o), sc = *(const f32x4*)(mb + 1024 + o), gn = *(const f32x4*)(P.normf + 8 * lane + o);
                const f32x4 x = (f32x4){v[j][4 * h], v[j][4 * h + 1], v[j][4 * h + 2], v[j][4 * h + 3]};
                *(f32x4*)(yr + o) = x * rstd * gn * (sc + 1.0f) + sh; }
    }
}
__device__ __forceinline__ void phase8q(const Params& P, LAS unsigned char* lds, int tid, int wave, int lane) {
    const float* mod = (const float*)(P.ws + WS_MOD);
    unsigned* cnt = (unsigned*)(P.ws + WS_CNT7); unsigned* ticket = (unsigned*)(P.ws + WS_TICKET);
    LAS int* ord = (LAS int*)(lds + 131072);
    LAS int* flag = ord + 272;
    pg8::StaticOrder S; S.init(MT, DM, (int)gridDim.x, 0);
    for (int i = tid; i < NTM; i += 512) flag[i] = 0;
    __syncthreads();
    { const int full = (S.nwg / S.G) * S.G; for (int L = full + tid; L < S.nwg; L += 512) { pg8::Unit u; S.map(L, u); flag[u.pm] = 1; } }
    __syncthreads();
    if (tid == 0) { int k = 0; for (int i = 0; i < NTM; ++i) if (!flag[i]) ord[k++] = i; for (int i = 0; i < NTM; ++i) if (flag[i]) ord[k++] = i; }
    __syncthreads();
    for (;;) {
        if (tid == 0) flag[268] = (int)__hip_atomic_fetch_add(ticket, 1u, __ATOMIC_RELAXED, __HIP_MEMORY_SCOPE_AGENT);
        __syncthreads();
        const int tk = flag[268];
        if (tk >= NTM * 4) break;
        const int pm = ord[tk >> 2], rb = tk & 3;
        if (wave == 0) {
            unsigned spins = 0;
            while ((unsigned)__builtin_amdgcn_readfirstlane(__hip_atomic_load(cnt + 64 * pm, __ATOMIC_RELAXED, __HIP_MEMORY_SCOPE_AGENT)) < 32u) { __builtin_amdgcn_s_sleep(4); if (++spins > (1u << 22)) break; }
            __builtin_amdgcn_fence(__ATOMIC_ACQUIRE, "agent");
            asm volatile("s_waitcnt vmcnt(0)" ::: "memory");
        }
        __syncthreads();
#pragma unroll 2
        for (int i = 0; i < 8; ++i) {
            const int row = pm * 256 + rb * 64 + wave * 8 + i;
            const int bs = row < MP ? (row >> 11) : 32 + ((row - MP) >> 6);
            float* yr = P.out + (size_t)row * DM + 4 * lane;
            const float* mb = mod + (size_t)bs * 8192 + 6144 + 4 * lane;
            f32x4 v[4]; float ss = 0.f;
#pragma unroll
            for (int j = 0; j < 4; ++j) { v[j] = *(const f32x4*)(yr + 256 * j); ss += (v[j].x * v[j].x + v[j].y * v[j].y) + (v[j].z * v[j].z + v[j].w * v[j].w); }
            const float rstd = rsqrtf(wave_sum(ss) * (1.f / DM) + EPS);
#pragma unroll
            for (int j = 0; j < 4; ++j) { const f32x4 sh = *(const f32x4*)(mb + 256 * j), sc = *(const f32x4*)(mb + 1024 + 256 * j), gn = *(const f32x4*)(P.normf + 4 * lane + 256 * j);
                *(f32x4*)(yr + 256 * j) = v[j] * rstd * gn * (sc + 1.0f) + sh; }
        }
    }
}

__device__ __forceinline__ void sample_fix(const Params& P, int wave, int lane) {
    const float* mod = (const float*)(P.ws + WS_MOD); const float* sl0 = (const float*)(P.ws + WS_SLAB4);
    bf16* a2 = (bf16*)(P.ws + WS_R0); bf16* x1b = (bf16*)(P.ws + WS_X1B); float* ss1 = (float*)(P.ws + WS_SS1);
    const int gw = blockIdx.x * 8 + wave, NGW = gridDim.x * 8;
    for (int r = gw; r < MS; r += NGW) {
        const int row = MP + r, bs = 32 + (r >> 6);
        const float* xr = P.x_s + (size_t)r * DM + 8 * lane; const float* sl = sl0 + (size_t)r * DM + 8 * lane; const float* mb = mod + (size_t)bs * 8192 + 8 * lane;
        float v[2][8], a[2][8]; float ss = 0.f;
#pragma unroll
        for (int j = 0; j < 2; ++j)
#pragma unroll
            for (int h = 0; h < 2; ++h) { const int o = 512 * j + 4 * h; f32x4 acc = *(const f32x4*)(sl + o);
#pragma unroll
                for (int p = 1; p < 4; ++p) acc += *(const f32x4*)(sl + (size_t)p * MS * DM + o);
                const f32x4 x = *(const f32x4*)(xr + o) + *(const f32x4*)(mb + 2048 + o) * acc;
                const f32x4 gs = *(const f32x4*)(P.ln2 + 8 * lane + o) * (*(const f32x4*)(mb + 4096 + o) + 1.0f);
#pragma unroll
                for (int e = 0; e < 4; ++e) { v[j][4 * h + e] = x[e]; a[j][4 * h + e] = x[e] * gs[e]; ss += x[e] * x[e]; } }
        ss = wave_sum(ss);
#pragma unroll
        for (int j = 0; j < 2; ++j) { u32x4 w; w.x = pk2(v[j][0], v[j][1]); w.y = pk2(v[j][2], v[j][3]); w.z = pk2(v[j][4], v[j][5]); w.w = pk2(v[j][6], v[j][7]);
            *(u32x4*)(x1b + (size_t)row * DM + 8 * lane + 512 * j) = w;
            w.x = pk2(a[j][0], a[j][1]); w.y = pk2(a[j][2], a[j][3]); w.z = pk2(a[j][4], a[j][5]); w.w = pk2(a[j][6], a[j][7]);
            *(u32x4*)(a2 + (size_t)row * DM + 8 * lane + 512 * j) = w; }
        if (lane < 16) ss1[(size_t)row * 16 + lane] = lane == 0 ? ss : 0.f;
    }
}

#ifndef N_LAUNCH
#define N_LAUNCH 1
#endif
#define LAUNDER_TID() int tid = threadIdx.x; asm volatile("" : "+v"(tid)); const int lane = tid & 63, wave = __builtin_amdgcn_readfirstlane(tid >> 6); (void)lane; (void)wave
template <int PHM>
__global__ void __launch_bounds__(512) fwd_mega(Params P) {
    extern __shared__ __attribute__((aligned(16))) unsigned char lds_raw[];
    LAS unsigned char* lds = (LAS unsigned char*)lds_raw;
    const int G = gridDim.x;
    unsigned char* ws = P.ws;
    volatile LAS unsigned* misc = (volatile LAS unsigned*)(lds + LDS_MISC);
    if (threadIdx.x < 2) misc[threadIdx.x] = 0u;
    __syncthreads();
    XcdBarrier bar; bar.bar = (unsigned*)(ws + WS_BAR); bar.x = 0; bar.st = misc;
#define GSYNC(a, b) do { if ((PHM & (a)) && (PHM & (b))) xcd_barrier(bar); } while (0)
    if constexpr (PHM == 511) {
      if (blockIdx.x == 0) for (int i = threadIdx.x; i < XCD_BAR_WORDS; i += 512) ((unsigned*)(ws + WS_BAR))[i] = 0u;
      if (blockIdx.x == 1) { for (int i = threadIdx.x; i < NTM * 64; i += 512) ((unsigned*)(ws + WS_CNT7))[i] = 0u; if (threadIdx.x < 64) ((unsigned*)(ws + WS_TICKET))[threadIdx.x] = 0u; }
      cg::this_grid().sync();
      bar = xcd_barrier_post((unsigned*)(ws + WS_BAR), misc); }
    if constexpr ((PHM & 1) != 0) { LAUNDER_TID(); phase0(P, lds, wave, lane); }
    GSYNC(1, 2);
    if constexpr ((PHM & 2) != 0) { LAUNDER_TID(); phase1(P, lds, tid, wave, lane); }
    GSYNC(2, 4);
    if constexpr ((PHM & 4) != 0) {
      pg8::Gemm g{(const bf16*)(ws + WS_R0), (const bf16*)(ws + WS_WIN), MT, INW, DM};
      OrderX S; S.S.init(MT, INW, G, (int)blockIdx.x); S.nX = 22; S.xpm = NTM; S.xpn0 = 11;
      Epi1 E{(bf16*)(ws + WS_R1), (float*)(ws + WS_SHW), P.out};
      pg8::gemm_phase<Epi1, OrderX, true, true>(lds, g, S, E); }
    GSYNC(4, 8);
    if constexpr ((PHM & 8) != 0) { LAUNDER_TID(); phase3(P, lds, tid, wave, lane);
#ifdef PROBE_P3X2
      cg::this_grid().sync(); phase3(P, lds, tid, wave, lane);
#endif
    }
    GSYNC(8, 16);
    if constexpr ((PHM & 16) != 0) {
      pg8::Gemm g{(const bf16*)(ws + WS_R2), (const bf16*)(ws + WS_WOUT), MT, DM, DM};
      OrderDown S; S.S.init(MP, DM, G, (int)blockIdx.x); S.ka = 4; S.kb = 4;
      Epi2 E{P.x_p, P.x_s, (const float*)(ws + WS_MOD), P.ln2, (bf16*)(ws + WS_X1B), (bf16*)(ws + WS_R0), (float*)(ws + WS_SS1), (float*)(ws + WS_SLAB4)};
      pg8::gemm_phase<Epi2, OrderDown, true, true>(lds, g, S, E); }
    GSYNC(16, 32);
    if constexpr ((PHM & 32) != 0) {
      LAUNDER_TID();
      sample_fix(P, wave, lane);
      if constexpr (PHM == 511) xcd_barrier(bar);
      pg8::Gemm g{(const bf16*)(ws + WS_R0), (const bf16*)(ws + WS_WUP), MT, 2 * DFF, DM};
      pg8::StaticOrder S; S.init(MT, 2 * DFF, G, (int)blockIdx.x);
      LAS float* rtab = (LAS float*)(lds + 131072);
      {
        LAS int* pmt = (LAS int*)lds;
        if (tid < 24) { pg8::Unit u; const bool ok = S.next(tid, u); pmt[tid] = ok ? u.pm : -1; }
        __syncthreads();
        if (tid < 256) { const float* ss = (const float*)(ws + WS_SS1);
#pragma unroll
          for (int i0 = 0; i0 < 24; i0 += 6) {
            f32x4 q[6][4]; int pmv[6];
#pragma unroll
            for (int k = 0; k < 6; ++k) { pmv[k] = pmt[i0 + k]; const f32x4* sp = (const f32x4*)(ss + (size_t)((pmv[k] < 0 ? 0 : pmv[k]) * 256 + tid) * 16);
#pragma unroll
                for (int e = 0; e < 4; ++e) q[k][e] = sp[e]; }
#pragma unroll
            for (int k = 0; k < 6; ++k) { const float tot = ((q[k][0].x + q[k][0].y) + (q[k][0].z + q[k][0].w)) + ((q[k][1].x + q[k][1].y) + (q[k][1].z + q[k][1].w)) + ((q[k][2].x + q[k][2].y) + (q[k][2].z + q[k][2].w)) + ((q[k][3].x + q[k][3].y) + (q[k][3].z + q[k][3].w));
                rtab[(i0 + k) * 256 + tid] = __builtin_amdgcn_rsqf(tot * (1.f / DM) + EPS); } } }
        __syncthreads(); }
#ifdef CONV_FUSED
      float* hA = (float*)(ws + WS_R1);
      Epi3C E{rtab, (const float*)(ws + WS_SHW), P.conv_w, P.conv_b, (bf16*)(ws + WS_R2), hA, hA + HT_STRIDE, hA + 2 * HT_STRIDE};
      pg8::gemm_phase<Epi3C, pg8::StaticOrder, true, true>(lds, g, S, E);
#else
      Epi3 E{rtab, (const float*)(ws + WS_SHW), (bf16*)(ws + WS_R1), (bf16*)(ws + WS_R2), P.out};
      pg8::gemm_phase<Epi3, pg8::StaticOrder, true, true>(lds, g, S, E);
#endif
#ifdef PROBE_P5X2
      cg::this_grid().sync(); pg8::gemm_phase<Epi3, pg8::StaticOrder, true, true>(lds, g, S, E);
#endif
    }
    GSYNC(32, 64);
#ifdef CONV_FUSED
    if constexpr ((PHM & 64) != 0) { LAUNDER_TID(); phase6c(P, tid); }
#else
    if constexpr ((PHM & 64) != 0) { LAUNDER_TID(); phase6(P, tid); }
#endif
    GSYNC(64, 128);
    if constexpr ((PHM & 128) != 0) {
      pg8::Gemm g{(const bf16*)(ws + WS_R2), (const bf16*)(ws + WS_WDN), MT, DM, DFF};
#ifdef P8_QUEUE
      OrderPub S; S.init(MT, DM, G, (int)blockIdx.x); S.cnt = (unsigned*)(ws + WS_CNT7);
      Epi4 E{(const float*)(ws + WS_MOD), (const bf16*)(ws + WS_X1B), (bf16*)(ws + WS_R0), (float*)(ws + WS_SLAB)};
      pg8::gemm_phase<Epi4, OrderPub, true, true>(lds, g, S, E); }
    if constexpr ((PHM & 256) != 0) { LAUNDER_TID(); phase8q(P, lds, tid, wave, lane); }
#else
      OrderDown S; S.S.init(MP, DM, G, (int)blockIdx.x); S.ka = 12; S.kb = 10;
      Epi4 E{(const float*)(ws + WS_MOD), (const bf16*)(ws + WS_X1B), (bf16*)(ws + WS_R0), (float*)(ws + WS_SLAB)};
      pg8::gemm_phase<Epi4, OrderDown, true, true>(lds, g, S, E); }
    GSYNC(128, 256);
    if constexpr ((PHM & 256) != 0) { LAUNDER_TID(); if (gridDim.x == 256) phase8n(P, lds, tid, wave, lane); else phase8(P, wave, lane); }
#endif
}

template <int PHM> static bool launch_one(const Params& p, int grid, bool coop, hipStream_t stream) {
    static bool attr_done = false;
    if (!attr_done) { if (hipFuncSetAttribute((const void*)fwd_mega<PHM>, hipFuncAttributeMaxDynamicSharedMemorySize, LDS_BYTES) != hipSuccess) { fprintf(stderr, "kernel_launch: hipFuncSetAttribute failed\n"); return false; } attr_done = true; }
    hipError_t e;
    if (coop) { Params pc = p; void* args[] = {&pc}; e = hipLaunchCooperativeKernel((const void*)fwd_mega<PHM>, dim3(grid), dim3(512), args, LDS_BYTES, stream); }
    else { hipLaunchKernelGGL(fwd_mega<PHM>, dim3(grid), dim3(512), LDS_BYTES, stream, p); e = hipPeekAtLastError(); }
    if (e != hipSuccess) { fprintf(stderr, "launch (mask %d) failed: %s (grid %d)\n", PHM, hipGetErrorString(e), grid); return false; }
    return true;
}
extern "C" void kernel_launch(void* const* d_in, const int* in_sizes, int n_in, void* d_out, int out_size, void* d_ws, size_t ws_size, hipStream_t stream) {
    static int grid = 0;
    if (grid == 0) {
        if (n_in != 22 || (size_t)out_size != OUT_TOTAL || ws_size < WS_END) { fprintf(stderr, "kernel_launch: unexpected sizes n_in %d out %d ws %zu\n", n_in, out_size, ws_size); grid = -1; return; }
        int dev = 0, cus = 0;
        (void)hipGetDevice(&dev);
        (void)hipDeviceGetAttribute(&cus, hipDeviceAttributeMultiprocessorCount, dev);
        grid = cus;
        if (grid > 256) grid = 256;
        if (grid < 2) grid = -1;
    }
    if (grid < 0) return;
    Params p{};
    const float** pp = (const float**)&p;
    for (int i = 0; i < 22; ++i) pp[i] = (const float*)d_in[i];
    p.out = (float*)d_out; p.ws = (unsigned char*)d_ws;
#if N_LAUNCH == 1
    launch_one<511>(p, grid, true, stream);
#else
    launch_one<1>(p, grid, false, stream) && launch_one<2>(p, grid, false, stream) && launch_one<4>(p, grid, false, stream) && launch_one<8>(p, grid, false, stream) &&
    launch_one<16>(p, grid, false, stream) && launch_one<32>(p, grid, false, stream) && launch_one<64>(p, grid, false, stream) && launch_one<128>(p, grid, false, stream) && launch_one<256>(p, grid, false, stream);
#endif
}
```

```cpp
#define CONV_FUSED 1
#include <hip/hip_runtime.h>
#include <hip/hip_cooperative_groups.h>
#include <cstdio>
#include <cstdint>
namespace cg = cooperative_groups;
namespace pg8 {
#define PG8_LAS __attribute__((address_space(3)))
typedef unsigned short bf16_t;
typedef short bf16x8 __attribute__((ext_vector_type(8)));
typedef float f32x4 __attribute__((ext_vector_type(4)));
typedef unsigned u32x4 __attribute__((ext_vector_type(4)));
constexpr int BM = 256, BK = 64, HALF = 128, HTB = HALF * BK * 2  , STAGE_BYTES = 8 * HTB, NXCD = 8, WGM = 8;

__host__ __device__ __forceinline__ int lds_byte(int r, int c) { const int st = (r >> 4) * 2 + (c >> 5), rr = r & 15, cc = c & 31, ob = rr * 64 + cc * 2; return st * 1024 + (ob ^ (((ob >> 9) & 1) << 5)); }
__host__ __device__ __forceinline__ void stage_rc(int b, int& R, int& C) { const int st = b / 1024, sb = b % 1024, swz = sb ^ (((sb >> 9) & 1) << 5); R = (st >> 1) * 16 + swz / 64; C = (st & 1) * 32 + (swz % 64) / 2; }
__host__ __device__ __forceinline__ int perm32(int rho) { const int n = rho >> 4, i = rho & 15; return 8 * (i >> 2) + 4 * n + (i & 3); }

struct Unit { int pm, pn, seq, kt0, nt; };
struct Gemm { const bf16_t* A; const bf16_t* Bt; int M, N, K; };

struct StaticOrder {
    int nM, nN, nwg, G, c;
    __host__ __device__ __forceinline__ void init(int M, int N, int G_, int c_) { nM = M / BM; nN = N / BM; nwg = nM * nN; G = G_; c = c_; }
    __host__ __device__ __forceinline__ bool next(int i, Unit& u) const {
        const long L = (long)i * G + c; if (L >= nwg) return false; u.seq = i; u.kt0 = 0; u.nt = 0; map(L, u); return true; }
    __host__ __device__ __forceinline__ void map(long L, Unit& u) const {
        int wgid = (int)L; { const int q = nwg / NXCD, r = nwg % NXCD, xcd = wgid % NXCD, off = wgid / NXCD; wgid = (xcd < r ? xcd * (q + 1) : r * (q + 1) + (xcd - r) * q) + off; }
        const int nig = WGM * nN, gid = wgid / nig, fm = gid * WGM, gsz = (nM - fm) < WGM ? (nM - fm) : WGM;
        u.pm = fm + ((wgid % nig) % gsz); u.pn = (wgid % nig) / gsz;
    }
    __device__ __forceinline__ void a_ready(const Unit&) const {}
    __device__ __forceinline__ void done(const Unit&) const {}
};

__device__ __forceinline__ unsigned cvt_pk_bf16(float lo, float hi) { unsigned r; asm volatile("v_cvt_pk_bf16_f32 %0, %1, %2" : "=v"(r) : "v"(lo), "v"(hi)); return r; }

template <class Epi, class Sched, bool ALIGN_EPI = false, bool SP2 = false>
__device__ __forceinline__ void gemm_phase(PG8_LAS unsigned char* lds, const Gemm g, const Sched& S, const Epi& E) {
    int tid_ = threadIdx.x; asm volatile("" : "+v"(tid_));
    const int tid = tid_, wid = __builtin_amdgcn_readfirstlane(tid >> 6), lane = tid & 63, wr = wid >> 2, wc = wid & 3, fr = lane & 15, fq = lane >> 4;
    const int K = g.K, nt = K / BK;
    unsigned voffA[2], voffB[2];
#pragma unroll
    for (int i = 0; i < 2; ++i) { int R, C; stage_rc(tid * 16 + i * 8192, R, C); const int Rb = Epi::PERM ? ((R & ~31) + perm32(R & 31)) : R;
        voffA[i] = (unsigned)(R * K + C) * 2u; voffB[i] = (unsigned)(Rb * K + C) * 2u; }
    const size_t kstep = (size_t)(BK * 2);
    const size_t hstep = (size_t)HALF * K * 2;
    const size_t tstep = 2 * hstep;
    const unsigned ldsw = (unsigned)wid * 1024u;
    const int aoff = lds_byte(wr * 64 + fr, fq * 8), boff = lds_byte(wc * 32 + fr, fq * 8);
#define PG8_SA(b, h) (((b) * 2 + (h)) * HTB)
#define PG8_SB(b, h) ((4 + (b) * 2 + (h)) * HTB)
#define PG8_STAGE(bufoff, gbase, voff) do { _Pragma("unroll") for (int _i = 0; _i < 2; ++_i) \
        __builtin_amdgcn_global_load_lds((const unsigned*)((const char*)(gbase) + (voff)[_i]), (PG8_LAS unsigned*)(lds + (bufoff) + ldsw + _i * 8192), 16, 0, 0); } while (0)
#define PG8_LDA(dst, b, h) do { _Pragma("unroll") for (int m = 0; m < 4; ++m) _Pragma("unroll") for (int k = 0; k < 2; ++k) dst[m][k] = *(const PG8_LAS bf16x8*)(lds + PG8_SA(b, h) + aoff + m * 2048 + k * 1024); } while (0)
#define PG8_LDB(dst, b, h) do { _Pragma("unroll") for (int n = 0; n < 2; ++n) _Pragma("unroll") for (int k = 0; k < 2; ++k) dst[n][k] = *(const PG8_LAS bf16x8*)(lds + PG8_SB(b, h) + boff + n * 2048 + k * 1024); } while (0)
#define PG8_MMA(ai, bj, At, Bt) do { __builtin_amdgcn_s_setprio(1); _Pragma("unroll") for (int m = 0; m < 4; ++m) _Pragma("unroll") for (int n = 0; n < 2; ++n) _Pragma("unroll") for (int k = 0; k < 2; ++k) \
        acc[ai][bj][m][n] = __builtin_amdgcn_mfma_f32_16x16x32_bf16(Bt[n][k], At[m][k], acc[ai][bj][m][n], 0, 0, 0); __builtin_amdgcn_s_setprio(0); } while (0)
#define PG8_WAIT_V(n) asm volatile("s_waitcnt vmcnt(" #n ")" ::: "memory")
#define PG8_WAIT_L(n) asm volatile("s_waitcnt lgkmcnt(" #n ")" ::: "memory")
#define PG8_BAR __builtin_amdgcn_s_barrier()
#define PG8_SCHED __builtin_amdgcn_sched_barrier(0)
    Unit cur, nxt; int ui = 0;
    if (!S.next(0, cur)) return;
    f32x4 acc[2][2][4][2];
#pragma unroll
    for (int a = 0; a < 2; ++a)
#pragma unroll
        for (int b = 0; b < 2; ++b)
#pragma unroll
            for (int m = 0; m < 4; ++m)
#pragma unroll
                for (int n = 0; n < 2; ++n) acc[a][b][m][n] = (f32x4){0.f, 0.f, 0.f, 0.f};
    bf16x8 At[4][2], B0[2][2], B1[2][2];
    const char* cA = (const char*)g.A + (size_t)cur.pm * tstep + (size_t)cur.kt0 * (BK * 2); const char* cB = (const char*)g.Bt + (size_t)cur.pn * tstep + (size_t)cur.kt0 * (BK * 2);
    S.a_ready(cur);
    if constexpr (SP2) {
        PG8_STAGE(PG8_SB(0, 0), cB, voffB); PG8_STAGE(PG8_SB(0, 1), cB + hstep, voffB); PG8_STAGE(PG8_SA(0, 0), cA, voffA); PG8_STAGE(PG8_SA(0, 1), cA + hstep, voffA);
        if (wr == 1) PG8_BAR;
        PG8_WAIT_V(2); PG8_BAR;
        PG8_STAGE(PG8_SB(1, 0), cB + kstep, voffB); PG8_STAGE(PG8_SA(1, 0), cA + kstep, voffA); PG8_STAGE(PG8_SB(1, 1), cB + hstep + kstep, voffB);
        PG8_WAIT_V(6); PG8_BAR;
    } else {
        PG8_STAGE(PG8_SB(0, 0), cB, voffB); PG8_STAGE(PG8_SA(0, 0), cA, voffA); PG8_STAGE(PG8_SB(0, 1), cB + hstep, voffB); PG8_STAGE(PG8_SA(0, 1), cA + hstep, voffA);
        if (wr == 1) PG8_BAR;
        PG8_WAIT_V(4); PG8_BAR;
        PG8_STAGE(PG8_SB(1, 0), cB + kstep, voffB); PG8_STAGE(PG8_SA(1, 0), cA + kstep, voffA); PG8_STAGE(PG8_SB(1, 1), cB + hstep + kstep, voffB);
        PG8_WAIT_V(6); PG8_BAR;
    }
    for (;;) {
        const bool has_next = S.next(ui + 1, nxt);
        const char* nA = has_next ? (const char*)g.A + (size_t)nxt.pm * tstep + (size_t)nxt.kt0 * (BK * 2) : cA; const char* nB = has_next ? (const char*)g.Bt + (size_t)nxt.pn * tstep + (size_t)nxt.kt0 * (BK * 2) : cB;
        const int ntu = cur.nt ? cur.nt : nt;
        for (int t = 0; t < ntu; t += 2) {
            const bool last = (t == ntu - 2);
            const char* a1 = cA + (size_t)(t + 1) * kstep;
            const char* a2 = last ? nA : cA + (size_t)(t + 2) * kstep; const char* b2 = last ? nB : cB + (size_t)(t + 2) * kstep;
            const char* a3 = a2 + kstep; const char* b3 = b2 + kstep;
            if (last && has_next) S.a_ready(nxt);
            if constexpr (SP2) {
            PG8_LDB(B0, 0, 0); PG8_LDB(B1, 0, 1); PG8_SCHED; PG8_LDA(At, 0, 0); PG8_STAGE(PG8_SA(1, 1), a1 + hstep, voffA);
            PG8_WAIT_V(8); PG8_WAIT_L(0); PG8_BAR; PG8_MMA(0, 0, At, B0); PG8_MMA(0, 1, At, B1); PG8_BAR; PG8_SCHED;
            PG8_LDA(At, 0, 1); PG8_STAGE(PG8_SB(0, 0), b2, voffB); PG8_STAGE(PG8_SB(0, 1), b2 + hstep, voffB); PG8_STAGE(PG8_SA(0, 0), a2, voffA);
            PG8_WAIT_V(8); PG8_WAIT_L(0); PG8_BAR; PG8_MMA(1, 0, At, B0); PG8_MMA(1, 1, At, B1); PG8_BAR; PG8_SCHED;
            PG8_LDB(B0, 1, 0); PG8_LDB(B1, 1, 1); PG8_SCHED; PG8_LDA(At, 1, 0); PG8_STAGE(PG8_SA(0, 1), a2 + hstep, voffA);
            PG8_WAIT_V(8); PG8_WAIT_L(0); PG8_BAR; PG8_MMA(0, 0, At, B0); PG8_MMA(0, 1, At, B1); PG8_BAR; PG8_SCHED;
            PG8_LDA(At, 1, 1); PG8_STAGE(PG8_SB(1, 0), b3, voffB); PG8_STAGE(PG8_SB(1, 1), b3 + hstep, voffB); PG8_STAGE(PG8_SA(1, 0), a3, voffA);
            PG8_WAIT_V(8); PG8_WAIT_L(0); PG8_BAR; PG8_MMA(1, 0, At, B0); PG8_MMA(1, 1, At, B1); PG8_BAR; PG8_SCHED;
            } else {
            PG8_LDB(B0, 0, 0); PG8_SCHED; PG8_LDA(At, 0, 0); PG8_STAGE(PG8_SA(1, 1), a1 + hstep, voffA);
            PG8_WAIT_L(8); PG8_BAR; PG8_WAIT_L(0); PG8_MMA(0, 0, At, B0); PG8_BAR; PG8_SCHED;
            PG8_LDB(B1, 0, 1); PG8_STAGE(PG8_SB(0, 0), b2, voffB);
            PG8_BAR; PG8_WAIT_L(0); PG8_MMA(0, 1, At, B1); PG8_BAR;
            PG8_LDA(At, 0, 1); PG8_STAGE(PG8_SA(0, 0), a2, voffA);
            PG8_BAR; PG8_WAIT_L(0); PG8_MMA(1, 0, At, B0); PG8_BAR; PG8_SCHED;
            PG8_STAGE(PG8_SB(0, 1), b2 + hstep, voffB);
            PG8_WAIT_V(6); PG8_BAR; PG8_MMA(1, 1, At, B1); PG8_BAR;
            PG8_LDB(B0, 1, 0); PG8_SCHED; PG8_LDA(At, 1, 0); PG8_STAGE(PG8_SA(0, 1), a2 + hstep, voffA);
            PG8_WAIT_L(8); PG8_BAR; PG8_WAIT_L(0); PG8_MMA(0, 0, At, B0); PG8_BAR; PG8_SCHED;
            PG8_LDB(B1, 1, 1); PG8_STAGE(PG8_SB(1, 0), b3, voffB);
            PG8_BAR; PG8_WAIT_L(0); PG8_MMA(0, 1, At, B1); PG8_BAR;
            PG8_LDA(At, 1, 1); PG8_STAGE(PG8_SA(1, 0), a3, voffA);
            PG8_BAR; PG8_WAIT_L(0); PG8_MMA(1, 0, At, B0); PG8_BAR; PG8_SCHED;
            PG8_STAGE(PG8_SB(1, 1), b3 + hstep, voffB);
            PG8_WAIT_V(6); PG8_BAR; PG8_MMA(1, 1, At, B1); PG8_BAR;
            }
        }
        if constexpr (ALIGN_EPI) { if (wr == 0) PG8_BAR; }
        if constexpr (!Epi::AFTER_DRAIN) { E(acc, cur, wr, wc, fr, fq); S.done(cur); }
        if (!has_next) break;
#pragma unroll
        for (int a = 0; a < 2; ++a)
#pragma unroll
            for (int b = 0; b < 2; ++b)
#pragma unroll
                for (int m = 0; m < 4; ++m)
#pragma unroll
                    for (int n = 0; n < 2; ++n) acc[a][b][m][n] = (f32x4){0.f, 0.f, 0.f, 0.f};
        cur = nxt; cA = nA; cB = nB; ++ui;
        if constexpr (ALIGN_EPI) { if (wr == 1) PG8_BAR; }
    }
    PG8_WAIT_V(0);
    if constexpr (!ALIGN_EPI) { if (wr == 0) PG8_BAR; }
    PG8_BAR;
    if constexpr (Epi::AFTER_DRAIN) { E.fused(acc, cur, wr, wc, fr, fq, lds, wid, lane); S.done(cur); }
#undef PG8_SA
#undef PG8_SB
#undef PG8_STAGE
#undef PG8_LDA
#undef PG8_LDB
#undef PG8_MMA
#undef PG8_WAIT_V
#undef PG8_WAIT_L
#undef PG8_BAR
#undef PG8_SCHED
}
}
constexpr int DM = 1024, SEQ = 2048, NB = 32, DECL = 64, DFF = 2816, INW = 2816;
constexpr int MP = NB * SEQ, MS = NB * DECL, MT = MP + MS;
constexpr int NGRP = MT / 64;
constexpr int NTM = MT / 256;
constexpr float EPS = 1e-6f;
constexpr size_t OFF_Y = 0;
constexpr size_t OFF_PRET = (size_t)MT * DM;
constexpr size_t OFF_PK = OFF_PRET + (size_t)NB * 4 * 128 * 128;
constexpr size_t OFF_PV = OFF_PK + (size_t)NB * 128 * 128;
constexpr size_t OFF_PCONV = OFF_PV + (size_t)NB * 128 * 128;
constexpr size_t OFF_SRET = OFF_PCONV + (size_t)NB * 2 * DFF;
constexpr size_t OFF_SK = OFF_SRET + (size_t)NB * 4 * 128 * 128;
constexpr size_t OFF_SV = OFF_SK + (size_t)NB * 64 * 128;
constexpr size_t OFF_SCONV = OFF_SV + (size_t)NB * 64 * 128;
constexpr size_t OUT_TOTAL = OFF_SCONV + (size_t)NB * 2 * DFF;
constexpr size_t MiB = 1u << 20;
constexpr size_t WS_WIN = 0;
constexpr size_t WS_WUP = WS_WIN + (size_t)INW * DM * 2;
constexpr size_t WS_WOUT = WS_WUP + (size_t)2 * DFF * DM * 2;
constexpr size_t WS_WDN = WS_WOUT + (size_t)DM * DM * 2;
constexpr size_t WS_MODP = 48 * MiB + 133 * MiB + 363 * MiB + 200 * MiB;
constexpr size_t WS_MOD = 32 * MiB;
constexpr size_t WS_SHW = 34 * MiB;
constexpr size_t WS_SS1 = 36 * MiB;
constexpr size_t WS_SS2 = 41 * MiB;
constexpr size_t WS_R0 = 48 * MiB;
constexpr size_t WS_R1 = WS_R0 + 133 * MiB;
constexpr size_t WS_R2 = WS_R1 + 363 * MiB;
constexpr size_t HT_STRIDE = (size_t)NGRP * 2 * DFF;
constexpr size_t WS_END = WS_R2 + 363 * MiB;
constexpr size_t WS_SLAB = WS_R1 + 264 * MiB;
constexpr size_t WS_SLAB4 = WS_R1 + 300 * MiB;
constexpr size_t WS_X1B = WS_R1 + 128 * MiB;
static_assert(3 * HT_STRIDE * 4 <= 128 * MiB && WS_X1B + (size_t)MT * DM * 2 <= WS_R2, "ws map");
static_assert(WS_WDN + (size_t)DM * DFF * 2 <= WS_MODP, "ws map");
static_assert((size_t)(MT + 256) * DM * 2 <= 133 * MiB && (size_t)MT * DFF * 2 <= 363 * MiB, "ws map");

constexpr size_t WS_BAR = 46 * MiB;
constexpr size_t WS_TICKET = 46 * MiB + 32768;
constexpr size_t WS_CNT7 = 46 * MiB + 65536;
constexpr int LDS_MISC = 155648;
constexpr int LDS_BYTES = 155648 + 64;

#define LAS __attribute__((address_space(3)))
typedef unsigned short bf16;
typedef float f32x4 __attribute__((ext_vector_type(4)));
typedef float f32x2 __attribute__((ext_vector_type(2)));
typedef short bf16x8 __attribute__((ext_vector_type(8)));
typedef unsigned u32x4 __attribute__((ext_vector_type(4)));
typedef unsigned u32x2 __attribute__((ext_vector_type(2)));
typedef __bf16 bf16x2_t __attribute__((ext_vector_type(2)));
#define LDS_WAIT() asm volatile("s_waitcnt lgkmcnt(0)" ::: "memory")

__device__ __forceinline__ unsigned pk2(float lo, float hi) { f32x2 v = {lo, hi}; bf16x2_t b = __builtin_convertvector(v, bf16x2_t); return __builtin_bit_cast(unsigned, b); }
__device__ __forceinline__ float bflo(unsigned w) { return __uint_as_float(w << 16); }
__device__ __forceinline__ float bfhi(unsigned w) { return __uint_as_float(w & 0xffff0000u); }
__device__ __forceinline__ float wave_sum(float v) {
#pragma unroll
    for (int o = 1; o < 64; o <<= 1) v += __shfl_xor(v, o);
    return v;
}
__device__ __forceinline__ float wave_sum_dpp(float v) {
    v += __int_as_float(__builtin_amdgcn_update_dpp(__float_as_int(v), __float_as_int(v), 0x128, 0xf, 0xf, false));
    v += __int_as_float(__builtin_amdgcn_update_dpp(__float_as_int(v), __float_as_int(v), 0x124, 0xf, 0xf, false));
    v += __int_as_float(__builtin_amdgcn_update_dpp(__float_as_int(v), __float_as_int(v), 0x122, 0xf, 0xf, false));
    v += __int_as_float(__builtin_amdgcn_update_dpp(__float_as_int(v), __float_as_int(v), 0x121, 0xf, 0xf, false));
    const int i = __float_as_int(v);
    return (__int_as_float(__builtin_amdgcn_readlane(i, 0)) + __int_as_float(__builtin_amdgcn_readlane(i, 16))) + (__int_as_float(__builtin_amdgcn_readlane(i, 32)) + __int_as_float(__builtin_amdgcn_readlane(i, 48)));
}
__device__ __forceinline__ float silu_f(float x) { return x * __builtin_amdgcn_rcpf(1.0f + __builtin_amdgcn_exp2f(-1.4426950408889634f * x)); }
__device__ __forceinline__ void unpack8(const u32x4 w, float (&f)[8]) { f[0] = bflo(w.x); f[1] = bfhi(w.x); f[2] = bflo(w.y); f[3] = bfhi(w.y); f[4] = bflo(w.z); f[5] = bfhi(w.z); f[6] = bflo(w.w); f[7] = bfhi(w.w); }
__device__ __forceinline__ int grp_bs(int g) { return g < 1024 ? (g >> 5) : 32 + (g - 1024); }

struct Params {
    const float *x_p, *x_s, *cache_k, *cache_v, *state_ret, *state_conv, *c_p, *c_s, *ln1, *ln2, *w_ada, *b_ada, *w_in, *w_out, *sinks, *w_up, *conv_w, *conv_b, *w_down, *normf, *w_ada_f, *b_ada_f;
    float* out; unsigned char* ws;
};

__device__ __forceinline__ void transpose_item(const float* W, int K, int N, bf16* WT, int dst_row0, int k0, int n0, LAS float* scr, int lane) {
    { f32x4 t[8];
#pragma unroll
      for (int i = 0; i < 8; ++i) t[i] = *(const f32x4*)(W + (size_t)(k0 + 8 * i + (lane >> 3)) * N + n0 + 4 * (lane & 7));
#pragma unroll
      for (int i = 0; i < 8; ++i) { LAS float* d = scr + (8 * i + (lane >> 3)) * 33 + 4 * (lane & 7); d[0] = t[i].x; d[1] = t[i].y; d[2] = t[i].z; d[3] = t[i].w; } }
    LDS_WAIT(); asm volatile("" ::: "memory");
    const int c = lane & 7;
#pragma unroll
    for (int j = 0; j < 4; ++j) { const int n = (lane >> 3) + 8 * j; const LAS float* s = scr + (8 * c) * 33 + n;
        u32x4 o; o.x = pk2(s[0 * 33], s[1 * 33]); o.y = pk2(s[2 * 33], s[3 * 33]); o.z = pk2(s[4 * 33], s[5 * 33]); o.w = pk2(s[6 * 33], s[7 * 33]);
        *(u32x4*)(WT + (size_t)(dst_row0 + n) * K + k0 + 8 * c) = o; }
    LDS_WAIT(); asm volatile("" ::: "memory");
}
constexpr int MOD_KS = 8, MOD_KC = 1024 / MOD_KS / 32;
__device__ __forceinline__ void mod_item(const Params& P, int it, LAS float* scr, int lane) {
    const int ct = it / MOD_KS, ks = it % MOD_KS, c0 = ct * 64;
    const float* W; const float* bias; int ldw;
    if (c0 < 6144) { W = P.w_ada + c0; bias = P.b_ada + c0; ldw = 6144; } else { W = P.w_ada_f + (c0 - 6144); bias = P.b_ada_f + (c0 - 6144); ldw = 2048; }
    float acc[64];
#pragma unroll
    for (int r = 0; r < 64; ++r) acc[r] = 0.f;
    const float* crow = (lane < 32 ? P.c_p + (size_t)lane * DM : P.c_s + (size_t)(lane - 32) * DM) + ks * (1024 / MOD_KS);
    const float* wk0 = W + (size_t)(ks * (1024 / MOD_KS)) * ldw + lane;
    f32x4 cv[8], cn[8];
#pragma unroll
    for (int q = 0; q < 8; ++q) cv[q] = *(const f32x4*)(crow + 4 * q);
    constexpr int NK4 = (1024 / MOD_KS) / 4;
    float w0 = wk0[0], w1 = wk0[(size_t)ldw], w2 = wk0[(size_t)2 * ldw], w3 = wk0[(size_t)3 * ldw];
    for (int kc = 0; kc < MOD_KC; ++kc) {
#pragma unroll
        for (int q = 0; q < 8; ++q) { f32x4 v = cv[q]; v.x = silu_f(v.x); v.y = silu_f(v.y); v.z = silu_f(v.z); v.w = silu_f(v.w); *(LAS f32x4*)(scr + lane * 36 + 4 * q) = v; }
        LDS_WAIT(); asm volatile("" ::: "memory");
        { const int kn = kc + 1 < MOD_KC ? kc + 1 : kc;
#pragma unroll
          for (int q = 0; q < 8; ++q) cn[q] = *(const f32x4*)(crow + kn * 32 + 4 * q); }
        for (int k4 = 0; k4 < 8; ++k4) {
            const int gk = kc * 8 + k4, gn = gk + 1 < NK4 ? gk + 1 : gk;
            const float* wn = wk0 + (size_t)(4 * gn) * ldw;
            const float n0 = wn[0], n1 = wn[(size_t)ldw], n2 = wn[(size_t)2 * ldw], n3 = wn[(size_t)3 * ldw];
#pragma unroll
            for (int r = 0; r < 64; ++r) { const f32x4 sv = *(const LAS f32x4*)(scr + r * 36 + 4 * k4);
                acc[r] = fmaf(sv.x, w0, acc[r]); acc[r] = fmaf(sv.y, w1, acc[r]); acc[r] = fmaf(sv.z, w2, acc[r]); acc[r] = fmaf(sv.w, w3, acc[r]); }
            w0 = n0; w1 = n1; w2 = n2; w3 = n3;
        }
        LDS_WAIT(); asm volatile("" ::: "memory");
#pragma unroll
        for (int q = 0; q < 8; ++q) cv[q] = cn[q];
    }
    float* dst = (float*)(P.ws + WS_MODP) + (size_t)ks * 64 * 8192 + c0 + lane;
    const float bv = (ks == 0) ? bias[lane] : 0.f;
#pragma unroll
    for (int r = 0; r < 64; ++r) dst[(size_t)r * 8192] = acc[r] + bv;
}
__device__ __forceinline__ void phase0(const Params& P, LAS unsigned char* lds, int wave, int lane) {
    LAS float* scr = (LAS float*)(lds + wave * 16384);
    const int gw = wave * gridDim.x + blockIdx.x, NGW = gridDim.x * 8;
    constexpr int I_MOD = 128 * MOD_KS, I_IN = 16 * 88, I_UP = 16 * 176, I_OUT = 16 * 32, I_DN = 44 * 32;
    constexpr int NIT = I_MOD + I_IN + I_UP + I_OUT + I_DN;
    for (int it = gw; it < NIT; it += NGW) {
        int r = it;
        if (r < I_MOD) { mod_item(P, r, scr, lane); continue; } r -= I_MOD;
        if (r < I_IN) { const int kb = r / 88, nb = r % 88; transpose_item(P.w_in, DM, INW, (bf16*)(P.ws + WS_WIN), nb * 32, kb * 64, nb * 32, scr, lane); continue; } r -= I_IN;
        if (r < I_UP) { const int kb = r / 176, nb = r % 176, n0 = nb * 32, isb = n0 >= DFF, j0 = n0 - isb * DFF;
            transpose_item(P.w_up, DM, 2 * DFF, (bf16*)(P.ws + WS_WUP), 256 * (j0 >> 7) + 128 * isb + (j0 & 127), kb * 64, n0, scr, lane); continue; } r -= I_UP;
        if (r < I_OUT) { const int kb = r / 32, nb = r % 32; transpose_item(P.w_out, DM, DM, (bf16*)(P.ws + WS_WOUT), nb * 32, kb * 64, nb * 32, scr, lane); continue; } r -= I_OUT;
        { const int kb = r / 32, nb = r % 32; transpose_item(P.w_down, DFF, DM, (bf16*)(P.ws + WS_WDN), nb * 32, kb * 64, nb * 32, scr, lane); }
    }
}

__device__ __forceinline__ void phase1(const Params& P, LAS unsigned char* lds, int tid, int wave, int lane) {
    const float* modp = (const float*)(P.ws + WS_MODP);
    float* mod = (float*)(P.ws + WS_MOD);
    bf16* H1 = (bf16*)(P.ws + WS_R0);
    for (int idx = blockIdx.x * 512 + tid; idx < 64 * 8192; idx += gridDim.x * 512) {
        float s = 0.f;
#pragma unroll
        for (int p_ = 0; p_ < MOD_KS; ++p_) s += modp[idx + (size_t)p_ * 524288];
        mod[idx] = s;
        const int col = idx & 8191, bs = idx >> 13;
        if (col >= 3072 && col < 4096) H1[(size_t)(MT + bs) * DM + (col - 3072)] = (bf16)(pk2(s, 0.f) & 0xffffu);
    }
    LAS float* lv = (LAS float*)lds;
    const int rpb = (MT + (int)gridDim.x - 1) / (int)gridDim.x, rbeg = (int)blockIdx.x * rpb, rend = (rbeg + rpb < MT) ? rbeg + rpb : MT;
    if (rbeg < rend) {
        const int bs0 = rbeg < MP ? (rbeg >> 11) : 32 + ((rbeg - MP) >> 6), bs1 = (rend - 1) < MP ? ((rend - 1) >> 11) : 32 + ((rend - 1 - MP) >> 6);
        const int nsl = bs1 - bs0 + 1;
        __syncthreads();
        for (int i = tid; i < nsl * 2048; i += 512) { const int sl = i >> 11, which = (i >> 10) & 1, col = i & 1023; const size_t o = (size_t)(bs0 + sl) * 8192 + which * 1024 + col;
            float sv = 0.f;
#pragma unroll
            for (int p_ = 0; p_ < MOD_KS; ++p_) sv += modp[o + (size_t)p_ * 524288];
            if (which) sv = P.ln1[col] * (1.f + sv);
            lv[i] = sv; }
        __syncthreads();
#pragma unroll 4
        for (int row = rbeg + wave; row < rend; row += 8) {
            const int bs = row < MP ? (row >> 11) : 32 + ((row - MP) >> 6);
            const LAS float* lvs = lv + (bs - bs0) * 2048;
            const float* xr = (row < MP ? P.x_p + (size_t)row * DM : P.x_s + (size_t)(row - MP) * DM) + 4 * lane;
            f32x4 v[4]; float ss = 0.f;
#pragma unroll
            for (int j = 0; j < 4; ++j) { v[j] = *(const f32x4*)(xr + 256 * j); ss += (v[j].x * v[j].x + v[j].y * v[j].y) + (v[j].z * v[j].z + v[j].w * v[j].w); }
            const float rstd = __builtin_amdgcn_rsqf(wave_sum_dpp(ss) * (1.f / DM) + EPS);
            bf16* hr = H1 + (size_t)row * DM + 4 * lane;
#pragma unroll
            for (int j = 0; j < 4; ++j) { const f32x4 sh = *(const LAS f32x4*)(lvs + 256 * j + 4 * lane), gs = *(const LAS f32x4*)(lvs + 1024 + 256 * j + 4 * lane);
                const f32x4 h = v[j] * rstd * gs + sh; u32x2 w; w.x = pk2(h.x, h.y); w.y = pk2(h.z, h.w); *(u32x2*)(hr + 256 * j) = w; }
        }
    }
}

struct OrderX {
    pg8::StaticOrder S; int nX, xpm, xpn0;
    __device__ __forceinline__ bool next(int i, pg8::Unit& u) const {
        const long L = (long)i * S.G + S.c;
        int pm = 0, pn = 0; bool ok = false;
        if (L < S.nwg) { pg8::Unit t; t.pm = 0; t.pn = 0; t.seq = 0; t.kt0 = 0; t.nt = 0; (void)S.next(i, t); pm = t.pm; pn = t.pn; ok = true; }
        else if (L < S.nwg + nX) { pm = xpm; pn = xpn0 + (int)(L - S.nwg); ok = true; }
        u.pm = pm; u.pn = pn; u.seq = i; u.kt0 = 0; u.nt = 0;
        return ok;
    }
    __device__ __forceinline__ void a_ready(const pg8::Unit&) const {}
    __device__ __forceinline__ void done(const pg8::Unit&) const {}
};
struct OrderPub : pg8::StaticOrder {
    unsigned* cnt;
    __device__ __forceinline__ void done(const pg8::Unit& u) const {
        asm volatile("s_waitcnt vmcnt(0)" ::: "memory");
        if ((threadIdx.x & 63) == 0) __hip_atomic_fetch_add(cnt + 64 * u.pm, 1u, __ATOMIC_RELAXED, __HIP_MEMORY_SCOPE_AGENT);
    }
};
struct OrderDown {
    pg8::StaticOrder S;
    int ka, kb;
    __device__ __forceinline__ bool next(int i, pg8::Unit& u) const {
        const long L = (long)i * S.G + S.c;
        int pm = 0, pn = 0, kt0 = 0, nt = 0; bool ok = false;
        if (L < S.nwg) { pg8::Unit t; t.pm = 0; t.pn = 0; t.seq = 0; t.kt0 = 0; t.nt = 0; (void)S.next(i, t); pm = t.pm; pn = t.pn; ok = true; }
        else if (L < S.nwg + 128) { const int q = (int)(L - S.nwg), tu = q >> 2, part = q & 3; pm = (MP / 256) + (tu & 7); pn = tu >> 3; kt0 = part < 2 ? ka * part : 2 * ka + kb * (part - 2); nt = part < 2 ? ka : kb; ok = true; }
        u.pm = pm; u.pn = pn; u.seq = i; u.kt0 = kt0; u.nt = nt;
        return ok;
    }
    __device__ __forceinline__ void a_ready(const pg8::Unit&) const {}
    __device__ __forceinline__ void done(const pg8::Unit&) const {}
};
typedef const f32x4 (&AccRef)[2][2][4][2];
struct Epi1 {
    static constexpr bool PERM = true, AFTER_DRAIN = false;
    bf16* proj; float* shw; float* out;
    __device__ __forceinline__ void operator()(AccRef acc, const pg8::Unit& u, int wr, int wc, int fr, int fq) const {
        if (u.pm == NTM) {
            if (wr == 0) {
#pragma unroll
                for (int m = 0; m < 4; ++m) { float* d = shw + (size_t)(16 * m + fr) * (2 * DFF) + 256 * (u.pn - 11) + 32 * wc + 8 * fq;
#pragma unroll
                    for (int bj = 0; bj < 2; ++bj)
#pragma unroll
                        for (int n = 0; n < 2; ++n) *(f32x4*)(d + 128 * bj + 4 * n) = acc[0][bj][m][n]; }
            }
            return;
        }
        const unsigned row0 = u.pm * 256 + wr * 64 + fr, col0 = u.pn * 256 + wc * 32 + 8 * fq;
#pragma unroll
        for (int ai = 0; ai < 2; ++ai)
#pragma unroll
            for (int m = 0; m < 4; ++m) { const unsigned o = (row0 + 128 * ai + 16 * m) * (unsigned)INW + col0;
#pragma unroll
                for (int bj = 0; bj < 2; ++bj) { const f32x4 v0 = acc[ai][bj][m][0], v1 = acc[ai][bj][m][1];
                    u32x4 w; w.x = pk2(v0[0], v0[1]); w.y = pk2(v0[2], v0[3]); w.z = pk2(v1[0], v1[1]); w.w = pk2(v1[2], v1[3]);
                    *(u32x4*)(proj + (o + 128 * bj)) = w; }
                asm volatile("" ::: "memory"); }
        if (u.pn == 10) {
            const unsigned c = 32 * wc + 8 * fq;
#pragma unroll
            for (int ai = 0; ai < 2; ++ai)
#pragma unroll
                for (int m = 0; m < 4; ++m) { const unsigned row = row0 + 128 * ai + 16 * m; unsigned ok, ov;
                    if (row < (unsigned)MP) { const unsigned t = row & 2047; if (t < SEQ - 128) continue; const unsigned o = ((row >> 11) * 128 + (t - (SEQ - 128))) * 128 + c; ok = (unsigned)OFF_PK + o; ov = (unsigned)OFF_PV + o; }
                    else { const unsigned o = (row - MP) * 128 + c; ok = (unsigned)OFF_SK + o; ov = (unsigned)OFF_SV + o; }
                    *(f32x4*)(out + ok) = acc[ai][0][m][0]; *(f32x4*)(out + ok + 4) = acc[ai][0][m][1];
                    *(f32x4*)(out + ov) = acc[ai][1][m][0]; *(f32x4*)(out + ov + 4) = acc[ai][1][m][1];
                    asm volatile("" ::: "memory"); }
        }
    }
};
struct Epi2 {
    static constexpr bool PERM = true, AFTER_DRAIN = false;
    const float *xp, *xs, *mod, *ln2; bf16* x1; bf16* a2; float* ss; float* slab;
    __device__ __forceinline__ void operator()(AccRef acc, const pg8::Unit& u, int wr, int wc, int fr, int fq) const {
        const int col0 = u.pn * 256 + wc * 32 + 8 * fq;
        if (u.nt != 0) {
            float* sb = slab + (size_t)(u.kt0 >> 2) * MS * DM;
#pragma unroll
            for (int ai = 0; ai < 2; ++ai)
#pragma unroll
                for (int m = 0; m < 4; ++m) { const unsigned ro = (unsigned)(u.pm * 256 - MP + 128 * ai + 64 * wr + 16 * m + fr) * DM + col0;
#pragma unroll
                    for (int bj = 0; bj < 2; ++bj) { *(f32x4*)(sb + ro + 128 * bj) = acc[ai][bj][m][0]; *(f32x4*)(sb + ro + 128 * bj + 4) = acc[ai][bj][m][1]; } }
            return;
        }
#pragma unroll
        for (int ai = 0; ai < 2; ++ai) {
            const int bs = grp_bs(4 * u.pm + 2 * ai + wr);
            const float* mb = mod + (size_t)bs * 8192;
            f32x4 g1v[2][2], gsv[2][2];
#pragma unroll
            for (int bj = 0; bj < 2; ++bj)
#pragma unroll
                for (int n = 0; n < 2; ++n) { const int c = col0 + 128 * bj + 4 * n; g1v[bj][n] = *(const f32x4*)(mb + 2048 + c);
                    gsv[bj][n] = *(const f32x4*)(ln2 + c) * (*(const f32x4*)(mb + 4096 + c) + 1.0f); }
#pragma unroll
            for (int m = 0; m < 4; ++m) {
                const int row = u.pm * 256 + 128 * ai + 64 * wr + 16 * m + fr;
                const float* xr = row < MP ? xp + (size_t)row * DM : xs + (size_t)(row - MP) * DM;
                float s = 0.f;
#pragma unroll
                for (int bj = 0; bj < 2; ++bj) { f32x4 a[2]; f32x4 xb[2];
#pragma unroll
                    for (int n = 0; n < 2; ++n) { const int c = col0 + 128 * bj + 4 * n; const f32x4 xv = *(const f32x4*)(xr + c); const f32x4 v = xv + g1v[bj][n] * acc[ai][bj][m][n];
                        xb[n] = v; s += (v.x * v.x + v.y * v.y) + (v.z * v.z + v.w * v.w); a[n] = v * gsv[bj][n]; }
                    u32x4 w; w.x = pk2(a[0].x, a[0].y); w.y = pk2(a[0].z, a[0].w); w.z = pk2(a[1].x, a[1].y); w.w = pk2(a[1].z, a[1].w);
                    *(u32x4*)(a2 + (size_t)row * DM + col0 + 128 * bj) = w;
                    w.x = pk2(xb[0].x, xb[0].y); w.y = pk2(xb[0].z, xb[0].w); w.z = pk2(xb[1].x, xb[1].y); w.w = pk2(xb[1].z, xb[1].w);
                    *(u32x4*)(x1 + (size_t)row * DM + col0 + 128 * bj) = w; }
                s += __shfl_xor(s, 16); s += __shfl_xor(s, 32);
                if (fq == 0) ss[(size_t)row * 16 + 4 * u.pn + wc] = s;
            }
        }
    }
};
struct Epi3 {
    static constexpr bool PERM = true, AFTER_DRAIN = false;
    const LAS float* rtab; const float* shw; bf16 *ua, *ub; float* out;
    __device__ __forceinline__ void operator()(AccRef acc, const pg8::Unit& u, int wr, int wc, int fr, int fq) const {
        const unsigned j0 = u.pn * 128 + wc * 32 + 8 * fq, pc0 = u.pn * 256 + wc * 32 + 8 * fq;
#pragma unroll
        for (int ai = 0; ai < 2; ++ai) {
            const unsigned grp = 4 * u.pm + 2 * ai + wr, bs = grp_bs((int)grp);
            const unsigned so = bs * (2 * DFF) + pc0;
            const f32x4 sa0 = *(const f32x4*)(shw + so), sa1 = *(const f32x4*)(shw + so + 4), sb0 = *(const f32x4*)(shw + so + 128), sb1 = *(const f32x4*)(shw + so + 132);
#pragma unroll
            for (int m = 0; m < 4; ++m) {
                const float rstd = rtab[u.seq * 256 + 128 * ai + 64 * wr + 16 * m + fr];
                const unsigned row = grp * 64 + 16 * m + fr;
                const f32x4 a0 = acc[ai][0][m][0] * rstd + sa0, a1 = acc[ai][0][m][1] * rstd + sa1, b0 = acc[ai][1][m][0] * rstd + sb0, b1 = acc[ai][1][m][1] * rstd + sb1;
                u32x4 w; w.x = pk2(a0[0], a0[1]); w.y = pk2(a0[2], a0[3]); w.z = pk2(a1[0], a1[1]); w.w = pk2(a1[2], a1[3]);
                *(u32x4*)(ua + (row * (unsigned)DFF + j0)) = w;
                w.x = pk2(b0[0], b0[1]); w.y = pk2(b0[2], b0[3]); w.z = pk2(b1[0], b1[1]); w.w = pk2(b1[2], b1[3]);
                *(u32x4*)(ub + (row * (unsigned)DFF + j0)) = w;
                if (m == 3 && fr >= 14) {
                    if (grp >= 1024) { float* d = out + OFF_SCONV + ((size_t)(grp - 1024) * 2 + (fr - 14)) * DFF + j0; *(f32x4*)d = a0; *(f32x4*)(d + 4) = a1; }
                    else if ((grp & 31) == 31) { float* d = out + OFF_PCONV + ((size_t)(grp >> 5) * 2 + (fr - 14)) * DFF + j0; *(f32x4*)d = a0; *(f32x4*)(d + 4) = a1; }
                }
            }
        }
    }
};
#ifdef CONV_FUSED
struct Epi3C {
    static constexpr bool PERM = true, AFTER_DRAIN = false;
    const LAS float* rtab; const float *shw, *cw, *cb; bf16* act; float *headA, *headB, *tailA;
    __device__ __forceinline__ void operator()(AccRef acc, const pg8::Unit& u, int wr, int wc, int fr, int fq) const {
        const unsigned j0 = u.pn * 128 + wc * 32 + 8 * fq, pc0 = u.pn * 256 + wc * 32 + 8 * fq;
        f32x4 w0[2], w1[2], w2[2], cbv[2];
#pragma unroll
        for (int n = 0; n < 2; ++n) { w0[n] = *(const f32x4*)(cw + j0 + 4 * n); w1[n] = *(const f32x4*)(cw + DFF + j0 + 4 * n); w2[n] = *(const f32x4*)(cw + 2 * DFF + j0 + 4 * n); cbv[n] = *(const f32x4*)(cb + j0 + 4 * n); }
#pragma unroll
        for (int ai = 0; ai < 2; ++ai) {
            asm volatile("" ::: "memory");
            const unsigned grp = 4 * u.pm + 2 * ai + wr, bs = grp_bs((int)grp);
            const unsigned so = bs * (2 * DFF) + pc0, ho = (grp * 2 + (fr & 1)) * DFF + j0;
            u32x2 ap[4][2], bp[4][2];
            {
                f32x4 sa[2], sb[2];
#pragma unroll
                for (int n = 0; n < 2; ++n) { sa[n] = *(const f32x4*)(shw + so + 4 * n); sb[n] = *(const f32x4*)(shw + so + 128 + 4 * n); }
#pragma unroll
                for (int m = 0; m < 4; ++m) {
                    const float rs = rtab[u.seq * 256 + 128 * ai + 64 * wr + 16 * m + fr];
#pragma unroll
                    for (int n = 0; n < 2; ++n) {
                        const f32x4 av = acc[ai][0][m][n] * rs + sa[n], bv = acc[ai][1][m][n] * rs + sb[n];
                        if (m == 0) { if (fr < 2) { *(f32x4*)(headA + ho + 4 * n) = av; *(f32x4*)(headB + ho + 4 * n) = bv; } }
                        if (m == 3) { if (fr >= 14) *(f32x4*)(tailA + ho + 4 * n) = av; }
                        ap[m][n].x = pk2(av.x, av.y); ap[m][n].y = pk2(av.z, av.w); bp[m][n].x = pk2(bv.x, bv.y); bp[m][n].y = pk2(bv.z, bv.w);
                    }
                }
            }
            asm volatile("" ::: "memory");
#pragma unroll
            for (int n = 0; n < 2; ++n)
#pragma unroll
                for (int h = 0; h < 2; ++h) {
                    unsigned q1 = 0u, q2 = 0u;
#pragma unroll
                    for (int m = 0; m < 4; ++m) {
                        const unsigned a = ap[m][n][h];
                        const unsigned s1 = (unsigned)__builtin_amdgcn_update_dpp((int)a, (int)a, 0x121, 0xf, 0xf, false);
                        const unsigned s2 = (unsigned)__builtin_amdgcn_update_dpp((int)a, (int)a, 0x122, 0xf, 0xf, false);
                        const unsigned pr1 = fr >= 1 ? s1 : q1, pr2 = fr >= 2 ? s2 : q2;
                        q1 = s1; q2 = s2;
                        const float c0 = cbv[n][2 * h] + w0[n][2 * h] * bflo(pr2) + w1[n][2 * h] * bflo(pr1) + w2[n][2 * h] * bflo(a);
                        const float c1 = cbv[n][2 * h + 1] + w0[n][2 * h + 1] * bfhi(pr2) + w1[n][2 * h + 1] * bfhi(pr1) + w2[n][2 * h + 1] * bfhi(a);
                        const unsigned bw = bp[m][n][h];
                        bp[m][n][h] = pk2(silu_f(c0) * bflo(bw), silu_f(c1) * bfhi(bw));
                    }
                    __builtin_amdgcn_sched_barrier(0);
                }
            asm volatile("" ::: "memory");
#pragma unroll
            for (int m = 0; m < 4; ++m) {
                if (m == 0 && fr < 2) continue;
                const unsigned row = grp * 64 + 16 * m + fr;
                const u32x4 w = (u32x4){bp[m][0].x, bp[m][0].y, bp[m][1].x, bp[m][1].y};
                *(u32x4*)(act + (row * (unsigned)DFF + j0)) = w;
            }
        }
    }
};
#endif
struct Epi4 {
    static constexpr bool PERM = true, AFTER_DRAIN = false;
    const float* mod; const bf16* x1; bf16* x2; float* slab;
    __device__ __forceinline__ void operator()(AccRef acc, const pg8::Unit& u, int wr, int wc, int fr, int fq) const {
        const int col0 = u.pn * 256 + wc * 32 + 8 * fq;
        if (u.nt != 0) {
            const int part = u.kt0 == 0 ? 0 : (u.kt0 == 12 ? 1 : (u.kt0 == 24 ? 2 : 3));
            float* sb = slab + (size_t)part * MS * DM;
#pragma unroll
            for (int ai = 0; ai < 2; ++ai)
#pragma unroll
                for (int m = 0; m < 4; ++m) { const unsigned ro = (unsigned)(u.pm * 256 - MP + 128 * ai + 64 * wr + 16 * m + fr) * DM + col0;
#pragma unroll
                    for (int bj = 0; bj < 2; ++bj) { *(f32x4*)(sb + ro + 128 * bj) = acc[ai][bj][m][0]; *(f32x4*)(sb + ro + 128 * bj + 4) = acc[ai][bj][m][1]; } }
            return;
        }
#pragma unroll
        for (int ai = 0; ai < 2; ++ai) {
            const int bs = grp_bs(4 * u.pm + 2 * ai + wr);
            const float* mb = mod + (size_t)bs * 8192 + 5120;
            f32x4 g2v[2][2];
#pragma unroll
            for (int bj = 0; bj < 2; ++bj)
#pragma unroll
                for (int n = 0; n < 2; ++n) g2v[bj][n] = *(const f32x4*)(mb + col0 + 128 * bj + 4 * n);
#pragma unroll
            for (int m = 0; m < 4; ++m) {
                const unsigned ro = (unsigned)(u.pm * 256 + 128 * ai + 64 * wr + 16 * m + fr) * DM + col0;
#pragma unroll
                for (int bj = 0; bj < 2; ++bj) { const u32x4 xw = *(const u32x4*)(x1 + ro + 128 * bj);
                    const f32x4 v0 = (f32x4){bflo(xw.x), bfhi(xw.x), bflo(xw.y), bfhi(xw.y)} + g2v[bj][0] * acc[ai][bj][m][0];
                    const f32x4 v1 = (f32x4){bflo(xw.z), bfhi(xw.z), bflo(xw.w), bfhi(xw.w)} + g2v[bj][1] * acc[ai][bj][m][1];
                    u32x4 w; w.x = pk2(v0.x, v0.y); w.y = pk2(v0.z, v0.w); w.z = pk2(v1.x, v1.y); w.w = pk2(v1.z, v1.w);
                    *(u32x4*)(x2 + ro + 128 * bj) = w; }
            }
        }
    }
};
#define GAS __attribute__((address_space(1)))
#define RLX_AGENT __ATOMIC_RELAXED, __HIP_MEMORY_SCOPE_AGENT
#define XB_TMO      128
#define XB_XCNT(j)  (256  + 64 * (j))
#define XB_XSUB(j)  (1280 + 64 * (j))
#define XB_XGEN(j)  (2304 + 64 * (j))
#define XB_TOP      3328
#define XB_TOPGEN   3392
#define XCD_BAR_WORDS 3456
#define XB_SPIN_CAP (1u << 18)

__device__ __forceinline__ unsigned xb_ld(unsigned* p)              { return __hip_atomic_load(p, __ATOMIC_RELAXED, __HIP_MEMORY_SCOPE_AGENT); }
__device__ __forceinline__ unsigned xb_add(unsigned* p, unsigned v) { return __hip_atomic_fetch_add(p, v, __ATOMIC_RELAXED, __HIP_MEMORY_SCOPE_AGENT); }
__device__ __forceinline__ unsigned xb_xcc_id() { return (unsigned)__builtin_amdgcn_s_getreg((3 << 11) | 20) & 0xFu; }
#define XB_SPIN(cond, bar) do { unsigned _sp = 0; while (cond) { __builtin_amdgcn_s_sleep(1); \
    if ((++_sp & 255u) == 0u) { if (xb_ld(&(bar)[XB_TMO])) break; if (_sp > XB_SPIN_CAP) { atomicAdd(&(bar)[XB_TMO], 1u); break; } } } } while (0)

struct XcdBarrier {
    unsigned* bar; unsigned x;
    volatile LAS unsigned* st;
};

__device__ __forceinline__ XcdBarrier xcd_barrier_post(unsigned* bar, volatile LAS unsigned* st) {
    XcdBarrier b; b.bar = bar; b.x = xb_xcc_id(); b.st = st;
    if (threadIdx.x == 0) (void)xb_add(&bar[XB_XCNT(b.x)], 1u);
    return b;
}
__device__ __forceinline__ void xcd_barrier_complete(unsigned* bar, unsigned x, unsigned& nloc, unsigned& nx) {
    const unsigned G = gridDim.x * gridDim.y * gridDim.z;
    unsigned sum, cnt, mine, sp = 0u;
    for (;;) {
        sum = 0u; cnt = 0u; mine = 0u;
#pragma unroll
        for (unsigned j = 0; j < 16; ++j) { const unsigned c = xb_ld(&bar[XB_XCNT(j)]); sum += c; cnt += (c > 0u) ? 1u : 0u; mine = (j == x) ? c : mine; }
        if (sum == G) break;
        __builtin_amdgcn_s_sleep(1);
        if ((++sp & 255u) == 0u) { if (xb_ld(&bar[XB_TMO])) break; if (sp > XB_SPIN_CAP) { atomicAdd(&bar[XB_TMO], 1u); break; } }
    }
    nloc = mine > 0u ? mine : 1u; nx = cnt > 0u ? cnt : 1u;
}

__device__ __forceinline__ void xcd_barrier(const XcdBarrier& b) {
    asm volatile("s_waitcnt vmcnt(0)" ::: "memory");
    __syncthreads();
    if (threadIdx.x == 0) {
        unsigned* bar = b.bar;
        __builtin_amdgcn_s_waitcnt(0);
        unsigned nloc = b.st[0], nx = b.st[1];
        if (nloc == 0u) { xcd_barrier_complete(bar, b.x, nloc, nx); b.st[0] = nloc; b.st[1] = nx; }
        const unsigned old = xb_add(&bar[XB_XSUB(b.x)], 1u);
        const unsigned gen = old / nloc;
        if (old + 1u == (gen + 1u) * nloc) {
            __builtin_amdgcn_fence(__ATOMIC_RELEASE, "agent");
            asm volatile("s_waitcnt vmcnt(0)" ::: "memory");
            const unsigned og = xb_add(&bar[XB_TOP], 1u);
            const unsigned tg = og / nx;
            if (og + 1u == (tg + 1u) * nx) xb_add(&bar[XB_TOPGEN], 1u);
            else XB_SPIN(xb_ld(&bar[XB_TOPGEN]) == tg, bar);
            __builtin_amdgcn_fence(__ATOMIC_ACQUIRE, "agent");
            xb_add(&bar[XB_XGEN(b.x)], 1u);
            asm volatile("s_waitcnt vmcnt(0)" ::: "memory");
        } else {
            XB_SPIN(xb_ld(&bar[XB_XGEN(b.x)]) == gen, bar);
            __builtin_amdgcn_fence(__ATOMIC_ACQUIRE, "agent");
            asm volatile("s_waitcnt vmcnt(0)" ::: "memory");
        }
    }
    __syncthreads();
}
#define MFMA16(a, b, c) __builtin_amdgcn_mfma_f32_16x16x32_bf16((a), (b), (c), 0, 0, 0)
constexpr int RQ = 0, RK = 17408, RKT = 34816, RVT = 53248, RP = 71680, RST = 80896, RO = 115712;
__device__ __forceinline__ void ret_item(const Params& P, LAS unsigned char* lds, int tid, int wave, int lane, int h, int row0, int nchunks, const float* st_in, bool has_in, float* st_out) {
    const bf16* proj = (const bf16*)(P.ws + WS_R1);
    bf16* mix = (bf16*)(P.ws + WS_R2);
    const int fr = lane & 15, fq = lane >> 4;
    const float lg2 = log2f(1.0f - exp2f(-5.0f - (float)h));
    const float kscale = 0.08838834764831845f;
    LAS bf16* Qs = (LAS bf16*)(lds + RQ); LAS bf16* Ks = (LAS bf16*)(lds + RK); LAS bf16* KT = (LAS bf16*)(lds + RKT); LAS bf16* VT = (LAS bf16*)(lds + RVT);
    LAS bf16* Ps = (LAS bf16*)(lds + RP); LAS bf16* ST = (LAS bf16*)(lds + RST); LAS float* Os = (LAS float*)(lds + RO);
    f32x4 st[8];
#pragma unroll
    for (int et = 0; et < 8; ++et) {
        f32x4 v;
#pragma unroll
        for (int r = 0; r < 4; ++r) v[r] = st_in[(size_t)(16 * wave + 4 * fq + r) * 128 + 16 * et + fr];
        asm volatile("" : "+v"(v));
#pragma unroll
        for (int r = 0; r < 4; ++r) v[r] = has_in ? v[r] : 0.f;
        st[et] = v;
    }
    __syncthreads();
#pragma unroll
    for (int et = 0; et < 8; ++et) { u32x2 w; w.x = pk2(st[et][0], st[et][1]); w.y = pk2(st[et][2], st[et][3]); *(LAS u32x2*)(ST + (16 * et + fr) * 136 + 16 * wave + 4 * fq) = w; }
    const size_t goff = (size_t)lane * INW + h * 128 + wave * 16;
    u32x4 pq[2], pk[2], pv[2];
    { const bf16* g = proj + (size_t)row0 * INW + goff;
      pq[0] = *(const u32x4*)(g); pq[1] = *(const u32x4*)(g + 8); pk[0] = *(const u32x4*)(g + 512); pk[1] = *(const u32x4*)(g + 520); pv[0] = *(const u32x4*)(g + 1024); pv[1] = *(const u32x4*)(g + 1032); }
    u32x4 gv0, gv1, gn0, gn1;
    const size_t ggoff = (size_t)(8 * wave + (lane >> 3)) * INW + 1536 + h * 128 + 16 * (lane & 7);
    gn0 = *(const u32x4*)(proj + (size_t)row0 * INW + ggoff); gn1 = *(const u32x4*)(proj + (size_t)row0 * INW + ggoff + 8);
    const float kf = kscale * exp2f(lg2 * (float)(63 - lane));
    const float g64 = exp2f(lg2 * 64.0f);
    for (int c = 0; c < nchunks; ++c) {
        const int rowc = row0 + 64 * c;
        *(LAS u32x4*)(Qs + lane * 136 + wave * 16) = pq[0]; *(LAS u32x4*)(Qs + lane * 136 + wave * 16 + 8) = pq[1];
        *(LAS u32x4*)(Ks + lane * 136 + wave * 16) = pk[0]; *(LAS u32x4*)(Ks + lane * 136 + wave * 16 + 8) = pk[1];
#pragma unroll
        for (int i = 0; i < 2; ++i)
#pragma unroll
            for (int j = 0; j < 4; ++j) { const unsigned wk = pk[i][j], wv = pv[i][j]; const int d = wave * 16 + i * 8 + j * 2;
                const unsigned kk = pk2(bflo(wk) * kf, bfhi(wk) * kf);
                KT[(d) * 72 + lane] = (bf16)(kk & 0xffffu); KT[(d + 1) * 72 + lane] = (bf16)(kk >> 16);
                VT[(d) * 72 + lane] = (bf16)(wv & 0xffffu); VT[(d + 1) * 72 + lane] = (bf16)(wv >> 16); }
        gv0 = gn0; gv1 = gn1;
        if (c + 1 < nchunks) { const bf16* g = proj + (size_t)(rowc + 64) * INW + goff;
            pq[0] = *(const u32x4*)(g); pq[1] = *(const u32x4*)(g + 8); pk[0] = *(const u32x4*)(g + 512); pk[1] = *(const u32x4*)(g + 520); pv[0] = *(const u32x4*)(g + 1024); pv[1] = *(const u32x4*)(g + 1032);
            gn0 = *(const u32x4*)(proj + (size_t)(rowc + 64) * INW + ggoff); gn1 = *(const u32x4*)(proj + (size_t)(rowc + 64) * INW + ggoff + 8); }
        __syncthreads();
        { const int mi = wave >> 1;
#pragma unroll
          for (int jj = 0; jj < 2; ++jj) { const int lj = 2 * (wave & 1) + jj; f32x4 s = (f32x4){0.f, 0.f, 0.f, 0.f};
#pragma unroll
            for (int ks = 0; ks < 4; ++ks) { const bf16x8 a = *(const LAS bf16x8*)(Ks + (16 * mi + fr) * 136 + 32 * ks + 8 * fq), b = *(const LAS bf16x8*)(Qs + (16 * lj + fr) * 136 + 32 * ks + 8 * fq); s = MFMA16(a, b, s); }
            const int l = 16 * lj + fr; float pvv[4];
#pragma unroll
            for (int r = 0; r < 4; ++r) { const int m = 16 * mi + 4 * fq + r; const int dlt = l - m; pvv[r] = dlt >= 0 ? s[r] * kscale * exp2f(lg2 * (float)dlt) : 0.f; }
            u32x2 w; w.x = pk2(pvv[0], pvv[1]); w.y = pk2(pvv[2], pvv[3]); *(LAS u32x2*)(Ps + l * 72 + 16 * mi + 4 * fq) = w; } }
#pragma unroll
        for (int et = 0; et < 8; ++et) st[et] = st[et] * g64;
#pragma unroll
        for (int ks = 0; ks < 2; ++ks) { const bf16x8 a = *(const LAS bf16x8*)(KT + (16 * wave + fr) * 72 + 32 * ks + 8 * fq);
#pragma unroll
            for (int et = 0; et < 8; ++et) { const bf16x8 b = *(const LAS bf16x8*)(VT + (16 * et + fr) * 72 + 32 * ks + 8 * fq); st[et] = MFMA16(a, b, st[et]); } }
        __syncthreads();
        { f32x4 oi[4], oc[4];
#pragma unroll
          for (int lt = 0; lt < 4; ++lt) { oi[lt] = (f32x4){0.f, 0.f, 0.f, 0.f}; oc[lt] = (f32x4){0.f, 0.f, 0.f, 0.f}; }
#pragma unroll
          for (int ks = 0; ks < 2; ++ks) { const bf16x8 b = *(const LAS bf16x8*)(VT + (16 * wave + fr) * 72 + 32 * ks + 8 * fq);
#pragma unroll
            for (int lt = 0; lt < 4; ++lt) { const bf16x8 a = *(const LAS bf16x8*)(Ps + (16 * lt + fr) * 72 + 32 * ks + 8 * fq); oi[lt] = MFMA16(a, b, oi[lt]); } }
#pragma unroll
          for (int ks = 0; ks < 4; ++ks) { const bf16x8 b = *(const LAS bf16x8*)(ST + (16 * wave + fr) * 136 + 32 * ks + 8 * fq);
#pragma unroll
            for (int lt = 0; lt < 4; ++lt) { const bf16x8 a = *(const LAS bf16x8*)(Qs + (16 * lt + fr) * 136 + 32 * ks + 8 * fq); oc[lt] = MFMA16(a, b, oc[lt]); } }
#pragma unroll
          for (int lt = 0; lt < 4; ++lt)
#pragma unroll
            for (int r = 0; r < 4; ++r) { const int l = 16 * lt + 4 * fq + r; Os[l * 132 + 16 * wave + fr] = oi[lt][r] + exp2f(lg2 * (float)(l + 1)) * oc[lt][r]; } }
        __syncthreads();
#pragma unroll
        for (int et = 0; et < 8; ++et) { u32x2 w; w.x = pk2(st[et][0], st[et][1]); w.y = pk2(st[et][2], st[et][3]); *(LAS u32x2*)(ST + (16 * et + fr) * 136 + 16 * wave + 4 * fq) = w; }
        {
          const int l = 8 * wave + (lane >> 3), seg = lane & 7;
          const u32x4 gw0 = gv0, gw1 = gv1;
          const LAS f32x4* op = (const LAS f32x4*)(Os + l * 132 + 16 * seg);
          f32x4 ov[4]; float ssq = 0.f;
#pragma unroll
          for (int k = 0; k < 4; ++k) { ov[k] = op[k]; ssq += (ov[k].x * ov[k].x + ov[k].y * ov[k].y) + (ov[k].z * ov[k].z + ov[k].w * ov[k].w); }
          ssq += __int_as_float(__builtin_amdgcn_update_dpp(__float_as_int(ssq), __float_as_int(ssq), 0xB1, 0xf, 0xf, false));
          ssq += __int_as_float(__builtin_amdgcn_update_dpp(__float_as_int(ssq), __float_as_int(ssq), 0x4E, 0xf, 0xf, false));
          ssq += __int_as_float(__builtin_amdgcn_update_dpp(__float_as_int(ssq), __float_as_int(ssq), 0x141, 0xf, 0xf, false));
          const float rstd = __builtin_amdgcn_rsqf(ssq * (1.f / 128.f) + EPS);
          float gf[16]; { float t8[8]; unpack8(gw0, t8);
#pragma unroll
            for (int e = 0; e < 8; ++e) gf[e] = t8[e];
            unpack8(gw1, t8);
#pragma unroll
            for (int e = 0; e < 8; ++e) gf[8 + e] = t8[e]; }
          u32x4 w0, w1;
#pragma unroll
          for (int k = 0; k < 2; ++k) { w0[2 * k] = pk2(silu_f(gf[4 * k]) * (ov[k].x * rstd), silu_f(gf[4 * k + 1]) * (ov[k].y * rstd)); w0[2 * k + 1] = pk2(silu_f(gf[4 * k + 2]) * (ov[k].z * rstd), silu_f(gf[4 * k + 3]) * (ov[k].w * rstd)); }
#pragma unroll
          for (int k = 0; k < 2; ++k) { w1[2 * k] = pk2(silu_f(gf[8 + 4 * k]) * (ov[2 + k].x * rstd), silu_f(gf[8 + 4 * k + 1]) * (ov[2 + k].y * rstd)); w1[2 * k + 1] = pk2(silu_f(gf[8 + 4 * k + 2]) * (ov[2 + k].z * rstd), silu_f(gf[8 + 4 * k + 3]) * (ov[2 + k].w * rstd)); }
          bf16* mp = mix + (size_t)(rowc + l) * DM + h * 128 + 16 * seg;
          *(u32x4*)mp = w0; *(u32x4*)(mp + 8) = w1; }
    }
#pragma unroll
    for (int et = 0; et < 8; ++et)
#pragma unroll
        for (int r = 0; r < 4; ++r) st_out[(size_t)(16 * wave + 4 * fq + r) * 128 + 16 * et + fr] = st[et][r];
}
constexpr int AK = 0, AVT = 27648;
__device__ __forceinline__ void att_item(const Params& P, LAS unsigned char* lds, int tid, int wave, int lane, bool sample, int b, int n, int g) {
    const bf16* proj = (const bf16*)(P.ws + WS_R1);
    bf16* mix = (bf16*)(P.ws + WS_R2);
    const int fr = lane & 15, fq = lane >> 4;
    LAS bf16* Kl = (LAS bf16*)(lds + AK); LAS bf16* VTl = (LAS bf16*)(lds + AVT);
    const int qrow0 = sample ? MP + 64 * b : b * SEQ + 64 * n;
    const int jmin = sample ? 0 : (n >= 2 ? 0 : 64 * (2 - n));
    __syncthreads();
    bf16x8 qa[2][2];
    { const int hd_ = 4 * g + (wave >> 1), qh_ = wave & 1;
#pragma unroll
      for (int qt = 0; qt < 2; ++qt)
#pragma unroll
        for (int ks = 0; ks < 2; ++ks) qa[qt][ks] = *(const bf16x8*)(proj + (size_t)(qrow0 + 32 * qh_ + 16 * qt + fr) * INW + 2048 + hd_ * 64 + 32 * ks + 8 * fq); }
    {
        u32x4 kw[3], vw[3];
        if (!sample) {
#pragma unroll
            for (int i = 0; i < 3; ++i) { const bool ok = 64 * i >= jmin;
                const int rb = ok ? b * SEQ + 64 * (n - 2) + 64 * i : qrow0;
                kw[i] = *(const u32x4*)(proj + (size_t)(rb + (tid >> 3)) * INW + 2560 + g * 64 + 8 * (tid & 7));
                vw[i] = *(const u32x4*)(proj + (size_t)(rb + lane) * INW + 2688 + g * 64 + 8 * wave);
                if (!ok) { kw[i] = (u32x4){0u, 0u, 0u, 0u}; vw[i] = (u32x4){0u, 0u, 0u, 0u}; } }
        } else {
            f32x4 kc[2][2], vc[2][2];
#pragma unroll
            for (int i = 0; i < 2; ++i) { const float* sk = P.cache_k + ((size_t)(b * 128 + 64 * i + (tid >> 3)) * 2 + g) * 64 + 8 * (tid & 7); const float* sv = P.cache_v + ((size_t)(b * 128 + 64 * i + lane) * 2 + g) * 64 + 8 * wave;
                kc[i][0] = *(const f32x4*)sk; kc[i][1] = *(const f32x4*)(sk + 4); vc[i][0] = *(const f32x4*)sv; vc[i][1] = *(const f32x4*)(sv + 4); }
            kw[2] = *(const u32x4*)(proj + (size_t)(MP + 64 * b + (tid >> 3)) * INW + 2560 + g * 64 + 8 * (tid & 7));
            vw[2] = *(const u32x4*)(proj + (size_t)(MP + 64 * b + lane) * INW + 2688 + g * 64 + 8 * wave);
#pragma unroll
            for (int i = 0; i < 2; ++i) { kw[i].x = pk2(kc[i][0].x, kc[i][0].y); kw[i].y = pk2(kc[i][0].z, kc[i][0].w); kw[i].z = pk2(kc[i][1].x, kc[i][1].y); kw[i].w = pk2(kc[i][1].z, kc[i][1].w);
                vw[i].x = pk2(vc[i][0].x, vc[i][0].y); vw[i].y = pk2(vc[i][0].z, vc[i][0].w); vw[i].z = pk2(vc[i][1].x, vc[i][1].y); vw[i].w = pk2(vc[i][1].z, vc[i][1].w); }
        }
#pragma unroll
        for (int i = 0; i < 3; ++i) { *(LAS u32x4*)(Kl + (64 * i + (tid >> 3)) * 72 + 8 * (tid & 7)) = kw[i];
            const int j = 64 * i + lane;
#pragma unroll
            for (int e = 0; e < 4; ++e) { VTl[(8 * wave + 2 * e) * 200 + j] = (bf16)(vw[i][e] & 0xffffu); VTl[(8 * wave + 2 * e + 1) * 200 + j] = (bf16)(vw[i][e] >> 16); } }
    }
    const int r = wave >> 1, qh = wave & 1, head = 4 * g + r;
    const float nb8 = -8.0f * exp2f(-(float)(head + 1));
    const float sink8 = 8.0f * P.sinks[head];
    const float c1 = 0.125f * 1.4426950408889634f;
    __syncthreads();
#pragma unroll 1
    for (int qt = 0; qt < 2; ++qt) {
        asm volatile("" ::: "memory");
        const int qi = 32 * qh + 16 * qt + fr;
        bf16x8 qf[2];
#pragma unroll
        for (int ks = 0; ks < 2; ++ks) { const u32x4 x0 = __builtin_bit_cast(u32x4, qa[0][ks]), x1 = __builtin_bit_cast(u32x4, qa[1][ks]); u32x4 xs;
#pragma unroll
            for (int e = 0; e < 4; ++e) xs[e] = qt ? x1[e] : x0[e];
            qf[ks] = __builtin_bit_cast(bf16x8, xs); }
        const float basef = (float)(128 + qi - 4 * fq);
        f32x4 s[12];
#pragma unroll
        for (int kt = 0; kt < 12; ++kt) {
#pragma unroll
            for (int rr = 0; rr < 4; ++rr) s[kt][rr] = fabsf(basef - (float)(16 * kt + rr)) * nb8;
#pragma unroll
            for (int ks = 0; ks < 2; ++ks) { const bf16x8 a = *(const LAS bf16x8*)(Kl + (16 * kt + fr) * 72 + 32 * ks + 8 * fq); s[kt] = MFMA16(a, qf[ks], s[kt]); } }
        if (jmin > 0) {
#pragma unroll
            for (int kt = 0; kt < 12; ++kt)
#pragma unroll
                for (int rr = 0; rr < 4; ++rr) s[kt][rr] = (16 * kt + 4 * fq + rr) >= jmin ? s[kt][rr] : -INFINITY;
        }
        float mx = sink8;
#pragma unroll
        for (int kt = 0; kt < 12; ++kt)
#pragma unroll
            for (int rr = 0; rr < 4; ++rr) mx = fmaxf(mx, s[kt][rr]);
        mx = fmaxf(mx, __shfl_xor(mx, 16)); mx = fmaxf(mx, __shfl_xor(mx, 32));
        const float mxc = mx * c1;
        float ls = 0.f;
#pragma unroll
        for (int kt = 0; kt < 12; ++kt)
#pragma unroll
            for (int rr = 0; rr < 4; ++rr) { const float p = __builtin_amdgcn_exp2f(s[kt][rr] * c1 - mxc); s[kt][rr] = p; ls += p; }
        ls += __shfl_xor(ls, 16); ls += __shfl_xor(ls, 32);
        const float inv = 1.0f / (ls + __builtin_amdgcn_exp2f(sink8 * c1 - mxc));
        f32x4 o[4];
#pragma unroll
        for (int dt = 0; dt < 4; ++dt) o[dt] = (f32x4){0.f, 0.f, 0.f, 0.f};
#pragma unroll
        for (int kk = 0; kk < 6; ++kk) {
            u32x4 w; w.x = pk2(s[2 * kk][0], s[2 * kk][1]); w.y = pk2(s[2 * kk][2], s[2 * kk][3]); w.z = pk2(s[2 * kk + 1][0], s[2 * kk + 1][1]); w.w = pk2(s[2 * kk + 1][2], s[2 * kk + 1][3]);
            const bf16x8 pb = __builtin_bit_cast(bf16x8, w);
#pragma unroll
            for (int dt = 0; dt < 4; ++dt) { const LAS bf16* vp = VTl + (16 * dt + fr) * 200 + 32 * kk + 4 * fq;
                const u32x2 lo = *(const LAS u32x2*)vp, hi = *(const LAS u32x2*)(vp + 16);
                const u32x4 aw = (u32x4){lo.x, lo.y, hi.x, hi.y}; const bf16x8 a = __builtin_bit_cast(bf16x8, aw);
                o[dt] = MFMA16(a, pb, o[dt]); }
        }
        bf16* mp = mix + (size_t)(qrow0 + qi) * DM + 512 + head * 64 + 4 * fq;
#pragma unroll
        for (int dt = 0; dt < 4; ++dt) { const f32x4 v = o[dt] * inv; u32x2 w; w.x = pk2(v[0], v[1]); w.y = pk2(v[2], v[3]); *(u32x2*)(mp + 16 * dt) = w; }
    }
}
__device__ __forceinline__ void phase3(const Params& P, LAS unsigned char* lds, int tid, int wave, int lane) {
    const int G = gridDim.x, NR = G / 2, blk = blockIdx.x;
    if (blk < NR) {
#ifndef NO_RET
#ifdef PROBE_RETX2
        for (int rep = 0; rep < 2; ++rep)
#endif
        for (int it = blk; it < 256; it += NR) {
            const bool sample = it >= 128; const int bh = it & 127, b = bh >> 2, h = bh & 3;
            ret_item(P, lds, tid, wave, lane, h, sample ? MP + 64 * b : b * SEQ, sample ? 1 : 32, P.state_ret + (size_t)bh * 16384, sample, P.out + (sample ? OFF_SRET : OFF_PRET) + (size_t)bh * 16384);
        }
#endif
    } else {
#ifndef NO_ATT
#ifdef PROBE_ATTX2
        for (int rep = 0; rep < 2; ++rep)
#endif
        for (int it = blk - NR; it < 2112; it += G - NR) {
            const bool sample = it >= 2048;
            att_item(P, lds, tid, wave, lane, sample, sample ? (it - 2048) >> 1 : it >> 6, sample ? 2 : (it >> 1) & 31, it & 1);
        }
#endif
    }
}

__device__ __forceinline__ void phase6(const Params& P, int tid) {
    const bf16* ua = (const bf16*)(P.ws + WS_R1); bf16* ub = (bf16*)(P.ws + WS_R2);
    constexpr int CH = DFF / 8;
    const int total = MT * CH;
    for (int idx = blockIdx.x * 512 + tid; idx < total; idx += gridDim.x * 512) {
        const int row = idx / CH, j = (idx - row * CH) * 8;
        const bool smp = row >= MP; const int t = smp ? ((row - MP) & 63) : (row & 2047);
        float a[8], p1[8], p2[8], bb[8];
        unpack8(*(const u32x4*)(ua + (size_t)row * DFF + j), a);
        unpack8(*(const u32x4*)(ub + (size_t)row * DFF + j), bb);
        if (t >= 1) unpack8(*(const u32x4*)(ua + (size_t)(row - 1) * DFF + j), p1);
        else if (smp) { const float* s = P.state_conv + ((size_t)((row - MP) >> 6) * 2 + 1) * DFF + j; const f32x4 x = *(const f32x4*)s, y = *(const f32x4*)(s + 4); p1[0] = x.x; p1[1] = x.y; p1[2] = x.z; p1[3] = x.w; p1[4] = y.x; p1[5] = y.y; p1[6] = y.z; p1[7] = y.w; }
        else {
#pragma unroll
            for (int e = 0; e < 8; ++e) p1[e] = 0.f; }
        if (t >= 2) unpack8(*(const u32x4*)(ua + (size_t)(row - 2) * DFF + j), p2);
        else if (smp) { const float* s = P.state_conv + ((size_t)((row - MP) >> 6) * 2 + t) * DFF + j; const f32x4 x = *(const f32x4*)s, y = *(const f32x4*)(s + 4); p2[0] = x.x; p2[1] = x.y; p2[2] = x.z; p2[3] = x.w; p2[4] = y.x; p2[5] = y.y; p2[6] = y.z; p2[7] = y.w; }
        else {
#pragma unroll
            for (int e = 0; e < 8; ++e) p2[e] = 0.f; }
        float r[8];
#pragma unroll
        for (int h = 0; h < 2; ++h) { const f32x4 w0 = *(const f32x4*)(P.conv_w + j + 4 * h), w1 = *(const f32x4*)(P.conv_w + DFF + j + 4 * h), w2 = *(const f32x4*)(P.conv_w + 2 * DFF + j + 4 * h), cb = *(const f32x4*)(P.conv_b + j + 4 * h);
#pragma unroll
            for (int e = 0; e < 4; ++e) { const float cv = cb[e] + w0[e] * p2[4 * h + e] + w1[e] * p1[4 * h + e] + w2[e] * a[4 * h + e]; r[4 * h + e] = silu_f(cv) * bb[4 * h + e]; } }
        u32x4 w; w.x = pk2(r[0], r[1]); w.y = pk2(r[2], r[3]); w.z = pk2(r[4], r[5]); w.w = pk2(r[6], r[7]);
        *(u32x4*)(ub + (size_t)row * DFF + j) = w;
    }
}
#ifdef CONV_FUSED
__device__ __forceinline__ void phase6c(const Params& P, int tid) {
    const float* headA = (const float*)(P.ws + WS_R1); const float* headB = headA + HT_STRIDE; const float* tailA = headA + 2 * HT_STRIDE;
    bf16* act = (bf16*)(P.ws + WS_R2);
    constexpr int CH = DFF / 4;
    const int total = NGRP * CH;
    for (int idx = blockIdx.x * 512 + tid; idx < total; idx += gridDim.x * 512) {
        const int g = idx / CH, j = (idx - g * CH) * 4;
        const bool smp = g >= 1024, first = !smp && (g & 31) == 0;
        const float* pp = smp ? P.state_conv + ((size_t)(g - 1024) * 2) * DFF + j : tailA + ((size_t)(first ? g : g - 1) * 2) * DFF + j;
        f32x4 p0 = *(const f32x4*)pp, p1 = *(const f32x4*)(pp + DFF);
        const f32x4 a0 = *(const f32x4*)(headA + ((size_t)g * 2) * DFF + j), a1 = *(const f32x4*)(headA + ((size_t)g * 2 + 1) * DFF + j);
        const f32x4 b0 = *(const f32x4*)(headB + ((size_t)g * 2) * DFF + j), b1 = *(const f32x4*)(headB + ((size_t)g * 2 + 1) * DFF + j);
        const f32x4 t0 = *(const f32x4*)(tailA + ((size_t)g * 2) * DFF + j), t1 = *(const f32x4*)(tailA + ((size_t)g * 2 + 1) * DFF + j);
        const f32x4 w0 = *(const f32x4*)(P.conv_w + j), w1 = *(const f32x4*)(P.conv_w + DFF + j), w2 = *(const f32x4*)(P.conv_w + 2 * DFF + j), cb = *(const f32x4*)(P.conv_b + j);
        if (first) { p0 = (f32x4){0.f, 0.f, 0.f, 0.f}; p1 = (f32x4){0.f, 0.f, 0.f, 0.f}; }
        const f32x4 c0 = cb + w0 * p0 + w1 * p1 + w2 * a0, c1 = cb + w0 * p1 + w1 * a0 + w2 * a1;
        u32x2 r0, r1;
        r0.x = pk2(silu_f(c0.x) * b0.x, silu_f(c0.y) * b0.y); r0.y = pk2(silu_f(c0.z) * b0.z, silu_f(c0.w) * b0.w);
        r1.x = pk2(silu_f(c1.x) * b1.x, silu_f(c1.y) * b1.y); r1.y = pk2(silu_f(c1.z) * b1.z, silu_f(c1.w) * b1.w);
        *(u32x2*)(act + (size_t)(64 * g) * DFF + j) = r0;
        *(u32x2*)(act + (size_t)(64 * g + 1) * DFF + j) = r1;
        if (smp) { float* d = P.out + OFF_SCONV + ((size_t)(g - 1024) * 2) * DFF + j; *(f32x4*)d = t0; *(f32x4*)(d + DFF) = t1; }
        else if ((g & 31) == 31) { float* d = P.out + OFF_PCONV + ((size_t)(g >> 5) * 2) * DFF + j; *(f32x4*)d = t0; *(f32x4*)(d + DFF) = t1; }
    }
}
#endif
__device__ __forceinline__ void phase8n(const Params& P, LAS unsigned char* lds, int tid, int wave, int lane) {
    const float* mod = (const float*)(P.ws + WS_MOD); const bf16* x2 = (const bf16*)(P.ws + WS_R0);
    LAS float* lv = (LAS float*)lds;
    const int b = blockIdx.x, bsP = b >> 3, bsS = 32 + (b >> 3);
    __syncthreads();
    for (int i = tid; i < 4096; i += 512) { const int sl = i >> 11, which = (i >> 10) & 1, col = i & 1023; const float* mb = mod + (size_t)(sl ? bsS : bsP) * 8192 + 6144;
        lv[i] = which ? P.normf[col] * (1.f + mb[1024 + col]) : mb[col]; }
    __syncthreads();
#pragma unroll 4
    for (int r = wave; r < 256; r += 8) {
        const int row = 256 * b + r;
        const bf16* xr = x2 + (size_t)row * DM + 4 * lane;
        f32x4 v[4]; float ss = 0.f;
#pragma unroll
        for (int j = 0; j < 4; ++j) { const u32x2 w = *(const u32x2*)(xr + 256 * j); v[j] = (f32x4){bflo(w.x), bfhi(w.x), bflo(w.y), bfhi(w.y)};
            ss += (v[j].x * v[j].x + v[j].y * v[j].y) + (v[j].z * v[j].z + v[j].w * v[j].w); }
        const float rstd = __builtin_amdgcn_rsqf(wave_sum_dpp(ss) * (1.f / DM) + EPS);
        float* yr = P.out + (size_t)row * DM + 4 * lane;
#pragma unroll
        for (int j = 0; j < 4; ++j) { const f32x4 sh = *(const LAS f32x4*)(lv + 256 * j + 4 * lane), gs = *(const LAS f32x4*)(lv + 1024 + 256 * j + 4 * lane);
            *(f32x4*)(yr + 256 * j) = v[j] * rstd * gs + sh; }
    }
    {
        const int r = 8 * b + wave, row = MP + r;
        const bf16* xr = (const bf16*)(P.ws + WS_X1B) + (size_t)row * DM + 4 * lane;
        const float* sl = (const float*)(P.ws + WS_SLAB) + (size_t)r * DM + 4 * lane;
        const float* g2 = mod + (size_t)bsS * 8192 + 5120 + 4 * lane;
        f32x4 v[4]; float ss = 0.f;
#pragma unroll
        for (int j = 0; j < 4; ++j) { const u32x2 w = *(const u32x2*)(xr + 256 * j); f32x4 a = *(const f32x4*)(sl + 256 * j);
#pragma unroll
            for (int p = 1; p < 4; ++p) a += *(const f32x4*)(sl + (size_t)p * MS * DM + 256 * j);
            v[j] = (f32x4){bflo(w.x), bfhi(w.x), bflo(w.y), bfhi(w.y)} + *(const f32x4*)(g2 + 256 * j) * a;
            ss += (v[j].x * v[j].x + v[j].y * v[j].y) + (v[j].z * v[j].z + v[j].w * v[j].w); }
        const float rstd = __builtin_amdgcn_rsqf(wave_sum_dpp(ss) * (1.f / DM) + EPS);
        float* yr = P.out + (size_t)row * DM + 4 * lane;
#pragma unroll
        for (int j = 0; j < 4; ++j) { const f32x4 sh = *(const LAS f32x4*)(lv + 2048 + 256 * j + 4 * lane), gs = *(const LAS f32x4*)(lv + 3072 + 256 * j + 4 * lane);
            *(f32x4*)(yr + 256 * j) = v[j] * rstd * gs + sh; }
    }
}
__device__ __forceinline__ void phase8(const Params& P, int wave, int lane) {
    const float* mod = (const float*)(P.ws + WS_MOD); const bf16* x2 = (const bf16*)(P.ws + WS_R0);
    const int gw = blockIdx.x * 8 + wave, NGW = gridDim.x * 8;
#pragma unroll 2
    for (int row = gw; row < MT; row += NGW) {
        const int bs = row < MP ? (row >> 11) : 32 + ((row - MP) >> 6);
        float* yr = P.out + (size_t)row * DM + 8 * lane;
        const float* mb = mod + (size_t)bs * 8192 + 6144 + 8 * lane;
        float v[2][8]; float ss = 0.f;
        if (row < MP) {
            const bf16* xr = x2 + (size_t)row * DM + 8 * lane;
#pragma unroll
            for (int j = 0; j < 2; ++j) unpack8(*(const u32x4*)(xr + 512 * j), v[j]);
        } else {
            const bf16* xr = (const bf16*)(P.ws + WS_X1B) + (size_t)row * DM + 8 * lane;
            const float* sl = (const float*)(P.ws + WS_SLAB) + (size_t)(row - MP) * DM + 8 * lane;
            const float* g2 = mod + (size_t)bs * 8192 + 5120 + 8 * lane;
#pragma unroll
            for (int j = 0; j < 2; ++j) { unpack8(*(const u32x4*)(xr + 512 * j), v[j]);
#pragma unroll
                for (int h = 0; h < 2; ++h) { const int o = 512 * j + 4 * h; f32x4 a = *(const f32x4*)(sl + o);
#pragma unroll
                    for (int p = 1; p < 4; ++p) a += *(const f32x4*)(sl + (size_t)p * MS * DM + o);
                    const f32x4 g = *(const f32x4*)(g2 + o);
#pragma unroll
                    for (int e = 0; e < 4; ++e) v[j][4 * h + e] += g[e] * a[e]; } }
        }
#pragma unroll
        for (int j = 0; j < 2; ++j)
#pragma unroll
            for (int e = 0; e < 8; ++e) ss += v[j][e] * v[j][e];
        const float rstd = rsqrtf(wave_sum(ss) * (1.f / DM) + EPS);
#pragma unroll
        for (int j = 0; j < 2; ++j)
#pragma unroll
            for (int h = 0; h < 2; ++h) { const int o = 512 * j + 4 * h; const f32x4 sh = *(const f32x4*)(mb + o), sc = *(const f32x4*)(mb + 1024 + o), gn = *(const f32x4*)(P.normf + 8 * lane + o);
                const f32x4 x = (f32x4){v[j][4 * h], v[j][4 * h + 1], v[j][4 * h + 2], v[j][4 * h + 3]};
                *(f32x4*)(yr + o) = x * rstd * gn * (sc + 1.0f) + sh; }
    }
}
__device__ __forceinline__ void phase8q(const Params& P, LAS unsigned char* lds, int tid, int wave, int lane) {
    const float* mod = (const float*)(P.ws + WS_MOD);
    unsigned* cnt = (unsigned*)(P.ws + WS_CNT7); unsigned* ticket = (unsigned*)(P.ws + WS_TICKET);
    LAS int* ord = (LAS int*)(lds + 131072);
    LAS int* flag = ord + 272;
    pg8::StaticOrder S; S.init(MT, DM, (int)gridDim.x, 0);
    for (int i = tid; i < NTM; i += 512) flag[i] = 0;
    __syncthreads();
    { const int full = (S.nwg / S.G) * S.G; for (int L = full + tid; L < S.nwg; L += 512) { pg8::Unit u; S.map(L, u); flag[u.pm] = 1; } }
    __syncthreads();
    if (tid == 0) { int k = 0; for (int i = 0; i < NTM; ++i) if (!flag[i]) ord[k++] = i; for (int i = 0; i < NTM; ++i) if (flag[i]) ord[k++] = i; }
    __syncthreads();
    for (;;) {
        if (tid == 0) flag[268] = (int)__hip_atomic_fetch_add(ticket, 1u, __ATOMIC_RELAXED, __HIP_MEMORY_SCOPE_AGENT);
        __syncthreads();
        const int tk = flag[268];
        if (tk >= NTM * 4) break;
        const int pm = ord[tk >> 2], rb = tk & 3;
        if (wave == 0) {
            unsigned spins = 0;
            while ((unsigned)__builtin_amdgcn_readfirstlane(__hip_atomic_load(cnt + 64 * pm, __ATOMIC_RELAXED, __HIP_MEMORY_SCOPE_AGENT)) < 32u) { __builtin_amdgcn_s_sleep(4); if (++spins > (1u << 22)) break; }
            __builtin_amdgcn_fence(__ATOMIC_ACQUIRE, "agent");
            asm volatile("s_waitcnt vmcnt(0)" ::: "memory");
        }
        __syncthreads();
#pragma unroll 2
        for (int i = 0; i < 8; ++i) {
            const int row = pm * 256 + rb * 64 + wave * 8 + i;
            const int bs = row < MP ? (row >> 11) : 32 + ((row - MP) >> 6);
            float* yr = P.out + (size_t)row * DM + 4 * lane;
            const float* mb = mod + (size_t)bs * 8192 + 6144 + 4 * lane;
            f32x4 v[4]; float ss = 0.f;
#pragma unroll
            for (int j = 0; j < 4; ++j) { v[j] = *(const f32x4*)(yr + 256 * j); ss += (v[j].x * v[j].x + v[j].y * v[j].y) + (v[j].z * v[j].z + v[j].w * v[j].w); }
            const float rstd = rsqrtf(wave_sum(ss) * (1.f / DM) + EPS);
#pragma unroll
            for (int j = 0; j < 4; ++j) { const f32x4 sh = *(const f32x4*)(mb + 256 * j), sc = *(const f32x4*)(mb + 1024 + 256 * j), gn = *(const f32x4*)(P.normf + 4 * lane + 256 * j);
                *(f32x4*)(yr + 256 * j) = v[j] * rstd * gn * (sc + 1.0f) + sh; }
        }
    }
}

__device__ __forceinline__ void sample_fix(const Params& P, int wave, int lane) {
    const float* mod = (const float*)(P.ws + WS_MOD); const float* sl0 = (const float*)(P.ws + WS_SLAB4);
    bf16* a2 = (bf16*)(P.ws + WS_R0); bf16* x1b = (bf16*)(P.ws + WS_X1B); float* ss1 = (float*)(P.ws + WS_SS1);
    const int gw = blockIdx.x * 8 + wave, NGW = gridDim.x * 8;
    for (int r = gw; r < MS; r += NGW) {
        const int row = MP + r, bs = 32 + (r >> 6);
        const float* xr = P.x_s + (size_t)r * DM + 8 * lane; const float* sl = sl0 + (size_t)r * DM + 8 * lane; const float* mb = mod + (size_t)bs * 8192 + 8 * lane;
        float v[2][8], a[2][8]; float ss = 0.f;
#pragma unroll
        for (int j = 0; j < 2; ++j)
#pragma unroll
            for (int h = 0; h < 2; ++h) { const int o = 512 * j + 4 * h; f32x4 acc = *(const f32x4*)(sl + o);
#pragma unroll
                for (int p = 1; p < 4; ++p) acc += *(const f32x4*)(sl + (size_t)p * MS * DM + o);
                const f32x4 x = *(const f32x4*)(xr + o) + *(const f32x4*)(mb + 2048 + o) * acc;
                const f32x4 gs = *(const f32x4*)(P.ln2 + 8 * lane + o) * (*(const f32x4*)(mb + 4096 + o) + 1.0f);
#pragma unroll
                for (int e = 0; e < 4; ++e) { v[j][4 * h + e] = x[e]; a[j][4 * h + e] = x[e] * gs[e]; ss += x[e] * x[e]; } }
        ss = wave_sum(ss);
#pragma unroll
        for (int j = 0; j < 2; ++j) { u32x4 w; w.x = pk2(v[j][0], v[j][1]); w.y = pk2(v[j][2], v[j][3]); w.z = pk2(v[j][4], v[j][5]); w.w = pk2(v[j][6], v[j][7]);
            *(u32x4*)(x1b + (size_t)row * DM + 8 * lane + 512 * j) = w;
            w.x = pk2(a[j][0], a[j][1]); w.y = pk2(a[j][2], a[j][3]); w.z = pk2(a[j][4], a[j][5]); w.w = pk2(a[j][6], a[j][7]);
            *(u32x4*)(a2 + (size_t)row * DM + 8 * lane + 512 * j) = w; }
        if (lane < 16) ss1[(size_t)row * 16 + lane] = lane == 0 ? ss : 0.f;
    }
}

#ifndef N_LAUNCH
#define N_LAUNCH 1
#endif
#define LAUNDER_TID() int tid = threadIdx.x; asm volatile("" : "+v"(tid)); const int lane = tid & 63, wave = __builtin_amdgcn_readfirstlane(tid >> 6); (void)lane; (void)wave
template <int PHM>
__global__ void __launch_bounds__(512) fwd_mega(Params P) {
    extern __shared__ __attribute__((aligned(16))) unsigned char lds_raw[];
    LAS unsigned char* lds = (LAS unsigned char*)lds_raw;
    const int G = gridDim.x;
    unsigned char* ws = P.ws;
    volatile LAS unsigned* misc = (volatile LAS unsigned*)(lds + LDS_MISC);
    if (threadIdx.x < 2) misc[threadIdx.x] = 0u;
    __syncthreads();
    XcdBarrier bar; bar.bar = (unsigned*)(ws + WS_BAR); bar.x = 0; bar.st = misc;
#define GSYNC(a, b) do { if ((PHM & (a)) && (PHM & (b))) xcd_barrier(bar); } while (0)
    if constexpr (PHM == 511) {
      if (blockIdx.x == 0) for (int i = threadIdx.x; i < XCD_BAR_WORDS; i += 512) ((unsigned*)(ws + WS_BAR))[i] = 0u;
      if (blockIdx.x == 1) { for (int i = threadIdx.x; i < NTM * 64; i += 512) ((unsigned*)(ws + WS_CNT7))[i] = 0u; if (threadIdx.x < 64) ((unsigned*)(ws + WS_TICKET))[threadIdx.x] = 0u; }
      cg::this_grid().sync();
      bar = xcd_barrier_post((unsigned*)(ws + WS_BAR), misc); }
    if constexpr ((PHM & 1) != 0) { LAUNDER_TID(); phase0(P, lds, wave, lane); }
    GSYNC(1, 2);
    if constexpr ((PHM & 2) != 0) { LAUNDER_TID(); phase1(P, lds, tid, wave, lane); }
    GSYNC(2, 4);
    if constexpr ((PHM & 4) != 0) {
      pg8::Gemm g{(const bf16*)(ws + WS_R0), (const bf16*)(ws + WS_WIN), MT, INW, DM};
      OrderX S; S.S.init(MT, INW, G, (int)blockIdx.x); S.nX = 22; S.xpm = NTM; S.xpn0 = 11;
      Epi1 E{(bf16*)(ws + WS_R1), (float*)(ws + WS_SHW), P.out};
      pg8::gemm_phase<Epi1, OrderX, true, true>(lds, g, S, E); }
    GSYNC(4, 8);
    if constexpr ((PHM & 8) != 0) { LAUNDER_TID(); phase3(P, lds, tid, wave, lane);
#ifdef PROBE_P3X2
      cg::this_grid().sync(); phase3(P, lds, tid, wave, lane);
#endif
    }
    GSYNC(8, 16);
    if constexpr ((PHM & 16) != 0) {
      pg8::Gemm g{(const bf16*)(ws + WS_R2), (const bf16*)(ws + WS_WOUT), MT, DM, DM};
      OrderDown S; S.S.init(MP, DM, G, (int)blockIdx.x); S.ka = 4; S.kb = 4;
      Epi2 E{P.x_p, P.x_s, (const float*)(ws + WS_MOD), P.ln2, (bf16*)(ws + WS_X1B), (bf16*)(ws + WS_R0), (float*)(ws + WS_SS1), (float*)(ws + WS_SLAB4)};
      pg8::gemm_phase<Epi2, OrderDown, true, true>(lds, g, S, E); }
    GSYNC(16, 32);
    if constexpr ((PHM & 32) != 0) {
      LAUNDER_TID();
      sample_fix(P, wave, lane);
      if constexpr (PHM == 511) xcd_barrier(bar);
      pg8::Gemm g{(const bf16*)(ws + WS_R0), (const bf16*)(ws + WS_WUP), MT, 2 * DFF, DM};
      pg8::StaticOrder S; S.init(MT, 2 * DFF, G, (int)blockIdx.x);
      LAS float* rtab = (LAS float*)(lds + 131072);
      {
        LAS int* pmt = (LAS int*)lds;
        if (tid < 24) { pg8::Unit u; const bool ok = S.next(tid, u); pmt[tid] = ok ? u.pm : -1; }
        __syncthreads();
        if (tid < 256) { const float* ss = (const float*)(ws + WS_SS1);
#pragma unroll
          for (int i0 = 0; i0 < 24; i0 += 6) {
            f32x4 q[6][4]; int pmv[6];
#pragma unroll
            for (int k = 0; k < 6; ++k) { pmv[k] = pmt[i0 + k]; const f32x4* sp = (const f32x4*)(ss + (size_t)((pmv[k] < 0 ? 0 : pmv[k]) * 256 + tid) * 16);
#pragma unroll
                for (int e = 0; e < 4; ++e) q[k][e] = sp[e]; }
#pragma unroll
            for (int k = 0; k < 6; ++k) { const float tot = ((q[k][0].x + q[k][0].y) + (q[k][0].z + q[k][0].w)) + ((q[k][1].x + q[k][1].y) + (q[k][1].z + q[k][1].w)) + ((q[k][2].x + q[k][2].y) + (q[k][2].z + q[k][2].w)) + ((q[k][3].x + q[k][3].y) + (q[k][3].z + q[k][3].w));
                rtab[(i0 + k) * 256 + tid] = __builtin_amdgcn_rsqf(tot * (1.f / DM) + EPS); } } }
        __syncthreads(); }
#ifdef CONV_FUSED
      float* hA = (float*)(ws + WS_R1);
      Epi3C E{rtab, (const float*)(ws + WS_SHW), P.conv_w, P.conv_b, (bf16*)(ws + WS_R2), hA, hA + HT_STRIDE, hA + 2 * HT_STRIDE};
      pg8::gemm_phase<Epi3C, pg8::StaticOrder, true, true>(lds, g, S, E);
#else
      Epi3 E{rtab, (const float*)(ws + WS_SHW), (bf16*)(ws + WS_R1), (bf16*)(ws + WS_R2), P.out};
      pg8::gemm_phase<Epi3, pg8::StaticOrder, true, true>(lds, g, S, E);
#endif
#ifdef PROBE_P5X2
      cg::this_grid().sync(); pg8::gemm_phase<Epi3, pg8::StaticOrder, true, true>(lds, g, S, E);
#endif
    }
    GSYNC(32, 64);
#ifdef CONV_FUSED
    if constexpr ((PHM & 64) != 0) { LAUNDER_TID(); phase6c(P, tid); }
#else
    if constexpr ((PHM & 64) != 0) { LAUNDER_TID(); phase6(P, tid); }
#endif
    GSYNC(64, 128);
    if constexpr ((PHM & 128) != 0) {
      pg8::Gemm g{(const bf16*)(ws + WS_R2), (const bf16*)(ws + WS_WDN), MT, DM, DFF};
#ifdef P8_QUEUE
      OrderPub S; S.init(MT, DM, G, (int)blockIdx.x); S.cnt = (unsigned*)(ws + WS_CNT7);
      Epi4 E{(const float*)(ws + WS_MOD), (const bf16*)(ws + WS_X1B), (bf16*)(ws + WS_R0), (float*)(ws + WS_SLAB)};
      pg8::gemm_phase<Epi4, OrderPub, true, true>(lds, g, S, E); }
    if constexpr ((PHM & 256) != 0) { LAUNDER_TID(); phase8q(P, lds, tid, wave, lane); }
#else
      OrderDown S; S.S.init(MP, DM, G, (int)blockIdx.x); S.ka = 12; S.kb = 10;
      Epi4 E{(const float*)(ws + WS_MOD), (const bf16*)(ws + WS_X1B), (bf16*)(ws + WS_R0), (float*)(ws + WS_SLAB)};
      pg8::gemm_phase<Epi4, OrderDown, true, true>(lds, g, S, E); }
    GSYNC(128, 256);
    if constexpr ((PHM & 256) != 0) { LAUNDER_TID(); if (gridDim.x == 256) phase8n(P, lds, tid, wave, lane); else phase8(P, wave, lane); }
#endif
}

template <int PHM> static bool launch_one(const Params& p, int grid, bool coop, hipStream_t stream) {
    static bool attr_done = false;
    if (!attr_done) { if (hipFuncSetAttribute((const void*)fwd_mega<PHM>, hipFuncAttributeMaxDynamicSharedMemorySize, LDS_BYTES) != hipSuccess) { fprintf(stderr, "kernel_launch: hipFuncSetAttribute failed\n"); return false; } attr_done = true; }
    hipError_t e;
    if (coop) { Params pc = p; void* args[] = {&pc}; e = hipLaunchCooperativeKernel((const void*)fwd_mega<PHM>, dim3(grid), dim3(512), args, LDS_BYTES, stream); }
    else { hipLaunchKernelGGL(fwd_mega<PHM>, dim3(grid), dim3(512), LDS_BYTES, stream, p); e = hipPeekAtLastError(); }
    if (e != hipSuccess) { fprintf(stderr, "launch (mask %d) failed: %s (grid %d)\n", PHM, hipGetErrorString(e), grid); return false; }
    return true;
}
extern "C" void kernel_launch(void* const* d_in, const int* in_sizes, int n_in, void* d_out, int out_size, void* d_ws, size_t ws_size, hipStream_t stream) {
    static int grid = 0;
    if (grid == 0) {
        if (n_in != 22 || (size_t)out_size != OUT_TOTAL || ws_size < WS_END) { fprintf(stderr, "kernel_launch: unexpected sizes n_in %d out %d ws %zu\n", n_in, out_size, ws_size); grid = -1; return; }
        int dev = 0, cus = 0;
        (void)hipGetDevice(&dev);
        (void)hipDeviceGetAttribute(&cus, hipDeviceAttributeMultiprocessorCount, dev);
        grid = cus;
        if (grid > 256) grid = 256;
        if (grid < 2) grid = -1;
    }
    if (grid < 0) return;
    Params p{};
    const float** pp = (const float**)&p;
    for (int i = 0; i < 22; ++i) pp[i] = (const float*)d_in[i];
    p.out = (float*)d_out; p.ws = (unsigned char*)d_ws;
#if N_LAUNCH == 1
    launch_one<511>(p, grid, true, stream);
#else
    launch_one<1>(p, grid, false, stream) && launch_one<2>(p, grid, false, stream) && launch_one<4>(p, grid, false, stream) && launch_one<8>(p, grid, false, stream) &&
    launch_one<16>(p, grid, false, stream) && launch_one<32>(p, grid, false, stream) && launch_one<64>(p, grid, false, stream) && launch_one<128>(p, grid, false, stream) && launch_one<256>(p, grid, false, stream);
#endif
}
```

```cpp
#define CONV_FUSED 1
#include <hip/hip_runtime.h>
#include <hip/hip_cooperative_groups.h>
#include <cstdio>
#include <cstdint>
namespace cg = cooperative_groups;
namespace pg8 {
#define PG8_LAS __attribute__((address_space(3)))
typedef unsigned short bf16_t;
typedef short bf16x8 __attribute__((ext_vector_type(8)));
typedef float f32x4 __attribute__((ext_vector_type(4)));
typedef unsigned u32x4 __attribute__((ext_vector_type(4)));
constexpr int BM = 256, BK = 64, HALF = 128, HTB = HALF * BK * 2  , STAGE_BYTES = 8 * HTB, NXCD = 8, WGM = 8;

__host__ __device__ __forceinline__ int lds_byte(int r, int c) { const int st = (r >> 4) * 2 + (c >> 5), rr = r & 15, cc = c & 31, ob = rr * 64 + cc * 2; return st * 1024 + (ob ^ (((ob >> 9) & 1) << 5)); }
__host__ __device__ __forceinline__ void stage_rc(int b, int& R, int& C) { const int st = b / 1024, sb = b % 1024, swz = sb ^ (((sb >> 9) & 1) << 5); R = (st >> 1) * 16 + swz / 64; C = (st & 1) * 32 + (swz % 64) / 2; }
__host__ __device__ __forceinline__ int perm32(int rho) { const int n = rho >> 4, i = rho & 15; return 8 * (i >> 2) + 4 * n + (i & 3); }

struct Unit { int pm, pn, seq, kt0, nt; };
struct Gemm { const bf16_t* A; const bf16_t* Bt; int M, N, K; };

struct StaticOrder {
    int nM, nN, nwg, G, c;
    __host__ __device__ __forceinline__ void init(int M, int N, int G_, int c_) { nM = M / BM; nN = N / BM; nwg = nM * nN; G = G_; c = c_; }
    __host__ __device__ __forceinline__ bool next(int i, Unit& u) const {
        const long L = (long)i * G + c; if (L >= nwg) return false; u.seq = i; u.kt0 = 0; u.nt = 0; map(L, u); return true; }
    __host__ __device__ __forceinline__ void map(long L, Unit& u) const {
        int wgid = (int)L; { const int q = nwg / NXCD, r = nwg % NXCD, xcd = wgid % NXCD, off = wgid / NXCD; wgid = (xcd < r ? xcd * (q + 1) : r * (q + 1) + (xcd - r) * q) + off; }
        const int nig = WGM * nN, gid = wgid / nig, fm = gid * WGM, gsz = (nM - fm) < WGM ? (nM - fm) : WGM;
        u.pm = fm + ((wgid % nig) % gsz); u.pn = (wgid % nig) / gsz;
    }
    __device__ __forceinline__ void a_ready(const Unit&) const {}
    __device__ __forceinline__ void done(const Unit&) const {}
};

__device__ __forceinline__ unsigned cvt_pk_bf16(float lo, float hi) { unsigned r; asm volatile("v_cvt_pk_bf16_f32 %0, %1, %2" : "=v"(r) : "v"(lo), "v"(hi)); return r; }

template <class Epi, class Sched, bool ALIGN_EPI = false, bool SP2 = false>
__device__ __forceinline__ void gemm_phase(PG8_LAS unsigned char* lds, const Gemm g, const Sched& S, const Epi& E) {
    int tid_ = threadIdx.x; asm volatile("" : "+v"(tid_));
    const int tid = tid_, wid = __builtin_amdgcn_readfirstlane(tid >> 6), lane = tid & 63, wr = wid >> 2, wc = wid & 3, fr = lane & 15, fq = lane >> 4;
    const int K = g.K, nt = K / BK;
    unsigned voffA[2], voffB[2];
#pragma unroll
    for (int i = 0; i < 2; ++i) { int R, C; stage_rc(tid * 16 + i * 8192, R, C); const int Rb = Epi::PERM ? ((R & ~31) + perm32(R & 31)) : R;
        voffA[i] = (unsigned)(R * K + C) * 2u; voffB[i] = (unsigned)(Rb * K + C) * 2u; }
    const size_t kstep = (size_t)(BK * 2);
    const size_t hstep = (size_t)HALF * K * 2;
    const size_t tstep = 2 * hstep;
    const unsigned ldsw = (unsigned)wid * 1024u;
    const int aoff = lds_byte(wr * 64 + fr, fq * 8), boff = lds_byte(wc * 32 + fr, fq * 8);
#define PG8_SA(b, h) (((b) * 2 + (h)) * HTB)
#define PG8_SB(b, h) ((4 + (b) * 2 + (h)) * HTB)
#define PG8_STAGE(bufoff, gbase, voff) do { _Pragma("unroll") for (int _i = 0; _i < 2; ++_i) \
        __builtin_amdgcn_global_load_lds((const unsigned*)((const char*)(gbase) + (voff)[_i]), (PG8_LAS unsigned*)(lds + (bufoff) + ldsw + _i * 8192), 16, 0, 0); } while (0)
#define PG8_LDA(dst, b, h) do { _Pragma("unroll") for (int m = 0; m < 4; ++m) _Pragma("unroll") for (int k = 0; k < 2; ++k) dst[m][k] = *(const PG8_LAS bf16x8*)(lds + PG8_SA(b, h) + aoff + m * 2048 + k * 1024); } while (0)
#define PG8_LDB(dst, b, h) do { _Pragma("unroll") for (int n = 0; n < 2; ++n) _Pragma("unroll") for (int k = 0; k < 2; ++k) dst[n][k] = *(const PG8_LAS bf16x8*)(lds + PG8_SB(b, h) + boff + n * 2048 + k * 1024); } while (0)
#define PG8_MMA(ai, bj, At, Bt) do { __builtin_amdgcn_s_setprio(1); _Pragma("unroll") for (int m = 0; m < 4; ++m) _Pragma("unroll") for (int n = 0; n < 2; ++n) _Pragma("unroll") for (int k = 0; k < 2; ++k) \
        acc[ai][bj][m][n] = __builtin_amdgcn_mfma_f32_16x16x32_bf16(Bt[n][k], At[m][k], acc[ai][bj][m][n], 0, 0, 0); __builtin_amdgcn_s_setprio(0); } while (0)
#define PG8_WAIT_V(n) asm volatile("s_waitcnt vmcnt(" #n ")" ::: "memory")
#define PG8_WAIT_L(n) asm volatile("s_waitcnt lgkmcnt(" #n ")" ::: "memory")
#define PG8_BAR __builtin_amdgcn_s_barrier()
#define PG8_SCHED __builtin_amdgcn_sched_barrier(0)
    Unit cur, nxt; int ui = 0;
    if (!S.next(0, cur)) return;
    f32x4 acc[2][2][4][2];
#pragma unroll
    for (int a = 0; a < 2; ++a)
#pragma unroll
        for (int b = 0; b < 2; ++b)
#pragma unroll
            for (int m = 0; m < 4; ++m)
#pragma unroll
                for (int n = 0; n < 2; ++n) acc[a][b][m][n] = (f32x4){0.f, 0.f, 0.f, 0.f};
    bf16x8 At[4][2], B0[2][2], B1[2][2];
    const char* cA = (const char*)g.A + (size_t)cur.pm * tstep + (size_t)cur.kt0 * (BK * 2); const char* cB = (const char*)g.Bt + (size_t)cur.pn * tstep + (size_t)cur.kt0 * (BK * 2);
    S.a_ready(cur);
    if constexpr (SP2) {
        PG8_STAGE(PG8_SB(0, 0), cB, voffB); PG8_STAGE(PG8_SB(0, 1), cB + hstep, voffB); PG8_STAGE(PG8_SA(0, 0), cA, voffA); PG8_STAGE(PG8_SA(0, 1), cA + hstep, voffA);
        if (wr == 1) PG8_BAR;
        PG8_WAIT_V(2); PG8_BAR;
        PG8_STAGE(PG8_SB(1, 0), cB + kstep, voffB); PG8_STAGE(PG8_SA(1, 0), cA + kstep, voffA); PG8_STAGE(PG8_SB(1, 1), cB + hstep + kstep, voffB);
        PG8_WAIT_V(6); PG8_BAR;
    } else {
        PG8_STAGE(PG8_SB(0, 0), cB, voffB); PG8_STAGE(PG8_SA(0, 0), cA, voffA); PG8_STAGE(PG8_SB(0, 1), cB + hstep, voffB); PG8_STAGE(PG8_SA(0, 1), cA + hstep, voffA);
        if (wr == 1) PG8_BAR;
        PG8_WAIT_V(4); PG8_BAR;
        PG8_STAGE(PG8_SB(1, 0), cB + kstep, voffB); PG8_STAGE(PG8_SA(1, 0), cA + kstep, voffA); PG8_STAGE(PG8_SB(1, 1), cB + hstep + kstep, voffB);
        PG8_WAIT_V(6); PG8_BAR;
    }
    for (;;) {
        const bool has_next = S.next(ui + 1, nxt);
        const char* nA = has_next ? (const char*)g.A + (size_t)nxt.pm * tstep + (size_t)nxt.kt0 * (BK * 2) : cA; const char* nB = has_next ? (const char*)g.Bt + (size_t)nxt.pn * tstep + (size_t)nxt.kt0 * (BK * 2) : cB;
        const int ntu = cur.nt ? cur.nt : nt;
        for (int t = 0; t < ntu; t += 2) {
            const bool last = (t == ntu - 2);
            const char* a1 = cA + (size_t)(t + 1) * kstep;
            const char* a2 = last ? nA : cA + (size_t)(t + 2) * kstep; const char* b2 = last ? nB : cB + (size_t)(t + 2) * kstep;
            const char* a3 = a2 + kstep; const char* b3 = b2 + kstep;
            if (last && has_next) S.a_ready(nxt);
            if constexpr (SP2) {
            PG8_LDB(B0, 0, 0); PG8_LDB(B1, 0, 1); PG8_SCHED; PG8_LDA(At, 0, 0); PG8_STAGE(PG8_SA(1, 1), a1 + hstep, voffA);
            PG8_WAIT_V(8); PG8_WAIT_L(0); PG8_BAR; PG8_MMA(0, 0, At, B0); PG8_MMA(0, 1, At, B1); PG8_BAR; PG8_SCHED;
            PG8_LDA(At, 0, 1); PG8_STAGE(PG8_SB(0, 0), b2, voffB); PG8_STAGE(PG8_SB(0, 1), b2 + hstep, voffB); PG8_STAGE(PG8_SA(0, 0), a2, voffA);
            PG8_WAIT_V(8); PG8_WAIT_L(0); PG8_BAR; PG8_MMA(1, 0, At, B0); PG8_MMA(1, 1, At, B1); PG8_BAR; PG8_SCHED;
            PG8_LDB(B0, 1, 0); PG8_LDB(B1, 1, 1); PG8_SCHED; PG8_LDA(At, 1, 0); PG8_STAGE(PG8_SA(0, 1), a2 + hstep, voffA);
            PG8_WAIT_V(8); PG8_WAIT_L(0); PG8_BAR; PG8_MMA(0, 0, At, B0); PG8_MMA(0, 1, At, B1); PG8_BAR; PG8_SCHED;
            PG8_LDA(At, 1, 1); PG8_STAGE(PG8_SB(1, 0), b3, voffB); PG8_STAGE(PG8_SB(1, 1), b3 + hstep, voffB); PG8_STAGE(PG8_SA(1, 0), a3, voffA);
            PG8_WAIT_V(8); PG8_WAIT_L(0); PG8_BAR; PG8_MMA(1, 0, At, B0); PG8_MMA(1, 1, At, B1); PG8_BAR; PG8_SCHED;
            } else {
            PG8_LDB(B0, 0, 0); PG8_SCHED; PG8_LDA(At, 0, 0); PG8_STAGE(PG8_SA(1, 1), a1 + hstep, voffA);
            PG8_WAIT_L(8); PG8_BAR; PG8_WAIT_L(0); PG8_MMA(0, 0, At, B0); PG8_BAR; PG8_SCHED;
            PG8_LDB(B1, 0, 1); PG8_STAGE(PG8_SB(0, 0), b2, voffB);
            PG8_BAR; PG8_WAIT_L(0); PG8_MMA(0, 1, At, B1); PG8_BAR;
            PG8_LDA(At, 0, 1); PG8_STAGE(PG8_SA(0, 0), a2, voffA);
            PG8_BAR; PG8_WAIT_L(0); PG8_MMA(1, 0, At, B0); PG8_BAR; PG8_SCHED;
            PG8_STAGE(PG8_SB(0, 1), b2 + hstep, voffB);
            PG8_WAIT_V(6); PG8_BAR; PG8_MMA(1, 1, At, B1); PG8_BAR;
            PG8_LDB(B0, 1, 0); PG8_SCHED; PG8_LDA(At, 1, 0); PG8_STAGE(PG8_SA(0, 1), a2 + hstep, voffA);
            PG8_WAIT_L(8); PG8_BAR; PG8_WAIT_L(0); PG8_MMA(0, 0, At, B0); PG8_BAR; PG8_SCHED;
            PG8_LDB(B1, 1, 1); PG8_STAGE(PG8_SB(1, 0), b3, voffB);
            PG8_BAR; PG8_WAIT_L(0); PG8_MMA(0, 1, At, B1); PG8_BAR;
            PG8_LDA(At, 1, 1); PG8_STAGE(PG8_SA(1, 0), a3, voffA);
            PG8_BAR; PG8_WAIT_L(0); PG8_MMA(1, 0, At, B0); PG8_BAR; PG8_SCHED;
            PG8_STAGE(PG8_SB(1, 1), b3 + hstep, voffB);
            PG8_WAIT_V(6); PG8_BAR; PG8_MMA(1, 1, At, B1); PG8_BAR;
            }
        }
        if constexpr (ALIGN_EPI) { if (wr == 0) PG8_BAR; }
        if constexpr (!Epi::AFTER_DRAIN) { E(acc, cur, wr, wc, fr, fq); S.done(cur); }
        if (!has_next) break;
#pragma unroll
        for (int a = 0; a < 2; ++a)
#pragma unroll
            for (int b = 0; b < 2; ++b)
#pragma unroll
                for (int m = 0; m < 4; ++m)
#pragma unroll
                    for (int n = 0; n < 2; ++n) acc[a][b][m][n] = (f32x4){0.f, 0.f, 0.f, 0.f};
        cur = nxt; cA = nA; cB = nB; ++ui;
        if constexpr (ALIGN_EPI) { if (wr == 1) PG8_BAR; }
    }
    PG8_WAIT_V(0);
    if constexpr (!ALIGN_EPI) { if (wr == 0) PG8_BAR; }
    PG8_BAR;
    if constexpr (Epi::AFTER_DRAIN) { E.fused(acc, cur, wr, wc, fr, fq, lds, wid, lane); S.done(cur); }
#undef PG8_SA
#undef PG8_SB
#undef PG8_STAGE
#undef PG8_LDA
#undef PG8_LDB
#undef PG8_MMA
#undef PG8_WAIT_V
#undef PG8_WAIT_L
#undef PG8_BAR
#undef PG8_SCHED
}
}
constexpr int DM = 1024, SEQ = 2048, NB = 32, DECL = 64, DFF = 2816, INW = 2816;
constexpr int MP = NB * SEQ, MS = NB * DECL, MT = MP + MS;
constexpr int NGRP = MT / 64;
constexpr int NTM = MT / 256;
constexpr float EPS = 1e-6f;
constexpr size_t OFF_Y = 0;
constexpr size_t OFF_PRET = (size_t)MT * DM;
constexpr size_t OFF_PK = OFF_PRET + (size_t)NB * 4 * 128 * 128;
constexpr size_t OFF_PV = OFF_PK + (size_t)NB * 128 * 128;
constexpr size_t OFF_PCONV = OFF_PV + (size_t)NB * 128 * 128;
constexpr size_t OFF_SRET = OFF_PCONV + (size_t)NB * 2 * DFF;
constexpr size_t OFF_SK = OFF_SRET + (size_t)NB * 4 * 128 * 128;
constexpr size_t OFF_SV = OFF_SK + (size_t)NB * 64 * 128;
constexpr size_t OFF_SCONV = OFF_SV + (size_t)NB * 64 * 128;
constexpr size_t OUT_TOTAL = OFF_SCONV + (size_t)NB * 2 * DFF;
constexpr size_t MiB = 1u << 20;
constexpr size_t WS_WIN = 0;
constexpr size_t WS_WUP = WS_WIN + (size_t)INW * DM * 2;
constexpr size_t WS_WOUT = WS_WUP + (size_t)2 * DFF * DM * 2;
constexpr size_t WS_WDN = WS_WOUT + (size_t)DM * DM * 2;
constexpr size_t WS_MODP = 48 * MiB + 133 * MiB + 363 * MiB + 200 * MiB;
constexpr size_t WS_MOD = 32 * MiB;
constexpr size_t WS_SHW = 34 * MiB;
constexpr size_t WS_SS1 = 36 * MiB;
constexpr size_t WS_SS2 = 41 * MiB;
constexpr size_t WS_R0 = 48 * MiB;
constexpr size_t WS_R1 = WS_R0 + 133 * MiB;
constexpr size_t WS_R2 = WS_R1 + 363 * MiB;
constexpr size_t HT_STRIDE = (size_t)NGRP * 2 * DFF;
constexpr size_t WS_END = WS_R2 + 363 * MiB;
constexpr size_t WS_SLAB = WS_R1 + 264 * MiB;
constexpr size_t WS_SLAB4 = WS_R1 + 300 * MiB;
constexpr size_t WS_X1B = WS_R1 + 128 * MiB;
static_assert(3 * HT_STRIDE * 4 <= 128 * MiB && WS_X1B + (size_t)MT * DM * 2 <= WS_R2, "ws map");
static_assert(WS_WDN + (size_t)DM * DFF * 2 <= WS_MODP, "ws map");
static_assert((size_t)(MT + 256) * DM * 2 <= 133 * MiB && (size_t)MT * DFF * 2 <= 363 * MiB, "ws map");

constexpr size_t WS_BAR = 46 * MiB;
constexpr size_t WS_TICKET = 46 * MiB + 32768;
constexpr size_t WS_CNT7 = 46 * MiB + 65536;
constexpr int LDS_MISC = 155648;
constexpr int LDS_BYTES = 155648 + 64;

#define LAS __attribute__((address_space(3)))
typedef unsigned short bf16;
typedef float f32x4 __attribute__((ext_vector_type(4)));
typedef float f32x2 __attribute__((ext_vector_type(2)));
typedef short bf16x8 __attribute__((ext_vector_type(8)));
typedef unsigned u32x4 __attribute__((ext_vector_type(4)));
typedef unsigned u32x2 __attribute__((ext_vector_type(2)));
typedef __bf16 bf16x2_t __attribute__((ext_vector_type(2)));
#define LDS_WAIT() asm volatile("s_waitcnt lgkmcnt(0)" ::: "memory")

__device__ __forceinline__ unsigned pk2(float lo, float hi) { f32x2 v = {lo, hi}; bf16x2_t b = __builtin_convertvector(v, bf16x2_t); return __builtin_bit_cast(unsigned, b); }
__device__ __forceinline__ float bflo(unsigned w) { return __uint_as_float(w << 16); }
__device__ __forceinline__ float bfhi(unsigned w) { return __uint_as_float(w & 0xffff0000u); }
__device__ __forceinline__ float wave_sum(float v) {
#pragma unroll
    for (int o = 1; o < 64; o <<= 1) v += __shfl_xor(v, o);
    return v;
}
__device__ __forceinline__ float wave_sum_dpp(float v) {
    v += __int_as_float(__builtin_amdgcn_update_dpp(__float_as_int(v), __float_as_int(v), 0x128, 0xf, 0xf, false));
    v += __int_as_float(__builtin_amdgcn_update_dpp(__float_as_int(v), __float_as_int(v), 0x124, 0xf, 0xf, false));
    v += __int_as_float(__builtin_amdgcn_update_dpp(__float_as_int(v), __float_as_int(v), 0x122, 0xf, 0xf, false));
    v += __int_as_float(__builtin_amdgcn_update_dpp(__float_as_int(v), __float_as_int(v), 0x121, 0xf, 0xf, false));
    const int i = __float_as_int(v);
    return (__int_as_float(__builtin_amdgcn_readlane(i, 0)) + __int_as_float(__builtin_amdgcn_readlane(i, 16))) + (__int_as_float(__builtin_amdgcn_readlane(i, 32)) + __int_as_float(__builtin_amdgcn_readlane(i, 48)));
}
__device__ __forceinline__ float silu_f(float x) { return x * __builtin_amdgcn_rcpf(1.0f + __builtin_amdgcn_exp2f(-1.4426950408889634f * x)); }
__device__ __forceinline__ void unpack8(const u32x4 w, float (&f)[8]) { f[0] = bflo(w.x); f[1] = bfhi(w.x); f[2] = bflo(w.y); f[3] = bfhi(w.y); f[4] = bflo(w.z); f[5] = bfhi(w.z); f[6] = bflo(w.w); f[7] = bfhi(w.w); }
__device__ __forceinline__ int grp_bs(int g) { return g < 1024 ? (g >> 5) : 32 + (g - 1024); }

struct Params {
    const float *x_p, *x_s, *cache_k, *cache_v, *state_ret, *state_conv, *c_p, *c_s, *ln1, *ln2, *w_ada, *b_ada, *w_in, *w_out, *sinks, *w_up, *conv_w, *conv_b, *w_down, *normf, *w_ada_f, *b_ada_f;
    float* out; unsigned char* ws;
};

__device__ __forceinline__ void transpose_item(const float* W, int K, int N, bf16* WT, int dst_row0, int k0, int n0, LAS float* scr, int lane) {
    { f32x4 t[8];
#pragma unroll
      for (int i = 0; i < 8; ++i) t[i] = *(const f32x4*)(W + (size_t)(k0 + 8 * i + (lane >> 3)) * N + n0 + 4 * (lane & 7));
#pragma unroll
      for (int i = 0; i < 8; ++i) { LAS float* d = scr + (8 * i + (lane >> 3)) * 33 + 4 * (lane & 7); d[0] = t[i].x; d[1] = t[i].y; d[2] = t[i].z; d[3] = t[i].w; } }
    LDS_WAIT(); asm volatile("" ::: "memory");
    const int c = lane & 7;
#pragma unroll
    for (int j = 0; j < 4; ++j) { const int n = (lane >> 3) + 8 * j; const LAS float* s = scr + (8 * c) * 33 + n;
        u32x4 o; o.x = pk2(s[0 * 33], s[1 * 33]); o.y = pk2(s[2 * 33], s[3 * 33]); o.z = pk2(s[4 * 33], s[5 * 33]); o.w = pk2(s[6 * 33], s[7 * 33]);
        *(u32x4*)(WT + (size_t)(dst_row0 + n) * K + k0 + 8 * c) = o; }
    LDS_WAIT(); asm volatile("" ::: "memory");
}
constexpr int MOD_KS = 8, MOD_KC = 1024 / MOD_KS / 32;
__device__ __forceinline__ void mod_item(const Params& P, int it, LAS float* scr, int lane) {
    const int ct = it / MOD_KS, ks = it % MOD_KS, c0 = ct * 64;
    const float* W; const float* bias; int ldw;
    if (c0 < 6144) { W = P.w_ada + c0; bias = P.b_ada + c0; ldw = 6144; } else { W = P.w_ada_f + (c0 - 6144); bias = P.b_ada_f + (c0 - 6144); ldw = 2048; }
    float acc[64];
#pragma unroll
    for (int r = 0; r < 64; ++r) acc[r] = 0.f;
    const float* crow = (lane < 32 ? P.c_p + (size_t)lane * DM : P.c_s + (size_t)(lane - 32) * DM) + ks * (1024 / MOD_KS);
    const float* wk0 = W + (size_t)(ks * (1024 / MOD_KS)) * ldw + lane;
    f32x4 cv[8], cn[8];
#pragma unroll
    for (int q = 0; q < 8; ++q) cv[q] = *(const f32x4*)(crow + 4 * q);
    constexpr int NK4 = (1024 / MOD_KS) / 4;
    float w0 = wk0[0], w1 = wk0[(size_t)ldw], w2 = wk0[(size_t)2 * ldw], w3 = wk0[(size_t)3 * ldw];
    for (int kc = 0; kc < MOD_KC; ++kc) {
#pragma unroll
        for (int q = 0; q < 8; ++q) { f32x4 v = cv[q]; v.x = silu_f(v.x); v.y = silu_f(v.y); v.z = silu_f(v.z); v.w = silu_f(v.w); *(LAS f32x4*)(scr + lane * 36 + 4 * q) = v; }
        LDS_WAIT(); asm volatile("" ::: "memory");
        { const int kn = kc + 1 < MOD_KC ? kc + 1 : kc;
#pragma unroll
          for (int q = 0; q < 8; ++q) cn[q] = *(const f32x4*)(crow + kn * 32 + 4 * q); }
        for (int k4 = 0; k4 < 8; ++k4) {
            const int gk = kc * 8 + k4, gn = gk + 1 < NK4 ? gk + 1 : gk;
            const float* wn = wk0 + (size_t)(4 * gn) * ldw;
            const float n0 = wn[0], n1 = wn[(size_t)ldw], n2 = wn[(size_t)2 * ldw], n3 = wn[(size_t)3 * ldw];
#pragma unroll
            for (int r = 0; r < 64; ++r) { const f32x4 sv = *(const LAS f32x4*)(scr + r * 36 + 4 * k4);
                acc[r] = fmaf(sv.x, w0, acc[r]); acc[r] = fmaf(sv.y, w1, acc[r]); acc[r] = fmaf(sv.z, w2, acc[r]); acc[r] = fmaf(sv.w, w3, acc[r]); }
            w0 = n0; w1 = n1; w2 = n2; w3 = n3;
        }
        LDS_WAIT(); asm volatile("" ::: "memory");
#pragma unroll
        for (int q = 0; q < 8; ++q) cv[q] = cn[q];
    }
    float* dst = (float*)(P.ws + WS_MODP) + (size_t)ks * 64 * 8192 + c0 + lane;
    const float bv = (ks == 0) ? bias[lane] : 0.f;
#pragma unroll
    for (int r = 0; r < 64; ++r) dst[(size_t)r * 8192] = acc[r] + bv;
}
__device__ __forceinline__ void phase0(const Params& P, LAS unsigned char* lds, int wave, int lane) {
    LAS float* scr = (LAS float*)(lds + wave * 16384);
    const int gw = wave * gridDim.x + blockIdx.x, NGW = gridDim.x * 8;
    constexpr int I_MOD = 128 * MOD_KS, I_IN = 16 * 88, I_UP = 16 * 176, I_OUT = 16 * 32, I_DN = 44 * 32;
    constexpr int NIT = I_MOD + I_IN + I_UP + I_OUT + I_DN;
    for (int it = gw; it < NIT; it += NGW) {
        int r = it;
        if (r < I_MOD) { mod_item(P, r, scr, lane); continue; } r -= I_MOD;
        if (r < I_IN) { const int kb = r / 88, nb = r % 88; transpose_item(P.w_in, DM, INW, (bf16*)(P.ws + WS_WIN), nb * 32, kb * 64, nb * 32, scr, lane); continue; } r -= I_IN;
        if (r < I_UP) { const int kb = r / 176, nb = r % 176, n0 = nb * 32, isb = n0 >= DFF, j0 = n0 - isb * DFF;
            transpose_item(P.w_up, DM, 2 * DFF, (bf16*)(P.ws + WS_WUP), 256 * (j0 >> 7) + 128 * isb + (j0 & 127), kb * 64, n0, scr, lane); continue; } r -= I_UP;
        if (r < I_OUT) { const int kb = r / 32, nb = r % 32; transpose_item(P.w_out, DM, DM, (bf16*)(P.ws + WS_WOUT), nb * 32, kb * 64, nb * 32, scr, lane); continue; } r -= I_OUT;
        { const int kb = r / 32, nb = r % 32; transpose_item(P.w_down, DFF, DM, (bf16*)(P.ws + WS_WDN), nb * 32, kb * 64, nb * 32, scr, lane); }
    }
}

__device__ __forceinline__ void phase1(const Params& P, LAS unsigned char* lds, int tid, int wave, int lane) {
    const float* modp = (const float*)(P.ws + WS_MODP);
    float* mod = (float*)(P.ws + WS_MOD);
    bf16* H1 = (bf16*)(P.ws + WS_R0);
    for (int idx = blockIdx.x * 512 + tid; idx < 64 * 8192; idx += gridDim.x * 512) {
        float s = 0.f;
#pragma unroll
        for (int p_ = 0; p_ < MOD_KS; ++p_) s += modp[idx + (size_t)p_ * 524288];
        mod[idx] = s;
        const int col = idx & 8191, bs = idx >> 13;
        if (col >= 3072 && col < 4096) H1[(size_t)(MT + bs) * DM + (col - 3072)] = (bf16)(pk2(s, 0.f) & 0xffffu);
    }
    LAS float* lv = (LAS float*)lds;
    const int rpb = (MT + (int)gridDim.x - 1) / (int)gridDim.x, rbeg = (int)blockIdx.x * rpb, rend = (rbeg + rpb < MT) ? rbeg + rpb : MT;
    if (rbeg < rend) {
        const int bs0 = rbeg < MP ? (rbeg >> 11) : 32 + ((rbeg - MP) >> 6), bs1 = (rend - 1) < MP ? ((rend - 1) >> 11) : 32 + ((rend - 1 - MP) >> 6);
        const int nsl = bs1 - bs0 + 1;
        __syncthreads();
        for (int i = tid; i < nsl * 2048; i += 512) { const int sl = i >> 11, which = (i >> 10) & 1, col = i & 1023; const size_t o = (size_t)(bs0 + sl) * 8192 + which * 1024 + col;
            float sv = 0.f;
#pragma unroll
            for (int p_ = 0; p_ < MOD_KS; ++p_) sv += modp[o + (size_t)p_ * 524288];
            if (which) sv = P.ln1[col] * (1.f + sv);
            lv[i] = sv; }
        __syncthreads();
#pragma unroll 4
        for (int row = rbeg + wave; row < rend; row += 8) {
            const int bs = row < MP ? (row >> 11) : 32 + ((row - MP) >> 6);
            const LAS float* lvs = lv + (bs - bs0) * 2048;
            const float* xr = (row < MP ? P.x_p + (size_t)row * DM : P.x_s + (size_t)(row - MP) * DM) + 4 * lane;
            f32x4 v[4]; float ss = 0.f;
#pragma unroll
            for (int j = 0; j < 4; ++j) { v[j] = *(const f32x4*)(xr + 256 * j); ss += (v[j].x * v[j].x + v[j].y * v[j].y) + (v[j].z * v[j].z + v[j].w * v[j].w); }
            const float rstd = __builtin_amdgcn_rsqf(wave_sum_dpp(ss) * (1.f / DM) + EPS);
            bf16* hr = H1 + (size_t)row * DM + 4 * lane;
#pragma unroll
            for (int j = 0; j < 4; ++j) { const f32x4 sh = *(const LAS f32x4*)(lvs + 256 * j + 4 * lane), gs = *(const LAS f32x4*)(lvs + 1024 + 256 * j + 4 * lane);
                const f32x4 h = v[j] * rstd * gs + sh; u32x2 w; w.x = pk2(h.x, h.y); w.y = pk2(h.z, h.w); *(u32x2*)(hr + 256 * j) = w; }
        }
    }
}

struct OrderX {
    pg8::StaticOrder S; int nX, xpm, xpn0;
    __device__ __forceinline__ bool next(int i, pg8::Unit& u) const {
        const long L = (long)i * S.G + S.c;
        int pm = 0, pn = 0; bool ok = false;
        if (L < S.nwg) { pg8::Unit t; t.pm = 0; t.pn = 0; t.seq = 0; t.kt0 = 0; t.nt = 0; (void)S.next(i, t); pm = t.pm; pn = t.pn; ok = true; }
        else if (L < S.nwg + nX) { pm = xpm; pn = xpn0 + (int)(L - S.nwg); ok = true; }
        u.pm = pm; u.pn = pn; u.seq = i; u.kt0 = 0; u.nt = 0;
        return ok;
    }
    __device__ __forceinline__ void a_ready(const pg8::Unit&) const {}
    __device__ __forceinline__ void done(const pg8::Unit&) const {}
};
struct OrderPub : pg8::StaticOrder {
    unsigned* cnt;
    __device__ __forceinline__ void done(const pg8::Unit& u) const {
        asm volatile("s_waitcnt vmcnt(0)" ::: "memory");
        if ((threadIdx.x & 63) == 0) __hip_atomic_fetch_add(cnt + 64 * u.pm, 1u, __ATOMIC_RELAXED, __HIP_MEMORY_SCOPE_AGENT);
    }
};
struct OrderDown {
    pg8::StaticOrder S;
    int ka, kb;
    __device__ __forceinline__ bool next(int i, pg8::Unit& u) const {
        const long L = (long)i * S.G + S.c;
        int pm = 0, pn = 0, kt0 = 0, nt = 0; bool ok = false;
        if (L < S.nwg) { pg8::Unit t; t.pm = 0; t.pn = 0; t.seq = 0; t.kt0 = 0; t.nt = 0; (void)S.next(i, t); pm = t.pm; pn = t.pn; ok = true; }
        else if (L < S.nwg + 128) { const int q = (int)(L - S.nwg), tu = q >> 2, part = q & 3; pm = (MP / 256) + (tu & 7); pn = tu >> 3; kt0 = part < 2 ? ka * part : 2 * ka + kb * (part - 2); nt = part < 2 ? ka : kb; ok = true; }
        u.pm = pm; u.pn = pn; u.seq = i; u.kt0 = kt0; u.nt = nt;
        return ok;
    }
    __device__ __forceinline__ void a_ready(const pg8::Unit&) const {}
    __device__ __forceinline__ void done(const pg8::Unit&) const {}
};
typedef const f32x4 (&AccRef)[2][2][4][2];
struct Epi1 {
    static constexpr bool PERM = true, AFTER_DRAIN = false;
    bf16* proj; float* shw; float* out;
    __device__ __forceinline__ void operator()(AccRef acc, const pg8::Unit& u, int wr, int wc, int fr, int fq) const {
        if (u.pm == NTM) {
            if (wr == 0) {
#pragma unroll
                for (int m = 0; m < 4; ++m) { float* d = shw + (size_t)(16 * m + fr) * (2 * DFF) + 256 * (u.pn - 11) + 32 * wc + 8 * fq;
#pragma unroll
                    for (int bj = 0; bj < 2; ++bj)
#pragma unroll
                        for (int n = 0; n < 2; ++n) *(f32x4*)(d + 128 * bj + 4 * n) = acc[0][bj][m][n]; }
            }
            return;
        }
        const unsigned row0 = u.pm * 256 + wr * 64 + fr, col0 = u.pn * 256 + wc * 32 + 8 * fq;
#pragma unroll
        for (int ai = 0; ai < 2; ++ai)
#pragma unroll
            for (int m = 0; m < 4; ++m) { const unsigned o = (row0 + 128 * ai + 16 * m) * (unsigned)INW + col0;
#pragma unroll
                for (int bj = 0; bj < 2; ++bj) { const f32x4 v0 = acc[ai][bj][m][0], v1 = acc[ai][bj][m][1];
                    u32x4 w; w.x = pk2(v0[0], v0[1]); w.y = pk2(v0[2], v0[3]); w.z = pk2(v1[0], v1[1]); w.w = pk2(v1[2], v1[3]);
                    *(u32x4*)(proj + (o + 128 * bj)) = w; }
                asm volatile("" ::: "memory"); }
        if (u.pn == 10) {
            const unsigned c = 32 * wc + 8 * fq;
#pragma unroll
            for (int ai = 0; ai < 2; ++ai)
#pragma unroll
                for (int m = 0; m < 4; ++m) { const unsigned row = row0 + 128 * ai + 16 * m; unsigned ok, ov;
                    if (row < (unsigned)MP) { const unsigned t = row & 2047; if (t < SEQ - 128) continue; const unsigned o = ((row >> 11) * 128 + (t - (SEQ - 128))) * 128 + c; ok = (unsigned)OFF_PK + o; ov = (unsigned)OFF_PV + o; }
                    else { const unsigned o = (row - MP) * 128 + c; ok = (unsigned)OFF_SK + o; ov = (unsigned)OFF_SV + o; }
                    *(f32x4*)(out + ok) = acc[ai][0][m][0]; *(f32x4*)(out + ok + 4) = acc[ai][0][m][1];
                    *(f32x4*)(out + ov) = acc[ai][1][m][0]; *(f32x4*)(out + ov + 4) = acc[ai][1][m][1];
                    asm volatile("" ::: "memory"); }
        }
    }
};
struct Epi2 {
    static constexpr bool PERM = true, AFTER_DRAIN = false;
    const float *xp, *xs, *mod, *ln2; bf16* x1; bf16* a2; float* ss; float* slab;
    __device__ __forceinline__ void operator()(AccRef acc, const pg8::Unit& u, int wr, int wc, int fr, int fq) const {
        const int col0 = u.pn * 256 + wc * 32 + 8 * fq;
        if (u.nt != 0) {
            float* sb = slab + (size_t)(u.kt0 >> 2) * MS * DM;
#pragma unroll
            for (int ai = 0; ai < 2; ++ai)
#pragma unroll
                for (int m = 0; m < 4; ++m) { const unsigned ro = (unsigned)(u.pm * 256 - MP + 128 * ai + 64 * wr + 16 * m + fr) * DM + col0;
#pragma unroll
                    for (int bj = 0; bj < 2; ++bj) { *(f32x4*)(sb + ro + 128 * bj) = acc[ai][bj][m][0]; *(f32x4*)(sb + ro + 128 * bj + 4) = acc[ai][bj][m][1]; } }
            return;
        }
#pragma unroll
        for (int ai = 0; ai < 2; ++ai) {
            const int bs = grp_bs(4 * u.pm + 2 * ai + wr);
            const float* mb = mod + (size_t)bs * 8192;
            f32x4 g1v[2][2], gsv[2][2];
#pragma unroll
            for (int bj = 0; bj < 2; ++bj)
#pragma unroll
                for (int n = 0; n < 2; ++n) { const int c = col0 + 128 * bj + 4 * n; g1v[bj][n] = *(const f32x4*)(mb + 2048 + c);
                    gsv[bj][n] = *(const f32x4*)(ln2 + c) * (*(const f32x4*)(mb + 4096 + c) + 1.0f); }
#pragma unroll
            for (int m = 0; m < 4; ++m) {
                const int row = u.pm * 256 + 128 * ai + 64 * wr + 16 * m + fr;
                const float* xr = row < MP ? xp + (size_t)row * DM : xs + (size_t)(row - MP) * DM;
                float s = 0.f;
#pragma unroll
                for (int bj = 0; bj < 2; ++bj) { f32x4 a[2]; f32x4 xb[2];
#pragma unroll
                    for (int n = 0; n < 2; ++n) { const int c = col0 + 128 * bj + 4 * n; const f32x4 xv = *(const f32x4*)(xr + c); const f32x4 v = xv + g1v[bj][n] * acc[ai][bj][m][n];
                        xb[n] = v; s += (v.x * v.x + v.y * v.y) + (v.z * v.z + v.w * v.w); a[n] = v * gsv[bj][n]; }
                    u32x4 w; w.x = pk2(a[0].x, a[0].y); w.y = pk2(a[0].z, a[0].w); w.z = pk2(a[1].x, a[1].y); w.w = pk2(a[1].z, a[1].w);
                    *(u32x4*)(a2 + (size_t)row * DM + col0 + 128 * bj) = w;
                    w.x = pk2(xb[0].x, xb[0].y); w.y = pk2(xb[0].z, xb[0].w); w.z = pk2(xb[1].x, xb[1].y); w.w = pk2(xb[1].z, xb[1].w);
                    *(u32x4*)(x1 + (size_t)row * DM + col0 + 128 * bj) = w; }
                s += __shfl_xor(s, 16); s += __shfl_xor(s, 32);
                if (fq == 0) ss[(size_t)row * 16 + 4 * u.pn + wc] = s;
            }
        }
    }
};
struct Epi3 {
    static constexpr bool PERM = true, AFTER_DRAIN = false;
    const LAS float* rtab; const float* shw; bf16 *ua, *ub; float* out;
    __device__ __forceinline__ void operator()(AccRef acc, const pg8::Unit& u, int wr, int wc, int fr, int fq) const {
        const unsigned j0 = u.pn * 128 + wc * 32 + 8 * fq, pc0 = u.pn * 256 + wc * 32 + 8 * fq;
#pragma unroll
        for (int ai = 0; ai < 2; ++ai) {
            const unsigned grp = 4 * u.pm + 2 * ai + wr, bs = grp_bs((int)grp);
            const unsigned so = bs * (2 * DFF) + pc0;
            const f32x4 sa0 = *(const f32x4*)(shw + so), sa1 = *(const f32x4*)(shw + so + 4), sb0 = *(const f32x4*)(shw + so + 128), sb1 = *(const f32x4*)(shw + so + 132);
#pragma unroll
            for (int m = 0; m < 4; ++m) {
                const float rstd = rtab[u.seq * 256 + 128 * ai + 64 * wr + 16 * m + fr];
                const unsigned row = grp * 64 + 16 * m + fr;
                const f32x4 a0 = acc[ai][0][m][0] * rstd + sa0, a1 = acc[ai][0][m][1] * rstd + sa1, b0 = acc[ai][1][m][0] * rstd + sb0, b1 = acc[ai][1][m][1] * rstd + sb1;
                u32x4 w; w.x = pk2(a0[0], a0[1]); w.y = pk2(a0[2], a0[3]); w.z = pk2(a1[0], a1[1]); w.w = pk2(a1[2], a1[3]);
                *(u32x4*)(ua + (row * (unsigned)DFF + j0)) = w;
                w.x = pk2(b0[0], b0[1]); w.y = pk2(b0[2], b0[3]); w.z = pk2(b1[0], b1[1]); w.w = pk2(b1[2], b1[3]);
                *(u32x4*)(ub + (row * (unsigned)DFF + j0)) = w;
                if (m == 3 && fr >= 14) {
                    if (grp >= 1024) { float* d = out + OFF_SCONV + ((size_t)(grp - 1024) * 2 + (fr - 14)) * DFF + j0; *(f32x4*)d = a0; *(f32x4*)(d + 4) = a1; }
                    else if ((grp & 31) == 31) { float* d = out + OFF_PCONV + ((size_t)(grp >> 5) * 2 + (fr - 14)) * DFF + j0; *(f32x4*)d = a0; *(f32x4*)(d + 4) = a1; }
                }
            }
        }
    }
};
#ifdef CONV_FUSED
struct Epi3C {
    static constexpr bool PERM = true, AFTER_DRAIN = false;
    const LAS float* rtab; const float *shw, *cw, *cb; bf16* act; float *headA, *headB, *tailA;
    __device__ __forceinline__ void operator()(AccRef acc, const pg8::Unit& u, int wr, int wc, int fr, int fq) const {
        const unsigned j0 = u.pn * 128 + wc * 32 + 8 * fq, pc0 = u.pn * 256 + wc * 32 + 8 * fq;
        f32x4 w0[2], w1[2], w2[2], cbv[2];
#pragma unroll
        for (int n = 0; n < 2; ++n) { w0[n] = *(const f32x4*)(cw + j0 + 4 * n); w1[n] = *(const f32x4*)(cw + DFF + j0 + 4 * n); w2[n] = *(const f32x4*)(cw + 2 * DFF + j0 + 4 * n); cbv[n] = *(const f32x4*)(cb + j0 + 4 * n); }
#pragma unroll
        for (int ai = 0; ai < 2; ++ai) {
            asm volatile("" ::: "memory");
            const unsigned grp = 4 * u.pm + 2 * ai + wr, bs = grp_bs((int)grp);
            const unsigned so = bs * (2 * DFF) + pc0, ho = (grp * 2 + (fr & 1)) * DFF + j0;
            u32x2 ap[4][2], bp[4][2];
            {
                f32x4 sa[2], sb[2];
#pragma unroll
                for (int n = 0; n < 2; ++n) { sa[n] = *(const f32x4*)(shw + so + 4 * n); sb[n] = *(const f32x4*)(shw + so + 128 + 4 * n); }
#pragma unroll
                for (int m = 0; m < 4; ++m) {
                    const float rs = rtab[u.seq * 256 + 128 * ai + 64 * wr + 16 * m + fr];
#pragma unroll
                    for (int n = 0; n < 2; ++n) {
                        const f32x4 av = acc[ai][0][m][n] * rs + sa[n], bv = acc[ai][1][m][n] * rs + sb[n];
                        if (m == 0) { if (fr < 2) { *(f32x4*)(headA + ho + 4 * n) = av; *(f32x4*)(headB + ho + 4 * n) = bv; } }
                        if (m == 3) { if (fr >= 14) *(f32x4*)(tailA + ho + 4 * n) = av; }
                        ap[m][n].x = pk2(av.x, av.y); ap[m][n].y = pk2(av.z, av.w); bp[m][n].x = pk2(bv.x, bv.y); bp[m][n].y = pk2(bv.z, bv.w);
                    }
                }
            }
            asm volatile("" ::: "memory");
#pragma unroll
            for (int n = 0; n < 2; ++n)
#pragma unroll
                for (int h = 0; h < 2; ++h) {
                    unsigned q1 = 0u, q2 = 0u;
#pragma unroll
                    for (int m = 0; m < 4; ++m) {
                        const unsigned a = ap[m][n][h];
                        const unsigned s1 = (unsigned)__builtin_amdgcn_update_dpp((int)a, (int)a, 0x121, 0xf, 0xf, false);
                        const unsigned s2 = (unsigned)__builtin_amdgcn_update_dpp((int)a, (int)a, 0x122, 0xf, 0xf, false);
                        const unsigned pr1 = fr >= 1 ? s1 : q1, pr2 = fr >= 2 ? s2 : q2;
                        q1 = s1; q2 = s2;
                        const float c0 = cbv[n][2 * h] + w0[n][2 * h] * bflo(pr2) + w1[n][2 * h] * bflo(pr1) + w2[n][2 * h] * bflo(a);
                        const float c1 = cbv[n][2 * h + 1] + w0[n][2 * h + 1] * bfhi(pr2) + w1[n][2 * h + 1] * bfhi(pr1) + w2[n][2 * h + 1] * bfhi(a);
                        const unsigned bw = bp[m][n][h];
                        bp[m][n][h] = pk2(silu_f(c0) * bflo(bw), silu_f(c1) * bfhi(bw));
                    }
                    __builtin_amdgcn_sched_barrier(0);
                }
            asm volatile("" ::: "memory");
#pragma unroll
            for (int m = 0; m < 4; ++m) {
                if (m == 0 && fr < 2) continue;
                const unsigned row = grp * 64 + 16 * m + fr;
                const u32x4 w = (u32x4){bp[m][0].x, bp[m][0].y, bp[m][1].x, bp[m][1].y};
                *(u32x4*)(act + (row * (unsigned)DFF + j0)) = w;
            }
        }
    }
};
#endif
struct Epi4 {
    static constexpr bool PERM = true, AFTER_DRAIN = false;
    const float* mod; const bf16* x1; bf16* x2; float* slab;
    __device__ __forceinline__ void operator()(AccRef acc, const pg8::Unit& u, int wr, int wc, int fr, int fq) const {
        const int col0 = u.pn * 256 + wc * 32 + 8 * fq;
        if (u.nt != 0) {
            const int part = u.kt0 == 0 ? 0 : (u.kt0 == 12 ? 1 : (u.kt0 == 24 ? 2 : 3));
            float* sb = slab + (size_t)part * MS * DM;
#pragma unroll
            for (int ai = 0; ai < 2; ++ai)
#pragma unroll
                for (int m = 0; m < 4; ++m) { const unsigned ro = (unsigned)(u.pm * 256 - MP + 128 * ai + 64 * wr + 16 * m + fr) * DM + col0;
#pragma unroll
                    for (int bj = 0; bj < 2; ++bj) { *(f32x4*)(sb + ro + 128 * bj) = acc[ai][bj][m][0]; *(f32x4*)(sb + ro + 128 * bj + 4) = acc[ai][bj][m][1]; } }
            return;
        }
#pragma unroll
        for (int ai = 0; ai < 2; ++ai) {
            const int bs = grp_bs(4 * u.pm + 2 * ai + wr);
            const float* mb = mod + (size_t)bs * 8192 + 5120;
            f32x4 g2v[2][2];
#pragma unroll
            for (int bj = 0; bj < 2; ++bj)
#pragma unroll
                for (int n = 0; n < 2; ++n) g2v[bj][n] = *(const f32x4*)(mb + col0 + 128 * bj + 4 * n);
#pragma unroll
            for (int m = 0; m < 4; ++m) {
                const unsigned ro = (unsigned)(u.pm * 256 + 128 * ai + 64 * wr + 16 * m + fr) * DM + col0;
#pragma unroll
                for (int bj = 0; bj < 2; ++bj) { const u32x4 xw = *(const u32x4*)(x1 + ro + 128 * bj);
                    const f32x4 v0 = (f32x4){bflo(xw.x), bfhi(xw.x), bflo(xw.y), bfhi(xw.y)} + g2v[bj][0] * acc[ai][bj][m][0];
                    const f32x4 v1 = (f32x4){bflo(xw.z), bfhi(xw.z), bflo(xw.w), bfhi(xw.w)} + g2v[bj][1] * acc[ai][bj][m][1];
                    u32x4 w; w.x = pk2(v0.x, v0.y); w.y = pk2(v0.z, v0.w); w.z = pk2(v1.x, v1.y); w.w = pk2(v1.z, v1.w);
                    *(u32x4*)(x2 + ro + 128 * bj) = w; }
            }
        }
    }
};
#define GAS __attribute__((address_space(1)))
#define RLX_AGENT __ATOMIC_RELAXED, __HIP_MEMORY_SCOPE_AGENT
#define XB_TMO      128
#define XB_XCNT(j)  (256  + 64 * (j))
#define XB_XSUB(j)  (1280 + 64 * (j))
#define XB_XGEN(j)  (2304 + 64 * (j))
#define XB_TOP      3328
#define XB_TOPGEN   3392
#define XCD_BAR_WORDS 3456
#define XB_SPIN_CAP (1u << 18)

__device__ __forceinline__ unsigned xb_ld(unsigned* p)              { return __hip_atomic_load(p, __ATOMIC_RELAXED, __HIP_MEMORY_SCOPE_AGENT); }
__device__ __forceinline__ unsigned xb_add(unsigned* p, unsigned v) { return __hip_atomic_fetch_add(p, v, __ATOMIC_RELAXED, __HIP_MEMORY_SCOPE_AGENT); }
__device__ __forceinline__ unsigned xb_xcc_id() { return (unsigned)__builtin_amdgcn_s_getreg((3 << 11) | 20) & 0xFu; }
#define XB_SPIN(cond, bar) do { unsigned _sp = 0; while (cond) { __builtin_amdgcn_s_sleep(1); \
    if ((++_sp & 255u) == 0u) { if (xb_ld(&(bar)[XB_TMO])) break; if (_sp > XB_SPIN_CAP) { atomicAdd(&(bar)[XB_TMO], 1u); break; } } } } while (0)

struct XcdBarrier {
    unsigned* bar; unsigned x;
    volatile LAS unsigned* st;
};

__device__ __forceinline__ XcdBarrier xcd_barrier_post(unsigned* bar, volatile LAS unsigned* st) {
    XcdBarrier b; b.bar = bar; b.x = xb_xcc_id(); b.st = st;
    if (threadIdx.x == 0) (void)xb_add(&bar[XB_XCNT(b.x)], 1u);
    return b;
}
__device__ __forceinline__ void xcd_barrier_complete(unsigned* bar, unsigned x, unsigned& nloc, unsigned& nx) {
    const unsigned G = gridDim.x * gridDim.y * gridDim.z;
    unsigned sum, cnt, mine, sp = 0u;
    for (;;) {
        sum = 0u; cnt = 0u; mine = 0u;
#pragma unroll
        for (unsigned j = 0; j < 16; ++j) { const unsigned c = xb_ld(&bar[XB_XCNT(j)]); sum += c; cnt += (c > 0u) ? 1u : 0u; mine = (j == x) ? c : mine; }
        if (sum == G) break;
        __builtin_amdgcn_s_sleep(1);
        if ((++sp & 255u) == 0u) { if (xb_ld(&bar[XB_TMO])) break; if (sp > XB_SPIN_CAP) { atomicAdd(&bar[XB_TMO], 1u); break; } }
    }
    nloc = mine > 0u ? mine : 1u; nx = cnt > 0u ? cnt : 1u;
}

__device__ __forceinline__ void xcd_barrier(const XcdBarrier& b) {
    asm volatile("s_waitcnt vmcnt(0)" ::: "memory");
    __syncthreads();
    if (threadIdx.x == 0) {
        unsigned* bar = b.bar;
        __builtin_amdgcn_s_waitcnt(0);
        unsigned nloc = b.st[0], nx = b.st[1];
        if (nloc == 0u) { xcd_barrier_complete(bar, b.x, nloc, nx); b.st[0] = nloc; b.st[1] = nx; }
        const unsigned old = xb_add(&bar[XB_XSUB(b.x)], 1u);
        const unsigned gen = old / nloc;
        if (old + 1u == (gen + 1u) * nloc) {
            __builtin_amdgcn_fence(__ATOMIC_RELEASE, "agent");
            asm volatile("s_waitcnt vmcnt(0)" ::: "memory");
            const unsigned og = xb_add(&bar[XB_TOP], 1u);
            const unsigned tg = og / nx;
            if (og + 1u == (tg + 1u) * nx) xb_add(&bar[XB_TOPGEN], 1u);
            else XB_SPIN(xb_ld(&bar[XB_TOPGEN]) == tg, bar);
            __builtin_amdgcn_fence(__ATOMIC_ACQUIRE, "agent");
            xb_add(&bar[XB_XGEN(b.x)], 1u);
            asm volatile("s_waitcnt vmcnt(0)" ::: "memory");
        } else {
            XB_SPIN(xb_ld(&bar[XB_XGEN(b.x)]) == gen, bar);
            __builtin_amdgcn_fence(__ATOMIC_ACQUIRE, "agent");
            asm volatile("s_waitcnt vmcnt(0)" ::: "memory");
        }
    }
    __syncthreads();
}
#define MFMA16(a, b, c) __builtin_amdgcn_mfma_f32_16x16x32_bf16((a), (b), (c), 0, 0, 0)
constexpr int RQ = 0, RK = 17408, RKT = 34816, RVT = 53248, RP = 71680, RST = 80896, RO = 115712;
__device__ __forceinline__ void ret_item(const Params& P, LAS unsigned char* lds, int tid, int wave, int lane, int h, int row0, int nchunks, const float* st_in, bool has_in, float* st_out) {
    const bf16* proj = (const bf16*)(P.ws + WS_R1);
    bf16* mix = (bf16*)(P.ws + WS_R2);
    const int fr = lane & 15, fq = lane >> 4;
    const float lg2 = log2f(1.0f - exp2f(-5.0f - (float)h));
    const float kscale = 0.08838834764831845f;
    LAS bf16* Qs = (LAS bf16*)(lds + RQ); LAS bf16* Ks = (LAS bf16*)(lds + RK); LAS bf16* KT = (LAS bf16*)(lds + RKT); LAS bf16* VT = (LAS bf16*)(lds + RVT);
    LAS bf16* Ps = (LAS bf16*)(lds + RP); LAS bf16* ST = (LAS bf16*)(lds + RST); LAS float* Os = (LAS float*)(lds + RO);
    f32x4 st[8];
#pragma unroll
    for (int et = 0; et < 8; ++et) {
        f32x4 v;
#pragma unroll
        for (int r = 0; r < 4; ++r) v[r] = st_in[(size_t)(16 * wave + 4 * fq + r) * 128 + 16 * et + fr];
        asm volatile("" : "+v"(v));
#pragma unroll
        for (int r = 0; r < 4; ++r) v[r] = has_in ? v[r] : 0.f;
        st[et] = v;
    }
    __syncthreads();
#pragma unroll
    for (int et = 0; et < 8; ++et) { u32x2 w; w.x = pk2(st[et][0], st[et][1]); w.y = pk2(st[et][2], st[et][3]); *(LAS u32x2*)(ST + (16 * et + fr) * 136 + 16 * wave + 4 * fq) = w; }
    const size_t goff = (size_t)lane * INW + h * 128 + wave * 16;
    u32x4 pq[2], pk[2], pv[2];
    { const bf16* g = proj + (size_t)row0 * INW + goff;
      pq[0] = *(const u32x4*)(g); pq[1] = *(const u32x4*)(g + 8); pk[0] = *(const u32x4*)(g + 512); pk[1] = *(const u32x4*)(g + 520); pv[0] = *(const u32x4*)(g + 1024); pv[1] = *(const u32x4*)(g + 1032); }
    u32x4 gv0, gv1, gn0, gn1;
    const size_t ggoff = (size_t)(8 * wave + (lane >> 3)) * INW + 1536 + h * 128 + 16 * (lane & 7);
    gn0 = *(const u32x4*)(proj + (size_t)row0 * INW + ggoff); gn1 = *(const u32x4*)(proj + (size_t)row0 * INW + ggoff + 8);
    const float kf = kscale * exp2f(lg2 * (float)(63 - lane));
    const float g64 = exp2f(lg2 * 64.0f);
    for (int c = 0; c < nchunks; ++c) {
        const int rowc = row0 + 64 * c;
        *(LAS u32x4*)(Qs + lane * 136 + wave * 16) = pq[0]; *(LAS u32x4*)(Qs + lane * 136 + wave * 16 + 8) = pq[1];
        *(LAS u32x4*)(Ks + lane * 136 + wave * 16) = pk[0]; *(LAS u32x4*)(Ks + lane * 136 + wave * 16 + 8) = pk[1];
#pragma unroll
        for (int i = 0; i < 2; ++i)
#pragma unroll
            for (int j = 0; j < 4; ++j) { const unsigned wk = pk[i][j], wv = pv[i][j]; const int d = wave * 16 + i * 8 + j * 2;
                const unsigned kk = pk2(bflo(wk) * kf, bfhi(wk) * kf);
                KT[(d) * 72 + lane] = (bf16)(kk & 0xffffu); KT[(d + 1) * 72 + lane] = (bf16)(kk >> 16);
                VT[(d) * 72 + lane] = (bf16)(wv & 0xffffu); VT[(d + 1) * 72 + lane] = (bf16)(wv >> 16); }
        gv0 = gn0; gv1 = gn1;
        if (c + 1 < nchunks) { const bf16* g = proj + (size_t)(rowc + 64) * INW + goff;
            pq[0] = *(const u32x4*)(g); pq[1] = *(const u32x4*)(g + 8); pk[0] = *(const u32x4*)(g + 512); pk[1] = *(const u32x4*)(g + 520); pv[0] = *(const u32x4*)(g + 1024); pv[1] = *(const u32x4*)(g + 1032);
            gn0 = *(const u32x4*)(proj + (size_t)(rowc + 64) * INW + ggoff); gn1 = *(const u32x4*)(proj + (size_t)(rowc + 64) * INW + ggoff + 8); }
        __syncthreads();
        { const int mi = wave >> 1;
#pragma unroll
          for (int jj = 0; jj < 2; ++jj) { const int lj = 2 * (wave & 1) + jj; f32x4 s = (f32x4){0.f, 0.f, 0.f, 0.f};
#pragma unroll
            for (int ks = 0; ks < 4; ++ks) { const bf16x8 a = *(const LAS bf16x8*)(Ks + (16 * mi + fr) * 136 + 32 * ks + 8 * fq), b = *(const LAS bf16x8*)(Qs + (16 * lj + fr) * 136 + 32 * ks + 8 * fq); s = MFMA16(a, b, s); }
            const int l = 16 * lj + fr; float pvv[4];
#pragma unroll
            for (int r = 0; r < 4; ++r) { const int m = 16 * mi + 4 * fq + r; const int dlt = l - m; pvv[r] = dlt >= 0 ? s[r] * kscale * exp2f(lg2 * (float)dlt) : 0.f; }
            u32x2 w; w.x = pk2(pvv[0], pvv[1]); w.y = pk2(pvv[2], pvv[3]); *(LAS u32x2*)(Ps + l * 72 + 16 * mi + 4 * fq) = w; } }
#pragma unroll
        for (int et = 0; et < 8; ++et) st[et] = st[et] * g64;
#pragma unroll
        for (int ks = 0; ks < 2; ++ks) { const bf16x8 a = *(const LAS bf16x8*)(KT + (16 * wave + fr) * 72 + 32 * ks + 8 * fq);
#pragma unroll
            for (int et = 0; et < 8; ++et) { const bf16x8 b = *(const LAS bf16x8*)(VT + (16 * et + fr) * 72 + 32 * ks + 8 * fq); st[et] = MFMA16(a, b, st[et]); } }
        __syncthreads();
        { f32x4 oi[4], oc[4];
#pragma unroll
          for (int lt = 0; lt < 4; ++lt) { oi[lt] = (f32x4){0.f, 0.f, 0.f, 0.f}; oc[lt] = (f32x4){0.f, 0.f, 0.f, 0.f}; }
#pragma unroll
          for (int ks = 0; ks < 2; ++ks) { const bf16x8 b = *(const LAS bf16x8*)(VT + (16 * wave + fr) * 72 + 32 * ks + 8 * fq);
#pragma unroll
            for (int lt = 0; lt < 4; ++lt) { const bf16x8 a = *(const LAS bf16x8*)(Ps + (16 * lt + fr) * 72 + 32 * ks + 8 * fq); oi[lt] = MFMA16(a, b, oi[lt]); } }
#pragma unroll
          for (int ks = 0; ks < 4; ++ks) { const bf16x8 b = *(const LAS bf16x8*)(ST + (16 * wave + fr) * 136 + 32 * ks + 8 * fq);
#pragma unroll
            for (int lt = 0; lt < 4; ++lt) { const bf16x8 a = *(const LAS bf16x8*)(Qs + (16 * lt + fr) * 136 + 32 * ks + 8 * fq); oc[lt] = MFMA16(a, b, oc[lt]); } }
#pragma unroll
          for (int lt = 0; lt < 4; ++lt)
#pragma unroll
            for (int r = 0; r < 4; ++r) { const int l = 16 * lt + 4 * fq + r; Os[l * 132 + 16 * wave + fr] = oi[lt][r] + exp2f(lg2 * (float)(l + 1)) * oc[lt][r]; } }
        __syncthreads();
#pragma unroll
        for (int et = 0; et < 8; ++et) { u32x2 w; w.x = pk2(st[et][0], st[et][1]); w.y = pk2(st[et][2], st[et][3]); *(LAS u32x2*)(ST + (16 * et + fr) * 136 + 16 * wave + 4 * fq) = w; }
        {
          const int l = 8 * wave + (lane >> 3), seg = lane & 7;
          const u32x4 gw0 = gv0, gw1 = gv1;
          const LAS f32x4* op = (const LAS f32x4*)(Os + l * 132 + 16 * seg);
          f32x4 ov[4]; float ssq = 0.f;
#pragma unroll
          for (int k = 0; k < 4; ++k) { ov[k] = op[k]; ssq += (ov[k].x * ov[k].x + ov[k].y * ov[k].y) + (ov[k].z * ov[k].z + ov[k].w * ov[k].w); }
          ssq += __int_as_float(__builtin_amdgcn_update_dpp(__float_as_int(ssq), __float_as_int(ssq), 0xB1, 0xf, 0xf, false));
          ssq += __int_as_float(__builtin_amdgcn_update_dpp(__float_as_int(ssq), __float_as_int(ssq), 0x4E, 0xf, 0xf, false));
          ssq += __int_as_float(__builtin_amdgcn_update_dpp(__float_as_int(ssq), __float_as_int(ssq), 0x141, 0xf, 0xf, false));
          const float rstd = __builtin_amdgcn_rsqf(ssq * (1.f / 128.f) + EPS);
          bf16* mp = mix + (size_t)(rowc + l) * DM + h * 128 + 16 * seg;
#pragma unroll
          for (int hf = 0; hf < 2; ++hf) {
              float gf[8]; unpack8(hf ? gw1 : gw0, gf);
              u32x4 w;
#pragma unroll
              for (int k = 0; k < 2; ++k) { const f32x4 o4 = ov[2 * hf + k];
                  w[2 * k] = pk2(silu_f(gf[4 * k]) * (o4.x * rstd), silu_f(gf[4 * k + 1]) * (o4.y * rstd)); w[2 * k + 1] = pk2(silu_f(gf[4 * k + 2]) * (o4.z * rstd), silu_f(gf[4 * k + 3]) * (o4.w * rstd)); }
              *(u32x4*)(mp + 8 * hf) = w;
              asm volatile("" ::: "memory");
          }
        }
    }
#pragma unroll
    for (int et = 0; et < 8; ++et)
#pragma unroll
        for (int r = 0; r < 4; ++r) st_out[(size_t)(16 * wave + 4 * fq + r) * 128 + 16 * et + fr] = st[et][r];
}
constexpr int AK = 0, AVT = 27648;
__device__ __forceinline__ void att_item(const Params& P, LAS unsigned char* lds, int tid, int wave, int lane, bool sample, int b, int n, int g) {
    const bf16* proj = (const bf16*)(P.ws + WS_R1);
    bf16* mix = (bf16*)(P.ws + WS_R2);
    const int fr = lane & 15, fq = lane >> 4;
    LAS bf16* Kl = (LAS bf16*)(lds + AK); LAS bf16* VTl = (LAS bf16*)(lds + AVT);
    const int qrow0 = sample ? MP + 64 * b : b * SEQ + 64 * n;
    const int jmin = sample ? 0 : (n >= 2 ? 0 : 64 * (2 - n));
    __syncthreads();
    bf16x8 qa[2][2];
    { const int hd_ = 4 * g + (wave >> 1), qh_ = wave & 1;
#pragma unroll
      for (int qt = 0; qt < 2; ++qt)
#pragma unroll
        for (int ks = 0; ks < 2; ++ks) qa[qt][ks] = *(const bf16x8*)(proj + (size_t)(qrow0 + 32 * qh_ + 16 * qt + fr) * INW + 2048 + hd_ * 64 + 32 * ks + 8 * fq); }
    {
        u32x4 kw[3], vw[3];
        if (!sample) {
#pragma unroll
            for (int i = 0; i < 3; ++i) { const bool ok = 64 * i >= jmin;
                const int rb = ok ? b * SEQ + 64 * (n - 2) + 64 * i : qrow0;
                kw[i] = *(const u32x4*)(proj + (size_t)(rb + (tid >> 3)) * INW + 2560 + g * 64 + 8 * (tid & 7));
                vw[i] = *(const u32x4*)(proj + (size_t)(rb + lane) * INW + 2688 + g * 64 + 8 * wave);
                if (!ok) { kw[i] = (u32x4){0u, 0u, 0u, 0u}; vw[i] = (u32x4){0u, 0u, 0u, 0u}; } }
        } else {
            f32x4 kc[2][2], vc[2][2];
#pragma unroll
            for (int i = 0; i < 2; ++i) { const float* sk = P.cache_k + ((size_t)(b * 128 + 64 * i + (tid >> 3)) * 2 + g) * 64 + 8 * (tid & 7); const float* sv = P.cache_v + ((size_t)(b * 128 + 64 * i + lane) * 2 + g) * 64 + 8 * wave;
                kc[i][0] = *(const f32x4*)sk; kc[i][1] = *(const f32x4*)(sk + 4); vc[i][0] = *(const f32x4*)sv; vc[i][1] = *(const f32x4*)(sv + 4); }
            kw[2] = *(const u32x4*)(proj + (size_t)(MP + 64 * b + (tid >> 3)) * INW + 2560 + g * 64 + 8 * (tid & 7));
            vw[2] = *(const u32x4*)(proj + (size_t)(MP + 64 * b + lane) * INW + 2688 + g * 64 + 8 * wave);
#pragma unroll
            for (int i = 0; i < 2; ++i) { kw[i].x = pk2(kc[i][0].x, kc[i][0].y); kw[i].y = pk2(kc[i][0].z, kc[i][0].w); kw[i].z = pk2(kc[i][1].x, kc[i][1].y); kw[i].w = pk2(kc[i][1].z, kc[i][1].w);
                vw[i].x = pk2(vc[i][0].x, vc[i][0].y); vw[i].y = pk2(vc[i][0].z, vc[i][0].w); vw[i].z = pk2(vc[i][1].x, vc[i][1].y); vw[i].w = pk2(vc[i][1].z, vc[i][1].w); }
        }
#pragma unroll
        for (int i = 0; i < 3; ++i) { *(LAS u32x4*)(Kl + (64 * i + (tid >> 3)) * 72 + 8 * (tid & 7)) = kw[i];
            const int j = 64 * i + lane;
#pragma unroll
            for (int e = 0; e < 4; ++e) { VTl[(8 * wave + 2 * e) * 200 + j] = (bf16)(vw[i][e] & 0xffffu); VTl[(8 * wave + 2 * e + 1) * 200 + j] = (bf16)(vw[i][e] >> 16); } }
    }
    const int r = wave >> 1, qh = wave & 1, head = 4 * g + r;
    const float nb8 = -8.0f * exp2f(-(float)(head + 1));
    const float sink8 = 8.0f * P.sinks[head];
    const float c1 = 0.125f * 1.4426950408889634f;
    __syncthreads();
#pragma unroll 1
    for (int qt = 0; qt < 2; ++qt) {
        asm volatile("" ::: "memory");
        const int qi = 32 * qh + 16 * qt + fr;
        bf16x8 qf[2];
#pragma unroll
        for (int ks = 0; ks < 2; ++ks) { const u32x4 x0 = __builtin_bit_cast(u32x4, qa[0][ks]), x1 = __builtin_bit_cast(u32x4, qa[1][ks]); u32x4 xs;
#pragma unroll
            for (int e = 0; e < 4; ++e) xs[e] = qt ? x1[e] : x0[e];
            qf[ks] = __builtin_bit_cast(bf16x8, xs); }
        const float basef = (float)(128 + qi - 4 * fq);
        f32x4 s[12];
#pragma unroll
        for (int kt = 0; kt < 12; ++kt) {
#pragma unroll
            for (int rr = 0; rr < 4; ++rr) s[kt][rr] = fabsf(basef - (float)(16 * kt + rr)) * nb8;
#pragma unroll
            for (int ks = 0; ks < 2; ++ks) { const bf16x8 a = *(const LAS bf16x8*)(Kl + (16 * kt + fr) * 72 + 32 * ks + 8 * fq); s[kt] = MFMA16(a, qf[ks], s[kt]); } }
        if (jmin > 0) {
#pragma unroll
            for (int kt = 0; kt < 12; ++kt)
#pragma unroll
                for (int rr = 0; rr < 4; ++rr) s[kt][rr] = (16 * kt + 4 * fq + rr) >= jmin ? s[kt][rr] : -INFINITY;
        }
        float mx = sink8;
#pragma unroll
        for (int kt = 0; kt < 12; ++kt)
#pragma unroll
            for (int rr = 0; rr < 4; ++rr) mx = fmaxf(mx, s[kt][rr]);
        mx = fmaxf(mx, __shfl_xor(mx, 16)); mx = fmaxf(mx, __shfl_xor(mx, 32));
        const float mxc = mx * c1;
        float ls = 0.f;
#pragma unroll
        for (int kt = 0; kt < 12; ++kt)
#pragma unroll
            for (int rr = 0; rr < 4; ++rr) { const float p = __builtin_amdgcn_exp2f(s[kt][rr] * c1 - mxc); s[kt][rr] = p; ls += p; }
        ls += __shfl_xor(ls, 16); ls += __shfl_xor(ls, 32);
        const float inv = 1.0f / (ls + __builtin_amdgcn_exp2f(sink8 * c1 - mxc));
        f32x4 o[4];
#pragma unroll
        for (int dt = 0; dt < 4; ++dt) o[dt] = (f32x4){0.f, 0.f, 0.f, 0.f};
#pragma unroll
        for (int kk = 0; kk < 6; ++kk) {
            u32x4 w; w.x = pk2(s[2 * kk][0], s[2 * kk][1]); w.y = pk2(s[2 * kk][2], s[2 * kk][3]); w.z = pk2(s[2 * kk + 1][0], s[2 * kk + 1][1]); w.w = pk2(s[2 * kk + 1][2], s[2 * kk + 1][3]);
            const bf16x8 pb = __builtin_bit_cast(bf16x8, w);
#pragma unroll
            for (int dt = 0; dt < 4; ++dt) { const LAS bf16* vp = VTl + (16 * dt + fr) * 200 + 32 * kk + 4 * fq;
                const u32x2 lo = *(const LAS u32x2*)vp, hi = *(const LAS u32x2*)(vp + 16);
                const u32x4 aw = (u32x4){lo.x, lo.y, hi.x, hi.y}; const bf16x8 a = __builtin_bit_cast(bf16x8, aw);
                o[dt] = MFMA16(a, pb, o[dt]); }
        }
        bf16* mp = mix + (size_t)(qrow0 + qi) * DM + 512 + head * 64 + 4 * fq;
#pragma unroll
        for (int dt = 0; dt < 4; ++dt) { const f32x4 v = o[dt] * inv; u32x2 w; w.x = pk2(v[0], v[1]); w.y = pk2(v[2], v[3]); *(u32x2*)(mp + 16 * dt) = w; }
    }
}
__device__ __forceinline__ void phase3(const Params& P, LAS unsigned char* lds, int tid, int wave, int lane) {
    const int G = gridDim.x, NR = G / 2, blk = blockIdx.x;
    {
        const bool sample = blk >= NR; const int bh = (sample ? blk - NR : blk) & 127, b = bh >> 2, h = bh & 3;
        if (blk < 2 * NR && (sample ? blk - NR : blk) < 128)
            ret_item(P, lds, tid, wave, lane, h, sample ? MP + 64 * b : b * SEQ, sample ? 1 : 32, P.state_ret + (size_t)bh * 16384, sample, P.out + (sample ? OFF_SRET : OFF_PRET) + (size_t)bh * 16384);
    }
    if (blk >= NR) {
        for (int it = blk - NR; it < 2112; it += G - NR) {
            const bool sample = it >= 2048;
            att_item(P, lds, tid, wave, lane, sample, sample ? (it - 2048) >> 1 : it >> 6, sample ? 2 : (it >> 1) & 31, it & 1);
        }
    }
}

__device__ __forceinline__ void phase6(const Params& P, int tid) {
    const bf16* ua = (const bf16*)(P.ws + WS_R1); bf16* ub = (bf16*)(P.ws + WS_R2);
    constexpr int CH = DFF / 8;
    const int total = MT * CH;
    for (int idx = blockIdx.x * 512 + tid; idx < total; idx += gridDim.x * 512) {
        const int row = idx / CH, j = (idx - row * CH) * 8;
        const bool smp = row >= MP; const int t = smp ? ((row - MP) & 63) : (row & 2047);
        float a[8], p1[8], p2[8], bb[8];
        unpack8(*(const u32x4*)(ua + (size_t)row * DFF + j), a);
        unpack8(*(const u32x4*)(ub + (size_t)row * DFF + j), bb);
        if (t >= 1) unpack8(*(const u32x4*)(ua + (size_t)(row - 1) * DFF + j), p1);
        else if (smp) { const float* s = P.state_conv + ((size_t)((row - MP) >> 6) * 2 + 1) * DFF + j; const f32x4 x = *(const f32x4*)s, y = *(const f32x4*)(s + 4); p1[0] = x.x; p1[1] = x.y; p1[2] = x.z; p1[3] = x.w; p1[4] = y.x; p1[5] = y.y; p1[6] = y.z; p1[7] = y.w; }
        else {
#pragma unroll
            for (int e = 0; e < 8; ++e) p1[e] = 0.f; }
        if (t >= 2) unpack8(*(const u32x4*)(ua + (size_t)(row - 2) * DFF + j), p2);
        else if (smp) { const float* s = P.state_conv + ((size_t)((row - MP) >> 6) * 2 + t) * DFF + j; const f32x4 x = *(const f32x4*)s, y = *(const f32x4*)(s + 4); p2[0] = x.x; p2[1] = x.y; p2[2] = x.z; p2[3] = x.w; p2[4] = y.x; p2[5] = y.y; p2[6] = y.z; p2[7] = y.w; }
        else {
#pragma unroll
            for (int e = 0; e < 8; ++e) p2[e] = 0.f; }
        float r[8];
#pragma unroll
        for (int h = 0; h < 2; ++h) { const f32x4 w0 = *(const f32x4*)(P.conv_w + j + 4 * h), w1 = *(const f32x4*)(P.conv_w + DFF + j + 4 * h), w2 = *(const f32x4*)(P.conv_w + 2 * DFF + j + 4 * h), cb = *(const f32x4*)(P.conv_b + j + 4 * h);
#pragma unroll
            for (int e = 0; e < 4; ++e) { const float cv = cb[e] + w0[e] * p2[4 * h + e] + w1[e] * p1[4 * h + e] + w2[e] * a[4 * h + e]; r[4 * h + e] = silu_f(cv) * bb[4 * h + e]; } }
        u32x4 w; w.x = pk2(r[0], r[1]); w.y = pk2(r[2], r[3]); w.z = pk2(r[4], r[5]); w.w = pk2(r[6], r[7]);
        *(u32x4*)(ub + (size_t)row * DFF + j) = w;
    }
}
#ifdef CONV_FUSED
__device__ __forceinline__ void phase6c(const Params& P, int tid) {
    const float* headA = (const float*)(P.ws + WS_R1); const float* headB = headA + HT_STRIDE; const float* tailA = headA + 2 * HT_STRIDE;
    bf16* act = (bf16*)(P.ws + WS_R2);
    constexpr int CH = DFF / 4;
    const int total = NGRP * CH;
    for (int idx = blockIdx.x * 512 + tid; idx < total; idx += gridDim.x * 512) {
        const int g = idx / CH, j = (idx - g * CH) * 4;
        const bool smp = g >= 1024, first = !smp && (g & 31) == 0;
        const float* pp = smp ? P.state_conv + ((size_t)(g - 1024) * 2) * DFF + j : tailA + ((size_t)(first ? g : g - 1) * 2) * DFF + j;
        f32x4 p0 = *(const f32x4*)pp, p1 = *(const f32x4*)(pp + DFF);
        const f32x4 a0 = *(const f32x4*)(headA + ((size_t)g * 2) * DFF + j), a1 = *(const f32x4*)(headA + ((size_t)g * 2 + 1) * DFF + j);
        const f32x4 b0 = *(const f32x4*)(headB + ((size_t)g * 2) * DFF + j), b1 = *(const f32x4*)(headB + ((size_t)g * 2 + 1) * DFF + j);
        const f32x4 t0 = *(const f32x4*)(tailA + ((size_t)g * 2) * DFF + j), t1 = *(const f32x4*)(tailA + ((size_t)g * 2 + 1) * DFF + j);
        const f32x4 w0 = *(const f32x4*)(P.conv_w + j), w1 = *(const f32x4*)(P.conv_w + DFF + j), w2 = *(const f32x4*)(P.conv_w + 2 * DFF + j), cb = *(const f32x4*)(P.conv_b + j);
        if (first) { p0 = (f32x4){0.f, 0.f, 0.f, 0.f}; p1 = (f32x4){0.f, 0.f, 0.f, 0.f}; }
        const f32x4 c0 = cb + w0 * p0 + w1 * p1 + w2 * a0, c1 = cb + w0 * p1 + w1 * a0 + w2 * a1;
        u32x2 r0, r1;
        r0.x = pk2(silu_f(c0.x) * b0.x, silu_f(c0.y) * b0.y); r0.y = pk2(silu_f(c0.z) * b0.z, silu_f(c0.w) * b0.w);
        r1.x = pk2(silu_f(c1.x) * b1.x, silu_f(c1.y) * b1.y); r1.y = pk2(silu_f(c1.z) * b1.z, silu_f(c1.w) * b1.w);
        *(u32x2*)(act + (size_t)(64 * g) * DFF + j) = r0;
        *(u32x2*)(act + (size_t)(64 * g + 1) * DFF + j) = r1;
        if (smp) { float* d = P.out + OFF_SCONV + ((size_t)(g - 1024) * 2) * DFF + j; *(f32x4*)d = t0; *(f32x4*)(d + DFF) = t1; }
        else if ((g & 31) == 31) { float* d = P.out + OFF_PCONV + ((size_t)(g >> 5) * 2) * DFF + j; *(f32x4*)d = t0; *(f32x4*)(d + DFF) = t1; }
    }
}
#endif
__device__ __forceinline__ void phase8n(const Params& P, LAS unsigned char* lds, int tid, int wave, int lane) {
    const float* mod = (const float*)(P.ws + WS_MOD); const bf16* x2 = (const bf16*)(P.ws + WS_R0);
    LAS float* lv = (LAS float*)lds;
    const int b = blockIdx.x, bsP = b >> 3, bsS = 32 + (b >> 3);
    __syncthreads();
    for (int i = tid; i < 4096; i += 512) { const int sl = i >> 11, which = (i >> 10) & 1, col = i & 1023; const float* mb = mod + (size_t)(sl ? bsS : bsP) * 8192 + 6144;
        lv[i] = which ? P.normf[col] * (1.f + mb[1024 + col]) : mb[col]; }
    __syncthreads();
#pragma unroll 4
    for (int r = wave; r < 256; r += 8) {
        const int row = 256 * b + r;
        const bf16* xr = x2 + (size_t)row * DM + 4 * lane;
        f32x4 v[4]; float ss = 0.f;
#pragma unroll
        for (int j = 0; j < 4; ++j) { const u32x2 w = *(const u32x2*)(xr + 256 * j); v[j] = (f32x4){bflo(w.x), bfhi(w.x), bflo(w.y), bfhi(w.y)};
            ss += (v[j].x * v[j].x + v[j].y * v[j].y) + (v[j].z * v[j].z + v[j].w * v[j].w); }
        const float rstd = __builtin_amdgcn_rsqf(wave_sum_dpp(ss) * (1.f / DM) + EPS);
        float* yr = P.out + (size_t)row * DM + 4 * lane;
#pragma unroll
        for (int j = 0; j < 4; ++j) { const f32x4 sh = *(const LAS f32x4*)(lv + 256 * j + 4 * lane), gs = *(const LAS f32x4*)(lv + 1024 + 256 * j + 4 * lane);
            *(f32x4*)(yr + 256 * j) = v[j] * rstd * gs + sh; }
    }
    {
        const int r = 8 * b + wave, row = MP + r;
        const bf16* xr = (const bf16*)(P.ws + WS_X1B) + (size_t)row * DM + 4 * lane;
        const float* sl = (const float*)(P.ws + WS_SLAB) + (size_t)r * DM + 4 * lane;
        const float* g2 = mod + (size_t)bsS * 8192 + 5120 + 4 * lane;
        f32x4 v[4]; float ss = 0.f;
#pragma unroll
        for (int j = 0; j < 4; ++j) { const u32x2 w = *(const u32x2*)(xr + 256 * j); f32x4 a = *(const f32x4*)(sl + 256 * j);
#pragma unroll
            for (int p = 1; p < 4; ++p) a += *(const f32x4*)(sl + (size_t)p * MS * DM + 256 * j);
            v[j] = (f32x4){bflo(w.x), bfhi(w.x), bflo(w.y), bfhi(w.y)} + *(const f32x4*)(g2 + 256 * j) * a;
            ss += (v[j].x * v[j].x + v[j].y * v[j].y) + (v[j].z * v[j].z + v[j].w * v[j].w); }
        const float rstd = __builtin_amdgcn_rsqf(wave_sum_dpp(ss) * (1.f / DM) + EPS);
        float* yr = P.out + (size_t)row * DM + 4 * lane;
#pragma unroll
        for (int j = 0; j < 4; ++j) { const f32x4 sh = *(const LAS f32x4*)(lv + 2048 + 256 * j + 4 * lane), gs = *(const LAS f32x4*)(lv + 3072 + 256 * j + 4 * lane);
            *(f32x4*)(yr + 256 * j) = v[j] * rstd * gs + sh; }
    }
}
__device__ __forceinline__ void phase8(const Params& P, int wave, int lane) {
    const float* mod = (const float*)(P.ws + WS_MOD); const bf16* x2 = (const bf16*)(P.ws + WS_R0);
    const int gw = blockIdx.x * 8 + wave, NGW = gridDim.x * 8;
#pragma unroll 2
    for (int row = gw; row < MT; row += NGW) {
        const int bs = row < MP ? (row >> 11) : 32 + ((row - MP) >> 6);
        float* yr = P.out + (size_t)row * DM + 8 * lane;
        const float* mb = mod + (size_t)bs * 8192 + 6144 + 8 * lane;
        float v[2][8]; float ss = 0.f;
        if (row < MP) {
            const bf16* xr = x2 + (size_t)row * DM + 8 * lane;
#pragma unroll
            for (int j = 0; j < 2; ++j) unpack8(*(const u32x4*)(xr + 512 * j), v[j]);
        } else {
            const bf16* xr = (const bf16*)(P.ws + WS_X1B) + (size_t)row * DM + 8 * lane;
            const float* sl = (const float*)(P.ws + WS_SLAB) + (size_t)(row - MP) * DM + 8 * lane;
            const float* g2 = mod + (size_t)bs * 8192 + 5120 + 8 * lane;
#pragma unroll
            for (int j = 0; j < 2; ++j) { unpack8(*(const u32x4*)(xr + 512 * j), v[j]);
#pragma unroll
                for (int h = 0; h < 2; ++h) { const int o = 512 * j + 4 * h; f32x4 a = *(const f32x4*)(sl + o);
#pragma unroll
                    for (int p = 1; p < 4; ++p) a += *(const f32x4*)(sl + (size_t)p * MS * DM + o);
                    const f32x4 g = *(const f32x4*)(g2 + o);
#pragma unroll
                    for (int e = 0; e < 4; ++e) v[j][4 * h + e] += g[e] * a[e]; } }
        }
#pragma unroll
        for (int j = 0; j < 2; ++j)
#pragma unroll
            for (int e = 0; e < 8; ++e) ss += v[j][e] * v[j][e];
        const float rstd = rsqrtf(wave_sum(ss) * (1.f / DM) + EPS);
#pragma unroll
        for (int j = 0; j < 2; ++j)
#pragma unroll
            for (int h = 0; h < 2; ++h) { const int o = 512 * j + 4 * h; const f32x4 sh = *(const f32x4*)(mb + o), sc = *(const f32x4*)(mb + 1024 + o), gn = *(const f32x4*)(P.normf + 8 * lane + o);
                const f32x4 x = (f32x4){v[j][4 * h], v[j][4 * h + 1], v[j][4 * h + 2], v[j][4 * h + 3]};
                *(f32x4*)(yr + o) = x * rstd * gn * (sc + 1.0f) + sh; }
    }
}
__device__ __forceinline__ void phase8q(const Params& P, LAS unsigned char* lds, int tid, int wave, int lane) {
    const float* mod = (const float*)(P.ws + WS_MOD);
    unsigned* cnt = (unsigned*)(P.ws + WS_CNT7); unsigned* ticket = (unsigned*)(P.ws + WS_TICKET);
    LAS int* ord = (LAS int*)(lds + 131072);
    LAS int* flag = ord + 272;
    pg8::StaticOrder S; S.init(MT, DM, (int)gridDim.x, 0);
    for (int i = tid; i < NTM; i += 512) flag[i] = 0;
    __syncthreads();
    { const int full = (S.nwg / S.G) * S.G; for (int L = full + tid; L < S.nwg; L += 512) { pg8::Unit u; S.map(L, u); flag[u.pm] = 1; } }
    __syncthreads();
    if (tid == 0) { int k = 0; for (int i = 0; i < NTM; ++i) if (!flag[i]) ord[k++] = i; for (int i = 0; i < NTM; ++i) if (flag[i]) ord[k++] = i; }
    __syncthreads();
    for (;;) {
        if (tid == 0) flag[268] = (int)__hip_atomic_fetch_add(ticket, 1u, __ATOMIC_RELAXED, __HIP_MEMORY_SCOPE_AGENT);
        __syncthreads();
        const int tk = flag[268];
        if (tk >= NTM * 4) break;
        const int pm = ord[tk >> 2], rb = tk & 3;
        if (wave == 0) {
            unsigned spins = 0;
            while ((unsigned)__builtin_amdgcn_readfirstlane(__hip_atomic_load(cnt + 64 * pm, __ATOMIC_RELAXED, __HIP_MEMORY_SCOPE_AGENT)) < 32u) { __builtin_amdgcn_s_sleep(4); if (++spins > (1u << 22)) break; }
            __builtin_amdgcn_fence(__ATOMIC_ACQUIRE, "agent");
            asm volatile("s_waitcnt vmcnt(0)" ::: "memory");
        }
        __syncthreads();
#pragma unroll 2
        for (int i = 0; i < 8; ++i) {
            const int row = pm * 256 + rb * 64 + wave * 8 + i;
            const int bs = row < MP ? (row >> 11) : 32 + ((row - MP) >> 6);
            float* yr = P.out + (size_t)row * DM + 4 * lane;
            const float* mb = mod + (size_t)bs * 8192 + 6144 + 4 * lane;
            f32x4 v[4]; float ss = 0.f;
#pragma unroll
            for (int j = 0; j < 4; ++j) { v[j] = *(const f32x4*)(yr + 256 * j); ss += (v[j].x * v[j].x + v[j].y * v[j].y) + (v[j].z * v[j].z + v[j].w * v[j].w); }
            const float rstd = rsqrtf(wave_sum(ss) * (1.f / DM) + EPS);
#pragma unroll
            for (int j = 0; j < 4; ++j) { const f32x4 sh = *(const f32x4*)(mb + 256 * j), sc = *(const f32x4*)(mb + 1024 + 256 * j), gn = *(const f32x4*)(P.normf + 4 * lane + 256 * j);
                *(f32x4*)(yr + 256 * j) = v[j] * rstd * gn * (sc + 1.0f) + sh; }
        }
    }
}

__device__ __forceinline__ void sample_fix(const Params& P, int wave, int lane) {
    const float* mod = (const float*)(P.ws + WS_MOD); const float* sl0 = (const float*)(P.ws + WS_SLAB4);
    bf16* a2 = (bf16*)(P.ws + WS_R0); bf16* x1b = (bf16*)(P.ws + WS_X1B); float* ss1 = (float*)(P.ws + WS_SS1);
    const int gw = blockIdx.x * 8 + wave, NGW = gridDim.x * 8;
    for (int r = gw; r < MS; r += NGW) {
        const int row = MP + r, bs = 32 + (r >> 6);
        const float* xr = P.x_s + (size_t)r * DM + 8 * lane; const float* sl = sl0 + (size_t)r * DM + 8 * lane; const float* mb = mod + (size_t)bs * 8192 + 8 * lane;
        float v[2][8], a[2][8]; float ss = 0.f;
#pragma unroll
        for (int j = 0; j < 2; ++j)
#pragma unroll
            for (int h = 0; h < 2; ++h) { const int o = 512 * j + 4 * h; f32x4 acc = *(const f32x4*)(sl + o);
#pragma unroll
                for (int p = 1; p < 4; ++p) acc += *(const f32x4*)(sl + (size_t)p * MS * DM + o);
                const f32x4 x = *(const f32x4*)(xr + o) + *(const f32x4*)(mb + 2048 + o) * acc;
                const f32x4 gs = *(const f32x4*)(P.ln2 + 8 * lane + o) * (*(const f32x4*)(mb + 4096 + o) + 1.0f);
#pragma unroll
                for (int e = 0; e < 4; ++e) { v[j][4 * h + e] = x[e]; a[j][4 * h + e] = x[e] * gs[e]; ss += x[e] * x[e]; } }
        ss = wave_sum(ss);
#pragma unroll
        for (int j = 0; j < 2; ++j) { u32x4 w; w.x = pk2(v[j][0], v[j][1]); w.y = pk2(v[j][2], v[j][3]); w.z = pk2(v[j][4], v[j][5]); w.w = pk2(v[j][6], v[j][7]);
            *(u32x4*)(x1b + (size_t)row * DM + 8 * lane + 512 * j) = w;
            w.x = pk2(a[j][0], a[j][1]); w.y = pk2(a[j][2], a[j][3]); w.z = pk2(a[j][4], a[j][5]); w.w = pk2(a[j][6], a[j][7]);
            *(u32x4*)(a2 + (size_t)row * DM + 8 * lane + 512 * j) = w; }
        if (lane < 16) ss1[(size_t)row * 16 + lane] = lane == 0 ? ss : 0.f;
    }
}

#ifndef N_LAUNCH
#define N_LAUNCH 1
#endif
#define LAUNDER_TID() int tid = threadIdx.x; asm volatile("" : "+v"(tid)); const int lane = tid & 63, wave = __builtin_amdgcn_readfirstlane(tid >> 6); (void)lane; (void)wave
template <int PHM>
__global__ void __launch_bounds__(512) fwd_mega(Params P) {
    extern __shared__ __attribute__((aligned(16))) unsigned char lds_raw[];
    LAS unsigned char* lds = (LAS unsigned char*)lds_raw;
    const int G = gridDim.x;
    unsigned char* ws = P.ws;
    volatile LAS unsigned* misc = (volatile LAS unsigned*)(lds + LDS_MISC);
    if (threadIdx.x < 2) misc[threadIdx.x] = 0u;
    __syncthreads();
    XcdBarrier bar; bar.bar = (unsigned*)(ws + WS_BAR); bar.x = 0; bar.st = misc;
#define GSYNC(a, b) do { if ((PHM & (a)) && (PHM & (b))) xcd_barrier(bar); } while (0)
    if constexpr (PHM == 511) {
      if (blockIdx.x == 0) for (int i = threadIdx.x; i < XCD_BAR_WORDS; i += 512) ((unsigned*)(ws + WS_BAR))[i] = 0u;
      if (blockIdx.x == 1) { for (int i = threadIdx.x; i < NTM * 64; i += 512) ((unsigned*)(ws + WS_CNT7))[i] = 0u; if (threadIdx.x < 64) ((unsigned*)(ws + WS_TICKET))[threadIdx.x] = 0u; }
      cg::this_grid().sync();
      bar = xcd_barrier_post((unsigned*)(ws + WS_BAR), misc); }
    if constexpr ((PHM & 1) != 0) { LAUNDER_TID(); phase0(P, lds, wave, lane); }
    GSYNC(1, 2);
    if constexpr ((PHM & 2) != 0) { LAUNDER_TID(); phase1(P, lds, tid, wave, lane); }
    GSYNC(2, 4);
    if constexpr ((PHM & 4) != 0) {
      pg8::Gemm g{(const bf16*)(ws + WS_R0), (const bf16*)(ws + WS_WIN), MT, INW, DM};
      OrderX S; S.S.init(MT, INW, G, (int)blockIdx.x); S.nX = 22; S.xpm = NTM; S.xpn0 = 11;
      Epi1 E{(bf16*)(ws + WS_R1), (float*)(ws + WS_SHW), P.out};
      pg8::gemm_phase<Epi1, OrderX, true, true>(lds, g, S, E); }
    GSYNC(4, 8);
    if constexpr ((PHM & 8) != 0) { LAUNDER_TID(); phase3(P, lds, tid, wave, lane);
#ifdef PROBE_P3X2
      cg::this_grid().sync(); phase3(P, lds, tid, wave, lane);
#endif
    }
    GSYNC(8, 16);
    if constexpr ((PHM & 16) != 0) {
      pg8::Gemm g{(const bf16*)(ws + WS_R2), (const bf16*)(ws + WS_WOUT), MT, DM, DM};
      OrderDown S; S.S.init(MP, DM, G, (int)blockIdx.x); S.ka = 4; S.kb = 4;
      Epi2 E{P.x_p, P.x_s, (const float*)(ws + WS_MOD), P.ln2, (bf16*)(ws + WS_X1B), (bf16*)(ws + WS_R0), (float*)(ws + WS_SS1), (float*)(ws + WS_SLAB4)};
      pg8::gemm_phase<Epi2, OrderDown, true, true>(lds, g, S, E); }
    GSYNC(16, 32);
    if constexpr ((PHM & 32) != 0) {
      LAUNDER_TID();
      sample_fix(P, wave, lane);
      if constexpr (PHM == 511) xcd_barrier(bar);
      pg8::Gemm g{(const bf16*)(ws + WS_R0), (const bf16*)(ws + WS_WUP), MT, 2 * DFF, DM};
      pg8::StaticOrder S; S.init(MT, 2 * DFF, G, (int)blockIdx.x);
      LAS float* rtab = (LAS float*)(lds + 131072);
      {
        LAS int* pmt = (LAS int*)lds;
        if (tid < 24) { pg8::Unit u; const bool ok = S.next(tid, u); pmt[tid] = ok ? u.pm : -1; }
        __syncthreads();
        if (tid < 256) { const float* ss = (const float*)(ws + WS_SS1);
#pragma unroll
          for (int i0 = 0; i0 < 24; i0 += 6) {
            f32x4 q[6][4]; int pmv[6];
#pragma unroll
            for (int k = 0; k < 6; ++k) { pmv[k] = pmt[i0 + k]; const f32x4* sp = (const f32x4*)(ss + (size_t)((pmv[k] < 0 ? 0 : pmv[k]) * 256 + tid) * 16);
#pragma unroll
                for (int e = 0; e < 4; ++e) q[k][e] = sp[e]; }
#pragma unroll
            for (int k = 0; k < 6; ++k) { const float tot = ((q[k][0].x + q[k][0].y) + (q[k][0].z + q[k][0].w)) + ((q[k][1].x + q[k][1].y) + (q[k][1].z + q[k][1].w)) + ((q[k][2].x + q[k][2].y) + (q[k][2].z + q[k][2].w)) + ((q[k][3].x + q[k][3].y) + (q[k][3].z + q[k][3].w));
                rtab[(i0 + k) * 256 + tid] = __builtin_amdgcn_rsqf(tot * (1.f / DM) + EPS); } } }
        __syncthreads(); }
#ifdef CONV_FUSED
      float* hA = (float*)(ws + WS_R1);
      Epi3C E{rtab, (const float*)(ws + WS_SHW), P.conv_w, P.conv_b, (bf16*)(ws + WS_R2), hA, hA + HT_STRIDE, hA + 2 * HT_STRIDE};
      pg8::gemm_phase<Epi3C, pg8::StaticOrder, true, true>(lds, g, S, E);
#else
      Epi3 E{rtab, (const float*)(ws + WS_SHW), (bf16*)(ws + WS_R1), (bf16*)(ws + WS_R2), P.out};
      pg8::gemm_phase<Epi3, pg8::StaticOrder, true, true>(lds, g, S, E);
#endif
#ifdef PROBE_P5X2
      cg::this_grid().sync(); pg8::gemm_phase<Epi3, pg8::StaticOrder, true, true>(lds, g, S, E);
#endif
    }
    GSYNC(32, 64);
#ifdef CONV_FUSED
    if constexpr ((PHM & 64) != 0) { LAUNDER_TID(); phase6c(P, tid); }
#else
    if constexpr ((PHM & 64) != 0) { LAUNDER_TID(); phase6(P, tid); }
#endif
    GSYNC(64, 128);
    if constexpr ((PHM & 128) != 0) {
      pg8::Gemm g{(const bf16*)(ws + WS_R2), (const bf16*)(ws + WS_WDN), MT, DM, DFF};
#ifdef P8_QUEUE
      OrderPub S; S.init(MT, DM, G, (int)blockIdx.x); S.cnt = (unsigned*)(ws + WS_CNT7);
      Epi4 E{(const float*)(ws + WS_MOD), (const bf16*)(ws + WS_X1B), (bf16*)(ws + WS_R0), (float*)(ws + WS_SLAB)};
      pg8::gemm_phase<Epi4, OrderPub, true, true>(lds, g, S, E); }
    if constexpr ((PHM & 256) != 0) { LAUNDER_TID(); phase8q(P, lds, tid, wave, lane); }
#else
      OrderDown S; S.S.init(MP, DM, G, (int)blockIdx.x); S.ka = 12; S.kb = 10;
      Epi4 E{(const float*)(ws + WS_MOD), (const bf16*)(ws + WS_X1B), (bf16*)(ws + WS_R0), (float*)(ws + WS_SLAB)};
      pg8::gemm_phase<Epi4, OrderDown, true, true>(lds, g, S, E); }
    GSYNC(128, 256);
    if constexpr ((PHM & 256) != 0) { LAUNDER_TID(); if (gridDim.x == 256) phase8n(P, lds, tid, wave, lane); else phase8(P, wave, lane); }
#endif
}

template <int PHM> static bool launch_one(const Params& p, int grid, bool coop, hipStream_t stream) {
    static bool attr_done = false;
    if (!attr_done) { if (hipFuncSetAttribute((const void*)fwd_mega<PHM>, hipFuncAttributeMaxDynamicSharedMemorySize, LDS_BYTES) != hipSuccess) { fprintf(stderr, "kernel_launch: hipFuncSetAttribute failed\n"); return false; } attr_done = true; }
    hipError_t e;
    if (coop) { Params pc = p; void* args[] = {&pc}; e = hipLaunchCooperativeKernel((const void*)fwd_mega<PHM>, dim3(grid), dim3(512), args, LDS_BYTES, stream); }
    else { hipLaunchKernelGGL(fwd_mega<PHM>, dim3(grid), dim3(512), LDS_BYTES, stream, p); e = hipPeekAtLastError(); }
    if (e != hipSuccess) { fprintf(stderr, "launch (mask %d) failed: %s (grid %d)\n", PHM, hipGetErrorString(e), grid); return false; }
    return true;
}
extern "C" void kernel_launch(void* const* d_in, const int* in_sizes, int n_in, void* d_out, int out_size, void* d_ws, size_t ws_size, hipStream_t stream) {
    static int grid = 0;
    if (grid == 0) {
        if (n_in != 22 || (size_t)out_size != OUT_TOTAL || ws_size < WS_END) { fprintf(stderr, "kernel_launch: unexpected sizes n_in %d out %d ws %zu\n", n_in, out_size, ws_size); grid = -1; return; }
        int dev = 0, cus = 0;
        (void)hipGetDevice(&dev);
        (void)hipDeviceGetAttribute(&cus, hipDeviceAttributeMultiprocessorCount, dev);
        grid = cus;
        if (grid > 256) grid = 256;
        if (grid < 2) grid = -1;
    }
    if (grid < 0) return;
    Params p{};
    const float** pp = (const float**)&p;
    for (int i = 0; i < 22; ++i) pp[i] = (const float*)d_in[i];
    p.out = (float*)d_out; p.ws = (unsigned char*)d_ws;
#if N_LAUNCH == 1
    launch_one<511>(p, grid, true, stream);
#else
    launch_one<1>(p, grid, false, stream) && launch_one<2>(p, grid, false, stream) && launch_one<4>(p, grid, false, stream) && launch_one<8>(p, grid, false, stream) &&
    launch_one<16>(p, grid, false, stream) && launch_one<32>(p, grid, false, stream) && launch_one<64>(p, grid, false, stream) && launch_one<128>(p, grid, false, stream) && launch_one<256>(p, grid, false, stream);
#endif
}
```

```cpp
#define CONV_FUSED 1
#include <hip/hip_runtime.h>
#include <hip/hip_cooperative_groups.h>
#include <cstdio>
#include <cstdint>
namespace cg = cooperative_groups;
namespace pg8 {
#define PG8_LAS __attribute__((address_space(3)))
typedef unsigned short bf16_t;
typedef short bf16x8 __attribute__((ext_vector_type(8)));
typedef float f32x4 __attribute__((ext_vector_type(4)));
typedef unsigned u32x4 __attribute__((ext_vector_type(4)));
constexpr int BM = 256, BK = 64, HALF = 128, HTB = HALF * BK * 2  , STAGE_BYTES = 8 * HTB, NXCD = 8, WGM = 8;

__host__ __device__ __forceinline__ int lds_byte(int r, int c) { const int st = (r >> 4) * 2 + (c >> 5), rr = r & 15, cc = c & 31, ob = rr * 64 + cc * 2; return st * 1024 + (ob ^ (((ob >> 9) & 1) << 5)); }
__host__ __device__ __forceinline__ void stage_rc(int b, int& R, int& C) { const int st = b / 1024, sb = b % 1024, swz = sb ^ (((sb >> 9) & 1) << 5); R = (st >> 1) * 16 + swz / 64; C = (st & 1) * 32 + (swz % 64) / 2; }
__host__ __device__ __forceinline__ int perm32(int rho) { const int n = rho >> 4, i = rho & 15; return 8 * (i >> 2) + 4 * n + (i & 3); }

struct Unit { int pm, pn, seq, kt0, nt; };
struct Gemm { const bf16_t* A; const bf16_t* Bt; int M, N, K; };

struct StaticOrder {
    int nM, nN, nwg, G, c;
    __host__ __device__ __forceinline__ void init(int M, int N, int G_, int c_) { nM = M / BM; nN = N / BM; nwg = nM * nN; G = G_; c = c_; }
    __host__ __device__ __forceinline__ bool next(int i, Unit& u) const {
        const long L = (long)i * G + c; if (L >= nwg) return false; u.seq = i; u.kt0 = 0; u.nt = 0; map(L, u); return true; }
    __host__ __device__ __forceinline__ void map(long L, Unit& u) const {
        int wgid = (int)L; { const int q = nwg / NXCD, r = nwg % NXCD, xcd = wgid % NXCD, off = wgid / NXCD; wgid = (xcd < r ? xcd * (q + 1) : r * (q + 1) + (xcd - r) * q) + off; }
        const int nig = WGM * nN, gid = wgid / nig, fm = gid * WGM, gsz = (nM - fm) < WGM ? (nM - fm) : WGM;
        u.pm = fm + ((wgid % nig) % gsz); u.pn = (wgid % nig) / gsz;
    }
    __device__ __forceinline__ void a_ready(const Unit&) const {}
    __device__ __forceinline__ void done(const Unit&) const {}
};

__device__ __forceinline__ unsigned cvt_pk_bf16(float lo, float hi) { unsigned r; asm volatile("v_cvt_pk_bf16_f32 %0, %1, %2" : "=v"(r) : "v"(lo), "v"(hi)); return r; }

template <class Epi, class Sched, bool ALIGN_EPI = false, bool SP2 = false>
__device__ __forceinline__ void gemm_phase(PG8_LAS unsigned char* lds, const Gemm g, const Sched& S, const Epi& E) {
    int tid_ = threadIdx.x; asm volatile("" : "+v"(tid_));
    const int tid = tid_, wid = __builtin_amdgcn_readfirstlane(tid >> 6), lane = tid & 63, wr = wid >> 2, wc = wid & 3, fr = lane & 15, fq = lane >> 4;
    const int K = g.K, nt = K / BK;
    unsigned voffA[2], voffB[2];
#pragma unroll
    for (int i = 0; i < 2; ++i) { int R, C; stage_rc(tid * 16 + i * 8192, R, C); const int Rb = Epi::PERM ? ((R & ~31) + perm32(R & 31)) : R;
        voffA[i] = (unsigned)(R * K + C) * 2u; voffB[i] = (unsigned)(Rb * K + C) * 2u; }
    const size_t kstep = (size_t)(BK * 2);
    const size_t hstep = (size_t)HALF * K * 2;
    const size_t tstep = 2 * hstep;
    const unsigned ldsw = (unsigned)wid * 1024u;
    const int aoff = lds_byte(wr * 64 + fr, fq * 8), boff = lds_byte(wc * 32 + fr, fq * 8);
#define PG8_SA(b, h) (((b) * 2 + (h)) * HTB)
#define PG8_SB(b, h) ((4 + (b) * 2 + (h)) * HTB)
#define PG8_STAGE(bufoff, gbase, voff) do { _Pragma("unroll") for (int _i = 0; _i < 2; ++_i) \
        __builtin_amdgcn_global_load_lds((const unsigned*)((const char*)(gbase) + (voff)[_i]), (PG8_LAS unsigned*)(lds + (bufoff) + ldsw + _i * 8192), 16, 0, 0); } while (0)
#define PG8_LDA(dst, b, h) do { _Pragma("unroll") for (int m = 0; m < 4; ++m) _Pragma("unroll") for (int k = 0; k < 2; ++k) dst[m][k] = *(const PG8_LAS bf16x8*)(lds + PG8_SA(b, h) + aoff + m * 2048 + k * 1024); } while (0)
#define PG8_LDB(dst, b, h) do { _Pragma("unroll") for (int n = 0; n < 2; ++n) _Pragma("unroll") for (int k = 0; k < 2; ++k) dst[n][k] = *(const PG8_LAS bf16x8*)(lds + PG8_SB(b, h) + boff + n * 2048 + k * 1024); } while (0)
#define PG8_MMA(ai, bj, At, Bt) do { __builtin_amdgcn_s_setprio(1); _Pragma("unroll") for (int m = 0; m < 4; ++m) _Pragma("unroll") for (int n = 0; n < 2; ++n) _Pragma("unroll") for (int k = 0; k < 2; ++k) \
        acc[ai][bj][m][n] = __builtin_amdgcn_mfma_f32_16x16x32_bf16(Bt[n][k], At[m][k], acc[ai][bj][m][n], 0, 0, 0); __builtin_amdgcn_s_setprio(0); } while (0)
#define PG8_WAIT_V(n) asm volatile("s_waitcnt vmcnt(" #n ")" ::: "memory")
#define PG8_WAIT_L(n) asm volatile("s_waitcnt lgkmcnt(" #n ")" ::: "memory")
#define PG8_BAR __builtin_amdgcn_s_barrier()
#define PG8_SCHED __builtin_amdgcn_sched_barrier(0)
    Unit cur, nxt; int ui = 0;
    if (!S.next(0, cur)) return;
    f32x4 acc[2][2][4][2];
#pragma unroll
    for (int a = 0; a < 2; ++a)
#pragma unroll
        for (int b = 0; b < 2; ++b)
#pragma unroll
            for (int m = 0; m < 4; ++m)
#pragma unroll
                for (int n = 0; n < 2; ++n) acc[a][b][m][n] = (f32x4){0.f, 0.f, 0.f, 0.f};
    bf16x8 At[4][2], B0[2][2], B1[2][2];
    const char* cA = (const char*)g.A + (size_t)cur.pm * tstep + (size_t)cur.kt0 * (BK * 2); const char* cB = (const char*)g.Bt + (size_t)cur.pn * tstep + (size_t)cur.kt0 * (BK * 2);
    S.a_ready(cur);
    if constexpr (SP2) {
        PG8_STAGE(PG8_SB(0, 0), cB, voffB); PG8_STAGE(PG8_SB(0, 1), cB + hstep, voffB); PG8_STAGE(PG8_SA(0, 0), cA, voffA); PG8_STAGE(PG8_SA(0, 1), cA + hstep, voffA);
        if (wr == 1) PG8_BAR;
        PG8_WAIT_V(2); PG8_BAR;
        PG8_STAGE(PG8_SB(1, 0), cB + kstep, voffB); PG8_STAGE(PG8_SA(1, 0), cA + kstep, voffA); PG8_STAGE(PG8_SB(1, 1), cB + hstep + kstep, voffB);
        PG8_WAIT_V(6); PG8_BAR;
    } else {
        PG8_STAGE(PG8_SB(0, 0), cB, voffB); PG8_STAGE(PG8_SA(0, 0), cA, voffA); PG8_STAGE(PG8_SB(0, 1), cB + hstep, voffB); PG8_STAGE(PG8_SA(0, 1), cA + hstep, voffA);
        if (wr == 1) PG8_BAR;
        PG8_WAIT_V(4); PG8_BAR;
        PG8_STAGE(PG8_SB(1, 0), cB + kstep, voffB); PG8_STAGE(PG8_SA(1, 0), cA + kstep, voffA); PG8_STAGE(PG8_SB(1, 1), cB + hstep + kstep, voffB);
        PG8_WAIT_V(6); PG8_BAR;
    }
    for (;;) {
        const bool has_next = S.next(ui + 1, nxt);
        const char* nA = has_next ? (const char*)g.A + (size_t)nxt.pm * tstep + (size_t)nxt.kt0 * (BK * 2) : cA; const char* nB = has_next ? (const char*)g.Bt + (size_t)nxt.pn * tstep + (size_t)nxt.kt0 * (BK * 2) : cB;
        const int ntu = cur.nt ? cur.nt : nt;
        for (int t = 0; t < ntu; t += 2) {
            const bool last = (t == ntu - 2);
            const char* a1 = cA + (size_t)(t + 1) * kstep;
            const char* a2 = last ? nA : cA + (size_t)(t + 2) * kstep; const char* b2 = last ? nB : cB + (size_t)(t + 2) * kstep;
            const char* a3 = a2 + kstep; const char* b3 = b2 + kstep;
            if (last && has_next) S.a_ready(nxt);
            if constexpr (SP2) {
            PG8_LDB(B0, 0, 0); PG8_LDB(B1, 0, 1); PG8_SCHED; PG8_LDA(At, 0, 0); PG8_STAGE(PG8_SA(1, 1), a1 + hstep, voffA);
            PG8_WAIT_V(8); PG8_WAIT_L(0); PG8_BAR; PG8_MMA(0, 0, At, B0); PG8_MMA(0, 1, At, B1); PG8_BAR; PG8_SCHED;
            PG8_LDA(At, 0, 1); PG8_STAGE(PG8_SB(0, 0), b2, voffB); PG8_STAGE(PG8_SB(0, 1), b2 + hstep, voffB); PG8_STAGE(PG8_SA(0, 0), a2, voffA);
            PG8_WAIT_V(8); PG8_WAIT_L(0); PG8_BAR; PG8_MMA(1, 0, At, B0); PG8_MMA(1, 1, At, B1); PG8_BAR; PG8_SCHED;
            PG8_LDB(B0, 1, 0); PG8_LDB(B1, 1, 1); PG8_SCHED; PG8_LDA(At, 1, 0); PG8_STAGE(PG8_SA(0, 1), a2 + hstep, voffA);
            PG8_WAIT_V(8); PG8_WAIT_L(0); PG8_BAR; PG8_MMA(0, 0, At, B0); PG8_MMA(0, 1, At, B1); PG8_BAR; PG8_SCHED;
            PG8_LDA(At, 1, 1); PG8_STAGE(PG8_SB(1, 0), b3, voffB); PG8_STAGE(PG8_SB(1, 1), b3 + hstep, voffB); PG8_STAGE(PG8_SA(1, 0), a3, voffA);
            PG8_WAIT_V(8); PG8_WAIT_L(0); PG8_BAR; PG8_MMA(1, 0, At, B0); PG8_MMA(1, 1, At, B1); PG8_BAR; PG8_SCHED;
            } else {
            PG8_LDB(B0, 0, 0); PG8_SCHED; PG8_LDA(At, 0, 0); PG8_STAGE(PG8_SA(1, 1), a1 + hstep, voffA);
            PG8_WAIT_L(8); PG8_BAR; PG8_WAIT_L(0); PG8_MMA(0, 0, At, B0); PG8_BAR; PG8_SCHED;
            PG8_LDB(B1, 0, 1); PG8_STAGE(PG8_SB(0, 0), b2, voffB);
            PG8_BAR; PG8_WAIT_L(0); PG8_MMA(0, 1, At, B1); PG8_BAR;
            PG8_LDA(At, 0, 1); PG8_STAGE(PG8_SA(0, 0), a2, voffA);
            PG8_BAR; PG8_WAIT_L(0); PG8_MMA(1, 0, At, B0); PG8_BAR; PG8_SCHED;
            PG8_STAGE(PG8_SB(0, 1), b2 + hstep, voffB);
            PG8_WAIT_V(6); PG8_BAR; PG8_MMA(1, 1, At, B1); PG8_BAR;
            PG8_LDB(B0, 1, 0); PG8_SCHED; PG8_LDA(At, 1, 0); PG8_STAGE(PG8_SA(0, 1), a2 + hstep, voffA);
            PG8_WAIT_L(8); PG8_BAR; PG8_WAIT_L(0); PG8_MMA(0, 0, At, B0); PG8_BAR; PG8_SCHED;
            PG8_LDB(B1, 1, 1); PG8_STAGE(PG8_SB(1, 0), b3, voffB);
            PG8_BAR; PG8_WAIT_L(0); PG8_MMA(0, 1, At, B1); PG8_BAR;
            PG8_LDA(At, 1, 1); PG8_STAGE(PG8_SA(1, 0), a3, voffA);
            PG8_BAR; PG8_WAIT_L(0); PG8_MMA(1, 0, At, B0); PG8_BAR; PG8_SCHED;
            PG8_STAGE(PG8_SB(1, 1), b3 + hstep, voffB);
            PG8_WAIT_V(6); PG8_BAR; PG8_MMA(1, 1, At, B1); PG8_BAR;
            }
        }
        if constexpr (ALIGN_EPI) { if (wr == 0) PG8_BAR; }
        if constexpr (!Epi::AFTER_DRAIN) { E(acc, cur, wr, wc, fr, fq); S.done(cur); }
        if (!has_next) break;
#pragma unroll
        for (int a = 0; a < 2; ++a)
#pragma unroll
            for (int b = 0; b < 2; ++b)
#pragma unroll
                for (int m = 0; m < 4; ++m)
#pragma unroll
                    for (int n = 0; n < 2; ++n) acc[a][b][m][n] = (f32x4){0.f, 0.f, 0.f, 0.f};
        cur = nxt; cA = nA; cB = nB; ++ui;
        if constexpr (ALIGN_EPI) { if (wr == 1) PG8_BAR; }
    }
    PG8_WAIT_V(0);
    if constexpr (!ALIGN_EPI) { if (wr == 0) PG8_BAR; }
    PG8_BAR;
    if constexpr (Epi::AFTER_DRAIN) { E.fused(acc, cur, wr, wc, fr, fq, lds, wid, lane); S.done(cur); }
#undef PG8_SA
#undef PG8_SB
#undef PG8_STAGE
#undef PG8_LDA
#undef PG8_LDB
#undef PG8_MMA
#undef PG8_WAIT_V
#undef PG8_WAIT_L
#undef PG8_BAR
#undef PG8_SCHED
}
}
constexpr int DM = 1024, SEQ = 2048, NB = 32, DECL = 64, DFF = 2816, INW = 2816;
constexpr int MP = NB * SEQ, MS = NB * DECL, MT = MP + MS;
constexpr int NGRP = MT / 64;
constexpr int NTM = MT / 256;
constexpr float EPS = 1e-6f;
constexpr size_t OFF_Y = 0;
constexpr size_t OFF_PRET = (size_t)MT * DM;
constexpr size_t OFF_PK = OFF_PRET + (size_t)NB * 4 * 128 * 128;
constexpr size_t OFF_PV = OFF_PK + (size_t)NB * 128 * 128;
constexpr size_t OFF_PCONV = OFF_PV + (size_t)NB * 128 * 128;
constexpr size_t OFF_SRET = OFF_PCONV + (size_t)NB * 2 * DFF;
constexpr size_t OFF_SK = OFF_SRET + (size_t)NB * 4 * 128 * 128;
constexpr size_t OFF_SV = OFF_SK + (size_t)NB * 64 * 128;
constexpr size_t OFF_SCONV = OFF_SV + (size_t)NB * 64 * 128;
constexpr size_t OUT_TOTAL = OFF_SCONV + (size_t)NB * 2 * DFF;
constexpr size_t MiB = 1u << 20;
constexpr size_t WS_WIN = 0;
constexpr size_t WS_WUP = WS_WIN + (size_t)INW * DM * 2;
constexpr size_t WS_WOUT = WS_WUP + (size_t)2 * DFF * DM * 2;
constexpr size_t WS_WDN = WS_WOUT + (size_t)DM * DM * 2;
constexpr size_t WS_MODP = 48 * MiB + 133 * MiB + 363 * MiB + 200 * MiB;
constexpr size_t WS_MOD = 32 * MiB;
constexpr size_t WS_SHW = 34 * MiB;
constexpr size_t WS_SS1 = 36 * MiB;
constexpr size_t WS_SS2 = 41 * MiB;
constexpr size_t WS_R0 = 48 * MiB;
constexpr size_t WS_R1 = WS_R0 + 133 * MiB;
constexpr size_t WS_R2 = WS_R1 + 363 * MiB;
constexpr size_t HT_STRIDE = (size_t)NGRP * 2 * DFF;
constexpr size_t WS_END = WS_R2 + 363 * MiB;
constexpr size_t WS_SLAB = WS_R1 + 264 * MiB;
constexpr size_t WS_SLAB4 = WS_R1 + 300 * MiB;
constexpr size_t WS_X1B = WS_R1 + 128 * MiB;
static_assert(3 * HT_STRIDE * 4 <= 128 * MiB && WS_X1B + (size_t)MT * DM * 2 <= WS_R2, "ws map");
static_assert(WS_WDN + (size_t)DM * DFF * 2 <= WS_MODP, "ws map");
static_assert((size_t)(MT + 256) * DM * 2 <= 133 * MiB && (size_t)MT * DFF * 2 <= 363 * MiB, "ws map");

constexpr size_t WS_BAR = 46 * MiB;
constexpr size_t WS_TICKET = 46 * MiB + 32768;
constexpr size_t WS_CNT7 = 46 * MiB + 65536;
constexpr int LDS_MISC = 155648;
constexpr int LDS_BYTES = 155648 + 64;

#define LAS __attribute__((address_space(3)))
typedef unsigned short bf16;
typedef float f32x4 __attribute__((ext_vector_type(4)));
typedef float f32x2 __attribute__((ext_vector_type(2)));
typedef short bf16x8 __attribute__((ext_vector_type(8)));
typedef unsigned u32x4 __attribute__((ext_vector_type(4)));
typedef unsigned u32x2 __attribute__((ext_vector_type(2)));
typedef __bf16 bf16x2_t __attribute__((ext_vector_type(2)));
#define LDS_WAIT() asm volatile("s_waitcnt lgkmcnt(0)" ::: "memory")

__device__ __forceinline__ unsigned pk2(float lo, float hi) { f32x2 v = {lo, hi}; bf16x2_t b = __builtin_convertvector(v, bf16x2_t); return __builtin_bit_cast(unsigned, b); }
__device__ __forceinline__ float bflo(unsigned w) { return __uint_as_float(w << 16); }
__device__ __forceinline__ float bfhi(unsigned w) { return __uint_as_float(w & 0xffff0000u); }
__device__ __forceinline__ float wave_sum(float v) {
#pragma unroll
    for (int o = 1; o < 64; o <<= 1) v += __shfl_xor(v, o);
    return v;
}
__device__ __forceinline__ float wave_sum_dpp(float v) {
    v += __int_as_float(__builtin_amdgcn_update_dpp(__float_as_int(v), __float_as_int(v), 0x128, 0xf, 0xf, false));
    v += __int_as_float(__builtin_amdgcn_update_dpp(__float_as_int(v), __float_as_int(v), 0x124, 0xf, 0xf, false));
    v += __int_as_float(__builtin_amdgcn_update_dpp(__float_as_int(v), __float_as_int(v), 0x122, 0xf, 0xf, false));
    v += __int_as_float(__builtin_amdgcn_update_dpp(__float_as_int(v), __float_as_int(v), 0x121, 0xf, 0xf, false));
    const int i = __float_as_int(v);
    return (__int_as_float(__builtin_amdgcn_readlane(i, 0)) + __int_as_float(__builtin_amdgcn_readlane(i, 16))) + (__int_as_float(__builtin_amdgcn_readlane(i, 32)) + __int_as_float(__builtin_amdgcn_readlane(i, 48)));
}
__device__ __forceinline__ float silu_f(float x) { return x * __builtin_amdgcn_rcpf(1.0f + __builtin_amdgcn_exp2f(-1.4426950408889634f * x)); }
__device__ __forceinline__ void unpack8(const u32x4 w, float (&f)[8]) { f[0] = bflo(w.x); f[1] = bfhi(w.x); f[2] = bflo(w.y); f[3] = bfhi(w.y); f[4] = bflo(w.z); f[5] = bfhi(w.z); f[6] = bflo(w.w); f[7] = bfhi(w.w); }
__device__ __forceinline__ int grp_bs(int g) { return g < 1024 ? (g >> 5) : 32 + (g - 1024); }

struct Params {
    const float *x_p, *x_s, *cache_k, *cache_v, *state_ret, *state_conv, *c_p, *c_s, *ln1, *ln2, *w_ada, *b_ada, *w_in, *w_out, *sinks, *w_up, *conv_w, *conv_b, *w_down, *normf, *w_ada_f, *b_ada_f;
    float* out; unsigned char* ws;
};

__device__ __forceinline__ void transpose_item(const float* W, int K, int N, bf16* WT, int dst_row0, int k0, int n0, LAS float* scr, int lane) {
    { f32x4 t[8];
#pragma unroll
      for (int i = 0; i < 8; ++i) t[i] = *(const f32x4*)(W + (size_t)(k0 + 8 * i + (lane >> 3)) * N + n0 + 4 * (lane & 7));
#pragma unroll
      for (int i = 0; i < 8; ++i) { LAS float* d = scr + (8 * i + (lane >> 3)) * 33 + 4 * (lane & 7); d[0] = t[i].x; d[1] = t[i].y; d[2] = t[i].z; d[3] = t[i].w; } }
    LDS_WAIT(); asm volatile("" ::: "memory");
    const int c = lane & 7;
#pragma unroll
    for (int j = 0; j < 4; ++j) { const int n = (lane >> 3) + 8 * j; const LAS float* s = scr + (8 * c) * 33 + n;
        u32x4 o; o.x = pk2(s[0 * 33], s[1 * 33]); o.y = pk2(s[2 * 33], s[3 * 33]); o.z = pk2(s[4 * 33], s[5 * 33]); o.w = pk2(s[6 * 33], s[7 * 33]);
        *(u32x4*)(WT + (size_t)(dst_row0 + n) * K + k0 + 8 * c) = o; }
    LDS_WAIT(); asm volatile("" ::: "memory");
}
constexpr int MOD_KS = 8, MOD_KC = 1024 / MOD_KS / 32;
__device__ __forceinline__ void mod_item(const Params& P, int it, LAS float* scr, int lane) {
    const int ct = it / MOD_KS, ks = it % MOD_KS, c0 = ct * 64;
    const float* W; const float* bias; int ldw;
    if (c0 < 6144) { W = P.w_ada + c0; bias = P.b_ada + c0; ldw = 6144; } else { W = P.w_ada_f + (c0 - 6144); bias = P.b_ada_f + (c0 - 6144); ldw = 2048; }
    float acc[64];
#pragma unroll
    for (int r = 0; r < 64; ++r) acc[r] = 0.f;
    const float* crow = (lane < 32 ? P.c_p + (size_t)lane * DM : P.c_s + (size_t)(lane - 32) * DM) + ks * (1024 / MOD_KS);
    const float* wk0 = W + (size_t)(ks * (1024 / MOD_KS)) * ldw + lane;
    f32x4 cv[8], cn[8];
#pragma unroll
    for (int q = 0; q < 8; ++q) cv[q] = *(const f32x4*)(crow + 4 * q);
    constexpr int NK4 = (1024 / MOD_KS) / 4;
    float w0 = wk0[0], w1 = wk0[(size_t)ldw], w2 = wk0[(size_t)2 * ldw], w3 = wk0[(size_t)3 * ldw];
    for (int kc = 0; kc < MOD_KC; ++kc) {
#pragma unroll
        for (int q = 0; q < 8; ++q) { f32x4 v = cv[q]; v.x = silu_f(v.x); v.y = silu_f(v.y); v.z = silu_f(v.z); v.w = silu_f(v.w); *(LAS f32x4*)(scr + lane * 36 + 4 * q) = v; }
        LDS_WAIT(); asm volatile("" ::: "memory");
        { const int kn = kc + 1 < MOD_KC ? kc + 1 : kc;
#pragma unroll
          for (int q = 0; q < 8; ++q) cn[q] = *(const f32x4*)(crow + kn * 32 + 4 * q); }
        for (int k4 = 0; k4 < 8; ++k4) {
            const int gk = kc * 8 + k4, gn = gk + 1 < NK4 ? gk + 1 : gk;
            const float* wn = wk0 + (size_t)(4 * gn) * ldw;
            const float n0 = wn[0], n1 = wn[(size_t)ldw], n2 = wn[(size_t)2 * ldw], n3 = wn[(size_t)3 * ldw];
#pragma unroll
            for (int r = 0; r < 64; ++r) { const f32x4 sv = *(const LAS f32x4*)(scr + r * 36 + 4 * k4);
                acc[r] = fmaf(sv.x, w0, acc[r]); acc[r] = fmaf(sv.y, w1, acc[r]); acc[r] = fmaf(sv.z, w2, acc[r]); acc[r] = fmaf(sv.w, w3, acc[r]); }
            w0 = n0; w1 = n1; w2 = n2; w3 = n3;
        }
        LDS_WAIT(); asm volatile("" ::: "memory");
#pragma unroll
        for (int q = 0; q < 8; ++q) cv[q] = cn[q];
    }
    float* dst = (float*)(P.ws + WS_MODP) + (size_t)ks * 64 * 8192 + c0 + lane;
    const float bv = (ks == 0) ? bias[lane] : 0.f;
#pragma unroll
    for (int r = 0; r < 64; ++r) dst[(size_t)r * 8192] = acc[r] + bv;
}
__device__ __forceinline__ void phase0(const Params& P, LAS unsigned char* lds, int wave, int lane) {
    LAS float* scr = (LAS float*)(lds + wave * 16384);
    const int gw = wave * gridDim.x + blockIdx.x, NGW = gridDim.x * 8;
    constexpr int I_MOD = 128 * MOD_KS, I_IN = 16 * 88, I_UP = 16 * 176, I_OUT = 16 * 32, I_DN = 44 * 32;
    constexpr int NIT = I_MOD + I_IN + I_UP + I_OUT + I_DN;
    for (int it = gw; it < NIT; it += NGW) {
        int r = it;
        if (r < I_MOD) { mod_item(P, r, scr, lane); continue; } r -= I_MOD;
        if (r < I_IN) { const int kb = r / 88, nb = r % 88; transpose_item(P.w_in, DM, INW, (bf16*)(P.ws + WS_WIN), nb * 32, kb * 64, nb * 32, scr, lane); continue; } r -= I_IN;
        if (r < I_UP) { const int kb = r / 176, nb = r % 176, n0 = nb * 32, isb = n0 >= DFF, j0 = n0 - isb * DFF;
            transpose_item(P.w_up, DM, 2 * DFF, (bf16*)(P.ws + WS_WUP), 256 * (j0 >> 7) + 128 * isb + (j0 & 127), kb * 64, n0, scr, lane); continue; } r -= I_UP;
        if (r < I_OUT) { const int kb = r / 32, nb = r % 32; transpose_item(P.w_out, DM, DM, (bf16*)(P.ws + WS_WOUT), nb * 32, kb * 64, nb * 32, scr, lane); continue; } r -= I_OUT;
        { const int kb = r / 32, nb = r % 32; transpose_item(P.w_down, DFF, DM, (bf16*)(P.ws + WS_WDN), nb * 32, kb * 64, nb * 32, scr, lane); }
    }
}

__device__ __forceinline__ void phase1(const Params& P, LAS unsigned char* lds, int tid, int wave, int lane) {
    const float* modp = (const float*)(P.ws + WS_MODP);
    float* mod = (float*)(P.ws + WS_MOD);
    bf16* H1 = (bf16*)(P.ws + WS_R0);
    for (int idx = blockIdx.x * 512 + tid; idx < 64 * 8192; idx += gridDim.x * 512) {
        float s = 0.f;
#pragma unroll
        for (int p_ = 0; p_ < MOD_KS; ++p_) s += modp[idx + (size_t)p_ * 524288];
        mod[idx] = s;
        const int col = idx & 8191, bs = idx >> 13;
        if (col >= 3072 && col < 4096) H1[(size_t)(MT + bs) * DM + (col - 3072)] = (bf16)(pk2(s, 0.f) & 0xffffu);
    }
    LAS float* lv = (LAS float*)lds;
    const int rpb = (MT + (int)gridDim.x - 1) / (int)gridDim.x, rbeg = (int)blockIdx.x * rpb, rend = (rbeg + rpb < MT) ? rbeg + rpb : MT;
    if (rbeg < rend) {
        const int bs0 = rbeg < MP ? (rbeg >> 11) : 32 + ((rbeg - MP) >> 6), bs1 = (rend - 1) < MP ? ((rend - 1) >> 11) : 32 + ((rend - 1 - MP) >> 6);
        const int nsl = bs1 - bs0 + 1;
        __syncthreads();
        for (int i = tid; i < nsl * 2048; i += 512) { const int sl = i >> 11, which = (i >> 10) & 1, col = i & 1023; const size_t o = (size_t)(bs0 + sl) * 8192 + which * 1024 + col;
            float sv = 0.f;
#pragma unroll
            for (int p_ = 0; p_ < MOD_KS; ++p_) sv += modp[o + (size_t)p_ * 524288];
            if (which) sv = P.ln1[col] * (1.f + sv);
            lv[i] = sv; }
        __syncthreads();
#pragma unroll 4
        for (int row = rbeg + wave; row < rend; row += 8) {
            const int bs = row < MP ? (row >> 11) : 32 + ((row - MP) >> 6);
            const LAS float* lvs = lv + (bs - bs0) * 2048;
            const float* xr = (row < MP ? P.x_p + (size_t)row * DM : P.x_s + (size_t)(row - MP) * DM) + 4 * lane;
            f32x4 v[4]; float ss = 0.f;
#pragma unroll
            for (int j = 0; j < 4; ++j) { v[j] = *(const f32x4*)(xr + 256 * j); ss += (v[j].x * v[j].x + v[j].y * v[j].y) + (v[j].z * v[j].z + v[j].w * v[j].w); }
            const float rstd = __builtin_amdgcn_rsqf(wave_sum_dpp(ss) * (1.f / DM) + EPS);
            bf16* hr = H1 + (size_t)row * DM + 4 * lane;
#pragma unroll
            for (int j = 0; j < 4; ++j) { const f32x4 sh = *(const LAS f32x4*)(lvs + 256 * j + 4 * lane), gs = *(const LAS f32x4*)(lvs + 1024 + 256 * j + 4 * lane);
                const f32x4 h = v[j] * rstd * gs + sh; u32x2 w; w.x = pk2(h.x, h.y); w.y = pk2(h.z, h.w); *(u32x2*)(hr + 256 * j) = w; }
        }
    }
}

struct OrderX {
    pg8::StaticOrder S; int nX, xpm, xpn0;
    __device__ __forceinline__ bool next(int i, pg8::Unit& u) const {
        const long L = (long)i * S.G + S.c;
        int pm = 0, pn = 0; bool ok = false;
        if (L < S.nwg) { pg8::Unit t; t.pm = 0; t.pn = 0; t.seq = 0; t.kt0 = 0; t.nt = 0; (void)S.next(i, t); pm = t.pm; pn = t.pn; ok = true; }
        else if (L < S.nwg + nX) { pm = xpm; pn = xpn0 + (int)(L - S.nwg); ok = true; }
        u.pm = pm; u.pn = pn; u.seq = i; u.kt0 = 0; u.nt = 0;
        return ok;
    }
    __device__ __forceinline__ void a_ready(const pg8::Unit&) const {}
    __device__ __forceinline__ void done(const pg8::Unit&) const {}
};
struct OrderPub : pg8::StaticOrder {
    unsigned* cnt;
    __device__ __forceinline__ void done(const pg8::Unit& u) const {
        asm volatile("s_waitcnt vmcnt(0)" ::: "memory");
        if ((threadIdx.x & 63) == 0) __hip_atomic_fetch_add(cnt + 64 * u.pm, 1u, __ATOMIC_RELAXED, __HIP_MEMORY_SCOPE_AGENT);
    }
};
struct OrderDown {
    pg8::StaticOrder S;
    int ka, kb;
    __device__ __forceinline__ bool next(int i, pg8::Unit& u) const {
        const long L = (long)i * S.G + S.c;
        int pm = 0, pn = 0, kt0 = 0, nt = 0; bool ok = false;
        if (L < S.nwg) { pg8::Unit t; t.pm = 0; t.pn = 0; t.seq = 0; t.kt0 = 0; t.nt = 0; (void)S.next(i, t); pm = t.pm; pn = t.pn; ok = true; }
        else if (L < S.nwg + 128) { const int q = (int)(L - S.nwg), tu = q >> 2, part = q & 3; pm = (MP / 256) + (tu & 7); pn = tu >> 3; kt0 = part < 2 ? ka * part : 2 * ka + kb * (part - 2); nt = part < 2 ? ka : kb; ok = true; }
        u.pm = pm; u.pn = pn; u.seq = i; u.kt0 = kt0; u.nt = nt;
        return ok;
    }
    __device__ __forceinline__ void a_ready(const pg8::Unit&) const {}
    __device__ __forceinline__ void done(const pg8::Unit&) const {}
};
typedef const f32x4 (&AccRef)[2][2][4][2];
struct Epi1 {
    static constexpr bool PERM = true, AFTER_DRAIN = false;
    bf16* proj; float* shw; float* out;
    __device__ __forceinline__ void operator()(AccRef acc, const pg8::Unit& u, int wr, int wc, int fr, int fq) const {
        if (u.pm == NTM) {
            if (wr == 0) {
#pragma unroll
                for (int m = 0; m < 4; ++m) { float* d = shw + (size_t)(16 * m + fr) * (2 * DFF) + 256 * (u.pn - 11) + 32 * wc + 8 * fq;
#pragma unroll
                    for (int bj = 0; bj < 2; ++bj)
#pragma unroll
                        for (int n = 0; n < 2; ++n) *(f32x4*)(d + 128 * bj + 4 * n) = acc[0][bj][m][n]; }
            }
            return;
        }
        const unsigned row0 = u.pm * 256 + wr * 64 + fr, col0 = u.pn * 256 + wc * 32 + 8 * fq;
#pragma unroll
        for (int ai = 0; ai < 2; ++ai)
#pragma unroll
            for (int m = 0; m < 4; ++m) { const unsigned o = (row0 + 128 * ai + 16 * m) * (unsigned)INW + col0;
#pragma unroll
                for (int bj = 0; bj < 2; ++bj) { const f32x4 v0 = acc[ai][bj][m][0], v1 = acc[ai][bj][m][1];
                    u32x4 w; w.x = pk2(v0[0], v0[1]); w.y = pk2(v0[2], v0[3]); w.z = pk2(v1[0], v1[1]); w.w = pk2(v1[2], v1[3]);
                    *(u32x4*)(proj + (o + 128 * bj)) = w; }
                asm volatile("" ::: "memory"); }
        if (u.pn == 10) {
            const unsigned c = 32 * wc + 8 * fq;
#pragma unroll
            for (int ai = 0; ai < 2; ++ai)
#pragma unroll
                for (int m = 0; m < 4; ++m) { const unsigned row = row0 + 128 * ai + 16 * m; unsigned ok, ov;
                    if (row < (unsigned)MP) { const unsigned t = row & 2047; if (t < SEQ - 128) continue; const unsigned o = ((row >> 11) * 128 + (t - (SEQ - 128))) * 128 + c; ok = (unsigned)OFF_PK + o; ov = (unsigned)OFF_PV + o; }
                    else { const unsigned o = (row - MP) * 128 + c; ok = (unsigned)OFF_SK + o; ov = (unsigned)OFF_SV + o; }
                    *(f32x4*)(out + ok) = acc[ai][0][m][0]; *(f32x4*)(out + ok + 4) = acc[ai][0][m][1];
                    *(f32x4*)(out + ov) = acc[ai][1][m][0]; *(f32x4*)(out + ov + 4) = acc[ai][1][m][1];
                    asm volatile("" ::: "memory"); }
        }
    }
};
struct Epi2 {
    static constexpr bool PERM = true, AFTER_DRAIN = false;
    const float *xp, *xs, *mod, *ln2; bf16* x1; bf16* a2; float* ss; float* slab;
    __device__ __forceinline__ void operator()(AccRef acc, const pg8::Unit& u, int wr, int wc, int fr, int fq) const {
        const int col0 = u.pn * 256 + wc * 32 + 8 * fq;
        if (u.nt != 0) {
            float* sb = slab + (size_t)(u.kt0 >> 2) * MS * DM;
#pragma unroll
            for (int ai = 0; ai < 2; ++ai)
#pragma unroll
                for (int m = 0; m < 4; ++m) { const unsigned ro = (unsigned)(u.pm * 256 - MP + 128 * ai + 64 * wr + 16 * m + fr) * DM + col0;
#pragma unroll
                    for (int bj = 0; bj < 2; ++bj) { *(f32x4*)(sb + ro + 128 * bj) = acc[ai][bj][m][0]; *(f32x4*)(sb + ro + 128 * bj + 4) = acc[ai][bj][m][1]; } }
            return;
        }
#pragma unroll
        for (int ai = 0; ai < 2; ++ai) {
            const int bs = grp_bs(4 * u.pm + 2 * ai + wr);
            const float* mb = mod + (size_t)bs * 8192;
            f32x4 g1v[2][2], gsv[2][2];
#pragma unroll
            for (int bj = 0; bj < 2; ++bj)
#pragma unroll
                for (int n = 0; n < 2; ++n) { const int c = col0 + 128 * bj + 4 * n; g1v[bj][n] = *(const f32x4*)(mb + 2048 + c);
                    gsv[bj][n] = *(const f32x4*)(ln2 + c) * (*(const f32x4*)(mb + 4096 + c) + 1.0f); }
#pragma unroll
            for (int m = 0; m < 4; ++m) {
                const int row = u.pm * 256 + 128 * ai + 64 * wr + 16 * m + fr;
                const float* xr = row < MP ? xp + (size_t)row * DM : xs + (size_t)(row - MP) * DM;
                float s = 0.f;
#pragma unroll
                for (int bj = 0; bj < 2; ++bj) { f32x4 a[2]; f32x4 xb[2];
#pragma unroll
                    for (int n = 0; n < 2; ++n) { const int c = col0 + 128 * bj + 4 * n; const f32x4 xv = *(const f32x4*)(xr + c); const f32x4 v = xv + g1v[bj][n] * acc[ai][bj][m][n];
                        xb[n] = v; s += (v.x * v.x + v.y * v.y) + (v.z * v.z + v.w * v.w); a[n] = v * gsv[bj][n]; }
                    u32x4 w; w.x = pk2(a[0].x, a[0].y); w.y = pk2(a[0].z, a[0].w); w.z = pk2(a[1].x, a[1].y); w.w = pk2(a[1].z, a[1].w);
                    *(u32x4*)(a2 + (size_t)row * DM + col0 + 128 * bj) = w;
                    w.x = pk2(xb[0].x, xb[0].y); w.y = pk2(xb[0].z, xb[0].w); w.z = pk2(xb[1].x, xb[1].y); w.w = pk2(xb[1].z, xb[1].w);
                    *(u32x4*)(x1 + (size_t)row * DM + col0 + 128 * bj) = w; }
                s += __shfl_xor(s, 16); s += __shfl_xor(s, 32);
                if (fq == 0) ss[(size_t)row * 16 + 4 * u.pn + wc] = s;
            }
        }
    }
};
struct Epi3 {
    static constexpr bool PERM = true, AFTER_DRAIN = false;
    const LAS float* rtab; const float* shw; bf16 *ua, *ub; float* out;
    __device__ __forceinline__ void operator()(AccRef acc, const pg8::Unit& u, int wr, int wc, int fr, int fq) const {
        const unsigned j0 = u.pn * 128 + wc * 32 + 8 * fq, pc0 = u.pn * 256 + wc * 32 + 8 * fq;
#pragma unroll
        for (int ai = 0; ai < 2; ++ai) {
            const unsigned grp = 4 * u.pm + 2 * ai + wr, bs = grp_bs((int)grp);
            const unsigned so = bs * (2 * DFF) + pc0;
            const f32x4 sa0 = *(const f32x4*)(shw + so), sa1 = *(const f32x4*)(shw + so + 4), sb0 = *(const f32x4*)(shw + so + 128), sb1 = *(const f32x4*)(shw + so + 132);
#pragma unroll
            for (int m = 0; m < 4; ++m) {
                const float rstd = rtab[u.seq * 256 + 128 * ai + 64 * wr + 16 * m + fr];
                const unsigned row = grp * 64 + 16 * m + fr;
                const f32x4 a0 = acc[ai][0][m][0] * rstd + sa0, a1 = acc[ai][0][m][1] * rstd + sa1, b0 = acc[ai][1][m][0] * rstd + sb0, b1 = acc[ai][1][m][1] * rstd + sb1;
                u32x4 w; w.x = pk2(a0[0], a0[1]); w.y = pk2(a0[2], a0[3]); w.z = pk2(a1[0], a1[1]); w.w = pk2(a1[2], a1[3]);
                *(u32x4*)(ua + (row * (unsigned)DFF + j0)) = w;
                w.x = pk2(b0[0], b0[1]); w.y = pk2(b0[2], b0[3]); w.z = pk2(b1[0], b1[1]); w.w = pk2(b1[2], b1[3]);
                *(u32x4*)(ub + (row * (unsigned)DFF + j0)) = w;
                if (m == 3 && fr >= 14) {
                    if (grp >= 1024) { float* d = out + OFF_SCONV + ((size_t)(grp - 1024) * 2 + (fr - 14)) * DFF + j0; *(f32x4*)d = a0; *(f32x4*)(d + 4) = a1; }
                    else if ((grp & 31) == 31) { float* d = out + OFF_PCONV + ((size_t)(grp >> 5) * 2 + (fr - 14)) * DFF + j0; *(f32x4*)d = a0; *(f32x4*)(d + 4) = a1; }
                }
            }
        }
    }
};
#ifdef CONV_FUSED
struct Epi3C {
    static constexpr bool PERM = true, AFTER_DRAIN = false;
    const LAS float* rtab; const float *shw, *cw, *cb; bf16* act; float *headA, *headB, *tailA;
    __device__ __forceinline__ void operator()(AccRef acc, const pg8::Unit& u, int wr, int wc, int fr, int fq) const {
        const unsigned j0 = u.pn * 128 + wc * 32 + 8 * fq, pc0 = u.pn * 256 + wc * 32 + 8 * fq;
        f32x4 w0[2], w1[2], w2[2], cbv[2];
#pragma unroll
        for (int n = 0; n < 2; ++n) { w0[n] = *(const f32x4*)(cw + j0 + 4 * n); w1[n] = *(const f32x4*)(cw + DFF + j0 + 4 * n); w2[n] = *(const f32x4*)(cw + 2 * DFF + j0 + 4 * n); cbv[n] = *(const f32x4*)(cb + j0 + 4 * n); }
        u32x2 ap[2][4][2], bp[2][4][2];
        f32x4 sa[2], sb[2];
        const unsigned bs0 = grp_bs((int)(4 * u.pm + wr));
        { const unsigned so = bs0 * (2 * DFF) + pc0;
#pragma unroll
          for (int n = 0; n < 2; ++n) { sa[n] = *(const f32x4*)(shw + so + 4 * n); sb[n] = *(const f32x4*)(shw + so + 128 + 4 * n); } }
#pragma unroll
        for (int ai = 0; ai < 2; ++ai) {
            const unsigned grp = 4 * u.pm + 2 * ai + wr, bs = grp_bs((int)grp);
            const unsigned ho = (grp * 2 + (fr & 1)) * DFF + j0;
            if (ai == 1 && bs != bs0) { const unsigned so = bs * (2 * DFF) + pc0;
#pragma unroll
                for (int n = 0; n < 2; ++n) { sa[n] = *(const f32x4*)(shw + so + 4 * n); sb[n] = *(const f32x4*)(shw + so + 128 + 4 * n); } }
#pragma unroll
            for (int m = 0; m < 4; ++m) {
                const float rs = rtab[u.seq * 256 + 128 * ai + 64 * wr + 16 * m + fr];
#pragma unroll
                for (int n = 0; n < 2; ++n) {
                    const f32x4 av = acc[ai][0][m][n] * rs + sa[n], bv = acc[ai][1][m][n] * rs + sb[n];
                    if (m == 0) { if (fr < 2) { *(f32x4*)(headA + ho + 4 * n) = av; *(f32x4*)(headB + ho + 4 * n) = bv; } }
                    if (m == 3) { if (fr >= 14) *(f32x4*)(tailA + ho + 4 * n) = av; }
                    ap[ai][m][n].x = pk2(av.x, av.y); ap[ai][m][n].y = pk2(av.z, av.w); bp[ai][m][n].x = pk2(bv.x, bv.y); bp[ai][m][n].y = pk2(bv.z, bv.w);
                }
            }
        }
        asm volatile("" ::: "memory");
#pragma unroll
        for (int ai = 0; ai < 2; ++ai) {
            const unsigned grp = 4 * u.pm + 2 * ai + wr;
#pragma unroll
            for (int n = 0; n < 2; ++n)
#pragma unroll
                for (int h = 0; h < 2; ++h) {
                    unsigned q1 = 0u, q2 = 0u;
#pragma unroll
                    for (int m = 0; m < 4; ++m) {
                        const unsigned a = ap[ai][m][n][h];
                        const unsigned s1 = (unsigned)__builtin_amdgcn_update_dpp((int)a, (int)a, 0x121, 0xf, 0xf, false);
                        const unsigned s2 = (unsigned)__builtin_amdgcn_update_dpp((int)a, (int)a, 0x122, 0xf, 0xf, false);
                        const unsigned pr1 = fr >= 1 ? s1 : q1, pr2 = fr >= 2 ? s2 : q2;
                        q1 = s1; q2 = s2;
                        const float c0 = cbv[n][2 * h] + w0[n][2 * h] * bflo(pr2) + w1[n][2 * h] * bflo(pr1) + w2[n][2 * h] * bflo(a);
                        const float c1 = cbv[n][2 * h + 1] + w0[n][2 * h + 1] * bfhi(pr2) + w1[n][2 * h + 1] * bfhi(pr1) + w2[n][2 * h + 1] * bfhi(a);
                        const unsigned bw = bp[ai][m][n][h];
                        bp[ai][m][n][h] = pk2(silu_f(c0) * bflo(bw), silu_f(c1) * bfhi(bw));
                    }
                    __builtin_amdgcn_sched_barrier(0);
                }
            asm volatile("" ::: "memory");
#pragma unroll
            for (int m = 0; m < 4; ++m) {
                if (m == 0 && fr < 2) continue;
                const unsigned row = grp * 64 + 16 * m + fr;
                const u32x4 w = (u32x4){bp[ai][m][0].x, bp[ai][m][0].y, bp[ai][m][1].x, bp[ai][m][1].y};
                *(u32x4*)(act + (row * (unsigned)DFF + j0)) = w;
            }
        }
    }
};
#endif
struct Epi4 {
    static constexpr bool PERM = true, AFTER_DRAIN = false;
    const float* mod; const bf16* x1; bf16* x2; float* slab;
    __device__ __forceinline__ void operator()(AccRef acc, const pg8::Unit& u, int wr, int wc, int fr, int fq) const {
        const int col0 = u.pn * 256 + wc * 32 + 8 * fq;
        if (u.nt != 0) {
            const int part = u.kt0 == 0 ? 0 : (u.kt0 == 12 ? 1 : (u.kt0 == 24 ? 2 : 3));
            float* sb = slab + (size_t)part * MS * DM;
#pragma unroll
            for (int ai = 0; ai < 2; ++ai)
#pragma unroll
                for (int m = 0; m < 4; ++m) { const unsigned ro = (unsigned)(u.pm * 256 - MP + 128 * ai + 64 * wr + 16 * m + fr) * DM + col0;
#pragma unroll
                    for (int bj = 0; bj < 2; ++bj) { *(f32x4*)(sb + ro + 128 * bj) = acc[ai][bj][m][0]; *(f32x4*)(sb + ro + 128 * bj + 4) = acc[ai][bj][m][1]; } }
            return;
        }
#pragma unroll
        for (int ai = 0; ai < 2; ++ai) {
            const int bs = grp_bs(4 * u.pm + 2 * ai + wr);
            const float* mb = mod + (size_t)bs * 8192 + 5120;
            f32x4 g2v[2][2];
#pragma unroll
            for (int bj = 0; bj < 2; ++bj)
#pragma unroll
                for (int n = 0; n < 2; ++n) g2v[bj][n] = *(const f32x4*)(mb + col0 + 128 * bj + 4 * n);
#pragma unroll
            for (int m = 0; m < 4; ++m) {
                const unsigned ro = (unsigned)(u.pm * 256 + 128 * ai + 64 * wr + 16 * m + fr) * DM + col0;
#pragma unroll
                for (int bj = 0; bj < 2; ++bj) { const u32x4 xw = *(const u32x4*)(x1 + ro + 128 * bj);
                    const f32x4 v0 = (f32x4){bflo(xw.x), bfhi(xw.x), bflo(xw.y), bfhi(xw.y)} + g2v[bj][0] * acc[ai][bj][m][0];
                    const f32x4 v1 = (f32x4){bflo(xw.z), bfhi(xw.z), bflo(xw.w), bfhi(xw.w)} + g2v[bj][1] * acc[ai][bj][m][1];
                    u32x4 w; w.x = pk2(v0.x, v0.y); w.y = pk2(v0.z, v0.w); w.z = pk2(v1.x, v1.y); w.w = pk2(v1.z, v1.w);
                    *(u32x4*)(x2 + ro + 128 * bj) = w; }
            }
        }
    }
};
#define GAS __attribute__((address_space(1)))
#define RLX_AGENT __ATOMIC_RELAXED, __HIP_MEMORY_SCOPE_AGENT
#define XB_TMO      128
#define XB_XCNT(j)  (256  + 64 * (j))
#define XB_XSUB(j)  (1280 + 64 * (j))
#define XB_XGEN(j)  (2304 + 64 * (j))
#define XB_TOP      3328
#define XB_TOPGEN   3392
#define XCD_BAR_WORDS 3456
#define XB_SPIN_CAP (1u << 18)

__device__ __forceinline__ unsigned xb_ld(unsigned* p)              { return __hip_atomic_load(p, __ATOMIC_RELAXED, __HIP_MEMORY_SCOPE_AGENT); }
__device__ __forceinline__ unsigned xb_add(unsigned* p, unsigned v) { return __hip_atomic_fetch_add(p, v, __ATOMIC_RELAXED, __HIP_MEMORY_SCOPE_AGENT); }
__device__ __forceinline__ unsigned xb_xcc_id() { return (unsigned)__builtin_amdgcn_s_getreg((3 << 11) | 20) & 0xFu; }
#define XB_SPIN(cond, bar) do { unsigned _sp = 0; while (cond) { __builtin_amdgcn_s_sleep(1); \
    if ((++_sp & 255u) == 0u) { if (xb_ld(&(bar)[XB_TMO])) break; if (_sp > XB_SPIN_CAP) { atomicAdd(&(bar)[XB_TMO], 1u); break; } } } } while (0)

struct XcdBarrier {
    unsigned* bar; unsigned x;
    volatile LAS unsigned* st;
};

__device__ __forceinline__ XcdBarrier xcd_barrier_post(unsigned* bar, volatile LAS unsigned* st) {
    XcdBarrier b; b.bar = bar; b.x = xb_xcc_id(); b.st = st;
    if (threadIdx.x == 0) (void)xb_add(&bar[XB_XCNT(b.x)], 1u);
    return b;
}
__device__ __forceinline__ void xcd_barrier_complete(unsigned* bar, unsigned x, unsigned& nloc, unsigned& nx) {
    const unsigned G = gridDim.x * gridDim.y * gridDim.z;
    unsigned sum, cnt, mine, sp = 0u;
    for (;;) {
        sum = 0u; cnt = 0u; mine = 0u;
#pragma unroll
        for (unsigned j = 0; j < 16; ++j) { const unsigned c = xb_ld(&bar[XB_XCNT(j)]); sum += c; cnt += (c > 0u) ? 1u : 0u; mine = (j == x) ? c : mine; }
        if (sum == G) break;
        __builtin_amdgcn_s_sleep(1);
        if ((++sp & 255u) == 0u) { if (xb_ld(&bar[XB_TMO])) break; if (sp > XB_SPIN_CAP) { atomicAdd(&bar[XB_TMO], 1u); break; } }
    }
    nloc = mine > 0u ? mine : 1u; nx = cnt > 0u ? cnt : 1u;
}

__device__ __forceinline__ void xcd_barrier(const XcdBarrier& b) {
    asm volatile("s_waitcnt vmcnt(0)" ::: "memory");
    __syncthreads();
    if (threadIdx.x == 0) {
        unsigned* bar = b.bar;
        __builtin_amdgcn_s_waitcnt(0);
        unsigned nloc = b.st[0], nx = b.st[1];
        if (nloc == 0u) { xcd_barrier_complete(bar, b.x, nloc, nx); b.st[0] = nloc; b.st[1] = nx; }
        const unsigned old = xb_add(&bar[XB_XSUB(b.x)], 1u);
        const unsigned gen = old / nloc;
        if (old + 1u == (gen + 1u) * nloc) {
            __builtin_amdgcn_fence(__ATOMIC_RELEASE, "agent");
            asm volatile("s_waitcnt vmcnt(0)" ::: "memory");
            const unsigned og = xb_add(&bar[XB_TOP], 1u);
            const unsigned tg = og / nx;
            if (og + 1u == (tg + 1u) * nx) xb_add(&bar[XB_TOPGEN], 1u);
            else XB_SPIN(xb_ld(&bar[XB_TOPGEN]) == tg, bar);
            __builtin_amdgcn_fence(__ATOMIC_ACQUIRE, "agent");
            xb_add(&bar[XB_XGEN(b.x)], 1u);
            asm volatile("s_waitcnt vmcnt(0)" ::: "memory");
        } else {
            XB_SPIN(xb_ld(&bar[XB_XGEN(b.x)]) == gen, bar);
            __builtin_amdgcn_fence(__ATOMIC_ACQUIRE, "agent");
            asm volatile("s_waitcnt vmcnt(0)" ::: "memory");
        }
    }
    __syncthreads();
}
#define MFMA16(a, b, c) __builtin_amdgcn_mfma_f32_16x16x32_bf16((a), (b), (c), 0, 0, 0)
constexpr int RQ = 0, RK = 17408, RKT = 34816, RVT = 53248, RP = 71680, RST = 80896, RO = 115712;
__device__ __forceinline__ void ret_item(const Params& P, LAS unsigned char* lds, int tid, int wave, int lane, int h, int row0, int nchunks, const float* st_in, bool has_in, float* st_out) {
    const bf16* proj = (const bf16*)(P.ws + WS_R1);
    bf16* mix = (bf16*)(P.ws + WS_R2);
    const int fr = lane & 15, fq = lane >> 4;
    const float lg2 = log2f(1.0f - exp2f(-5.0f - (float)h));
    const float kscale = 0.08838834764831845f;
    LAS bf16* Qs = (LAS bf16*)(lds + RQ); LAS bf16* Ks = (LAS bf16*)(lds + RK); LAS bf16* KT = (LAS bf16*)(lds + RKT); LAS bf16* VT = (LAS bf16*)(lds + RVT);
    LAS bf16* Ps = (LAS bf16*)(lds + RP); LAS bf16* ST = (LAS bf16*)(lds + RST); LAS float* Os = (LAS float*)(lds + RO);
    f32x4 st[8];
#pragma unroll
    for (int et = 0; et < 8; ++et) {
        f32x4 v;
#pragma unroll
        for (int r = 0; r < 4; ++r) v[r] = st_in[(size_t)(16 * wave + 4 * fq + r) * 128 + 16 * et + fr];
        asm volatile("" : "+v"(v));
#pragma unroll
        for (int r = 0; r < 4; ++r) v[r] = has_in ? v[r] : 0.f;
        st[et] = v;
    }
    __syncthreads();
#pragma unroll
    for (int et = 0; et < 8; ++et) { u32x2 w; w.x = pk2(st[et][0], st[et][1]); w.y = pk2(st[et][2], st[et][3]); *(LAS u32x2*)(ST + (16 * et + fr) * 136 + 16 * wave + 4 * fq) = w; }
    const size_t goff = (size_t)lane * INW + h * 128 + wave * 16;
    u32x4 pq[2], pk[2], pv[2];
    { const bf16* g = proj + (size_t)row0 * INW + goff;
      pq[0] = *(const u32x4*)(g); pq[1] = *(const u32x4*)(g + 8); pk[0] = *(const u32x4*)(g + 512); pk[1] = *(const u32x4*)(g + 520); pv[0] = *(const u32x4*)(g + 1024); pv[1] = *(const u32x4*)(g + 1032); }
    u32x4 gv0, gv1, gn0, gn1;
    const size_t ggoff = (size_t)(8 * wave + (lane >> 3)) * INW + 1536 + h * 128 + 16 * (lane & 7);
    gn0 = *(const u32x4*)(proj + (size_t)row0 * INW + ggoff); gn1 = *(const u32x4*)(proj + (size_t)row0 * INW + ggoff + 8);
    const float kf = kscale * exp2f(lg2 * (float)(63 - lane));
    const float g64 = exp2f(lg2 * 64.0f);
    for (int c = 0; c < nchunks; ++c) {
        const int rowc = row0 + 64 * c;
        *(LAS u32x4*)(Qs + lane * 136 + wave * 16) = pq[0]; *(LAS u32x4*)(Qs + lane * 136 + wave * 16 + 8) = pq[1];
        *(LAS u32x4*)(Ks + lane * 136 + wave * 16) = pk[0]; *(LAS u32x4*)(Ks + lane * 136 + wave * 16 + 8) = pk[1];
#pragma unroll
        for (int i = 0; i < 2; ++i)
#pragma unroll
            for (int j = 0; j < 4; ++j) { const unsigned wk = pk[i][j], wv = pv[i][j]; const int d = wave * 16 + i * 8 + j * 2;
                const unsigned kk = pk2(bflo(wk) * kf, bfhi(wk) * kf);
                KT[(d) * 72 + lane] = (bf16)(kk & 0xffffu); KT[(d + 1) * 72 + lane] = (bf16)(kk >> 16);
                VT[(d) * 72 + lane] = (bf16)(wv & 0xffffu); VT[(d + 1) * 72 + lane] = (bf16)(wv >> 16); }
        gv0 = gn0; gv1 = gn1;
        if (c + 1 < nchunks) { const bf16* g = proj + (size_t)(rowc + 64) * INW + goff;
            pq[0] = *(const u32x4*)(g); pq[1] = *(const u32x4*)(g + 8); pk[0] = *(const u32x4*)(g + 512); pk[1] = *(const u32x4*)(g + 520); pv[0] = *(const u32x4*)(g + 1024); pv[1] = *(const u32x4*)(g + 1032);
            gn0 = *(const u32x4*)(proj + (size_t)(rowc + 64) * INW + ggoff); gn1 = *(const u32x4*)(proj + (size_t)(rowc + 64) * INW + ggoff + 8); }
        __syncthreads();
        { const int mi = wave >> 1;
#pragma unroll
          for (int jj = 0; jj < 2; ++jj) { const int lj = 2 * (wave & 1) + jj; f32x4 s = (f32x4){0.f, 0.f, 0.f, 0.f};
#pragma unroll
            for (int ks = 0; ks < 4; ++ks) { const bf16x8 a = *(const LAS bf16x8*)(Ks + (16 * mi + fr) * 136 + 32 * ks + 8 * fq), b = *(const LAS bf16x8*)(Qs + (16 * lj + fr) * 136 + 32 * ks + 8 * fq); s = MFMA16(a, b, s); }
            const int l = 16 * lj + fr; float pvv[4];
#pragma unroll
            for (int r = 0; r < 4; ++r) { const int m = 16 * mi + 4 * fq + r; const int dlt = l - m; pvv[r] = dlt >= 0 ? s[r] * kscale * exp2f(lg2 * (float)dlt) : 0.f; }
            u32x2 w; w.x = pk2(pvv[0], pvv[1]); w.y = pk2(pvv[2], pvv[3]); *(LAS u32x2*)(Ps + l * 72 + 16 * mi + 4 * fq) = w; } }
#pragma unroll
        for (int et = 0; et < 8; ++et) st[et] = st[et] * g64;
#pragma unroll
        for (int ks = 0; ks < 2; ++ks) { const bf16x8 a = *(const LAS bf16x8*)(KT + (16 * wave + fr) * 72 + 32 * ks + 8 * fq);
#pragma unroll
            for (int et = 0; et < 8; ++et) { const bf16x8 b = *(const LAS bf16x8*)(VT + (16 * et + fr) * 72 + 32 * ks + 8 * fq); st[et] = MFMA16(a, b, st[et]); } }
        __syncthreads();
        { f32x4 oi[4], oc[4];
#pragma unroll
          for (int lt = 0; lt < 4; ++lt) { oi[lt] = (f32x4){0.f, 0.f, 0.f, 0.f}; oc[lt] = (f32x4){0.f, 0.f, 0.f, 0.f}; }
#pragma unroll
          for (int ks = 0; ks < 2; ++ks) { const bf16x8 b = *(const LAS bf16x8*)(VT + (16 * wave + fr) * 72 + 32 * ks + 8 * fq);
#pragma unroll
            for (int lt = 0; lt < 4; ++lt) { const bf16x8 a = *(const LAS bf16x8*)(Ps + (16 * lt + fr) * 72 + 32 * ks + 8 * fq); oi[lt] = MFMA16(a, b, oi[lt]); } }
#pragma unroll
          for (int ks = 0; ks < 4; ++ks) { const bf16x8 b = *(const LAS bf16x8*)(ST + (16 * wave + fr) * 136 + 32 * ks + 8 * fq);
#pragma unroll
            for (int lt = 0; lt < 4; ++lt) { const bf16x8 a = *(const LAS bf16x8*)(Qs + (16 * lt + fr) * 136 + 32 * ks + 8 * fq); oc[lt] = MFMA16(a, b, oc[lt]); } }
#pragma unroll
          for (int lt = 0; lt < 4; ++lt)
#pragma unroll
            for (int r = 0; r < 4; ++r) { const int l = 16 * lt + 4 * fq + r; Os[l * 132 + 16 * wave + fr] = oi[lt][r] + exp2f(lg2 * (float)(l + 1)) * oc[lt][r]; } }
        __syncthreads();
#pragma unroll
        for (int et = 0; et < 8; ++et) { u32x2 w; w.x = pk2(st[et][0], st[et][1]); w.y = pk2(st[et][2], st[et][3]); *(LAS u32x2*)(ST + (16 * et + fr) * 136 + 16 * wave + 4 * fq) = w; }
        {
          const int l = 8 * wave + (lane >> 3), seg = lane & 7;
          const u32x4 gw0 = gv0, gw1 = gv1;
          const LAS f32x4* op = (const LAS f32x4*)(Os + l * 132 + 16 * seg);
          f32x4 ov[4]; float ssq = 0.f;
#pragma unroll
          for (int k = 0; k < 4; ++k) { ov[k] = op[k]; ssq += (ov[k].x * ov[k].x + ov[k].y * ov[k].y) + (ov[k].z * ov[k].z + ov[k].w * ov[k].w); }
          ssq += __int_as_float(__builtin_amdgcn_update_dpp(__float_as_int(ssq), __float_as_int(ssq), 0xB1, 0xf, 0xf, false));
          ssq += __int_as_float(__builtin_amdgcn_update_dpp(__float_as_int(ssq), __float_as_int(ssq), 0x4E, 0xf, 0xf, false));
          ssq += __int_as_float(__builtin_amdgcn_update_dpp(__float_as_int(ssq), __float_as_int(ssq), 0x141, 0xf, 0xf, false));
          const float rstd = __builtin_amdgcn_rsqf(ssq * (1.f / 128.f) + EPS);
          bf16* mp = mix + (size_t)(rowc + l) * DM + h * 128 + 16 * seg;
#pragma unroll
          for (int hf = 0; hf < 2; ++hf) {
              float gf[8]; unpack8(hf ? gw1 : gw0, gf);
              u32x4 w;
#pragma unroll
              for (int k = 0; k < 2; ++k) { const f32x4 o4 = ov[2 * hf + k];
                  w[2 * k] = pk2(silu_f(gf[4 * k]) * (o4.x * rstd), silu_f(gf[4 * k + 1]) * (o4.y * rstd)); w[2 * k + 1] = pk2(silu_f(gf[4 * k + 2]) * (o4.z * rstd), silu_f(gf[4 * k + 3]) * (o4.w * rstd)); }
              *(u32x4*)(mp + 8 * hf) = w;
              asm volatile("" ::: "memory");
          }
        }
    }
#pragma unroll
    for (int et = 0; et < 8; ++et)
#pragma unroll
        for (int r = 0; r < 4; ++r) st_out[(size_t)(16 * wave + 4 * fq + r) * 128 + 16 * et + fr] = st[et][r];
}
constexpr int AK = 0, AVT = 27648;
__device__ __forceinline__ void att_item(const Params& P, LAS unsigned char* lds, int tid, int wave, int lane, bool sample, int b, int n, int g) {
    const bf16* proj = (const bf16*)(P.ws + WS_R1);
    bf16* mix = (bf16*)(P.ws + WS_R2);
    const int fr = lane & 15, fq = lane >> 4;
    LAS bf16* Kl = (LAS bf16*)(lds + AK); LAS bf16* VTl = (LAS bf16*)(lds + AVT);
    const int qrow0 = sample ? MP + 64 * b : b * SEQ + 64 * n;
    const int jmin = sample ? 0 : (n >= 2 ? 0 : 64 * (2 - n));
    __syncthreads();
    bf16x8 qa[2][2];
    { const int hd_ = 4 * g + (wave >> 1), qh_ = wave & 1;
#pragma unroll
      for (int qt = 0; qt < 2; ++qt)
#pragma unroll
        for (int ks = 0; ks < 2; ++ks) qa[qt][ks] = *(const bf16x8*)(proj + (size_t)(qrow0 + 32 * qh_ + 16 * qt + fr) * INW + 2048 + hd_ * 64 + 32 * ks + 8 * fq); }
    {
        u32x4 kw[3], vw[3];
        if (!sample) {
#pragma unroll
            for (int i = 0; i < 3; ++i) { const bool ok = 64 * i >= jmin;
                const int rb = ok ? b * SEQ + 64 * (n - 2) + 64 * i : qrow0;
                kw[i] = *(const u32x4*)(proj + (size_t)(rb + (tid >> 3)) * INW + 2560 + g * 64 + 8 * (tid & 7));
                vw[i] = *(const u32x4*)(proj + (size_t)(rb + lane) * INW + 2688 + g * 64 + 8 * wave);
                if (!ok) { kw[i] = (u32x4){0u, 0u, 0u, 0u}; vw[i] = (u32x4){0u, 0u, 0u, 0u}; } }
        } else {
            f32x4 kc[2][2], vc[2][2];
#pragma unroll
            for (int i = 0; i < 2; ++i) { const float* sk = P.cache_k + ((size_t)(b * 128 + 64 * i + (tid >> 3)) * 2 + g) * 64 + 8 * (tid & 7); const float* sv = P.cache_v + ((size_t)(b * 128 + 64 * i + lane) * 2 + g) * 64 + 8 * wave;
                kc[i][0] = *(const f32x4*)sk; kc[i][1] = *(const f32x4*)(sk + 4); vc[i][0] = *(const f32x4*)sv; vc[i][1] = *(const f32x4*)(sv + 4); }
            kw[2] = *(const u32x4*)(proj + (size_t)(MP + 64 * b + (tid >> 3)) * INW + 2560 + g * 64 + 8 * (tid & 7));
            vw[2] = *(const u32x4*)(proj + (size_t)(MP + 64 * b + lane) * INW + 2688 + g * 64 + 8 * wave);
#pragma unroll
            for (int i = 0; i < 2; ++i) { kw[i].x = pk2(kc[i][0].x, kc[i][0].y); kw[i].y = pk2(kc[i][0].z, kc[i][0].w); kw[i].z = pk2(kc[i][1].x, kc[i][1].y); kw[i].w = pk2(kc[i][1].z, kc[i][1].w);
                vw[i].x = pk2(vc[i][0].x, vc[i][0].y); vw[i].y = pk2(vc[i][0].z, vc[i][0].w); vw[i].z = pk2(vc[i][1].x, vc[i][1].y); vw[i].w = pk2(vc[i][1].z, vc[i][1].w); }
        }
#pragma unroll
        for (int i = 0; i < 3; ++i) { *(LAS u32x4*)(Kl + (64 * i + (tid >> 3)) * 72 + 8 * (tid & 7)) = kw[i];
            const int j = 64 * i + lane;
#pragma unroll
            for (int e = 0; e < 4; ++e) { VTl[(8 * wave + 2 * e) * 200 + j] = (bf16)(vw[i][e] & 0xffffu); VTl[(8 * wave + 2 * e + 1) * 200 + j] = (bf16)(vw[i][e] >> 16); } }
    }
    const int r = wave >> 1, qh = wave & 1, head = 4 * g + r;
    const float nb8 = -8.0f * exp2f(-(float)(head + 1));
    const float sink8 = 8.0f * P.sinks[head];
    const float c1 = 0.125f * 1.4426950408889634f;
    __syncthreads();
#pragma unroll 1
    for (int qt = 0; qt < 2; ++qt) {
        asm volatile("" ::: "memory");
        const int qi = 32 * qh + 16 * qt + fr;
        bf16x8 qf[2];
#pragma unroll
        for (int ks = 0; ks < 2; ++ks) { const u32x4 x0 = __builtin_bit_cast(u32x4, qa[0][ks]), x1 = __builtin_bit_cast(u32x4, qa[1][ks]); u32x4 xs;
#pragma unroll
            for (int e = 0; e < 4; ++e) xs[e] = qt ? x1[e] : x0[e];
            qf[ks] = __builtin_bit_cast(bf16x8, xs); }
        const float basef = (float)(128 + qi - 4 * fq);
        f32x4 s[12];
#pragma unroll
        for (int kt = 0; kt < 12; ++kt) {
#pragma unroll
            for (int rr = 0; rr < 4; ++rr) s[kt][rr] = fabsf(basef - (float)(16 * kt + rr)) * nb8;
#pragma unroll
            for (int ks = 0; ks < 2; ++ks) { const bf16x8 a = *(const LAS bf16x8*)(Kl + (16 * kt + fr) * 72 + 32 * ks + 8 * fq); s[kt] = MFMA16(a, qf[ks], s[kt]); } }
        if (jmin > 0) {
#pragma unroll
            for (int kt = 0; kt < 12; ++kt)
#pragma unroll
                for (int rr = 0; rr < 4; ++rr) s[kt][rr] = (16 * kt + 4 * fq + rr) >= jmin ? s[kt][rr] : -INFINITY;
        }
        float mx = sink8;
#pragma unroll
        for (int kt = 0; kt < 12; ++kt)
#pragma unroll
            for (int rr = 0; rr < 4; ++rr) mx = fmaxf(mx, s[kt][rr]);
        mx = fmaxf(mx, __shfl_xor(mx, 16)); mx = fmaxf(mx, __shfl_xor(mx, 32));
        const float mxc = mx * c1;
        float ls = 0.f;
#pragma unroll
        for (int kt = 0; kt < 12; ++kt)
#pragma unroll
            for (int rr = 0; rr < 4; ++rr) { const float p = __builtin_amdgcn_exp2f(s[kt][rr] * c1 - mxc); s[kt][rr] = p; ls += p; }
        ls += __shfl_xor(ls, 16); ls += __shfl_xor(ls, 32);
        const float inv = 1.0f / (ls + __builtin_amdgcn_exp2f(sink8 * c1 - mxc));
        f32x4 o[4];
#pragma unroll
        for (int dt = 0; dt < 4; ++dt) o[dt] = (f32x4){0.f, 0.f, 0.f, 0.f};
#pragma unroll
        for (int kk = 0; kk < 6; ++kk) {
            u32x4 w; w.x = pk2(s[2 * kk][0], s[2 * kk][1]); w.y = pk2(s[2 * kk][2], s[2 * kk][3]); w.z = pk2(s[2 * kk + 1][0], s[2 * kk + 1][1]); w.w = pk2(s[2 * kk + 1][2], s[2 * kk + 1][3]);
            const bf16x8 pb = __builtin_bit_cast(bf16x8, w);
#pragma unroll
            for (int dt = 0; dt < 4; ++dt) { const LAS bf16* vp = VTl + (16 * dt + fr) * 200 + 32 * kk + 4 * fq;
                const u32x2 lo = *(const LAS u32x2*)vp, hi = *(const LAS u32x2*)(vp + 16);
                const u32x4 aw = (u32x4){lo.x, lo.y, hi.x, hi.y}; const bf16x8 a = __builtin_bit_cast(bf16x8, aw);
                o[dt] = MFMA16(a, pb, o[dt]); }
        }
        bf16* mp = mix + (size_t)(qrow0 + qi) * DM + 512 + head * 64 + 4 * fq;
#pragma unroll
        for (int dt = 0; dt < 4; ++dt) { const f32x4 v = o[dt] * inv; u32x2 w; w.x = pk2(v[0], v[1]); w.y = pk2(v[2], v[3]); *(u32x2*)(mp + 16 * dt) = w; }
    }
}
__device__ __forceinline__ void phase3(const Params& P, LAS unsigned char* lds, int tid, int wave, int lane) {
    const int G = gridDim.x, NR = G / 2, blk = blockIdx.x;
    {
        const bool sample = blk >= NR; const int bh = (sample ? blk - NR : blk) & 127, b = bh >> 2, h = bh & 3;
        if (blk < 2 * NR && (sample ? blk - NR : blk) < 128)
            ret_item(P, lds, tid, wave, lane, h, sample ? MP + 64 * b : b * SEQ, sample ? 1 : 32, P.state_ret + (size_t)bh * 16384, sample, P.out + (sample ? OFF_SRET : OFF_PRET) + (size_t)bh * 16384);
    }
    if (blk >= NR) {
        for (int it = blk - NR; it < 2112; it += G - NR) {
            const bool sample = it >= 2048;
            att_item(P, lds, tid, wave, lane, sample, sample ? (it - 2048) >> 1 : it >> 6, sample ? 2 : (it >> 1) & 31, it & 1);
        }
    }
}

__device__ __forceinline__ void phase6(const Params& P, int tid) {
    const bf16* ua = (const bf16*)(P.ws + WS_R1); bf16* ub = (bf16*)(P.ws + WS_R2);
    constexpr int CH = DFF / 8;
    const int total = MT * CH;
    for (int idx = blockIdx.x * 512 + tid; idx < total; idx += gridDim.x * 512) {
        const int row = idx / CH, j = (idx - row * CH) * 8;
        const bool smp = row >= MP; const int t = smp ? ((row - MP) & 63) : (row & 2047);
        float a[8], p1[8], p2[8], bb[8];
        unpack8(*(const u32x4*)(ua + (size_t)row * DFF + j), a);
        unpack8(*(const u32x4*)(ub + (size_t)row * DFF + j), bb);
        if (t >= 1) unpack8(*(const u32x4*)(ua + (size_t)(row - 1) * DFF + j), p1);
        else if (smp) { const float* s = P.state_conv + ((size_t)((row - MP) >> 6) * 2 + 1) * DFF + j; const f32x4 x = *(const f32x4*)s, y = *(const f32x4*)(s + 4); p1[0] = x.x; p1[1] = x.y; p1[2] = x.z; p1[3] = x.w; p1[4] = y.x; p1[5] = y.y; p1[6] = y.z; p1[7] = y.w; }
        else {
#pragma unroll
            for (int e = 0; e < 8; ++e) p1[e] = 0.f; }
        if (t >= 2) unpack8(*(const u32x4*)(ua + (size_t)(row - 2) * DFF + j), p2);
        else if (smp) { const float* s = P.state_conv + ((size_t)((row - MP) >> 6) * 2 + t) * DFF + j; const f32x4 x = *(const f32x4*)s, y = *(const f32x4*)(s + 4); p2[0] = x.x; p2[1] = x.y; p2[2] = x.z; p2[3] = x.w; p2[4] = y.x; p2[5] = y.y; p2[6] = y.z; p2[7] = y.w; }
        else {
#pragma unroll
            for (int e = 0; e < 8; ++e) p2[e] = 0.f; }
        float r[8];
#pragma unroll
        for (int h = 0; h < 2; ++h) { const f32x4 w0 = *(const f32x4*)(P.conv_w + j + 4 * h), w1 = *(const f32x4*)(P.conv_w + DFF + j + 4 * h), w2 = *(const f32x4*)(P.conv_w + 2 * DFF + j + 4 * h), cb = *(const f32x4*)(P.conv_b + j + 4 * h);
#pragma unroll
            for (int e = 0; e < 4; ++e) { const float cv = cb[e] + w0[e] * p2[4 * h + e] + w1[e] * p1[4 * h + e] + w2[e] * a[4 * h + e]; r[4 * h + e] = silu_f(cv) * bb[4 * h + e]; } }
        u32x4 w; w.x = pk2(r[0], r[1]); w.y = pk2(r[2], r[3]); w.z = pk2(r[4], r[5]); w.w = pk2(r[6], r[7]);
        *(u32x4*)(ub + (size_t)row * DFF + j) = w;
    }
}
#ifdef CONV_FUSED
__device__ __forceinline__ void phase6c(const Params& P, int tid) {
    const float* headA = (const float*)(P.ws + WS_R1); const float* headB = headA + HT_STRIDE; const float* tailA = headA + 2 * HT_STRIDE;
    bf16* act = (bf16*)(P.ws + WS_R2);
    constexpr int CH = DFF / 4;
    const int total = NGRP * CH;
    for (int idx = blockIdx.x * 512 + tid; idx < total; idx += gridDim.x * 512) {
        const int g = idx / CH, j = (idx - g * CH) * 4;
        const bool smp = g >= 1024, first = !smp && (g & 31) == 0;
        const float* pp = smp ? P.state_conv + ((size_t)(g - 1024) * 2) * DFF + j : tailA + ((size_t)(first ? g : g - 1) * 2) * DFF + j;
        f32x4 p0 = *(const f32x4*)pp, p1 = *(const f32x4*)(pp + DFF);
        const f32x4 a0 = *(const f32x4*)(headA + ((size_t)g * 2) * DFF + j), a1 = *(const f32x4*)(headA + ((size_t)g * 2 + 1) * DFF + j);
        const f32x4 b0 = *(const f32x4*)(headB + ((size_t)g * 2) * DFF + j), b1 = *(const f32x4*)(headB + ((size_t)g * 2 + 1) * DFF + j);
        const f32x4 t0 = *(const f32x4*)(tailA + ((size_t)g * 2) * DFF + j), t1 = *(const f32x4*)(tailA + ((size_t)g * 2 + 1) * DFF + j);
        const f32x4 w0 = *(const f32x4*)(P.conv_w + j), w1 = *(const f32x4*)(P.conv_w + DFF + j), w2 = *(const f32x4*)(P.conv_w + 2 * DFF + j), cb = *(const f32x4*)(P.conv_b + j);
        if (first) { p0 = (f32x4){0.f, 0.f, 0.f, 0.f}; p1 = (f32x4){0.f, 0.f, 0.f, 0.f}; }
        const f32x4 c0 = cb + w0 * p0 + w1 * p1 + w2 * a0, c1 = cb + w0 * p1 + w1 * a0 + w2 * a1;
        u32x2 r0, r1;
        r0.x = pk2(silu_f(c0.x) * b0.x, silu_f(c0.y) * b0.y); r0.y = pk2(silu_f(c0.z) * b0.z, silu_f(c0.w) * b0.w);
        r1.x = pk2(silu_f(c1.x) * b1.x, silu_f(c1.y) * b1.y); r1.y = pk2(silu_f(c1.z) * b1.z, silu_f(c1.w) * b1.w);
        *(u32x2*)(act + (size_t)(64 * g) * DFF + j) = r0;
        *(u32x2*)(act + (size_t)(64 * g + 1) * DFF + j) = r1;
        if (smp) { float* d = P.out + OFF_SCONV + ((size_t)(g - 1024) * 2) * DFF + j; *(f32x4*)d = t0; *(f32x4*)(d + DFF) = t1; }
        else if ((g & 31) == 31) { float* d = P.out + OFF_PCONV + ((size_t)(g >> 5) * 2) * DFF + j; *(f32x4*)d = t0; *(f32x4*)(d + DFF) = t1; }
    }
}
#endif
__device__ __forceinline__ void phase8n(const Params& P, LAS unsigned char* lds, int tid, int wave, int lane) {
    const float* mod = (const float*)(P.ws + WS_MOD); const bf16* x2 = (const bf16*)(P.ws + WS_R0);
    LAS float* lv = (LAS float*)lds;
    const int b = blockIdx.x, bsP = b >> 3, bsS = 32 + (b >> 3);
    __syncthreads();
    for (int i = tid; i < 4096; i += 512) { const int sl = i >> 11, which = (i >> 10) & 1, col = i & 1023; const float* mb = mod + (size_t)(sl ? bsS : bsP) * 8192 + 6144;
        lv[i] = which ? P.normf[col] * (1.f + mb[1024 + col]) : mb[col]; }
    __syncthreads();
#pragma unroll 4
    for (int r = wave; r < 256; r += 8) {
        const int row = 256 * b + r;
        const bf16* xr = x2 + (size_t)row * DM + 4 * lane;
        f32x4 v[4]; float ss = 0.f;
#pragma unroll
        for (int j = 0; j < 4; ++j) { const u32x2 w = *(const u32x2*)(xr + 256 * j); v[j] = (f32x4){bflo(w.x), bfhi(w.x), bflo(w.y), bfhi(w.y)};
            ss += (v[j].x * v[j].x + v[j].y * v[j].y) + (v[j].z * v[j].z + v[j].w * v[j].w); }
        const float rstd = __builtin_amdgcn_rsqf(wave_sum_dpp(ss) * (1.f / DM) + EPS);
        float* yr = P.out + (size_t)row * DM + 4 * lane;
#pragma unroll
        for (int j = 0; j < 4; ++j) { const f32x4 sh = *(const LAS f32x4*)(lv + 256 * j + 4 * lane), gs = *(const LAS f32x4*)(lv + 1024 + 256 * j + 4 * lane);
            *(f32x4*)(yr + 256 * j) = v[j] * rstd * gs + sh; }
    }
    {
        const int r = 8 * b + wave, row = MP + r;
        const bf16* xr = (const bf16*)(P.ws + WS_X1B) + (size_t)row * DM + 4 * lane;
        const float* sl = (const float*)(P.ws + WS_SLAB) + (size_t)r * DM + 4 * lane;
        const float* g2 = mod + (size_t)bsS * 8192 + 5120 + 4 * lane;
        f32x4 v[4]; float ss = 0.f;
#pragma unroll
        for (int j = 0; j < 4; ++j) { const u32x2 w = *(const u32x2*)(xr + 256 * j); f32x4 a = *(const f32x4*)(sl + 256 * j);
#pragma unroll
            for (int p = 1; p < 4; ++p) a += *(const f32x4*)(sl + (size_t)p * MS * DM + 256 * j);
            v[j] = (f32x4){bflo(w.x), bfhi(w.x), bflo(w.y), bfhi(w.y)} + *(const f32x4*)(g2 + 256 * j) * a;
            ss += (v[j].x * v[j].x + v[j].y * v[j].y) + (v[j].z * v[j].z + v[j].w * v[j].w); }
        const float rstd = __builtin_amdgcn_rsqf(wave_sum_dpp(ss) * (1.f / DM) + EPS);
        float* yr = P.out + (size_t)row * DM + 4 * lane;
#pragma unroll
        for (int j = 0; j < 4; ++j) { const f32x4 sh = *(const LAS f32x4*)(lv + 2048 + 256 * j + 4 * lane), gs = *(const LAS f32x4*)(lv + 3072 + 256 * j + 4 * lane);
            *(f32x4*)(yr + 256 * j) = v[j] * rstd * gs + sh; }
    }
}
__device__ __forceinline__ void phase8(const Params& P, int wave, int lane) {
    const float* mod = (const float*)(P.ws + WS_MOD); const bf16* x2 = (const bf16*)(P.ws + WS_R0);
    const int gw = blockIdx.x * 8 + wave, NGW = gridDim.x * 8;
#pragma unroll 2
    for (int row = gw; row < MT; row += NGW) {
        const int bs = row < MP ? (row >> 11) : 32 + ((row - MP) >> 6);
        float* yr = P.out + (size_t)row * DM + 8 * lane;
        const float* mb = mod + (size_t)bs * 8192 + 6144 + 8 * lane;
        float v[2][8]; float ss = 0.f;
        if (row < MP) {
            const bf16* xr = x2 + (size_t)row * DM + 8 * lane;
#pragma unroll
            for (int j = 0; j < 2; ++j) unpack8(*(const u32x4*)(xr + 512 * j), v[j]);
        } else {
            const bf16* xr = (const bf16*)(P.ws + WS_X1B) + (size_t)row * DM + 8 * lane;
            const float* sl = (const float*)(P.ws + WS_SLAB) + (size_t)(row - MP) * DM + 8 * lane;
            const float* g2 = mod + (size_t)bs * 8192 + 5120 + 8 * lane;
#pragma unroll
            for (int j = 0; j < 2; ++j) { unpack8(*(const u32x4*)(xr + 512 * j), v[j]);
#pragma unroll
                for (int h = 0; h < 2; ++h) { const int o = 512 * j + 4 * h; f32x4 a = *(const f32x4*)(sl + o);
#pragma unroll
                    for (int p = 1; p < 4; ++p) a += *(const f32x4*)(sl + (size_t)p * MS * DM + o);
                    const f32x4 g = *(const f32x4*)(g2 + o);
#pragma unroll
                    for (int e = 0; e < 4; ++e) v[j][4 * h + e] += g[e] * a[e]; } }
        }
#pragma unroll
        for (int j = 0; j < 2; ++j)
#pragma unroll
            for (int e = 0; e < 8; ++e) ss += v[j][e] * v[j][e];
        const float rstd = rsqrtf(wave_sum(ss) * (1.f / DM) + EPS);
#pragma unroll
        for (int j = 0; j < 2; ++j)
#pragma unroll
            for (int h = 0; h < 2; ++h) { const int o = 512 * j + 4 * h; const f32x4 sh = *(const f32x4*)(mb + o), sc = *(const f32x4*)(mb + 1024 + o), gn = *(const f32x4*)(P.normf + 8 * lane + o);
                const f32x4 x = (f32x4){v[j][4 * h], v[j][4 * h + 1], v[j][4 * h + 2], v[j][4 * h + 3]};
                *(f32x4*)(yr + o) = x * rstd * gn * (sc + 1.0f) + sh; }
    }
}
__device__ __forceinline__ void phase8q(const Params& P, LAS unsigned char* lds, int tid, int wave, int lane) {
    const float* mod = (const float*)(P.ws + WS_MOD);
    unsigned* cnt = (unsigned*)(P.ws + WS_CNT7); unsigned* ticket = (unsigned*)(P.ws + WS_TICKET);
    LAS int* ord = (LAS int*)(lds + 131072);
    LAS int* flag = ord + 272;
    pg8::StaticOrder S; S.init(MT, DM, (int)gridDim.x, 0);
    for (int i = tid; i < NTM; i += 512) flag[i] = 0;
    __syncthreads();
    { const int full = (S.nwg / S.G) * S.G; for (int L = full + tid; L < S.nwg; L += 512) { pg8::Unit u; S.map(L, u); flag[u.pm] = 1; } }
    __syncthreads();
    if (tid == 0) { int k = 0; for (int i = 0; i < NTM; ++i) if (!flag[i]) ord[k++] = i; for (int i = 0; i < NTM; ++i) if (flag[i]) ord[k++] = i; }
    __syncthreads();
    for (;;) {
        if (tid == 0) flag[268] = (int)__hip_atomic_fetch_add(ticket, 1u, __ATOMIC_RELAXED, __HIP_MEMORY_SCOPE_AGENT);
        __syncthreads();
        const int tk = flag[268];
        if (tk >= NTM * 4) break;
        const int pm = ord[tk >> 2], rb = tk & 3;
        if (wave == 0) {
            unsigned spins = 0;
            while ((unsigned)__builtin_amdgcn_readfirstlane(__hip_atomic_load(cnt + 64 * pm, __ATOMIC_RELAXED, __HIP_MEMORY_SCOPE_AGENT)) < 32u) { __builtin_amdgcn_s_sleep(4); if (++spins > (1u << 22)) break; }
            __builtin_amdgcn_fence(__ATOMIC_ACQUIRE, "agent");
            asm volatile("s_waitcnt vmcnt(0)" ::: "memory");
        }
        __syncthreads();
#pragma unroll 2
        for (int i = 0; i < 8; ++i) {
            const int row = pm * 256 + rb * 64 + wave * 8 + i;
            const int bs = row < MP ? (row >> 11) : 32 + ((row - MP) >> 6);
            float* yr = P.out + (size_t)row * DM + 4 * lane;
            const float* mb = mod + (size_t)bs * 8192 + 6144 + 4 * lane;
            f32x4 v[4]; float ss = 0.f;
#pragma unroll
            for (int j = 0; j < 4; ++j) { v[j] = *(const f32x4*)(yr + 256 * j); ss += (v[j].x * v[j].x + v[j].y * v[j].y) + (v[j].z * v[j].z + v[j].w * v[j].w); }
            const float rstd = rsqrtf(wave_sum(ss) * (1.f / DM) + EPS);
#pragma unroll
            for (int j = 0; j < 4; ++j) { const f32x4 sh = *(const f32x4*)(mb + 256 * j), sc = *(const f32x4*)(mb + 1024 + 256 * j), gn = *(const f32x4*)(P.normf + 4 * lane + 256 * j);
                *(f32x4*)(yr + 256 * j) = v[j] * rstd * gn * (sc + 1.0f) + sh; }
        }
    }
}

__device__ __forceinline__ void sample_fix(const Params& P, int wave, int lane) {
    const float* mod = (const float*)(P.ws + WS_MOD); const float* sl0 = (const float*)(P.ws + WS_SLAB4);
    bf16* a2 = (bf16*)(P.ws + WS_R0); bf16* x1b = (bf16*)(P.ws + WS_X1B); float* ss1 = (float*)(P.ws + WS_SS1);
    const int gw = blockIdx.x * 8 + wave, NGW = gridDim.x * 8;
    for (int r = gw; r < MS; r += NGW) {
        const int row = MP + r, bs = 32 + (r >> 6);
        const float* xr = P.x_s + (size_t)r * DM + 8 * lane; const float* sl = sl0 + (size_t)r * DM + 8 * lane; const float* mb = mod + (size_t)bs * 8192 + 8 * lane;
        float v[2][8], a[2][8]; float ss = 0.f;
#pragma unroll
        for (int j = 0; j < 2; ++j)
#pragma unroll
            for (int h = 0; h < 2; ++h) { const int o = 512 * j + 4 * h; f32x4 acc = *(const f32x4*)(sl + o);
#pragma unroll
                for (int p = 1; p < 4; ++p) acc += *(const f32x4*)(sl + (size_t)p * MS * DM + o);
                const f32x4 x = *(const f32x4*)(xr + o) + *(const f32x4*)(mb + 2048 + o) * acc;
                const f32x4 gs = *(const f32x4*)(P.ln2 + 8 * lane + o) * (*(const f32x4*)(mb + 4096 + o) + 1.0f);
#pragma unroll
                for (int e = 0; e < 4; ++e) { v[j][4 * h + e] = x[e]; a[j][4 * h + e] = x[e] * gs[e]; ss += x[e] * x[e]; } }
        ss = wave_sum(ss);
#pragma unroll
        for (int j = 0; j < 2; ++j) { u32x4 w; w.x = pk2(v[j][0], v[j][1]); w.y = pk2(v[j][2], v[j][3]); w.z = pk2(v[j][4], v[j][5]); w.w = pk2(v[j][6], v[j][7]);
            *(u32x4*)(x1b + (size_t)row * DM + 8 * lane + 512 * j) = w;
            w.x = pk2(a[j][0], a[j][1]); w.y = pk2(a[j][2], a[j][3]); w.z = pk2(a[j][4], a[j][5]); w.w = pk2(a[j][6], a[j][7]);
            *(u32x4*)(a2 + (size_t)row * DM + 8 * lane + 512 * j) = w; }
        if (lane < 16) ss1[(size_t)row * 16 + lane] = lane == 0 ? ss : 0.f;
    }
}

#ifndef N_LAUNCH
#define N_LAUNCH 1
#endif
#define LAUNDER_TID() int tid = threadIdx.x; asm volatile("" : "+v"(tid)); const int lane = tid & 63, wave = __builtin_amdgcn_readfirstlane(tid >> 6); (void)lane; (void)wave
template <int PHM>
__global__ void __launch_bounds__(512) fwd_mega(Params P) {
    extern __shared__ __attribute__((aligned(16))) unsigned char lds_raw[];
    LAS unsigned char* lds = (LAS unsigned char*)lds_raw;
    const int G = gridDim.x;
    unsigned char* ws = P.ws;
    volatile LAS unsigned* misc = (volatile LAS unsigned*)(lds + LDS_MISC);
    if (threadIdx.x < 2) misc[threadIdx.x] = 0u;
    __syncthreads();
    XcdBarrier bar; bar.bar = (unsigned*)(ws + WS_BAR); bar.x = 0; bar.st = misc;
#define GSYNC(a, b) do { if ((PHM & (a)) && (PHM & (b))) xcd_barrier(bar); } while (0)
    if constexpr (PHM == 511) {
      if (blockIdx.x == 0) for (int i = threadIdx.x; i < XCD_BAR_WORDS; i += 512) ((unsigned*)(ws + WS_BAR))[i] = 0u;
      if (blockIdx.x == 1) { for (int i = threadIdx.x; i < NTM * 64; i += 512) ((unsigned*)(ws + WS_CNT7))[i] = 0u; if (threadIdx.x < 64) ((unsigned*)(ws + WS_TICKET))[threadIdx.x] = 0u; }
      cg::this_grid().sync();
      bar = xcd_barrier_post((unsigned*)(ws + WS_BAR), misc); }
    if constexpr ((PHM & 1) != 0) { LAUNDER_TID(); phase0(P, lds, wave, lane); }
    GSYNC(1, 2);
    if constexpr ((PHM & 2) != 0) { LAUNDER_TID(); phase1(P, lds, tid, wave, lane); }
    GSYNC(2, 4);
    if constexpr ((PHM & 4) != 0) {
      pg8::Gemm g{(const bf16*)(ws + WS_R0), (const bf16*)(ws + WS_WIN), MT, INW, DM};
      OrderX S; S.S.init(MT, INW, G, (int)blockIdx.x); S.nX = 22; S.xpm = NTM; S.xpn0 = 11;
      Epi1 E{(bf16*)(ws + WS_R1), (float*)(ws + WS_SHW), P.out};
      pg8::gemm_phase<Epi1, OrderX, true, true>(lds, g, S, E); }
    GSYNC(4, 8);
    if constexpr ((PHM & 8) != 0) { LAUNDER_TID(); phase3(P, lds, tid, wave, lane);
#ifdef PROBE_P3X2
      cg::this_grid().sync(); phase3(P, lds, tid, wave, lane);
#endif
    }
    GSYNC(8, 16);
    if constexpr ((PHM & 16) != 0) {
      pg8::Gemm g{(const bf16*)(ws + WS_R2), (const bf16*)(ws + WS_WOUT), MT, DM, DM};
      OrderDown S; S.S.init(MP, DM, G, (int)blockIdx.x); S.ka = 4; S.kb = 4;
      Epi2 E{P.x_p, P.x_s, (const float*)(ws + WS_MOD), P.ln2, (bf16*)(ws + WS_X1B), (bf16*)(ws + WS_R0), (float*)(ws + WS_SS1), (float*)(ws + WS_SLAB4)};
      pg8::gemm_phase<Epi2, OrderDown, true, true>(lds, g, S, E); }
    GSYNC(16, 32);
    if constexpr ((PHM & 32) != 0) {
      LAUNDER_TID();
      sample_fix(P, wave, lane);
      if constexpr (PHM == 511) xcd_barrier(bar);
      pg8::Gemm g{(const bf16*)(ws + WS_R0), (const bf16*)(ws + WS_WUP), MT, 2 * DFF, DM};
      pg8::StaticOrder S; S.init(MT, 2 * DFF, G, (int)blockIdx.x);
      LAS float* rtab = (LAS float*)(lds + 131072);
      {
        LAS int* pmt = (LAS int*)lds;
        if (tid < 24) { pg8::Unit u; const bool ok = S.next(tid, u); pmt[tid] = ok ? u.pm : -1; }
        __syncthreads();
        if (tid < 256) { const float* ss = (const float*)(ws + WS_SS1);
#pragma unroll
          for (int i0 = 0; i0 < 24; i0 += 6) {
            f32x4 q[6][4]; int pmv[6];
#pragma unroll
            for (int k = 0; k < 6; ++k) { pmv[k] = pmt[i0 + k]; const f32x4* sp = (const f32x4*)(ss + (size_t)((pmv[k] < 0 ? 0 : pmv[k]) * 256 + tid) * 16);
#pragma unroll
                for (int e = 0; e < 4; ++e) q[k][e] = sp[e]; }
#pragma unroll
            for (int k = 0; k < 6; ++k) { const float tot = ((q[k][0].x + q[k][0].y) + (q[k][0].z + q[k][0].w)) + ((q[k][1].x + q[k][1].y) + (q[k][1].z + q[k][1].w)) + ((q[k][2].x + q[k][2].y) + (q[k][2].z + q[k][2].w)) + ((q[k][3].x + q[k][3].y) + (q[k][3].z + q[k][3].w));
                rtab[(i0 + k) * 256 + tid] = __builtin_amdgcn_rsqf(tot * (1.f / DM) + EPS); } } }
        __syncthreads(); }
#ifdef CONV_FUSED
      float* hA = (float*)(ws + WS_R1);
      Epi3C E{rtab, (const float*)(ws + WS_SHW), P.conv_w, P.conv_b, (bf16*)(ws + WS_R2), hA, hA + HT_STRIDE, hA + 2 * HT_STRIDE};
      pg8::gemm_phase<Epi3C, pg8::StaticOrder, true, true>(lds, g, S, E);
#else
      Epi3 E{rtab, (const float*)(ws + WS_SHW), (bf16*)(ws + WS_R1), (bf16*)(ws + WS_R2), P.out};
      pg8::gemm_phase<Epi3, pg8::StaticOrder, true, true>(lds, g, S, E);
#endif
#ifdef PROBE_P5X2
      cg::this_grid().sync(); pg8::gemm_phase<Epi3, pg8::StaticOrder, true, true>(lds, g, S, E);
#endif
    }
    GSYNC(32, 64);
#ifdef CONV_FUSED
    if constexpr ((PHM & 64) != 0) { LAUNDER_TID(); phase6c(P, tid); }
#else
    if constexpr ((PHM & 64) != 0) { LAUNDER_TID(); phase6(P, tid); }
#endif
    GSYNC(64, 128);
    if constexpr ((PHM & 128) != 0) {
      pg8::Gemm g{(const bf16*)(ws + WS_R2), (const bf16*)(ws + WS_WDN), MT, DM, DFF};
#ifdef P8_QUEUE
      OrderPub S; S.init(MT, DM, G, (int)blockIdx.x); S.cnt = (unsigned*)(ws + WS_CNT7);
      Epi4 E{(const float*)(ws + WS_MOD), (const bf16*)(ws + WS_X1B), (bf16*)(ws + WS_R0), (float*)(ws + WS_SLAB)};
      pg8::gemm_phase<Epi4, OrderPub, true, true>(lds, g, S, E); }
    if constexpr ((PHM & 256) != 0) { LAUNDER_TID(); phase8q(P, lds, tid, wave, lane); }
#else
      OrderDown S; S.S.init(MP, DM, G, (int)blockIdx.x); S.ka = 12; S.kb = 10;
      Epi4 E{(const float*)(ws + WS_MOD), (const bf16*)(ws + WS_X1B), (bf16*)(ws + WS_R0), (float*)(ws + WS_SLAB)};
      pg8::gemm_phase<Epi4, OrderDown, true, true>(lds, g, S, E); }
    GSYNC(128, 256);
    if constexpr ((PHM & 256) != 0) { LAUNDER_TID(); if (gridDim.x == 256) phase8n(P, lds, tid, wave, lane); else phase8(P, wave, lane); }
#endif
}

template <int PHM> static bool launch_one(const Params& p, int grid, bool coop, hipStream_t stream) {
    static bool attr_done = false;
    if (!attr_done) { if (hipFuncSetAttribute((const void*)fwd_mega<PHM>, hipFuncAttributeMaxDynamicSharedMemorySize, LDS_BYTES) != hipSuccess) { fprintf(stderr, "kernel_launch: hipFuncSetAttribute failed\n"); return false; } attr_done = true; }
    hipError_t e;
    if (coop) { Params pc = p; void* args[] = {&pc}; e = hipLaunchCooperativeKernel((const void*)fwd_mega<PHM>, dim3(grid), dim3(512), args, LDS_BYTES, stream); }
    else { hipLaunchKernelGGL(fwd_mega<PHM>, dim3(grid), dim3(512), LDS_BYTES, stream, p); e = hipPeekAtLastError(); }
    if (e != hipSuccess) { fprintf(stderr, "launch (mask %d) failed: %s (grid %d)\n", PHM, hipGetErrorString(e), grid); return false; }
    return true;
}
extern "C" void kernel_launch(void* const* d_in, const int* in_sizes, int n_in, void* d_out, int out_size, void* d_ws, size_t ws_size, hipStream_t stream) {
    static int grid = 0;
    if (grid == 0) {
        if (n_in != 22 || (size_t)out_size != OUT_TOTAL || ws_size < WS_END) { fprintf(stderr, "kernel_launch: unexpected sizes n_in %d out %d ws %zu\n", n_in, out_size, ws_size); grid = -1; return; }
        int dev = 0, cus = 0;
        (void)hipGetDevice(&dev);
        (void)hipDeviceGetAttribute(&cus, hipDeviceAttributeMultiprocessorCount, dev);
        grid = cus;
        if (grid > 256) grid = 256;
        if (grid < 2) grid = -1;
    }
    if (grid < 0) return;
    Params p{};
    const float** pp = (const float**)&p;
    for (int i = 0; i < 22; ++i) pp[i] = (const float*)d_in[i];
    p.out = (float*)d_out; p.ws = (unsigned char*)d_ws;
#if N_LAUNCH == 1
    launch_one<511>(p, grid, true, stream);
#else
    launch_one<1>(p, grid, false, stream) && launch_one<2>(p, grid, false, stream) && launch_one<4>(p, grid, false, stream) && launch_one<8>(p, grid, false, stream) &&
    launch_one<16>(p, grid, false, stream) && launch_one<32>(p, grid, false, stream) && launch_one<64>(p, grid, false, stream) && launch_one<128>(p, grid, false, stream) && launch_one<256>(p, grid, false, stream);
#endif
}
```

```cpp
#define CONV_FUSED 1
#include <hip/hip_runtime.h>
#include <hip/hip_cooperative_groups.h>
#include <cstdio>
#include <cstdint>
namespace cg = cooperative_groups;
namespace pg8 {
#define PG8_LAS __attribute__((address_space(3)))
typedef unsigned short bf16_t;
typedef short bf16x8 __attribute__((ext_vector_type(8)));
typedef float f32x4 __attribute__((ext_vector_type(4)));
typedef unsigned u32x4 __attribute__((ext_vector_type(4)));
constexpr int BM = 256, BK = 64, HALF = 128, HTB = HALF * BK * 2  , STAGE_BYTES = 8 * HTB, NXCD = 8, WGM = 8;

__host__ __device__ __forceinline__ int lds_byte(int r, int c) { const int st = (r >> 4) * 2 + (c >> 5), rr = r & 15, cc = c & 31, ob = rr * 64 + cc * 2; return st * 1024 + (ob ^ (((ob >> 9) & 1) << 5)); }
__host__ __device__ __forceinline__ void stage_rc(int b, int& R, int& C) { const int st = b / 1024, sb = b % 1024, swz = sb ^ (((sb >> 9) & 1) << 5); R = (st >> 1) * 16 + swz / 64; C = (st & 1) * 32 + (swz % 64) / 2; }
__host__ __device__ __forceinline__ int perm32(int rho) { const int n = rho >> 4, i = rho & 15; return 8 * (i >> 2) + 4 * n + (i & 3); }

struct Unit { int pm, pn, seq, kt0, nt; };
struct Gemm { const bf16_t* A; const bf16_t* Bt; int M, N, K; };

struct StaticOrder {
    int nM, nN, nwg, G, c;
    __host__ __device__ __forceinline__ void init(int M, int N, int G_, int c_) { nM = M / BM; nN = N / BM; nwg = nM * nN; G = G_; c = c_; }
    __host__ __device__ __forceinline__ bool next(int i, Unit& u) const {
        const long L = (long)i * G + c; if (L >= nwg) return false; u.seq = i; u.kt0 = 0; u.nt = 0; map(L, u); return true; }
    __host__ __device__ __forceinline__ void map(long L, Unit& u) const {
        int wgid = (int)L; { const int q = nwg / NXCD, r = nwg % NXCD, xcd = wgid % NXCD, off = wgid / NXCD; wgid = (xcd < r ? xcd * (q + 1) : r * (q + 1) + (xcd - r) * q) + off; }
        const int nig = WGM * nN, gid = wgid / nig, fm = gid * WGM, gsz = (nM - fm) < WGM ? (nM - fm) : WGM;
        u.pm = fm + ((wgid % nig) % gsz); u.pn = (wgid % nig) / gsz;
    }
    __device__ __forceinline__ void a_ready(const Unit&) const {}
    __device__ __forceinline__ void done(const Unit&) const {}
};

__device__ __forceinline__ unsigned cvt_pk_bf16(float lo, float hi) { unsigned r; asm volatile("v_cvt_pk_bf16_f32 %0, %1, %2" : "=v"(r) : "v"(lo), "v"(hi)); return r; }

template <class Epi, class Sched, bool ALIGN_EPI = false, bool SP2 = false>
__device__ __forceinline__ void gemm_phase(PG8_LAS unsigned char* lds, const Gemm g, const Sched& S, const Epi& E) {
    int tid_ = threadIdx.x; asm volatile("" : "+v"(tid_));
    const int tid = tid_, wid = __builtin_amdgcn_readfirstlane(tid >> 6), lane = tid & 63, wr = wid >> 2, wc = wid & 3, fr = lane & 15, fq = lane >> 4;
    const int K = g.K, nt = K / BK;
    unsigned voffA[2], voffB[2];
#pragma unroll
    for (int i = 0; i < 2; ++i) { int R, C; stage_rc(tid * 16 + i * 8192, R, C); const int Rb = Epi::PERM ? ((R & ~31) + perm32(R & 31)) : R;
        voffA[i] = (unsigned)(R * K + C) * 2u; voffB[i] = (unsigned)(Rb * K + C) * 2u; }
    const size_t kstep = (size_t)(BK * 2);
    const size_t hstep = (size_t)HALF * K * 2;
    const size_t tstep = 2 * hstep;
    const unsigned ldsw = (unsigned)wid * 1024u;
    const int aoff = lds_byte(wr * 64 + fr, fq * 8), boff = lds_byte(wc * 32 + fr, fq * 8);
#define PG8_SA(b, h) (((b) * 2 + (h)) * HTB)
#define PG8_SB(b, h) ((4 + (b) * 2 + (h)) * HTB)
#define PG8_STAGE(bufoff, gbase, voff) do { _Pragma("unroll") for (int _i = 0; _i < 2; ++_i) \
        __builtin_amdgcn_global_load_lds((const unsigned*)((const char*)(gbase) + (voff)[_i]), (PG8_LAS unsigned*)(lds + (bufoff) + ldsw + _i * 8192), 16, 0, 0); } while (0)
#define PG8_LDA(dst, b, h) do { _Pragma("unroll") for (int m = 0; m < 4; ++m) _Pragma("unroll") for (int k = 0; k < 2; ++k) dst[m][k] = *(const PG8_LAS bf16x8*)(lds + PG8_SA(b, h) + aoff + m * 2048 + k * 1024); } while (0)
#define PG8_LDB(dst, b, h) do { _Pragma("unroll") for (int n = 0; n < 2; ++n) _Pragma("unroll") for (int k = 0; k < 2; ++k) dst[n][k] = *(const PG8_LAS bf16x8*)(lds + PG8_SB(b, h) + boff + n * 2048 + k * 1024); } while (0)
#define PG8_MMA(ai, bj, At, Bt) do { __builtin_amdgcn_s_setprio(1); _Pragma("unroll") for (int m = 0; m < 4; ++m) _Pragma("unroll") for (int n = 0; n < 2; ++n) _Pragma("unroll") for (int k = 0; k < 2; ++k) \
        acc[ai][bj][m][n] = __builtin_amdgcn_mfma_f32_16x16x32_bf16(Bt[n][k], At[m][k], acc[ai][bj][m][n], 0, 0, 0); __builtin_amdgcn_s_setprio(0); } while (0)
#define PG8_WAIT_V(n) asm volatile("s_waitcnt vmcnt(" #n ")" ::: "memory")
#define PG8_WAIT_L(n) asm volatile("s_waitcnt lgkmcnt(" #n ")" ::: "memory")
#define PG8_BAR __builtin_amdgcn_s_barrier()
#define PG8_SCHED __builtin_amdgcn_sched_barrier(0)
    Unit cur, nxt; int ui = 0;
    if (!S.next(0, cur)) return;
    f32x4 acc[2][2][4][2];
#pragma unroll
    for (int a = 0; a < 2; ++a)
#pragma unroll
        for (int b = 0; b < 2; ++b)
#pragma unroll
            for (int m = 0; m < 4; ++m)
#pragma unroll
                for (int n = 0; n < 2; ++n) acc[a][b][m][n] = (f32x4){0.f, 0.f, 0.f, 0.f};
    bf16x8 At[4][2], B0[2][2], B1[2][2];
    const char* cA = (const char*)g.A + (size_t)cur.pm * tstep + (size_t)cur.kt0 * (BK * 2); const char* cB = (const char*)g.Bt + (size_t)cur.pn * tstep + (size_t)cur.kt0 * (BK * 2);
    S.a_ready(cur);
    if constexpr (SP2) {
        PG8_STAGE(PG8_SB(0, 0), cB, voffB); PG8_STAGE(PG8_SB(0, 1), cB + hstep, voffB); PG8_STAGE(PG8_SA(0, 0), cA, voffA); PG8_STAGE(PG8_SA(0, 1), cA + hstep, voffA);
        if (wr == 1) PG8_BAR;
        PG8_WAIT_V(2); PG8_BAR;
        PG8_STAGE(PG8_SB(1, 0), cB + kstep, voffB); PG8_STAGE(PG8_SA(1, 0), cA + kstep, voffA); PG8_STAGE(PG8_SB(1, 1), cB + hstep + kstep, voffB);
        PG8_WAIT_V(6); PG8_BAR;
    } else {
        PG8_STAGE(PG8_SB(0, 0), cB, voffB); PG8_STAGE(PG8_SA(0, 0), cA, voffA); PG8_STAGE(PG8_SB(0, 1), cB + hstep, voffB); PG8_STAGE(PG8_SA(0, 1), cA + hstep, voffA);
        if (wr == 1) PG8_BAR;
        PG8_WAIT_V(4); PG8_BAR;
        PG8_STAGE(PG8_SB(1, 0), cB + kstep, voffB); PG8_STAGE(PG8_SA(1, 0), cA + kstep, voffA); PG8_STAGE(PG8_SB(1, 1), cB + hstep + kstep, voffB);
        PG8_WAIT_V(6); PG8_BAR;
    }
    for (;;) {
        const bool has_next = S.next(ui + 1, nxt);
        const char* nA = has_next ? (const char*)g.A + (size_t)nxt.pm * tstep + (size_t)nxt.kt0 * (BK * 2) : cA; const char* nB = has_next ? (const char*)g.Bt + (size_t)nxt.pn * tstep + (size_t)nxt.kt0 * (BK * 2) : cB;
        const int ntu = cur.nt ? cur.nt : nt;
        for (int t = 0; t < ntu; t += 2) {
            const bool last = (t == ntu - 2);
            const char* a1 = cA + (size_t)(t + 1) * kstep;
            const char* a2 = last ? nA : cA + (size_t)(t + 2) * kstep; const char* b2 = last ? nB : cB + (size_t)(t + 2) * kstep;
            const char* a3 = a2 + kstep; const char* b3 = b2 + kstep;
            if (last && has_next) S.a_ready(nxt);
            if constexpr (SP2) {
            PG8_LDB(B0, 0, 0); PG8_LDB(B1, 0, 1); PG8_SCHED; PG8_LDA(At, 0, 0); PG8_STAGE(PG8_SA(1, 1), a1 + hstep, voffA);
            PG8_WAIT_V(8); PG8_WAIT_L(0); PG8_BAR; PG8_MMA(0, 0, At, B0); PG8_MMA(0, 1, At, B1); PG8_BAR; PG8_SCHED;
            PG8_LDA(At, 0, 1); PG8_STAGE(PG8_SB(0, 0), b2, voffB); PG8_STAGE(PG8_SB(0, 1), b2 + hstep, voffB); PG8_STAGE(PG8_SA(0, 0), a2, voffA);
            PG8_WAIT_V(8); PG8_WAIT_L(0); PG8_BAR; PG8_MMA(1, 0, At, B0); PG8_MMA(1, 1, At, B1); PG8_BAR; PG8_SCHED;
            PG8_LDB(B0, 1, 0); PG8_LDB(B1, 1, 1); PG8_SCHED; PG8_LDA(At, 1, 0); PG8_STAGE(PG8_SA(0, 1), a2 + hstep, voffA);
            PG8_WAIT_V(8); PG8_WAIT_L(0); PG8_BAR; PG8_MMA(0, 0, At, B0); PG8_MMA(0, 1, At, B1); PG8_BAR; PG8_SCHED;
            PG8_LDA(At, 1, 1); PG8_STAGE(PG8_SB(1, 0), b3, voffB); PG8_STAGE(PG8_SB(1, 1), b3 + hstep, voffB); PG8_STAGE(PG8_SA(1, 0), a3, voffA);
            PG8_WAIT_V(8); PG8_WAIT_L(0); PG8_BAR; PG8_MMA(1, 0, At, B0); PG8_MMA(1, 1, At, B1); PG8_BAR; PG8_SCHED;
            } else {
            PG8_LDB(B0, 0, 0); PG8_SCHED; PG8_LDA(At, 0, 0); PG8_STAGE(PG8_SA(1, 1), a1 + hstep, voffA);
            PG8_WAIT_L(8); PG8_BAR; PG8_WAIT_L(0); PG8_MMA(0, 0, At, B0); PG8_BAR; PG8_SCHED;
            PG8_LDB(B1, 0, 1); PG8_STAGE(PG8_SB(0, 0), b2, voffB);
            PG8_BAR; PG8_WAIT_L(0); PG8_MMA(0, 1, At, B1); PG8_BAR;
            PG8_LDA(At, 0, 1); PG8_STAGE(PG8_SA(0, 0), a2, voffA);
            PG8_BAR; PG8_WAIT_L(0); PG8_MMA(1, 0, At, B0); PG8_BAR; PG8_SCHED;
            PG8_STAGE(PG8_SB(0, 1), b2 + hstep, voffB);
            PG8_WAIT_V(6); PG8_BAR; PG8_MMA(1, 1, At, B1); PG8_BAR;
            PG8_LDB(B0, 1, 0); PG8_SCHED; PG8_LDA(At, 1, 0); PG8_STAGE(PG8_SA(0, 1), a2 + hstep, voffA);
            PG8_WAIT_L(8); PG8_BAR; PG8_WAIT_L(0); PG8_MMA(0, 0, At, B0); PG8_BAR; PG8_SCHED;
            PG8_LDB(B1, 1, 1); PG8_STAGE(PG8_SB(1, 0), b3, voffB);
            PG8_BAR; PG8_WAIT_L(0); PG8_MMA(0, 1, At, B1); PG8_BAR;
            PG8_LDA(At, 1, 1); PG8_STAGE(PG8_SA(1, 0), a3, voffA);
            PG8_BAR; PG8_WAIT_L(0); PG8_MMA(1, 0, At, B0); PG8_BAR; PG8_SCHED;
            PG8_STAGE(PG8_SB(1, 1), b3 + hstep, voffB);
            PG8_WAIT_V(6); PG8_BAR; PG8_MMA(1, 1, At, B1); PG8_BAR;
            }
        }
        if constexpr (ALIGN_EPI) { if (wr == 0) PG8_BAR; }
        if constexpr (!Epi::AFTER_DRAIN) { E(acc, cur, wr, wc, fr, fq); S.done(cur); }
        if (!has_next) break;
#pragma unroll
        for (int a = 0; a < 2; ++a)
#pragma unroll
            for (int b = 0; b < 2; ++b)
#pragma unroll
                for (int m = 0; m < 4; ++m)
#pragma unroll
                    for (int n = 0; n < 2; ++n) acc[a][b][m][n] = (f32x4){0.f, 0.f, 0.f, 0.f};
        cur = nxt; cA = nA; cB = nB; ++ui;
        if constexpr (ALIGN_EPI) { if (wr == 1) PG8_BAR; }
    }
    PG8_WAIT_V(0);
    if constexpr (!ALIGN_EPI) { if (wr == 0) PG8_BAR; }
    PG8_BAR;
    if constexpr (Epi::AFTER_DRAIN) { E.fused(acc, cur, wr, wc, fr, fq, lds, wid, lane); S.done(cur); }
#undef PG8_SA
#undef PG8_SB
#undef PG8_STAGE
#undef PG8_LDA
#undef PG8_LDB
#undef PG8_MMA
#undef PG8_WAIT_V
#undef PG8_WAIT_L
#undef PG8_BAR
#undef PG8_SCHED
}
}
constexpr int DM = 1024, SEQ = 2048, NB = 32, DECL = 64, DFF = 2816, INW = 2816;
constexpr int MP = NB * SEQ, MS = NB * DECL, MT = MP + MS;
constexpr int NGRP = MT / 64;
constexpr int NTM = MT / 256;
constexpr float EPS = 1e-6f;
constexpr size_t OFF_Y = 0;
constexpr size_t OFF_PRET = (size_t)MT * DM;
constexpr size_t OFF_PK = OFF_PRET + (size_t)NB * 4 * 128 * 128;
constexpr size_t OFF_PV = OFF_PK + (size_t)NB * 128 * 128;
constexpr size_t OFF_PCONV = OFF_PV + (size_t)NB * 128 * 128;
constexpr size_t OFF_SRET = OFF_PCONV + (size_t)NB * 2 * DFF;
constexpr size_t OFF_SK = OFF_SRET + (size_t)NB * 4 * 128 * 128;
constexpr size_t OFF_SV = OFF_SK + (size_t)NB * 64 * 128;
constexpr size_t OFF_SCONV = OFF_SV + (size_t)NB * 64 * 128;
constexpr size_t OUT_TOTAL = OFF_SCONV + (size_t)NB * 2 * DFF;
constexpr size_t MiB = 1u << 20;
constexpr size_t WS_WIN = 0;
constexpr size_t WS_WUP = WS_WIN + (size_t)INW * DM * 2;
constexpr size_t WS_WOUT = WS_WUP + (size_t)2 * DFF * DM * 2;
constexpr size_t WS_WDN = WS_WOUT + (size_t)DM * DM * 2;
constexpr size_t WS_MODP = 48 * MiB + 133 * MiB + 363 * MiB + 200 * MiB;
constexpr size_t WS_MOD = 32 * MiB;
constexpr size_t WS_SHW = 34 * MiB;
constexpr size_t WS_SS1 = 36 * MiB;
constexpr size_t WS_SS2 = 41 * MiB;
constexpr size_t WS_R0 = 48 * MiB;
constexpr size_t WS_R1 = WS_R0 + 133 * MiB;
constexpr size_t WS_R2 = WS_R1 + 363 * MiB;
constexpr size_t HT_STRIDE = (size_t)NGRP * 2 * DFF;
constexpr size_t WS_END = WS_R2 + 363 * MiB;
constexpr size_t WS_SLAB = WS_R1 + 264 * MiB;
constexpr size_t WS_SLAB4 = WS_R1 + 300 * MiB;
constexpr size_t WS_X1B = WS_R1 + 128 * MiB;
static_assert(3 * HT_STRIDE * 4 <= 128 * MiB && WS_X1B + (size_t)MT * DM * 2 <= WS_R2, "ws map");
static_assert(WS_WDN + (size_t)DM * DFF * 2 <= WS_MODP, "ws map");
static_assert((size_t)(MT + 256) * DM * 2 <= 133 * MiB && (size_t)MT * DFF * 2 <= 363 * MiB, "ws map");

constexpr size_t WS_BAR = 46 * MiB;
constexpr size_t WS_TICKET = 46 * MiB + 32768;
constexpr size_t WS_CNT7 = 46 * MiB + 65536;
constexpr int LDS_MISC = 155648;
constexpr int LDS_BYTES = 155648 + 64;

#define LAS __attribute__((address_space(3)))
typedef unsigned short bf16;
typedef float f32x4 __attribute__((ext_vector_type(4)));
typedef float f32x2 __attribute__((ext_vector_type(2)));
typedef short bf16x8 __attribute__((ext_vector_type(8)));
typedef unsigned u32x4 __attribute__((ext_vector_type(4)));
typedef unsigned u32x2 __attribute__((ext_vector_type(2)));
typedef __bf16 bf16x2_t __attribute__((ext_vector_type(2)));
#define LDS_WAIT() asm volatile("s_waitcnt lgkmcnt(0)" ::: "memory")

__device__ __forceinline__ unsigned pk2(float lo, float hi) { f32x2 v = {lo, hi}; bf16x2_t b = __builtin_convertvector(v, bf16x2_t); return __builtin_bit_cast(unsigned, b); }
__device__ __forceinline__ float bflo(unsigned w) { return __uint_as_float(w << 16); }
__device__ __forceinline__ float bfhi(unsigned w) { return __uint_as_float(w & 0xffff0000u); }
__device__ __forceinline__ float wave_sum(float v) {
#pragma unroll
    for (int o = 1; o < 64; o <<= 1) v += __shfl_xor(v, o);
    return v;
}
__device__ __forceinline__ float wave_sum_dpp(float v) {
    v += __int_as_float(__builtin_amdgcn_update_dpp(__float_as_int(v), __float_as_int(v), 0x128, 0xf, 0xf, false));
    v += __int_as_float(__builtin_amdgcn_update_dpp(__float_as_int(v), __float_as_int(v), 0x124, 0xf, 0xf, false));
    v += __int_as_float(__builtin_amdgcn_update_dpp(__float_as_int(v), __float_as_int(v), 0x122, 0xf, 0xf, false));
    v += __int_as_float(__builtin_amdgcn_update_dpp(__float_as_int(v), __float_as_int(v), 0x121, 0xf, 0xf, false));
    const int i = __float_as_int(v);
    return (__int_as_float(__builtin_amdgcn_readlane(i, 0)) + __int_as_float(__builtin_amdgcn_readlane(i, 16))) + (__int_as_float(__builtin_amdgcn_readlane(i, 32)) + __int_as_float(__builtin_amdgcn_readlane(i, 48)));
}
__device__ __forceinline__ float silu_f(float x) { return x * __builtin_amdgcn_rcpf(1.0f + __builtin_amdgcn_exp2f(-1.4426950408889634f * x)); }
__device__ __forceinline__ void unpack8(const u32x4 w, float (&f)[8]) { f[0] = bflo(w.x); f[1] = bfhi(w.x); f[2] = bflo(w.y); f[3] = bfhi(w.y); f[4] = bflo(w.z); f[5] = bfhi(w.z); f[6] = bflo(w.w); f[7] = bfhi(w.w); }
__device__ __forceinline__ int grp_bs(int g) { return g < 1024 ? (g >> 5) : 32 + (g - 1024); }

struct Params {
    const float *x_p, *x_s, *cache_k, *cache_v, *state_ret, *state_conv, *c_p, *c_s, *ln1, *ln2, *w_ada, *b_ada, *w_in, *w_out, *sinks, *w_up, *conv_w, *conv_b, *w_down, *normf, *w_ada_f, *b_ada_f;
    float* out; unsigned char* ws;
};

__device__ __forceinline__ void transpose_item(const float* W, int K, int N, bf16* WT, int dst_row0, int k0, int n0, LAS float* scr, int lane) {
    { f32x4 t[8];
#pragma unroll
      for (int i = 0; i < 8; ++i) t[i] = *(const f32x4*)(W + (size_t)(k0 + 8 * i + (lane >> 3)) * N + n0 + 4 * (lane & 7));
#pragma unroll
      for (int i = 0; i < 8; ++i) { LAS float* d = scr + (8 * i + (lane >> 3)) * 33 + 4 * (lane & 7); d[0] = t[i].x; d[1] = t[i].y; d[2] = t[i].z; d[3] = t[i].w; } }
    LDS_WAIT(); asm volatile("" ::: "memory");
    const int c = lane & 7;
#pragma unroll
    for (int j = 0; j < 4; ++j) { const int n = (lane >> 3) + 8 * j; const LAS float* s = scr + (8 * c) * 33 + n;
        u32x4 o; o.x = pk2(s[0 * 33], s[1 * 33]); o.y = pk2(s[2 * 33], s[3 * 33]); o.z = pk2(s[4 * 33], s[5 * 33]); o.w = pk2(s[6 * 33], s[7 * 33]);
        *(u32x4*)(WT + (size_t)(dst_row0 + n) * K + k0 + 8 * c) = o; }
    LDS_WAIT(); asm volatile("" ::: "memory");
}
constexpr int MOD_KS = 8, MOD_KC = 1024 / MOD_KS / 32;
__device__ __forceinline__ void mod_item(const Params& P, int it, LAS float* scr, int lane) {
    const int ct = it / MOD_KS, ks = it % MOD_KS, c0 = ct * 64;
    const float* W; const float* bias; int ldw;
    if (c0 < 6144) { W = P.w_ada + c0; bias = P.b_ada + c0; ldw = 6144; } else { W = P.w_ada_f + (c0 - 6144); bias = P.b_ada_f + (c0 - 6144); ldw = 2048; }
    float acc[64];
#pragma unroll
    for (int r = 0; r < 64; ++r) acc[r] = 0.f;
    const float* crow = (lane < 32 ? P.c_p + (size_t)lane * DM : P.c_s + (size_t)(lane - 32) * DM) + ks * (1024 / MOD_KS);
    const float* wk0 = W + (size_t)(ks * (1024 / MOD_KS)) * ldw + lane;
    f32x4 cv[8], cn[8];
#pragma unroll
    for (int q = 0; q < 8; ++q) cv[q] = *(const f32x4*)(crow + 4 * q);
    constexpr int NK4 = (1024 / MOD_KS) / 4;
    float w0 = wk0[0], w1 = wk0[(size_t)ldw], w2 = wk0[(size_t)2 * ldw], w3 = wk0[(size_t)3 * ldw];
    for (int kc = 0; kc < MOD_KC; ++kc) {
#pragma unroll
        for (int q = 0; q < 8; ++q) { f32x4 v = cv[q]; v.x = silu_f(v.x); v.y = silu_f(v.y); v.z = silu_f(v.z); v.w = silu_f(v.w); *(LAS f32x4*)(scr + lane * 36 + 4 * q) = v; }
        LDS_WAIT(); asm volatile("" ::: "memory");
        { const int kn = kc + 1 < MOD_KC ? kc + 1 : kc;
#pragma unroll
          for (int q = 0; q < 8; ++q) cn[q] = *(const f32x4*)(crow + kn * 32 + 4 * q); }
        for (int k4 = 0; k4 < 8; ++k4) {
            const int gk = kc * 8 + k4, gn = gk + 1 < NK4 ? gk + 1 : gk;
            const float* wn = wk0 + (size_t)(4 * gn) * ldw;
            const float n0 = wn[0], n1 = wn[(size_t)ldw], n2 = wn[(size_t)2 * ldw], n3 = wn[(size_t)3 * ldw];
#pragma unroll
            for (int r = 0; r < 64; ++r) { const f32x4 sv = *(const LAS f32x4*)(scr + r * 36 + 4 * k4);
                acc[r] = fmaf(sv.x, w0, acc[r]); acc[r] = fmaf(sv.y, w1, acc[r]); acc[r] = fmaf(sv.z, w2, acc[r]); acc[r] = fmaf(sv.w, w3, acc[r]); }
            w0 = n0; w1 = n1; w2 = n2; w3 = n3;
        }
        LDS_WAIT(); asm volatile("" ::: "memory");
#pragma unroll
        for (int q = 0; q < 8; ++q) cv[q] = cn[q];
    }
    float* dst = (float*)(P.ws + WS_MODP) + (size_t)ks * 64 * 8192 + c0 + lane;
    const float bv = (ks == 0) ? bias[lane] : 0.f;
#pragma unroll
    for (int r = 0; r < 64; ++r) dst[(size_t)r * 8192] = acc[r] + bv;
}
__device__ __forceinline__ void phase0(const Params& P, LAS unsigned char* lds, int wave, int lane) {
    LAS float* scr = (LAS float*)(lds + wave * 16384);
    const int gw = wave * gridDim.x + blockIdx.x, NGW = gridDim.x * 8;
    constexpr int I_MOD = 128 * MOD_KS, I_IN = 16 * 88, I_UP = 16 * 176, I_OUT = 16 * 32, I_DN = 44 * 32;
    constexpr int NIT = I_MOD + I_IN + I_UP + I_OUT + I_DN;
    for (int it = gw; it < NIT; it += NGW) {
        int r = it;
        if (r < I_MOD) { mod_item(P, r, scr, lane); continue; } r -= I_MOD;
        if (r < I_IN) { const int kb = r / 88, nb = r % 88; transpose_item(P.w_in, DM, INW, (bf16*)(P.ws + WS_WIN), nb * 32, kb * 64, nb * 32, scr, lane); continue; } r -= I_IN;
        if (r < I_UP) { const int kb = r / 176, nb = r % 176, n0 = nb * 32, isb = n0 >= DFF, j0 = n0 - isb * DFF;
            transpose_item(P.w_up, DM, 2 * DFF, (bf16*)(P.ws + WS_WUP), 256 * (j0 >> 7) + 128 * isb + (j0 & 127), kb * 64, n0, scr, lane); continue; } r -= I_UP;
        if (r < I_OUT) { const int kb = r / 32, nb = r % 32; transpose_item(P.w_out, DM, DM, (bf16*)(P.ws + WS_WOUT), nb * 32, kb * 64, nb * 32, scr, lane); continue; } r -= I_OUT;
        { const int kb = r / 32, nb = r % 32; transpose_item(P.w_down, DFF, DM, (bf16*)(P.ws + WS_WDN), nb * 32, kb * 64, nb * 32, scr, lane); }
    }
}

__device__ __forceinline__ void phase1(const Params& P, LAS unsigned char* lds, int tid, int wave, int lane) {
    const float* modp = (const float*)(P.ws + WS_MODP);
    float* mod = (float*)(P.ws + WS_MOD);
    bf16* H1 = (bf16*)(P.ws + WS_R0);
    for (int idx = blockIdx.x * 512 + tid; idx < 64 * 8192; idx += gridDim.x * 512) {
        float s = 0.f;
#pragma unroll
        for (int p_ = 0; p_ < MOD_KS; ++p_) s += modp[idx + (size_t)p_ * 524288];
        mod[idx] = s;
        const int col = idx & 8191, bs = idx >> 13;
        if (col >= 3072 && col < 4096) H1[(size_t)(MT + bs) * DM + (col - 3072)] = (bf16)(pk2(s, 0.f) & 0xffffu);
    }
    LAS float* lv = (LAS float*)lds;
    if (gridDim.x == 256) {
        const int b = blockIdx.x, bsP = b >> 3, bsS = 32 + (b >> 3);
        __syncthreads();
        for (int i = tid; i < 4096; i += 512) { const int sl = i >> 11, which = (i >> 10) & 1, col = i & 1023; const size_t o = (size_t)(sl ? bsS : bsP) * 8192 + which * 1024 + col;
            float sv = 0.f;
#pragma unroll
            for (int p_ = 0; p_ < MOD_KS; ++p_) sv += modp[o + (size_t)p_ * 524288];
            if (which) sv = P.ln1[col] * (1.f + sv);
            lv[i] = sv; }
        __syncthreads();
#pragma unroll 4
        for (int r = wave; r < 264; r += 8) {
            const bool smp = r >= 256;
            const int row = smp ? MP + 8 * b + (r - 256) : 256 * b + r;
            const LAS float* lvs = lv + (smp ? 2048 : 0);
            const float* xr = (smp ? P.x_s + (size_t)(row - MP) * DM : P.x_p + (size_t)row * DM) + 4 * lane;
            f32x4 v[4]; float ss = 0.f;
#pragma unroll
            for (int j = 0; j < 4; ++j) { v[j] = *(const f32x4*)(xr + 256 * j); ss += (v[j].x * v[j].x + v[j].y * v[j].y) + (v[j].z * v[j].z + v[j].w * v[j].w); }
            const float rstd = __builtin_amdgcn_rsqf(wave_sum_dpp(ss) * (1.f / DM) + EPS);
            bf16* hr = H1 + (size_t)row * DM + 4 * lane;
#pragma unroll
            for (int j = 0; j < 4; ++j) { const f32x4 sh = *(const LAS f32x4*)(lvs + 256 * j + 4 * lane), gs = *(const LAS f32x4*)(lvs + 1024 + 256 * j + 4 * lane);
                const f32x4 h = v[j] * rstd * gs + sh; u32x2 w; w.x = pk2(h.x, h.y); w.y = pk2(h.z, h.w); *(u32x2*)(hr + 256 * j) = w; }
        }
        return;
    }
    const int rpb = (MT + (int)gridDim.x - 1) / (int)gridDim.x, rbeg = (int)blockIdx.x * rpb, rend = (rbeg + rpb < MT) ? rbeg + rpb : MT;
    if (rbeg < rend) {
        const int bs0 = rbeg < MP ? (rbeg >> 11) : 32 + ((rbeg - MP) >> 6), bs1 = (rend - 1) < MP ? ((rend - 1) >> 11) : 32 + ((rend - 1 - MP) >> 6);
        const int nsl = bs1 - bs0 + 1;
        __syncthreads();
        for (int i = tid; i < nsl * 2048; i += 512) { const int sl = i >> 11, which = (i >> 10) & 1, col = i & 1023; const size_t o = (size_t)(bs0 + sl) * 8192 + which * 1024 + col;
            float sv = 0.f;
#pragma unroll
            for (int p_ = 0; p_ < MOD_KS; ++p_) sv += modp[o + (size_t)p_ * 524288];
            if (which) sv = P.ln1[col] * (1.f + sv);
            lv[i] = sv; }
        __syncthreads();
#pragma unroll 4
        for (int row = rbeg + wave; row < rend; row += 8) {
            const int bs = row < MP ? (row >> 11) : 32 + ((row - MP) >> 6);
            const LAS float* lvs = lv + (bs - bs0) * 2048;
            const float* xr = (row < MP ? P.x_p + (size_t)row * DM : P.x_s + (size_t)(row - MP) * DM) + 4 * lane;
            f32x4 v[4]; float ss = 0.f;
#pragma unroll
            for (int j = 0; j < 4; ++j) { v[j] = *(const f32x4*)(xr + 256 * j); ss += (v[j].x * v[j].x + v[j].y * v[j].y) + (v[j].z * v[j].z + v[j].w * v[j].w); }
            const float rstd = __builtin_amdgcn_rsqf(wave_sum_dpp(ss) * (1.f / DM) + EPS);
            bf16* hr = H1 + (size_t)row * DM + 4 * lane;
#pragma unroll
            for (int j = 0; j < 4; ++j) { const f32x4 sh = *(const LAS f32x4*)(lvs + 256 * j + 4 * lane), gs = *(const LAS f32x4*)(lvs + 1024 + 256 * j + 4 * lane);
                const f32x4 h = v[j] * rstd * gs + sh; u32x2 w; w.x = pk2(h.x, h.y); w.y = pk2(h.z, h.w); *(u32x2*)(hr + 256 * j) = w; }
        }
    }
}

struct OrderX {
    pg8::StaticOrder S; int nX, xpm, xpn0;
    __device__ __forceinline__ bool next(int i, pg8::Unit& u) const {
        const long L = (long)i * S.G + S.c;
        int pm = 0, pn = 0; bool ok = false;
        if (L < S.nwg) { pg8::Unit t; t.pm = 0; t.pn = 0; t.seq = 0; t.kt0 = 0; t.nt = 0; (void)S.next(i, t); pm = t.pm; pn = t.pn; ok = true; }
        else if (L < S.nwg + nX) { pm = xpm; pn = xpn0 + (int)(L - S.nwg); ok = true; }
        u.pm = pm; u.pn = pn; u.seq = i; u.kt0 = 0; u.nt = 0;
        return ok;
    }
    __device__ __forceinline__ void a_ready(const pg8::Unit&) const {}
    __device__ __forceinline__ void done(const pg8::Unit&) const {}
};
struct OrderPub : pg8::StaticOrder {
    unsigned* cnt;
    __device__ __forceinline__ void done(const pg8::Unit& u) const {
        asm volatile("s_waitcnt vmcnt(0)" ::: "memory");
        if ((threadIdx.x & 63) == 0) __hip_atomic_fetch_add(cnt + 64 * u.pm, 1u, __ATOMIC_RELAXED, __HIP_MEMORY_SCOPE_AGENT);
    }
};
struct OrderDown {
    pg8::StaticOrder S;
    int ka, kb;
    __device__ __forceinline__ bool next(int i, pg8::Unit& u) const {
        const long L = (long)i * S.G + S.c;
        int pm = 0, pn = 0, kt0 = 0, nt = 0; bool ok = false;
        if (L < S.nwg) { pg8::Unit t; t.pm = 0; t.pn = 0; t.seq = 0; t.kt0 = 0; t.nt = 0; (void)S.next(i, t); pm = t.pm; pn = t.pn; ok = true; }
        else if (L < S.nwg + 128) { const int q = (int)(L - S.nwg), tu = q >> 2, part = q & 3; pm = (MP / 256) + (tu & 7); pn = tu >> 3; kt0 = part < 2 ? ka * part : 2 * ka + kb * (part - 2); nt = part < 2 ? ka : kb; ok = true; }
        u.pm = pm; u.pn = pn; u.seq = i; u.kt0 = kt0; u.nt = nt;
        return ok;
    }
    __device__ __forceinline__ void a_ready(const pg8::Unit&) const {}
    __device__ __forceinline__ void done(const pg8::Unit&) const {}
};
typedef const f32x4 (&AccRef)[2][2][4][2];
struct Epi1 {
    static constexpr bool PERM = true, AFTER_DRAIN = false;
    bf16* proj; float* shw; float* out;
    __device__ __forceinline__ void operator()(AccRef acc, const pg8::Unit& u, int wr, int wc, int fr, int fq) const {
        if (u.pm == NTM) {
            if (wr == 0) {
#pragma unroll
                for (int m = 0; m < 4; ++m) { float* d = shw + (size_t)(16 * m + fr) * (2 * DFF) + 256 * (u.pn - 11) + 32 * wc + 8 * fq;
#pragma unroll
                    for (int bj = 0; bj < 2; ++bj)
#pragma unroll
                        for (int n = 0; n < 2; ++n) *(f32x4*)(d + 128 * bj + 4 * n) = acc[0][bj][m][n]; }
            }
            return;
        }
        const unsigned row0 = u.pm * 256 + wr * 64 + fr, col0 = u.pn * 256 + wc * 32 + 8 * fq;
#pragma unroll
        for (int ai = 0; ai < 2; ++ai)
#pragma unroll
            for (int m = 0; m < 4; ++m) { const unsigned o = (row0 + 128 * ai + 16 * m) * (unsigned)INW + col0;
#pragma unroll
                for (int bj = 0; bj < 2; ++bj) { const f32x4 v0 = acc[ai][bj][m][0], v1 = acc[ai][bj][m][1];
                    u32x4 w; w.x = pk2(v0[0], v0[1]); w.y = pk2(v0[2], v0[3]); w.z = pk2(v1[0], v1[1]); w.w = pk2(v1[2], v1[3]);
                    *(u32x4*)(proj + (o + 128 * bj)) = w; }
                asm volatile("" ::: "memory"); }
        if (u.pn == 10) {
            const unsigned c = 32 * wc + 8 * fq;
#pragma unroll
            for (int ai = 0; ai < 2; ++ai)
#pragma unroll
                for (int m = 0; m < 4; ++m) { const unsigned row = row0 + 128 * ai + 16 * m; unsigned ok, ov;
                    if (row < (unsigned)MP) { const unsigned t = row & 2047; if (t < SEQ - 128) continue; const unsigned o = ((row >> 11) * 128 + (t - (SEQ - 128))) * 128 + c; ok = (unsigned)OFF_PK + o; ov = (unsigned)OFF_PV + o; }
                    else { const unsigned o = (row - MP) * 128 + c; ok = (unsigned)OFF_SK + o; ov = (unsigned)OFF_SV + o; }
                    *(f32x4*)(out + ok) = acc[ai][0][m][0]; *(f32x4*)(out + ok + 4) = acc[ai][0][m][1];
                    *(f32x4*)(out + ov) = acc[ai][1][m][0]; *(f32x4*)(out + ov + 4) = acc[ai][1][m][1];
                    asm volatile("" ::: "memory"); }
        }
    }
};
struct Epi2 {
    static constexpr bool PERM = true, AFTER_DRAIN = false;
    const float *xp, *xs, *mod, *ln2; bf16* x1; bf16* a2; float* ss; float* slab;
    __device__ __forceinline__ void operator()(AccRef acc, const pg8::Unit& u, int wr, int wc, int fr, int fq) const {
        const int col0 = u.pn * 256 + wc * 32 + 8 * fq;
        if (u.nt != 0) {
            float* sb = slab + (size_t)(u.kt0 >> 2) * MS * DM;
#pragma unroll
            for (int ai = 0; ai < 2; ++ai)
#pragma unroll
                for (int m = 0; m < 4; ++m) { const unsigned ro = (unsigned)(u.pm * 256 - MP + 128 * ai + 64 * wr + 16 * m + fr) * DM + col0;
#pragma unroll
                    for (int bj = 0; bj < 2; ++bj) { *(f32x4*)(sb + ro + 128 * bj) = acc[ai][bj][m][0]; *(f32x4*)(sb + ro + 128 * bj + 4) = acc[ai][bj][m][1]; } }
            return;
        }
#pragma unroll
        for (int ai = 0; ai < 2; ++ai) {
            const int bs = grp_bs(4 * u.pm + 2 * ai + wr);
            const float* mb = mod + (size_t)bs * 8192;
            f32x4 g1v[2][2], gsv[2][2];
#pragma unroll
            for (int bj = 0; bj < 2; ++bj)
#pragma unroll
                for (int n = 0; n < 2; ++n) { const int c = col0 + 128 * bj + 4 * n; g1v[bj][n] = *(const f32x4*)(mb + 2048 + c);
                    gsv[bj][n] = *(const f32x4*)(ln2 + c) * (*(const f32x4*)(mb + 4096 + c) + 1.0f); }
#pragma unroll
            for (int m = 0; m < 4; ++m) {
                const int row = u.pm * 256 + 128 * ai + 64 * wr + 16 * m + fr;
                const float* xr = row < MP ? xp + (size_t)row * DM : xs + (size_t)(row - MP) * DM;
                float s = 0.f;
#pragma unroll
                for (int bj = 0; bj < 2; ++bj) { f32x4 a[2]; f32x4 xb[2];
#pragma unroll
                    for (int n = 0; n < 2; ++n) { const int c = col0 + 128 * bj + 4 * n; const f32x4 xv = *(const f32x4*)(xr + c); const f32x4 v = xv + g1v[bj][n] * acc[ai][bj][m][n];
                        xb[n] = v; s += (v.x * v.x + v.y * v.y) + (v.z * v.z + v.w * v.w); a[n] = v * gsv[bj][n]; }
                    u32x4 w; w.x = pk2(a[0].x, a[0].y); w.y = pk2(a[0].z, a[0].w); w.z = pk2(a[1].x, a[1].y); w.w = pk2(a[1].z, a[1].w);
                    *(u32x4*)(a2 + (size_t)row * DM + col0 + 128 * bj) = w;
                    w.x = pk2(xb[0].x, xb[0].y); w.y = pk2(xb[0].z, xb[0].w); w.z = pk2(xb[1].x, xb[1].y); w.w = pk2(xb[1].z, xb[1].w);
                    *(u32x4*)(x1 + (size_t)row * DM + col0 + 128 * bj) = w; }
                s += __shfl_xor(s, 16); s += __shfl_xor(s, 32);
                if (fq == 0) ss[(size_t)row * 16 + 4 * u.pn + wc] = s;
            }
        }
    }
};
struct Epi3 {
    static constexpr bool PERM = true, AFTER_DRAIN = false;
    const LAS float* rtab; const float* shw; bf16 *ua, *ub; float* out;
    __device__ __forceinline__ void operator()(AccRef acc, const pg8::Unit& u, int wr, int wc, int fr, int fq) const {
        const unsigned j0 = u.pn * 128 + wc * 32 + 8 * fq, pc0 = u.pn * 256 + wc * 32 + 8 * fq;
#pragma unroll
        for (int ai = 0; ai < 2; ++ai) {
            const unsigned grp = 4 * u.pm + 2 * ai + wr, bs = grp_bs((int)grp);
            const unsigned so = bs * (2 * DFF) + pc0;
            const f32x4 sa0 = *(const f32x4*)(shw + so), sa1 = *(const f32x4*)(shw + so + 4), sb0 = *(const f32x4*)(shw + so + 128), sb1 = *(const f32x4*)(shw + so + 132);
#pragma unroll
            for (int m = 0; m < 4; ++m) {
                const float rstd = rtab[u.seq * 256 + 128 * ai + 64 * wr + 16 * m + fr];
                const unsigned row = grp * 64 + 16 * m + fr;
                const f32x4 a0 = acc[ai][0][m][0] * rstd + sa0, a1 = acc[ai][0][m][1] * rstd + sa1, b0 = acc[ai][1][m][0] * rstd + sb0, b1 = acc[ai][1][m][1] * rstd + sb1;
                u32x4 w; w.x = pk2(a0[0], a0[1]); w.y = pk2(a0[2], a0[3]); w.z = pk2(a1[0], a1[1]); w.w = pk2(a1[2], a1[3]);
                *(u32x4*)(ua + (row * (unsigned)DFF + j0)) = w;
                w.x = pk2(b0[0], b0[1]); w.y = pk2(b0[2], b0[3]); w.z = pk2(b1[0], b1[1]); w.w = pk2(b1[2], b1[3]);
                *(u32x4*)(ub + (row * (unsigned)DFF + j0)) = w;
                if (m == 3 && fr >= 14) {
                    if (grp >= 1024) { float* d = out + OFF_SCONV + ((size_t)(grp - 1024) * 2 + (fr - 14)) * DFF + j0; *(f32x4*)d = a0; *(f32x4*)(d + 4) = a1; }
                    else if ((grp & 31) == 31) { float* d = out + OFF_PCONV + ((size_t)(grp >> 5) * 2 + (fr - 14)) * DFF + j0; *(f32x4*)d = a0; *(f32x4*)(d + 4) = a1; }
                }
            }
        }
    }
};
#ifdef CONV_FUSED
struct Epi3C {
    static constexpr bool PERM = true, AFTER_DRAIN = false;
    const LAS float* rtab; const float *shw, *cw, *cb; bf16* act; float *headA, *headB, *tailA;
    __device__ __forceinline__ void operator()(AccRef acc, const pg8::Unit& u, int wr, int wc, int fr, int fq) const {
        const unsigned j0 = u.pn * 128 + wc * 32 + 8 * fq, pc0 = u.pn * 256 + wc * 32 + 8 * fq;
        f32x4 w0[2], w1[2], w2[2], cbv[2];
#pragma unroll
        for (int n = 0; n < 2; ++n) { w0[n] = *(const f32x4*)(cw + j0 + 4 * n); w1[n] = *(const f32x4*)(cw + DFF + j0 + 4 * n); w2[n] = *(const f32x4*)(cw + 2 * DFF + j0 + 4 * n); cbv[n] = *(const f32x4*)(cb + j0 + 4 * n); }
        u32x2 ap[2][4][2], bp[2][4][2];
        f32x4 sa[2], sb[2];
        const unsigned bs0 = grp_bs((int)(4 * u.pm + wr));
        { const unsigned so = bs0 * (2 * DFF) + pc0;
#pragma unroll
          for (int n = 0; n < 2; ++n) { sa[n] = *(const f32x4*)(shw + so + 4 * n); sb[n] = *(const f32x4*)(shw + so + 128 + 4 * n); } }
#pragma unroll
        for (int ai = 0; ai < 2; ++ai) {
            const unsigned grp = 4 * u.pm + 2 * ai + wr, bs = grp_bs((int)grp);
            const unsigned ho = (grp * 2 + (fr & 1)) * DFF + j0;
            if (ai == 1 && bs != bs0) { const unsigned so = bs * (2 * DFF) + pc0;
#pragma unroll
                for (int n = 0; n < 2; ++n) { sa[n] = *(const f32x4*)(shw + so + 4 * n); sb[n] = *(const f32x4*)(shw + so + 128 + 4 * n); } }
#pragma unroll
            for (int m = 0; m < 4; ++m) {
                const float rs = rtab[u.seq * 256 + 128 * ai + 64 * wr + 16 * m + fr];
#pragma unroll
                for (int n = 0; n < 2; ++n) {
                    const f32x4 av = acc[ai][0][m][n] * rs + sa[n], bv = acc[ai][1][m][n] * rs + sb[n];
                    if (m == 0) { if (fr < 2) { *(f32x4*)(headA + ho + 4 * n) = av; *(f32x4*)(headB + ho + 4 * n) = bv; } }
                    if (m == 3) { if (fr >= 14) *(f32x4*)(tailA + ho + 4 * n) = av; }
                    ap[ai][m][n].x = pk2(av.x, av.y); ap[ai][m][n].y = pk2(av.z, av.w); bp[ai][m][n].x = pk2(bv.x, bv.y); bp[ai][m][n].y = pk2(bv.z, bv.w);
                }
            }
        }
        asm volatile("" ::: "memory");
#pragma unroll
        for (int ai = 0; ai < 2; ++ai) {
            const unsigned grp = 4 * u.pm + 2 * ai + wr;
#pragma unroll
            for (int n = 0; n < 2; ++n)
#pragma unroll
                for (int h = 0; h < 2; ++h) {
                    unsigned q1 = 0u, q2 = 0u;
#pragma unroll
                    for (int m = 0; m < 4; ++m) {
                        const unsigned a = ap[ai][m][n][h];
                        const unsigned s1 = (unsigned)__builtin_amdgcn_update_dpp((int)a, (int)a, 0x121, 0xf, 0xf, false);
                        const unsigned s2 = (unsigned)__builtin_amdgcn_update_dpp((int)a, (int)a, 0x122, 0xf, 0xf, false);
                        const unsigned pr1 = fr >= 1 ? s1 : q1, pr2 = fr >= 2 ? s2 : q2;
                        q1 = s1; q2 = s2;
                        const float c0 = cbv[n][2 * h] + w0[n][2 * h] * bflo(pr2) + w1[n][2 * h] * bflo(pr1) + w2[n][2 * h] * bflo(a);
                        const float c1 = cbv[n][2 * h + 1] + w0[n][2 * h + 1] * bfhi(pr2) + w1[n][2 * h + 1] * bfhi(pr1) + w2[n][2 * h + 1] * bfhi(a);
                        const unsigned bw = bp[ai][m][n][h];
                        bp[ai][m][n][h] = pk2(silu_f(c0) * bflo(bw), silu_f(c1) * bfhi(bw));
                    }
                    __builtin_amdgcn_sched_barrier(0);
                }
            asm volatile("" ::: "memory");
#pragma unroll
            for (int m = 0; m < 4; ++m) {
                if (m == 0 && fr < 2) continue;
                const unsigned row = grp * 64 + 16 * m + fr;
                const u32x4 w = (u32x4){bp[ai][m][0].x, bp[ai][m][0].y, bp[ai][m][1].x, bp[ai][m][1].y};
                *(u32x4*)(act + (row * (unsigned)DFF + j0)) = w;
            }
        }
    }
};
#endif
struct Epi4 {
    static constexpr bool PERM = true, AFTER_DRAIN = false;
    const float* mod; const bf16* x1; bf16* x2; float* slab;
    __device__ __forceinline__ void operator()(AccRef acc, const pg8::Unit& u, int wr, int wc, int fr, int fq) const {
        const int col0 = u.pn * 256 + wc * 32 + 8 * fq;
        if (u.nt != 0) {
            const int part = u.kt0 == 0 ? 0 : (u.kt0 == 12 ? 1 : (u.kt0 == 24 ? 2 : 3));
            float* sb = slab + (size_t)part * MS * DM;
#pragma unroll
            for (int ai = 0; ai < 2; ++ai)
#pragma unroll
                for (int m = 0; m < 4; ++m) { const unsigned ro = (unsigned)(u.pm * 256 - MP + 128 * ai + 64 * wr + 16 * m + fr) * DM + col0;
#pragma unroll
                    for (int bj = 0; bj < 2; ++bj) { *(f32x4*)(sb + ro + 128 * bj) = acc[ai][bj][m][0]; *(f32x4*)(sb + ro + 128 * bj + 4) = acc[ai][bj][m][1]; } }
            return;
        }
#pragma unroll
        for (int ai = 0; ai < 2; ++ai) {
            const int bs = grp_bs(4 * u.pm + 2 * ai + wr);
            const float* mb = mod + (size_t)bs * 8192 + 5120;
            f32x4 g2v[2][2];
#pragma unroll
            for (int bj = 0; bj < 2; ++bj)
#pragma unroll
                for (int n = 0; n < 2; ++n) g2v[bj][n] = *(const f32x4*)(mb + col0 + 128 * bj + 4 * n);
#pragma unroll
            for (int m = 0; m < 4; ++m) {
                const unsigned ro = (unsigned)(u.pm * 256 + 128 * ai + 64 * wr + 16 * m + fr) * DM + col0;
#pragma unroll
                for (int bj = 0; bj < 2; ++bj) { const u32x4 xw = *(const u32x4*)(x1 + ro + 128 * bj);
                    const f32x4 v0 = (f32x4){bflo(xw.x), bfhi(xw.x), bflo(xw.y), bfhi(xw.y)} + g2v[bj][0] * acc[ai][bj][m][0];
                    const f32x4 v1 = (f32x4){bflo(xw.z), bfhi(xw.z), bflo(xw.w), bfhi(xw.w)} + g2v[bj][1] * acc[ai][bj][m][1];
                    u32x4 w; w.x = pk2(v0.x, v0.y); w.y = pk2(v0.z, v0.w); w.z = pk2(v1.x, v1.y); w.w = pk2(v1.z, v1.w);
                    *(u32x4*)(x2 + ro + 128 * bj) = w; }
            }
        }
    }
};
#define GAS __attribute__((address_space(1)))
#define RLX_AGENT __ATOMIC_RELAXED, __HIP_MEMORY_SCOPE_AGENT
#define XB_TMO      128
#define XB_XCNT(j)  (256  + 64 * (j))
#define XB_XSUB(j)  (1280 + 64 * (j))
#define XB_XGEN(j)  (2304 + 64 * (j))
#define XB_TOP      3328
#define XB_TOPGEN   3392
#define XCD_BAR_WORDS 3456
#define XB_SPIN_CAP (1u << 18)

__device__ __forceinline__ unsigned xb_ld(unsigned* p)              { return __hip_atomic_load(p, __ATOMIC_RELAXED, __HIP_MEMORY_SCOPE_AGENT); }
__device__ __forceinline__ unsigned xb_add(unsigned* p, unsigned v) { return __hip_atomic_fetch_add(p, v, __ATOMIC_RELAXED, __HIP_MEMORY_SCOPE_AGENT); }
__device__ __forceinline__ unsigned xb_xcc_id() { return (unsigned)__builtin_amdgcn_s_getreg((3 << 11) | 20) & 0xFu; }
#define XB_SPIN(cond, bar) do { unsigned _sp = 0; while (cond) { __builtin_amdgcn_s_sleep(1); \
    if ((++_sp & 255u) == 0u) { if (xb_ld(&(bar)[XB_TMO])) break; if (_sp > XB_SPIN_CAP) { atomicAdd(&(bar)[XB_TMO], 1u); break; } } } } while (0)

struct XcdBarrier {
    unsigned* bar; unsigned x;
    volatile LAS unsigned* st;
};

__device__ __forceinline__ XcdBarrier xcd_barrier_post(unsigned* bar, volatile LAS unsigned* st) {
    XcdBarrier b; b.bar = bar; b.x = xb_xcc_id(); b.st = st;
    if (threadIdx.x == 0) (void)xb_add(&bar[XB_XCNT(b.x)], 1u);
    return b;
}
__device__ __forceinline__ void xcd_barrier_complete(unsigned* bar, unsigned x, unsigned& nloc, unsigned& nx) {
    const unsigned G = gridDim.x * gridDim.y * gridDim.z;
    unsigned sum, cnt, mine, sp = 0u;
    for (;;) {
        sum = 0u; cnt = 0u; mine = 0u;
#pragma unroll
        for (unsigned j = 0; j < 16; ++j) { const unsigned c = xb_ld(&bar[XB_XCNT(j)]); sum += c; cnt += (c > 0u) ? 1u : 0u; mine = (j == x) ? c : mine; }
        if (sum == G) break;
        __builtin_amdgcn_s_sleep(1);
        if ((++sp & 255u) == 0u) { if (xb_ld(&bar[XB_TMO])) break; if (sp > XB_SPIN_CAP) { atomicAdd(&bar[XB_TMO], 1u); break; } }
    }
    nloc = mine > 0u ? mine : 1u; nx = cnt > 0u ? cnt : 1u;
}

__device__ __forceinline__ void xcd_barrier(const XcdBarrier& b) {
    asm volatile("s_waitcnt vmcnt(0)" ::: "memory");
    __syncthreads();
    if (threadIdx.x == 0) {
        unsigned* bar = b.bar;
        __builtin_amdgcn_s_waitcnt(0);
        unsigned nloc = b.st[0], nx = b.st[1];
        if (nloc == 0u) { xcd_barrier_complete(bar, b.x, nloc, nx); b.st[0] = nloc; b.st[1] = nx; }
        const unsigned old = xb_add(&bar[XB_XSUB(b.x)], 1u);
        const unsigned gen = old / nloc;
        if (old + 1u == (gen + 1u) * nloc) {
            __builtin_amdgcn_fence(__ATOMIC_RELEASE, "agent");
            asm volatile("s_waitcnt vmcnt(0)" ::: "memory");
            const unsigned og = xb_add(&bar[XB_TOP], 1u);
            const unsigned tg = og / nx;
            if (og + 1u == (tg + 1u) * nx) xb_add(&bar[XB_TOPGEN], 1u);
            else XB_SPIN(xb_ld(&bar[XB_TOPGEN]) == tg, bar);
            __builtin_amdgcn_fence(__ATOMIC_ACQUIRE, "agent");
            xb_add(&bar[XB_XGEN(b.x)], 1u);
            asm volatile("s_waitcnt vmcnt(0)" ::: "memory");
        } else {
            XB_SPIN(xb_ld(&bar[XB_XGEN(b.x)]) == gen, bar);
            __builtin_amdgcn_fence(__ATOMIC_ACQUIRE, "agent");
            asm volatile("s_waitcnt vmcnt(0)" ::: "memory");
        }
    }
    __syncthreads();
}
#define MFMA16(a, b, c) __builtin_amdgcn_mfma_f32_16x16x32_bf16((a), (b), (c), 0, 0, 0)
constexpr int RQ = 0, RK = 17408, RKT = 34816, RVT = 53248, RP = 71680, RST = 80896, RO = 115712;
__device__ __forceinline__ void ret_item(const Params& P, LAS unsigned char* lds, int tid, int wave, int lane, int h, int row0, int nchunks, const float* st_in, bool has_in, float* st_out) {
    const bf16* proj = (const bf16*)(P.ws + WS_R1);
    bf16* mix = (bf16*)(P.ws + WS_R2);
    const int fr = lane & 15, fq = lane >> 4;
    const float lg2 = log2f(1.0f - exp2f(-5.0f - (float)h));
    const float kscale = 0.08838834764831845f;
    LAS bf16* Qs = (LAS bf16*)(lds + RQ); LAS bf16* Ks = (LAS bf16*)(lds + RK); LAS bf16* KT = (LAS bf16*)(lds + RKT); LAS bf16* VT = (LAS bf16*)(lds + RVT);
    LAS bf16* Ps = (LAS bf16*)(lds + RP); LAS bf16* ST = (LAS bf16*)(lds + RST); LAS float* Os = (LAS float*)(lds + RO);
    f32x4 st[8];
#pragma unroll
    for (int et = 0; et < 8; ++et) {
        f32x4 v;
#pragma unroll
        for (int r = 0; r < 4; ++r) v[r] = st_in[(size_t)(16 * wave + 4 * fq + r) * 128 + 16 * et + fr];
        asm volatile("" : "+v"(v));
#pragma unroll
        for (int r = 0; r < 4; ++r) v[r] = has_in ? v[r] : 0.f;
        st[et] = v;
    }
    __syncthreads();
#pragma unroll
    for (int et = 0; et < 8; ++et) { u32x2 w; w.x = pk2(st[et][0], st[et][1]); w.y = pk2(st[et][2], st[et][3]); *(LAS u32x2*)(ST + (16 * et + fr) * 136 + 16 * wave + 4 * fq) = w; }
    const size_t goff = (size_t)lane * INW + h * 128 + wave * 16;
    u32x4 pq[2], pk[2], pv[2];
    { const bf16* g = proj + (size_t)row0 * INW + goff;
      pq[0] = *(const u32x4*)(g); pq[1] = *(const u32x4*)(g + 8); pk[0] = *(const u32x4*)(g + 512); pk[1] = *(const u32x4*)(g + 520); pv[0] = *(const u32x4*)(g + 1024); pv[1] = *(const u32x4*)(g + 1032); }
    u32x4 gv0, gv1, gn0, gn1;
    const size_t ggoff = (size_t)(8 * wave + (lane >> 3)) * INW + 1536 + h * 128 + 16 * (lane & 7);
    gn0 = *(const u32x4*)(proj + (size_t)row0 * INW + ggoff); gn1 = *(const u32x4*)(proj + (size_t)row0 * INW + ggoff + 8);
    const float kf = kscale * exp2f(lg2 * (float)(63 - lane));
    const float g64 = exp2f(lg2 * 64.0f);
    for (int c = 0; c < nchunks; ++c) {
        const int rowc = row0 + 64 * c;
        *(LAS u32x4*)(Qs + lane * 136 + wave * 16) = pq[0]; *(LAS u32x4*)(Qs + lane * 136 + wave * 16 + 8) = pq[1];
        *(LAS u32x4*)(Ks + lane * 136 + wave * 16) = pk[0]; *(LAS u32x4*)(Ks + lane * 136 + wave * 16 + 8) = pk[1];
#pragma unroll
        for (int i = 0; i < 2; ++i)
#pragma unroll
            for (int j = 0; j < 4; ++j) { const unsigned wk = pk[i][j], wv = pv[i][j]; const int d = wave * 16 + i * 8 + j * 2;
                const unsigned kk = pk2(bflo(wk) * kf, bfhi(wk) * kf);
                KT[(d) * 72 + lane] = (bf16)(kk & 0xffffu); KT[(d + 1) * 72 + lane] = (bf16)(kk >> 16);
                VT[(d) * 72 + lane] = (bf16)(wv & 0xffffu); VT[(d + 1) * 72 + lane] = (bf16)(wv >> 16); }
        gv0 = gn0; gv1 = gn1;
        if (c + 1 < nchunks) { const bf16* g = proj + (size_t)(rowc + 64) * INW + goff;
            pq[0] = *(const u32x4*)(g); pq[1] = *(const u32x4*)(g + 8); pk[0] = *(const u32x4*)(g + 512); pk[1] = *(const u32x4*)(g + 520); pv[0] = *(const u32x4*)(g + 1024); pv[1] = *(const u32x4*)(g + 1032);
            gn0 = *(const u32x4*)(proj + (size_t)(rowc + 64) * INW + ggoff); gn1 = *(const u32x4*)(proj + (size_t)(rowc + 64) * INW + ggoff + 8); }
        __syncthreads();
        { const int mi = wave >> 1;
#pragma unroll
          for (int jj = 0; jj < 2; ++jj) { const int lj = 2 * (wave & 1) + jj; f32x4 s = (f32x4){0.f, 0.f, 0.f, 0.f};
#pragma unroll
            for (int ks = 0; ks < 4; ++ks) { const bf16x8 a = *(const LAS bf16x8*)(Ks + (16 * mi + fr) * 136 + 32 * ks + 8 * fq), b = *(const LAS bf16x8*)(Qs + (16 * lj + fr) * 136 + 32 * ks + 8 * fq); s = MFMA16(a, b, s); }
            const int l = 16 * lj + fr; float pvv[4];
#pragma unroll
            for (int r = 0; r < 4; ++r) { const int m = 16 * mi + 4 * fq + r; const int dlt = l - m; pvv[r] = dlt >= 0 ? s[r] * kscale * exp2f(lg2 * (float)dlt) : 0.f; }
            u32x2 w; w.x = pk2(pvv[0], pvv[1]); w.y = pk2(pvv[2], pvv[3]); *(LAS u32x2*)(Ps + l * 72 + 16 * mi + 4 * fq) = w; } }
#pragma unroll
        for (int et = 0; et < 8; ++et) st[et] = st[et] * g64;
#pragma unroll
        for (int ks = 0; ks < 2; ++ks) { const bf16x8 a = *(const LAS bf16x8*)(KT + (16 * wave + fr) * 72 + 32 * ks + 8 * fq);
#pragma unroll
            for (int et = 0; et < 8; ++et) { const bf16x8 b = *(const LAS bf16x8*)(VT + (16 * et + fr) * 72 + 32 * ks + 8 * fq); st[et] = MFMA16(a, b, st[et]); } }
        __syncthreads();
        { f32x4 oi[4], oc[4];
#pragma unroll
          for (int lt = 0; lt < 4; ++lt) { oi[lt] = (f32x4){0.f, 0.f, 0.f, 0.f}; oc[lt] = (f32x4){0.f, 0.f, 0.f, 0.f}; }
#pragma unroll
          for (int ks = 0; ks < 2; ++ks) { const bf16x8 b = *(const LAS bf16x8*)(VT + (16 * wave + fr) * 72 + 32 * ks + 8 * fq);
#pragma unroll
            for (int lt = 0; lt < 4; ++lt) { const bf16x8 a = *(const LAS bf16x8*)(Ps + (16 * lt + fr) * 72 + 32 * ks + 8 * fq); oi[lt] = MFMA16(a, b, oi[lt]); } }
#pragma unroll
          for (int ks = 0; ks < 4; ++ks) { const bf16x8 b = *(const LAS bf16x8*)(ST + (16 * wave + fr) * 136 + 32 * ks + 8 * fq);
#pragma unroll
            for (int lt = 0; lt < 4; ++lt) { const bf16x8 a = *(const LAS bf16x8*)(Qs + (16 * lt + fr) * 136 + 32 * ks + 8 * fq); oc[lt] = MFMA16(a, b, oc[lt]); } }
#pragma unroll
          for (int lt = 0; lt < 4; ++lt)
#pragma unroll
            for (int r = 0; r < 4; ++r) { const int l = 16 * lt + 4 * fq + r; Os[l * 132 + 16 * wave + fr] = oi[lt][r] + exp2f(lg2 * (float)(l + 1)) * oc[lt][r]; } }
        __syncthreads();
#pragma unroll
        for (int et = 0; et < 8; ++et) { u32x2 w; w.x = pk2(st[et][0], st[et][1]); w.y = pk2(st[et][2], st[et][3]); *(LAS u32x2*)(ST + (16 * et + fr) * 136 + 16 * wave + 4 * fq) = w; }
        {
          const int l = 8 * wave + (lane >> 3), seg = lane & 7;
          const u32x4 gw0 = gv0, gw1 = gv1;
          const LAS f32x4* op = (const LAS f32x4*)(Os + l * 132 + 16 * seg);
          f32x4 ov[4]; float ssq = 0.f;
#pragma unroll
          for (int k = 0; k < 4; ++k) { ov[k] = op[k]; ssq += (ov[k].x * ov[k].x + ov[k].y * ov[k].y) + (ov[k].z * ov[k].z + ov[k].w * ov[k].w); }
          ssq += __int_as_float(__builtin_amdgcn_update_dpp(__float_as_int(ssq), __float_as_int(ssq), 0xB1, 0xf, 0xf, false));
          ssq += __int_as_float(__builtin_amdgcn_update_dpp(__float_as_int(ssq), __float_as_int(ssq), 0x4E, 0xf, 0xf, false));
          ssq += __int_as_float(__builtin_amdgcn_update_dpp(__float_as_int(ssq), __float_as_int(ssq), 0x141, 0xf, 0xf, false));
          const float rstd = __builtin_amdgcn_rsqf(ssq * (1.f / 128.f) + EPS);
          bf16* mp = mix + (size_t)(rowc + l) * DM + h * 128 + 16 * seg;
#pragma unroll
          for (int hf = 0; hf < 2; ++hf) {
              float gf[8]; unpack8(hf ? gw1 : gw0, gf);
              u32x4 w;
#pragma unroll
              for (int k = 0; k < 2; ++k) { const f32x4 o4 = ov[2 * hf + k];
                  w[2 * k] = pk2(silu_f(gf[4 * k]) * (o4.x * rstd), silu_f(gf[4 * k + 1]) * (o4.y * rstd)); w[2 * k + 1] = pk2(silu_f(gf[4 * k + 2]) * (o4.z * rstd), silu_f(gf[4 * k + 3]) * (o4.w * rstd)); }
              *(u32x4*)(mp + 8 * hf) = w;
              asm volatile("" ::: "memory");
          }
        }
    }
#pragma unroll
    for (int et = 0; et < 8; ++et)
#pragma unroll
        for (int r = 0; r < 4; ++r) st_out[(size_t)(16 * wave + 4 * fq + r) * 128 + 16 * et + fr] = st[et][r];
}
constexpr int AK = 0, AVT = 27648;
__device__ __forceinline__ void att_item(const Params& P, LAS unsigned char* lds, int tid, int wave, int lane, bool sample, int b, int n, int g) {
    const bf16* proj = (const bf16*)(P.ws + WS_R1);
    bf16* mix = (bf16*)(P.ws + WS_R2);
    const int fr = lane & 15, fq = lane >> 4;
    LAS bf16* Kl = (LAS bf16*)(lds + AK); LAS bf16* VTl = (LAS bf16*)(lds + AVT);
    const int qrow0 = sample ? MP + 64 * b : b * SEQ + 64 * n;
    const int jmin = sample ? 0 : (n >= 2 ? 0 : 64 * (2 - n));
    __syncthreads();
    bf16x8 qa[2][2];
    { const int hd_ = 4 * g + (wave >> 1), qh_ = wave & 1;
#pragma unroll
      for (int qt = 0; qt < 2; ++qt)
#pragma unroll
        for (int ks = 0; ks < 2; ++ks) qa[qt][ks] = *(const bf16x8*)(proj + (size_t)(qrow0 + 32 * qh_ + 16 * qt + fr) * INW + 2048 + hd_ * 64 + 32 * ks + 8 * fq); }
    {
        u32x4 kw[3], vw[3];
        if (!sample) {
#pragma unroll
            for (int i = 0; i < 3; ++i) { const bool ok = 64 * i >= jmin;
                const int rb = ok ? b * SEQ + 64 * (n - 2) + 64 * i : qrow0;
                kw[i] = *(const u32x4*)(proj + (size_t)(rb + (tid >> 3)) * INW + 2560 + g * 64 + 8 * (tid & 7));
                vw[i] = *(const u32x4*)(proj + (size_t)(rb + lane) * INW + 2688 + g * 64 + 8 * wave);
                if (!ok) { kw[i] = (u32x4){0u, 0u, 0u, 0u}; vw[i] = (u32x4){0u, 0u, 0u, 0u}; } }
        } else {
            f32x4 kc[2][2], vc[2][2];
#pragma unroll
            for (int i = 0; i < 2; ++i) { const float* sk = P.cache_k + ((size_t)(b * 128 + 64 * i + (tid >> 3)) * 2 + g) * 64 + 8 * (tid & 7); const float* sv = P.cache_v + ((size_t)(b * 128 + 64 * i + lane) * 2 + g) * 64 + 8 * wave;
                kc[i][0] = *(const f32x4*)sk; kc[i][1] = *(const f32x4*)(sk + 4); vc[i][0] = *(const f32x4*)sv; vc[i][1] = *(const f32x4*)(sv + 4); }
            kw[2] = *(const u32x4*)(proj + (size_t)(MP + 64 * b + (tid >> 3)) * INW + 2560 + g * 64 + 8 * (tid & 7));
            vw[2] = *(const u32x4*)(proj + (size_t)(MP + 64 * b + lane) * INW + 2688 + g * 64 + 8 * wave);
#pragma unroll
            for (int i = 0; i < 2; ++i) { kw[i].x = pk2(kc[i][0].x, kc[i][0].y); kw[i].y = pk2(kc[i][0].z, kc[i][0].w); kw[i].z = pk2(kc[i][1].x, kc[i][1].y); kw[i].w = pk2(kc[i][1].z, kc[i][1].w);
                vw[i].x = pk2(vc[i][0].x, vc[i][0].y); vw[i].y = pk2(vc[i][0].z, vc[i][0].w); vw[i].z = pk2(vc[i][1].x, vc[i][1].y); vw[i].w = pk2(vc[i][1].z, vc[i][1].w); }
        }
#pragma unroll
        for (int i = 0; i < 3; ++i) { *(LAS u32x4*)(Kl + (64 * i + (tid >> 3)) * 72 + 8 * (tid & 7)) = kw[i];
            const int j = 64 * i + lane;
#pragma unroll
            for (int e = 0; e < 4; ++e) { VTl[(8 * wave + 2 * e) * 200 + j] = (bf16)(vw[i][e] & 0xffffu); VTl[(8 * wave + 2 * e + 1) * 200 + j] = (bf16)(vw[i][e] >> 16); } }
    }
    const int r = wave >> 1, qh = wave & 1, head = 4 * g + r;
    const float nb8 = -8.0f * exp2f(-(float)(head + 1));
    const float sink8 = 8.0f * P.sinks[head];
    const float c1 = 0.125f * 1.4426950408889634f;
    __syncthreads();
#pragma unroll 1
    for (int qt = 0; qt < 2; ++qt) {
        asm volatile("" ::: "memory");
        const int qi = 32 * qh + 16 * qt + fr;
        bf16x8 qf[2];
#pragma unroll
        for (int ks = 0; ks < 2; ++ks) { const u32x4 x0 = __builtin_bit_cast(u32x4, qa[0][ks]), x1 = __builtin_bit_cast(u32x4, qa[1][ks]); u32x4 xs;
#pragma unroll
            for (int e = 0; e < 4; ++e) xs[e] = qt ? x1[e] : x0[e];
            qf[ks] = __builtin_bit_cast(bf16x8, xs); }
        const float basef = (float)(128 + qi - 4 * fq);
        f32x4 s[12];
#pragma unroll
        for (int kt = 0; kt < 12; ++kt) {
#pragma unroll
            for (int rr = 0; rr < 4; ++rr) s[kt][rr] = fabsf(basef - (float)(16 * kt + rr)) * nb8;
#pragma unroll
            for (int ks = 0; ks < 2; ++ks) { const bf16x8 a = *(const LAS bf16x8*)(Kl + (16 * kt + fr) * 72 + 32 * ks + 8 * fq); s[kt] = MFMA16(a, qf[ks], s[kt]); } }
        if (jmin > 0) {
#pragma unroll
            for (int kt = 0; kt < 12; ++kt)
#pragma unroll
                for (int rr = 0; rr < 4; ++rr) s[kt][rr] = (16 * kt + 4 * fq + rr) >= jmin ? s[kt][rr] : -INFINITY;
        }
        float mx = sink8;
#pragma unroll
        for (int kt = 0; kt < 12; ++kt)
#pragma unroll
            for (int rr = 0; rr < 4; ++rr) mx = fmaxf(mx, s[kt][rr]);
        mx = fmaxf(mx, __shfl_xor(mx, 16)); mx = fmaxf(mx, __shfl_xor(mx, 32));
        const float mxc = mx * c1;
        float ls = 0.f;
#pragma unroll
        for (int kt = 0; kt < 12; ++kt)
#pragma unroll
            for (int rr = 0; rr < 4; ++rr) { const float p = __builtin_amdgcn_exp2f(s[kt][rr] * c1 - mxc); s[kt][rr] = p; ls += p; }
        ls += __shfl_xor(ls, 16); ls += __shfl_xor(ls, 32);
        const float inv = 1.0f / (ls + __builtin_amdgcn_exp2f(sink8 * c1 - mxc));
        f32x4 o[4];
#pragma unroll
        for (int dt = 0; dt < 4; ++dt) o[dt] = (f32x4){0.f, 0.f, 0.f, 0.f};
#pragma unroll
        for (int kk = 0; kk < 6; ++kk) {
            u32x4 w; w.x = pk2(s[2 * kk][0], s[2 * kk][1]); w.y = pk2(s[2 * kk][2], s[2 * kk][3]); w.z = pk2(s[2 * kk + 1][0], s[2 * kk + 1][1]); w.w = pk2(s[2 * kk + 1][2], s[2 * kk + 1][3]);
            const bf16x8 pb = __builtin_bit_cast(bf16x8, w);
#pragma unroll
            for (int dt = 0; dt < 4; ++dt) { const LAS bf16* vp = VTl + (16 * dt + fr) * 200 + 32 * kk + 4 * fq;
                const u32x2 lo = *(const LAS u32x2*)vp, hi = *(const LAS u32x2*)(vp + 16);
                const u32x4 aw = (u32x4){lo.x, lo.y, hi.x, hi.y}; const bf16x8 a = __builtin_bit_cast(bf16x8, aw);
                o[dt] = MFMA16(a, pb, o[dt]); }
        }
        bf16* mp = mix + (size_t)(qrow0 + qi) * DM + 512 + head * 64 + 4 * fq;
#pragma unroll
        for (int dt = 0; dt < 4; ++dt) { const f32x4 v = o[dt] * inv; u32x2 w; w.x = pk2(v[0], v[1]); w.y = pk2(v[2], v[3]); *(u32x2*)(mp + 16 * dt) = w; }
    }
}
__device__ __forceinline__ void phase3(const Params& P, LAS unsigned char* lds, int tid, int wave, int lane) {
    const int G = gridDim.x, NR = G / 2, blk = blockIdx.x;
    {
        const bool sample = blk >= NR; const int bh = (sample ? blk - NR : blk) & 127, b = bh >> 2, h = bh & 3;
        if (blk < 2 * NR && (sample ? blk - NR : blk) < 128)
            ret_item(P, lds, tid, wave, lane, h, sample ? MP + 64 * b : b * SEQ, sample ? 1 : 32, P.state_ret + (size_t)bh * 16384, sample, P.out + (sample ? OFF_SRET : OFF_PRET) + (size_t)bh * 16384);
    }
    if (blk >= NR) {
        for (int it = blk - NR; it < 2112; it += G - NR) {
            const bool sample = it >= 2048;
            att_item(P, lds, tid, wave, lane, sample, sample ? (it - 2048) >> 1 : it >> 6, sample ? 2 : (it >> 1) & 31, it & 1);
        }
    }
}

__device__ __forceinline__ void phase6(const Params& P, int tid) {
    const bf16* ua = (const bf16*)(P.ws + WS_R1); bf16* ub = (bf16*)(P.ws + WS_R2);
    constexpr int CH = DFF / 8;
    const int total = MT * CH;
    for (int idx = blockIdx.x * 512 + tid; idx < total; idx += gridDim.x * 512) {
        const int row = idx / CH, j = (idx - row * CH) * 8;
        const bool smp = row >= MP; const int t = smp ? ((row - MP) & 63) : (row & 2047);
        float a[8], p1[8], p2[8], bb[8];
        unpack8(*(const u32x4*)(ua + (size_t)row * DFF + j), a);
        unpack8(*(const u32x4*)(ub + (size_t)row * DFF + j), bb);
        if (t >= 1) unpack8(*(const u32x4*)(ua + (size_t)(row - 1) * DFF + j), p1);
        else if (smp) { const float* s = P.state_conv + ((size_t)((row - MP) >> 6) * 2 + 1) * DFF + j; const f32x4 x = *(const f32x4*)s, y = *(const f32x4*)(s + 4); p1[0] = x.x; p1[1] = x.y; p1[2] = x.z; p1[3] = x.w; p1[4] = y.x; p1[5] = y.y; p1[6] = y.z; p1[7] = y.w; }
        else {
#pragma unroll
            for (int e = 0; e < 8; ++e) p1[e] = 0.f; }
        if (t >= 2) unpack8(*(const u32x4*)(ua + (size_t)(row - 2) * DFF + j), p2);
        else if (smp) { const float* s = P.state_conv + ((size_t)((row - MP) >> 6) * 2 + t) * DFF + j; const f32x4 x = *(const f32x4*)s, y = *(const f32x4*)(s + 4); p2[0] = x.x; p2[1] = x.y; p2[2] = x.z; p2[3] = x.w; p2[4] = y.x; p2[5] = y.y; p2[6] = y.z; p2[7] = y.w; }
        else {
#pragma unroll
            for (int e = 0; e < 8; ++e) p2[e] = 0.f; }
        float r[8];
#pragma unroll
        for (int h = 0; h < 2; ++h) { const f32x4 w0 = *(const f32x4*)(P.conv_w + j + 4 * h), w1 = *(const f32x4*)(P.conv_w + DFF + j + 4 * h), w2 = *(const f32x4*)(P.conv_w + 2 * DFF + j + 4 * h), cb = *(const f32x4*)(P.conv_b + j + 4 * h);
#pragma unroll
            for (int e = 0; e < 4; ++e) { const float cv = cb[e] + w0[e] * p2[4 * h + e] + w1[e] * p1[4 * h + e] + w2[e] * a[4 * h + e]; r[4 * h + e] = silu_f(cv) * bb[4 * h + e]; } }
        u32x4 w; w.x = pk2(r[0], r[1]); w.y = pk2(r[2], r[3]); w.z = pk2(r[4], r[5]); w.w = pk2(r[6], r[7]);
        *(u32x4*)(ub + (size_t)row * DFF + j) = w;
    }
}
#ifdef CONV_FUSED
__device__ __forceinline__ void phase6c(const Params& P, int tid) {
    const float* headA = (const float*)(P.ws + WS_R1); const float* headB = headA + HT_STRIDE; const float* tailA = headA + 2 * HT_STRIDE;
    bf16* act = (bf16*)(P.ws + WS_R2);
    constexpr int CH = DFF / 4;
    const int total = NGRP * CH;
    for (int idx = blockIdx.x * 512 + tid; idx < total; idx += gridDim.x * 512) {
        const int g = idx / CH, j = (idx - g * CH) * 4;
        const bool smp = g >= 1024, first = !smp && (g & 31) == 0;
        const float* pp = smp ? P.state_conv + ((size_t)(g - 1024) * 2) * DFF + j : tailA + ((size_t)(first ? g : g - 1) * 2) * DFF + j;
        f32x4 p0 = *(const f32x4*)pp, p1 = *(const f32x4*)(pp + DFF);
        const f32x4 a0 = *(const f32x4*)(headA + ((size_t)g * 2) * DFF + j), a1 = *(const f32x4*)(headA + ((size_t)g * 2 + 1) * DFF + j);
        const f32x4 b0 = *(const f32x4*)(headB + ((size_t)g * 2) * DFF + j), b1 = *(const f32x4*)(headB + ((size_t)g * 2 + 1) * DFF + j);
        const f32x4 t0 = *(const f32x4*)(tailA + ((size_t)g * 2) * DFF + j), t1 = *(const f32x4*)(tailA + ((size_t)g * 2 + 1) * DFF + j);
        const f32x4 w0 = *(const f32x4*)(P.conv_w + j), w1 = *(const f32x4*)(P.conv_w + DFF + j), w2 = *(const f32x4*)(P.conv_w + 2 * DFF + j), cb = *(const f32x4*)(P.conv_b + j);
        if (first) { p0 = (f32x4){0.f, 0.f, 0.f, 0.f}; p1 = (f32x4){0.f, 0.f, 0.f, 0.f}; }
        const f32x4 c0 = cb + w0 * p0 + w1 * p1 + w2 * a0, c1 = cb + w0 * p1 + w1 * a0 + w2 * a1;
        u32x2 r0, r1;
        r0.x = pk2(silu_f(c0.x) * b0.x, silu_f(c0.y) * b0.y); r0.y = pk2(silu_f(c0.z) * b0.z, silu_f(c0.w) * b0.w);
        r1.x = pk2(silu_f(c1.x) * b1.x, silu_f(c1.y) * b1.y); r1.y = pk2(silu_f(c1.z) * b1.z, silu_f(c1.w) * b1.w);
        *(u32x2*)(act + (size_t)(64 * g) * DFF + j) = r0;
        *(u32x2*)(act + (size_t)(64 * g + 1) * DFF + j) = r1;
        if (smp) { float* d = P.out + OFF_SCONV + ((size_t)(g - 1024) * 2) * DFF + j; *(f32x4*)d = t0; *(f32x4*)(d + DFF) = t1; }
        else if ((g & 31) == 31) { float* d = P.out + OFF_PCONV + ((size_t)(g >> 5) * 2) * DFF + j; *(f32x4*)d = t0; *(f32x4*)(d + DFF) = t1; }
    }
}
#endif
__device__ __forceinline__ void phase8n(const Params& P, LAS unsigned char* lds, int tid, int wave, int lane) {
    const float* mod = (const float*)(P.ws + WS_MOD); const bf16* x2 = (const bf16*)(P.ws + WS_R0);
    LAS float* lv = (LAS float*)lds;
    const int b = blockIdx.x, bsP = b >> 3, bsS = 32 + (b >> 3);
    __syncthreads();
    for (int i = tid; i < 4096; i += 512) { const int sl = i >> 11, which = (i >> 10) & 1, col = i & 1023; const float* mb = mod + (size_t)(sl ? bsS : bsP) * 8192 + 6144;
        lv[i] = which ? P.normf[col] * (1.f + mb[1024 + col]) : mb[col]; }
    __syncthreads();
#pragma unroll 4
    for (int r = wave; r < 256; r += 8) {
        const int row = 256 * b + r;
        const bf16* xr = x2 + (size_t)row * DM + 4 * lane;
        f32x4 v[4]; float ss = 0.f;
#pragma unroll
        for (int j = 0; j < 4; ++j) { const u32x2 w = *(const u32x2*)(xr + 256 * j); v[j] = (f32x4){bflo(w.x), bfhi(w.x), bflo(w.y), bfhi(w.y)};
            ss += (v[j].x * v[j].x + v[j].y * v[j].y) + (v[j].z * v[j].z + v[j].w * v[j].w); }
        const float rstd = __builtin_amdgcn_rsqf(wave_sum_dpp(ss) * (1.f / DM) + EPS);
        float* yr = P.out + (size_t)row * DM + 4 * lane;
#pragma unroll
        for (int j = 0; j < 4; ++j) { const f32x4 sh = *(const LAS f32x4*)(lv + 256 * j + 4 * lane), gs = *(const LAS f32x4*)(lv + 1024 + 256 * j + 4 * lane);
            *(f32x4*)(yr + 256 * j) = v[j] * rstd * gs + sh; }
    }
    {
        const int r = 8 * b + wave, row = MP + r;
        const bf16* xr = (const bf16*)(P.ws + WS_X1B) + (size_t)row * DM + 4 * lane;
        const float* sl = (const float*)(P.ws + WS_SLAB) + (size_t)r * DM + 4 * lane;
        const float* g2 = mod + (size_t)bsS * 8192 + 5120 + 4 * lane;
        f32x4 v[4]; float ss = 0.f;
#pragma unroll
        for (int j = 0; j < 4; ++j) { const u32x2 w = *(const u32x2*)(xr + 256 * j); f32x4 a = *(const f32x4*)(sl + 256 * j);
#pragma unroll
            for (int p = 1; p < 4; ++p) a += *(const f32x4*)(sl + (size_t)p * MS * DM + 256 * j);
            v[j] = (f32x4){bflo(w.x), bfhi(w.x), bflo(w.y), bfhi(w.y)} + *(const f32x4*)(g2 + 256 * j) * a;
            ss += (v[j].x * v[j].x + v[j].y * v[j].y) + (v[j].z * v[j].z + v[j].w * v[j].w); }
        const float rstd = __builtin_amdgcn_rsqf(wave_sum_dpp(ss) * (1.f / DM) + EPS);
        float* yr = P.out + (size_t)row * DM + 4 * lane;
#pragma unroll
        for (int j = 0; j < 4; ++j) { const f32x4 sh = *(const LAS f32x4*)(lv + 2048 + 256 * j + 4 * lane), gs = *(const LAS f32x4*)(lv + 3072 + 256 * j + 4 * lane);
            *(f32x4*)(yr + 256 * j) = v[j] * rstd * gs + sh; }
    }
}
__device__ __forceinline__ void phase8(const Params& P, int wave, int lane) {
    const float* mod = (const float*)(P.ws + WS_MOD); const bf16* x2 = (const bf16*)(P.ws + WS_R0);
    const int gw = blockIdx.x * 8 + wave, NGW = gridDim.x * 8;
#pragma unroll 2
    for (int row = gw; row < MT; row += NGW) {
        const int bs = row < MP ? (row >> 11) : 32 + ((row - MP) >> 6);
        float* yr = P.out + (size_t)row * DM + 8 * lane;
        const float* mb = mod + (size_t)bs * 8192 + 6144 + 8 * lane;
        float v[2][8]; float ss = 0.f;
        if (row < MP) {
            const bf16* xr = x2 + (size_t)row * DM + 8 * lane;
#pragma unroll
            for (int j = 0; j < 2; ++j) unpack8(*(const u32x4*)(xr + 512 * j), v[j]);
        } else {
            const bf16* xr = (const bf16*)(P.ws + WS_X1B) + (size_t)row * DM + 8 * lane;
            const float* sl = (const float*)(P.ws + WS_SLAB) + (size_t)(row - MP) * DM + 8 * lane;
            const float* g2 = mod + (size_t)bs * 8192 + 5120 + 8 * lane;
#pragma unroll
            for (int j = 0; j < 2; ++j) { unpack8(*(const u32x4*)(xr + 512 * j), v[j]);
#pragma unroll
                for (int h = 0; h < 2; ++h) { const int o = 512 * j + 4 * h; f32x4 a = *(const f32x4*)(sl + o);
#pragma unroll
                    for (int p = 1; p < 4; ++p) a += *(const f32x4*)(sl + (size_t)p * MS * DM + o);
                    const f32x4 g = *(const f32x4*)(g2 + o);
#pragma unroll
                    for (int e = 0; e < 4; ++e) v[j][4 * h + e] += g[e] * a[e]; } }
        }
#pragma unroll
        for (int j = 0; j < 2; ++j)
#pragma unroll
            for (int e = 0; e < 8; ++e) ss += v[j][e] * v[j][e];
        const float rstd = rsqrtf(wave_sum(ss) * (1.f / DM) + EPS);
#pragma unroll
        for (int j = 0; j < 2; ++j)
#pragma unroll
            for (int h = 0; h < 2; ++h) { const int o = 512 * j + 4 * h; const f32x4 sh = *(const f32x4*)(mb + o), sc = *(const f32x4*)(mb + 1024 + o), gn = *(const f32x4*)(P.normf + 8 * lane + o);
                const f32x4 x = (f32x4){v[j][4 * h], v[j][4 * h + 1], v[j][4 * h + 2], v[j][4 * h + 3]};
                *(f32x4*)(yr + o) = x * rstd * gn * (sc + 1.0f) + sh; }
    }
}
__device__ __forceinline__ void phase8q(const Params& P, LAS unsigned char* lds, int tid, int wave, int lane) {
    const float* mod = (const float*)(P.ws + WS_MOD);
    unsigned* cnt = (unsigned*)(P.ws + WS_CNT7); unsigned* ticket = (unsigned*)(P.ws + WS_TICKET);
    LAS int* ord = (LAS int*)(lds + 131072);
    LAS int* flag = ord + 272;
    pg8::StaticOrder S; S.init(MT, DM, (int)gridDim.x, 0);
    for (int i = tid; i < NTM; i += 512) flag[i] = 0;
    __syncthreads();
    { const int full = (S.nwg / S.G) * S.G; for (int L = full + tid; L < S.nwg; L += 512) { pg8::Unit u; S.map(L, u); flag[u.pm] = 1; } }
    __syncthreads();
    if (tid == 0) { int k = 0; for (int i = 0; i < NTM; ++i) if (!flag[i]) ord[k++] = i; for (int i = 0; i < NTM; ++i) if (flag[i]) ord[k++] = i; }
    __syncthreads();
    for (;;) {
        if (tid == 0) flag[268] = (int)__hip_atomic_fetch_add(ticket, 1u, __ATOMIC_RELAXED, __HIP_MEMORY_SCOPE_AGENT);
        __syncthreads();
        const int tk = flag[268];
        if (tk >= NTM * 4) break;
        const int pm = ord[tk >> 2], rb = tk & 3;
        if (wave == 0) {
            unsigned spins = 0;
            while ((unsigned)__builtin_amdgcn_readfirstlane(__hip_atomic_load(cnt + 64 * pm, __ATOMIC_RELAXED, __HIP_MEMORY_SCOPE_AGENT)) < 32u) { __builtin_amdgcn_s_sleep(4); if (++spins > (1u << 22)) break; }
            __builtin_amdgcn_fence(__ATOMIC_ACQUIRE, "agent");
            asm volatile("s_waitcnt vmcnt(0)" ::: "memory");
        }
        __syncthreads();
#pragma unroll 2
        for (int i = 0; i < 8; ++i) {
            const int row = pm * 256 + rb * 64 + wave * 8 + i;
            const int bs = row < MP ? (row >> 11) : 32 + ((row - MP) >> 6);
            float* yr = P.out + (size_t)row * DM + 4 * lane;
            const float* mb = mod + (size_t)bs * 8192 + 6144 + 4 * lane;
            f32x4 v[4]; float ss = 0.f;
#pragma unroll
            for (int j = 0; j < 4; ++j) { v[j] = *(const f32x4*)(yr + 256 * j); ss += (v[j].x * v[j].x + v[j].y * v[j].y) + (v[j].z * v[j].z + v[j].w * v[j].w); }
            const float rstd = rsqrtf(wave_sum(ss) * (1.f / DM) + EPS);
#pragma unroll
            for (int j = 0; j < 4; ++j) { const f32x4 sh = *(const f32x4*)(mb + 256 * j), sc = *(const f32x4*)(mb + 1024 + 256 * j), gn = *(const f32x4*)(P.normf + 4 * lane + 256 * j);
                *(f32x4*)(yr + 256 * j) = v[j] * rstd * gn * (sc + 1.0f) + sh; }
        }
    }
}

__device__ __forceinline__ void sample_fix(const Params& P, int wave, int lane) {
    const float* mod = (const float*)(P.ws + WS_MOD); const float* sl0 = (const float*)(P.ws + WS_SLAB4);
    bf16* a2 = (bf16*)(P.ws + WS_R0); bf16* x1b = (bf16*)(P.ws + WS_X1B); float* ss1 = (float*)(P.ws + WS_SS1);
    const int gw = blockIdx.x * 8 + wave, NGW = gridDim.x * 8;
    for (int r = gw; r < MS; r += NGW) {
        const int row = MP + r, bs = 32 + (r >> 6);
        const float* xr = P.x_s + (size_t)r * DM + 8 * lane; const float* sl = sl0 + (size_t)r * DM + 8 * lane; const float* mb = mod + (size_t)bs * 8192 + 8 * lane;
        float v[2][8], a[2][8]; float ss = 0.f;
#pragma unroll
        for (int j = 0; j < 2; ++j)
#pragma unroll
            for (int h = 0; h < 2; ++h) { const int o = 512 * j + 4 * h; f32x4 acc = *(const f32x4*)(sl + o);
#pragma unroll
                for (int p = 1; p < 4; ++p) acc += *(const f32x4*)(sl + (size_t)p * MS * DM + o);
                const f32x4 x = *(const f32x4*)(xr + o) + *(const f32x4*)(mb + 2048 + o) * acc;
                const f32x4 gs = *(const f32x4*)(P.ln2 + 8 * lane + o) * (*(const f32x4*)(mb + 4096 + o) + 1.0f);
#pragma unroll
                for (int e = 0; e < 4; ++e) { v[j][4 * h + e] = x[e]; a[j][4 * h + e] = x[e] * gs[e]; ss += x[e] * x[e]; } }
        ss = wave_sum(ss);
#pragma unroll
        for (int j = 0; j < 2; ++j) { u32x4 w; w.x = pk2(v[j][0], v[j][1]); w.y = pk2(v[j][2], v[j][3]); w.z = pk2(v[j][4], v[j][5]); w.w = pk2(v[j][6], v[j][7]);
            *(u32x4*)(x1b + (size_t)row * DM + 8 * lane + 512 * j) = w;
            w.x = pk2(a[j][0], a[j][1]); w.y = pk2(a[j][2], a[j][3]); w.z = pk2(a[j][4], a[j][5]); w.w = pk2(a[j][6], a[j][7]);
            *(u32x4*)(a2 + (size_t)row * DM + 8 * lane + 512 * j) = w; }
        if (lane < 16) ss1[(size_t)row * 16 + lane] = lane == 0 ? ss : 0.f;
    }
}

#ifndef N_LAUNCH
#define N_LAUNCH 1
#endif
#define LAUNDER_TID() int tid = threadIdx.x; asm volatile("" : "+v"(tid)); const int lane = tid & 63, wave = __builtin_amdgcn_readfirstlane(tid >> 6); (void)lane; (void)wave
template <int PHM>
__global__ void __launch_bounds__(512) fwd_mega(Params P) {
    extern __shared__ __attribute__((aligned(16))) unsigned char lds_raw[];
    LAS unsigned char* lds = (LAS unsigned char*)lds_raw;
    const int G = gridDim.x;
    unsigned char* ws = P.ws;
    volatile LAS unsigned* misc = (volatile LAS unsigned*)(lds + LDS_MISC);
    if (threadIdx.x < 2) misc[threadIdx.x] = 0u;
    __syncthreads();
    XcdBarrier bar; bar.bar = (unsigned*)(ws + WS_BAR); bar.x = 0; bar.st = misc;
#define GSYNC(a, b) do { if ((PHM & (a)) && (PHM & (b))) xcd_barrier(bar); } while (0)
    if constexpr (PHM == 511) {
      if (blockIdx.x == 0) for (int i = threadIdx.x; i < XCD_BAR_WORDS; i += 512) ((unsigned*)(ws + WS_BAR))[i] = 0u;
      if (blockIdx.x == 1) { for (int i = threadIdx.x; i < NTM * 64; i += 512) ((unsigned*)(ws + WS_CNT7))[i] = 0u; if (threadIdx.x < 64) ((unsigned*)(ws + WS_TICKET))[threadIdx.x] = 0u; }
      cg::this_grid().sync();
      bar = xcd_barrier_post((unsigned*)(ws + WS_BAR), misc); }
    if constexpr ((PHM & 1) != 0) { LAUNDER_TID(); phase0(P, lds, wave, lane); }
    GSYNC(1, 2);
    if constexpr ((PHM & 2) != 0) { LAUNDER_TID(); phase1(P, lds, tid, wave, lane); }
    GSYNC(2, 4);
    if constexpr ((PHM & 4) != 0) {
      pg8::Gemm g{(const bf16*)(ws + WS_R0), (const bf16*)(ws + WS_WIN), MT, INW, DM};
      OrderX S; S.S.init(MT, INW, G, (int)blockIdx.x); S.nX = 22; S.xpm = NTM; S.xpn0 = 11;
      Epi1 E{(bf16*)(ws + WS_R1), (float*)(ws + WS_SHW), P.out};
      pg8::gemm_phase<Epi1, OrderX, true, true>(lds, g, S, E); }
    GSYNC(4, 8);
    if constexpr ((PHM & 8) != 0) { LAUNDER_TID(); phase3(P, lds, tid, wave, lane);
#ifdef PROBE_P3X2
      cg::this_grid().sync(); phase3(P, lds, tid, wave, lane);
#endif
    }
    GSYNC(8, 16);
    if constexpr ((PHM & 16) != 0) {
      pg8::Gemm g{(const bf16*)(ws + WS_R2), (const bf16*)(ws + WS_WOUT), MT, DM, DM};
      OrderDown S; S.S.init(MP, DM, G, (int)blockIdx.x); S.ka = 4; S.kb = 4;
      Epi2 E{P.x_p, P.x_s, (const float*)(ws + WS_MOD), P.ln2, (bf16*)(ws + WS_X1B), (bf16*)(ws + WS_R0), (float*)(ws + WS_SS1), (float*)(ws + WS_SLAB4)};
      pg8::gemm_phase<Epi2, OrderDown, true, true>(lds, g, S, E); }
    GSYNC(16, 32);
    if constexpr ((PHM & 32) != 0) {
      LAUNDER_TID();
      sample_fix(P, wave, lane);
      if constexpr (PHM == 511) xcd_barrier(bar);
      pg8::Gemm g{(const bf16*)(ws + WS_R0), (const bf16*)(ws + WS_WUP), MT, 2 * DFF, DM};
      pg8::StaticOrder S; S.init(MT, 2 * DFF, G, (int)blockIdx.x);
      LAS float* rtab = (LAS float*)(lds + 131072);
      {
        LAS int* pmt = (LAS int*)lds;
        if (tid < 24) { pg8::Unit u; const bool ok = S.next(tid, u); pmt[tid] = ok ? u.pm : -1; }
        __syncthreads();
        if (tid < 256) { const float* ss = (const float*)(ws + WS_SS1);
#pragma unroll
          for (int i0 = 0; i0 < 24; i0 += 6) {
            f32x4 q[6][4]; int pmv[6];
#pragma unroll
            for (int k = 0; k < 6; ++k) { pmv[k] = pmt[i0 + k]; const f32x4* sp = (const f32x4*)(ss + (size_t)((pmv[k] < 0 ? 0 : pmv[k]) * 256 + tid) * 16);
#pragma unroll
                for (int e = 0; e < 4; ++e) q[k][e] = sp[e]; }
#pragma unroll
            for (int k = 0; k < 6; ++k) { const float tot = ((q[k][0].x + q[k][0].y) + (q[k][0].z + q[k][0].w)) + ((q[k][1].x + q[k][1].y) + (q[k][1].z + q[k][1].w)) + ((q[k][2].x + q[k][2].y) + (q[k][2].z + q[k][2].w)) + ((q[k][3].x + q[k][3].y) + (q[k][3].z + q[k][3].w));
                rtab[(i0 + k) * 256 + tid] = __builtin_amdgcn_rsqf(tot * (1.f / DM) + EPS); } } }
        __syncthreads(); }
#ifdef CONV_FUSED
      float* hA = (float*)(ws + WS_R1);
      Epi3C E{rtab, (const float*)(ws + WS_SHW), P.conv_w, P.conv_b, (bf16*)(ws + WS_R2), hA, hA + HT_STRIDE, hA + 2 * HT_STRIDE};
      pg8::gemm_phase<Epi3C, pg8::StaticOrder, true, true>(lds, g, S, E);
#else
      Epi3 E{rtab, (const float*)(ws + WS_SHW), (bf16*)(ws + WS_R1), (bf16*)(ws + WS_R2), P.out};
      pg8::gemm_phase<Epi3, pg8::StaticOrder, true, true>(lds, g, S, E);
#endif
#ifdef PROBE_P5X2
      cg::this_grid().sync(); pg8::gemm_phase<Epi3, pg8::StaticOrder, true, true>(lds, g, S, E);
#endif
    }
    GSYNC(32, 64);
#ifdef CONV_FUSED
    if constexpr ((PHM & 64) != 0) { LAUNDER_TID(); phase6c(P, tid); }
#else
    if constexpr ((PHM & 64) != 0) { LAUNDER_TID(); phase6(P, tid); }
#endif
    GSYNC(64, 128);
    if constexpr ((PHM & 128) != 0) {
      pg8::Gemm g{(const bf16*)(ws + WS_R2), (const bf16*)(ws + WS_WDN), MT, DM, DFF};
#ifdef P8_QUEUE
      OrderPub S; S.init(MT, DM, G, (int)blockIdx.x); S.cnt = (unsigned*)(ws + WS_CNT7);
      Epi4 E{(const float*)(ws + WS_MOD), (const bf16*)(ws + WS_X1B), (bf16*)(ws + WS_R0), (float*)(ws + WS_SLAB)};
      pg8::gemm_phase<Epi4, OrderPub, true, true>(lds, g, S, E); }
    if constexpr ((PHM & 256) != 0) { LAUNDER_TID(); phase8q(P, lds, tid, wave, lane); }
#else
      OrderDown S; S.S.init(MP, DM, G, (int)blockIdx.x); S.ka = 12; S.kb = 10;
      Epi4 E{(const float*)(ws + WS_MOD), (const bf16*)(ws + WS_X1B), (bf16*)(ws + WS_R0), (float*)(ws + WS_SLAB)};
      pg8::gemm_phase<Epi4, OrderDown, true, true>(lds, g, S, E); }
    GSYNC(128, 256);
    if constexpr ((PHM & 256) != 0) { LAUNDER_TID(); if (gridDim.x == 256) phase8n(P, lds, tid, wave, lane); else phase8(P, wave, lane); }
#endif
}

template <int PHM> static bool launch_one(const Params& p, int grid, bool coop, hipStream_t stream) {
    static bool attr_done = false;
    if (!attr_done) { if (hipFuncSetAttribute((const void*)fwd_mega<PHM>, hipFuncAttributeMaxDynamicSharedMemorySize, LDS_BYTES) != hipSuccess) { fprintf(stderr, "kernel_launch: hipFuncSetAttribute failed\n"); return false; } attr_done = true; }
    hipError_t e;
    if (coop) { Params pc = p; void* args[] = {&pc}; e = hipLaunchCooperativeKernel((const void*)fwd_mega<PHM>, dim3(grid), dim3(512), args, LDS_BYTES, stream); }
    else { hipLaunchKernelGGL(fwd_mega<PHM>, dim3(grid), dim3(512), LDS_BYTES, stream, p); e = hipPeekAtLastError(); }
    if (e != hipSuccess) { fprintf(stderr, "launch (mask %d) failed: %s (grid %d)\n", PHM, hipGetErrorString(e), grid); return false; }
    return true;
}
extern "C" void kernel_launch(void* const* d_in, const int* in_sizes, int n_in, void* d_out, int out_size, void* d_ws, size_t ws_size, hipStream_t stream) {
    static int grid = 0;
    if (grid == 0) {
        if (n_in != 22 || (size_t)out_size != OUT_TOTAL || ws_size < WS_END) { fprintf(stderr, "kernel_launch: unexpected sizes n_in %d out %d ws %zu\n", n_in, out_size, ws_size); grid = -1; return; }
        int dev = 0, cus = 0;
        (void)hipGetDevice(&dev);
        (void)hipDeviceGetAttribute(&cus, hipDeviceAttributeMultiprocessorCount, dev);
        grid = cus;
        if (grid > 256) grid = 256;
        if (grid < 2) grid = -1;
    }
    if (grid < 0) return;
    Params p{};
    const float** pp = (const float**)&p;
    for (int i = 0; i < 22; ++i) pp[i] = (const float*)d_in[i];
    p.out = (float*)d_out; p.ws = (unsigned char*)d_ws;
#if N_LAUNCH == 1
    launch_one<511>(p, grid, true, stream);
#else
    launch_one<1>(p, grid, false, stream) && launch_one<2>(p, grid, false, stream) && launch_one<4>(p, grid, false, stream) && launch_one<8>(p, grid, false, stream) &&
    launch_one<16>(p, grid, false, stream) && launch_one<32>(p, grid, false, stream) && launch_one<64>(p, grid, false, stream) && launch_one<128>(p, grid, false, stream) && launch_one<256>(p, grid, false, stream);
#endif
}
```

```cpp
#define CONV_FUSED 1
#include <hip/hip_runtime.h>
#include <hip/hip_cooperative_groups.h>
#include <cstdio>
#include <cstdint>
namespace cg = cooperative_groups;
namespace pg8 {
#define PG8_LAS __attribute__((address_space(3)))
typedef unsigned short bf16_t;
typedef short bf16x8 __attribute__((ext_vector_type(8)));
typedef float f32x4 __attribute__((ext_vector_type(4)));
typedef unsigned u32x4 __attribute__((ext_vector_type(4)));
constexpr int BM = 256, BK = 64, HALF = 128, HTB = HALF * BK * 2  , STAGE_BYTES = 8 * HTB, NXCD = 8, WGM = 8;

__host__ __device__ __forceinline__ int lds_byte(int r, int c) { const int st = (r >> 4) * 2 + (c >> 5), rr = r & 15, cc = c & 31, ob = rr * 64 + cc * 2; return st * 1024 + (ob ^ (((ob >> 9) & 1) << 5)); }
__host__ __device__ __forceinline__ void stage_rc(int b, int& R, int& C) { const int st = b / 1024, sb = b % 1024, swz = sb ^ (((sb >> 9) & 1) << 5); R = (st >> 1) * 16 + swz / 64; C = (st & 1) * 32 + (swz % 64) / 2; }
__host__ __device__ __forceinline__ int perm32(int rho) { const int n = rho >> 4, i = rho & 15; return 8 * (i >> 2) + 4 * n + (i & 3); }

struct Unit { int pm, pn, seq, kt0, nt; };
struct Gemm { const bf16_t* A; const bf16_t* Bt; int M, N, K; };

struct StaticOrder {
    int nM, nN, nwg, G, c;
    __host__ __device__ __forceinline__ void init(int M, int N, int G_, int c_) { nM = M / BM; nN = N / BM; nwg = nM * nN; G = G_; c = c_; }
    __host__ __device__ __forceinline__ bool next(int i, Unit& u) const {
        const long L = (long)i * G + c; if (L >= nwg) return false; u.seq = i; u.kt0 = 0; u.nt = 0; map(L, u); return true; }
    __host__ __device__ __forceinline__ void map(long L, Unit& u) const {
        int wgid = (int)L; { const int q = nwg / NXCD, r = nwg % NXCD, xcd = wgid % NXCD, off = wgid / NXCD; wgid = (xcd < r ? xcd * (q + 1) : r * (q + 1) + (xcd - r) * q) + off; }
        const int nig = WGM * nN, gid = wgid / nig, fm = gid * WGM, gsz = (nM - fm) < WGM ? (nM - fm) : WGM;
        u.pm = fm + ((wgid % nig) % gsz); u.pn = (wgid % nig) / gsz;
    }
    __device__ __forceinline__ void a_ready(const Unit&) const {}
    __device__ __forceinline__ void done(const Unit&) const {}
};

__device__ __forceinline__ unsigned cvt_pk_bf16(float lo, float hi) { unsigned r; asm volatile("v_cvt_pk_bf16_f32 %0, %1, %2" : "=v"(r) : "v"(lo), "v"(hi)); return r; }

template <class Epi, class Sched, bool ALIGN_EPI = false, bool SP2 = false>
__device__ __forceinline__ void gemm_phase(PG8_LAS unsigned char* lds, const Gemm g, const Sched& S, const Epi& E) {
    int tid_ = threadIdx.x; asm volatile("" : "+v"(tid_));
    const int tid = tid_, wid = __builtin_amdgcn_readfirstlane(tid >> 6), lane = tid & 63, wr = wid >> 2, wc = wid & 3, fr = lane & 15, fq = lane >> 4;
    const int K = g.K, nt = K / BK;
    unsigned voffA[2], voffB[2];
#pragma unroll
    for (int i = 0; i < 2; ++i) { int R, C; stage_rc(tid * 16 + i * 8192, R, C); const int Rb = Epi::PERM ? ((R & ~31) + perm32(R & 31)) : R;
        voffA[i] = (unsigned)(R * K + C) * 2u; voffB[i] = (unsigned)(Rb * K + C) * 2u; }
    const size_t kstep = (size_t)(BK * 2);
    const size_t hstep = (size_t)HALF * K * 2;
    const size_t tstep = 2 * hstep;
    const unsigned ldsw = (unsigned)wid * 1024u;
    const int aoff = lds_byte(wr * 64 + fr, fq * 8), boff = lds_byte(wc * 32 + fr, fq * 8);
#define PG8_SA(b, h) (((b) * 2 + (h)) * HTB)
#define PG8_SB(b, h) ((4 + (b) * 2 + (h)) * HTB)
#define PG8_STAGE(bufoff, gbase, voff) do { _Pragma("unroll") for (int _i = 0; _i < 2; ++_i) \
        __builtin_amdgcn_global_load_lds((const unsigned*)((const char*)(gbase) + (voff)[_i]), (PG8_LAS unsigned*)(lds + (bufoff) + ldsw + _i * 8192), 16, 0, 0); } while (0)
#define PG8_LDA(dst, b, h) do { _Pragma("unroll") for (int m = 0; m < 4; ++m) _Pragma("unroll") for (int k = 0; k < 2; ++k) dst[m][k] = *(const PG8_LAS bf16x8*)(lds + PG8_SA(b, h) + aoff + m * 2048 + k * 1024); } while (0)
#define PG8_LDB(dst, b, h) do { _Pragma("unroll") for (int n = 0; n < 2; ++n) _Pragma("unroll") for (int k = 0; k < 2; ++k) dst[n][k] = *(const PG8_LAS bf16x8*)(lds + PG8_SB(b, h) + boff + n * 2048 + k * 1024); } while (0)
#define PG8_MMA(ai, bj, At, Bt) do { __builtin_amdgcn_s_setprio(1); _Pragma("unroll") for (int m = 0; m < 4; ++m) _Pragma("unroll") for (int n = 0; n < 2; ++n) _Pragma("unroll") for (int k = 0; k < 2; ++k) \
        acc[ai][bj][m][n] = __builtin_amdgcn_mfma_f32_16x16x32_bf16(Bt[n][k], At[m][k], acc[ai][bj][m][n], 0, 0, 0); __builtin_amdgcn_s_setprio(0); } while (0)
#define PG8_WAIT_V(n) asm volatile("s_waitcnt vmcnt(" #n ")" ::: "memory")
#define PG8_WAIT_L(n) asm volatile("s_waitcnt lgkmcnt(" #n ")" ::: "memory")
#define PG8_BAR __builtin_amdgcn_s_barrier()
#define PG8_SCHED __builtin_amdgcn_sched_barrier(0)
    Unit cur, nxt; int ui = 0;
    if (!S.next(0, cur)) return;
    f32x4 acc[2][2][4][2];
#pragma unroll
    for (int a = 0; a < 2; ++a)
#pragma unroll
        for (int b = 0; b < 2; ++b)
#pragma unroll
            for (int m = 0; m < 4; ++m)
#pragma unroll
                for (int n = 0; n < 2; ++n) acc[a][b][m][n] = (f32x4){0.f, 0.f, 0.f, 0.f};
    bf16x8 At[4][2], B0[2][2], B1[2][2];
    const char* cA = (const char*)g.A + (size_t)cur.pm * tstep + (size_t)cur.kt0 * (BK * 2); const char* cB = (const char*)g.Bt + (size_t)cur.pn * tstep + (size_t)cur.kt0 * (BK * 2);
    S.a_ready(cur);
    if constexpr (SP2) {
        PG8_STAGE(PG8_SB(0, 0), cB, voffB); PG8_STAGE(PG8_SB(0, 1), cB + hstep, voffB); PG8_STAGE(PG8_SA(0, 0), cA, voffA); PG8_STAGE(PG8_SA(0, 1), cA + hstep, voffA);
        if (wr == 1) PG8_BAR;
        PG8_WAIT_V(2); PG8_BAR;
        PG8_STAGE(PG8_SB(1, 0), cB + kstep, voffB); PG8_STAGE(PG8_SA(1, 0), cA + kstep, voffA); PG8_STAGE(PG8_SB(1, 1), cB + hstep + kstep, voffB);
        PG8_WAIT_V(6); PG8_BAR;
    } else {
        PG8_STAGE(PG8_SB(0, 0), cB, voffB); PG8_STAGE(PG8_SA(0, 0), cA, voffA); PG8_STAGE(PG8_SB(0, 1), cB + hstep, voffB); PG8_STAGE(PG8_SA(0, 1), cA + hstep, voffA);
        if (wr == 1) PG8_BAR;
        PG8_WAIT_V(4); PG8_BAR;
        PG8_STAGE(PG8_SB(1, 0), cB + kstep, voffB); PG8_STAGE(PG8_SA(1, 0), cA + kstep, voffA); PG8_STAGE(PG8_SB(1, 1), cB + hstep + kstep, voffB);
        PG8_WAIT_V(6); PG8_BAR;
    }
    for (;;) {
        const bool has_next = S.next(ui + 1, nxt);
        const char* nA = has_next ? (const char*)g.A + (size_t)nxt.pm * tstep + (size_t)nxt.kt0 * (BK * 2) : cA; const char* nB = has_next ? (const char*)g.Bt + (size_t)nxt.pn * tstep + (size_t)nxt.kt0 * (BK * 2) : cB;
        const int ntu = cur.nt ? cur.nt : nt;
        for (int t = 0; t < ntu; t += 2) {
            const bool last = (t == ntu - 2);
            const char* a1 = cA + (size_t)(t + 1) * kstep;
            const char* a2 = last ? nA : cA + (size_t)(t + 2) * kstep; const char* b2 = last ? nB : cB + (size_t)(t + 2) * kstep;
            const char* a3 = a2 + kstep; const char* b3 = b2 + kstep;
            if (last && has_next) S.a_ready(nxt);
            if constexpr (SP2) {
            PG8_LDB(B0, 0, 0); PG8_LDB(B1, 0, 1); PG8_SCHED; PG8_LDA(At, 0, 0); PG8_STAGE(PG8_SA(1, 1), a1 + hstep, voffA);
            PG8_WAIT_V(8); PG8_WAIT_L(0); PG8_BAR; PG8_MMA(0, 0, At, B0); PG8_MMA(0, 1, At, B1); PG8_BAR; PG8_SCHED;
            PG8_LDA(At, 0, 1); PG8_STAGE(PG8_SB(0, 0), b2, voffB); PG8_STAGE(PG8_SB(0, 1), b2 + hstep, voffB); PG8_STAGE(PG8_SA(0, 0), a2, voffA);
            PG8_WAIT_V(8); PG8_WAIT_L(0); PG8_BAR; PG8_MMA(1, 0, At, B0); PG8_MMA(1, 1, At, B1); PG8_BAR; PG8_SCHED;
            PG8_LDB(B0, 1, 0); PG8_LDB(B1, 1, 1); PG8_SCHED; PG8_LDA(At, 1, 0); PG8_STAGE(PG8_SA(0, 1), a2 + hstep, voffA);
            PG8_WAIT_V(8); PG8_WAIT_L(0); PG8_BAR; PG8_MMA(0, 0, At, B0); PG8_MMA(0, 1, At, B1); PG8_BAR; PG8_SCHED;
            PG8_LDA(At, 1, 1); PG8_STAGE(PG8_SB(1, 0), b3, voffB); PG8_STAGE(PG8_SB(1, 1), b3 + hstep, voffB); PG8_STAGE(PG8_SA(1, 0), a3, voffA);
            PG8_WAIT_V(8); PG8_WAIT_L(0); PG8_BAR; PG8_MMA(1, 0, At, B0); PG8_MMA(1, 1, At, B1); PG8_BAR; PG8_SCHED;
            } else {
            PG8_LDB(B0, 0, 0); PG8_SCHED; PG8_LDA(At, 0, 0); PG8_STAGE(PG8_SA(1, 1), a1 + hstep, voffA);
            PG8_WAIT_L(8); PG8_BAR; PG8_WAIT_L(0); PG8_MMA(0, 0, At, B0); PG8_BAR; PG8_SCHED;
            PG8_LDB(B1, 0, 1); PG8_STAGE(PG8_SB(0, 0), b2, voffB);
            PG8_BAR; PG8_WAIT_L(0); PG8_MMA(0, 1, At, B1); PG8_BAR;
            PG8_LDA(At, 0, 1); PG8_STAGE(PG8_SA(0, 0), a2, voffA);
            PG8_BAR; PG8_WAIT_L(0); PG8_MMA(1, 0, At, B0); PG8_BAR; PG8_SCHED;
            PG8_STAGE(PG8_SB(0, 1), b2 + hstep, voffB);
            PG8_WAIT_V(6); PG8_BAR; PG8_MMA(1, 1, At, B1); PG8_BAR;
            PG8_LDB(B0, 1, 0); PG8_SCHED; PG8_LDA(At, 1, 0); PG8_STAGE(PG8_SA(0, 1), a2 + hstep, voffA);
            PG8_WAIT_L(8); PG8_BAR; PG8_WAIT_L(0); PG8_MMA(0, 0, At, B0); PG8_BAR; PG8_SCHED;
            PG8_LDB(B1, 1, 1); PG8_STAGE(PG8_SB(1, 0), b3, voffB);
            PG8_BAR; PG8_WAIT_L(0); PG8_MMA(0, 1, At, B1); PG8_BAR;
            PG8_LDA(At, 1, 1); PG8_STAGE(PG8_SA(1, 0), a3, voffA);
            PG8_BAR; PG8_WAIT_L(0); PG8_MMA(1, 0, At, B0); PG8_BAR; PG8_SCHED;
            PG8_STAGE(PG8_SB(1, 1), b3 + hstep, voffB);
            PG8_WAIT_V(6); PG8_BAR; PG8_MMA(1, 1, At, B1); PG8_BAR;
            }
        }
        if constexpr (ALIGN_EPI) { if (wr == 0) PG8_BAR; }
        if constexpr (!Epi::AFTER_DRAIN) { E(acc, cur, wr, wc, fr, fq); S.done(cur); }
        if (!has_next) break;
#pragma unroll
        for (int a = 0; a < 2; ++a)
#pragma unroll
            for (int b = 0; b < 2; ++b)
#pragma unroll
                for (int m = 0; m < 4; ++m)
#pragma unroll
                    for (int n = 0; n < 2; ++n) acc[a][b][m][n] = (f32x4){0.f, 0.f, 0.f, 0.f};
        cur = nxt; cA = nA; cB = nB; ++ui;
        if constexpr (ALIGN_EPI) { if (wr == 1) PG8_BAR; }
    }
    PG8_WAIT_V(0);
    if constexpr (!ALIGN_EPI) { if (wr == 0) PG8_BAR; }
    PG8_BAR;
    if constexpr (Epi::AFTER_DRAIN) { E.fused(acc, cur, wr, wc, fr, fq, lds, wid, lane); S.done(cur); }
#undef PG8_SA
#undef PG8_SB
#undef PG8_STAGE
#undef PG8_LDA
#undef PG8_LDB
#undef PG8_MMA
#undef PG8_WAIT_V
#undef PG8_WAIT_L
#undef PG8_BAR
#undef PG8_SCHED
}
}
constexpr int DM = 1024, SEQ = 2048, NB = 32, DECL = 64, DFF = 2816, INW = 2816;
constexpr int MP = NB * SEQ, MS = NB * DECL, MT = MP + MS;
constexpr int NGRP = MT / 64;
constexpr int NTM = MT / 256;
constexpr float EPS = 1e-6f;
constexpr size_t OFF_Y = 0;
constexpr size_t OFF_PRET = (size_t)MT * DM;
constexpr size_t OFF_PK = OFF_PRET + (size_t)NB * 4 * 128 * 128;
constexpr size_t OFF_PV = OFF_PK + (size_t)NB * 128 * 128;
constexpr size_t OFF_PCONV = OFF_PV + (size_t)NB * 128 * 128;
constexpr size_t OFF_SRET = OFF_PCONV + (size_t)NB * 2 * DFF;
constexpr size_t OFF_SK = OFF_SRET + (size_t)NB * 4 * 128 * 128;
constexpr size_t OFF_SV = OFF_SK + (size_t)NB * 64 * 128;
constexpr size_t OFF_SCONV = OFF_SV + (size_t)NB * 64 * 128;
constexpr size_t OUT_TOTAL = OFF_SCONV + (size_t)NB * 2 * DFF;
constexpr size_t MiB = 1u << 20;
constexpr size_t WS_WIN = 0;
constexpr size_t WS_WUP = WS_WIN + (size_t)INW * DM * 2;
constexpr size_t WS_WOUT = WS_WUP + (size_t)2 * DFF * DM * 2;
constexpr size_t WS_WDN = WS_WOUT + (size_t)DM * DM * 2;
constexpr size_t WS_MODP = 48 * MiB + 133 * MiB + 363 * MiB + 200 * MiB;
constexpr size_t WS_MOD = 32 * MiB;
constexpr size_t WS_SHW = 34 * MiB;
constexpr size_t WS_SS1 = 36 * MiB;
constexpr size_t WS_SS2 = 41 * MiB;
constexpr size_t WS_R0 = 48 * MiB;
constexpr size_t WS_R1 = WS_R0 + 133 * MiB;
constexpr size_t WS_R2 = WS_R1 + 363 * MiB;
constexpr size_t HT_STRIDE = (size_t)NGRP * 2 * DFF;
constexpr size_t WS_END = WS_R2 + 363 * MiB;
constexpr size_t WS_SLAB = WS_R1 + 264 * MiB;
constexpr size_t WS_SLAB4 = WS_R1 + 300 * MiB;
constexpr size_t WS_X1B = WS_R1 + 128 * MiB;
static_assert(3 * HT_STRIDE * 4 <= 128 * MiB && WS_X1B + (size_t)MT * DM * 2 <= WS_R2, "ws map");
static_assert(WS_WDN + (size_t)DM * DFF * 2 <= WS_MODP, "ws map");
static_assert((size_t)(MT + 256) * DM * 2 <= 133 * MiB && (size_t)MT * DFF * 2 <= 363 * MiB, "ws map");

constexpr size_t WS_BAR = 46 * MiB;
constexpr size_t WS_TICKET = 46 * MiB + 32768;
constexpr size_t WS_CNT7 = 46 * MiB + 65536;
constexpr int LDS_MISC = 155648;
constexpr int LDS_BYTES = 155648 + 64;

#define LAS __attribute__((address_space(3)))
typedef unsigned short bf16;
typedef float f32x4 __attribute__((ext_vector_type(4)));
typedef float f32x2 __attribute__((ext_vector_type(2)));
typedef short bf16x8 __attribute__((ext_vector_type(8)));
typedef unsigned u32x4 __attribute__((ext_vector_type(4)));
typedef unsigned u32x2 __attribute__((ext_vector_type(2)));
typedef __bf16 bf16x2_t __attribute__((ext_vector_type(2)));
#define LDS_WAIT() asm volatile("s_waitcnt lgkmcnt(0)" ::: "memory")

__device__ __forceinline__ unsigned pk2(float lo, float hi) { f32x2 v = {lo, hi}; bf16x2_t b = __builtin_convertvector(v, bf16x2_t); return __builtin_bit_cast(unsigned, b); }
__device__ __forceinline__ float bflo(unsigned w) { return __uint_as_float(w << 16); }
__device__ __forceinline__ float bfhi(unsigned w) { return __uint_as_float(w & 0xffff0000u); }
__device__ __forceinline__ float wave_sum(float v) {
#pragma unroll
    for (int o = 1; o < 64; o <<= 1) v += __shfl_xor(v, o);
    return v;
}
__device__ __forceinline__ float wave_sum_dpp(float v) {
    v += __int_as_float(__builtin_amdgcn_update_dpp(__float_as_int(v), __float_as_int(v), 0x128, 0xf, 0xf, false));
    v += __int_as_float(__builtin_amdgcn_update_dpp(__float_as_int(v), __float_as_int(v), 0x124, 0xf, 0xf, false));
    v += __int_as_float(__builtin_amdgcn_update_dpp(__float_as_int(v), __float_as_int(v), 0x122, 0xf, 0xf, false));
    v += __int_as_float(__builtin_amdgcn_update_dpp(__float_as_int(v), __float_as_int(v), 0x121, 0xf, 0xf, false));
    const int i = __float_as_int(v);
    return (__int_as_float(__builtin_amdgcn_readlane(i, 0)) + __int_as_float(__builtin_amdgcn_readlane(i, 16))) + (__int_as_float(__builtin_amdgcn_readlane(i, 32)) + __int_as_float(__builtin_amdgcn_readlane(i, 48)));
}
__device__ __forceinline__ float silu_f(float x) { return x * __builtin_amdgcn_rcpf(1.0f + __builtin_amdgcn_exp2f(-1.4426950408889634f * x)); }
__device__ __forceinline__ void unpack8(const u32x4 w, float (&f)[8]) { f[0] = bflo(w.x); f[1] = bfhi(w.x); f[2] = bflo(w.y); f[3] = bfhi(w.y); f[4] = bflo(w.z); f[5] = bfhi(w.z); f[6] = bflo(w.w); f[7] = bfhi(w.w); }
__device__ __forceinline__ int grp_bs(int g) { return g < 1024 ? (g >> 5) : 32 + (g - 1024); }

struct Params {
    const float *x_p, *x_s, *cache_k, *cache_v, *state_ret, *state_conv, *c_p, *c_s, *ln1, *ln2, *w_ada, *b_ada, *w_in, *w_out, *sinks, *w_up, *conv_w, *conv_b, *w_down, *normf, *w_ada_f, *b_ada_f;
    float* out; unsigned char* ws;
};

__device__ __forceinline__ void transpose_item(const float* W, int K, int N, bf16* WT, int dst_row0, int k0, int n0, LAS float* scr, int lane) {
    { f32x4 t[8];
#pragma unroll
      for (int i = 0; i < 8; ++i) t[i] = *(const f32x4*)(W + (size_t)(k0 + 8 * i + (lane >> 3)) * N + n0 + 4 * (lane & 7));
#pragma unroll
      for (int i = 0; i < 8; ++i) { LAS float* d = scr + (8 * i + (lane >> 3)) * 33 + 4 * (lane & 7); d[0] = t[i].x; d[1] = t[i].y; d[2] = t[i].z; d[3] = t[i].w; } }
    LDS_WAIT(); asm volatile("" ::: "memory");
    const int c = lane & 7;
#pragma unroll
    for (int j = 0; j < 4; ++j) { const int n = (lane >> 3) + 8 * j; const LAS float* s = scr + (8 * c) * 33 + n;
        u32x4 o; o.x = pk2(s[0 * 33], s[1 * 33]); o.y = pk2(s[2 * 33], s[3 * 33]); o.z = pk2(s[4 * 33], s[5 * 33]); o.w = pk2(s[6 * 33], s[7 * 33]);
        *(u32x4*)(WT + (size_t)(dst_row0 + n) * K + k0 + 8 * c) = o; }
    LDS_WAIT(); asm volatile("" ::: "memory");
}
constexpr int MOD_KS = 8, MOD_KC = 1024 / MOD_KS / 32;
__device__ __forceinline__ void mod_item(const Params& P, int it, LAS float* scr, int lane) {
    const int ct = it / MOD_KS, ks = it % MOD_KS, c0 = ct * 64;
    const float* W; const float* bias; int ldw;
    if (c0 < 6144) { W = P.w_ada + c0; bias = P.b_ada + c0; ldw = 6144; } else { W = P.w_ada_f + (c0 - 6144); bias = P.b_ada_f + (c0 - 6144); ldw = 2048; }
    float acc[64];
#pragma unroll
    for (int r = 0; r < 64; ++r) acc[r] = 0.f;
    const float* crow = (lane < 32 ? P.c_p + (size_t)lane * DM : P.c_s + (size_t)(lane - 32) * DM) + ks * (1024 / MOD_KS);
    const float* wk0 = W + (size_t)(ks * (1024 / MOD_KS)) * ldw + lane;
    f32x4 cv[8], cn[8];
#pragma unroll
    for (int q = 0; q < 8; ++q) cv[q] = *(const f32x4*)(crow + 4 * q);
    constexpr int NK4 = (1024 / MOD_KS) / 4;
    float w0 = wk0[0], w1 = wk0[(size_t)ldw], w2 = wk0[(size_t)2 * ldw], w3 = wk0[(size_t)3 * ldw];
    for (int kc = 0; kc < MOD_KC; ++kc) {
#pragma unroll
        for (int q = 0; q < 8; ++q) { f32x4 v = cv[q]; v.x = silu_f(v.x); v.y = silu_f(v.y); v.z = silu_f(v.z); v.w = silu_f(v.w); *(LAS f32x4*)(scr + lane * 36 + 4 * q) = v; }
        LDS_WAIT(); asm volatile("" ::: "memory");
        { const int kn = kc + 1 < MOD_KC ? kc + 1 : kc;
#pragma unroll
          for (int q = 0; q < 8; ++q) cn[q] = *(const f32x4*)(crow + kn * 32 + 4 * q); }
        for (int k4 = 0; k4 < 8; ++k4) {
            const int gk = kc * 8 + k4, gn = gk + 1 < NK4 ? gk + 1 : gk;
            const float* wn = wk0 + (size_t)(4 * gn) * ldw;
            const float n0 = wn[0], n1 = wn[(size_t)ldw], n2 = wn[(size_t)2 * ldw], n3 = wn[(size_t)3 * ldw];
#pragma unroll
            for (int r = 0; r < 64; ++r) { const f32x4 sv = *(const LAS f32x4*)(scr + r * 36 + 4 * k4);
                acc[r] = fmaf(sv.x, w0, acc[r]); acc[r] = fmaf(sv.y, w1, acc[r]); acc[r] = fmaf(sv.z, w2, acc[r]); acc[r] = fmaf(sv.w, w3, acc[r]); }
            w0 = n0; w1 = n1; w2 = n2; w3 = n3;
        }
        LDS_WAIT(); asm volatile("" ::: "memory");
#pragma unroll
        for (int q = 0; q < 8; ++q) cv[q] = cn[q];
    }
    float* dst = (float*)(P.ws + WS_MODP) + (size_t)ks * 64 * 8192 + c0 + lane;
    const float bv = (ks == 0) ? bias[lane] : 0.f;
#pragma unroll
    for (int r = 0; r < 64; ++r) dst[(size_t)r * 8192] = acc[r] + bv;
}
__device__ __forceinline__ void phase0(const Params& P, LAS unsigned char* lds, int wave, int lane) {
    LAS float* scr = (LAS float*)(lds + wave * 16384);
    const int gw = wave * gridDim.x + blockIdx.x, NGW = gridDim.x * 8;
    constexpr int I_MOD = 128 * MOD_KS, I_IN = 16 * 88, I_UP = 16 * 176, I_OUT = 16 * 32, I_DN = 44 * 32;
    constexpr int NIT = I_MOD + I_IN + I_UP + I_OUT + I_DN;
    for (int it = gw; it < NIT; it += NGW) {
        int r = it;
        if (r < I_MOD) { mod_item(P, r, scr, lane); continue; } r -= I_MOD;
        if (r < I_IN) { const int kb = r / 88, nb = r % 88; transpose_item(P.w_in, DM, INW, (bf16*)(P.ws + WS_WIN), nb * 32, kb * 64, nb * 32, scr, lane); continue; } r -= I_IN;
        if (r < I_UP) { const int kb = r / 176, nb = r % 176, n0 = nb * 32, isb = n0 >= DFF, j0 = n0 - isb * DFF;
            transpose_item(P.w_up, DM, 2 * DFF, (bf16*)(P.ws + WS_WUP), 256 * (j0 >> 7) + 128 * isb + (j0 & 127), kb * 64, n0, scr, lane); continue; } r -= I_UP;
        if (r < I_OUT) { const int kb = r / 32, nb = r % 32; transpose_item(P.w_out, DM, DM, (bf16*)(P.ws + WS_WOUT), nb * 32, kb * 64, nb * 32, scr, lane); continue; } r -= I_OUT;
        { const int kb = r / 32, nb = r % 32; transpose_item(P.w_down, DFF, DM, (bf16*)(P.ws + WS_WDN), nb * 32, kb * 64, nb * 32, scr, lane); }
    }
}

__device__ __forceinline__ void phase1(const Params& P, LAS unsigned char* lds, int tid, int wave, int lane) {
    const float* modp = (const float*)(P.ws + WS_MODP);
    float* mod = (float*)(P.ws + WS_MOD);
    bf16* H1 = (bf16*)(P.ws + WS_R0);
    for (int idx = blockIdx.x * 512 + tid; idx < 64 * 8192; idx += gridDim.x * 512) {
        float s = 0.f;
#pragma unroll
        for (int p_ = 0; p_ < MOD_KS; ++p_) s += modp[idx + (size_t)p_ * 524288];
        mod[idx] = s;
        const int col = idx & 8191, bs = idx >> 13;
        if (col >= 3072 && col < 4096) H1[(size_t)(MT + bs) * DM + (col - 3072)] = (bf16)(pk2(s, 0.f) & 0xffffu);
    }
    LAS float* lv = (LAS float*)lds;
    if (gridDim.x == 256) {
        const int b = blockIdx.x, bsP = b >> 3, bsS = 32 + (b >> 3);
        __syncthreads();
        for (int i = tid; i < 4096; i += 512) { const int sl = i >> 11, which = (i >> 10) & 1, col = i & 1023; const size_t o = (size_t)(sl ? bsS : bsP) * 8192 + which * 1024 + col;
            float sv = 0.f;
#pragma unroll
            for (int p_ = 0; p_ < MOD_KS; ++p_) sv += modp[o + (size_t)p_ * 524288];
            if (which) sv = P.ln1[col] * (1.f + sv);
            lv[i] = sv; }
        __syncthreads();
#pragma unroll 4
        for (int r = wave; r < 264; r += 8) {
            const bool smp = r >= 256;
            const int row = smp ? MP + 8 * b + (r - 256) : 256 * b + r;
            const LAS float* lvs = lv + (smp ? 2048 : 0);
            const float* xr = (smp ? P.x_s + (size_t)(row - MP) * DM : P.x_p + (size_t)row * DM) + 4 * lane;
            f32x4 v[4]; float ss = 0.f;
#pragma unroll
            for (int j = 0; j < 4; ++j) { v[j] = __builtin_nontemporal_load((const f32x4*)(xr + 256 * j));     ss += (v[j].x * v[j].x + v[j].y * v[j].y) + (v[j].z * v[j].z + v[j].w * v[j].w); }
            const float rstd = __builtin_amdgcn_rsqf(wave_sum_dpp(ss) * (1.f / DM) + EPS);
            bf16* hr = H1 + (size_t)row * DM + 4 * lane;
#pragma unroll
            for (int j = 0; j < 4; ++j) { const f32x4 sh = *(const LAS f32x4*)(lvs + 256 * j + 4 * lane), gs = *(const LAS f32x4*)(lvs + 1024 + 256 * j + 4 * lane);
                const f32x4 h = v[j] * rstd * gs + sh; u32x2 w; w.x = pk2(h.x, h.y); w.y = pk2(h.z, h.w); *(u32x2*)(hr + 256 * j) = w; }
        }
        return;
    }
    const int rpb = (MT + (int)gridDim.x - 1) / (int)gridDim.x, rbeg = (int)blockIdx.x * rpb, rend = (rbeg + rpb < MT) ? rbeg + rpb : MT;
    if (rbeg < rend) {
        const int bs0 = rbeg < MP ? (rbeg >> 11) : 32 + ((rbeg - MP) >> 6), bs1 = (rend - 1) < MP ? ((rend - 1) >> 11) : 32 + ((rend - 1 - MP) >> 6);
        const int nsl = bs1 - bs0 + 1;
        __syncthreads();
        for (int i = tid; i < nsl * 2048; i += 512) { const int sl = i >> 11, which = (i >> 10) & 1, col = i & 1023; const size_t o = (size_t)(bs0 + sl) * 8192 + which * 1024 + col;
            float sv = 0.f;
#pragma unroll
            for (int p_ = 0; p_ < MOD_KS; ++p_) sv += modp[o + (size_t)p_ * 524288];
            if (which) sv = P.ln1[col] * (1.f + sv);
            lv[i] = sv; }
        __syncthreads();
#pragma unroll 4
        for (int row = rbeg + wave; row < rend; row += 8) {
            const int bs = row < MP ? (row >> 11) : 32 + ((row - MP) >> 6);
            const LAS float* lvs = lv + (bs - bs0) * 2048;
            const float* xr = (row < MP ? P.x_p + (size_t)row * DM : P.x_s + (size_t)(row - MP) * DM) + 4 * lane;
            f32x4 v[4]; float ss = 0.f;
#pragma unroll
            for (int j = 0; j < 4; ++j) { v[j] = *(const f32x4*)(xr + 256 * j); ss += (v[j].x * v[j].x + v[j].y * v[j].y) + (v[j].z * v[j].z + v[j].w * v[j].w); }
            const float rstd = __builtin_amdgcn_rsqf(wave_sum_dpp(ss) * (1.f / DM) + EPS);
            bf16* hr = H1 + (size_t)row * DM + 4 * lane;
#pragma unroll
            for (int j = 0; j < 4; ++j) { const f32x4 sh = *(const LAS f32x4*)(lvs + 256 * j + 4 * lane), gs = *(const LAS f32x4*)(lvs + 1024 + 256 * j + 4 * lane);
                const f32x4 h = v[j] * rstd * gs + sh; u32x2 w; w.x = pk2(h.x, h.y); w.y = pk2(h.z, h.w); *(u32x2*)(hr + 256 * j) = w; }
        }
    }
}

struct OrderX {
    pg8::StaticOrder S; int nX, xpm, xpn0;
    __device__ __forceinline__ bool next(int i, pg8::Unit& u) const {
        const long L = (long)i * S.G + S.c;
        int pm = 0, pn = 0; bool ok = false;
        if (L < S.nwg) { pg8::Unit t; t.pm = 0; t.pn = 0; t.seq = 0; t.kt0 = 0; t.nt = 0; (void)S.next(i, t); pm = t.pm; pn = t.pn; ok = true; }
        else if (L < S.nwg + nX) { pm = xpm; pn = xpn0 + (int)(L - S.nwg); ok = true; }
        u.pm = pm; u.pn = pn; u.seq = i; u.kt0 = 0; u.nt = 0;
        return ok;
    }
    __device__ __forceinline__ void a_ready(const pg8::Unit&) const {}
    __device__ __forceinline__ void done(const pg8::Unit&) const {}
};
struct OrderPub : pg8::StaticOrder {
    unsigned* cnt;
    __device__ __forceinline__ void done(const pg8::Unit& u) const {
        asm volatile("s_waitcnt vmcnt(0)" ::: "memory");
        if ((threadIdx.x & 63) == 0) __hip_atomic_fetch_add(cnt + 64 * u.pm, 1u, __ATOMIC_RELAXED, __HIP_MEMORY_SCOPE_AGENT);
    }
};
struct OrderDown {
    pg8::StaticOrder S;
    int ka, kb;
    __device__ __forceinline__ bool next(int i, pg8::Unit& u) const {
        const long L = (long)i * S.G + S.c;
        int pm = 0, pn = 0, kt0 = 0, nt = 0; bool ok = false;
        if (L < S.nwg) { pg8::Unit t; t.pm = 0; t.pn = 0; t.seq = 0; t.kt0 = 0; t.nt = 0; (void)S.next(i, t); pm = t.pm; pn = t.pn; ok = true; }
        else if (L < S.nwg + 128) { const int q = (int)(L - S.nwg), tu = q >> 2, part = q & 3; pm = (MP / 256) + (tu & 7); pn = tu >> 3; kt0 = part < 2 ? ka * part : 2 * ka + kb * (part - 2); nt = part < 2 ? ka : kb; ok = true; }
        u.pm = pm; u.pn = pn; u.seq = i; u.kt0 = kt0; u.nt = nt;
        return ok;
    }
    __device__ __forceinline__ void a_ready(const pg8::Unit&) const {}
    __device__ __forceinline__ void done(const pg8::Unit&) const {}
};
typedef const f32x4 (&AccRef)[2][2][4][2];
struct Epi1 {
    static constexpr bool PERM = true, AFTER_DRAIN = false;
    bf16* proj; float* shw; float* out;
    __device__ __forceinline__ void operator()(AccRef acc, const pg8::Unit& u, int wr, int wc, int fr, int fq) const {
        if (u.pm == NTM) {
            if (wr == 0) {
#pragma unroll
                for (int m = 0; m < 4; ++m) { float* d = shw + (size_t)(16 * m + fr) * (2 * DFF) + 256 * (u.pn - 11) + 32 * wc + 8 * fq;
#pragma unroll
                    for (int bj = 0; bj < 2; ++bj)
#pragma unroll
                        for (int n = 0; n < 2; ++n) *(f32x4*)(d + 128 * bj + 4 * n) = acc[0][bj][m][n]; }
            }
            return;
        }
        const unsigned row0 = u.pm * 256 + wr * 64 + fr, col0 = u.pn * 256 + wc * 32 + 8 * fq;
#pragma unroll
        for (int ai = 0; ai < 2; ++ai)
#pragma unroll
            for (int m = 0; m < 4; ++m) { const unsigned o = (row0 + 128 * ai + 16 * m) * (unsigned)INW + col0;
#pragma unroll
                for (int bj = 0; bj < 2; ++bj) { const f32x4 v0 = acc[ai][bj][m][0], v1 = acc[ai][bj][m][1];
                    u32x4 w; w.x = pk2(v0[0], v0[1]); w.y = pk2(v0[2], v0[3]); w.z = pk2(v1[0], v1[1]); w.w = pk2(v1[2], v1[3]);
                    *(u32x4*)(proj + (o + 128 * bj)) = w; }
                asm volatile("" ::: "memory"); }
        if (u.pn == 10) {
            const unsigned c = 32 * wc + 8 * fq;
#pragma unroll
            for (int ai = 0; ai < 2; ++ai)
#pragma unroll
                for (int m = 0; m < 4; ++m) { const unsigned row = row0 + 128 * ai + 16 * m; unsigned ok, ov;
                    if (row < (unsigned)MP) { const unsigned t = row & 2047; if (t < SEQ - 128) continue; const unsigned o = ((row >> 11) * 128 + (t - (SEQ - 128))) * 128 + c; ok = (unsigned)OFF_PK + o; ov = (unsigned)OFF_PV + o; }
                    else { const unsigned o = (row - MP) * 128 + c; ok = (unsigned)OFF_SK + o; ov = (unsigned)OFF_SV + o; }
                    *(f32x4*)(out + ok) = acc[ai][0][m][0]; *(f32x4*)(out + ok + 4) = acc[ai][0][m][1];
                    *(f32x4*)(out + ov) = acc[ai][1][m][0]; *(f32x4*)(out + ov + 4) = acc[ai][1][m][1];
                    asm volatile("" ::: "memory"); }
        }
    }
};
struct Epi2 {
    static constexpr bool PERM = true, AFTER_DRAIN = false;
    const float *xp, *xs, *mod, *ln2; bf16* x1; bf16* a2; float* ss; float* slab;
    __device__ __forceinline__ void operator()(AccRef acc, const pg8::Unit& u, int wr, int wc, int fr, int fq) const {
        const int col0 = u.pn * 256 + wc * 32 + 8 * fq;
        if (u.nt != 0) {
            float* sb = slab + (size_t)(u.kt0 >> 2) * MS * DM;
#pragma unroll
            for (int ai = 0; ai < 2; ++ai)
#pragma unroll
                for (int m = 0; m < 4; ++m) { const unsigned ro = (unsigned)(u.pm * 256 - MP + 128 * ai + 64 * wr + 16 * m + fr) * DM + col0;
#pragma unroll
                    for (int bj = 0; bj < 2; ++bj) { *(f32x4*)(sb + ro + 128 * bj) = acc[ai][bj][m][0]; *(f32x4*)(sb + ro + 128 * bj + 4) = acc[ai][bj][m][1]; } }
            return;
        }
#pragma unroll
        for (int ai = 0; ai < 2; ++ai) {
            const int bs = grp_bs(4 * u.pm + 2 * ai + wr);
            const float* mb = mod + (size_t)bs * 8192;
            f32x4 g1v[2][2], gsv[2][2];
#pragma unroll
            for (int bj = 0; bj < 2; ++bj)
#pragma unroll
                for (int n = 0; n < 2; ++n) { const int c = col0 + 128 * bj + 4 * n; g1v[bj][n] = *(const f32x4*)(mb + 2048 + c);
                    gsv[bj][n] = *(const f32x4*)(ln2 + c) * (*(const f32x4*)(mb + 4096 + c) + 1.0f); }
#pragma unroll
            for (int m = 0; m < 4; ++m) {
                const int row = u.pm * 256 + 128 * ai + 64 * wr + 16 * m + fr;
                const float* xr = row < MP ? xp + (size_t)row * DM : xs + (size_t)(row - MP) * DM;
                float s = 0.f;
#pragma unroll
                for (int bj = 0; bj < 2; ++bj) { f32x4 a[2]; f32x4 xb[2];
#pragma unroll
                    for (int n = 0; n < 2; ++n) { const int c = col0 + 128 * bj + 4 * n; const f32x4 xv = *(const f32x4*)(xr + c); const f32x4 v = xv + g1v[bj][n] * acc[ai][bj][m][n];
                        xb[n] = v; s += (v.x * v.x + v.y * v.y) + (v.z * v.z + v.w * v.w); a[n] = v * gsv[bj][n]; }
                    u32x4 w; w.x = pk2(a[0].x, a[0].y); w.y = pk2(a[0].z, a[0].w); w.z = pk2(a[1].x, a[1].y); w.w = pk2(a[1].z, a[1].w);
                    *(u32x4*)(a2 + (size_t)row * DM + col0 + 128 * bj) = w;
                    w.x = pk2(xb[0].x, xb[0].y); w.y = pk2(xb[0].z, xb[0].w); w.z = pk2(xb[1].x, xb[1].y); w.w = pk2(xb[1].z, xb[1].w);
                    *(u32x4*)(x1 + (size_t)row * DM + col0 + 128 * bj) = w; }
                s += __shfl_xor(s, 16); s += __shfl_xor(s, 32);
                if (fq == 0) ss[(size_t)row * 16 + 4 * u.pn + wc] = s;
            }
        }
    }
};
struct Epi3 {
    static constexpr bool PERM = true, AFTER_DRAIN = false;
    const LAS float* rtab; const float* shw; bf16 *ua, *ub; float* out;
    __device__ __forceinline__ void operator()(AccRef acc, const pg8::Unit& u, int wr, int wc, int fr, int fq) const {
        const unsigned j0 = u.pn * 128 + wc * 32 + 8 * fq, pc0 = u.pn * 256 + wc * 32 + 8 * fq;
#pragma unroll
        for (int ai = 0; ai < 2; ++ai) {
            const unsigned grp = 4 * u.pm + 2 * ai + wr, bs = grp_bs((int)grp);
            const unsigned so = bs * (2 * DFF) + pc0;
            const f32x4 sa0 = *(const f32x4*)(shw + so), sa1 = *(const f32x4*)(shw + so + 4), sb0 = *(const f32x4*)(shw + so + 128), sb1 = *(const f32x4*)(shw + so + 132);
#pragma unroll
            for (int m = 0; m < 4; ++m) {
                const float rstd = rtab[u.seq * 256 + 128 * ai + 64 * wr + 16 * m + fr];
                const unsigned row = grp * 64 + 16 * m + fr;
                const f32x4 a0 = acc[ai][0][m][0] * rstd + sa0, a1 = acc[ai][0][m][1] * rstd + sa1, b0 = acc[ai][1][m][0] * rstd + sb0, b1 = acc[ai][1][m][1] * rstd + sb1;
                u32x4 w; w.x = pk2(a0[0], a0[1]); w.y = pk2(a0[2], a0[3]); w.z = pk2(a1[0], a1[1]); w.w = pk2(a1[2], a1[3]);
                *(u32x4*)(ua + (row * (unsigned)DFF + j0)) = w;
                w.x = pk2(b0[0], b0[1]); w.y = pk2(b0[2], b0[3]); w.z = pk2(b1[0], b1[1]); w.w = pk2(b1[2], b1[3]);
                *(u32x4*)(ub + (row * (unsigned)DFF + j0)) = w;
                if (m == 3 && fr >= 14) {
                    if (grp >= 1024) { float* d = out + OFF_SCONV + ((size_t)(grp - 1024) * 2 + (fr - 14)) * DFF + j0; *(f32x4*)d = a0; *(f32x4*)(d + 4) = a1; }
                    else if ((grp & 31) == 31) { float* d = out + OFF_PCONV + ((size_t)(grp >> 5) * 2 + (fr - 14)) * DFF + j0; *(f32x4*)d = a0; *(f32x4*)(d + 4) = a1; }
                }
            }
        }
    }
};
#ifdef CONV_FUSED
struct Epi3C {
    static constexpr bool PERM = true, AFTER_DRAIN = false;
    const LAS float* rtab; const float *shw, *cw, *cb; bf16* act; float *headA, *headB, *tailA;
    __device__ __forceinline__ void operator()(AccRef acc, const pg8::Unit& u, int wr, int wc, int fr, int fq) const {
        const unsigned j0 = u.pn * 128 + wc * 32 + 8 * fq, pc0 = u.pn * 256 + wc * 32 + 8 * fq;
        f32x4 w0[2], w1[2], w2[2], cbv[2];
#pragma unroll
        for (int n = 0; n < 2; ++n) { w0[n] = *(const f32x4*)(cw + j0 + 4 * n); w1[n] = *(const f32x4*)(cw + DFF + j0 + 4 * n); w2[n] = *(const f32x4*)(cw + 2 * DFF + j0 + 4 * n); cbv[n] = *(const f32x4*)(cb + j0 + 4 * n); }
        u32x2 ap[2][4][2], bp[2][4][2];
        f32x4 sa[2], sb[2];
        const unsigned bs0 = grp_bs((int)(4 * u.pm + wr));
        { const unsigned so = bs0 * (2 * DFF) + pc0;
#pragma unroll
          for (int n = 0; n < 2; ++n) { sa[n] = *(const f32x4*)(shw + so + 4 * n); sb[n] = *(const f32x4*)(shw + so + 128 + 4 * n); } }
#pragma unroll
        for (int ai = 0; ai < 2; ++ai) {
            const unsigned grp = 4 * u.pm + 2 * ai + wr, bs = grp_bs((int)grp);
            const unsigned ho = (grp * 2 + (fr & 1)) * DFF + j0;
            if (ai == 1 && bs != bs0) { const unsigned so = bs * (2 * DFF) + pc0;
#pragma unroll
                for (int n = 0; n < 2; ++n) { sa[n] = *(const f32x4*)(shw + so + 4 * n); sb[n] = *(const f32x4*)(shw + so + 128 + 4 * n); } }
#pragma unroll
            for (int m = 0; m < 4; ++m) {
                const float rs = rtab[u.seq * 256 + 128 * ai + 64 * wr + 16 * m + fr];
#pragma unroll
                for (int n = 0; n < 2; ++n) {
                    const f32x4 av = acc[ai][0][m][n] * rs + sa[n], bv = acc[ai][1][m][n] * rs + sb[n];
                    if (m == 0) { if (fr < 2) { *(f32x4*)(headA + ho + 4 * n) = av; *(f32x4*)(headB + ho + 4 * n) = bv; } }
                    if (m == 3) { if (fr >= 14) *(f32x4*)(tailA + ho + 4 * n) = av; }
                    ap[ai][m][n].x = pk2(av.x, av.y); ap[ai][m][n].y = pk2(av.z, av.w); bp[ai][m][n].x = pk2(bv.x, bv.y); bp[ai][m][n].y = pk2(bv.z, bv.w);
                }
            }
        }
        asm volatile("" ::: "memory");
#pragma unroll
        for (int ai = 0; ai < 2; ++ai) {
            const unsigned grp = 4 * u.pm + 2 * ai + wr;
#pragma unroll
            for (int n = 0; n < 2; ++n)
#pragma unroll
                for (int h = 0; h < 2; ++h) {
                    unsigned q1 = 0u, q2 = 0u;
#pragma unroll
                    for (int m = 0; m < 4; ++m) {
                        const unsigned a = ap[ai][m][n][h];
                        const unsigned s1 = (unsigned)__builtin_amdgcn_update_dpp((int)a, (int)a, 0x121, 0xf, 0xf, false);
                        const unsigned s2 = (unsigned)__builtin_amdgcn_update_dpp((int)a, (int)a, 0x122, 0xf, 0xf, false);
                        const unsigned pr1 = fr >= 1 ? s1 : q1, pr2 = fr >= 2 ? s2 : q2;
                        q1 = s1; q2 = s2;
                        const float c0 = cbv[n][2 * h] + w0[n][2 * h] * bflo(pr2) + w1[n][2 * h] * bflo(pr1) + w2[n][2 * h] * bflo(a);
                        const float c1 = cbv[n][2 * h + 1] + w0[n][2 * h + 1] * bfhi(pr2) + w1[n][2 * h + 1] * bfhi(pr1) + w2[n][2 * h + 1] * bfhi(a);
                        const unsigned bw = bp[ai][m][n][h];
                        bp[ai][m][n][h] = pk2(silu_f(c0) * bflo(bw), silu_f(c1) * bfhi(bw));
                    }
                    __builtin_amdgcn_sched_barrier(0);
                }
            asm volatile("" ::: "memory");
#pragma unroll
            for (int m = 0; m < 4; ++m) {
                if (m == 0 && fr < 2) continue;
                const unsigned row = grp * 64 + 16 * m + fr;
                const u32x4 w = (u32x4){bp[ai][m][0].x, bp[ai][m][0].y, bp[ai][m][1].x, bp[ai][m][1].y};
                *(u32x4*)(act + (row * (unsigned)DFF + j0)) = w;
            }
        }
    }
};
#endif
struct Epi4 {
    static constexpr bool PERM = true, AFTER_DRAIN = false;
    const float* mod; const bf16* x1; bf16* x2; float* slab;
    __device__ __forceinline__ void operator()(AccRef acc, const pg8::Unit& u, int wr, int wc, int fr, int fq) const {
        const int col0 = u.pn * 256 + wc * 32 + 8 * fq;
        if (u.nt != 0) {
            const int part = u.kt0 == 0 ? 0 : (u.kt0 == 12 ? 1 : (u.kt0 == 24 ? 2 : 3));
            float* sb = slab + (size_t)part * MS * DM;
#pragma unroll
            for (int ai = 0; ai < 2; ++ai)
#pragma unroll
                for (int m = 0; m < 4; ++m) { const unsigned ro = (unsigned)(u.pm * 256 - MP + 128 * ai + 64 * wr + 16 * m + fr) * DM + col0;
#pragma unroll
                    for (int bj = 0; bj < 2; ++bj) { *(f32x4*)(sb + ro + 128 * bj) = acc[ai][bj][m][0]; *(f32x4*)(sb + ro + 128 * bj + 4) = acc[ai][bj][m][1]; } }
            return;
        }
#pragma unroll
        for (int ai = 0; ai < 2; ++ai) {
            const int bs = grp_bs(4 * u.pm + 2 * ai + wr);
            const float* mb = mod + (size_t)bs * 8192 + 5120;
            f32x4 g2v[2][2];
#pragma unroll
            for (int bj = 0; bj < 2; ++bj)
#pragma unroll
                for (int n = 0; n < 2; ++n) g2v[bj][n] = *(const f32x4*)(mb + col0 + 128 * bj + 4 * n);
#pragma unroll
            for (int m = 0; m < 4; ++m) {
                const unsigned ro = (unsigned)(u.pm * 256 + 128 * ai + 64 * wr + 16 * m + fr) * DM + col0;
#pragma unroll
                for (int bj = 0; bj < 2; ++bj) { const u32x4 xw = *(const u32x4*)(x1 + ro + 128 * bj);
                    const f32x4 v0 = (f32x4){bflo(xw.x), bfhi(xw.x), bflo(xw.y), bfhi(xw.y)} + g2v[bj][0] * acc[ai][bj][m][0];
                    const f32x4 v1 = (f32x4){bflo(xw.z), bfhi(xw.z), bflo(xw.w), bfhi(xw.w)} + g2v[bj][1] * acc[ai][bj][m][1];
                    u32x4 w; w.x = pk2(v0.x, v0.y); w.y = pk2(v0.z, v0.w); w.z = pk2(v1.x, v1.y); w.w = pk2(v1.z, v1.w);
                    *(u32x4*)(x2 + ro + 128 * bj) = w; }
            }
        }
    }
};
#define GAS __attribute__((address_space(1)))
#define RLX_AGENT __ATOMIC_RELAXED, __HIP_MEMORY_SCOPE_AGENT
#define XB_TMO      128
#define XB_XCNT(j)  (256  + 64 * (j))
#define XB_XSUB(j)  (1280 + 64 * (j))
#define XB_XGEN(j)  (2304 + 64 * (j))
#define XB_TOP      3328
#define XB_TOPGEN   3392
#define XCD_BAR_WORDS 3456
#define XB_SPIN_CAP (1u << 18)

__device__ __forceinline__ unsigned xb_ld(unsigned* p)              { return __hip_atomic_load(p, __ATOMIC_RELAXED, __HIP_MEMORY_SCOPE_AGENT); }
__device__ __forceinline__ unsigned xb_add(unsigned* p, unsigned v) { return __hip_atomic_fetch_add(p, v, __ATOMIC_RELAXED, __HIP_MEMORY_SCOPE_AGENT); }
__device__ __forceinline__ unsigned xb_xcc_id() { return (unsigned)__builtin_amdgcn_s_getreg((3 << 11) | 20) & 0xFu; }
#define XB_SPIN(cond, bar) do { unsigned _sp = 0; while (cond) { __builtin_amdgcn_s_sleep(1); \
    if ((++_sp & 255u) == 0u) { if (xb_ld(&(bar)[XB_TMO])) break; if (_sp > XB_SPIN_CAP) { atomicAdd(&(bar)[XB_TMO], 1u); break; } } } } while (0)

struct XcdBarrier {
    unsigned* bar; unsigned x;
    volatile LAS unsigned* st;
};

__device__ __forceinline__ XcdBarrier xcd_barrier_post(unsigned* bar, volatile LAS unsigned* st) {
    XcdBarrier b; b.bar = bar; b.x = xb_xcc_id(); b.st = st;
    if (threadIdx.x == 0) (void)xb_add(&bar[XB_XCNT(b.x)], 1u);
    return b;
}
__device__ __forceinline__ void xcd_barrier_complete(unsigned* bar, unsigned x, unsigned& nloc, unsigned& nx) {
    const unsigned G = gridDim.x * gridDim.y * gridDim.z;
    unsigned sum, cnt, mine, sp = 0u;
    for (;;) {
        sum = 0u; cnt = 0u; mine = 0u;
#pragma unroll
        for (unsigned j = 0; j < 16; ++j) { const unsigned c = xb_ld(&bar[XB_XCNT(j)]); sum += c; cnt += (c > 0u) ? 1u : 0u; mine = (j == x) ? c : mine; }
        if (sum == G) break;
        __builtin_amdgcn_s_sleep(1);
        if ((++sp & 255u) == 0u) { if (xb_ld(&bar[XB_TMO])) break; if (sp > XB_SPIN_CAP) { atomicAdd(&bar[XB_TMO], 1u); break; } }
    }
    nloc = mine > 0u ? mine : 1u; nx = cnt > 0u ? cnt : 1u;
}

__device__ __forceinline__ void xcd_barrier(const XcdBarrier& b) {
    asm volatile("s_waitcnt vmcnt(0)" ::: "memory");
    __syncthreads();
    if (threadIdx.x == 0) {
        unsigned* bar = b.bar;
        __builtin_amdgcn_s_waitcnt(0);
        unsigned nloc = b.st[0], nx = b.st[1];
        if (nloc == 0u) { xcd_barrier_complete(bar, b.x, nloc, nx); b.st[0] = nloc; b.st[1] = nx; }
        const unsigned old = xb_add(&bar[XB_XSUB(b.x)], 1u);
        const unsigned gen = old / nloc;
        if (old + 1u == (gen + 1u) * nloc) {
            __builtin_amdgcn_fence(__ATOMIC_RELEASE, "agent");
            asm volatile("s_waitcnt vmcnt(0)" ::: "memory");
            const unsigned og = xb_add(&bar[XB_TOP], 1u);
            const unsigned tg = og / nx;
            if (og + 1u == (tg + 1u) * nx) xb_add(&bar[XB_TOPGEN], 1u);
            else XB_SPIN(xb_ld(&bar[XB_TOPGEN]) == tg, bar);
            __builtin_amdgcn_fence(__ATOMIC_ACQUIRE, "agent");
            xb_add(&bar[XB_XGEN(b.x)], 1u);
            asm volatile("s_waitcnt vmcnt(0)" ::: "memory");
        } else {
            XB_SPIN(xb_ld(&bar[XB_XGEN(b.x)]) == gen, bar);
            __builtin_amdgcn_fence(__ATOMIC_ACQUIRE, "agent");
            asm volatile("s_waitcnt vmcnt(0)" ::: "memory");
        }
    }
    __syncthreads();
}
#define MFMA16(a, b, c) __builtin_amdgcn_mfma_f32_16x16x32_bf16((a), (b), (c), 0, 0, 0)
constexpr int RQ = 0, RK = 17408, RKT = 34816, RVT = 53248, RP = 71680, RST = 80896, RO = 115712;
__device__ __forceinline__ void ret_item(const Params& P, LAS unsigned char* lds, int tid, int wave, int lane, int h, int row0, int nchunks, const float* st_in, bool has_in, float* st_out) {
    const bf16* proj = (const bf16*)(P.ws + WS_R1);
    bf16* mix = (bf16*)(P.ws + WS_R2);
    const int fr = lane & 15, fq = lane >> 4;
    const float lg2 = log2f(1.0f - exp2f(-5.0f - (float)h));
    const float kscale = 0.08838834764831845f;
    LAS bf16* Qs = (LAS bf16*)(lds + RQ); LAS bf16* Ks = (LAS bf16*)(lds + RK); LAS bf16* KT = (LAS bf16*)(lds + RKT); LAS bf16* VT = (LAS bf16*)(lds + RVT);
    LAS bf16* Ps = (LAS bf16*)(lds + RP); LAS bf16* ST = (LAS bf16*)(lds + RST); LAS float* Os = (LAS float*)(lds + RO);
    f32x4 st[8];
#pragma unroll
    for (int et = 0; et < 8; ++et) {
        f32x4 v;
#pragma unroll
        for (int r = 0; r < 4; ++r) v[r] = st_in[(size_t)(16 * wave + 4 * fq + r) * 128 + 16 * et + fr];
        asm volatile("" : "+v"(v));
#pragma unroll
        for (int r = 0; r < 4; ++r) v[r] = has_in ? v[r] : 0.f;
        st[et] = v;
    }
    __syncthreads();
#pragma unroll
    for (int et = 0; et < 8; ++et) { u32x2 w; w.x = pk2(st[et][0], st[et][1]); w.y = pk2(st[et][2], st[et][3]); *(LAS u32x2*)(ST + (16 * et + fr) * 136 + 16 * wave + 4 * fq) = w; }
    const size_t goff = (size_t)lane * INW + h * 128 + wave * 16;
    u32x4 pq[2], pk[2], pv[2];
    { const bf16* g = proj + (size_t)row0 * INW + goff;
      pq[0] = *(const u32x4*)(g); pq[1] = *(const u32x4*)(g + 8); pk[0] = *(const u32x4*)(g + 512); pk[1] = *(const u32x4*)(g + 520); pv[0] = *(const u32x4*)(g + 1024); pv[1] = *(const u32x4*)(g + 1032); }
    u32x4 gv0, gv1, gn0, gn1;
    const size_t ggoff = (size_t)(8 * wave + (lane >> 3)) * INW + 1536 + h * 128 + 16 * (lane & 7);
    gn0 = *(const u32x4*)(proj + (size_t)row0 * INW + ggoff); gn1 = *(const u32x4*)(proj + (size_t)row0 * INW + ggoff + 8);
    const float kf = kscale * exp2f(lg2 * (float)(63 - lane));
    const float g64 = exp2f(lg2 * 64.0f);
    for (int c = 0; c < nchunks; ++c) {
        const int rowc = row0 + 64 * c;
        *(LAS u32x4*)(Qs + lane * 136 + wave * 16) = pq[0]; *(LAS u32x4*)(Qs + lane * 136 + wave * 16 + 8) = pq[1];
        *(LAS u32x4*)(Ks + lane * 136 + wave * 16) = pk[0]; *(LAS u32x4*)(Ks + lane * 136 + wave * 16 + 8) = pk[1];
#pragma unroll
        for (int i = 0; i < 2; ++i)
#pragma unroll
            for (int j = 0; j < 4; ++j) { const unsigned wk = pk[i][j], wv = pv[i][j]; const int d = wave * 16 + i * 8 + j * 2;
                const unsigned kk = pk2(bflo(wk) * kf, bfhi(wk) * kf);
                KT[(d) * 72 + lane] = (bf16)(kk & 0xffffu); KT[(d + 1) * 72 + lane] = (bf16)(kk >> 16);
                VT[(d) * 72 + lane] = (bf16)(wv & 0xffffu); VT[(d + 1) * 72 + lane] = (bf16)(wv >> 16); }
        gv0 = gn0; gv1 = gn1;
        if (c + 1 < nchunks) { const bf16* g = proj + (size_t)(rowc + 64) * INW + goff;
            pq[0] = *(const u32x4*)(g); pq[1] = *(const u32x4*)(g + 8); pk[0] = *(const u32x4*)(g + 512); pk[1] = *(const u32x4*)(g + 520); pv[0] = *(const u32x4*)(g + 1024); pv[1] = *(const u32x4*)(g + 1032);
            gn0 = *(const u32x4*)(proj + (size_t)(rowc + 64) * INW + ggoff); gn1 = *(const u32x4*)(proj + (size_t)(rowc + 64) * INW + ggoff + 8); }
        __syncthreads();
        { const int mi = wave >> 1;
#pragma unroll
          for (int jj = 0; jj < 2; ++jj) { const int lj = 2 * (wave & 1) + jj; f32x4 s = (f32x4){0.f, 0.f, 0.f, 0.f};
#pragma unroll
            for (int ks = 0; ks < 4; ++ks) { const bf16x8 a = *(const LAS bf16x8*)(Ks + (16 * mi + fr) * 136 + 32 * ks + 8 * fq), b = *(const LAS bf16x8*)(Qs + (16 * lj + fr) * 136 + 32 * ks + 8 * fq); s = MFMA16(a, b, s); }
            const int l = 16 * lj + fr; float pvv[4];
#pragma unroll
            for (int r = 0; r < 4; ++r) { const int m = 16 * mi + 4 * fq + r; const int dlt = l - m; pvv[r] = dlt >= 0 ? s[r] * kscale * exp2f(lg2 * (float)dlt) : 0.f; }
            u32x2 w; w.x = pk2(pvv[0], pvv[1]); w.y = pk2(pvv[2], pvv[3]); *(LAS u32x2*)(Ps + l * 72 + 16 * mi + 4 * fq) = w; } }
#pragma unroll
        for (int et = 0; et < 8; ++et) st[et] = st[et] * g64;
#pragma unroll
        for (int ks = 0; ks < 2; ++ks) { const bf16x8 a = *(const LAS bf16x8*)(KT + (16 * wave + fr) * 72 + 32 * ks + 8 * fq);
#pragma unroll
            for (int et = 0; et < 8; ++et) { const bf16x8 b = *(const LAS bf16x8*)(VT + (16 * et + fr) * 72 + 32 * ks + 8 * fq); st[et] = MFMA16(a, b, st[et]); } }
        __syncthreads();
        { f32x4 oi[4], oc[4];
#pragma unroll
          for (int lt = 0; lt < 4; ++lt) { oi[lt] = (f32x4){0.f, 0.f, 0.f, 0.f}; oc[lt] = (f32x4){0.f, 0.f, 0.f, 0.f}; }
#pragma unroll
          for (int ks = 0; ks < 2; ++ks) { const bf16x8 b = *(const LAS bf16x8*)(VT + (16 * wave + fr) * 72 + 32 * ks + 8 * fq);
#pragma unroll
            for (int lt = 0; lt < 4; ++lt) { const bf16x8 a = *(const LAS bf16x8*)(Ps + (16 * lt + fr) * 72 + 32 * ks + 8 * fq); oi[lt] = MFMA16(a, b, oi[lt]); } }
#pragma unroll
          for (int ks = 0; ks < 4; ++ks) { const bf16x8 b = *(const LAS bf16x8*)(ST + (16 * wave + fr) * 136 + 32 * ks + 8 * fq);
#pragma unroll
            for (int lt = 0; lt < 4; ++lt) { const bf16x8 a = *(const LAS bf16x8*)(Qs + (16 * lt + fr) * 136 + 32 * ks + 8 * fq); oc[lt] = MFMA16(a, b, oc[lt]); } }
#pragma unroll
          for (int lt = 0; lt < 4; ++lt)
#pragma unroll
            for (int r = 0; r < 4; ++r) { const int l = 16 * lt + 4 * fq + r; Os[l * 132 + 16 * wave + fr] = oi[lt][r] + exp2f(lg2 * (float)(l + 1)) * oc[lt][r]; } }
        __syncthreads();
#pragma unroll
        for (int et = 0; et < 8; ++et) { u32x2 w; w.x = pk2(st[et][0], st[et][1]); w.y = pk2(st[et][2], st[et][3]); *(LAS u32x2*)(ST + (16 * et + fr) * 136 + 16 * wave + 4 * fq) = w; }
        {
          const int l = 8 * wave + (lane >> 3), seg = lane & 7;
          const u32x4 gw0 = gv0, gw1 = gv1;
          const LAS f32x4* op = (const LAS f32x4*)(Os + l * 132 + 16 * seg);
          f32x4 ov[4]; float ssq = 0.f;
#pragma unroll
          for (int k = 0; k < 4; ++k) { ov[k] = op[k]; ssq += (ov[k].x * ov[k].x + ov[k].y * ov[k].y) + (ov[k].z * ov[k].z + ov[k].w * ov[k].w); }
          ssq += __int_as_float(__builtin_amdgcn_update_dpp(__float_as_int(ssq), __float_as_int(ssq), 0xB1, 0xf, 0xf, false));
          ssq += __int_as_float(__builtin_amdgcn_update_dpp(__float_as_int(ssq), __float_as_int(ssq), 0x4E, 0xf, 0xf, false));
          ssq += __int_as_float(__builtin_amdgcn_update_dpp(__float_as_int(ssq), __float_as_int(ssq), 0x141, 0xf, 0xf, false));
          const float rstd = __builtin_amdgcn_rsqf(ssq * (1.f / 128.f) + EPS);
          bf16* mp = mix + (size_t)(rowc + l) * DM + h * 128 + 16 * seg;
#pragma unroll
          for (int hf = 0; hf < 2; ++hf) {
              float gf[8]; unpack8(hf ? gw1 : gw0, gf);
              u32x4 w;
#pragma unroll
              for (int k = 0; k < 2; ++k) { const f32x4 o4 = ov[2 * hf + k];
                  w[2 * k] = pk2(silu_f(gf[4 * k]) * (o4.x * rstd), silu_f(gf[4 * k + 1]) * (o4.y * rstd)); w[2 * k + 1] = pk2(silu_f(gf[4 * k + 2]) * (o4.z * rstd), silu_f(gf[4 * k + 3]) * (o4.w * rstd)); }
              *(u32x4*)(mp + 8 * hf) = w;
              asm volatile("" ::: "memory");
          }
        }
    }
#pragma unroll
    for (int et = 0; et < 8; ++et)
#pragma unroll
        for (int r = 0; r < 4; ++r) st_out[(size_t)(16 * wave + 4 * fq + r) * 128 + 16 * et + fr] = st[et][r];
}
constexpr int AK = 0, AVT = 27648;
__device__ __forceinline__ void att_item(const Params& P, LAS unsigned char* lds, int tid, int wave, int lane, bool sample, int b, int n, int g) {
    const bf16* proj = (const bf16*)(P.ws + WS_R1);
    bf16* mix = (bf16*)(P.ws + WS_R2);
    const int fr = lane & 15, fq = lane >> 4;
    LAS bf16* Kl = (LAS bf16*)(lds + AK); LAS bf16* VTl = (LAS bf16*)(lds + AVT);
    const int qrow0 = sample ? MP + 64 * b : b * SEQ + 64 * n;
    const int jmin = sample ? 0 : (n >= 2 ? 0 : 64 * (2 - n));
    __syncthreads();
    bf16x8 qa[2][2];
    { const int hd_ = 4 * g + (wave >> 1), qh_ = wave & 1;
#pragma unroll
      for (int qt = 0; qt < 2; ++qt)
#pragma unroll
        for (int ks = 0; ks < 2; ++ks) qa[qt][ks] = *(const bf16x8*)(proj + (size_t)(qrow0 + 32 * qh_ + 16 * qt + fr) * INW + 2048 + hd_ * 64 + 32 * ks + 8 * fq); }
    {
        u32x4 kw[3], vw[3];
        if (!sample) {
#pragma unroll
            for (int i = 0; i < 3; ++i) { const bool ok = 64 * i >= jmin;
                const int rb = ok ? b * SEQ + 64 * (n - 2) + 64 * i : qrow0;
                kw[i] = *(const u32x4*)(proj + (size_t)(rb + (tid >> 3)) * INW + 2560 + g * 64 + 8 * (tid & 7));
                vw[i] = *(const u32x4*)(proj + (size_t)(rb + lane) * INW + 2688 + g * 64 + 8 * wave);
                if (!ok) { kw[i] = (u32x4){0u, 0u, 0u, 0u}; vw[i] = (u32x4){0u, 0u, 0u, 0u}; } }
        } else {
            f32x4 kc[2][2], vc[2][2];
#pragma unroll
            for (int i = 0; i < 2; ++i) { const float* sk = P.cache_k + ((size_t)(b * 128 + 64 * i + (tid >> 3)) * 2 + g) * 64 + 8 * (tid & 7); const float* sv = P.cache_v + ((size_t)(b * 128 + 64 * i + lane) * 2 + g) * 64 + 8 * wave;
                kc[i][0] = *(const f32x4*)sk; kc[i][1] = *(const f32x4*)(sk + 4); vc[i][0] = *(const f32x4*)sv; vc[i][1] = *(const f32x4*)(sv + 4); }
            kw[2] = *(const u32x4*)(proj + (size_t)(MP + 64 * b + (tid >> 3)) * INW + 2560 + g * 64 + 8 * (tid & 7));
            vw[2] = *(const u32x4*)(proj + (size_t)(MP + 64 * b + lane) * INW + 2688 + g * 64 + 8 * wave);
#pragma unroll
            for (int i = 0; i < 2; ++i) { kw[i].x = pk2(kc[i][0].x, kc[i][0].y); kw[i].y = pk2(kc[i][0].z, kc[i][0].w); kw[i].z = pk2(kc[i][1].x, kc[i][1].y); kw[i].w = pk2(kc[i][1].z, kc[i][1].w);
                vw[i].x = pk2(vc[i][0].x, vc[i][0].y); vw[i].y = pk2(vc[i][0].z, vc[i][0].w); vw[i].z = pk2(vc[i][1].x, vc[i][1].y); vw[i].w = pk2(vc[i][1].z, vc[i][1].w); }
        }
#pragma unroll
        for (int i = 0; i < 3; ++i) { *(LAS u32x4*)(Kl + (64 * i + (tid >> 3)) * 72 + 8 * (tid & 7)) = kw[i];
            const int j = 64 * i + lane;
#pragma unroll
            for (int e = 0; e < 4; ++e) { VTl[(8 * wave + 2 * e) * 200 + j] = (bf16)(vw[i][e] & 0xffffu); VTl[(8 * wave + 2 * e + 1) * 200 + j] = (bf16)(vw[i][e] >> 16); } }
    }
    const int r = wave >> 1, qh = wave & 1, head = 4 * g + r;
    const float nb8 = -8.0f * exp2f(-(float)(head + 1));
    const float sink8 = 8.0f * P.sinks[head];
    const float c1 = 0.125f * 1.4426950408889634f;
    __syncthreads();
#pragma unroll 1
    for (int qt = 0; qt < 2; ++qt) {
        asm volatile("" ::: "memory");
        const int qi = 32 * qh + 16 * qt + fr;
        bf16x8 qf[2];
#pragma unroll
        for (int ks = 0; ks < 2; ++ks) { const u32x4 x0 = __builtin_bit_cast(u32x4, qa[0][ks]), x1 = __builtin_bit_cast(u32x4, qa[1][ks]); u32x4 xs;
#pragma unroll
            for (int e = 0; e < 4; ++e) xs[e] = qt ? x1[e] : x0[e];
            qf[ks] = __builtin_bit_cast(bf16x8, xs); }
        const float basef = (float)(128 + qi - 4 * fq);
        f32x4 s[12];
#pragma unroll
        for (int kt = 0; kt < 12; ++kt) {
#pragma unroll
            for (int rr = 0; rr < 4; ++rr) s[kt][rr] = fabsf(basef - (float)(16 * kt + rr)) * nb8;
#pragma unroll
            for (int ks = 0; ks < 2; ++ks) { const bf16x8 a = *(const LAS bf16x8*)(Kl + (16 * kt + fr) * 72 + 32 * ks + 8 * fq); s[kt] = MFMA16(a, qf[ks], s[kt]); } }
        if (jmin > 0) {
#pragma unroll
            for (int kt = 0; kt < 12; ++kt)
#pragma unroll
                for (int rr = 0; rr < 4; ++rr) s[kt][rr] = (16 * kt + 4 * fq + rr) >= jmin ? s[kt][rr] : -INFINITY;
        }
        float mx = sink8;
#pragma unroll
        for (int kt = 0; kt < 12; ++kt)
#pragma unroll
            for (int rr = 0; rr < 4; ++rr) mx = fmaxf(mx, s[kt][rr]);
        mx = fmaxf(mx, __shfl_xor(mx, 16)); mx = fmaxf(mx, __shfl_xor(mx, 32));
        const float mxc = mx * c1;
        float ls = 0.f;
#pragma unroll
        for (int kt = 0; kt < 12; ++kt)
#pragma unroll
            for (int rr = 0; rr < 4; ++rr) { const float p = __builtin_amdgcn_exp2f(s[kt][rr] * c1 - mxc); s[kt][rr] = p; ls += p; }
        ls += __shfl_xor(ls, 16); ls += __shfl_xor(ls, 32);
        const float inv = 1.0f / (ls + __builtin_amdgcn_exp2f(sink8 * c1 - mxc));
        f32x4 o[4];
#pragma unroll
        for (int dt = 0; dt < 4; ++dt) o[dt] = (f32x4){0.f, 0.f, 0.f, 0.f};
#pragma unroll
        for (int kk = 0; kk < 6; ++kk) {
            u32x4 w; w.x = pk2(s[2 * kk][0], s[2 * kk][1]); w.y = pk2(s[2 * kk][2], s[2 * kk][3]); w.z = pk2(s[2 * kk + 1][0], s[2 * kk + 1][1]); w.w = pk2(s[2 * kk + 1][2], s[2 * kk + 1][3]);
            const bf16x8 pb = __builtin_bit_cast(bf16x8, w);
#pragma unroll
            for (int dt = 0; dt < 4; ++dt) { const LAS bf16* vp = VTl + (16 * dt + fr) * 200 + 32 * kk + 4 * fq;
                const u32x2 lo = *(const LAS u32x2*)vp, hi = *(const LAS u32x2*)(vp + 16);
                const u32x4 aw = (u32x4){lo.x, lo.y, hi.x, hi.y}; const bf16x8 a = __builtin_bit_cast(bf16x8, aw);
                o[dt] = MFMA16(a, pb, o[dt]); }
        }
        bf16* mp = mix + (size_t)(qrow0 + qi) * DM + 512 + head * 64 + 4 * fq;
#pragma unroll
        for (int dt = 0; dt < 4; ++dt) { const f32x4 v = o[dt] * inv; u32x2 w; w.x = pk2(v[0], v[1]); w.y = pk2(v[2], v[3]); *(u32x2*)(mp + 16 * dt) = w; }
    }
}
__device__ __forceinline__ void phase3(const Params& P, LAS unsigned char* lds, int tid, int wave, int lane) {
    const int G = gridDim.x, NR = G / 2, blk = blockIdx.x;
    {
        const bool sample = blk >= NR; const int bh = (sample ? blk - NR : blk) & 127, b = bh >> 2, h = bh & 3;
        if (blk < 2 * NR && (sample ? blk - NR : blk) < 128)
            ret_item(P, lds, tid, wave, lane, h, sample ? MP + 64 * b : b * SEQ, sample ? 1 : 32, P.state_ret + (size_t)bh * 16384, sample, P.out + (sample ? OFF_SRET : OFF_PRET) + (size_t)bh * 16384);
    }
    if (blk >= NR) {
        for (int it = blk - NR; it < 2112; it += G - NR) {
            const bool sample = it >= 2048;
            att_item(P, lds, tid, wave, lane, sample, sample ? (it - 2048) >> 1 : it >> 6, sample ? 2 : (it >> 1) & 31, it & 1);
        }
    }
}

__device__ __forceinline__ void phase6(const Params& P, int tid) {
    const bf16* ua = (const bf16*)(P.ws + WS_R1); bf16* ub = (bf16*)(P.ws + WS_R2);
    constexpr int CH = DFF / 8;
    const int total = MT * CH;
    for (int idx = blockIdx.x * 512 + tid; idx < total; idx += gridDim.x * 512) {
        const int row = idx / CH, j = (idx - row * CH) * 8;
        const bool smp = row >= MP; const int t = smp ? ((row - MP) & 63) : (row & 2047);
        float a[8], p1[8], p2[8], bb[8];
        unpack8(*(const u32x4*)(ua + (size_t)row * DFF + j), a);
        unpack8(*(const u32x4*)(ub + (size_t)row * DFF + j), bb);
        if (t >= 1) unpack8(*(const u32x4*)(ua + (size_t)(row - 1) * DFF + j), p1);
        else if (smp) { const float* s = P.state_conv + ((size_t)((row - MP) >> 6) * 2 + 1) * DFF + j; const f32x4 x = *(const f32x4*)s, y = *(const f32x4*)(s + 4); p1[0] = x.x; p1[1] = x.y; p1[2] = x.z; p1[3] = x.w; p1[4] = y.x; p1[5] = y.y; p1[6] = y.z; p1[7] = y.w; }
        else {
#pragma unroll
            for (int e = 0; e < 8; ++e) p1[e] = 0.f; }
        if (t >= 2) unpack8(*(const u32x4*)(ua + (size_t)(row - 2) * DFF + j), p2);
        else if (smp) { const float* s = P.state_conv + ((size_t)((row - MP) >> 6) * 2 + t) * DFF + j; const f32x4 x = *(const f32x4*)s, y = *(const f32x4*)(s + 4); p2[0] = x.x; p2[1] = x.y; p2[2] = x.z; p2[3] = x.w; p2[4] = y.x; p2[5] = y.y; p2[6] = y.z; p2[7] = y.w; }
        else {
#pragma unroll
            for (int e = 0; e < 8; ++e) p2[e] = 0.f; }
        float r[8];
#pragma unroll
        for (int h = 0; h < 2; ++h) { const f32x4 w0 = *(const f32x4*)(P.conv_w + j + 4 * h), w1 = *(const f32x4*)(P.conv_w + DFF + j + 4 * h), w2 = *(const f32x4*)(P.conv_w + 2 * DFF + j + 4 * h), cb = *(const f32x4*)(P.conv_b + j + 4 * h);
#pragma unroll
            for (int e = 0; e < 4; ++e) { const float cv = cb[e] + w0[e] * p2[4 * h + e] + w1[e] * p1[4 * h + e] + w2[e] * a[4 * h + e]; r[4 * h + e] = silu_f(cv) * bb[4 * h + e]; } }
        u32x4 w; w.x = pk2(r[0], r[1]); w.y = pk2(r[2], r[3]); w.z = pk2(r[4], r[5]); w.w = pk2(r[6], r[7]);
        *(u32x4*)(ub + (size_t)row * DFF + j) = w;
    }
}
#ifdef CONV_FUSED
__device__ __forceinline__ void phase6c(const Params& P, int tid) {
    const float* headA = (const float*)(P.ws + WS_R1); const float* headB = headA + HT_STRIDE; const float* tailA = headA + 2 * HT_STRIDE;
    bf16* act = (bf16*)(P.ws + WS_R2);
    constexpr int CH = DFF / 4;
    const int total = NGRP * CH;
    for (int idx = blockIdx.x * 512 + tid; idx < total; idx += gridDim.x * 512) {
        const int g = idx / CH, j = (idx - g * CH) * 4;
        const bool smp = g >= 1024, first = !smp && (g & 31) == 0;
        const float* pp = smp ? P.state_conv + ((size_t)(g - 1024) * 2) * DFF + j : tailA + ((size_t)(first ? g : g - 1) * 2) * DFF + j;
        f32x4 p0 = *(const f32x4*)pp, p1 = *(const f32x4*)(pp + DFF);
        const f32x4 a0 = *(const f32x4*)(headA + ((size_t)g * 2) * DFF + j), a1 = *(const f32x4*)(headA + ((size_t)g * 2 + 1) * DFF + j);
        const f32x4 b0 = *(const f32x4*)(headB + ((size_t)g * 2) * DFF + j), b1 = *(const f32x4*)(headB + ((size_t)g * 2 + 1) * DFF + j);
        const f32x4 t0 = *(const f32x4*)(tailA + ((size_t)g * 2) * DFF + j), t1 = *(const f32x4*)(tailA + ((size_t)g * 2 + 1) * DFF + j);
        const f32x4 w0 = *(const f32x4*)(P.conv_w + j), w1 = *(const f32x4*)(P.conv_w + DFF + j), w2 = *(const f32x4*)(P.conv_w + 2 * DFF + j), cb = *(const f32x4*)(P.conv_b + j);
        if (first) { p0 = (f32x4){0.f, 0.f, 0.f, 0.f}; p1 = (f32x4){0.f, 0.f, 0.f, 0.f}; }
        const f32x4 c0 = cb + w0 * p0 + w1 * p1 + w2 * a0, c1 = cb + w0 * p1 + w1 * a0 + w2 * a1;
        u32x2 r0, r1;
        r0.x = pk2(silu_f(c0.x) * b0.x, silu_f(c0.y) * b0.y); r0.y = pk2(silu_f(c0.z) * b0.z, silu_f(c0.w) * b0.w);
        r1.x = pk2(silu_f(c1.x) * b1.x, silu_f(c1.y) * b1.y); r1.y = pk2(silu_f(c1.z) * b1.z, silu_f(c1.w) * b1.w);
        *(u32x2*)(act + (size_t)(64 * g) * DFF + j) = r0;
        *(u32x2*)(act + (size_t)(64 * g + 1) * DFF + j) = r1;
        if (smp) { float* d = P.out + OFF_SCONV + ((size_t)(g - 1024) * 2) * DFF + j; *(f32x4*)d = t0; *(f32x4*)(d + DFF) = t1; }
        else if ((g & 31) == 31) { float* d = P.out + OFF_PCONV + ((size_t)(g >> 5) * 2) * DFF + j; *(f32x4*)d = t0; *(f32x4*)(d + DFF) = t1; }
    }
}
#endif
__device__ __forceinline__ void phase8n(const Params& P, LAS unsigned char* lds, int tid, int wave, int lane) {
    const float* mod = (const float*)(P.ws + WS_MOD); const bf16* x2 = (const bf16*)(P.ws + WS_R0);
    LAS float* lv = (LAS float*)lds;
    const int b = blockIdx.x, bsP = b >> 3, bsS = 32 + (b >> 3);
    __syncthreads();
    for (int i = tid; i < 4096; i += 512) { const int sl = i >> 11, which = (i >> 10) & 1, col = i & 1023; const float* mb = mod + (size_t)(sl ? bsS : bsP) * 8192 + 6144;
        lv[i] = which ? P.normf[col] * (1.f + mb[1024 + col]) : mb[col]; }
    __syncthreads();
#pragma unroll 4
    for (int r = wave; r < 256; r += 8) {
        const int row = 256 * b + r;
        const bf16* xr = x2 + (size_t)row * DM + 4 * lane;
        f32x4 v[4]; float ss = 0.f;
#pragma unroll
        for (int j = 0; j < 4; ++j) { const u32x2 w = *(const u32x2*)(xr + 256 * j); v[j] = (f32x4){bflo(w.x), bfhi(w.x), bflo(w.y), bfhi(w.y)};
            ss += (v[j].x * v[j].x + v[j].y * v[j].y) + (v[j].z * v[j].z + v[j].w * v[j].w); }
        const float rstd = __builtin_amdgcn_rsqf(wave_sum_dpp(ss) * (1.f / DM) + EPS);
        float* yr = P.out + (size_t)row * DM + 4 * lane;
#pragma unroll
        for (int j = 0; j < 4; ++j) { const f32x4 sh = *(const LAS f32x4*)(lv + 256 * j + 4 * lane), gs = *(const LAS f32x4*)(lv + 1024 + 256 * j + 4 * lane);
            *(f32x4*)(yr + 256 * j) = v[j] * rstd * gs + sh; }
    }
    {
        const int r = 8 * b + wave, row = MP + r;
        const bf16* xr = (const bf16*)(P.ws + WS_X1B) + (size_t)row * DM + 4 * lane;
        const float* sl = (const float*)(P.ws + WS_SLAB) + (size_t)r * DM + 4 * lane;
        const float* g2 = mod + (size_t)bsS * 8192 + 5120 + 4 * lane;
        f32x4 v[4]; float ss = 0.f;
#pragma unroll
        for (int j = 0; j < 4; ++j) { const u32x2 w = *(const u32x2*)(xr + 256 * j); f32x4 a = *(const f32x4*)(sl + 256 * j);
#pragma unroll
            for (int p = 1; p < 4; ++p) a += *(const f32x4*)(sl + (size_t)p * MS * DM + 256 * j);
            v[j] = (f32x4){bflo(w.x), bfhi(w.x), bflo(w.y), bfhi(w.y)} + *(const f32x4*)(g2 + 256 * j) * a;
            ss += (v[j].x * v[j].x + v[j].y * v[j].y) + (v[j].z * v[j].z + v[j].w * v[j].w); }
        const float rstd = __builtin_amdgcn_rsqf(wave_sum_dpp(ss) * (1.f / DM) + EPS);
        float* yr = P.out + (size_t)row * DM + 4 * lane;
#pragma unroll
        for (int j = 0; j < 4; ++j) { const f32x4 sh = *(const LAS f32x4*)(lv + 2048 + 256 * j + 4 * lane), gs = *(const LAS f32x4*)(lv + 3072 + 256 * j + 4 * lane);
            *(f32x4*)(yr + 256 * j) = v[j] * rstd * gs + sh; }
    }
}
__device__ __forceinline__ void phase8(const Params& P, int wave, int lane) {
    const float* mod = (const float*)(P.ws + WS_MOD); const bf16* x2 = (const bf16*)(P.ws + WS_R0);
    const int gw = blockIdx.x * 8 + wave, NGW = gridDim.x * 8;
#pragma unroll 2
    for (int row = gw; row < MT; row += NGW) {
        const int bs = row < MP ? (row >> 11) : 32 + ((row - MP) >> 6);
        float* yr = P.out + (size_t)row * DM + 8 * lane;
        const float* mb = mod + (size_t)bs * 8192 + 6144 + 8 * lane;
        float v[2][8]; float ss = 0.f;
        if (row < MP) {
            const bf16* xr = x2 + (size_t)row * DM + 8 * lane;
#pragma unroll
            for (int j = 0; j < 2; ++j) unpack8(*(const u32x4*)(xr + 512 * j), v[j]);
        } else {
            const bf16* xr = (const bf16*)(P.ws + WS_X1B) + (size_t)row * DM + 8 * lane;
            const float* sl = (const float*)(P.ws + WS_SLAB) + (size_t)(row - MP) * DM + 8 * lane;
            const float* g2 = mod + (size_t)bs * 8192 + 5120 + 8 * lane;
#pragma unroll
            for (int j = 0; j < 2; ++j) { unpack8(*(const u32x4*)(xr + 512 * j), v[j]);
#pragma unroll
                for (int h = 0; h < 2; ++h) { const int o = 512 * j + 4 * h; f32x4 a = *(const f32x4*)(sl + o);
#pragma unroll
                    for (int p = 1; p < 4; ++p) a += *(const f32x4*)(sl + (size_t)p * MS * DM + o);
                    const f32x4 g = *(const f32x4*)(g2 + o);
#pragma unroll
                    for (int e = 0; e < 4; ++e) v[j][4 * h + e] += g[e] * a[e]; } }
        }
#pragma unroll
        for (int j = 0; j < 2; ++j)
#pragma unroll
            for (int e = 0; e < 8; ++e) ss += v[j][e] * v[j][e];
        const float rstd = rsqrtf(wave_sum(ss) * (1.f / DM) + EPS);
#pragma unroll
        for (int j = 0; j < 2; ++j)
#pragma unroll
            for (int h = 0; h < 2; ++h) { const int o = 512 * j + 4 * h; const f32x4 sh = *(const f32x4*)(mb + o), sc = *(const f32x4*)(mb + 1024 + o), gn = *(const f32x4*)(P.normf + 8 * lane + o);
                const f32x4 x = (f32x4){v[j][4 * h], v[j][4 * h + 1], v[j][4 * h + 2], v[j][4 * h + 3]};
                *(f32x4*)(yr + o) = x * rstd * gn * (sc + 1.0f) + sh; }
    }
}
__device__ __forceinline__ void phase8q(const Params& P, LAS unsigned char* lds, int tid, int wave, int lane) {
    const float* mod = (const float*)(P.ws + WS_MOD);
    unsigned* cnt = (unsigned*)(P.ws + WS_CNT7); unsigned* ticket = (unsigned*)(P.ws + WS_TICKET);
    LAS int* ord = (LAS int*)(lds + 131072);
    LAS int* flag = ord + 272;
    pg8::StaticOrder S; S.init(MT, DM, (int)gridDim.x, 0);
    for (int i = tid; i < NTM; i += 512) flag[i] = 0;
    __syncthreads();
    { const int full = (S.nwg / S.G) * S.G; for (int L = full + tid; L < S.nwg; L += 512) { pg8::Unit u; S.map(L, u); flag[u.pm] = 1; } }
    __syncthreads();
    if (tid == 0) { int k = 0; for (int i = 0; i < NTM; ++i) if (!flag[i]) ord[k++] = i; for (int i = 0; i < NTM; ++i) if (flag[i]) ord[k++] = i; }
    __syncthreads();
    for (;;) {
        if (tid == 0) flag[268] = (int)__hip_atomic_fetch_add(ticket, 1u, __ATOMIC_RELAXED, __HIP_MEMORY_SCOPE_AGENT);
        __syncthreads();
        const int tk = flag[268];
        if (tk >= NTM * 4) break;
        const int pm = ord[tk >> 2], rb = tk & 3;
        if (wave == 0) {
            unsigned spins = 0;
            while ((unsigned)__builtin_amdgcn_readfirstlane(__hip_atomic_load(cnt + 64 * pm, __ATOMIC_RELAXED, __HIP_MEMORY_SCOPE_AGENT)) < 32u) { __builtin_amdgcn_s_sleep(4); if (++spins > (1u << 22)) break; }
            __builtin_amdgcn_fence(__ATOMIC_ACQUIRE, "agent");
            asm volatile("s_waitcnt vmcnt(0)" ::: "memory");
        }
        __syncthreads();
#pragma unroll 2
        for (int i = 0; i < 8; ++i) {
            const int row = pm * 256 + rb * 64 + wave * 8 + i;
            const int bs = row < MP ? (row >> 11) : 32 + ((row - MP) >> 6);
            float* yr = P.out + (size_t)row * DM + 4 * lane;
            const float* mb = mod + (size_t)bs * 8192 + 6144 + 4 * lane;
            f32x4 v[4]; float ss = 0.f;
#pragma unroll
            for (int j = 0; j < 4; ++j) { v[j] = *(const f32x4*)(yr + 256 * j); ss += (v[j].x * v[j].x + v[j].y * v[j].y) + (v[j].z * v[j].z + v[j].w * v[j].w); }
            const float rstd = rsqrtf(wave_sum(ss) * (1.f / DM) + EPS);
#pragma unroll
            for (int j = 0; j < 4; ++j) { const f32x4 sh = *(const f32x4*)(mb + 256 * j), sc = *(const f32x4*)(mb + 1024 + 256 * j), gn = *(const f32x4*)(P.normf + 4 * lane + 256 * j);
                *(f32x4*)(yr + 256 * j) = v[j] * rstd * gn * (sc + 1.0f) + sh; }
        }
    }
}

__device__ __forceinline__ void sample_fix(const Params& P, int wave, int lane) {
    const float* mod = (const float*)(P.ws + WS_MOD); const float* sl0 = (const float*)(P.ws + WS_SLAB4);
    bf16* a2 = (bf16*)(P.ws + WS_R0); bf16* x1b = (bf16*)(P.ws + WS_X1B); float* ss1 = (float*)(P.ws + WS_SS1);
    const int gw = blockIdx.x * 8 + wave, NGW = gridDim.x * 8;
    for (int r = gw; r < MS; r += NGW) {
        const int row = MP + r, bs = 32 + (r >> 6);
        const float* xr = P.x_s + (size_t)r * DM + 8 * lane; const float* sl = sl0 + (size_t)r * DM + 8 * lane; const float* mb = mod + (size_t)bs * 8192 + 8 * lane;
        float v[2][8], a[2][8]; float ss = 0.f;
#pragma unroll
        for (int j = 0; j < 2; ++j)
#pragma unroll
            for (int h = 0; h < 2; ++h) { const int o = 512 * j + 4 * h; f32x4 acc = *(const f32x4*)(sl + o);
#pragma unroll
                for (int p = 1; p < 4; ++p) acc += *(const f32x4*)(sl + (size_t)p * MS * DM + o);
                const f32x4 x = *(const f32x4*)(xr + o) + *(const f32x4*)(mb + 2048 + o) * acc;
                const f32x4 gs = *(const f32x4*)(P.ln2 + 8 * lane + o) * (*(const f32x4*)(mb + 4096 + o) + 1.0f);
#pragma unroll
                for (int e = 0; e < 4; ++e) { v[j][4 * h + e] = x[e]; a[j][4 * h + e] = x[e] * gs[e]; ss += x[e] * x[e]; } }
        ss = wave_sum(ss);
#pragma unroll
        for (int j = 0; j < 2; ++j) { u32x4 w; w.x = pk2(v[j][0], v[j][1]); w.y = pk2(v[j][2], v[j][3]); w.z = pk2(v[j][4], v[j][5]); w.w = pk2(v[j][6], v[j][7]);
            *(u32x4*)(x1b + (size_t)row * DM + 8 * lane + 512 * j) = w;
            w.x = pk2(a[j][0], a[j][1]); w.y = pk2(a[j][2], a[j][3]); w.z = pk2(a[j][4], a[j][5]); w.w = pk2(a[j][6], a[j][7]);
            *(u32x4*)(a2 + (size_t)row * DM + 8 * lane + 512 * j) = w; }
        if (lane < 16) ss1[(size_t)row * 16 + lane] = lane == 0 ? ss : 0.f;
    }
}

#ifndef N_LAUNCH
#define N_LAUNCH 1
#endif
#define LAUNDER_TID() int tid = threadIdx.x; asm volatile("" : "+v"(tid)); const int lane = tid & 63, wave = __builtin_amdgcn_readfirstlane(tid >> 6); (void)lane; (void)wave
template <int PHM>
__global__ void __launch_bounds__(512) fwd_mega(Params P) {
    extern __shared__ __attribute__((aligned(16))) unsigned char lds_raw[];
    LAS unsigned char* lds = (LAS unsigned char*)lds_raw;
    const int G = gridDim.x;
    unsigned char* ws = P.ws;
    volatile LAS unsigned* misc = (volatile LAS unsigned*)(lds + LDS_MISC);
    if (threadIdx.x < 2) misc[threadIdx.x] = 0u;
    __syncthreads();
    XcdBarrier bar; bar.bar = (unsigned*)(ws + WS_BAR); bar.x = 0; bar.st = misc;
#define GSYNC(a, b) do { if ((PHM & (a)) && (PHM & (b))) xcd_barrier(bar); } while (0)
    if constexpr (PHM == 511) {
      if (blockIdx.x == 0) for (int i = threadIdx.x; i < XCD_BAR_WORDS; i += 512) ((unsigned*)(ws + WS_BAR))[i] = 0u;
      if (blockIdx.x == 1) { for (int i = threadIdx.x; i < NTM * 64; i += 512) ((unsigned*)(ws + WS_CNT7))[i] = 0u; if (threadIdx.x < 64) ((unsigned*)(ws + WS_TICKET))[threadIdx.x] = 0u; }
      cg::this_grid().sync();
      bar = xcd_barrier_post((unsigned*)(ws + WS_BAR), misc); }
    if constexpr ((PHM & 1) != 0) { LAUNDER_TID(); phase0(P, lds, wave, lane); }
    GSYNC(1, 2);
    if constexpr ((PHM & 2) != 0) { LAUNDER_TID(); phase1(P, lds, tid, wave, lane); }
    GSYNC(2, 4);
    if constexpr ((PHM & 4) != 0) {
      pg8::Gemm g{(const bf16*)(ws + WS_R0), (const bf16*)(ws + WS_WIN), MT, INW, DM};
      OrderX S; S.S.init(MT, INW, G, (int)blockIdx.x); S.nX = 22; S.xpm = NTM; S.xpn0 = 11;
      Epi1 E{(bf16*)(ws + WS_R1), (float*)(ws + WS_SHW), P.out};
      pg8::gemm_phase<Epi1, OrderX, true, true>(lds, g, S, E); }
    GSYNC(4, 8);
    if constexpr ((PHM & 8) != 0) { LAUNDER_TID(); phase3(P, lds, tid, wave, lane);
#ifdef PROBE_P3X2
      cg::this_grid().sync(); phase3(P, lds, tid, wave, lane);
#endif
    }
    GSYNC(8, 16);
    if constexpr ((PHM & 16) != 0) {
      pg8::Gemm g{(const bf16*)(ws + WS_R2), (const bf16*)(ws + WS_WOUT), MT, DM, DM};
      OrderDown S; S.S.init(MP, DM, G, (int)blockIdx.x); S.ka = 4; S.kb = 4;
      Epi2 E{P.x_p, P.x_s, (const float*)(ws + WS_MOD), P.ln2, (bf16*)(ws + WS_X1B), (bf16*)(ws + WS_R0), (float*)(ws + WS_SS1), (float*)(ws + WS_SLAB4)};
      pg8::gemm_phase<Epi2, OrderDown, true, true>(lds, g, S, E); }
    GSYNC(16, 32);
    if constexpr ((PHM & 32) != 0) {
      LAUNDER_TID();
      sample_fix(P, wave, lane);
      if constexpr (PHM == 511) xcd_barrier(bar);
      pg8::Gemm g{(const bf16*)(ws + WS_R0), (const bf16*)(ws + WS_WUP), MT, 2 * DFF, DM};
      pg8::StaticOrder S; S.init(MT, 2 * DFF, G, (int)blockIdx.x);
      LAS float* rtab = (LAS float*)(lds + 131072);
      {
        LAS int* pmt = (LAS int*)lds;
        if (tid < 24) { pg8::Unit u; const bool ok = S.next(tid, u); pmt[tid] = ok ? u.pm : -1; }
        __syncthreads();
        if (tid < 256) { const float* ss = (const float*)(ws + WS_SS1);
#pragma unroll
          for (int i0 = 0; i0 < 24; i0 += 6) {
            f32x4 q[6][4]; int pmv[6];
#pragma unroll
            for (int k = 0; k < 6; ++k) { pmv[k] = pmt[i0 + k]; const f32x4* sp = (const f32x4*)(ss + (size_t)((pmv[k] < 0 ? 0 : pmv[k]) * 256 + tid) * 16);
#pragma unroll
                for (int e = 0; e < 4; ++e) q[k][e] = sp[e]; }
#pragma unroll
            for (int k = 0; k < 6; ++k) { const float tot = ((q[k][0].x + q[k][0].y) + (q[k][0].z + q[k][0].w)) + ((q[k][1].x + q[k][1].y) + (q[k][1].z + q[k][1].w)) + ((q[k][2].x + q[k][2].y) + (q[k][2].z + q[k][2].w)) + ((q[k][3].x + q[k][3].y) + (q[k][3].z + q[k][3].w));
                rtab[(i0 + k) * 256 + tid] = __builtin_amdgcn_rsqf(tot * (1.f / DM) + EPS); } } }
        __syncthreads(); }
#ifdef CONV_FUSED
      float* hA = (float*)(ws + WS_R1);
      Epi3C E{rtab, (const float*)(ws + WS_SHW), P.conv_w, P.conv_b, (bf16*)(ws + WS_R2), hA, hA + HT_STRIDE, hA + 2 * HT_STRIDE};
      pg8::gemm_phase<Epi3C, pg8::StaticOrder, true, true>(lds, g, S, E);
#else
      Epi3 E{rtab, (const float*)(ws + WS_SHW), (bf16*)(ws + WS_R1), (bf16*)(ws + WS_R2), P.out};
      pg8::gemm_phase<Epi3, pg8::StaticOrder, true, true>(lds, g, S, E);
#endif
#ifdef PROBE_P5X2
      cg::this_grid().sync(); pg8::gemm_phase<Epi3, pg8::StaticOrder, true, true>(lds, g, S, E);
#endif
    }
    GSYNC(32, 64);
#ifdef CONV_FUSED
    if constexpr ((PHM & 64) != 0) { LAUNDER_TID(); phase6c(P, tid); }
#else
    if constexpr ((PHM & 64) != 0) { LAUNDER_TID(); phase6(P, tid); }
#endif
    GSYNC(64, 128);
    if constexpr ((PHM & 128) != 0) {
      pg8::Gemm g{(const bf16*)(ws + WS_R2), (const bf16*)(ws + WS_WDN), MT, DM, DFF};
#ifdef P8_QUEUE
      OrderPub S; S.init(MT, DM, G, (int)blockIdx.x); S.cnt = (unsigned*)(ws + WS_CNT7);
      Epi4 E{(const float*)(ws + WS_MOD), (const bf16*)(ws + WS_X1B), (bf16*)(ws + WS_R0), (float*)(ws + WS_SLAB)};
      pg8::gemm_phase<Epi4, OrderPub, true, true>(lds, g, S, E); }
    if constexpr ((PHM & 256) != 0) { LAUNDER_TID(); phase8q(P, lds, tid, wave, lane); }
#else
      OrderDown S; S.S.init(MP, DM, G, (int)blockIdx.x); S.ka = 12; S.kb = 10;
      Epi4 E{(const float*)(ws + WS_MOD), (const bf16*)(ws + WS_X1B), (bf16*)(ws + WS_R0), (float*)(ws + WS_SLAB)};
      pg8::gemm_phase<Epi4, OrderDown, true, true>(lds, g, S, E); }
    GSYNC(128, 256);
    if constexpr ((PHM & 256) != 0) { LAUNDER_TID(); if (gridDim.x == 256) phase8n(P, lds, tid, wave, lane); else phase8(P, wave, lane); }
#endif
}

template <int PHM> static bool launch_one(const Params& p, int grid, bool coop, hipStream_t stream) {
    static bool attr_done = false;
    if (!attr_done) { if (hipFuncSetAttribute((const void*)fwd_mega<PHM>, hipFuncAttributeMaxDynamicSharedMemorySize, LDS_BYTES) != hipSuccess) { fprintf(stderr, "kernel_launch: hipFuncSetAttribute failed\n"); return false; } attr_done = true; }
    hipError_t e;
    if (coop) { Params pc = p; void* args[] = {&pc}; e = hipLaunchCooperativeKernel((const void*)fwd_mega<PHM>, dim3(grid), dim3(512), args, LDS_BYTES, stream); }
    else { hipLaunchKernelGGL(fwd_mega<PHM>, dim3(grid), dim3(512), LDS_BYTES, stream, p); e = hipPeekAtLastError(); }
    if (e != hipSuccess) { fprintf(stderr, "launch (mask %d) failed: %s (grid %d)\n", PHM, hipGetErrorString(e), grid); return false; }
    return true;
}
extern "C" void kernel_launch(void* const* d_in, const int* in_sizes, int n_in, void* d_out, int out_size, void* d_ws, size_t ws_size, hipStream_t stream) {
    static int grid = 0;
    if (grid == 0) {
        if (n_in != 22 || (size_t)out_size != OUT_TOTAL || ws_size < WS_END) { fprintf(stderr, "kernel_launch: unexpected sizes n_in %d out %d ws %zu\n", n_in, out_size, ws_size); grid = -1; return; }
        int dev = 0, cus = 0;
        (void)hipGetDevice(&dev);
        (void)hipDeviceGetAttribute(&cus, hipDeviceAttributeMultiprocessorCount, dev);
        grid = cus;
        if (grid > 256) grid = 256;
        if (grid < 2) grid = -1;
    }
    if (grid < 0) return;
    Params p{};
    const float** pp = (const float**)&p;
    for (int i = 0; i < 22; ++i) pp[i] = (const float*)d_in[i];
    p.out = (float*)d_out; p.ws = (unsigned char*)d_ws;
#if N_LAUNCH == 1
    launch_one<511>(p, grid, true, stream);
#else
    launch_one<1>(p, grid, false, stream) && launch_one<2>(p, grid, false, stream) && launch_one<4>(p, grid, false, stream) && launch_one<8>(p, grid, false, stream) &&
    launch_one<16>(p, grid, false, stream) && launch_one<32>(p, grid, false, stream) && launch_one<64>(p, grid, false, stream) && launch_one<128>(p, grid, false, stream) && launch_one<256>(p, grid, false, stream);
#endif
}
```
